# Optimizing an MI355X kernel written in HIP

```python
import jax, jax.numpy as jnp
from jax import lax
import numpy as np

D_MODEL = 4096
BATCH = 2
SEQ = 8192
DEPTH = 1

MEM_LEN = 256
MIX_WIDTH = D_MODEL
POOL_WIDTH = MIX_WIDTH // 2
ATTN_WIDTH = MIX_WIDTH - POOL_WIDTH
POOL_WINDOWS = (2, 4, 8, 16)
N_POOL_GROUPS = len(POOL_WINDOWS)
POOL_GROUP_WIDTH = POOL_WIDTH // N_POOL_GROUPS
HEAD_DIM = 128
MOBA_HEADS = ATTN_WIDTH // HEAD_DIM
MOBA_BLOCK = 256
MOBA_TOPK = 3
MOBA_Q_CHUNK = 32
MIX_IN_WIDTH = POOL_WIDTH + 3 * ATTN_WIDTH
ROPE_THETA = 10000.0
XATTN_HEADS = 4
XATTN_HEAD_DIM = D_MODEL // XATTN_HEADS
FFN_HIDDEN = -((-8 * D_MODEL) // (3 * 256)) * 256
LN_EPS = 1e-5
DEEPNORM_ALPHA = (2 * DEPTH) ** 0.25
DEEPNORM_BETA = (8 * DEPTH) ** -0.25

kernel_name = 'hybrid_pool_moba_deepnorm_block'


def layer_norm(x, g, b):
    xf = x.astype(jnp.float32)
    mu = jnp.mean(xf, axis=-1, keepdims=True)
    var = jnp.mean(jnp.square(xf - mu), axis=-1, keepdims=True)
    return ((xf - mu) * lax.rsqrt(var + LN_EPS) * g + b).astype(x.dtype)


def rope(t, pos):
    half = t.shape[-1] // 2
    inv = ROPE_THETA ** (-jnp.arange(half, dtype=jnp.float32) / half)
    ang = pos.astype(jnp.float32)[:, None] * inv[None, :]
    cos, sin = jnp.cos(ang), jnp.sin(ang)
    t1 = t[..., :half].astype(jnp.float32)
    t2 = t[..., half:].astype(jnp.float32)
    return jnp.concatenate([t1 * cos - t2 * sin, t2 * cos + t1 * sin], axis=-1).astype(t.dtype)


def pool_mixer(u, w_pool, scale):
    B, S, _ = u.shape
    u = u.reshape(B, S, N_POOL_GROUPS, POOL_GROUP_WIDTH)
    uf = u.astype(jnp.float32)
    cs = jnp.pad(jnp.cumsum(uf, axis=1), ((0, 0), (1, 0), (0, 0), (0, 0)))
    win = jnp.array(POOL_WINDOWS, dtype=jnp.int32)
    t = jnp.arange(S, dtype=jnp.int32)
    lo = jnp.maximum(t[:, None] + 1 - win[None, :], 0)
    cnt = jnp.minimum(t[:, None] + 1, win[None, :]).astype(jnp.float32)
    grp = jnp.arange(N_POOL_GROUPS)[None, :]
    mean = (cs[:, 1:] - cs[:, lo, grp]) / cnt[None, :, :, None]
    mixed = (mean - uf).astype(u.dtype)
    y = jnp.einsum('bsgc,gcd->bsgd', mixed, w_pool) * scale.reshape(N_POOL_GROUPS, POOL_GROUP_WIDTH)
    return y.reshape(B, S, POOL_WIDTH)


def _gather_blocks(blocks, idx):
    return jax.vmap(jax.vmap(lambda bl, i: bl[i]))(blocks, idx)


def moba_attention(q, k, v):
    B, H, S, hd = q.shape
    nb = -(-S // MOBA_BLOCK)
    sp = nb * MOBA_BLOCK
    pad = ((0, 0), (0, 0), (0, sp - S), (0, 0))
    q, k, v = jnp.pad(q, pad), jnp.pad(k, pad), jnp.pad(v, pad)
    kb = k.reshape(B, H, nb, MOBA_BLOCK, hd)
    vb = v.reshape(B, H, nb, MOBA_BLOCK, hd)
    kmean = jnp.mean(kb.astype(jnp.float32), axis=3)
    gate = jnp.einsum('bhtd,bhnd->bhtn', q.astype(jnp.float32), kmean)
    qblk_all = jnp.arange(sp) // MOBA_BLOCK
    gate = jnp.where(jnp.arange(nb)[None, :] < qblk_all[:, None], gate, -jnp.inf)
    k_sel = min(MOBA_TOPK, nb)
    _, sel_idx = lax.top_k(gate, k_sel)
    scale = HEAD_DIM ** -0.5
    key_off = jnp.arange(MOBA_BLOCK)
    C = MOBA_Q_CHUNK

    def step(s0):
        qc = lax.dynamic_slice_in_dim(q, s0, C, axis=2)
        ic = lax.dynamic_slice_in_dim(sel_idx, s0, C, axis=2)
        blk = s0 // MOBA_BLOCK
        kown = lax.dynamic_index_in_dim(kb, blk, axis=2, keepdims=False)
        vown = lax.dynamic_index_in_dim(vb, blk, axis=2, keepdims=False)
        ksel = _gather_blocks(kb, ic)
        vsel = _gather_blocks(vb, ic)
        qpos = s0 + jnp.arange(C)
        sel_ok = jnp.arange(k_sel)[None, :] < (qpos // MOBA_BLOCK)[:, None]
        own_ok = (blk * MOBA_BLOCK + key_off)[None, :] <= qpos[:, None]
        s_sel = jnp.einsum('bhcd,bhckpd->bhckp', qc, ksel).astype(jnp.float32) * scale
        s_sel = jnp.where(sel_ok[None, None, :, :, None], s_sel, -jnp.inf)
        s_sel = s_sel.reshape(B, H, C, k_sel * MOBA_BLOCK)
        s_own = jnp.einsum('bhcd,bhpd->bhcp', qc, kown).astype(jnp.float32) * scale
        s_own = jnp.where(own_ok[None, None], s_own, -jnp.inf)
        p = jax.nn.softmax(jnp.concatenate([s_sel, s_own], axis=-1), axis=-1)
        p_sel = p[..., :k_sel * MOBA_BLOCK].reshape(B, H, C, k_sel, MOBA_BLOCK).astype(v.dtype)
        p_own = p[..., k_sel * MOBA_BLOCK:].astype(v.dtype)
        return (jnp.einsum('bhckp,bhckpd->bhcd', p_sel, vsel)
                + jnp.einsum('bhcp,bhpd->bhcd', p_own, vown))

    out = lax.map(step, jnp.arange(sp // C, dtype=jnp.int32) * C)
    out = out.transpose(1, 2, 0, 3, 4).reshape(B, H, sp, hd)
    return out[:, :, :S]


def hybrid_mixer(x, w_in, w_pool, pool_scale, w_out, pos):
    B, S, _ = x.shape
    h = x @ w_in
    hp = h[..., :POOL_WIDTH]
    hq = h[..., POOL_WIDTH:POOL_WIDTH + ATTN_WIDTH]
    hk = h[..., POOL_WIDTH + ATTN_WIDTH:POOL_WIDTH + 2 * ATTN_WIDTH]
    hv = h[..., POOL_WIDTH + 2 * ATTN_WIDTH:]
    pool_out = pool_mixer(hp, w_pool, pool_scale)

    def to_heads(t):
        return t.reshape(B, S, MOBA_HEADS, HEAD_DIM).transpose(0, 2, 1, 3)

    q = rope(to_heads(hq), pos)
    k = rope(to_heads(hk), pos)
    a = moba_attention(q, k, to_heads(hv))
    a = a.transpose(0, 2, 1, 3).reshape(B, S, ATTN_WIDTH)
    return jnp.concatenate([pool_out, a], axis=-1) @ w_out


def memory_cross_attention(x, mem, wq, wkv, wo):
    B, S, D = x.shape
    M = mem.shape[1]
    q = (x @ wq).reshape(B, S, XATTN_HEADS, XATTN_HEAD_DIM)
    kv = mem @ wkv
    k = kv[..., :D].reshape(B, M, XATTN_HEADS, XATTN_HEAD_DIM)
    v = kv[..., D:].reshape(B, M, XATTN_HEADS, XATTN_HEAD_DIM)
    s = jnp.einsum('bshd,bmhd->bhsm', q, k).astype(jnp.float32) * XATTN_HEAD_DIM ** -0.5
    p = jax.nn.softmax(s, axis=-1).astype(x.dtype)
    o = jnp.einsum('bhsm,bmhd->bshd', p, v).reshape(B, S, D)
    return o @ wo


def swiglu_ffn(x, w_gate, w_up, w_down):
    return (jax.nn.silu(x @ w_gate) * (x @ w_up)) @ w_down


def _normal(key, shape, std):
    return std * jax.random.normal(key, shape, dtype=jnp.float32)


def setup_inputs(seed: int = 0) -> dict:
    key = jax.random.key(seed)
    ks = jax.random.split(key, 18)
    L, D = DEPTH, D_MODEL
    return {
        'x': _normal(ks[0], (BATCH, SEQ, D), 1.0),
        'mem': _normal(ks[1], (BATCH, MEM_LEN, D), 1.0),
        'w_mix_in': _normal(ks[2], (L, D, MIX_IN_WIDTH), D ** -0.5),
        'w_pool': _normal(ks[3], (L, N_POOL_GROUPS, POOL_GROUP_WIDTH, POOL_GROUP_WIDTH), POOL_GROUP_WIDTH ** -0.5),
        'pool_scale': 1.0 + _normal(ks[4], (L, POOL_WIDTH), 0.1),
        'w_mix_out': _normal(ks[5], (L, MIX_WIDTH, D), DEEPNORM_BETA * MIX_WIDTH ** -0.5),
        'ln1_g': 1.0 + _normal(ks[6], (L, D), 0.02),
        'ln1_b': _normal(ks[7], (L, D), 0.02),
        'w_xq': _normal(ks[8], (L, D, D), D ** -0.5),
        'w_xkv': _normal(ks[9], (L, D, 2 * D), D ** -0.5),
        'w_xo': _normal(ks[10], (L, D, D), DEEPNORM_BETA * D ** -0.5),
        'ln2_g': 1.0 + _normal(ks[11], (L, D), 0.02),
        'ln2_b': _normal(ks[12], (L, D), 0.02),
        'w_gate': _normal(ks[13], (L, D, FFN_HIDDEN), D ** -0.5),
        'w_up': _normal(ks[14], (L, D, FFN_HIDDEN), D ** -0.5),
        'w_down': _normal(ks[15], (L, FFN_HIDDEN, D), DEEPNORM_BETA * FFN_HIDDEN ** -0.5),
        'ln3_g': 1.0 + _normal(ks[16], (L, D), 0.02),
        'ln3_b': _normal(ks[17], (L, D), 0.02),
    }


def reference(x, mem, w_mix_in, w_pool, pool_scale, w_mix_out, ln1_g, ln1_b,
              w_xq, w_xkv, w_xo, ln2_g, ln2_b, w_gate, w_up, w_down, ln3_g, ln3_b):
    pos = jnp.arange(x.shape[1], dtype=jnp.int32)
    h = x
    for l in range(DEPTH):
        mix = hybrid_mixer(h, w_mix_in[l], w_pool[l], pool_scale[l], w_mix_out[l], pos)
        h = layer_norm(DEEPNORM_ALPHA * h + mix, ln1_g[l], ln1_b[l])
        xa = memory_cross_attention(h, mem, w_xq[l], w_xkv[l], w_xo[l])
        h = layer_norm(DEEPNORM_ALPHA * h + xa, ln2_g[l], ln2_b[l])
        ff = swiglu_ffn(h, w_gate[l], w_up[l], w_down[l])
        h = layer_norm(DEEPNORM_ALPHA * h + ff, ln3_g[l], ln3_b[l])
    return h
```

```cpp
#include <hip/hip_runtime.h>
#include <cstdio>
#include <cstdint>

namespace pg8 {
#define PG8_LAS __attribute__((address_space(3)))
typedef unsigned short bf16_t;
typedef short bf16x8 __attribute__((ext_vector_type(8)));
typedef float f32x4 __attribute__((ext_vector_type(4)));
typedef float f32x2 __attribute__((ext_vector_type(2)));
typedef unsigned u32x4 __attribute__((ext_vector_type(4)));
typedef unsigned u32x2 __attribute__((ext_vector_type(2)));
constexpr int BM = 256, BK = 64, HALF = 128, HTB = HALF * BK * 2  , STAGE_BYTES = 8 * HTB, NXCD = 8, WGM = 8;

__host__ __device__ __forceinline__ int lds_byte(int r, int c) { const int st = (r >> 4) * 2 + (c >> 5), rr = r & 15, cc = c & 31, ob = rr * 64 + cc * 2; return st * 1024 + (ob ^ (((ob >> 9) & 1) << 5)); }
__host__ __device__ __forceinline__ void stage_rc(int b, int& R, int& C) { const int st = b / 1024, sb = b % 1024, swz = sb ^ (((sb >> 9) & 1) << 5); R = (st >> 1) * 16 + swz / 64; C = (st & 1) * 32 + (swz % 64) / 2; }
__host__ __device__ __forceinline__ int perm32(int rho) { const int n = rho >> 4, i = rho & 15; return 8 * (i >> 2) + 4 * n + (i & 3); }

struct Unit { int pm, pn; };
struct Gemm {
    const char* A; const char* B; int lda, ldb, K;
    size_t a_pm, a_pn; int a_pn_sh; size_t b_pn, b_pm; int b_pm_sh;
    __device__ __forceinline__ const char* a_ptr(const Unit& u) const { return A + (size_t)u.pm * a_pm + (size_t)(u.pn >> a_pn_sh) * a_pn; }
    __device__ __forceinline__ const char* b_ptr(const Unit& u) const { return B + (size_t)u.pn * b_pn + (size_t)(u.pm >> b_pm_sh) * b_pm; }
};
__device__ __forceinline__ Gemm make_gemm(const void* A, int lda, const void* B, int ldb, int K) {
    Gemm g; g.A = (const char*)A; g.B = (const char*)B; g.lda = lda; g.ldb = ldb; g.K = K;
    g.a_pm = (size_t)BM * lda * 2; g.a_pn = 0; g.a_pn_sh = 0; g.b_pn = (size_t)BM * ldb * 2; g.b_pm = 0; g.b_pm_sh = 0; return g;
}

struct StaticOrder {
    int nM, nN, nwg, G, c;
    __host__ __device__ void init(int M, int N, int G_, int c_) { nM = M / BM; nN = N / BM; nwg = nM * nN; G = G_; c = c_; }
    __host__ __device__ bool next(int i, Unit& u) const {
        const long L = (long)i * G + c; if (L >= nwg) return false;
        int wgid = (int)L; { const int q = nwg / NXCD, r = nwg % NXCD, xcd = wgid % NXCD, off = wgid / NXCD; wgid = (xcd < r ? xcd * (q + 1) : r * (q + 1) + (xcd - r) * q) + off; }
        const int nig = WGM * nN, gid = wgid / nig, fm = gid * WGM, gsz = (nM - fm) < WGM ? (nM - fm) : WGM;
        u.pm = fm + ((wgid % nig) % gsz); u.pn = (wgid % nig) / gsz; return true;
    }
    __device__ __forceinline__ void a_ready(const Unit&) const {}
    __device__ __forceinline__ void done(const Unit&) const {}
};

__device__ __forceinline__ unsigned cvt_pk_bf16(float lo, float hi) { unsigned r; asm volatile("v_cvt_pk_bf16_f32 %0, %1, %2" : "=v"(r) : "v"(lo), "v"(hi)); return r; }

struct EpiMixIn {
    static constexpr bool PERM = true, AFTER_DRAIN = false;
    bf16_t* base; size_t tstride; const float* rope;
    __device__ __forceinline__ void operator()(const f32x4 (&acc)[2][2][4][2], const Unit& u, int wr, int wc, int fr, int fq) const {
        const int t = u.pn >> 3; const bool rp = (t == 1) || (t == 2);
        bf16_t* ob = base + (size_t)t * tstride;
        const int row0 = u.pm * BM + wr * 64 + fr, col0 = (u.pn & 7) * BM + wc * 32 + 8 * fq;
#pragma unroll
        for (int ai = 0; ai < 2; ++ai)
#pragma unroll
            for (int m = 0; m < 4; ++m) {
                const int row = row0 + ai * HALF + m * 16; bf16_t* rowp = ob + (size_t)row * 2048 + col0;
                f32x4 cs0 = (f32x4){1.f, 0.f, 1.f, 0.f}, cs1 = cs0;
                if (rp) { const f32x4* tp = (const f32x4*)(rope + ((size_t)(row & 8191) * 64 + wc * 16 + fq * 4) * 2); cs0 = tp[0]; cs1 = tp[1]; }
#pragma unroll
                for (int bj = 0; bj < 2; ++bj) {
                    const f32x4 v0 = acc[ai][bj][m][0], v1 = acc[ai][bj][m][1];
                    const float a0 = v0[0] * cs0[0] - v0[1] * cs0[1], a1 = v0[1] * cs0[0] + v0[0] * cs0[1];
                    const float a2 = v0[2] * cs0[2] - v0[3] * cs0[3], a3 = v0[3] * cs0[2] + v0[2] * cs0[3];
                    const float b0 = v1[0] * cs1[0] - v1[1] * cs1[1], b1 = v1[1] * cs1[0] + v1[0] * cs1[1];
                    const float b2 = v1[2] * cs1[2] - v1[3] * cs1[3], b3 = v1[3] * cs1[2] + v1[2] * cs1[3];
                    u32x4 w; w.x = cvt_pk_bf16(a0, a1); w.y = cvt_pk_bf16(a2, a3); w.z = cvt_pk_bf16(b0, b1); w.w = cvt_pk_bf16(b2, b3);
                    *(u32x4*)(rowp + bj * HALF) = w;
                }
            }
    }
};
struct EpiStore {
    static constexpr bool PERM = true, AFTER_DRAIN = false;
    bf16_t* O; int ldc, coff;
    __device__ __forceinline__ void operator()(const f32x4 (&acc)[2][2][4][2], const Unit& u, int wr, int wc, int fr, int fq) const {
        const int row0 = u.pm * BM + wr * 64 + fr, col0 = coff + u.pn * BM + wc * 32 + 8 * fq;
#pragma unroll
        for (int ai = 0; ai < 2; ++ai)
#pragma unroll
            for (int m = 0; m < 4; ++m) { bf16_t* rowp = O + (size_t)(row0 + ai * HALF + m * 16) * ldc + col0;
#pragma unroll
                for (int bj = 0; bj < 2; ++bj) { const f32x4 v0 = acc[ai][bj][m][0], v1 = acc[ai][bj][m][1];
                    u32x4 w; w.x = cvt_pk_bf16(v0[0], v0[1]); w.y = cvt_pk_bf16(v0[2], v0[3]); w.z = cvt_pk_bf16(v1[0], v1[1]); w.w = cvt_pk_bf16(v1[2], v1[3]);
                    *(u32x4*)(rowp + bj * HALF) = w; } }
    }
};
struct EpiResid {
    static constexpr bool PERM = false, AFTER_DRAIN = false;
    const float* res; float* out; int ldc; float alpha;
    __device__ __forceinline__ void operator()(const f32x4 (&acc)[2][2][4][2], const Unit& u, int wr, int wc, int fr, int fq) const {
        const int row0 = u.pm * BM + wr * 64 + fr, col0 = u.pn * BM + wc * 32 + 4 * fq;
#pragma unroll
        for (int ai = 0; ai < 2; ++ai)
#pragma unroll
            for (int m = 0; m < 4; ++m) { const size_t off = (size_t)(row0 + ai * HALF + m * 16) * ldc + col0;
#pragma unroll
                for (int bj = 0; bj < 2; ++bj)
#pragma unroll
                    for (int n = 0; n < 2; ++n) { const f32x4 r = *(const f32x4*)(res + off + bj * HALF + n * 16); *(f32x4*)(out + off + bj * HALF + n * 16) = r * alpha + acc[ai][bj][m][n]; }
                asm volatile("" ::: "memory"); }
    }
};
struct EpiSwiGLU {
    static constexpr bool PERM = true, AFTER_DRAIN = false;
    bf16_t* G; int ldc;
    __device__ __forceinline__ float act(float g, float u) const { return g * u * __builtin_amdgcn_rcpf(1.0f + __builtin_amdgcn_exp2f(-1.4426950408889634f * g)); }
    __device__ __forceinline__ void operator()(const f32x4 (&acc)[2][2][4][2], const Unit& u, int wr, int wc, int fr, int fq) const {
        const int row0 = u.pm * BM + wr * 64 + fr, col0 = u.pn * HALF + wc * 32 + 8 * fq;
#pragma unroll
        for (int ai = 0; ai < 2; ++ai)
#pragma unroll
            for (int m = 0; m < 4; ++m) { bf16_t* rowp = G + (size_t)(row0 + ai * HALF + m * 16) * ldc + col0;
                const f32x4 g0 = acc[ai][0][m][0], g1 = acc[ai][0][m][1], u0 = acc[ai][1][m][0], u1 = acc[ai][1][m][1];
                u32x4 w; w.x = cvt_pk_bf16(act(g0[0], u0[0]), act(g0[1], u0[1])); w.y = cvt_pk_bf16(act(g0[2], u0[2]), act(g0[3], u0[3]));
                w.z = cvt_pk_bf16(act(g1[0], u1[0]), act(g1[1], u1[1])); w.w = cvt_pk_bf16(act(g1[2], u1[2]), act(g1[3], u1[3]));
                *(u32x4*)rowp = w; }
    }
};
struct EpiSoftmax {
    static constexpr bool PERM = true, AFTER_DRAIN = true;
    bf16_t* P; int ldc; float c2;
    __device__ __forceinline__ void fused(f32x4 (&acc)[2][2][4][2], const Unit& u, int wr, int wc, int fr, int fq, PG8_LAS unsigned char* lds, int wid, int lane) const {
        PG8_LAS float* T1 = (PG8_LAS float*)lds;
        PG8_LAS float* T2 = (PG8_LAS float*)(lds + 4096);
#pragma unroll
        for (int ai = 0; ai < 2; ++ai)
#pragma unroll
            for (int m = 0; m < 4; ++m) { float mx = -3.0e38f;
#pragma unroll
                for (int bj = 0; bj < 2; ++bj)
#pragma unroll
                    for (int n = 0; n < 2; ++n) { const f32x4 x = acc[ai][bj][m][n]; mx = fmaxf(mx, fmaxf(fmaxf(x[0], x[1]), fmaxf(x[2], x[3]))); }
                mx = fmaxf(mx, __shfl_xor(mx, 16)); mx = fmaxf(mx, __shfl_xor(mx, 32));
                if (fq == 0) T1[(ai * HALF + wr * 64 + m * 16 + fr) * 4 + wc] = mx; }
        asm volatile("s_waitcnt lgkmcnt(0)" ::: "memory"); __builtin_amdgcn_s_barrier(); asm volatile("" ::: "memory");
#pragma unroll
        for (int ai = 0; ai < 2; ++ai)
#pragma unroll
            for (int m = 0; m < 4; ++m) { const int r = ai * HALF + wr * 64 + m * 16 + fr;
                const f32x4 t = *(const PG8_LAS f32x4*)(T1 + r * 4); const float mx = fmaxf(fmaxf(t[0], t[1]), fmaxf(t[2], t[3])) * c2; float s = 0.f;
#pragma unroll
                for (int bj = 0; bj < 2; ++bj)
#pragma unroll
                    for (int n = 0; n < 2; ++n) { f32x4 x = acc[ai][bj][m][n];
#pragma unroll
                        for (int e = 0; e < 4; ++e) { x[e] = __builtin_amdgcn_exp2f(x[e] * c2 - mx); s += x[e]; }
                        acc[ai][bj][m][n] = x; }
                s += __shfl_xor(s, 16); s += __shfl_xor(s, 32);
                if (fq == 0) T2[r * 4 + wc] = s; }
        asm volatile("s_waitcnt lgkmcnt(0)" ::: "memory"); __builtin_amdgcn_s_barrier(); asm volatile("" ::: "memory");
        const int row0 = u.pm * BM + wr * 64 + fr, col0 = u.pn * BM + wc * 32 + 8 * fq;
#pragma unroll
        for (int ai = 0; ai < 2; ++ai)
#pragma unroll
            for (int m = 0; m < 4; ++m) { const int r = ai * HALF + wr * 64 + m * 16 + fr;
                const f32x4 t = *(const PG8_LAS f32x4*)(T2 + r * 4); const float inv = 1.0f / ((t[0] + t[1]) + (t[2] + t[3]));
                bf16_t* rowp = P + (size_t)(row0 + ai * HALF + m * 16) * ldc + col0;
#pragma unroll
                for (int bj = 0; bj < 2; ++bj) { const f32x4 v0 = acc[ai][bj][m][0] * inv, v1 = acc[ai][bj][m][1] * inv;
                    u32x4 w; w.x = cvt_pk_bf16(v0[0], v0[1]); w.y = cvt_pk_bf16(v0[2], v0[3]); w.z = cvt_pk_bf16(v1[0], v1[1]); w.w = cvt_pk_bf16(v1[2], v1[3]);
                    *(u32x4*)(rowp + bj * HALF) = w; } }
    }
};

template <class Epi, class Sched, bool ALIGN_EPI = false, bool SP2 = false>
__device__ __forceinline__ void gemm_phase(PG8_LAS unsigned char* lds, const Gemm g, const Sched& S, const Epi& E) {
    const int tid = threadIdx.x, wid = __builtin_amdgcn_readfirstlane(tid >> 6), lane = tid & 63, wr = wid >> 2, wc = wid & 3, fr = lane & 15, fq = lane >> 4;
    const int K = g.K, nt = K / BK;
    unsigned voffA[2], voffB[2];
#pragma unroll
    for (int i = 0; i < 2; ++i) { int R, C; stage_rc(tid * 16 + i * 8192, R, C); const int Rb = Epi::PERM ? ((R & ~31) + perm32(R & 31)) : R;
        voffA[i] = (unsigned)(R * g.lda + C) * 2u; voffB[i] = (unsigned)(Rb * g.ldb + C) * 2u; }
    const size_t kstep = (size_t)(BK * 2);
    const size_t hA = (size_t)HALF * g.lda * 2, hB = (size_t)HALF * g.ldb * 2;
    const unsigned ldsw = (unsigned)wid * 1024u;
    const int aoff = lds_byte(wr * 64 + fr, fq * 8), boff = lds_byte(wc * 32 + fr, fq * 8);
#define PG8_SA(b, h) (((b) * 2 + (h)) * HTB)
#define PG8_SB(b, h) ((4 + (b) * 2 + (h)) * HTB)
#define PG8_STAGE(bufoff, gbase, voff) do { _Pragma("unroll") for (int _i = 0; _i < 2; ++_i) \
        __builtin_amdgcn_global_load_lds((const unsigned*)((const char*)(gbase) + (voff)[_i]), (PG8_LAS unsigned*)(lds + (bufoff) + ldsw + _i * 8192), 16, 0, 0); } while (0)
#define PG8_LDA(dst, b, h) do { _Pragma("unroll") for (int m = 0; m < 4; ++m) _Pragma("unroll") for (int k = 0; k < 2; ++k) dst[m][k] = *(const PG8_LAS bf16x8*)(lds + PG8_SA(b, h) + aoff + m * 2048 + k * 1024); } while (0)
#define PG8_LDB(dst, b, h) do { _Pragma("unroll") for (int n = 0; n < 2; ++n) _Pragma("unroll") for (int k = 0; k < 2; ++k) dst[n][k] = *(const PG8_LAS bf16x8*)(lds + PG8_SB(b, h) + boff + n * 2048 + k * 1024); } while (0)
#define PG8_MMA(ai, bj, At, Bt) do { __builtin_amdgcn_s_setprio(1); _Pragma("unroll") for (int m = 0; m < 4; ++m) _Pragma("unroll") for (int n = 0; n < 2; ++n) _Pragma("unroll") for (int k = 0; k < 2; ++k) \
        acc[ai][bj][m][n] = __builtin_amdgcn_mfma_f32_16x16x32_bf16(Bt[n][k], At[m][k], acc[ai][bj][m][n], 0, 0, 0); __builtin_amdgcn_s_setprio(0); } while (0)
#define PG8_WAIT_V(n) asm volatile("s_waitcnt vmcnt(" #n ")" ::: "memory")
#define PG8_WAIT_L(n) asm volatile("s_waitcnt lgkmcnt(" #n ")" ::: "memory")
#define PG8_BAR __builtin_amdgcn_s_barrier()
#define PG8_SCHED __builtin_amdgcn_sched_barrier(0)
    Unit cur, nxt; int ui = 0;
    if (!S.next(0, cur)) return;
    f32x4 acc[2][2][4][2];
#pragma unroll
    for (int a = 0; a < 2; ++a)
#pragma unroll
        for (int b = 0; b < 2; ++b)
#pragma unroll
            for (int m = 0; m < 4; ++m)
#pragma unroll
                for (int n = 0; n < 2; ++n) acc[a][b][m][n] = (f32x4){0.f, 0.f, 0.f, 0.f};
    bf16x8 At[4][2], B0[2][2], B1[2][2];
    const char* cA = g.a_ptr(cur); const char* cB = g.b_ptr(cur);
    S.a_ready(cur);
    if constexpr (SP2) {
        PG8_STAGE(PG8_SB(0, 0), cB, voffB); PG8_STAGE(PG8_SB(0, 1), cB + hB, voffB); PG8_STAGE(PG8_SA(0, 0), cA, voffA); PG8_STAGE(PG8_SA(0, 1), cA + hA, voffA);
        if (wr == 1) PG8_BAR;
        PG8_WAIT_V(2); PG8_BAR;
        PG8_STAGE(PG8_SB(1, 0), cB + kstep, voffB); PG8_STAGE(PG8_SA(1, 0), cA + kstep, voffA); PG8_STAGE(PG8_SB(1, 1), cB + hB + kstep, voffB);
        PG8_WAIT_V(6); PG8_BAR;
    } else {
        PG8_STAGE(PG8_SB(0, 0), cB, voffB); PG8_STAGE(PG8_SA(0, 0), cA, voffA); PG8_STAGE(PG8_SB(0, 1), cB + hB, voffB); PG8_STAGE(PG8_SA(0, 1), cA + hA, voffA);
        if (wr == 1) PG8_BAR;
        PG8_WAIT_V(4); PG8_BAR;
        PG8_STAGE(PG8_SB(1, 0), cB + kstep, voffB); PG8_STAGE(PG8_SA(1, 0), cA + kstep, voffA); PG8_STAGE(PG8_SB(1, 1), cB + hB + kstep, voffB);
        PG8_WAIT_V(6); PG8_BAR;
    }
    for (;;) {
        const bool has_next = S.next(ui + 1, nxt);
        const char* nA = has_next ? g.a_ptr(nxt) : cA; const char* nB = has_next ? g.b_ptr(nxt) : cB;
        for (int t = 0; t < nt; t += 2) {
            const bool last = (t == nt - 2);
            const char* a1 = cA + (size_t)(t + 1) * kstep;
            const char* a2 = last ? nA : cA + (size_t)(t + 2) * kstep; const char* b2 = last ? nB : cB + (size_t)(t + 2) * kstep;
            const char* a3 = a2 + kstep; const char* b3 = b2 + kstep;
            if (last && has_next) S.a_ready(nxt);
            if constexpr (SP2) {
            PG8_LDB(B0, 0, 0); PG8_LDB(B1, 0, 1); PG8_SCHED; PG8_LDA(At, 0, 0); PG8_STAGE(PG8_SA(1, 1), a1 + hA, voffA);
            PG8_WAIT_V(8); PG8_WAIT_L(0); PG8_BAR; PG8_MMA(0, 0, At, B0); PG8_MMA(0, 1, At, B1); PG8_BAR; PG8_SCHED;
            PG8_LDA(At, 0, 1); PG8_STAGE(PG8_SB(0, 0), b2, voffB); PG8_STAGE(PG8_SB(0, 1), b2 + hB, voffB); PG8_STAGE(PG8_SA(0, 0), a2, voffA);
            PG8_WAIT_V(8); PG8_WAIT_L(0); PG8_BAR; PG8_MMA(1, 0, At, B0); PG8_MMA(1, 1, At, B1); PG8_BAR; PG8_SCHED;
            PG8_LDB(B0, 1, 0); PG8_LDB(B1, 1, 1); PG8_SCHED; PG8_LDA(At, 1, 0); PG8_STAGE(PG8_SA(0, 1), a2 + hA, voffA);
            PG8_WAIT_V(8); PG8_WAIT_L(0); PG8_BAR; PG8_MMA(0, 0, At, B0); PG8_MMA(0, 1, At, B1); PG8_BAR; PG8_SCHED;
            PG8_LDA(At, 1, 1); PG8_STAGE(PG8_SB(1, 0), b3, voffB); PG8_STAGE(PG8_SB(1, 1), b3 + hB, voffB); PG8_STAGE(PG8_SA(1, 0), a3, voffA);
            PG8_WAIT_V(8); PG8_WAIT_L(0); PG8_BAR; PG8_MMA(1, 0, At, B0); PG8_MMA(1, 1, At, B1); PG8_BAR; PG8_SCHED;
            } else {
            PG8_LDB(B0, 0, 0); PG8_SCHED; PG8_LDA(At, 0, 0); PG8_STAGE(PG8_SA(1, 1), a1 + hA, voffA);
            PG8_WAIT_L(8); PG8_BAR; PG8_WAIT_L(0); PG8_MMA(0, 0, At, B0); PG8_BAR; PG8_SCHED;
            PG8_LDB(B1, 0, 1); PG8_STAGE(PG8_SB(0, 0), b2, voffB);
            PG8_BAR; PG8_WAIT_L(0); PG8_MMA(0, 1, At, B1); PG8_BAR;
            PG8_LDA(At, 0, 1); PG8_STAGE(PG8_SA(0, 0), a2, voffA);
            PG8_BAR; PG8_WAIT_L(0); PG8_MMA(1, 0, At, B0); PG8_BAR; PG8_SCHED;
            PG8_STAGE(PG8_SB(0, 1), b2 + hB, voffB);
            PG8_WAIT_V(6); PG8_BAR; PG8_MMA(1, 1, At, B1); PG8_BAR;
            PG8_LDB(B0, 1, 0); PG8_SCHED; PG8_LDA(At, 1, 0); PG8_STAGE(PG8_SA(0, 1), a2 + hA, voffA);
            PG8_WAIT_L(8); PG8_BAR; PG8_WAIT_L(0); PG8_MMA(0, 0, At, B0); PG8_BAR; PG8_SCHED;
            PG8_LDB(B1, 1, 1); PG8_STAGE(PG8_SB(1, 0), b3, voffB);
            PG8_BAR; PG8_WAIT_L(0); PG8_MMA(0, 1, At, B1); PG8_BAR;
            PG8_LDA(At, 1, 1); PG8_STAGE(PG8_SA(1, 0), a3, voffA);
            PG8_BAR; PG8_WAIT_L(0); PG8_MMA(1, 0, At, B0); PG8_BAR; PG8_SCHED;
            PG8_STAGE(PG8_SB(1, 1), b3 + hB, voffB);
            PG8_WAIT_V(6); PG8_BAR; PG8_MMA(1, 1, At, B1); PG8_BAR;
            }
        }
        if constexpr (ALIGN_EPI) { if (wr == 0) PG8_BAR; }
        if constexpr (!Epi::AFTER_DRAIN) { E(acc, cur, wr, wc, fr, fq); S.done(cur); }
        if (!has_next) break;
#pragma unroll
        for (int a = 0; a < 2; ++a)
#pragma unroll
            for (int b = 0; b < 2; ++b)
#pragma unroll
                for (int m = 0; m < 4; ++m)
#pragma unroll
                    for (int n = 0; n < 2; ++n) acc[a][b][m][n] = (f32x4){0.f, 0.f, 0.f, 0.f};
        cur = nxt; cA = nA; cB = nB; ++ui;
        if constexpr (ALIGN_EPI) { if (wr == 1) PG8_BAR; }
    }
    PG8_WAIT_V(0);
    if constexpr (!ALIGN_EPI) { if (wr == 0) PG8_BAR; }
    PG8_BAR;
    if constexpr (Epi::AFTER_DRAIN) { E.fused(acc, cur, wr, wc, fr, fq, lds, wid, lane); S.done(cur); }
#undef PG8_SA
#undef PG8_SB
#undef PG8_STAGE
#undef PG8_LDA
#undef PG8_LDB
#undef PG8_MMA
#undef PG8_WAIT_V
#undef PG8_WAIT_L
#undef PG8_BAR
#undef PG8_SCHED
}
}

namespace att {
using bf16_t = unsigned short;
using bf16x8 = __attribute__((ext_vector_type(8))) short;
using s16x4  = __attribute__((ext_vector_type(4))) short;
using f32x16 = __attribute__((ext_vector_type(16))) float;
using u32x4  = __attribute__((ext_vector_type(4))) unsigned;
using u32x2  = __attribute__((ext_vector_type(2))) unsigned;
constexpr int   D = 128, NW = 8, QBLK = 32, KVBLK = 64, NT = 4;
constexpr float SCALE = 0.088388347648318440f;
constexpr float THR = 8.f;
constexpr int   LDQ = 2048, LDK = 2048;
constexpr size_t SHM_V = KVBLK * D * 2, SHM_K = KVBLK * D * 2, SHM_ATTN = 2 * SHM_V + 2 * SHM_K;
#define KSWZ(row, colB) ((row) * 256 + ((colB) ^ (((row) & 7) << 4)))
#define SBAR() __builtin_amdgcn_sched_barrier(0)
__device__ __forceinline__ int crow(int r, int hi) { return (r & 3) + 8 * (r >> 2) + 4 * hi; }
__device__ __forceinline__ unsigned cvtpk(float lo, float hi) { unsigned r; asm volatile("v_cvt_pk_bf16_f32 %0, %1, %2" : "=v"(r) : "v"(lo), "v"(hi)); return r; }

__device__ __forceinline__ void partialSM(f32x16& p0, f32x16& p1, float& m_reg, float& mn, float& alpha) {
  constexpr float C = SCALE * 1.4426950408889634f;
  float pmax = p0[0];
#pragma unroll
  for (int r = 1; r < 16; ++r) pmax = fmaxf(pmax, p0[r]);
#pragma unroll
  for (int r = 0; r < 16; ++r) pmax = fmaxf(pmax, p1[r]);
  { auto rr = __builtin_amdgcn_permlane32_swap(__float_as_uint(pmax), __float_as_uint(pmax), false, false);
    pmax = fmaxf(__uint_as_float(rr[0]), __uint_as_float(rr[1])); }
  if (__builtin_expect(__all(pmax - m_reg <= THR / SCALE), 1)) { mn = m_reg; alpha = 1.f; }
  else { mn = fmaxf(m_reg, pmax); alpha = __builtin_amdgcn_exp2f((m_reg - mn) * C); m_reg = mn; }
  float mnC = -mn * C;
#pragma unroll
  for (int r = 0; r < 16; ++r) p0[r] = fmaf(p0[r], C, mnC);
#pragma unroll
  for (int r = 0; r < 16; ++r) p1[r] = fmaf(p1[r], C, mnC);
#pragma unroll
  for (int r = 0; r < 16; ++r) p0[r] = __builtin_amdgcn_exp2f(p0[r]);
}
__device__ __forceinline__ void finishSM(f32x16& p0, f32x16& p1, float alpha, float& l_reg, bf16x8& pa0, bf16x8& pa1, bf16x8& pa2, bf16x8& pa3) {
#pragma unroll
  for (int r = 0; r < 16; ++r) p1[r] = __builtin_amdgcn_exp2f(p1[r]);
  float ps = 0;
#pragma unroll
  for (int r = 0; r < 16; ++r) ps += p0[r];
#pragma unroll
  for (int r = 0; r < 16; ++r) ps += p1[r];
  { auto rr = __builtin_amdgcn_permlane32_swap(__float_as_uint(ps), __float_as_uint(ps), false, false);
    ps = __uint_as_float(rr[0]) + __uint_as_float(rr[1]); }
  l_reg = l_reg * alpha + ps;
#define PK4(P, BASE, OUT) do { unsigned a0 = cvtpk(P[BASE + 0], P[BASE + 1]), a1 = cvtpk(P[BASE + 2], P[BASE + 3]);   \
    unsigned b0 = cvtpk(P[BASE + 4], P[BASE + 5]), b1 = cvtpk(P[BASE + 6], P[BASE + 7]);                              \
    auto r0 = __builtin_amdgcn_permlane32_swap(a0, b0, false, false); auto r1 = __builtin_amdgcn_permlane32_swap(a1, b1, false, false); \
    u32x4 w = {r0[0], r1[0], r0[1], r1[1]}; OUT = *reinterpret_cast<bf16x8*>(&w); } while (0)
  PK4(p0, 0, pa0); PK4(p0, 8, pa1); PK4(p1, 0, pa2); PK4(p1, 8, pa3);
#undef PK4
}
__device__ __forceinline__ void qkt(f32x16& p0, f32x16& p1, const char* Ks, const bf16x8* qr, int r32, int hi) {
  p0 = f32x16{}; p1 = f32x16{};
#pragma unroll
  for (int d0 = 0; d0 < 8; ++d0) { int cb = (d0 * 16 + hi * 8) * 2;
    bf16x8 b0 = *reinterpret_cast<const bf16x8*>(Ks + KSWZ(r32, cb));
    bf16x8 b1 = *reinterpret_cast<const bf16x8*>(Ks + KSWZ(32 + r32, cb));
    p0 = __builtin_amdgcn_mfma_f32_32x32x16_bf16(b0, qr[d0], p0, 0, 0, 0);
    p1 = __builtin_amdgcn_mfma_f32_32x32x16_bf16(b1, qr[d0], p1, 0, 0, 0); }
}
__device__ __forceinline__ void cmask(f32x16& p0, f32x16& p1, int jt, int qloc, int hi) {
#pragma unroll
  for (int r = 0; r < 16; ++r) { const int key = 64 * jt + crow(r, hi); if (key > qloc) p0[r] = -1e30f; if (key + 32 > qloc) p1[r] = -1e30f; }
}
__device__ __forceinline__ int v_st(int k, int c) { const int kk = (k & ~0xC) | ((k & 4) << 1) | ((k & 8) >> 1); return ((kk >> 3) * 4 + (c >> 5)) * 512 + ((kk & 7) * 32 + (c & 31)) * 2; }
__device__ __forceinline__ int v_rd_base(int lane) { return ((lane & 3) << 3) | (((lane >> 2) & 3) << 6) | (((lane >> 4) & 1) << 5) | (((lane >> 5) & 1) << 8); }
constexpr int v_rd_off(int d0, int ks, int half) { return d0 * 512 + ks * 4096 + half * 2048; }
template <int OFF> __device__ __forceinline__ s16x4 tr_read(int vb) {
  s16x4 r; asm volatile("ds_read_b64_tr_b16 %0, %1 offset:%2" : "=&v"(r) : "v"(vb), "i"(OFF) : "memory"); return r;
}
template <int D0> __device__ __forceinline__ void pv_one(f32x16& od, int vb, bf16x8 pa0, bf16x8 pa1, bf16x8 pa2, bf16x8 pa3) {
  const s16x4 l0 = tr_read<v_rd_off(D0, 0, 0)>(vb), h0 = tr_read<v_rd_off(D0, 0, 1)>(vb), l1 = tr_read<v_rd_off(D0, 1, 0)>(vb), h1 = tr_read<v_rd_off(D0, 1, 1)>(vb);
  const s16x4 l2 = tr_read<v_rd_off(D0, 2, 0)>(vb), h2 = tr_read<v_rd_off(D0, 2, 1)>(vb), l3 = tr_read<v_rd_off(D0, 3, 0)>(vb), h3 = tr_read<v_rd_off(D0, 3, 1)>(vb);
  asm volatile("s_waitcnt lgkmcnt(0)" ::: "memory"); SBAR();
#define PK(L, H) (bf16x8){L[0], L[1], L[2], L[3], H[0], H[1], H[2], H[3]}
  od = __builtin_amdgcn_mfma_f32_32x32x16_bf16(PK(l0, h0), pa0, od, 0, 0, 0);
  od = __builtin_amdgcn_mfma_f32_32x32x16_bf16(PK(l1, h1), pa1, od, 0, 0, 0);
  od = __builtin_amdgcn_mfma_f32_32x32x16_bf16(PK(l2, h2), pa2, od, 0, 0, 0);
  od = __builtin_amdgcn_mfma_f32_32x32x16_bf16(PK(l3, h3), pa3, od, 0, 0, 0);
#undef PK
}
__device__ __forceinline__ void pv_d0(f32x16* o, int vb, bf16x8 pa0, bf16x8 pa1, bf16x8 pa2, bf16x8 pa3) {
  pv_one<0>(o[0], vb, pa0, pa1, pa2, pa3); pv_one<1>(o[1], vb, pa0, pa1, pa2, pa3); pv_one<2>(o[2], vb, pa0, pa1, pa2, pa3); pv_one<3>(o[3], vb, pa0, pa1, pa2, pa3);
}

__device__ __forceinline__ void attn_item(const bf16_t* __restrict__ Qrow, const bf16_t* __restrict__ Kh, const bf16_t* __restrict__ Vh, bool causal, int qloc,
                                          bf16_t* Orow, float2* MLrow, bool valid, char* lds) {
  const int tid = threadIdx.x, lane = tid & 63, r32 = lane & 31, hi = lane >> 5;
  char* V_lds = lds; char* K_lds = lds + 2 * SHM_V;
  float m_reg = -1e30f, l_reg = 0; f32x16 o[4] = {}; bf16x8 qr[8];
  const bf16_t* Qw = Qrow + hi * 8;
#pragma unroll
  for (int d0 = 0; d0 < 8; ++d0) qr[d0] = *reinterpret_cast<const bf16x8*>(Qw + d0 * 16);
  const int sr = tid >> 4, sc = (tid & 15) * 8, vst0 = v_st(sr, sc), vst1 = v_st(32 + sr, sc);
  const int vb0 = (int)(uintptr_t)V_lds + v_rd_base(lane);
  struct { bf16x8 vs0, vs1, ks0, ks1; } sr_[2];
#define SLOAD(i, k0) do { sr_[i].vs0 = *reinterpret_cast<const bf16x8*>(&Vh[(long)((k0) + sr) * LDK + sc]); sr_[i].vs1 = *reinterpret_cast<const bf16x8*>(&Vh[(long)((k0) + 32 + sr) * LDK + sc]); \
    sr_[i].ks0 = *reinterpret_cast<const bf16x8*>(&Kh[(long)((k0) + sr) * LDK + sc]); sr_[i].ks1 = *reinterpret_cast<const bf16x8*>(&Kh[(long)((k0) + 32 + sr) * LDK + sc]); } while (0)
#define SWRITE(b, i) do { *(bf16x8*)(V_lds + (b) * SHM_V + vst0) = sr_[i].vs0;          \
    *(bf16x8*)(V_lds + (b) * SHM_V + vst1) = sr_[i].vs1; int kc = sc * 2;               \
    *(bf16x8*)(K_lds + (b) * SHM_K + KSWZ(sr, kc)) = sr_[i].ks0;                       \
    *(bf16x8*)(K_lds + (b) * SHM_K + KSWZ(32 + sr, kc)) = sr_[i].ks1; } while (0)
#define SWAIT() asm volatile("s_waitcnt vmcnt(4)" ::: "memory")
#define RESC(a) do { if (__any((a) < 1.f)) { _Pragma("unroll") for (int d = 0; d < 4; ++d) _Pragma("unroll") for (int r = 0; r < 16; ++r) o[d][r] *= (a); } } while (0)
  f32x16 pA0, pA1, pB0, pB1; float mnA, mnB, alA, alB; bf16x8 pa0, pa1, pa2, pa3;
  constexpr int SE = 0, SO = 1;
  SLOAD(SE, 0); asm volatile("s_waitcnt vmcnt(0)" ::: "memory"); SWRITE(0, SE); __syncthreads();
  qkt(pA0, pA1, K_lds, qr, r32, hi); if (causal) cmask(pA0, pA1, 0, qloc, hi); partialSM(pA0, pA1, m_reg, mnA, alA);
  SLOAD(SO, KVBLK); SLOAD(SE, 2 * KVBLK);
  SWAIT(); SWRITE(1, SO); __syncthreads();
  {
    SBAR(); qkt(pB0, pB1, K_lds + SHM_K, qr, r32, hi); if (causal) cmask(pB0, pB1, 1, qloc, hi);
    finishSM(pA0, pA1, alA, l_reg, pa0, pa1, pa2, pa3); SBAR();
    SLOAD(SO, 3 * KVBLK); SBAR();
    pv_d0(o, vb0, pa0, pa1, pa2, pa3); partialSM(pB0, pB1, m_reg, mnB, alB);
    __syncthreads(); SWAIT(); SWRITE(0, SE);
    RESC(alB); __syncthreads();
    SBAR(); qkt(pA0, pA1, K_lds, qr, r32, hi); if (causal) cmask(pA0, pA1, 2, qloc, hi);
    finishSM(pB0, pB1, alB, l_reg, pa0, pa1, pa2, pa3); SBAR();
    pv_d0(o, vb0 + (int)SHM_V, pa0, pa1, pa2, pa3); partialSM(pA0, pA1, m_reg, mnA, alA);
    __syncthreads(); asm volatile("s_waitcnt vmcnt(0)" ::: "memory"); SWRITE(1, SO);
    RESC(alA); __syncthreads();
  }
  SBAR(); qkt(pB0, pB1, K_lds + SHM_K, qr, r32, hi); if (causal) cmask(pB0, pB1, 3, qloc, hi);
  finishSM(pA0, pA1, alA, l_reg, pa0, pa1, pa2, pa3); SBAR();
  pv_d0(o, vb0, pa0, pa1, pa2, pa3); partialSM(pB0, pB1, m_reg, mnB, alB);
  __syncthreads(); RESC(alB);
  finishSM(pB0, pB1, alB, l_reg, pa0, pa1, pa2, pa3); SBAR();
  pv_d0(o, vb0 + (int)SHM_V, pa0, pa1, pa2, pa3);
  const float rl = 1.0f / l_reg;
  if (valid) {
#pragma unroll
    for (int d0 = 0; d0 < 4; ++d0)
#pragma unroll
      for (int g = 0; g < 4; ++g) { u32x2 w; w.x = cvtpk(o[d0][4 * g] * rl, o[d0][4 * g + 1] * rl); w.y = cvtpk(o[d0][4 * g + 2] * rl, o[d0][4 * g + 3] * rl);
        *reinterpret_cast<u32x2*>(Orow + 32 * d0 + 8 * g + 4 * hi) = w; }
    if (hi == 0) *MLrow = make_float2(m_reg, l_reg);
  }
#undef SLOAD
#undef SWRITE
#undef SWAIT
#undef RESC
}
#undef KSWZ
#undef SBAR
}

constexpr int NWAVES = 8;
#ifndef MK_N_LAUNCHES
#define MK_N_LAUNCHES 1
#endif
constexpr int N_PHASES = 16;
constexpr int N_LAUNCHES = MK_N_LAUNCHES;

constexpr int BATCH = 2, SEQ = 8192, DM = 4096, M = BATCH * SEQ, MEMLEN = 256;
constexpr int PW = 2048, AW = 2048, NH = 16, HD = 128, NBLK = 32, MIXIN = 8192, FF = 11008, XH = 4, XHD = 1024;
constexpr float LN_EPS = 1e-5f;
constexpr float DN_ALPHA = 1.189207115002721f;

constexpr size_t MiB = 1u << 20;
constexpr size_t WS_CTL = 0, CTL_ZERO_BYTES = 1 * MiB;
constexpr size_t WS_ROPE = 1 * MiB;
constexpr size_t WS_KMH = 5 * MiB, WS_KML = 5 * MiB + 512 * 1024;
constexpr size_t WS_MEMB = 6 * MiB;
constexpr size_t WS_KX = 10 * MiB;
constexpr size_t WS_VT = 14 * MiB;
constexpr size_t WS_LIST = 18 * MiB;
constexpr size_t WS_ML = 26 * MiB;
constexpr size_t WS_WIN = 34 * MiB, WS_WPOOL = 98 * MiB, WS_WOUT = 100 * MiB, WS_WXQ = 132 * MiB, WS_WXKV = 164 * MiB, WS_WXO = 228 * MiB, WS_WGU = 260 * MiB, WS_WDN = 432 * MiB;
constexpr size_t WS_ACT = 518 * MiB;
constexpr size_t WS_HP = WS_ACT, WS_Q = WS_ACT + 64 * MiB, WS_K = WS_ACT + 128 * MiB, WS_V = WS_ACT + 192 * MiB;
constexpr size_t WS_XB = WS_ACT + 256 * MiB;
constexpr size_t WS_PM = WS_ACT + 256 * MiB;
constexpr size_t WS_PARTO = WS_ACT + 256 * MiB;
constexpr size_t WS_CAT = WS_ACT + 512 * MiB;
constexpr size_t WS_HB = WS_ACT;
constexpr size_t WS_QX = WS_ACT + 128 * MiB;
constexpr size_t WS_PB = WS_ACT + 256 * MiB;
constexpr size_t WS_OX = WS_ACT + 288 * MiB;
constexpr size_t WS_G = WS_ACT + 128 * MiB;
constexpr size_t WS_END = WS_ACT + 640 * MiB;
static_assert(WS_WDN + (size_t)DM * FF * 2 <= WS_ACT && WS_G + (size_t)M * FF * 2 <= WS_END && WS_WGU + (size_t)2 * FF * DM * 2 <= WS_WDN, "d_ws map");
constexpr int LIST_STRIDE = 256 * 496;
__host__ __device__ constexpr int list_off(int j) { return 256 * (31 * j - (j * (j - 1)) / 2); }
constexpr int CW_TMO = 0, CW_CODE = 1;
constexpr int CW_BAR = 4096;
constexpr int CW_GCNT = 8192;
constexpr int CW_CHK = 16384;

constexpr int RING_OFF = 0, RING_BYTES = 131072;
constexpr int LDSCTL_OFF = RING_BYTES, MISC_OFF = LDSCTL_OFF + 320;
constexpr int LDS_BYTES = 147456;

#define GAS __attribute__((address_space(1)))
#define LAS __attribute__((address_space(3)))
typedef unsigned short bf16;
typedef unsigned v4u __attribute__((ext_vector_type(4)));
typedef unsigned v2u __attribute__((ext_vector_type(2)));
typedef float f32x4 __attribute__((ext_vector_type(4)));
typedef short bf16x8 __attribute__((ext_vector_type(8)));
typedef float f32x16 __attribute__((ext_vector_type(16)));
typedef GAS unsigned gu32;
#define RLX_AGENT __ATOMIC_RELAXED, __HIP_MEMORY_SCOPE_AGENT
#define LDS_WAIT() asm volatile("s_waitcnt lgkmcnt(0)" ::: "memory")
#define VM_WAIT() asm volatile("s_waitcnt vmcnt(0)" ::: "memory")
__device__ __forceinline__ unsigned f2bf(float f) { unsigned u = __builtin_bit_cast(unsigned, f); return (u + 0x7fffu + ((u >> 16) & 1u)) >> 16; }
__device__ __forceinline__ unsigned pk2(float lo, float hi) { return f2bf(lo) | (f2bf(hi) << 16); }
__device__ __forceinline__ float bf_lo(unsigned w) { return __builtin_bit_cast(float, w << 16); }
__device__ __forceinline__ float bf_hi(unsigned w) { return __builtin_bit_cast(float, w & 0xffff0000u); }
__device__ __forceinline__ float bf2f(bf16 b) { return __builtin_bit_cast(float, ((unsigned)b) << 16); }
#define XB_TMO      128
#define XB_XCNT(j)  (256  + 64 * (j))
#define XB_XSUB(j)  (1280 + 64 * (j))
#define XB_XGEN(j)  (2304 + 64 * (j))
#define XB_TOP      3328
#define XB_TOPGEN   3392
#define XCD_BAR_WORDS 3456
#define XB_SPIN_CAP (1u << 18)

__device__ __forceinline__ unsigned xb_ld(unsigned* p)              { return __hip_atomic_load(p, __ATOMIC_RELAXED, __HIP_MEMORY_SCOPE_AGENT); }
__device__ __forceinline__ unsigned xb_add(unsigned* p, unsigned v) { return __hip_atomic_fetch_add(p, v, __ATOMIC_RELAXED, __HIP_MEMORY_SCOPE_AGENT); }
__device__ __forceinline__ unsigned xb_xcc_id() { return (unsigned)__builtin_amdgcn_s_getreg((3 << 11) | 20) & 0xFu; }
#define XB_SPIN(cond, bar) do { unsigned _sp = 0; while (cond) { __builtin_amdgcn_s_sleep(1); \
    if ((++_sp & 255u) == 0u) { if (xb_ld(&(bar)[XB_TMO])) break; if (_sp > XB_SPIN_CAP) { atomicAdd(&(bar)[XB_TMO], 1u); break; } } } } while (0)

struct XcdBarrier {
    unsigned* bar; unsigned x;
    volatile LAS unsigned* st;
};

__device__ __forceinline__ XcdBarrier xcd_barrier_post(unsigned* bar, volatile LAS unsigned* st) {
    XcdBarrier b; b.bar = bar; b.x = xb_xcc_id(); b.st = st;
    if (threadIdx.x == 0) (void)xb_add(&bar[XB_XCNT(b.x)], 1u);
    return b;
}
__device__ __forceinline__ void xcd_barrier_complete(unsigned* bar, unsigned x, unsigned& nloc, unsigned& nx) {
    const unsigned G = gridDim.x * gridDim.y * gridDim.z;
    unsigned sum, cnt, mine, sp = 0u;
    for (;;) {
        sum = 0u; cnt = 0u; mine = 0u;
#pragma unroll
        for (unsigned j = 0; j < 16; ++j) { const unsigned c = xb_ld(&bar[XB_XCNT(j)]); sum += c; cnt += (c > 0u) ? 1u : 0u; mine = (j == x) ? c : mine; }
        if (sum == G) break;
        __builtin_amdgcn_s_sleep(1);
        if ((++sp & 255u) == 0u) { if (xb_ld(&bar[XB_TMO])) break; if (sp > XB_SPIN_CAP) { atomicAdd(&bar[XB_TMO], 1u); break; } }
    }
    nloc = mine > 0u ? mine : 1u; nx = cnt > 0u ? cnt : 1u;
}

__device__ __forceinline__ void xcd_barrier(const XcdBarrier& b) {
    asm volatile("s_waitcnt vmcnt(0)" ::: "memory");
    __syncthreads();
    if (threadIdx.x == 0) {
        unsigned* bar = b.bar;
        __builtin_amdgcn_s_waitcnt(0);
        unsigned nloc = b.st[0], nx = b.st[1];
        if (nloc == 0u) { xcd_barrier_complete(bar, b.x, nloc, nx); b.st[0] = nloc; b.st[1] = nx; }
        const unsigned old = xb_add(&bar[XB_XSUB(b.x)], 1u);
        const unsigned gen = old / nloc;
        if (old + 1u == (gen + 1u) * nloc) {
            __builtin_amdgcn_fence(__ATOMIC_RELEASE, "agent");
            asm volatile("s_waitcnt vmcnt(0)" ::: "memory");
            const unsigned og = xb_add(&bar[XB_TOP], 1u);
            const unsigned tg = og / nx;
            if (og + 1u == (tg + 1u) * nx) xb_add(&bar[XB_TOPGEN], 1u);
            else XB_SPIN(xb_ld(&bar[XB_TOPGEN]) == tg, bar);
            __builtin_amdgcn_fence(__ATOMIC_ACQUIRE, "agent");
            xb_add(&bar[XB_XGEN(b.x)], 1u);
            asm volatile("s_waitcnt vmcnt(0)" ::: "memory");
        } else {
            XB_SPIN(xb_ld(&bar[XB_XGEN(b.x)]) == gen, bar);
            __builtin_amdgcn_fence(__ATOMIC_ACQUIRE, "agent");
            asm volatile("s_waitcnt vmcnt(0)" ::: "memory");
        }
    }
    __syncthreads();
}

struct Frame {
    LAS unsigned char* lds;
    volatile LAS unsigned* MISC;
    gu32* ctl;
    int tid, lane, wave;
    int G;
    unsigned char* ws;
};
__device__ __forceinline__ float wave_sum(float v) {
#pragma unroll
    for (int o = 1; o < 64; o <<= 1) v += __shfl_xor(v, o);
    return v;
}

template <class RowMap>
__device__ __forceinline__ void p0_transpose_item(const float* W, int K, int N, bf16* WT, LAS float* scr, int item, int lane, const RowMap& rm, const float* colscale) {
    const int nblk = N / 32, kb = item / nblk, nb = item % nblk, k0 = 64 * kb, n0 = 32 * nb;
#pragma unroll 8
    for (int i = 0; i < 32; ++i) { const int kk = 2 * i + (lane >> 5); scr[kk * 33 + (lane & 31)] = W[(size_t)(k0 + kk) * N + n0 + (lane & 31)]; }
    LDS_WAIT(); asm volatile("" ::: "memory");
    const int c = lane & 7;
#pragma unroll
    for (int j = 0; j < 4; ++j) { const int n = (lane >> 3) + 8 * j; const LAS float* s = scr + (8 * c) * 33 + n; const float sc = colscale ? colscale[n0 + n] : 1.0f;
        v4u o; o.x = pk2(s[0 * 33] * sc, s[1 * 33] * sc); o.y = pk2(s[2 * 33] * sc, s[3 * 33] * sc); o.z = pk2(s[4 * 33] * sc, s[5 * 33] * sc); o.w = pk2(s[6 * 33] * sc, s[7 * 33] * sc);
        *(GAS v4u*)(WT + (size_t)rm(n0 + n) * K + k0 + 8 * c) = o; }
    LDS_WAIT(); asm volatile("" ::: "memory");
}
struct RmIdent { int off; __device__ __forceinline__ int operator()(int n) const { return off + n; } };
struct RmMixIn { __device__ __forceinline__ int operator()(int n) const { if (n < 2048 || n >= 6144) return n; const int d = n & 127; return (n & ~127) + 2 * (d & 63) + (d >> 6); } };
struct RmGateUp { int up; __device__ __forceinline__ int operator()(int n) const { return (n >> 7) * 256 + up * 128 + (n & 127); } };

__device__ __forceinline__ void sincos_d(double a, double& s, double& c) {
    const double n = __builtin_rint(a * 0.63661977236758134308);
    double r = __builtin_fma(-n, 1.5707963267948966, a); r = __builtin_fma(-n, 6.123233995736766e-17, r);
    const double r2 = r * r;
    double ps = -7.6471637318198164759e-13; ps = ps * r2 + 1.6059043836821614599e-10; ps = ps * r2 - 2.5052108385441718775e-08; ps = ps * r2 + 2.7557319223985890653e-06;
    ps = ps * r2 - 1.9841269841269841270e-04; ps = ps * r2 + 8.3333333333333333333e-03; ps = ps * r2 - 1.6666666666666666667e-01; ps = r + r * r2 * ps;
    double pc = 4.7794773323873852974e-14; pc = pc * r2 - 1.1470745597729724714e-11; pc = pc * r2 + 2.0876756987868098979e-09; pc = pc * r2 - 2.7557319223985890653e-07;
    pc = pc * r2 + 2.4801587301587301587e-05; pc = pc * r2 - 1.3888888888888888889e-03; pc = pc * r2 + 4.1666666666666666667e-02; pc = pc * r2 - 0.5; pc = 1.0 + r2 * pc;
    const int q = ((int)n) & 3;
    s = (q == 0) ? ps : (q == 1) ? pc : (q == 2) ? -ps : -pc;
    c = (q == 0) ? pc : (q == 1) ? -ps : (q == 2) ? -pc : ps;
}
__device__ __forceinline__ float rope_inv(int i) {
    const double y = -(double)i * (13.287712379549449 / 64.0); const double fl = __builtin_floor(y); const double z = (y - fl) * 0.69314718055994530942;
    double e = 1.0, term = 1.0;
#pragma unroll
    for (int k = 1; k <= 20; ++k) { term = term * z / (double)k; e += term; }
    return (float)__builtin_ldexp(e, (int)fl);
}

__device__ __forceinline__ void p0_prologue(Frame& F, const float* const* in) {
    LAS float* scr = (LAS float*)(F.lds + RING_OFF + F.wave * 16384);
    const int gw = blockIdx.x * NWAVES + F.wave, NGW = F.G * NWAVES;
    const float* w_mix_in = in[2]; const float* w_pool = in[3]; const float* pool_scale = in[4]; const float* w_mix_out = in[5];
    const float* w_xq = in[8]; const float* w_xkv = in[9]; const float* w_xo = in[10]; const float* w_gate = in[13]; const float* w_up = in[14]; const float* w_down = in[15];
    bf16* WIN = (bf16*)(F.ws + WS_WIN); bf16* WPOOL = (bf16*)(F.ws + WS_WPOOL); bf16* WOUT = (bf16*)(F.ws + WS_WOUT); bf16* WXQ = (bf16*)(F.ws + WS_WXQ);
    bf16* WXKV = (bf16*)(F.ws + WS_WXKV); bf16* WXO = (bf16*)(F.ws + WS_WXO); bf16* WGU = (bf16*)(F.ws + WS_WGU); bf16* WDN = (bf16*)(F.ws + WS_WDN);
    constexpr int I_IN = (DM / 64) * (MIXIN / 32), I_POOL = (512 / 64) * (512 / 32), I_SQ = (DM / 64) * (DM / 32), I_KV = (DM / 64) * (2 * DM / 32), I_GU = (DM / 64) * (FF / 32), I_DN = (FF / 64) * (DM / 32);
    constexpr int NITEMS = I_IN + 4 * I_POOL + 3 * I_SQ + I_KV + 2 * I_GU + I_DN;
    for (int it = gw; it < NITEMS; it += NGW) {
        int r = it;
        if (r < I_IN) { p0_transpose_item(w_mix_in, DM, MIXIN, WIN, scr, r, F.lane, RmMixIn{}, nullptr); continue; } r -= I_IN;
        if (r < 4 * I_POOL) { const int g = r / I_POOL; p0_transpose_item(w_pool + (size_t)g * 512 * 512, 512, 512, WPOOL, scr, r % I_POOL, F.lane, RmIdent{g * 512}, pool_scale + g * 512); continue; } r -= 4 * I_POOL;
        if (r < I_SQ) { p0_transpose_item(w_mix_out, DM, DM, WOUT, scr, r, F.lane, RmIdent{0}, nullptr); continue; } r -= I_SQ;
        if (r < I_SQ) { p0_transpose_item(w_xq, DM, DM, WXQ, scr, r, F.lane, RmIdent{0}, nullptr); continue; } r -= I_SQ;
        if (r < I_KV) { p0_transpose_item(w_xkv, DM, 2 * DM, WXKV, scr, r, F.lane, RmIdent{0}, nullptr); continue; } r -= I_KV;
        if (r < I_SQ) { p0_transpose_item(w_xo, DM, DM, WXO, scr, r, F.lane, RmIdent{0}, nullptr); continue; } r -= I_SQ;
        if (r < I_GU) { p0_transpose_item(w_gate, DM, FF, WGU, scr, r, F.lane, RmGateUp{0}, nullptr); continue; } r -= I_GU;
        if (r < I_GU) { p0_transpose_item(w_up, DM, FF, WGU, scr, r, F.lane, RmGateUp{1}, nullptr); continue; } r -= I_GU;
        p0_transpose_item(w_down, FF, DM, WDN, scr, r, F.lane, RmIdent{0}, nullptr);
    }
    const size_t gt = (size_t)blockIdx.x * (NWAVES * 64) + F.tid, NT = (size_t)F.G * NWAVES * 64;
    { const float* x = in[0]; bf16* XB = (bf16*)(F.ws + WS_XB);
      for (size_t i = gt; i < (size_t)M * DM / 8; i += NT) { const f32x4 a = *(const GAS f32x4*)(x + i * 8), b = *(const GAS f32x4*)(x + i * 8 + 4);
          v4u o; o.x = pk2(a.x, a.y); o.y = pk2(a.z, a.w); o.z = pk2(b.x, b.y); o.w = pk2(b.z, b.w); *(GAS v4u*)(XB + i * 8) = o; } }
    { const float* x = in[1]; bf16* XB = (bf16*)(F.ws + WS_MEMB);
      for (size_t i = gt; i < (size_t)BATCH * MEMLEN * DM / 8; i += NT) { const f32x4 a = *(const GAS f32x4*)(x + i * 8), b = *(const GAS f32x4*)(x + i * 8 + 4);
          v4u o; o.x = pk2(a.x, a.y); o.y = pk2(a.z, a.w); o.z = pk2(b.x, b.y); o.w = pk2(b.z, b.w); *(GAS v4u*)(XB + i * 8) = o; } }
    { float2* tab = (float2*)(F.ws + WS_ROPE);
      for (size_t i = gt; i < (size_t)SEQ * 64; i += NT) { const int pos = (int)(i >> 6), fi = (int)(i & 63); const float ang = (float)pos * rope_inv(fi);
          double s, c; sincos_d((double)ang, s, c); tab[i] = make_float2((float)c, (float)s); } }
}

__device__ __forceinline__ void ln_rows(Frame& F, float* X, bf16* XB, const float* g, const float* b) {
    const int gw = blockIdx.x * NWAVES + F.wave, NGW = F.G * NWAVES;
    for (int m = gw; m < M; m += NGW) {
        GAS f32x4* xr = (GAS f32x4*)(X + (size_t)m * DM) + F.lane;
        f32x4 v[16]; float s = 0.f;
#pragma unroll
        for (int j = 0; j < 16; ++j) { v[j] = xr[64 * j]; s += (v[j].x + v[j].y) + (v[j].z + v[j].w); }
        const float mean = wave_sum(s) * (1.f / DM); float s2 = 0.f;
#pragma unroll
        for (int j = 0; j < 16; ++j) { v[j] = v[j] - mean; s2 += (v[j].x * v[j].x + v[j].y * v[j].y) + (v[j].z * v[j].z + v[j].w * v[j].w); }
        const float rstd = 1.f / sqrtf(wave_sum(s2) * (1.f / DM) + LN_EPS);
#pragma unroll
        for (int j = 0; j < 16; ++j) { const f32x4 gg = ((const GAS f32x4*)g)[64 * j + F.lane], bb = ((const GAS f32x4*)b)[64 * j + F.lane];
            const f32x4 y = v[j] * rstd * gg + bb; xr[64 * j] = y;
            if (XB) { v2u o; o.x = pk2(y.x, y.y); o.y = pk2(y.z, y.w); ((GAS v2u*)(XB + (size_t)m * DM))[64 * j + F.lane] = o; } }
    }
}

__device__ __forceinline__ void pool_ew(Frame& F) {
    const bf16* HP = (const bf16*)(F.ws + WS_HP); bf16* PMo = (bf16*)(F.ws + WS_PM);
    const size_t gt = (size_t)blockIdx.x * (NWAVES * 64) + F.tid, NT = (size_t)F.G * NWAVES * 64;
    for (size_t idx = gt; idx < (size_t)M * 256; idx += NT) {
        const int t = (int)(idx >> 8), c = (int)(idx & 255) * 8, grp = c >> 9, w = 2 << grp, tpos = t & (SEQ - 1), cnt = (tpos + 1 < w) ? tpos + 1 : w;
        float acc[8]; float u0[8];
#pragma unroll
        for (int e = 0; e < 8; ++e) acc[e] = 0.f;
        for (int j = 0; j < cnt; ++j) { const v4u r = *(const GAS v4u*)(HP + (size_t)(t - j) * PW + c);
            const float f[8] = {bf_lo(r.x), bf_hi(r.x), bf_lo(r.y), bf_hi(r.y), bf_lo(r.z), bf_hi(r.z), bf_lo(r.w), bf_hi(r.w)};
#pragma unroll
            for (int e = 0; e < 8; ++e) { acc[e] += f[e]; if (j == 0) u0[e] = f[e]; } }
        const float inv = 1.0f / (float)cnt;
        v4u o; o.x = pk2(acc[0] * inv - u0[0], acc[1] * inv - u0[1]); o.y = pk2(acc[2] * inv - u0[2], acc[3] * inv - u0[3]);
        o.z = pk2(acc[4] * inv - u0[4], acc[5] * inv - u0[5]); o.w = pk2(acc[6] * inv - u0[6], acc[7] * inv - u0[7]);
        *(GAS v4u*)(PMo + (size_t)t * PW + c) = o;
    }
}

__device__ __forceinline__ void kmean_phase(Frame& F) {
    const bf16* Kb = (const bf16*)(F.ws + WS_K); bf16* KMH = (bf16*)(F.ws + WS_KMH); bf16* KML = (bf16*)(F.ws + WS_KML);
    LAS float* part = (LAS float*)(F.lds + RING_OFF);
    for (int item = blockIdx.x; item < 64 * 4; item += F.G) {
        const int bn = item >> 2, chunk = item & 3;
        float acc[8];
#pragma unroll
        for (int e = 0; e < 8; ++e) acc[e] = 0.f;
        const bf16* base = Kb + (size_t)(bn * 256 + F.wave * 32) * AW + chunk * 512 + F.lane * 8;
#pragma unroll 8
        for (int r = 0; r < 32; ++r) { const v4u q = *(const GAS v4u*)(base + (size_t)r * AW);
            acc[0] += bf_lo(q.x); acc[1] += bf_hi(q.x); acc[2] += bf_lo(q.y); acc[3] += bf_hi(q.y); acc[4] += bf_lo(q.z); acc[5] += bf_hi(q.z); acc[6] += bf_lo(q.w); acc[7] += bf_hi(q.w); }
#pragma unroll
        for (int e = 0; e < 8; ++e) part[F.wave * 512 + F.lane * 8 + e] = acc[e];
        __syncthreads();
        { float s = 0.f;
#pragma unroll
          for (int w = 0; w < 8; ++w) s += part[w * 512 + F.tid];
          const float mean = s * (1.0f / 256.0f); const unsigned hb = f2bf(mean); const float hf = __builtin_bit_cast(float, hb << 16);
          KMH[(size_t)bn * AW + chunk * 512 + F.tid] = (bf16)hb; KML[(size_t)bn * AW + chunk * 512 + F.tid] = (bf16)f2bf(mean - hf); }
        __syncthreads();
    }
}

__device__ __forceinline__ void gate_phase(Frame& F) {
    const bf16* Qb = (const bf16*)(F.ws + WS_Q); const bf16* KMH = (const bf16*)(F.ws + WS_KMH); const bf16* KML = (const bf16*)(F.ws + WS_KML);
    unsigned short* lists = (unsigned short*)(F.ws + WS_LIST); gu32* gcnt = F.ctl + CW_GCNT;
    LAS float* gl = (LAS float*)(F.lds + RING_OFF);
    LAS unsigned* lcnt = (LAS unsigned*)(F.lds + RING_OFF + 34816);
    LAS unsigned* gb = lcnt + 32;
    const int r32 = F.lane & 31, hi = F.lane >> 5;
    for (int uid = blockIdx.x; uid < 1024; uid += F.G) {
        const int bh = uid >> 5, qb = uid & 31, b = bh >> 4, h = bh & 15;
        if (qb == 0) continue;
        if (F.tid < 32) lcnt[F.tid] = 0u;
        const size_t trow = (size_t)b * SEQ + 256 * qb + 32 * F.wave + r32;
        f32x16 acc = {};
#pragma unroll
        for (int s = 0; s < 8; ++s) {
            const bf16x8 bq = *(const GAS bf16x8*)(Qb + trow * AW + h * HD + 16 * s + 8 * hi);
            const bf16x8 ah = *(const GAS bf16x8*)(KMH + (size_t)(b * 32 + r32) * AW + h * HD + 16 * s + 8 * hi);
            const bf16x8 al = *(const GAS bf16x8*)(KML + (size_t)(b * 32 + r32) * AW + h * HD + 16 * s + 8 * hi);
            acc = __builtin_amdgcn_mfma_f32_32x32x16_bf16(ah, bq, acc, 0, 0, 0);
            acc = __builtin_amdgcn_mfma_f32_32x32x16_bf16(al, bq, acc, 0, 0, 0);
        }
#pragma unroll
        for (int r = 0; r < 16; ++r) gl[(32 * F.wave + r32) * 33 + att::crow(r, hi)] = acc[r];
        __syncthreads();
        int s0 = 0, s1 = 0, s2 = 0; unsigned p0 = 0, p1 = 0, p2 = 0; const int nsel = qb < 3 ? qb : 3;
        if (F.tid < 256) {
            float v0 = -__builtin_inff(), v1 = v0, v2 = v0;
            for (int n = 0; n < qb; ++n) { const float g = gl[F.tid * 33 + n];
                if (g > v0) { v2 = v1; s2 = s1; v1 = v0; s1 = s0; v0 = g; s0 = n; }
                else if (g > v1) { v2 = v1; s2 = s1; v1 = g; s1 = n; }
                else if (g > v2) { v2 = g; s2 = n; } }
            p0 = __hip_atomic_fetch_add(lcnt + s0, 1u, __ATOMIC_RELAXED, __HIP_MEMORY_SCOPE_WORKGROUP);
            if (nsel > 1) p1 = __hip_atomic_fetch_add(lcnt + s1, 1u, __ATOMIC_RELAXED, __HIP_MEMORY_SCOPE_WORKGROUP);
            if (nsel > 2) p2 = __hip_atomic_fetch_add(lcnt + s2, 1u, __ATOMIC_RELAXED, __HIP_MEMORY_SCOPE_WORKGROUP);
        }
        __syncthreads();
        if (F.tid < 32) { const unsigned c = lcnt[F.tid]; gb[F.tid] = c ? __hip_atomic_fetch_add(gcnt + bh * 32 + F.tid, c, RLX_AGENT) : 0u; }
        __syncthreads();
        if (F.tid < 256) {
            unsigned short* lb = lists + (size_t)bh * LIST_STRIDE; const unsigned tl = (unsigned)(256 * qb + F.tid);
            lb[list_off(s0) + gb[s0] + p0] = (unsigned short)(tl | (0u << 13));
            if (nsel > 1) lb[list_off(s1) + gb[s1] + p1] = (unsigned short)(tl | (1u << 13));
            if (nsel > 2) lb[list_off(s2) + gb[s2] + p2] = (unsigned short)(tl | (2u << 13));
        }
        __syncthreads();
    }
}

__device__ __forceinline__ void attn_phase(Frame& F, char* ldsg) {
    const bf16* Qb = (const bf16*)(F.ws + WS_Q); const bf16* Kb = (const bf16*)(F.ws + WS_K); const bf16* Vb = (const bf16*)(F.ws + WS_V);
    bf16* PO = (bf16*)(F.ws + WS_PARTO); float2* ML = (float2*)(F.ws + WS_ML);
    const unsigned short* lists = (const unsigned short*)(F.ws + WS_LIST); const gu32* gcnt = F.ctl + CW_GCNT;
    LAS int* pre = (LAS int*)(F.lds + RING_OFF + 67584);
    for (int i = F.tid; i < 1024; i += NWAVES * 64) pre[i] = (int)((__hip_atomic_load(gcnt + i, RLX_AGENT) + 255u) >> 8);
    __syncthreads();
    if (F.wave == 0) {
        int loc[16]; int s = 0;
#pragma unroll
        for (int k = 0; k < 16; ++k) { loc[k] = pre[F.lane * 16 + k]; s += loc[k]; }
        int incl = s;
#pragma unroll
        for (int o = 1; o < 64; o <<= 1) { const int v = __shfl_up(incl, o); if (F.lane >= o) incl += v; }
        int run = incl - s;
#pragma unroll
        for (int k = 0; k < 16; ++k) { pre[F.lane * 16 + k] = run; run += loc[k]; }
        if (F.lane == 63) pre[1024] = incl;
    }
    __syncthreads();
    const int total = 1024 + pre[1024];
    const int r32 = F.lane & 31, rloc = 32 * F.wave + r32;
    for (int id = blockIdx.x; id < total; id += F.G) {
        int bh, j, t, slot; bool causal, valid;
        if (id < 1024) { bh = id >> 5; j = id & 31; causal = true; valid = true; t = 256 * j + rloc; slot = 3; }
        else {
            const int x = id - 1024; int lo = 0, hi2 = 1023;
            while (lo < hi2) { const int mid = (lo + hi2 + 1) >> 1; if (pre[mid] <= x) lo = mid; else hi2 = mid - 1; }
            const int li = lo, chunk = x - pre[li]; bh = li >> 5; j = li & 31; causal = false;
            const int cnt = (int)__hip_atomic_load(gcnt + li, RLX_AGENT) - 256 * chunk;
            valid = rloc < cnt;
            const unsigned e = lists[(size_t)bh * LIST_STRIDE + list_off(j) + 256 * chunk + (valid ? rloc : 0)];
            t = (int)(e & 8191u); slot = (int)(e >> 13);
        }
        const int b = bh >> 4, h = bh & 15;
        const bf16* Qrow = Qb + ((size_t)b * SEQ + t) * AW + h * HD;
        const bf16* Kh = Kb + ((size_t)b * SEQ + 256 * j) * AW + h * HD; const bf16* Vh = Vb + ((size_t)b * SEQ + 256 * j) * AW + h * HD;
        bf16* Orow = PO + (((size_t)slot * 32 + bh) * SEQ + t) * HD; float2* MLrow = ML + ((size_t)slot * 32 + bh) * SEQ + t;
        att::attn_item(Qrow, Kh, Vh, causal, rloc, Orow, MLrow, valid, ldsg);
    }
}

__device__ __forceinline__ void combine_phase(Frame& F) {
    const bf16* PO = (const bf16*)(F.ws + WS_PARTO); const float2* ML = (const float2*)(F.ws + WS_ML); bf16* CAT = (bf16*)(F.ws + WS_CAT);
    constexpr float C = att::SCALE * 1.4426950408889634f;
    const size_t gt = (size_t)blockIdx.x * (NWAVES * 64) + F.tid, NT = (size_t)F.G * NWAVES * 64;
    for (size_t idx = gt; idx < (size_t)32 * SEQ * 16; idx += NT) {
        const int dc = (int)(idx & 15), t = (int)((idx >> 4) & (SEQ - 1)), bh = (int)(idx >> 17), qb = t >> 8, nsel = qb < 3 ? qb : 3;
        float2 ml[4]; float mx;
        ml[3] = ML[((size_t)3 * 32 + bh) * SEQ + t]; mx = ml[3].x;
#pragma unroll
        for (int k = 0; k < 3; ++k) { if (k < nsel) { ml[k] = ML[((size_t)k * 32 + bh) * SEQ + t]; mx = fmaxf(mx, ml[k].x); } else ml[k] = make_float2(0.f, 0.f); }
        float acc[8]; float wsum = 0.f;
#pragma unroll
        for (int e = 0; e < 8; ++e) acc[e] = 0.f;
#pragma unroll
        for (int k = 0; k < 4; ++k) { if (k == 3 || k < nsel) {
            const float w = ml[k].y * __builtin_amdgcn_exp2f((ml[k].x - mx) * C); wsum += w;
            const v4u r = *(const GAS v4u*)(PO + (((size_t)k * 32 + bh) * SEQ + t) * HD + dc * 8);
            acc[0] += w * bf_lo(r.x); acc[1] += w * bf_hi(r.x); acc[2] += w * bf_lo(r.y); acc[3] += w * bf_hi(r.y);
            acc[4] += w * bf_lo(r.z); acc[5] += w * bf_hi(r.z); acc[6] += w * bf_lo(r.w); acc[7] += w * bf_hi(r.w); } }
        const float inv = 1.0f / wsum; const int b = bh >> 4, h = bh & 15;
        v4u o; o.x = pk2(acc[0] * inv, acc[1] * inv); o.y = pk2(acc[2] * inv, acc[3] * inv); o.z = pk2(acc[4] * inv, acc[5] * inv); o.w = pk2(acc[6] * inv, acc[7] * inv);
        *(GAS v4u*)(CAT + ((size_t)b * SEQ + t) * DM + PW + h * HD + dc * 8) = o;
    }
}

struct Args { const float* in[18]; float* out; unsigned char* ws; int ph_lo, ph_hi, li, pad; };
__global__ void __launch_bounds__(NWAVES * 64, 2) mega_fwd(Args args) {
    extern __shared__ __attribute__((aligned(16))) unsigned char lds[];
    Frame F;
    F.lds = (LAS unsigned char*)lds;
    F.MISC = (volatile LAS unsigned*)(F.lds + MISC_OFF);
    F.tid = threadIdx.x; F.lane = F.tid & 63; F.wave = __builtin_amdgcn_readfirstlane(F.tid >> 6);
    F.G = gridDim.x; F.ws = args.ws;
    F.ctl = (gu32*)(args.ws + WS_CTL);
    for (int u = F.tid; u < (LDS_BYTES - LDSCTL_OFF) / 4; u += NWAVES * 64) ((LAS unsigned*)(F.lds + LDSCTL_OFF))[u] = 0u;
    __syncthreads();
    XcdBarrier bar; bar.bar = (unsigned*)(F.ctl + CW_BAR); bar.x = 0; bar.st = nullptr;
    if (N_LAUNCHES == 1) bar = xcd_barrier_post((unsigned*)(F.ctl + CW_BAR), F.MISC + 8);
#define GRID_BAR() do { if (N_LAUNCHES == 1) xcd_barrier(bar); } while (0)
    const int lo = args.ph_lo, hi = args.ph_hi;
#define IN(k) (lo <= (k) && (k) < hi)
#define BOTH(k) (IN(k) && IN((k) + 1))
    unsigned char* ws = args.ws;
    const int G = F.G, cid = (int)blockIdx.x;
    float* out = args.out;

    if (IN(0)) { p0_prologue(F, args.in); if (BOTH(0)) GRID_BAR(); }

    if (IN(1)) {
        { pg8::Gemm g = pg8::make_gemm(ws + WS_XB, DM, ws + WS_WIN, DM, DM); pg8::StaticOrder S; S.init(M, MIXIN, G, cid);
          pg8::EpiMixIn E{(pg8::bf16_t*)(ws + WS_HP), (size_t)M * 2048, (const float*)(ws + WS_ROPE)};
          pg8::gemm_phase<pg8::EpiMixIn, pg8::StaticOrder, true, true>(F.lds + RING_OFF, g, S, E); }
        { pg8::Gemm g = pg8::make_gemm(ws + WS_MEMB, DM, ws + WS_WXKV, DM, DM); pg8::StaticOrder S; S.init(BATCH * MEMLEN, DM, G, cid);
          pg8::EpiStore E{(pg8::bf16_t*)(ws + WS_KX), DM, 0};
          pg8::gemm_phase<pg8::EpiStore, pg8::StaticOrder, true, true>(F.lds + RING_OFF, g, S, E); }
        { pg8::Gemm g = pg8::make_gemm(ws + WS_WXKV + (size_t)DM * DM * 2, DM, ws + WS_MEMB, DM, DM); pg8::StaticOrder S; S.init(DM, BATCH * MEMLEN, G, cid);
          pg8::EpiStore E{(pg8::bf16_t*)(ws + WS_VT), BATCH * MEMLEN, 0};
          pg8::gemm_phase<pg8::EpiStore, pg8::StaticOrder, true, true>(F.lds + RING_OFF, g, S, E); }
        if (BOTH(1)) GRID_BAR();
    }

    if (IN(2)) { pool_ew(F); kmean_phase(F); if (BOTH(2)) GRID_BAR(); }

    if (IN(3)) {
        { pg8::Gemm g = pg8::make_gemm(ws + WS_PM, PW, ws + WS_WPOOL, 512, 512); g.a_pn = 512 * 2; g.a_pn_sh = 1; pg8::StaticOrder S; S.init(M, PW, G, cid);
          pg8::EpiStore E{(pg8::bf16_t*)(ws + WS_CAT), DM, 0};
          pg8::gemm_phase<pg8::EpiStore, pg8::StaticOrder, true, true>(F.lds + RING_OFF, g, S, E); }
        gate_phase(F);
        if (BOTH(3)) GRID_BAR();
    }

    if (IN(4)) { attn_phase(F, (char*)lds + RING_OFF); if (BOTH(4)) GRID_BAR(); }

    if (IN(5)) { combine_phase(F); if (BOTH(5)) GRID_BAR(); }

    if (IN(6)) {
        pg8::Gemm g = pg8::make_gemm(ws + WS_CAT, DM, ws + WS_WOUT, DM, DM); pg8::StaticOrder S; S.init(M, DM, G, cid);
        pg8::EpiResid E{args.in[0], out, DM, DN_ALPHA};
        pg8::gemm_phase<pg8::EpiResid, pg8::StaticOrder, true, true>(F.lds + RING_OFF, g, S, E);
        if (BOTH(6)) GRID_BAR();
    }
    if (IN(7)) { ln_rows(F, out, (bf16*)(ws + WS_HB), args.in[6], args.in[7]); if (BOTH(7)) GRID_BAR(); }

    if (IN(8)) {
        pg8::Gemm g = pg8::make_gemm(ws + WS_HB, DM, ws + WS_WXQ, DM, DM); pg8::StaticOrder S; S.init(M, DM, G, cid);
        pg8::EpiStore E{(pg8::bf16_t*)(ws + WS_QX), DM, 0};
        pg8::gemm_phase<pg8::EpiStore, pg8::StaticOrder, true, true>(F.lds + RING_OFF, g, S, E);
        if (BOTH(8)) GRID_BAR();
    }
    if (IN(9)) {
        if (G == 256) {
            pg8::Gemm g = pg8::make_gemm(ws + WS_QX, DM, ws + WS_KX, DM, XHD); g.a_pn = XHD * 2; g.a_pn_sh = 0; g.b_pn = XHD * 2; g.b_pm = (size_t)MEMLEN * DM * 2; g.b_pm_sh = 5;
            pg8::StaticOrder S; S.init(M, XH * 256, G, cid);
            pg8::EpiSoftmax E{(pg8::bf16_t*)(ws + WS_PB), XH * MEMLEN, 0.03125f * 1.4426950408889634f};
            pg8::gemm_phase<pg8::EpiSoftmax, pg8::StaticOrder, false, true>(F.lds + RING_OFF, g, S, E);
        }
        if (BOTH(9)) GRID_BAR();
    }
    if (IN(10)) {
        pg8::Gemm g = pg8::make_gemm(ws + WS_PB, XH * MEMLEN, ws + WS_VT, BATCH * MEMLEN, MEMLEN); g.a_pn = MEMLEN * 2; g.a_pn_sh = 2; g.b_pm = MEMLEN * 2; g.b_pm_sh = 5;
        pg8::StaticOrder S; S.init(M, DM, G, cid);
        pg8::EpiStore E{(pg8::bf16_t*)(ws + WS_OX), DM, 0};
        pg8::gemm_phase<pg8::EpiStore, pg8::StaticOrder, true, true>(F.lds + RING_OFF, g, S, E);
        if (BOTH(10)) GRID_BAR();
    }
    if (IN(11)) {
        pg8::Gemm g = pg8::make_gemm(ws + WS_OX, DM, ws + WS_WXO, DM, DM); pg8::StaticOrder S; S.init(M, DM, G, cid);
        pg8::EpiResid E{out, out, DM, DN_ALPHA};
        pg8::gemm_phase<pg8::EpiResid, pg8::StaticOrder, true, true>(F.lds + RING_OFF, g, S, E);
        if (BOTH(11)) GRID_BAR();
    }
    if (IN(12)) { ln_rows(F, out, (bf16*)(ws + WS_HB), args.in[11], args.in[12]); if (BOTH(12)) GRID_BAR(); }

    if (IN(13)) {
        pg8::Gemm g = pg8::make_gemm(ws + WS_HB, DM, ws + WS_WGU, DM, DM); pg8::StaticOrder S; S.init(M, 2 * FF, G, cid);
        pg8::EpiSwiGLU E{(pg8::bf16_t*)(ws + WS_G), FF};
        pg8::gemm_phase<pg8::EpiSwiGLU, pg8::StaticOrder, true, true>(F.lds + RING_OFF, g, S, E);
        if (BOTH(13)) GRID_BAR();
    }
    if (IN(14)) {
        pg8::Gemm g = pg8::make_gemm(ws + WS_G, FF, ws + WS_WDN, FF, FF); pg8::StaticOrder S; S.init(M, DM, G, cid);
        pg8::EpiResid E{out, out, DM, DN_ALPHA};
        pg8::gemm_phase<pg8::EpiResid, pg8::StaticOrder, true, true>(F.lds + RING_OFF, g, S, E);
        if (BOTH(14)) GRID_BAR();
    }
    if (IN(15)) { ln_rows(F, out, nullptr, args.in[16], args.in[17]); }
#undef IN
#undef BOTH
#undef GRID_BAR
}

extern "C" void kernel_launch(void* const* d_in, const int* in_sizes, int n_in, void* d_out, int out_size, void* d_ws, size_t ws_size, hipStream_t stream) {
    static int grid = 0;
    if (grid == 0) {
        if (n_in != 18 || in_sizes[0] != M * DM || out_size != M * DM || ws_size < WS_END) { fprintf(stderr, "kernel_launch: shape / workspace mismatch (n_in %d, in0 %d, out %d, ws %zu, need %zu)\n", n_in, n_in > 0 ? in_sizes[0] : -1, out_size, ws_size, (size_t)WS_END); grid = -1; return; }
        int dev = 0, cus = 0, per_cu = 0;
        if (hipGetDevice(&dev) != hipSuccess || hipDeviceGetAttribute(&cus, hipDeviceAttributeMultiprocessorCount, dev) != hipSuccess) { grid = -1; return; }
        if (hipFuncSetAttribute((const void*)mega_fwd, hipFuncAttributeMaxDynamicSharedMemorySize, LDS_BYTES) != hipSuccess) { fprintf(stderr, "kernel_launch: hipFuncSetAttribute failed\n"); grid = -1; return; }
        if (hipOccupancyMaxActiveBlocksPerMultiprocessor(&per_cu, (const void*)mega_fwd, NWAVES * 64, LDS_BYTES) != hipSuccess || per_cu < 1)
            fprintf(stderr, "kernel_launch: note: occupancy query reports %d workgroups per CU\n", per_cu);
        (void)hipGetLastError();
        grid = cus;
        if (grid != 256) fprintf(stderr, "kernel_launch: %d CUs; the cross-attention score phase needs a 256-workgroup grid\n", grid);
    }
    if (grid < 0) return;
    if (hipMemsetAsync((char*)d_ws + WS_CTL, 0, CTL_ZERO_BYTES, stream) != hipSuccess) return;
    Args a{};
    for (int i = 0; i < 18; ++i) a.in[i] = (const float*)d_in[i];
    a.out = (float*)d_out; a.ws = (unsigned char*)d_ws; a.pad = 0;
    for (int li = 0; li < N_LAUNCHES; ++li) {
        a.ph_lo = (N_LAUNCHES == 1) ? 0 : li; a.ph_hi = (N_LAUNCHES == 1) ? N_PHASES : li + 1; a.li = li;
        hipLaunchKernelGGL(mega_fwd, dim3(grid), dim3(NWAVES * 64), LDS_BYTES, stream, a);
        if (hipPeekAtLastError() != hipSuccess) { fprintf(stderr, "kernel_launch: launch %d failed\n", li); break; }
    }
}
```

```cpp
#include <hip/hip_runtime.h>
#include <cstdio>
#include <cstdint>

namespace pg8 {
#define PG8_LAS __attribute__((address_space(3)))
typedef unsigned short bf16_t;
typedef short bf16x8 __attribute__((ext_vector_type(8)));
typedef float f32x4 __attribute__((ext_vector_type(4)));
typedef float f32x2 __attribute__((ext_vector_type(2)));
typedef unsigned u32x4 __attribute__((ext_vector_type(4)));
typedef unsigned u32x2 __attribute__((ext_vector_type(2)));
constexpr int BM = 256, BK = 64, HALF = 128, HTB = HALF * BK * 2  , STAGE_BYTES = 8 * HTB, NXCD = 8, WGM = 8;

__host__ __device__ __forceinline__ int lds_byte(int r, int c) { const int st = (r >> 4) * 2 + (c >> 5), rr = r & 15, cc = c & 31, ob = rr * 64 + cc * 2; return st * 1024 + (ob ^ (((ob >> 9) & 1) << 5)); }
__host__ __device__ __forceinline__ void stage_rc(int b, int& R, int& C) { const int st = b / 1024, sb = b % 1024, swz = sb ^ (((sb >> 9) & 1) << 5); R = (st >> 1) * 16 + swz / 64; C = (st & 1) * 32 + (swz % 64) / 2; }
__host__ __device__ __forceinline__ int perm32(int rho) { const int n = rho >> 4, i = rho & 15; return 8 * (i >> 2) + 4 * n + (i & 3); }

struct Unit { int pm, pn, pz; };
struct Gemm {
    const char* A; const char* B; int lda, ldb, K;
    size_t a_pm, a_pn; int a_pn_sh; size_t b_pn, b_pm; int b_pm_sh;
    __device__ __forceinline__ const char* a_ptr(const Unit& u) const { return A + (size_t)u.pm * a_pm + (size_t)(u.pn >> a_pn_sh) * a_pn; }
    __device__ __forceinline__ const char* b_ptr(const Unit& u) const { return B + (size_t)u.pn * b_pn + (size_t)(u.pm >> b_pm_sh) * b_pm; }
};
__device__ __forceinline__ Gemm make_gemm(const void* A, int lda, const void* B, int ldb, int K) {
    Gemm g; g.A = (const char*)A; g.B = (const char*)B; g.lda = lda; g.ldb = ldb; g.K = K;
    g.a_pm = (size_t)BM * lda * 2; g.a_pn = 0; g.a_pn_sh = 0; g.b_pn = (size_t)BM * ldb * 2; g.b_pm = 0; g.b_pm_sh = 0; return g;
}

struct StaticOrder {
    int nM, nN, nwg, G, c;
    __host__ __device__ void init(int M, int N, int G_, int c_) { nM = M / BM; nN = N / BM; nwg = nM * nN; G = G_; c = c_; }
    __host__ __device__ bool next(int i, Unit& u) const {
        const long L = (long)i * G + c; if (L >= nwg) return false;
        int wgid = (int)L; { const int q = nwg / NXCD, r = nwg % NXCD, xcd = wgid % NXCD, off = wgid / NXCD; wgid = (xcd < r ? xcd * (q + 1) : r * (q + 1) + (xcd - r) * q) + off; }
        const int nig = WGM * nN, gid = wgid / nig, fm = gid * WGM, gsz = (nM - fm) < WGM ? (nM - fm) : WGM;
        u.pm = fm + ((wgid % nig) % gsz); u.pn = (wgid % nig) / gsz; u.pz = 0; return true;
    }
    __device__ __forceinline__ void a_ready(const Unit&) const {}
    __device__ __forceinline__ void done(const Unit&) const {}
};

__device__ __forceinline__ unsigned cvt_pk_bf16(float lo, float hi) { unsigned r; asm volatile("v_cvt_pk_bf16_f32 %0, %1, %2" : "=v"(r) : "v"(lo), "v"(hi)); return r; }

struct EpiMixIn {
    static constexpr bool PERM = true, AFTER_DRAIN = false;
    bf16_t* base; size_t tstride; const float* rope;
    __device__ __forceinline__ void operator()(const f32x4 (&acc)[2][2][4][2], const Unit& u, int wr, int wc, int fr, int fq) const {
        const int t = u.pn >> 3; const bool rp = (t == 1) || (t == 2);
        bf16_t* ob = base + (size_t)t * tstride;
        const int row0 = u.pm * BM + wr * 64 + fr, col0 = (u.pn & 7) * BM + wc * 32 + 8 * fq;
#pragma unroll
        for (int ai = 0; ai < 2; ++ai)
#pragma unroll
            for (int m = 0; m < 4; ++m) {
                const int row = row0 + ai * HALF + m * 16; bf16_t* rowp = ob + (size_t)row * 2048 + col0;
                f32x4 cs0 = (f32x4){1.f, 0.f, 1.f, 0.f}, cs1 = cs0;
                if (rp) { const f32x4* tp = (const f32x4*)(rope + ((size_t)(row & 8191) * 64 + wc * 16 + fq * 4) * 2); cs0 = tp[0]; cs1 = tp[1]; }
#pragma unroll
                for (int bj = 0; bj < 2; ++bj) {
                    const f32x4 v0 = acc[ai][bj][m][0], v1 = acc[ai][bj][m][1];
                    const float a0 = v0[0] * cs0[0] - v0[1] * cs0[1], a1 = v0[1] * cs0[0] + v0[0] * cs0[1];
                    const float a2 = v0[2] * cs0[2] - v0[3] * cs0[3], a3 = v0[3] * cs0[2] + v0[2] * cs0[3];
                    const float b0 = v1[0] * cs1[0] - v1[1] * cs1[1], b1 = v1[1] * cs1[0] + v1[0] * cs1[1];
                    const float b2 = v1[2] * cs1[2] - v1[3] * cs1[3], b3 = v1[3] * cs1[2] + v1[2] * cs1[3];
                    u32x4 w; w.x = cvt_pk_bf16(a0, a1); w.y = cvt_pk_bf16(a2, a3); w.z = cvt_pk_bf16(b0, b1); w.w = cvt_pk_bf16(b2, b3);
                    *(u32x4*)(rowp + bj * HALF) = w;
                }
            }
    }
};
struct EpiStore {
    static constexpr bool PERM = true, AFTER_DRAIN = false;
    bf16_t* O; int ldc, coff;
    __device__ __forceinline__ void operator()(const f32x4 (&acc)[2][2][4][2], const Unit& u, int wr, int wc, int fr, int fq) const {
        const int row0 = u.pm * BM + wr * 64 + fr, col0 = coff + u.pn * BM + wc * 32 + 8 * fq;
#pragma unroll
        for (int ai = 0; ai < 2; ++ai)
#pragma unroll
            for (int m = 0; m < 4; ++m) { bf16_t* rowp = O + (size_t)(row0 + ai * HALF + m * 16) * ldc + col0;
#pragma unroll
                for (int bj = 0; bj < 2; ++bj) { const f32x4 v0 = acc[ai][bj][m][0], v1 = acc[ai][bj][m][1];
                    u32x4 w; w.x = cvt_pk_bf16(v0[0], v0[1]); w.y = cvt_pk_bf16(v0[2], v0[3]); w.z = cvt_pk_bf16(v1[0], v1[1]); w.w = cvt_pk_bf16(v1[2], v1[3]);
                    *(u32x4*)(rowp + bj * HALF) = w; } }
    }
};
struct EpiResid {
    static constexpr bool PERM = false, AFTER_DRAIN = false;
    const float* res; float* out; int ldc; float alpha;
    __device__ __forceinline__ void operator()(const f32x4 (&acc)[2][2][4][2], const Unit& u, int wr, int wc, int fr, int fq) const {
        const int row0 = u.pm * BM + wr * 64 + fr, col0 = u.pn * BM + wc * 32 + 4 * fq;
#pragma unroll
        for (int ai = 0; ai < 2; ++ai)
#pragma unroll
            for (int m = 0; m < 4; ++m) { const size_t off = (size_t)(row0 + ai * HALF + m * 16) * ldc + col0;
#pragma unroll
                for (int bj = 0; bj < 2; ++bj)
#pragma unroll
                    for (int n = 0; n < 2; ++n) { const f32x4 r = *(const f32x4*)(res + off + bj * HALF + n * 16); *(f32x4*)(out + off + bj * HALF + n * 16) = r * alpha + acc[ai][bj][m][n]; }
                asm volatile("" ::: "memory"); }
    }
};
struct EpiSwiGLU {
    static constexpr bool PERM = true, AFTER_DRAIN = false;
    bf16_t* G; int ldc;
    __device__ __forceinline__ float act(float g, float u) const { return g * u * __builtin_amdgcn_rcpf(1.0f + __builtin_amdgcn_exp2f(-1.4426950408889634f * g)); }
    __device__ __forceinline__ void operator()(const f32x4 (&acc)[2][2][4][2], const Unit& u, int wr, int wc, int fr, int fq) const {
        const int row0 = u.pm * BM + wr * 64 + fr, col0 = u.pn * HALF + wc * 32 + 8 * fq;
#pragma unroll
        for (int ai = 0; ai < 2; ++ai)
#pragma unroll
            for (int m = 0; m < 4; ++m) { bf16_t* rowp = G + (size_t)(row0 + ai * HALF + m * 16) * ldc + col0;
                const f32x4 g0 = acc[ai][0][m][0], g1 = acc[ai][0][m][1], u0 = acc[ai][1][m][0], u1 = acc[ai][1][m][1];
                u32x4 w; w.x = cvt_pk_bf16(act(g0[0], u0[0]), act(g0[1], u0[1])); w.y = cvt_pk_bf16(act(g0[2], u0[2]), act(g0[3], u0[3]));
                w.z = cvt_pk_bf16(act(g1[0], u1[0]), act(g1[1], u1[1])); w.w = cvt_pk_bf16(act(g1[2], u1[2]), act(g1[3], u1[3]));
                *(u32x4*)rowp = w; }
    }
};
struct EpiSoftmax {
    static constexpr bool PERM = true, AFTER_DRAIN = true;
    bf16_t* P; int ldc; float c2;
    __device__ __forceinline__ void fused(f32x4 (&acc)[2][2][4][2], const Unit& u, int wr, int wc, int fr, int fq, PG8_LAS unsigned char* lds, int wid, int lane) const {
        PG8_LAS float* T1 = (PG8_LAS float*)lds;
        PG8_LAS float* T2 = (PG8_LAS float*)(lds + 4096);
#pragma unroll
        for (int ai = 0; ai < 2; ++ai)
#pragma unroll
            for (int m = 0; m < 4; ++m) { float mx = -3.0e38f;
#pragma unroll
                for (int bj = 0; bj < 2; ++bj)
#pragma unroll
                    for (int n = 0; n < 2; ++n) { const f32x4 x = acc[ai][bj][m][n]; mx = fmaxf(mx, fmaxf(fmaxf(x[0], x[1]), fmaxf(x[2], x[3]))); }
                mx = fmaxf(mx, __shfl_xor(mx, 16)); mx = fmaxf(mx, __shfl_xor(mx, 32));
                if (fq == 0) T1[(ai * HALF + wr * 64 + m * 16 + fr) * 4 + wc] = mx; }
        asm volatile("s_waitcnt lgkmcnt(0)" ::: "memory"); __builtin_amdgcn_s_barrier(); asm volatile("" ::: "memory");
#pragma unroll
        for (int ai = 0; ai < 2; ++ai)
#pragma unroll
            for (int m = 0; m < 4; ++m) { const int r = ai * HALF + wr * 64 + m * 16 + fr;
                const f32x4 t = *(const PG8_LAS f32x4*)(T1 + r * 4); const float mx = fmaxf(fmaxf(t[0], t[1]), fmaxf(t[2], t[3])) * c2; float s = 0.f;
#pragma unroll
                for (int bj = 0; bj < 2; ++bj)
#pragma unroll
                    for (int n = 0; n < 2; ++n) { f32x4 x = acc[ai][bj][m][n];
#pragma unroll
                        for (int e = 0; e < 4; ++e) { x[e] = __builtin_amdgcn_exp2f(x[e] * c2 - mx); s += x[e]; }
                        acc[ai][bj][m][n] = x; }
                s += __shfl_xor(s, 16); s += __shfl_xor(s, 32);
                if (fq == 0) T2[r * 4 + wc] = s; }
        asm volatile("s_waitcnt lgkmcnt(0)" ::: "memory"); __builtin_amdgcn_s_barrier(); asm volatile("" ::: "memory");
        const int row0 = u.pm * BM + wr * 64 + fr, col0 = u.pn * BM + wc * 32 + 8 * fq;
#pragma unroll
        for (int ai = 0; ai < 2; ++ai)
#pragma unroll
            for (int m = 0; m < 4; ++m) { const int r = ai * HALF + wr * 64 + m * 16 + fr;
                const f32x4 t = *(const PG8_LAS f32x4*)(T2 + r * 4); const float inv = 1.0f / ((t[0] + t[1]) + (t[2] + t[3]));
                bf16_t* rowp = P + (size_t)(row0 + ai * HALF + m * 16) * ldc + col0;
#pragma unroll
                for (int bj = 0; bj < 2; ++bj) { const f32x4 v0 = acc[ai][bj][m][0] * inv, v1 = acc[ai][bj][m][1] * inv;
                    u32x4 w; w.x = cvt_pk_bf16(v0[0], v0[1]); w.y = cvt_pk_bf16(v0[2], v0[3]); w.z = cvt_pk_bf16(v1[0], v1[1]); w.w = cvt_pk_bf16(v1[2], v1[3]);
                    *(u32x4*)(rowp + bj * HALF) = w; } }
    }
};

struct GemmKV {
    const char* memb; const char* wk; const char* wv; int lda, ldb, K;
    __device__ __forceinline__ const char* a_ptr(const Unit& u) const { return ((u.pz >> 2) ? wv : memb) + (size_t)u.pm * (BM * 4096 * 2) + (size_t)(u.pz & 3) * 2048; }
    __device__ __forceinline__ const char* b_ptr(const Unit& u) const { return ((u.pz >> 2) ? memb : wk) + (size_t)u.pn * (BM * 4096 * 2) + (size_t)(u.pz & 3) * 2048; }
};
struct OrderKV {
    int G, c;
    __device__ __forceinline__ bool next(int i, Unit& u) const { const int L = i * G + c; if (L >= 256) return false; const int kind = L >> 7, idx = L & 127, tile = idx >> 2;
        u.pz = kind * 4 + (idx & 3); if (kind == 0) { u.pm = tile >> 4; u.pn = tile & 15; } else { u.pm = tile >> 1; u.pn = tile & 1; } return true; }
    __device__ __forceinline__ void a_ready(const Unit&) const {}
    __device__ __forceinline__ void done(const Unit&) const {}
};
struct EpiSlabKV {
    static constexpr bool PERM = false, AFTER_DRAIN = false;
    float* SK; float* SV;
    __device__ __forceinline__ void operator()(const f32x4 (&acc)[2][2][4][2], const Unit& u, int wr, int wc, int fr, int fq) const {
        const int kind = u.pz >> 2, ldc = kind ? 512 : 4096; float* C = (kind ? SV : SK) + (size_t)(u.pz & 3) * (512 * 4096);
        const int row0 = u.pm * BM + wr * 64 + fr, col0 = u.pn * BM + wc * 32 + 4 * fq;
#pragma unroll
        for (int ai = 0; ai < 2; ++ai)
#pragma unroll
            for (int m = 0; m < 4; ++m) { float* rowp = C + (size_t)(row0 + ai * HALF + m * 16) * ldc + col0;
#pragma unroll
                for (int bj = 0; bj < 2; ++bj)
#pragma unroll
                    for (int n = 0; n < 2; ++n) *(f32x4*)(rowp + bj * HALF + n * 16) = acc[ai][bj][m][n]; }
    }
};
struct EpiResidLN {
    static constexpr bool PERM = false, AFTER_DRAIN = false;
    float* T; const f32x2* stats; int gi;
    __device__ __forceinline__ void operator()(const f32x4 (&acc)[2][2][4][2], const Unit& u, int wr, int wc, int fr, int fq) const {
        constexpr int ldc = 4096; constexpr float alpha = 1.189207115002721f;
        const float* const __attribute__((address_space(4)))* inp = (const float* const __attribute__((address_space(4)))*)__builtin_amdgcn_kernarg_segment_ptr();
        const float* g = inp[gi]; const float* b = inp[gi + 1];
        const int row0 = u.pm * BM + wr * 64 + fr, col0 = u.pn * BM + wc * 32 + 4 * fq;
        f32x4 gv[2][2], bv[2][2];
#pragma unroll
        for (int bj = 0; bj < 2; ++bj)
#pragma unroll
            for (int n = 0; n < 2; ++n) { gv[bj][n] = *(const f32x4*)(g + col0 + bj * HALF + n * 16) * alpha; bv[bj][n] = *(const f32x4*)(b + col0 + bj * HALF + n * 16) * alpha; }
#pragma unroll
        for (int ai = 0; ai < 2; ++ai)
#pragma unroll
            for (int m = 0; m < 4; ++m) { const int row = row0 + ai * HALF + m * 16; const size_t off = (size_t)row * ldc + col0; const f32x2 st = stats[row];
#pragma unroll
                for (int bj = 0; bj < 2; ++bj)
#pragma unroll
                    for (int n = 0; n < 2; ++n) { const f32x4 r = *(const f32x4*)(T + off + bj * HALF + n * 16);
                        *(f32x4*)(T + off + bj * HALF + n * 16) = ((r - st.x) * st.y) * gv[bj][n] + bv[bj][n] + acc[ai][bj][m][n]; }
                asm volatile("" ::: "memory"); }
    }
};

template <class Epi, class Sched, bool ALIGN_EPI = false, bool SP2 = false, class GT = Gemm>
__device__ __forceinline__ void gemm_phase(PG8_LAS unsigned char* lds, const GT g, const Sched& S, const Epi& E) {
    const int tid = threadIdx.x, wid = __builtin_amdgcn_readfirstlane(tid >> 6), lane = tid & 63, wr = wid >> 2, wc = wid & 3, fr = lane & 15, fq = lane >> 4;
    const int K = g.K, nt = K / BK;
    unsigned voffA[2], voffB[2];
#pragma unroll
    for (int i = 0; i < 2; ++i) { int R, C; stage_rc(tid * 16 + i * 8192, R, C); const int Rb = Epi::PERM ? ((R & ~31) + perm32(R & 31)) : R;
        voffA[i] = (unsigned)(R * g.lda + C) * 2u; voffB[i] = (unsigned)(Rb * g.ldb + C) * 2u; }
    const size_t kstep = (size_t)(BK * 2);
    const size_t hA = (size_t)HALF * g.lda * 2, hB = (size_t)HALF * g.ldb * 2;
    const unsigned ldsw = (unsigned)wid * 1024u;
    const int aoff = lds_byte(wr * 64 + fr, fq * 8), boff = lds_byte(wc * 32 + fr, fq * 8);
#define PG8_SA(b, h) (((b) * 2 + (h)) * HTB)
#define PG8_SB(b, h) ((4 + (b) * 2 + (h)) * HTB)
#define PG8_STAGE(bufoff, gbase, voff) do { _Pragma("unroll") for (int _i = 0; _i < 2; ++_i) \
        __builtin_amdgcn_global_load_lds((const unsigned*)((const char*)(gbase) + (voff)[_i]), (PG8_LAS unsigned*)(lds + (bufoff) + ldsw + _i * 8192), 16, 0, 0); } while (0)
#define PG8_LDA(dst, b, h) do { _Pragma("unroll") for (int m = 0; m < 4; ++m) _Pragma("unroll") for (int k = 0; k < 2; ++k) dst[m][k] = *(const PG8_LAS bf16x8*)(lds + PG8_SA(b, h) + aoff + m * 2048 + k * 1024); } while (0)
#define PG8_LDB(dst, b, h) do { _Pragma("unroll") for (int n = 0; n < 2; ++n) _Pragma("unroll") for (int k = 0; k < 2; ++k) dst[n][k] = *(const PG8_LAS bf16x8*)(lds + PG8_SB(b, h) + boff + n * 2048 + k * 1024); } while (0)
#define PG8_MMA(ai, bj, At, Bt) do { __builtin_amdgcn_s_setprio(1); _Pragma("unroll") for (int m = 0; m < 4; ++m) _Pragma("unroll") for (int n = 0; n < 2; ++n) _Pragma("unroll") for (int k = 0; k < 2; ++k) \
        acc[ai][bj][m][n] = __builtin_amdgcn_mfma_f32_16x16x32_bf16(Bt[n][k], At[m][k], acc[ai][bj][m][n], 0, 0, 0); __builtin_amdgcn_s_setprio(0); } while (0)
#define PG8_WAIT_V(n) asm volatile("s_waitcnt vmcnt(" #n ")" ::: "memory")
#define PG8_WAIT_L(n) asm volatile("s_waitcnt lgkmcnt(" #n ")" ::: "memory")
#define PG8_BAR __builtin_amdgcn_s_barrier()
#define PG8_SCHED __builtin_amdgcn_sched_barrier(0)
    Unit cur, nxt; int ui = 0;
    if (!S.next(0, cur)) return;
    f32x4 acc[2][2][4][2];
#pragma unroll
    for (int a = 0; a < 2; ++a)
#pragma unroll
        for (int b = 0; b < 2; ++b)
#pragma unroll
            for (int m = 0; m < 4; ++m)
#pragma unroll
                for (int n = 0; n < 2; ++n) acc[a][b][m][n] = (f32x4){0.f, 0.f, 0.f, 0.f};
    bf16x8 At[4][2], B0[2][2], B1[2][2];
    const char* cA = g.a_ptr(cur); const char* cB = g.b_ptr(cur);
    S.a_ready(cur);
    if constexpr (SP2) {
        PG8_STAGE(PG8_SB(0, 0), cB, voffB); PG8_STAGE(PG8_SB(0, 1), cB + hB, voffB); PG8_STAGE(PG8_SA(0, 0), cA, voffA); PG8_STAGE(PG8_SA(0, 1), cA + hA, voffA);
        if (wr == 1) PG8_BAR;
        PG8_WAIT_V(2); PG8_BAR;
        PG8_STAGE(PG8_SB(1, 0), cB + kstep, voffB); PG8_STAGE(PG8_SA(1, 0), cA + kstep, voffA); PG8_STAGE(PG8_SB(1, 1), cB + hB + kstep, voffB);
        PG8_WAIT_V(6); PG8_BAR;
    } else {
        PG8_STAGE(PG8_SB(0, 0), cB, voffB); PG8_STAGE(PG8_SA(0, 0), cA, voffA); PG8_STAGE(PG8_SB(0, 1), cB + hB, voffB); PG8_STAGE(PG8_SA(0, 1), cA + hA, voffA);
        if (wr == 1) PG8_BAR;
        PG8_WAIT_V(4); PG8_BAR;
        PG8_STAGE(PG8_SB(1, 0), cB + kstep, voffB); PG8_STAGE(PG8_SA(1, 0), cA + kstep, voffA); PG8_STAGE(PG8_SB(1, 1), cB + hB + kstep, voffB);
        PG8_WAIT_V(6); PG8_BAR;
    }
    for (;;) {
        const bool has_next = S.next(ui + 1, nxt);
        const char* nA = has_next ? g.a_ptr(nxt) : cA; const char* nB = has_next ? g.b_ptr(nxt) : cB;
        for (int t = 0; t < nt; t += 2) {
            const bool last = (t == nt - 2);
            const char* a1 = cA + (size_t)(t + 1) * kstep;
            const char* a2 = last ? nA : cA + (size_t)(t + 2) * kstep; const char* b2 = last ? nB : cB + (size_t)(t + 2) * kstep;
            const char* a3 = a2 + kstep; const char* b3 = b2 + kstep;
            if (last && has_next) S.a_ready(nxt);
            if constexpr (SP2) {
            PG8_LDB(B0, 0, 0); PG8_LDB(B1, 0, 1); PG8_SCHED; PG8_LDA(At, 0, 0); PG8_STAGE(PG8_SA(1, 1), a1 + hA, voffA);
            PG8_WAIT_V(8); PG8_WAIT_L(0); PG8_BAR; PG8_MMA(0, 0, At, B0); PG8_MMA(0, 1, At, B1); PG8_BAR; PG8_SCHED;
            PG8_LDA(At, 0, 1); PG8_STAGE(PG8_SB(0, 0), b2, voffB); PG8_STAGE(PG8_SB(0, 1), b2 + hB, voffB); PG8_STAGE(PG8_SA(0, 0), a2, voffA);
            PG8_WAIT_V(8); PG8_WAIT_L(0); PG8_BAR; PG8_MMA(1, 0, At, B0); PG8_MMA(1, 1, At, B1); PG8_BAR; PG8_SCHED;
            PG8_LDB(B0, 1, 0); PG8_LDB(B1, 1, 1); PG8_SCHED; PG8_LDA(At, 1, 0); PG8_STAGE(PG8_SA(0, 1), a2 + hA, voffA);
            PG8_WAIT_V(8); PG8_WAIT_L(0); PG8_BAR; PG8_MMA(0, 0, At, B0); PG8_MMA(0, 1, At, B1); PG8_BAR; PG8_SCHED;
            PG8_LDA(At, 1, 1); PG8_STAGE(PG8_SB(1, 0), b3, voffB); PG8_STAGE(PG8_SB(1, 1), b3 + hB, voffB); PG8_STAGE(PG8_SA(1, 0), a3, voffA);
            PG8_WAIT_V(8); PG8_WAIT_L(0); PG8_BAR; PG8_MMA(1, 0, At, B0); PG8_MMA(1, 1, At, B1); PG8_BAR; PG8_SCHED;
            } else {
            PG8_LDB(B0, 0, 0); PG8_SCHED; PG8_LDA(At, 0, 0); PG8_STAGE(PG8_SA(1, 1), a1 + hA, voffA);
            PG8_WAIT_L(8); PG8_BAR; PG8_WAIT_L(0); PG8_MMA(0, 0, At, B0); PG8_BAR; PG8_SCHED;
            PG8_LDB(B1, 0, 1); PG8_STAGE(PG8_SB(0, 0), b2, voffB);
            PG8_BAR; PG8_WAIT_L(0); PG8_MMA(0, 1, At, B1); PG8_BAR;
            PG8_LDA(At, 0, 1); PG8_STAGE(PG8_SA(0, 0), a2, voffA);
            PG8_BAR; PG8_WAIT_L(0); PG8_MMA(1, 0, At, B0); PG8_BAR; PG8_SCHED;
            PG8_STAGE(PG8_SB(0, 1), b2 + hB, voffB);
            PG8_WAIT_V(6); PG8_BAR; PG8_MMA(1, 1, At, B1); PG8_BAR;
            PG8_LDB(B0, 1, 0); PG8_SCHED; PG8_LDA(At, 1, 0); PG8_STAGE(PG8_SA(0, 1), a2 + hA, voffA);
            PG8_WAIT_L(8); PG8_BAR; PG8_WAIT_L(0); PG8_MMA(0, 0, At, B0); PG8_BAR; PG8_SCHED;
            PG8_LDB(B1, 1, 1); PG8_STAGE(PG8_SB(1, 0), b3, voffB);
            PG8_BAR; PG8_WAIT_L(0); PG8_MMA(0, 1, At, B1); PG8_BAR;
            PG8_LDA(At, 1, 1); PG8_STAGE(PG8_SA(1, 0), a3, voffA);
            PG8_BAR; PG8_WAIT_L(0); PG8_MMA(1, 0, At, B0); PG8_BAR; PG8_SCHED;
            PG8_STAGE(PG8_SB(1, 1), b3 + hB, voffB);
            PG8_WAIT_V(6); PG8_BAR; PG8_MMA(1, 1, At, B1); PG8_BAR;
            }
        }
        if constexpr (ALIGN_EPI) { if (wr == 0) PG8_BAR; }
        if constexpr (!Epi::AFTER_DRAIN) { E(acc, cur, wr, wc, fr, fq); S.done(cur); }
        if (!has_next) break;
#pragma unroll
        for (int a = 0; a < 2; ++a)
#pragma unroll
            for (int b = 0; b < 2; ++b)
#pragma unroll
                for (int m = 0; m < 4; ++m)
#pragma unroll
                    for (int n = 0; n < 2; ++n) acc[a][b][m][n] = (f32x4){0.f, 0.f, 0.f, 0.f};
        cur = nxt; cA = nA; cB = nB; ++ui;
        if constexpr (ALIGN_EPI) { if (wr == 1) PG8_BAR; }
    }
    PG8_WAIT_V(0);
    if constexpr (!ALIGN_EPI) { if (wr == 0) PG8_BAR; }
    PG8_BAR;
    if constexpr (Epi::AFTER_DRAIN) { E.fused(acc, cur, wr, wc, fr, fq, lds, wid, lane); S.done(cur); }
#undef PG8_SA
#undef PG8_SB
#undef PG8_STAGE
#undef PG8_LDA
#undef PG8_LDB
#undef PG8_MMA
#undef PG8_WAIT_V
#undef PG8_WAIT_L
#undef PG8_BAR
#undef PG8_SCHED
}
}

namespace att {
using bf16_t = unsigned short;
using bf16x8 = __attribute__((ext_vector_type(8))) short;
using s16x4  = __attribute__((ext_vector_type(4))) short;
using f32x16 = __attribute__((ext_vector_type(16))) float;
using u32x4  = __attribute__((ext_vector_type(4))) unsigned;
using u32x2  = __attribute__((ext_vector_type(2))) unsigned;
constexpr int   D = 128, NW = 8, QBLK = 32, KVBLK = 64, NT = 4;
constexpr float SCALE = 0.088388347648318440f;
constexpr float THR = 8.f;
constexpr int   LDQ = 2048, LDK = 2048;
constexpr size_t SHM_V = KVBLK * D * 2, SHM_K = KVBLK * D * 2, SHM_ATTN = 2 * SHM_V + 2 * SHM_K;
#define KSWZ(row, colB) ((row) * 256 + ((colB) ^ (((row) & 7) << 4)))
#define SBAR() __builtin_amdgcn_sched_barrier(0)
__device__ __forceinline__ int crow(int r, int hi) { return (r & 3) + 8 * (r >> 2) + 4 * hi; }
__device__ __forceinline__ unsigned cvtpk(float lo, float hi) { unsigned r; asm volatile("v_cvt_pk_bf16_f32 %0, %1, %2" : "=v"(r) : "v"(lo), "v"(hi)); return r; }

__device__ __forceinline__ void partialSM(f32x16& p0, f32x16& p1, float& m_reg, float& mn, float& alpha) {
  constexpr float C = SCALE * 1.4426950408889634f;
  float pmax = p0[0];
#pragma unroll
  for (int r = 1; r < 16; ++r) pmax = fmaxf(pmax, p0[r]);
#pragma unroll
  for (int r = 0; r < 16; ++r) pmax = fmaxf(pmax, p1[r]);
  { auto rr = __builtin_amdgcn_permlane32_swap(__float_as_uint(pmax), __float_as_uint(pmax), false, false);
    pmax = fmaxf(__uint_as_float(rr[0]), __uint_as_float(rr[1])); }
  if (__builtin_expect(__all(pmax - m_reg <= THR / SCALE), 1)) { mn = m_reg; alpha = 1.f; }
  else { mn = fmaxf(m_reg, pmax); alpha = __builtin_amdgcn_exp2f((m_reg - mn) * C); m_reg = mn; }
  float mnC = -mn * C;
#pragma unroll
  for (int r = 0; r < 16; ++r) p0[r] = fmaf(p0[r], C, mnC);
#pragma unroll
  for (int r = 0; r < 16; ++r) p1[r] = fmaf(p1[r], C, mnC);
#pragma unroll
  for (int r = 0; r < 16; ++r) p0[r] = __builtin_amdgcn_exp2f(p0[r]);
}
__device__ __forceinline__ void finishSM(f32x16& p0, f32x16& p1, float alpha, float& l_reg, bf16x8& pa0, bf16x8& pa1, bf16x8& pa2, bf16x8& pa3) {
#pragma unroll
  for (int r = 0; r < 16; ++r) p1[r] = __builtin_amdgcn_exp2f(p1[r]);
  float ps = 0;
#pragma unroll
  for (int r = 0; r < 16; ++r) ps += p0[r];
#pragma unroll
  for (int r = 0; r < 16; ++r) ps += p1[r];
  { auto rr = __builtin_amdgcn_permlane32_swap(__float_as_uint(ps), __float_as_uint(ps), false, false);
    ps = __uint_as_float(rr[0]) + __uint_as_float(rr[1]); }
  l_reg = l_reg * alpha + ps;
#define PK4(P, BASE, OUT) do { unsigned a0 = cvtpk(P[BASE + 0], P[BASE + 1]), a1 = cvtpk(P[BASE + 2], P[BASE + 3]);   \
    unsigned b0 = cvtpk(P[BASE + 4], P[BASE + 5]), b1 = cvtpk(P[BASE + 6], P[BASE + 7]);                              \
    auto r0 = __builtin_amdgcn_permlane32_swap(a0, b0, false, false); auto r1 = __builtin_amdgcn_permlane32_swap(a1, b1, false, false); \
    u32x4 w = {r0[0], r1[0], r0[1], r1[1]}; OUT = *reinterpret_cast<bf16x8*>(&w); } while (0)
  PK4(p0, 0, pa0); PK4(p0, 8, pa1); PK4(p1, 0, pa2); PK4(p1, 8, pa3);
#undef PK4
}
__device__ __forceinline__ void qkt(f32x16& p0, f32x16& p1, const char* Ks, const bf16x8* qr, int r32, int hi) {
  p0 = f32x16{}; p1 = f32x16{};
#pragma unroll
  for (int d0 = 0; d0 < 8; ++d0) { int cb = (d0 * 16 + hi * 8) * 2;
    bf16x8 b0 = *reinterpret_cast<const bf16x8*>(Ks + KSWZ(r32, cb));
    bf16x8 b1 = *reinterpret_cast<const bf16x8*>(Ks + KSWZ(32 + r32, cb));
    p0 = __builtin_amdgcn_mfma_f32_32x32x16_bf16(b0, qr[d0], p0, 0, 0, 0);
    p1 = __builtin_amdgcn_mfma_f32_32x32x16_bf16(b1, qr[d0], p1, 0, 0, 0); }
}
__device__ __forceinline__ void cmask(f32x16& p0, f32x16& p1, int jt, int qloc, int hi) {
#pragma unroll
  for (int r = 0; r < 16; ++r) { const int key = 64 * jt + crow(r, hi); if (key > qloc) p0[r] = -1e30f; if (key + 32 > qloc) p1[r] = -1e30f; }
}
__device__ __forceinline__ int v_st(int k, int c) { const int kk = (k & ~0xC) | ((k & 4) << 1) | ((k & 8) >> 1); return ((kk >> 3) * 4 + (c >> 5)) * 512 + ((kk & 7) * 32 + (c & 31)) * 2; }
__device__ __forceinline__ int v_rd_base(int lane) { return ((lane & 3) << 3) | (((lane >> 2) & 3) << 6) | (((lane >> 4) & 1) << 5) | (((lane >> 5) & 1) << 8); }
constexpr int v_rd_off(int d0, int ks, int half) { return d0 * 512 + ks * 4096 + half * 2048; }
template <int OFF> __device__ __forceinline__ s16x4 tr_read(int vb) {
  s16x4 r; asm volatile("ds_read_b64_tr_b16 %0, %1 offset:%2" : "=&v"(r) : "v"(vb), "i"(OFF) : "memory"); return r;
}
template <int D0> __device__ __forceinline__ void pv_one(f32x16& od, int vb, bf16x8 pa0, bf16x8 pa1, bf16x8 pa2, bf16x8 pa3) {
  const s16x4 l0 = tr_read<v_rd_off(D0, 0, 0)>(vb), h0 = tr_read<v_rd_off(D0, 0, 1)>(vb), l1 = tr_read<v_rd_off(D0, 1, 0)>(vb), h1 = tr_read<v_rd_off(D0, 1, 1)>(vb);
  const s16x4 l2 = tr_read<v_rd_off(D0, 2, 0)>(vb), h2 = tr_read<v_rd_off(D0, 2, 1)>(vb), l3 = tr_read<v_rd_off(D0, 3, 0)>(vb), h3 = tr_read<v_rd_off(D0, 3, 1)>(vb);
  asm volatile("s_waitcnt lgkmcnt(0)" ::: "memory"); SBAR();
#define PK(L, H) (bf16x8){L[0], L[1], L[2], L[3], H[0], H[1], H[2], H[3]}
  od = __builtin_amdgcn_mfma_f32_32x32x16_bf16(PK(l0, h0), pa0, od, 0, 0, 0);
  od = __builtin_amdgcn_mfma_f32_32x32x16_bf16(PK(l1, h1), pa1, od, 0, 0, 0);
  od = __builtin_amdgcn_mfma_f32_32x32x16_bf16(PK(l2, h2), pa2, od, 0, 0, 0);
  od = __builtin_amdgcn_mfma_f32_32x32x16_bf16(PK(l3, h3), pa3, od, 0, 0, 0);
#undef PK
}
__device__ __forceinline__ void pv_d0(f32x16* o, int vb, bf16x8 pa0, bf16x8 pa1, bf16x8 pa2, bf16x8 pa3) {
  pv_one<0>(o[0], vb, pa0, pa1, pa2, pa3); pv_one<1>(o[1], vb, pa0, pa1, pa2, pa3); pv_one<2>(o[2], vb, pa0, pa1, pa2, pa3); pv_one<3>(o[3], vb, pa0, pa1, pa2, pa3);
}

__device__ __forceinline__ void attn_item(const bf16_t* __restrict__ Qrow, const bf16_t* __restrict__ Kh, const bf16_t* __restrict__ Vh, bool causal, int qloc,
                                          bf16_t* Orow, float2* MLrow, bool valid, char* lds) {
  const int tid = threadIdx.x, lane = tid & 63, r32 = lane & 31, hi = lane >> 5;
  char* V_lds = lds; char* K_lds = lds + 2 * SHM_V;
  float m_reg = -1e30f, l_reg = 0; f32x16 o[4] = {}; bf16x8 qr[8];
  const bf16_t* Qw = Qrow + hi * 8;
#pragma unroll
  for (int d0 = 0; d0 < 8; ++d0) qr[d0] = *reinterpret_cast<const bf16x8*>(Qw + d0 * 16);
  const int sr = tid >> 4, sc = (tid & 15) * 8, vst0 = v_st(sr, sc), vst1 = v_st(32 + sr, sc);
  const int vb0 = (int)(uintptr_t)V_lds + v_rd_base(lane);
  struct { bf16x8 vs0, vs1, ks0, ks1; } sr_[2];
#define SLOAD(i, k0) do { sr_[i].vs0 = *reinterpret_cast<const bf16x8*>(&Vh[(long)((k0) + sr) * LDK + sc]); sr_[i].vs1 = *reinterpret_cast<const bf16x8*>(&Vh[(long)((k0) + 32 + sr) * LDK + sc]); \
    sr_[i].ks0 = *reinterpret_cast<const bf16x8*>(&Kh[(long)((k0) + sr) * LDK + sc]); sr_[i].ks1 = *reinterpret_cast<const bf16x8*>(&Kh[(long)((k0) + 32 + sr) * LDK + sc]); } while (0)
#define SWRITE(b, i) do { *(bf16x8*)(V_lds + (b) * SHM_V + vst0) = sr_[i].vs0;          \
    *(bf16x8*)(V_lds + (b) * SHM_V + vst1) = sr_[i].vs1; int kc = sc * 2;               \
    *(bf16x8*)(K_lds + (b) * SHM_K + KSWZ(sr, kc)) = sr_[i].ks0;                       \
    *(bf16x8*)(K_lds + (b) * SHM_K + KSWZ(32 + sr, kc)) = sr_[i].ks1; } while (0)
#define SWAIT() asm volatile("s_waitcnt vmcnt(4)" ::: "memory")
#define RESC(a) do { if (__any((a) < 1.f)) { _Pragma("unroll") for (int d = 0; d < 4; ++d) _Pragma("unroll") for (int r = 0; r < 16; ++r) o[d][r] *= (a); } } while (0)
  f32x16 pA0, pA1, pB0, pB1; float mnA, mnB, alA, alB; bf16x8 pa0, pa1, pa2, pa3;
  constexpr int SE = 0, SO = 1;
  SLOAD(SE, 0); asm volatile("s_waitcnt vmcnt(0)" ::: "memory"); SWRITE(0, SE); __syncthreads();
  qkt(pA0, pA1, K_lds, qr, r32, hi); if (causal) cmask(pA0, pA1, 0, qloc, hi); partialSM(pA0, pA1, m_reg, mnA, alA);
  SLOAD(SO, KVBLK); SLOAD(SE, 2 * KVBLK);
  SWAIT(); SWRITE(1, SO); __syncthreads();
  {
    SBAR(); qkt(pB0, pB1, K_lds + SHM_K, qr, r32, hi); if (causal) cmask(pB0, pB1, 1, qloc, hi);
    finishSM(pA0, pA1, alA, l_reg, pa0, pa1, pa2, pa3); SBAR();
    SLOAD(SO, 3 * KVBLK); SBAR();
    pv_d0(o, vb0, pa0, pa1, pa2, pa3); partialSM(pB0, pB1, m_reg, mnB, alB);
    __syncthreads(); SWAIT(); SWRITE(0, SE);
    RESC(alB); __syncthreads();
    SBAR(); qkt(pA0, pA1, K_lds, qr, r32, hi); if (causal) cmask(pA0, pA1, 2, qloc, hi);
    finishSM(pB0, pB1, alB, l_reg, pa0, pa1, pa2, pa3); SBAR();
    pv_d0(o, vb0 + (int)SHM_V, pa0, pa1, pa2, pa3); partialSM(pA0, pA1, m_reg, mnA, alA);
    __syncthreads(); asm volatile("s_waitcnt vmcnt(0)" ::: "memory"); SWRITE(1, SO);
    RESC(alA); __syncthreads();
  }
  SBAR(); qkt(pB0, pB1, K_lds + SHM_K, qr, r32, hi); if (causal) cmask(pB0, pB1, 3, qloc, hi);
  finishSM(pA0, pA1, alA, l_reg, pa0, pa1, pa2, pa3); SBAR();
  pv_d0(o, vb0, pa0, pa1, pa2, pa3); partialSM(pB0, pB1, m_reg, mnB, alB);
  __syncthreads(); RESC(alB);
  finishSM(pB0, pB1, alB, l_reg, pa0, pa1, pa2, pa3); SBAR();
  pv_d0(o, vb0 + (int)SHM_V, pa0, pa1, pa2, pa3);
  const float rl = 1.0f / l_reg;
  if (valid) {
#pragma unroll
    for (int d0 = 0; d0 < 4; ++d0)
#pragma unroll
      for (int g = 0; g < 4; ++g) { u32x2 w; w.x = cvtpk(o[d0][4 * g] * rl, o[d0][4 * g + 1] * rl); w.y = cvtpk(o[d0][4 * g + 2] * rl, o[d0][4 * g + 3] * rl);
        *reinterpret_cast<u32x2*>(Orow + 32 * d0 + 8 * g + 4 * hi) = w; }
    if (hi == 0) *MLrow = make_float2(m_reg, l_reg);
  }
#undef SLOAD
#undef SWRITE
#undef SWAIT
#undef RESC
}
#undef KSWZ
#undef SBAR
}

constexpr int NWAVES = 8;
#ifndef MK_N_LAUNCHES
#define MK_N_LAUNCHES 1
#endif
constexpr int N_PHASES = 16;
constexpr int N_LAUNCHES = MK_N_LAUNCHES;

constexpr int BATCH = 2, SEQ = 8192, DM = 4096, M = BATCH * SEQ, MEMLEN = 256;
constexpr int PW = 2048, AW = 2048, NH = 16, HD = 128, NBLK = 32, MIXIN = 8192, FF = 11008, XH = 4, XHD = 1024;
constexpr float LN_EPS = 1e-5f;
constexpr float DN_ALPHA = 1.189207115002721f;

constexpr size_t MiB = 1u << 20;
constexpr size_t WS_CTL = 0, CTL_ZERO_BYTES = 1 * MiB;
constexpr size_t WS_ROPE = 1 * MiB;
constexpr size_t WS_KMH = 5 * MiB, WS_KML = 5 * MiB + 512 * 1024;
constexpr size_t WS_MEMB = 6 * MiB;
constexpr size_t WS_KX = 10 * MiB;
constexpr size_t WS_VT = 14 * MiB;
constexpr size_t WS_LIST = 18 * MiB;
constexpr size_t WS_ML = 26 * MiB;
constexpr size_t WS_WIN = 34 * MiB, WS_WPOOL = 98 * MiB, WS_WOUT = 100 * MiB, WS_WXQ = 132 * MiB, WS_WXKV = 164 * MiB, WS_WXO = 228 * MiB, WS_WGU = 260 * MiB, WS_WDN = 432 * MiB;
constexpr size_t WS_ACT = 518 * MiB;
constexpr size_t WS_HP = WS_ACT, WS_Q = WS_ACT + 64 * MiB, WS_K = WS_ACT + 128 * MiB, WS_V = WS_ACT + 192 * MiB;
constexpr size_t WS_XB = WS_ACT + 256 * MiB;
constexpr size_t WS_PM = WS_ACT + 256 * MiB;
constexpr size_t WS_PARTO = WS_ACT + 256 * MiB;
constexpr size_t WS_CAT = WS_ACT + 512 * MiB;
constexpr size_t WS_HB = WS_ACT;
constexpr size_t WS_QX = WS_ACT + 128 * MiB;
constexpr size_t WS_PB = WS_ACT + 256 * MiB;
constexpr size_t WS_OX = WS_ACT + 288 * MiB;
constexpr size_t WS_G = WS_ACT + 128 * MiB;
constexpr size_t WS_SLAB = WS_ACT + 640 * MiB;
constexpr size_t WS_STATS = WS_ML;
constexpr size_t WS_END = WS_ACT + 704 * MiB;
static_assert(WS_WDN + (size_t)DM * FF * 2 <= WS_ACT && WS_G + (size_t)M * FF * 2 <= WS_END && WS_WGU + (size_t)2 * FF * DM * 2 <= WS_WDN, "d_ws map");
constexpr int LIST_STRIDE = 256 * 496;
__host__ __device__ constexpr int list_off(int j) { return 256 * (31 * j - (j * (j - 1)) / 2); }
constexpr int CW_TMO = 0, CW_CODE = 1;
constexpr int CW_BAR = 4096;
constexpr int CW_GCNT = 8192;
constexpr int CW_CHK = 16384;

constexpr int RING_OFF = 0, RING_BYTES = 131072;
constexpr int LDSCTL_OFF = RING_BYTES, MISC_OFF = LDSCTL_OFF + 320;
constexpr int LDS_BYTES = 147456;

#define GAS __attribute__((address_space(1)))
#define LAS __attribute__((address_space(3)))
typedef unsigned short bf16;
typedef unsigned v4u __attribute__((ext_vector_type(4)));
typedef unsigned v2u __attribute__((ext_vector_type(2)));
typedef float f32x4 __attribute__((ext_vector_type(4)));
typedef short bf16x8 __attribute__((ext_vector_type(8)));
typedef float f32x16 __attribute__((ext_vector_type(16)));
typedef GAS unsigned gu32;
#define RLX_AGENT __ATOMIC_RELAXED, __HIP_MEMORY_SCOPE_AGENT
#define LDS_WAIT() asm volatile("s_waitcnt lgkmcnt(0)" ::: "memory")
#define VM_WAIT() asm volatile("s_waitcnt vmcnt(0)" ::: "memory")
__device__ __forceinline__ unsigned f2bf(float f) { unsigned u = __builtin_bit_cast(unsigned, f); return (u + 0x7fffu + ((u >> 16) & 1u)) >> 16; }
__device__ __forceinline__ unsigned pk2(float lo, float hi) { return f2bf(lo) | (f2bf(hi) << 16); }
__device__ __forceinline__ float bf_lo(unsigned w) { return __builtin_bit_cast(float, w << 16); }
__device__ __forceinline__ float bf_hi(unsigned w) { return __builtin_bit_cast(float, w & 0xffff0000u); }
__device__ __forceinline__ float bf2f(bf16 b) { return __builtin_bit_cast(float, ((unsigned)b) << 16); }
#define XB_TMO      128
#define XB_XCNT(j)  (256  + 64 * (j))
#define XB_XSUB(j)  (1280 + 64 * (j))
#define XB_XGEN(j)  (2304 + 64 * (j))
#define XB_TOP      3328
#define XB_TOPGEN   3392
#define XCD_BAR_WORDS 3456
#define XB_SPIN_CAP (1u << 18)

__device__ __forceinline__ unsigned xb_ld(unsigned* p)              { return __hip_atomic_load(p, __ATOMIC_RELAXED, __HIP_MEMORY_SCOPE_AGENT); }
__device__ __forceinline__ unsigned xb_add(unsigned* p, unsigned v) { return __hip_atomic_fetch_add(p, v, __ATOMIC_RELAXED, __HIP_MEMORY_SCOPE_AGENT); }
__device__ __forceinline__ unsigned xb_xcc_id() { return (unsigned)__builtin_amdgcn_s_getreg((3 << 11) | 20) & 0xFu; }
#define XB_SPIN(cond, bar) do { unsigned _sp = 0; while (cond) { __builtin_amdgcn_s_sleep(1); \
    if ((++_sp & 255u) == 0u) { if (xb_ld(&(bar)[XB_TMO])) break; if (_sp > XB_SPIN_CAP) { atomicAdd(&(bar)[XB_TMO], 1u); break; } } } } while (0)

struct XcdBarrier {
    unsigned* bar; unsigned x;
    volatile LAS unsigned* st;
};

__device__ __forceinline__ XcdBarrier xcd_barrier_post(unsigned* bar, volatile LAS unsigned* st) {
    XcdBarrier b; b.bar = bar; b.x = xb_xcc_id(); b.st = st;
    if (threadIdx.x == 0) (void)xb_add(&bar[XB_XCNT(b.x)], 1u);
    return b;
}
__device__ __forceinline__ void xcd_barrier_complete(unsigned* bar, unsigned x, unsigned& nloc, unsigned& nx) {
    const unsigned G = gridDim.x * gridDim.y * gridDim.z;
    unsigned sum, cnt, mine, sp = 0u;
    for (;;) {
        sum = 0u; cnt = 0u; mine = 0u;
#pragma unroll
        for (unsigned j = 0; j < 16; ++j) { const unsigned c = xb_ld(&bar[XB_XCNT(j)]); sum += c; cnt += (c > 0u) ? 1u : 0u; mine = (j == x) ? c : mine; }
        if (sum == G) break;
        __builtin_amdgcn_s_sleep(1);
        if ((++sp & 255u) == 0u) { if (xb_ld(&bar[XB_TMO])) break; if (sp > XB_SPIN_CAP) { atomicAdd(&bar[XB_TMO], 1u); break; } }
    }
    nloc = mine > 0u ? mine : 1u; nx = cnt > 0u ? cnt : 1u;
}

__device__ __forceinline__ void xcd_barrier(const XcdBarrier& b) {
    asm volatile("s_waitcnt vmcnt(0)" ::: "memory");
    __syncthreads();
    if (threadIdx.x == 0) {
        unsigned* bar = b.bar;
        __builtin_amdgcn_s_waitcnt(0);
        unsigned nloc = b.st[0], nx = b.st[1];
        if (nloc == 0u) { xcd_barrier_complete(bar, b.x, nloc, nx); b.st[0] = nloc; b.st[1] = nx; }
        const unsigned old = xb_add(&bar[XB_XSUB(b.x)], 1u);
        const unsigned gen = old / nloc;
        if (old + 1u == (gen + 1u) * nloc) {
            __builtin_amdgcn_fence(__ATOMIC_RELEASE, "agent");
            asm volatile("s_waitcnt vmcnt(0)" ::: "memory");
            const unsigned og = xb_add(&bar[XB_TOP], 1u);
            const unsigned tg = og / nx;
            if (og + 1u == (tg + 1u) * nx) xb_add(&bar[XB_TOPGEN], 1u);
            else XB_SPIN(xb_ld(&bar[XB_TOPGEN]) == tg, bar);
            __builtin_amdgcn_fence(__ATOMIC_ACQUIRE, "agent");
            xb_add(&bar[XB_XGEN(b.x)], 1u);
            asm volatile("s_waitcnt vmcnt(0)" ::: "memory");
        } else {
            XB_SPIN(xb_ld(&bar[XB_XGEN(b.x)]) == gen, bar);
            __builtin_amdgcn_fence(__ATOMIC_ACQUIRE, "agent");
            asm volatile("s_waitcnt vmcnt(0)" ::: "memory");
        }
    }
    __syncthreads();
}

struct Frame {
    LAS unsigned char* lds;
    volatile LAS unsigned* MISC;
    gu32* ctl;
    int tid, lane, wave;
    int G;
    unsigned char* ws;
};
__device__ __forceinline__ float wave_sum(float v) {
#pragma unroll
    for (int o = 1; o < 64; o <<= 1) v += __shfl_xor(v, o);
    return v;
}

template <class RowMap>
__device__ __forceinline__ void p0_transpose_item(const float* W, int K, int N, bf16* WT, LAS float* scr, int item, int lane, const RowMap& rm, const float* colscale) {
    const int nblk = N / 32, kb = item / nblk, nb = item % nblk, k0 = 64 * kb, n0 = 32 * nb;
    float ld[32];
    const float* src = W + (size_t)(k0 + (lane >> 5)) * N + n0 + (lane & 31);
#pragma unroll
    for (int i = 0; i < 32; ++i) ld[i] = *(const GAS float*)(src + (size_t)(2 * i) * N);
#pragma unroll
    for (int i = 0; i < 32; ++i) scr[(2 * i + (lane >> 5)) * 33 + (lane & 31)] = ld[i];
    LDS_WAIT(); asm volatile("" ::: "memory");
    const int c = lane & 7;
#pragma unroll
    for (int j = 0; j < 4; ++j) { const int n = (lane >> 3) + 8 * j; const LAS float* s = scr + (8 * c) * 33 + n; const float sc = colscale ? colscale[n0 + n] : 1.0f;
        v4u o; o.x = pk2(s[0 * 33] * sc, s[1 * 33] * sc); o.y = pk2(s[2 * 33] * sc, s[3 * 33] * sc); o.z = pk2(s[4 * 33] * sc, s[5 * 33] * sc); o.w = pk2(s[6 * 33] * sc, s[7 * 33] * sc);
        *(GAS v4u*)(WT + (size_t)rm(n0 + n) * K + k0 + 8 * c) = o; }
    LDS_WAIT(); asm volatile("" ::: "memory");
}
struct RmIdent { int off; __device__ __forceinline__ int operator()(int n) const { return off + n; } };
struct RmMixIn { __device__ __forceinline__ int operator()(int n) const { if (n < 2048 || n >= 6144) return n; const int d = n & 127; return (n & ~127) + 2 * (d & 63) + (d >> 6); } };
struct RmGateUp { int up; __device__ __forceinline__ int operator()(int n) const { return (n >> 7) * 256 + up * 128 + (n & 127); } };

__device__ __forceinline__ void sincos_d(double a, double& s, double& c) {
    const double n = __builtin_rint(a * 0.63661977236758134308);
    double r = __builtin_fma(-n, 1.5707963267948966, a); r = __builtin_fma(-n, 6.123233995736766e-17, r);
    const double r2 = r * r;
    double ps = -7.6471637318198164759e-13; ps = ps * r2 + 1.6059043836821614599e-10; ps = ps * r2 - 2.5052108385441718775e-08; ps = ps * r2 + 2.7557319223985890653e-06;
    ps = ps * r2 - 1.9841269841269841270e-04; ps = ps * r2 + 8.3333333333333333333e-03; ps = ps * r2 - 1.6666666666666666667e-01; ps = r + r * r2 * ps;
    double pc = 4.7794773323873852974e-14; pc = pc * r2 - 1.1470745597729724714e-11; pc = pc * r2 + 2.0876756987868098979e-09; pc = pc * r2 - 2.7557319223985890653e-07;
    pc = pc * r2 + 2.4801587301587301587e-05; pc = pc * r2 - 1.3888888888888888889e-03; pc = pc * r2 + 4.1666666666666666667e-02; pc = pc * r2 - 0.5; pc = 1.0 + r2 * pc;
    const int q = ((int)n) & 3;
    s = (q == 0) ? ps : (q == 1) ? pc : (q == 2) ? -ps : -pc;
    c = (q == 0) ? pc : (q == 1) ? -ps : (q == 2) ? -pc : ps;
}
__device__ __forceinline__ float rope_inv(int i) {
    const double y = -(double)i * (13.287712379549449 / 64.0); const double fl = __builtin_floor(y); const double z = (y - fl) * 0.69314718055994530942;
    double e = 1.0, term = 1.0;
#pragma unroll
    for (int k = 1; k <= 20; ++k) { term = term * z / (double)k; e += term; }
    return (float)__builtin_ldexp(e, (int)fl);
}

__device__ __forceinline__ void p0_prologue(Frame& F, const float* const* in) {
    LAS float* scr = (LAS float*)(F.lds + RING_OFF + F.wave * 16384);
    const int gw = blockIdx.x * NWAVES + F.wave, NGW = F.G * NWAVES;
    const float* w_mix_in = in[2]; const float* w_pool = in[3]; const float* pool_scale = in[4]; const float* w_mix_out = in[5];
    const float* w_xq = in[8]; const float* w_xkv = in[9]; const float* w_xo = in[10]; const float* w_gate = in[13]; const float* w_up = in[14]; const float* w_down = in[15];
    bf16* WIN = (bf16*)(F.ws + WS_WIN); bf16* WPOOL = (bf16*)(F.ws + WS_WPOOL); bf16* WOUT = (bf16*)(F.ws + WS_WOUT); bf16* WXQ = (bf16*)(F.ws + WS_WXQ);
    bf16* WXKV = (bf16*)(F.ws + WS_WXKV); bf16* WXO = (bf16*)(F.ws + WS_WXO); bf16* WGU = (bf16*)(F.ws + WS_WGU); bf16* WDN = (bf16*)(F.ws + WS_WDN);
    constexpr int I_IN = (DM / 64) * (MIXIN / 32), I_POOL = (512 / 64) * (512 / 32), I_SQ = (DM / 64) * (DM / 32), I_KV = (DM / 64) * (2 * DM / 32), I_GU = (DM / 64) * (FF / 32), I_DN = (FF / 64) * (DM / 32);
    constexpr int NITEMS = I_IN + 4 * I_POOL + 3 * I_SQ + I_KV + 2 * I_GU + I_DN;
    for (int it = gw; it < NITEMS; it += NGW) {
        int r = it;
        if (r < I_IN) { p0_transpose_item(w_mix_in, DM, MIXIN, WIN, scr, r, F.lane, RmMixIn{}, nullptr); continue; } r -= I_IN;
        if (r < 4 * I_POOL) { const int g = r / I_POOL; p0_transpose_item(w_pool + (size_t)g * 512 * 512, 512, 512, WPOOL, scr, r % I_POOL, F.lane, RmIdent{g * 512}, pool_scale + g * 512); continue; } r -= 4 * I_POOL;
        if (r < I_SQ) { p0_transpose_item(w_mix_out, DM, DM, WOUT, scr, r, F.lane, RmIdent{0}, nullptr); continue; } r -= I_SQ;
        if (r < I_SQ) { p0_transpose_item(w_xq, DM, DM, WXQ, scr, r, F.lane, RmIdent{0}, nullptr); continue; } r -= I_SQ;
        if (r < I_KV) { p0_transpose_item(w_xkv, DM, 2 * DM, WXKV, scr, r, F.lane, RmIdent{0}, nullptr); continue; } r -= I_KV;
        if (r < I_SQ) { p0_transpose_item(w_xo, DM, DM, WXO, scr, r, F.lane, RmIdent{0}, nullptr); continue; } r -= I_SQ;
        if (r < I_GU) { p0_transpose_item(w_gate, DM, FF, WGU, scr, r, F.lane, RmGateUp{0}, nullptr); continue; } r -= I_GU;
        if (r < I_GU) { p0_transpose_item(w_up, DM, FF, WGU, scr, r, F.lane, RmGateUp{1}, nullptr); continue; } r -= I_GU;
        p0_transpose_item(w_down, FF, DM, WDN, scr, r, F.lane, RmIdent{0}, nullptr);
    }
    const size_t gt = (size_t)blockIdx.x * (NWAVES * 64) + F.tid, NT = (size_t)F.G * NWAVES * 64;
    { const float* x = in[0]; bf16* XB = (bf16*)(F.ws + WS_XB);
      for (size_t i = gt; i < (size_t)M * DM / 8; i += NT) { const f32x4 a = *(const GAS f32x4*)(x + i * 8), b = *(const GAS f32x4*)(x + i * 8 + 4);
          v4u o; o.x = pk2(a.x, a.y); o.y = pk2(a.z, a.w); o.z = pk2(b.x, b.y); o.w = pk2(b.z, b.w); *(GAS v4u*)(XB + i * 8) = o; } }
    { const float* x = in[1]; bf16* XB = (bf16*)(F.ws + WS_MEMB);
      for (size_t i = gt; i < (size_t)BATCH * MEMLEN * DM / 8; i += NT) { const f32x4 a = *(const GAS f32x4*)(x + i * 8), b = *(const GAS f32x4*)(x + i * 8 + 4);
          v4u o; o.x = pk2(a.x, a.y); o.y = pk2(a.z, a.w); o.z = pk2(b.x, b.y); o.w = pk2(b.z, b.w); *(GAS v4u*)(XB + i * 8) = o; } }
    { float2* tab = (float2*)(F.ws + WS_ROPE);
      for (size_t i = gt; i < (size_t)SEQ * 64; i += NT) { const int pos = (int)(i >> 6), fi = (int)(i & 63); const float ang = (float)pos * rope_inv(fi);
          double s, c; sincos_d((double)ang, s, c); tab[i] = make_float2((float)c, (float)s); } }
}

template <bool WRITE_F32>
__device__ __forceinline__ void ln_rows(Frame& F, float* X, bf16* XB, float2* stats, const float* g, const float* b) {
    const int gw = blockIdx.x * NWAVES + F.wave, NGW = F.G * NWAVES;
    for (int m = gw; m < M; m += NGW) {
        GAS f32x4* xr = (GAS f32x4*)(X + (size_t)m * DM) + F.lane;
        f32x4 v[16]; float s = 0.f;
#pragma unroll
        for (int j = 0; j < 16; ++j) { v[j] = xr[64 * j]; s += (v[j].x + v[j].y) + (v[j].z + v[j].w); }
        const float mean = wave_sum(s) * (1.f / DM); float s2 = 0.f;
#pragma unroll
        for (int j = 0; j < 16; ++j) { v[j] = v[j] - mean; s2 += (v[j].x * v[j].x + v[j].y * v[j].y) + (v[j].z * v[j].z + v[j].w * v[j].w); }
        const float rstd = 1.f / sqrtf(wave_sum(s2) * (1.f / DM) + LN_EPS);
        if (stats && F.lane == 0) stats[m] = make_float2(mean, rstd);
#pragma unroll
        for (int j = 0; j < 16; ++j) { const f32x4 gg = ((const GAS f32x4*)g)[64 * j + F.lane], bb = ((const GAS f32x4*)b)[64 * j + F.lane];
            const f32x4 y = (v[j] * rstd) * gg + bb; if (WRITE_F32) xr[64 * j] = y;
            if (XB) { v2u o; o.x = pk2(y.x, y.y); o.y = pk2(y.z, y.w); ((GAS v2u*)(XB + (size_t)m * DM))[64 * j + F.lane] = o; } }
    }
}

__device__ __forceinline__ void up8(const v4u& r, float (&f)[8]) { f[0] = bf_lo(r.x); f[1] = bf_hi(r.x); f[2] = bf_lo(r.y); f[3] = bf_hi(r.y); f[4] = bf_lo(r.z); f[5] = bf_hi(r.z); f[6] = bf_lo(r.w); f[7] = bf_hi(r.w); }
template <int W>
__device__ __forceinline__ void pool_run(const bf16* HP, bf16* PMo, int t0, int c) {
    const int tp0 = t0 & (SEQ - 1);
    v4u raw[16 + W - 1];
#pragma unroll
    for (int j = 0; j < 16 + W - 1; ++j) { const int dt = j - (W - 1); raw[j] = (v4u){0u, 0u, 0u, 0u}; if (tp0 + dt >= 0) raw[j] = *(const GAS v4u*)(HP + (size_t)(t0 + dt) * PW + c); }
    float S[8], u[8];
#pragma unroll
    for (int e = 0; e < 8; ++e) S[e] = 0.f;
#pragma unroll
    for (int j = 0; j < W - 1; ++j) { up8(raw[j], u);
#pragma unroll
        for (int e = 0; e < 8; ++e) S[e] += u[e]; }
#pragma unroll
    for (int i = 0; i < 16; ++i) {
        up8(raw[W - 1 + i], u);
#pragma unroll
        for (int e = 0; e < 8; ++e) S[e] += u[e];
        const int tp = tp0 + i; const float inv = (tp + 1 < W) ? 1.0f / (float)(tp + 1) : 1.0f / (float)W;
        v4u o; o.x = pk2(S[0] * inv - u[0], S[1] * inv - u[1]); o.y = pk2(S[2] * inv - u[2], S[3] * inv - u[3]);
        o.z = pk2(S[4] * inv - u[4], S[5] * inv - u[5]); o.w = pk2(S[6] * inv - u[6], S[7] * inv - u[7]);
        *(GAS v4u*)(PMo + (size_t)(t0 + i) * PW + c) = o;
        float d[8]; up8(raw[i], d);
#pragma unroll
        for (int e = 0; e < 8; ++e) S[e] -= d[e];
    }
}
__device__ __forceinline__ void pool_ew(Frame& F) {
    const bf16* HP = (const bf16*)(F.ws + WS_HP); bf16* PMo = (bf16*)(F.ws + WS_PM);
    const size_t gt = (size_t)blockIdx.x * (NWAVES * 64) + F.tid, NT = (size_t)F.G * NWAVES * 64;
    for (size_t idx = gt; idx < (size_t)(M / 16) * 256; idx += NT) {
        const int t0 = (int)(idx >> 8) * 16, c = (int)(idx & 255) * 8, grp = __builtin_amdgcn_readfirstlane(c >> 9);
        if (grp == 0) pool_run<2>(HP, PMo, t0, c); else if (grp == 1) pool_run<4>(HP, PMo, t0, c); else if (grp == 2) pool_run<8>(HP, PMo, t0, c); else pool_run<16>(HP, PMo, t0, c);
    }
}
__device__ __forceinline__ void kv_reduce(Frame& F) {
    const float* SK = (const float*)(F.ws + WS_SLAB); bf16* KX = (bf16*)(F.ws + WS_KX);
    const size_t gt = (size_t)blockIdx.x * (NWAVES * 64) + F.tid, NT = (size_t)F.G * NWAVES * 64, NE = (size_t)512 * 4096;
    for (size_t i = gt; i < 2 * NE / 4; i += NT) { const size_t kind = (i * 4) / NE, e = (i * 4) % NE; const float* sb = SK + kind * 4 * NE + e;
        const f32x4 a = *(const GAS f32x4*)sb + *(const GAS f32x4*)(sb + NE) + *(const GAS f32x4*)(sb + 2 * NE) + *(const GAS f32x4*)(sb + 3 * NE);
        v2u o; o.x = pk2(a.x, a.y); o.y = pk2(a.z, a.w); *(GAS v2u*)(KX + kind * NE + e) = o; }
}

__device__ __forceinline__ void kmean_phase(Frame& F) {
    const bf16* Kb = (const bf16*)(F.ws + WS_K); bf16* KMH = (bf16*)(F.ws + WS_KMH); bf16* KML = (bf16*)(F.ws + WS_KML);
    LAS float* part = (LAS float*)(F.lds + RING_OFF);
    for (int item = blockIdx.x; item < 64 * 4; item += F.G) {
        const int bn = item >> 2, chunk = item & 3;
        float acc[8];
#pragma unroll
        for (int e = 0; e < 8; ++e) acc[e] = 0.f;
        const bf16* base = Kb + (size_t)(bn * 256 + F.wave * 32) * AW + chunk * 512 + F.lane * 8;
#pragma unroll
        for (int r = 0; r < 32; ++r) { const v4u q = *(const GAS v4u*)(base + (size_t)r * AW);
            acc[0] += bf_lo(q.x); acc[1] += bf_hi(q.x); acc[2] += bf_lo(q.y); acc[3] += bf_hi(q.y); acc[4] += bf_lo(q.z); acc[5] += bf_hi(q.z); acc[6] += bf_lo(q.w); acc[7] += bf_hi(q.w); }
#pragma unroll
        for (int e = 0; e < 8; ++e) part[F.wave * 512 + F.lane * 8 + e] = acc[e];
        __syncthreads();
        { float s = 0.f;
#pragma unroll
          for (int w = 0; w < 8; ++w) s += part[w * 512 + F.tid];
          const float mean = s * (1.0f / 256.0f); const unsigned hb = f2bf(mean); const float hf = __builtin_bit_cast(float, hb << 16);
          KMH[(size_t)bn * AW + chunk * 512 + F.tid] = (bf16)hb; KML[(size_t)bn * AW + chunk * 512 + F.tid] = (bf16)f2bf(mean - hf); }
        __syncthreads();
    }
}

__device__ __forceinline__ void gate_phase(Frame& F) {
    const bf16* Qb = (const bf16*)(F.ws + WS_Q); const bf16* KMH = (const bf16*)(F.ws + WS_KMH); const bf16* KML = (const bf16*)(F.ws + WS_KML);
    unsigned short* lists = (unsigned short*)(F.ws + WS_LIST); gu32* gcnt = F.ctl + CW_GCNT;
    LAS float* gl = (LAS float*)(F.lds + RING_OFF);
    LAS unsigned* lcnt = (LAS unsigned*)(F.lds + RING_OFF + 34816);
    LAS unsigned* gb = lcnt + 32;
    const int r32 = F.lane & 31, hi = F.lane >> 5;
    for (int uid = blockIdx.x; uid < 1024; uid += F.G) {
        const int bh = uid >> 5, qb = uid & 31, b = bh >> 4, h = bh & 15;
        if (qb == 0) continue;
        if (F.tid < 32) lcnt[F.tid] = 0u;
        const size_t trow = (size_t)b * SEQ + 256 * qb + 32 * F.wave + r32;
        f32x16 acc = {};
#pragma unroll
        for (int s = 0; s < 8; ++s) {
            const bf16x8 bq = *(const GAS bf16x8*)(Qb + trow * AW + h * HD + 16 * s + 8 * hi);
            const bf16x8 ah = *(const GAS bf16x8*)(KMH + (size_t)(b * 32 + r32) * AW + h * HD + 16 * s + 8 * hi);
            const bf16x8 al = *(const GAS bf16x8*)(KML + (size_t)(b * 32 + r32) * AW + h * HD + 16 * s + 8 * hi);
            acc = __builtin_amdgcn_mfma_f32_32x32x16_bf16(ah, bq, acc, 0, 0, 0);
            acc = __builtin_amdgcn_mfma_f32_32x32x16_bf16(al, bq, acc, 0, 0, 0);
        }
#pragma unroll
        for (int r = 0; r < 16; ++r) gl[(32 * F.wave + r32) * 33 + att::crow(r, hi)] = acc[r];
        __syncthreads();
        int s0 = 0, s1 = 0, s2 = 0; unsigned p0 = 0, p1 = 0, p2 = 0; const int nsel = qb < 3 ? qb : 3;
        if (F.tid < 256) {
            float v0 = -__builtin_inff(), v1 = v0, v2 = v0;
            for (int n = 0; n < qb; ++n) { const float g = gl[F.tid * 33 + n];
                if (g > v0) { v2 = v1; s2 = s1; v1 = v0; s1 = s0; v0 = g; s0 = n; }
                else if (g > v1) { v2 = v1; s2 = s1; v1 = g; s1 = n; }
                else if (g > v2) { v2 = g; s2 = n; } }
            p0 = __hip_atomic_fetch_add(lcnt + s0, 1u, __ATOMIC_RELAXED, __HIP_MEMORY_SCOPE_WORKGROUP);
            if (nsel > 1) p1 = __hip_atomic_fetch_add(lcnt + s1, 1u, __ATOMIC_RELAXED, __HIP_MEMORY_SCOPE_WORKGROUP);
            if (nsel > 2) p2 = __hip_atomic_fetch_add(lcnt + s2, 1u, __ATOMIC_RELAXED, __HIP_MEMORY_SCOPE_WORKGROUP);
        }
        __syncthreads();
        if (F.tid < 32) { const unsigned c = lcnt[F.tid]; gb[F.tid] = c ? __hip_atomic_fetch_add(gcnt + bh * 32 + F.tid, c, RLX_AGENT) : 0u; }
        __syncthreads();
        if (F.tid < 256) {
            unsigned short* lb = lists + (size_t)bh * LIST_STRIDE; const unsigned tl = (unsigned)(256 * qb + F.tid);
            lb[list_off(s0) + gb[s0] + p0] = (unsigned short)(tl | (0u << 13));
            if (nsel > 1) lb[list_off(s1) + gb[s1] + p1] = (unsigned short)(tl | (1u << 13));
            if (nsel > 2) lb[list_off(s2) + gb[s2] + p2] = (unsigned short)(tl | (2u << 13));
        }
        __syncthreads();
    }
}

__device__ __forceinline__ void attn_phase(Frame& F, char* ldsg) {
    const bf16* Qb = (const bf16*)(F.ws + WS_Q); const bf16* Kb = (const bf16*)(F.ws + WS_K); const bf16* Vb = (const bf16*)(F.ws + WS_V);
    bf16* PO = (bf16*)(F.ws + WS_PARTO); float2* ML = (float2*)(F.ws + WS_ML);
    const unsigned short* lists = (const unsigned short*)(F.ws + WS_LIST); const gu32* gcnt = F.ctl + CW_GCNT;
    LAS int* pre = (LAS int*)(F.lds + RING_OFF + 67584);
    for (int i = F.tid; i < 1024; i += NWAVES * 64) pre[i] = (int)((__hip_atomic_load(gcnt + i, RLX_AGENT) + 255u) >> 8);
    __syncthreads();
    if (F.wave == 0) {
        int loc[16]; int s = 0;
#pragma unroll
        for (int k = 0; k < 16; ++k) { loc[k] = pre[F.lane * 16 + k]; s += loc[k]; }
        int incl = s;
#pragma unroll
        for (int o = 1; o < 64; o <<= 1) { const int v = __shfl_up(incl, o); if (F.lane >= o) incl += v; }
        int run = incl - s;
#pragma unroll
        for (int k = 0; k < 16; ++k) { pre[F.lane * 16 + k] = run; run += loc[k]; }
        if (F.lane == 63) pre[1024] = incl;
    }
    __syncthreads();
    const int total = 1024 + pre[1024];
    const int r32 = F.lane & 31, rloc = 32 * F.wave + r32;
    for (int id = blockIdx.x; id < total; id += F.G) {
        int bh, j, t, slot; bool causal, valid;
        if (id < 1024) { bh = id >> 5; j = id & 31; causal = true; valid = true; t = 256 * j + rloc; slot = 3; }
        else {
            const int x = id - 1024; int lo = 0, hi2 = 1023;
            while (lo < hi2) { const int mid = (lo + hi2 + 1) >> 1; if (pre[mid] <= x) lo = mid; else hi2 = mid - 1; }
            const int li = lo, chunk = x - pre[li]; bh = li >> 5; j = li & 31; causal = false;
            const int cnt = (int)__hip_atomic_load(gcnt + li, RLX_AGENT) - 256 * chunk;
            valid = rloc < cnt;
            const unsigned e = lists[(size_t)bh * LIST_STRIDE + list_off(j) + 256 * chunk + (valid ? rloc : 0)];
            t = (int)(e & 8191u); slot = (int)(e >> 13);
        }
        const int b = bh >> 4, h = bh & 15;
        const bf16* Qrow = Qb + ((size_t)b * SEQ + t) * AW + h * HD;
        const bf16* Kh = Kb + ((size_t)b * SEQ + 256 * j) * AW + h * HD; const bf16* Vh = Vb + ((size_t)b * SEQ + 256 * j) * AW + h * HD;
        bf16* Orow = PO + (((size_t)slot * 32 + bh) * SEQ + t) * HD; float2* MLrow = ML + ((size_t)slot * 32 + bh) * SEQ + t;
        att::attn_item(Qrow, Kh, Vh, causal, rloc, Orow, MLrow, valid, ldsg);
    }
}

__device__ __forceinline__ void combine_phase(Frame& F) {
    const bf16* PO = (const bf16*)(F.ws + WS_PARTO); const float2* ML = (const float2*)(F.ws + WS_ML); bf16* CAT = (bf16*)(F.ws + WS_CAT);
    constexpr float C = att::SCALE * 1.4426950408889634f;
    const size_t gt = (size_t)blockIdx.x * (NWAVES * 64) + F.tid, NT = (size_t)F.G * NWAVES * 64;
    for (size_t idx = gt; idx < (size_t)32 * SEQ * 16; idx += NT) {
        const int dc = (int)(idx & 15), t = (int)((idx >> 4) & (SEQ - 1)), bh = (int)(idx >> 17), qb = t >> 8, nsel = qb < 3 ? qb : 3;
        float2 ml[4]; float mx;
        ml[3] = ML[((size_t)3 * 32 + bh) * SEQ + t]; mx = ml[3].x;
#pragma unroll
        for (int k = 0; k < 3; ++k) { if (k < nsel) { ml[k] = ML[((size_t)k * 32 + bh) * SEQ + t]; mx = fmaxf(mx, ml[k].x); } else ml[k] = make_float2(0.f, 0.f); }
        float acc[8]; float wsum = 0.f;
#pragma unroll
        for (int e = 0; e < 8; ++e) acc[e] = 0.f;
#pragma unroll
        for (int k = 0; k < 4; ++k) { if (k == 3 || k < nsel) {
            const float w = ml[k].y * __builtin_amdgcn_exp2f((ml[k].x - mx) * C); wsum += w;
            const v4u r = *(const GAS v4u*)(PO + (((size_t)k * 32 + bh) * SEQ + t) * HD + dc * 8);
            acc[0] += w * bf_lo(r.x); acc[1] += w * bf_hi(r.x); acc[2] += w * bf_lo(r.y); acc[3] += w * bf_hi(r.y);
            acc[4] += w * bf_lo(r.z); acc[5] += w * bf_hi(r.z); acc[6] += w * bf_lo(r.w); acc[7] += w * bf_hi(r.w); } }
        const float inv = 1.0f / wsum; const int b = bh >> 4, h = bh & 15;
        v4u o; o.x = pk2(acc[0] * inv, acc[1] * inv); o.y = pk2(acc[2] * inv, acc[3] * inv); o.z = pk2(acc[4] * inv, acc[5] * inv); o.w = pk2(acc[6] * inv, acc[7] * inv);
        *(GAS v4u*)(CAT + ((size_t)b * SEQ + t) * DM + PW + h * HD + dc * 8) = o;
    }
}

struct Args { const float* in[18]; float* out; unsigned char* ws; int ph_lo, ph_hi, li, pad; };
__global__ void __launch_bounds__(NWAVES * 64, 2) mega_fwd(Args args) {
    extern __shared__ __attribute__((aligned(16))) unsigned char lds[];
    Frame F;
    F.lds = (LAS unsigned char*)lds;
    F.MISC = (volatile LAS unsigned*)(F.lds + MISC_OFF);
    F.tid = threadIdx.x; F.lane = F.tid & 63; F.wave = __builtin_amdgcn_readfirstlane(F.tid >> 6);
    F.G = gridDim.x; F.ws = args.ws;
    F.ctl = (gu32*)(args.ws + WS_CTL);
    for (int u = F.tid; u < (LDS_BYTES - LDSCTL_OFF) / 4; u += NWAVES * 64) ((LAS unsigned*)(F.lds + LDSCTL_OFF))[u] = 0u;
    __syncthreads();
    XcdBarrier bar; bar.bar = (unsigned*)(F.ctl + CW_BAR); bar.x = 0; bar.st = nullptr;
    if (N_LAUNCHES == 1) bar = xcd_barrier_post((unsigned*)(F.ctl + CW_BAR), F.MISC + 8);
#define GRID_BAR() do { if (N_LAUNCHES == 1) xcd_barrier(bar); } while (0)
    const int lo = args.ph_lo, hi = args.ph_hi;
#define IN(k) (lo <= (k) && (k) < hi)
#define BOTH(k) (IN(k) && IN((k) + 1))
#ifndef PROBE_DUP
#define PROBE_DUP 0
#endif
#define REP(k) for (int _rep = 0; _rep < (((PROBE_DUP >> (k)) & 1) ? 2 : 1); ++_rep)
    unsigned char* ws = args.ws;
    const int G = F.G, cid = (int)blockIdx.x;
    float* out = args.out;

    if (IN(0)) { REP(0) { p0_prologue(F, args.in); } if (BOTH(0)) GRID_BAR(); }

    if (IN(1)) {
        { pg8::GemmKV g{(const char*)(ws + WS_MEMB), (const char*)(ws + WS_WXKV), (const char*)(ws + WS_WXKV + (size_t)DM * DM * 2), DM, DM, 1024};
          pg8::OrderKV S{G, cid}; pg8::EpiSlabKV E{(float*)(ws + WS_SLAB), (float*)(ws + WS_SLAB) + (size_t)4 * 512 * 4096};
          REP(16) { pg8::gemm_phase<pg8::EpiSlabKV, pg8::OrderKV, true, true, pg8::GemmKV>(F.lds + RING_OFF, g, S, E); } }
        { pg8::Gemm g = pg8::make_gemm(ws + WS_XB, DM, ws + WS_WIN, DM, DM); pg8::StaticOrder S; S.init(M, MIXIN, G, cid);
          pg8::EpiMixIn E{(pg8::bf16_t*)(ws + WS_HP), (size_t)M * 2048, (const float*)(ws + WS_ROPE)};
          REP(1) { pg8::gemm_phase<pg8::EpiMixIn, pg8::StaticOrder, true, true>(F.lds + RING_OFF, g, S, E); } }
        if (BOTH(1)) GRID_BAR();
    }

    if (IN(2)) { REP(2) { pool_ew(F); kmean_phase(F); kv_reduce(F); } if (BOTH(2)) GRID_BAR(); }

    if (IN(3)) {
        { pg8::Gemm g = pg8::make_gemm(ws + WS_PM, PW, ws + WS_WPOOL, 512, 512); g.a_pn = 512 * 2; g.a_pn_sh = 1; pg8::StaticOrder S; S.init(M, PW, G, cid);
          pg8::EpiStore E{(pg8::bf16_t*)(ws + WS_CAT), DM, 0};
          REP(3) { pg8::gemm_phase<pg8::EpiStore, pg8::StaticOrder, true, true>(F.lds + RING_OFF, g, S, E); } }
        gate_phase(F);
        if (BOTH(3)) GRID_BAR();
    }

    if (IN(4)) { REP(4) { attn_phase(F, (char*)lds + RING_OFF); __syncthreads(); } if (BOTH(4)) GRID_BAR(); }

    if (IN(5)) { REP(5) { combine_phase(F); } if (BOTH(5)) GRID_BAR(); }

    if (IN(6)) {
        pg8::Gemm g = pg8::make_gemm(ws + WS_CAT, DM, ws + WS_WOUT, DM, DM); pg8::StaticOrder S; S.init(M, DM, G, cid);
        pg8::EpiResid E{args.in[0], out, DM, DN_ALPHA};
        REP(6) { pg8::gemm_phase<pg8::EpiResid, pg8::StaticOrder, true, true>(F.lds + RING_OFF, g, S, E); }
        if (BOTH(6)) GRID_BAR();
    }
    if (IN(7)) { ln_rows<false>(F, out, (bf16*)(ws + WS_HB), (float2*)(ws + WS_STATS), args.in[6], args.in[7]); if (BOTH(7)) GRID_BAR(); }

    if (IN(8)) {
        pg8::Gemm g = pg8::make_gemm(ws + WS_HB, DM, ws + WS_WXQ, DM, DM); pg8::StaticOrder S; S.init(M, DM, G, cid);
        pg8::EpiStore E{(pg8::bf16_t*)(ws + WS_QX), DM, 0};
        REP(8) { pg8::gemm_phase<pg8::EpiStore, pg8::StaticOrder, true, true>(F.lds + RING_OFF, g, S, E); }
        if (BOTH(8)) GRID_BAR();
    }
    if (IN(9)) {
        if (G == 256) {
            pg8::Gemm g = pg8::make_gemm(ws + WS_QX, DM, ws + WS_KX, DM, XHD); g.a_pn = XHD * 2; g.a_pn_sh = 0; g.b_pn = XHD * 2; g.b_pm = (size_t)MEMLEN * DM * 2; g.b_pm_sh = 5;
            pg8::StaticOrder S; S.init(M, XH * 256, G, cid);
            pg8::EpiSoftmax E{(pg8::bf16_t*)(ws + WS_PB), XH * MEMLEN, 0.03125f * 1.4426950408889634f};
            REP(9) { pg8::gemm_phase<pg8::EpiSoftmax, pg8::StaticOrder, false, true>(F.lds + RING_OFF, g, S, E); }
        }
        if (BOTH(9)) GRID_BAR();
    }
    if (IN(10)) {
        pg8::Gemm g = pg8::make_gemm(ws + WS_PB, XH * MEMLEN, ws + WS_VT, BATCH * MEMLEN, MEMLEN); g.a_pn = MEMLEN * 2; g.a_pn_sh = 2; g.b_pm = MEMLEN * 2; g.b_pm_sh = 5;
        pg8::StaticOrder S; S.init(M, DM, G, cid);
        pg8::EpiStore E{(pg8::bf16_t*)(ws + WS_OX), DM, 0};
        REP(10) { pg8::gemm_phase<pg8::EpiStore, pg8::StaticOrder, true, true>(F.lds + RING_OFF, g, S, E); }
        if (BOTH(10)) GRID_BAR();
    }
    if (IN(11)) {
        pg8::Gemm g = pg8::make_gemm(ws + WS_OX, DM, ws + WS_WXO, DM, DM); pg8::StaticOrder S; S.init(M, DM, G, cid);
        pg8::EpiResidLN E{out, (const pg8::f32x2*)(ws + WS_STATS), 6};
        pg8::gemm_phase<pg8::EpiResidLN, pg8::StaticOrder, true, true>(F.lds + RING_OFF, g, S, E);
        if (BOTH(11)) GRID_BAR();
    }
    if (IN(12)) { ln_rows<false>(F, out, (bf16*)(ws + WS_HB), (float2*)(ws + WS_STATS), args.in[11], args.in[12]); if (BOTH(12)) GRID_BAR(); }

    if (IN(13)) {
        pg8::Gemm g = pg8::make_gemm(ws + WS_HB, DM, ws + WS_WGU, DM, DM); pg8::StaticOrder S; S.init(M, 2 * FF, G, cid);
        pg8::EpiSwiGLU E{(pg8::bf16_t*)(ws + WS_G), FF};
        REP(13) { pg8::gemm_phase<pg8::EpiSwiGLU, pg8::StaticOrder, true, true>(F.lds + RING_OFF, g, S, E); }
        if (BOTH(13)) GRID_BAR();
    }
    if (IN(14)) {
        pg8::Gemm g = pg8::make_gemm(ws + WS_G, FF, ws + WS_WDN, FF, FF); pg8::StaticOrder S; S.init(M, DM, G, cid);
        pg8::EpiResidLN E{out, (const pg8::f32x2*)(ws + WS_STATS), 11};
        pg8::gemm_phase<pg8::EpiResidLN, pg8::StaticOrder, true, true>(F.lds + RING_OFF, g, S, E);
        if (BOTH(14)) GRID_BAR();
    }
    if (IN(15)) { ln_rows<true>(F, out, nullptr, nullptr, args.in[16], args.in[17]); }
#undef IN
#undef BOTH
#undef GRID_BAR
}

extern "C" void kernel_launch(void* const* d_in, const int* in_sizes, int n_in, void* d_out, int out_size, void* d_ws, size_t ws_size, hipStream_t stream) {
    static int grid = 0;
    if (grid == 0) {
        if (n_in != 18 || in_sizes[0] != M * DM || out_size != M * DM || ws_size < WS_END) { fprintf(stderr, "kernel_launch: shape / workspace mismatch (n_in %d, in0 %d, out %d, ws %zu, need %zu)\n", n_in, n_in > 0 ? in_sizes[0] : -1, out_size, ws_size, (size_t)WS_END); grid = -1; return; }
        int dev = 0, cus = 0, per_cu = 0;
        if (hipGetDevice(&dev) != hipSuccess || hipDeviceGetAttribute(&cus, hipDeviceAttributeMultiprocessorCount, dev) != hipSuccess) { grid = -1; return; }
        if (hipFuncSetAttribute((const void*)mega_fwd, hipFuncAttributeMaxDynamicSharedMemorySize, LDS_BYTES) != hipSuccess) { fprintf(stderr, "kernel_launch: hipFuncSetAttribute failed\n"); grid = -1; return; }
        if (hipOccupancyMaxActiveBlocksPerMultiprocessor(&per_cu, (const void*)mega_fwd, NWAVES * 64, LDS_BYTES) != hipSuccess || per_cu < 1)
            fprintf(stderr, "kernel_launch: note: occupancy query reports %d workgroups per CU\n", per_cu);
        (void)hipGetLastError();
        grid = cus;
        if (grid != 256) fprintf(stderr, "kernel_launch: %d CUs; the cross-attention score phase needs a 256-workgroup grid\n", grid);
    }
    if (grid < 0) return;
    if (hipMemsetAsync((char*)d_ws + WS_CTL, 0, CTL_ZERO_BYTES, stream) != hipSuccess) return;
    Args a{};
    for (int i = 0; i < 18; ++i) a.in[i] = (const float*)d_in[i];
    a.out = (float*)d_out; a.ws = (unsigned char*)d_ws; a.pad = 0;
    for (int li = 0; li < N_LAUNCHES; ++li) {
        a.ph_lo = (N_LAUNCHES == 1) ? 0 : li; a.ph_hi = (N_LAUNCHES == 1) ? N_PHASES : li + 1; a.li = li;
        hipLaunchKernelGGL(mega_fwd, dim3(grid), dim3(NWAVES * 64), LDS_BYTES, stream, a);
        if (hipPeekAtLastError() != hipSuccess) { fprintf(stderr, "kernel_launch: launch %d failed\n", li); break; }
    }
}
```

```cpp
#include <hip/hip_runtime.h>
#include <cstdio>
#include <cstdint>

namespace pg8 {
#define PG8_LAS __attribute__((address_space(3)))
typedef unsigned short bf16_t;
typedef short bf16x8 __attribute__((ext_vector_type(8)));
typedef float f32x4 __attribute__((ext_vector_type(4)));
typedef float f32x2 __attribute__((ext_vector_type(2)));
typedef unsigned u32x4 __attribute__((ext_vector_type(4)));
typedef unsigned u32x2 __attribute__((ext_vector_type(2)));
constexpr int BM = 256, BK = 64, HALF = 128, HTB = HALF * BK * 2  , STAGE_BYTES = 8 * HTB, NXCD = 8, WGM = 8;

__host__ __device__ __forceinline__ int lds_byte(int r, int c) { const int st = (r >> 4) * 2 + (c >> 5), rr = r & 15, cc = c & 31, ob = rr * 64 + cc * 2; return st * 1024 + (ob ^ (((ob >> 9) & 1) << 5)); }
__host__ __device__ __forceinline__ void stage_rc(int b, int& R, int& C) { const int st = b / 1024, sb = b % 1024, swz = sb ^ (((sb >> 9) & 1) << 5); R = (st >> 1) * 16 + swz / 64; C = (st & 1) * 32 + (swz % 64) / 2; }
__host__ __device__ __forceinline__ int perm32(int rho) { const int n = rho >> 4, i = rho & 15; return 8 * (i >> 2) + 4 * n + (i & 3); }

struct Unit { int pm, pn, pz; };
struct Gemm {
    const char* A; const char* B; int lda, ldb, K;
    size_t a_pm, a_pn; int a_pn_sh; size_t b_pn, b_pm; int b_pm_sh;
    __device__ __forceinline__ const char* a_ptr(const Unit& u) const { return A + (size_t)u.pm * a_pm + (size_t)(u.pn >> a_pn_sh) * a_pn; }
    __device__ __forceinline__ const char* b_ptr(const Unit& u) const { return B + (size_t)u.pn * b_pn + (size_t)(u.pm >> b_pm_sh) * b_pm; }
};
__device__ __forceinline__ Gemm make_gemm(const void* A, int lda, const void* B, int ldb, int K) {
    Gemm g; g.A = (const char*)A; g.B = (const char*)B; g.lda = lda; g.ldb = ldb; g.K = K;
    g.a_pm = (size_t)BM * lda * 2; g.a_pn = 0; g.a_pn_sh = 0; g.b_pn = (size_t)BM * ldb * 2; g.b_pm = 0; g.b_pm_sh = 0; return g;
}

struct StaticOrder {
    int nM, nN, nwg, G, c;
    __host__ __device__ void init(int M, int N, int G_, int c_) { nM = M / BM; nN = N / BM; nwg = nM * nN; G = G_; c = c_; }
    __host__ __device__ bool next(int i, Unit& u) const {
        const long L = (long)i * G + c; if (L >= nwg) return false;
        int wgid = (int)L; { const int q = nwg / NXCD, r = nwg % NXCD, xcd = wgid % NXCD, off = wgid / NXCD; wgid = (xcd < r ? xcd * (q + 1) : r * (q + 1) + (xcd - r) * q) + off; }
        const int nig = WGM * nN, gid = wgid / nig, fm = gid * WGM, gsz = (nM - fm) < WGM ? (nM - fm) : WGM;
        u.pm = fm + ((wgid % nig) % gsz); u.pn = (wgid % nig) / gsz; u.pz = 0; return true;
    }
    __device__ __forceinline__ void a_ready(const Unit&) const {}
    __device__ __forceinline__ void done(const Unit&) const {}
};

__device__ __forceinline__ unsigned cvt_pk_bf16(float lo, float hi) { unsigned r; asm volatile("v_cvt_pk_bf16_f32 %0, %1, %2" : "=v"(r) : "v"(lo), "v"(hi)); return r; }

struct EpiMixIn {
    static constexpr bool PERM = true, AFTER_DRAIN = false;
    bf16_t* base; size_t tstride; const float* rope;
    __device__ __forceinline__ void operator()(const f32x4 (&acc)[2][2][4][2], const Unit& u, int wr, int wc, int fr, int fq) const {
        const int t = u.pn >> 3; const bool rp = (t == 1) || (t == 2);
        bf16_t* ob = base + (size_t)t * tstride;
        const int row0 = u.pm * BM + wr * 64 + fr, col0 = (u.pn & 7) * BM + wc * 32 + 8 * fq;
#pragma unroll
        for (int ai = 0; ai < 2; ++ai)
#pragma unroll
            for (int m = 0; m < 4; ++m) {
                const int row = row0 + ai * HALF + m * 16; bf16_t* rowp = ob + (size_t)row * 2048 + col0;
                f32x4 cs0 = (f32x4){1.f, 0.f, 1.f, 0.f}, cs1 = cs0;
                if (rp) { const f32x4* tp = (const f32x4*)(rope + ((size_t)(row & 8191) * 64 + wc * 16 + fq * 4) * 2); cs0 = tp[0]; cs1 = tp[1]; }
#pragma unroll
                for (int bj = 0; bj < 2; ++bj) {
                    const f32x4 v0 = acc[ai][bj][m][0], v1 = acc[ai][bj][m][1];
                    const float a0 = v0[0] * cs0[0] - v0[1] * cs0[1], a1 = v0[1] * cs0[0] + v0[0] * cs0[1];
                    const float a2 = v0[2] * cs0[2] - v0[3] * cs0[3], a3 = v0[3] * cs0[2] + v0[2] * cs0[3];
                    const float b0 = v1[0] * cs1[0] - v1[1] * cs1[1], b1 = v1[1] * cs1[0] + v1[0] * cs1[1];
                    const float b2 = v1[2] * cs1[2] - v1[3] * cs1[3], b3 = v1[3] * cs1[2] + v1[2] * cs1[3];
                    u32x4 w; w.x = cvt_pk_bf16(a0, a1); w.y = cvt_pk_bf16(a2, a3); w.z = cvt_pk_bf16(b0, b1); w.w = cvt_pk_bf16(b2, b3);
                    *(u32x4*)(rowp + bj * HALF) = w;
                }
            }
    }
};
struct EpiStore {
    static constexpr bool PERM = true, AFTER_DRAIN = false;
    bf16_t* O; int ldc, coff;
    __device__ __forceinline__ void operator()(const f32x4 (&acc)[2][2][4][2], const Unit& u, int wr, int wc, int fr, int fq) const {
        const int row0 = u.pm * BM + wr * 64 + fr, col0 = coff + u.pn * BM + wc * 32 + 8 * fq;
#pragma unroll
        for (int ai = 0; ai < 2; ++ai)
#pragma unroll
            for (int m = 0; m < 4; ++m) { bf16_t* rowp = O + (size_t)(row0 + ai * HALF + m * 16) * ldc + col0;
#pragma unroll
                for (int bj = 0; bj < 2; ++bj) { const f32x4 v0 = acc[ai][bj][m][0], v1 = acc[ai][bj][m][1];
                    u32x4 w; w.x = cvt_pk_bf16(v0[0], v0[1]); w.y = cvt_pk_bf16(v0[2], v0[3]); w.z = cvt_pk_bf16(v1[0], v1[1]); w.w = cvt_pk_bf16(v1[2], v1[3]);
                    *(u32x4*)(rowp + bj * HALF) = w; } }
    }
};
struct EpiResid {
    static constexpr bool PERM = false, AFTER_DRAIN = false;
    const float* res; float* out; int ldc; float alpha;
    __device__ __forceinline__ void operator()(const f32x4 (&acc)[2][2][4][2], const Unit& u, int wr, int wc, int fr, int fq) const {
        const int row0 = u.pm * BM + wr * 64 + fr, col0 = u.pn * BM + wc * 32 + 4 * fq;
#pragma unroll
        for (int ai = 0; ai < 2; ++ai)
#pragma unroll
            for (int m = 0; m < 4; ++m) { const size_t off = (size_t)(row0 + ai * HALF + m * 16) * ldc + col0;
#pragma unroll
                for (int bj = 0; bj < 2; ++bj)
#pragma unroll
                    for (int n = 0; n < 2; ++n) { const f32x4 r = *(const f32x4*)(res + off + bj * HALF + n * 16); *(f32x4*)(out + off + bj * HALF + n * 16) = r * alpha + acc[ai][bj][m][n]; }
                asm volatile("" ::: "memory"); }
    }
};
struct EpiSwiGLU {
    static constexpr bool PERM = true, AFTER_DRAIN = false;
    bf16_t* G; int ldc;
    __device__ __forceinline__ float act(float g, float u) const { return g * u * __builtin_amdgcn_rcpf(1.0f + __builtin_amdgcn_exp2f(-1.4426950408889634f * g)); }
    __device__ __forceinline__ void operator()(const f32x4 (&acc)[2][2][4][2], const Unit& u, int wr, int wc, int fr, int fq) const {
        const int row0 = u.pm * BM + wr * 64 + fr, col0 = u.pn * HALF + wc * 32 + 8 * fq;
#pragma unroll
        for (int ai = 0; ai < 2; ++ai)
#pragma unroll
            for (int m = 0; m < 4; ++m) { bf16_t* rowp = G + (size_t)(row0 + ai * HALF + m * 16) * ldc + col0;
                const f32x4 g0 = acc[ai][0][m][0], g1 = acc[ai][0][m][1], u0 = acc[ai][1][m][0], u1 = acc[ai][1][m][1];
                u32x4 w; w.x = cvt_pk_bf16(act(g0[0], u0[0]), act(g0[1], u0[1])); w.y = cvt_pk_bf16(act(g0[2], u0[2]), act(g0[3], u0[3]));
                w.z = cvt_pk_bf16(act(g1[0], u1[0]), act(g1[1], u1[1])); w.w = cvt_pk_bf16(act(g1[2], u1[2]), act(g1[3], u1[3]));
                *(u32x4*)rowp = w; }
    }
};
struct EpiSoftmax {
    static constexpr bool PERM = true, AFTER_DRAIN = true;
    bf16_t* P; int ldc; float c2;
    __device__ __forceinline__ void fused(f32x4 (&acc)[2][2][4][2], const Unit& u, int wr, int wc, int fr, int fq, PG8_LAS unsigned char* lds, int wid, int lane) const {
        PG8_LAS float* T1 = (PG8_LAS float*)lds;
        PG8_LAS float* T2 = (PG8_LAS float*)(lds + 4096);
#pragma unroll
        for (int ai = 0; ai < 2; ++ai)
#pragma unroll
            for (int m = 0; m < 4; ++m) { float mx = -3.0e38f;
#pragma unroll
                for (int bj = 0; bj < 2; ++bj)
#pragma unroll
                    for (int n = 0; n < 2; ++n) { const f32x4 x = acc[ai][bj][m][n]; mx = fmaxf(mx, fmaxf(fmaxf(x[0], x[1]), fmaxf(x[2], x[3]))); }
                mx = fmaxf(mx, __shfl_xor(mx, 16)); mx = fmaxf(mx, __shfl_xor(mx, 32));
                if (fq == 0) T1[(ai * HALF + wr * 64 + m * 16 + fr) * 4 + wc] = mx; }
        asm volatile("s_waitcnt lgkmcnt(0)" ::: "memory"); __builtin_amdgcn_s_barrier(); asm volatile("" ::: "memory");
#pragma unroll
        for (int ai = 0; ai < 2; ++ai)
#pragma unroll
            for (int m = 0; m < 4; ++m) { const int r = ai * HALF + wr * 64 + m * 16 + fr;
                const f32x4 t = *(const PG8_LAS f32x4*)(T1 + r * 4); const float mx = fmaxf(fmaxf(t[0], t[1]), fmaxf(t[2], t[3])) * c2; float s = 0.f;
#pragma unroll
                for (int bj = 0; bj < 2; ++bj)
#pragma unroll
                    for (int n = 0; n < 2; ++n) { f32x4 x = acc[ai][bj][m][n];
#pragma unroll
                        for (int e = 0; e < 4; ++e) { x[e] = __builtin_amdgcn_exp2f(x[e] * c2 - mx); s += x[e]; }
                        acc[ai][bj][m][n] = x; }
                s += __shfl_xor(s, 16); s += __shfl_xor(s, 32);
                if (fq == 0) T2[r * 4 + wc] = s; }
        asm volatile("s_waitcnt lgkmcnt(0)" ::: "memory"); __builtin_amdgcn_s_barrier(); asm volatile("" ::: "memory");
        const int row0 = u.pm * BM + wr * 64 + fr, col0 = u.pn * BM + wc * 32 + 8 * fq;
#pragma unroll
        for (int ai = 0; ai < 2; ++ai)
#pragma unroll
            for (int m = 0; m < 4; ++m) { const int r = ai * HALF + wr * 64 + m * 16 + fr;
                const f32x4 t = *(const PG8_LAS f32x4*)(T2 + r * 4); const float inv = 1.0f / ((t[0] + t[1]) + (t[2] + t[3]));
                bf16_t* rowp = P + (size_t)(row0 + ai * HALF + m * 16) * ldc + col0;
#pragma unroll
                for (int bj = 0; bj < 2; ++bj) { const f32x4 v0 = acc[ai][bj][m][0] * inv, v1 = acc[ai][bj][m][1] * inv;
                    u32x4 w; w.x = cvt_pk_bf16(v0[0], v0[1]); w.y = cvt_pk_bf16(v0[2], v0[3]); w.z = cvt_pk_bf16(v1[0], v1[1]); w.w = cvt_pk_bf16(v1[2], v1[3]);
                    *(u32x4*)(rowp + bj * HALF) = w; } }
    }
};

struct GemmKV {
    const char* memb; const char* wkv; int lda, ldb, K;
    __device__ __forceinline__ const char* a_ptr(const Unit& u) const { return memb + (size_t)u.pm * (BM * 4096 * 2) + (size_t)u.pz * 2048; }
    __device__ __forceinline__ const char* b_ptr(const Unit& u) const { return wkv + (size_t)u.pn * (BM * 4096 * 2) + (size_t)u.pz * 2048; }
};
struct OrderKV {
    int G, c;
    __device__ __forceinline__ bool next(int i, Unit& u) const { const int L = i * G + c; if (L >= 256) return false; const int tile = L >> 2; u.pz = L & 3; u.pm = tile >> 5; u.pn = tile & 31; return true; }
    __device__ __forceinline__ void a_ready(const Unit&) const {}
    __device__ __forceinline__ void done(const Unit&) const {}
};
struct EpiSlabKV {
    static constexpr bool PERM = false, AFTER_DRAIN = false;
    float* S;
    __device__ __forceinline__ void operator()(const f32x4 (&acc)[2][2][4][2], const Unit& u, int wr, int wc, int fr, int fq) const {
        float* C = S + (size_t)u.pz * (512 * 8192);
        const int row0 = u.pm * BM + wr * 64 + fr, col0 = u.pn * BM + wc * 32 + 4 * fq;
#pragma unroll
        for (int ai = 0; ai < 2; ++ai)
#pragma unroll
            for (int m = 0; m < 4; ++m) { float* rowp = C + (size_t)(row0 + ai * HALF + m * 16) * 8192 + col0;
#pragma unroll
                for (int bj = 0; bj < 2; ++bj)
#pragma unroll
                    for (int n = 0; n < 2; ++n) *(f32x4*)(rowp + bj * HALF + n * 16) = acc[ai][bj][m][n]; }
    }
};
struct GemmAbs {
    const char* kvx; const char* wq_raw; const char* wo_t; int lda, ldb, K;
    __device__ __forceinline__ const char* a_ptr(const Unit& u) const {
        return u.pz ? wo_t + (size_t)u.pm * (BM * 4096 * 2) + (size_t)(u.pn & 3) * 2048
                    : kvx + (size_t)(u.pm >> 2) * (BM * 8192 * 2) + (size_t)(u.pm & 3) * 2048; }
    __device__ __forceinline__ const char* b_ptr(const Unit& u) const {
        return u.pz ? kvx + 8192 + (size_t)(u.pn >> 2) * (BM * 8192 * 2) + (size_t)(u.pn & 3) * 2048
                    : wq_raw + (size_t)u.pn * (BM * 4096 * 2) + (size_t)(u.pm & 3) * 2048; }
};
struct OrderAbs {
    int c;
    __device__ __forceinline__ bool next(int i, Unit& u) const { if (i != 0 || c >= 256) return false; if (c < 128) { u.pz = 0; u.pm = c >> 4; u.pn = c & 15; } else { const int t = c - 128; u.pz = 1; u.pm = t >> 3; u.pn = t & 7; } return true; }
    __device__ __forceinline__ void a_ready(const Unit&) const {}
    __device__ __forceinline__ void done(const Unit&) const {}
};
struct EpiStoreAbs {
    static constexpr bool PERM = true, AFTER_DRAIN = false;
    bf16_t* WQK; bf16_t* WVOT;
    __device__ __forceinline__ void operator()(const f32x4 (&acc)[2][2][4][2], const Unit& u, int wr, int wc, int fr, int fq) const {
        bf16_t* O = u.pz ? WVOT : WQK; const int ldc = u.pz ? 2048 : 4096;
        const int row0 = u.pm * BM + wr * 64 + fr, col0 = u.pn * BM + wc * 32 + 8 * fq;
#pragma unroll
        for (int ai = 0; ai < 2; ++ai)
#pragma unroll
            for (int m = 0; m < 4; ++m) { bf16_t* rowp = O + (size_t)(row0 + ai * HALF + m * 16) * ldc + col0;
#pragma unroll
                for (int bj = 0; bj < 2; ++bj) { const f32x4 v0 = acc[ai][bj][m][0], v1 = acc[ai][bj][m][1];
                    u32x4 w; w.x = cvt_pk_bf16(v0[0], v0[1]); w.y = cvt_pk_bf16(v0[2], v0[3]); w.z = cvt_pk_bf16(v1[0], v1[1]); w.w = cvt_pk_bf16(v1[2], v1[3]);
                    *(u32x4*)(rowp + bj * HALF) = w; } }
    }
};
struct EpiResidLN {
    static constexpr bool PERM = false, AFTER_DRAIN = false;
    float* T; const f32x2* stats; int gi;
    __device__ __forceinline__ void operator()(const f32x4 (&acc)[2][2][4][2], const Unit& u, int wr, int wc, int fr, int fq) const {
        constexpr int ldc = 4096; constexpr float alpha = 1.189207115002721f;
        const float* const __attribute__((address_space(4)))* inp = (const float* const __attribute__((address_space(4)))*)__builtin_amdgcn_kernarg_segment_ptr();
        const float* g = inp[gi]; const float* b = inp[gi + 1];
        const int row0 = u.pm * BM + wr * 64 + fr, col0 = u.pn * BM + wc * 32 + 4 * fq;
        f32x4 gv[2][2], bv[2][2];
#pragma unroll
        for (int bj = 0; bj < 2; ++bj)
#pragma unroll
            for (int n = 0; n < 2; ++n) { gv[bj][n] = *(const f32x4*)(g + col0 + bj * HALF + n * 16) * alpha; bv[bj][n] = *(const f32x4*)(b + col0 + bj * HALF + n * 16) * alpha; }
#pragma unroll
        for (int ai = 0; ai < 2; ++ai)
#pragma unroll
            for (int m = 0; m < 4; ++m) { const int row = row0 + ai * HALF + m * 16; const size_t off = (size_t)row * ldc + col0; const f32x2 st = stats[row];
#pragma unroll
                for (int bj = 0; bj < 2; ++bj)
#pragma unroll
                    for (int n = 0; n < 2; ++n) { const f32x4 r = *(const f32x4*)(T + off + bj * HALF + n * 16);
                        *(f32x4*)(T + off + bj * HALF + n * 16) = ((r - st.x) * st.y) * gv[bj][n] + bv[bj][n] + acc[ai][bj][m][n]; }
                asm volatile("" ::: "memory"); }
    }
};

template <class Epi, class Sched, bool ALIGN_EPI = false, bool SP2 = false, class GT = Gemm>
__device__ __forceinline__ void gemm_phase(PG8_LAS unsigned char* lds, const GT g, const Sched& S, const Epi& E) {
    const int tid = threadIdx.x, wid = __builtin_amdgcn_readfirstlane(tid >> 6), lane = tid & 63, wr = wid >> 2, wc = wid & 3, fr = lane & 15, fq = lane >> 4;
    const int K = g.K, nt = K / BK;
    unsigned voffA[2], voffB[2];
#pragma unroll
    for (int i = 0; i < 2; ++i) { int R, C; stage_rc(tid * 16 + i * 8192, R, C); const int Rb = Epi::PERM ? ((R & ~31) + perm32(R & 31)) : R;
        voffA[i] = (unsigned)(R * g.lda + C) * 2u; voffB[i] = (unsigned)(Rb * g.ldb + C) * 2u; }
    const size_t kstep = (size_t)(BK * 2);
    const size_t hA = (size_t)HALF * g.lda * 2, hB = (size_t)HALF * g.ldb * 2;
    const unsigned ldsw = (unsigned)wid * 1024u;
    const int aoff = lds_byte(wr * 64 + fr, fq * 8), boff = lds_byte(wc * 32 + fr, fq * 8);
#define PG8_SA(b, h) (((b) * 2 + (h)) * HTB)
#define PG8_SB(b, h) ((4 + (b) * 2 + (h)) * HTB)
#define PG8_STAGE(bufoff, gbase, voff) do { _Pragma("unroll") for (int _i = 0; _i < 2; ++_i) \
        __builtin_amdgcn_global_load_lds((const unsigned*)((const char*)(gbase) + (voff)[_i]), (PG8_LAS unsigned*)(lds + (bufoff) + ldsw + _i * 8192), 16, 0, 0); } while (0)
#define PG8_LDA(dst, b, h) do { _Pragma("unroll") for (int m = 0; m < 4; ++m) _Pragma("unroll") for (int k = 0; k < 2; ++k) dst[m][k] = *(const PG8_LAS bf16x8*)(lds + PG8_SA(b, h) + aoff + m * 2048 + k * 1024); } while (0)
#define PG8_LDB(dst, b, h) do { _Pragma("unroll") for (int n = 0; n < 2; ++n) _Pragma("unroll") for (int k = 0; k < 2; ++k) dst[n][k] = *(const PG8_LAS bf16x8*)(lds + PG8_SB(b, h) + boff + n * 2048 + k * 1024); } while (0)
#define PG8_MMA(ai, bj, At, Bt) do { __builtin_amdgcn_s_setprio(1); _Pragma("unroll") for (int m = 0; m < 4; ++m) _Pragma("unroll") for (int n = 0; n < 2; ++n) _Pragma("unroll") for (int k = 0; k < 2; ++k) \
        acc[ai][bj][m][n] = __builtin_amdgcn_mfma_f32_16x16x32_bf16(Bt[n][k], At[m][k], acc[ai][bj][m][n], 0, 0, 0); __builtin_amdgcn_s_setprio(0); } while (0)
#define PG8_WAIT_V(n) asm volatile("s_waitcnt vmcnt(" #n ")" ::: "memory")
#define PG8_WAIT_L(n) asm volatile("s_waitcnt lgkmcnt(" #n ")" ::: "memory")
#define PG8_BAR __builtin_amdgcn_s_barrier()
#define PG8_SCHED __builtin_amdgcn_sched_barrier(0)
    Unit cur, nxt; int ui = 0;
    if (!S.next(0, cur)) return;
    f32x4 acc[2][2][4][2];
#pragma unroll
    for (int a = 0; a < 2; ++a)
#pragma unroll
        for (int b = 0; b < 2; ++b)
#pragma unroll
            for (int m = 0; m < 4; ++m)
#pragma unroll
                for (int n = 0; n < 2; ++n) acc[a][b][m][n] = (f32x4){0.f, 0.f, 0.f, 0.f};
    bf16x8 At[4][2], B0[2][2], B1[2][2];
    const char* cA = g.a_ptr(cur); const char* cB = g.b_ptr(cur);
    S.a_ready(cur);
    if constexpr (SP2) {
        PG8_STAGE(PG8_SB(0, 0), cB, voffB); PG8_STAGE(PG8_SB(0, 1), cB + hB, voffB); PG8_STAGE(PG8_SA(0, 0), cA, voffA); PG8_STAGE(PG8_SA(0, 1), cA + hA, voffA);
        if (wr == 1) PG8_BAR;
        PG8_WAIT_V(2); PG8_BAR;
        PG8_STAGE(PG8_SB(1, 0), cB + kstep, voffB); PG8_STAGE(PG8_SA(1, 0), cA + kstep, voffA); PG8_STAGE(PG8_SB(1, 1), cB + hB + kstep, voffB);
        PG8_WAIT_V(6); PG8_BAR;
    } else {
        PG8_STAGE(PG8_SB(0, 0), cB, voffB); PG8_STAGE(PG8_SA(0, 0), cA, voffA); PG8_STAGE(PG8_SB(0, 1), cB + hB, voffB); PG8_STAGE(PG8_SA(0, 1), cA + hA, voffA);
        if (wr == 1) PG8_BAR;
        PG8_WAIT_V(4); PG8_BAR;
        PG8_STAGE(PG8_SB(1, 0), cB + kstep, voffB); PG8_STAGE(PG8_SA(1, 0), cA + kstep, voffA); PG8_STAGE(PG8_SB(1, 1), cB + hB + kstep, voffB);
        PG8_WAIT_V(6); PG8_BAR;
    }
    for (;;) {
        const bool has_next = S.next(ui + 1, nxt);
        const char* nA = has_next ? g.a_ptr(nxt) : cA; const char* nB = has_next ? g.b_ptr(nxt) : cB;
        for (int t = 0; t < nt; t += 2) {
            const bool last = (t == nt - 2);
            const char* a1 = cA + (size_t)(t + 1) * kstep;
            const char* a2 = last ? nA : cA + (size_t)(t + 2) * kstep; const char* b2 = last ? nB : cB + (size_t)(t + 2) * kstep;
            const char* a3 = a2 + kstep; const char* b3 = b2 + kstep;
            if (last && has_next) S.a_ready(nxt);
            if constexpr (SP2) {
            PG8_LDB(B0, 0, 0); PG8_LDB(B1, 0, 1); PG8_SCHED; PG8_LDA(At, 0, 0); PG8_STAGE(PG8_SA(1, 1), a1 + hA, voffA);
            PG8_WAIT_V(8); PG8_WAIT_L(0); PG8_BAR; PG8_MMA(0, 0, At, B0); PG8_MMA(0, 1, At, B1); PG8_BAR; PG8_SCHED;
            PG8_LDA(At, 0, 1); PG8_STAGE(PG8_SB(0, 0), b2, voffB); PG8_STAGE(PG8_SB(0, 1), b2 + hB, voffB); PG8_STAGE(PG8_SA(0, 0), a2, voffA);
            PG8_WAIT_V(8); PG8_WAIT_L(0); PG8_BAR; PG8_MMA(1, 0, At, B0); PG8_MMA(1, 1, At, B1); PG8_BAR; PG8_SCHED;
            PG8_LDB(B0, 1, 0); PG8_LDB(B1, 1, 1); PG8_SCHED; PG8_LDA(At, 1, 0); PG8_STAGE(PG8_SA(0, 1), a2 + hA, voffA);
            PG8_WAIT_V(8); PG8_WAIT_L(0); PG8_BAR; PG8_MMA(0, 0, At, B0); PG8_MMA(0, 1, At, B1); PG8_BAR; PG8_SCHED;
            PG8_LDA(At, 1, 1); PG8_STAGE(PG8_SB(1, 0), b3, voffB); PG8_STAGE(PG8_SB(1, 1), b3 + hB, voffB); PG8_STAGE(PG8_SA(1, 0), a3, voffA);
            PG8_WAIT_V(8); PG8_WAIT_L(0); PG8_BAR; PG8_MMA(1, 0, At, B0); PG8_MMA(1, 1, At, B1); PG8_BAR; PG8_SCHED;
            } else {
            PG8_LDB(B0, 0, 0); PG8_SCHED; PG8_LDA(At, 0, 0); PG8_STAGE(PG8_SA(1, 1), a1 + hA, voffA);
            PG8_WAIT_L(8); PG8_BAR; PG8_WAIT_L(0); PG8_MMA(0, 0, At, B0); PG8_BAR; PG8_SCHED;
            PG8_LDB(B1, 0, 1); PG8_STAGE(PG8_SB(0, 0), b2, voffB);
            PG8_BAR; PG8_WAIT_L(0); PG8_MMA(0, 1, At, B1); PG8_BAR;
            PG8_LDA(At, 0, 1); PG8_STAGE(PG8_SA(0, 0), a2, voffA);
            PG8_BAR; PG8_WAIT_L(0); PG8_MMA(1, 0, At, B0); PG8_BAR; PG8_SCHED;
            PG8_STAGE(PG8_SB(0, 1), b2 + hB, voffB);
            PG8_WAIT_V(6); PG8_BAR; PG8_MMA(1, 1, At, B1); PG8_BAR;
            PG8_LDB(B0, 1, 0); PG8_SCHED; PG8_LDA(At, 1, 0); PG8_STAGE(PG8_SA(0, 1), a2 + hA, voffA);
            PG8_WAIT_L(8); PG8_BAR; PG8_WAIT_L(0); PG8_MMA(0, 0, At, B0); PG8_BAR; PG8_SCHED;
            PG8_LDB(B1, 1, 1); PG8_STAGE(PG8_SB(1, 0), b3, voffB);
            PG8_BAR; PG8_WAIT_L(0); PG8_MMA(0, 1, At, B1); PG8_BAR;
            PG8_LDA(At, 1, 1); PG8_STAGE(PG8_SA(1, 0), a3, voffA);
            PG8_BAR; PG8_WAIT_L(0); PG8_MMA(1, 0, At, B0); PG8_BAR; PG8_SCHED;
            PG8_STAGE(PG8_SB(1, 1), b3 + hB, voffB);
            PG8_WAIT_V(6); PG8_BAR; PG8_MMA(1, 1, At, B1); PG8_BAR;
            }
        }
        if constexpr (ALIGN_EPI) { if (wr == 0) PG8_BAR; }
        if constexpr (!Epi::AFTER_DRAIN) { E(acc, cur, wr, wc, fr, fq); S.done(cur); }
        if (!has_next) break;
#pragma unroll
        for (int a = 0; a < 2; ++a)
#pragma unroll
            for (int b = 0; b < 2; ++b)
#pragma unroll
                for (int m = 0; m < 4; ++m)
#pragma unroll
                    for (int n = 0; n < 2; ++n) acc[a][b][m][n] = (f32x4){0.f, 0.f, 0.f, 0.f};
        cur = nxt; cA = nA; cB = nB; ++ui;
        if constexpr (ALIGN_EPI) { if (wr == 1) PG8_BAR; }
    }
    PG8_WAIT_V(0);
    if constexpr (!ALIGN_EPI) { if (wr == 0) PG8_BAR; }
    PG8_BAR;
    if constexpr (Epi::AFTER_DRAIN) { E.fused(acc, cur, wr, wc, fr, fq, lds, wid, lane); S.done(cur); }
#undef PG8_SA
#undef PG8_SB
#undef PG8_STAGE
#undef PG8_LDA
#undef PG8_LDB
#undef PG8_MMA
#undef PG8_WAIT_V
#undef PG8_WAIT_L
#undef PG8_BAR
#undef PG8_SCHED
}
}

namespace att {
using bf16_t = unsigned short;
using bf16x8 = __attribute__((ext_vector_type(8))) short;
using s16x4  = __attribute__((ext_vector_type(4))) short;
using f32x16 = __attribute__((ext_vector_type(16))) float;
using u32x4  = __attribute__((ext_vector_type(4))) unsigned;
using u32x2  = __attribute__((ext_vector_type(2))) unsigned;
constexpr int   D = 128, NW = 8, QBLK = 32, KVBLK = 64, NT = 4;
constexpr float SCALE = 0.088388347648318440f;
constexpr float THR = 8.f;
constexpr int   LDQ = 2048, LDK = 2048;
constexpr size_t SHM_V = KVBLK * D * 2, SHM_K = KVBLK * D * 2, SHM_ATTN = 2 * SHM_V + 2 * SHM_K;
#define KSWZ(row, colB) ((row) * 256 + ((colB) ^ (((row) & 7) << 4)))
#define SBAR() __builtin_amdgcn_sched_barrier(0)
__device__ __forceinline__ int crow(int r, int hi) { return (r & 3) + 8 * (r >> 2) + 4 * hi; }
__device__ __forceinline__ unsigned cvtpk(float lo, float hi) { unsigned r; asm volatile("v_cvt_pk_bf16_f32 %0, %1, %2" : "=v"(r) : "v"(lo), "v"(hi)); return r; }

__device__ __forceinline__ void partialSM(f32x16& p0, f32x16& p1, float& m_reg, float& mn, float& alpha) {
  constexpr float C = SCALE * 1.4426950408889634f;
  float pmax = p0[0];
#pragma unroll
  for (int r = 1; r < 16; ++r) pmax = fmaxf(pmax, p0[r]);
#pragma unroll
  for (int r = 0; r < 16; ++r) pmax = fmaxf(pmax, p1[r]);
  { auto rr = __builtin_amdgcn_permlane32_swap(__float_as_uint(pmax), __float_as_uint(pmax), false, false);
    pmax = fmaxf(__uint_as_float(rr[0]), __uint_as_float(rr[1])); }
  if (__builtin_expect(__all(pmax - m_reg <= THR / SCALE), 1)) { mn = m_reg; alpha = 1.f; }
  else { mn = fmaxf(m_reg, pmax); alpha = __builtin_amdgcn_exp2f((m_reg - mn) * C); m_reg = mn; }
  float mnC = -mn * C;
#pragma unroll
  for (int r = 0; r < 16; ++r) p0[r] = fmaf(p0[r], C, mnC);
#pragma unroll
  for (int r = 0; r < 16; ++r) p1[r] = fmaf(p1[r], C, mnC);
#pragma unroll
  for (int r = 0; r < 16; ++r) p0[r] = __builtin_amdgcn_exp2f(p0[r]);
}
__device__ __forceinline__ void finishSM(f32x16& p0, f32x16& p1, float alpha, float& l_reg, bf16x8& pa0, bf16x8& pa1, bf16x8& pa2, bf16x8& pa3) {
#pragma unroll
  for (int r = 0; r < 16; ++r) p1[r] = __builtin_amdgcn_exp2f(p1[r]);
  float ps = 0;
#pragma unroll
  for (int r = 0; r < 16; ++r) ps += p0[r];
#pragma unroll
  for (int r = 0; r < 16; ++r) ps += p1[r];
  { auto rr = __builtin_amdgcn_permlane32_swap(__float_as_uint(ps), __float_as_uint(ps), false, false);
    ps = __uint_as_float(rr[0]) + __uint_as_float(rr[1]); }
  l_reg = l_reg * alpha + ps;
#define PK4(P, BASE, OUT) do { unsigned a0 = cvtpk(P[BASE + 0], P[BASE + 1]), a1 = cvtpk(P[BASE + 2], P[BASE + 3]);   \
    unsigned b0 = cvtpk(P[BASE + 4], P[BASE + 5]), b1 = cvtpk(P[BASE + 6], P[BASE + 7]);                              \
    auto r0 = __builtin_amdgcn_permlane32_swap(a0, b0, false, false); auto r1 = __builtin_amdgcn_permlane32_swap(a1, b1, false, false); \
    u32x4 w = {r0[0], r1[0], r0[1], r1[1]}; OUT = *reinterpret_cast<bf16x8*>(&w); } while (0)
  PK4(p0, 0, pa0); PK4(p0, 8, pa1); PK4(p1, 0, pa2); PK4(p1, 8, pa3);
#undef PK4
}
__device__ __forceinline__ void qkt(f32x16& p0, f32x16& p1, const char* Ks, const bf16x8* qr, int r32, int hi) {
  p0 = f32x16{}; p1 = f32x16{};
#pragma unroll
  for (int d0 = 0; d0 < 8; ++d0) { int cb = (d0 * 16 + hi * 8) * 2;
    bf16x8 b0 = *reinterpret_cast<const bf16x8*>(Ks + KSWZ(r32, cb));
    bf16x8 b1 = *reinterpret_cast<const bf16x8*>(Ks + KSWZ(32 + r32, cb));
    p0 = __builtin_amdgcn_mfma_f32_32x32x16_bf16(b0, qr[d0], p0, 0, 0, 0);
    p1 = __builtin_amdgcn_mfma_f32_32x32x16_bf16(b1, qr[d0], p1, 0, 0, 0); }
}
__device__ __forceinline__ void cmask(f32x16& p0, f32x16& p1, int jt, int qloc, int hi) {
#pragma unroll
  for (int r = 0; r < 16; ++r) { const int key = 64 * jt + crow(r, hi); if (key > qloc) p0[r] = -1e30f; if (key + 32 > qloc) p1[r] = -1e30f; }
}
__device__ __forceinline__ int v_st(int k, int c) { const int kk = (k & ~0xC) | ((k & 4) << 1) | ((k & 8) >> 1); return ((kk >> 3) * 4 + (c >> 5)) * 512 + ((kk & 7) * 32 + (c & 31)) * 2; }
__device__ __forceinline__ int v_rd_base(int lane) { return ((lane & 3) << 3) | (((lane >> 2) & 3) << 6) | (((lane >> 4) & 1) << 5) | (((lane >> 5) & 1) << 8); }
constexpr int v_rd_off(int d0, int ks, int half) { return d0 * 512 + ks * 4096 + half * 2048; }
template <int OFF> __device__ __forceinline__ s16x4 tr_read(int vb) {
  s16x4 r; asm volatile("ds_read_b64_tr_b16 %0, %1 offset:%2" : "=&v"(r) : "v"(vb), "i"(OFF) : "memory"); return r;
}
template <int D0> __device__ __forceinline__ void pv_one(f32x16& od, int vb, bf16x8 pa0, bf16x8 pa1, bf16x8 pa2, bf16x8 pa3) {
  const s16x4 l0 = tr_read<v_rd_off(D0, 0, 0)>(vb), h0 = tr_read<v_rd_off(D0, 0, 1)>(vb), l1 = tr_read<v_rd_off(D0, 1, 0)>(vb), h1 = tr_read<v_rd_off(D0, 1, 1)>(vb);
  const s16x4 l2 = tr_read<v_rd_off(D0, 2, 0)>(vb), h2 = tr_read<v_rd_off(D0, 2, 1)>(vb), l3 = tr_read<v_rd_off(D0, 3, 0)>(vb), h3 = tr_read<v_rd_off(D0, 3, 1)>(vb);
  asm volatile("s_waitcnt lgkmcnt(0)" ::: "memory"); SBAR();
#define PK(L, H) (bf16x8){L[0], L[1], L[2], L[3], H[0], H[1], H[2], H[3]}
  od = __builtin_amdgcn_mfma_f32_32x32x16_bf16(PK(l0, h0), pa0, od, 0, 0, 0);
  od = __builtin_amdgcn_mfma_f32_32x32x16_bf16(PK(l1, h1), pa1, od, 0, 0, 0);
  od = __builtin_amdgcn_mfma_f32_32x32x16_bf16(PK(l2, h2), pa2, od, 0, 0, 0);
  od = __builtin_amdgcn_mfma_f32_32x32x16_bf16(PK(l3, h3), pa3, od, 0, 0, 0);
#undef PK
}
__device__ __forceinline__ void pv_d0(f32x16* o, int vb, bf16x8 pa0, bf16x8 pa1, bf16x8 pa2, bf16x8 pa3) {
  pv_one<0>(o[0], vb, pa0, pa1, pa2, pa3); pv_one<1>(o[1], vb, pa0, pa1, pa2, pa3); pv_one<2>(o[2], vb, pa0, pa1, pa2, pa3); pv_one<3>(o[3], vb, pa0, pa1, pa2, pa3);
}

__device__ __forceinline__ void attn_item(const bf16_t* __restrict__ Qrow, const bf16_t* __restrict__ Kh, const bf16_t* __restrict__ Vh, bool causal, int qloc,
                                          bf16_t* Orow, float2* MLrow, bool valid, char* lds) {
  const int tid = threadIdx.x, lane = tid & 63, r32 = lane & 31, hi = lane >> 5;
  char* V_lds = lds; char* K_lds = lds + 2 * SHM_V;
  float m_reg = -1e30f, l_reg = 0; f32x16 o[4] = {}; bf16x8 qr[8];
  const bf16_t* Qw = Qrow + hi * 8;
#pragma unroll
  for (int d0 = 0; d0 < 8; ++d0) qr[d0] = *reinterpret_cast<const bf16x8*>(Qw + d0 * 16);
  const int sr = tid >> 4, sc = (tid & 15) * 8, vst0 = v_st(sr, sc), vst1 = v_st(32 + sr, sc);
  const int vb0 = (int)(uintptr_t)V_lds + v_rd_base(lane);
  struct { bf16x8 vs0, vs1, ks0, ks1; } sr_[2];
#define SLOAD(i, k0) do { sr_[i].vs0 = *reinterpret_cast<const bf16x8*>(&Vh[(long)((k0) + sr) * LDK + sc]); sr_[i].vs1 = *reinterpret_cast<const bf16x8*>(&Vh[(long)((k0) + 32 + sr) * LDK + sc]); \
    sr_[i].ks0 = *reinterpret_cast<const bf16x8*>(&Kh[(long)((k0) + sr) * LDK + sc]); sr_[i].ks1 = *reinterpret_cast<const bf16x8*>(&Kh[(long)((k0) + 32 + sr) * LDK + sc]); } while (0)
#define SWRITE(b, i) do { *(bf16x8*)(V_lds + (b) * SHM_V + vst0) = sr_[i].vs0;          \
    *(bf16x8*)(V_lds + (b) * SHM_V + vst1) = sr_[i].vs1; int kc = sc * 2;               \
    *(bf16x8*)(K_lds + (b) * SHM_K + KSWZ(sr, kc)) = sr_[i].ks0;                       \
    *(bf16x8*)(K_lds + (b) * SHM_K + KSWZ(32 + sr, kc)) = sr_[i].ks1; } while (0)
#define SWAIT() asm volatile("s_waitcnt vmcnt(4)" ::: "memory")
#define RESC(a) do { if (__any((a) < 1.f)) { _Pragma("unroll") for (int d = 0; d < 4; ++d) _Pragma("unroll") for (int r = 0; r < 16; ++r) o[d][r] *= (a); } } while (0)
  f32x16 pA0, pA1, pB0, pB1; float mnA, mnB, alA, alB; bf16x8 pa0, pa1, pa2, pa3;
  constexpr int SE = 0, SO = 1;
  SLOAD(SE, 0); asm volatile("s_waitcnt vmcnt(0)" ::: "memory"); SWRITE(0, SE); __syncthreads();
  qkt(pA0, pA1, K_lds, qr, r32, hi); if (causal) cmask(pA0, pA1, 0, qloc, hi); partialSM(pA0, pA1, m_reg, mnA, alA);
  SLOAD(SO, KVBLK); SLOAD(SE, 2 * KVBLK);
  SWAIT(); SWRITE(1, SO); __syncthreads();
  {
    SBAR(); qkt(pB0, pB1, K_lds + SHM_K, qr, r32, hi); if (causal) cmask(pB0, pB1, 1, qloc, hi);
    finishSM(pA0, pA1, alA, l_reg, pa0, pa1, pa2, pa3); SBAR();
    SLOAD(SO, 3 * KVBLK); SBAR();
    pv_d0(o, vb0, pa0, pa1, pa2, pa3); partialSM(pB0, pB1, m_reg, mnB, alB);
    __syncthreads(); SWAIT(); SWRITE(0, SE);
    RESC(alB); __syncthreads();
    SBAR(); qkt(pA0, pA1, K_lds, qr, r32, hi); if (causal) cmask(pA0, pA1, 2, qloc, hi);
    finishSM(pB0, pB1, alB, l_reg, pa0, pa1, pa2, pa3); SBAR();
    pv_d0(o, vb0 + (int)SHM_V, pa0, pa1, pa2, pa3); partialSM(pA0, pA1, m_reg, mnA, alA);
    __syncthreads(); asm volatile("s_waitcnt vmcnt(0)" ::: "memory"); SWRITE(1, SO);
    RESC(alA); __syncthreads();
  }
  SBAR(); qkt(pB0, pB1, K_lds + SHM_K, qr, r32, hi); if (causal) cmask(pB0, pB1, 3, qloc, hi);
  finishSM(pA0, pA1, alA, l_reg, pa0, pa1, pa2, pa3); SBAR();
  pv_d0(o, vb0, pa0, pa1, pa2, pa3); partialSM(pB0, pB1, m_reg, mnB, alB);
  __syncthreads(); RESC(alB);
  finishSM(pB0, pB1, alB, l_reg, pa0, pa1, pa2, pa3); SBAR();
  pv_d0(o, vb0 + (int)SHM_V, pa0, pa1, pa2, pa3);
  const float rl = 1.0f / l_reg;
  if (valid) {
#pragma unroll
    for (int d0 = 0; d0 < 4; ++d0)
#pragma unroll
      for (int g = 0; g < 4; ++g) { u32x2 w; w.x = cvtpk(o[d0][4 * g] * rl, o[d0][4 * g + 1] * rl); w.y = cvtpk(o[d0][4 * g + 2] * rl, o[d0][4 * g + 3] * rl);
        *reinterpret_cast<u32x2*>(Orow + 32 * d0 + 8 * g + 4 * hi) = w; }
    if (hi == 0) *MLrow = make_float2(m_reg, l_reg);
  }
#undef SLOAD
#undef SWRITE
#undef SWAIT
#undef RESC
}
#undef KSWZ
#undef SBAR
}

constexpr int NWAVES = 8;
#ifndef MK_N_LAUNCHES
#define MK_N_LAUNCHES 1
#endif
constexpr int N_PHASES = 16;
constexpr int N_LAUNCHES = MK_N_LAUNCHES;

constexpr int BATCH = 2, SEQ = 8192, DM = 4096, M = BATCH * SEQ, MEMLEN = 256;
constexpr int PW = 2048, AW = 2048, NH = 16, HD = 128, NBLK = 32, MIXIN = 8192, FF = 11008, XH = 4, XHD = 1024;
constexpr float LN_EPS = 1e-5f;
constexpr float DN_ALPHA = 1.189207115002721f;

constexpr size_t MiB = 1u << 20;
constexpr size_t WS_CTL = 0, CTL_ZERO_BYTES = 1 * MiB;
constexpr size_t WS_ROPE = 1 * MiB;
constexpr size_t WS_KMH = 5 * MiB, WS_KML = 5 * MiB + 512 * 1024;
constexpr size_t WS_MEMB = 6 * MiB;
constexpr size_t WS_KVX = 10 * MiB;
constexpr size_t WS_LIST = 18 * MiB;
constexpr size_t WS_ML = 26 * MiB;
constexpr size_t WS_WIN = 34 * MiB, WS_WPOOL = 98 * MiB, WS_WOUT = 100 * MiB, WS_WXQ = 132 * MiB, WS_WXKV = 164 * MiB, WS_WXO = 228 * MiB, WS_WGU = 260 * MiB, WS_WDN = 432 * MiB;
constexpr size_t WS_ACT = 518 * MiB;
constexpr size_t WS_HP = WS_ACT, WS_Q = WS_ACT + 64 * MiB, WS_K = WS_ACT + 128 * MiB, WS_V = WS_ACT + 192 * MiB;
constexpr size_t WS_XB = WS_ACT + 256 * MiB;
constexpr size_t WS_PM = WS_ACT + 256 * MiB;
constexpr size_t WS_PARTO = WS_ACT + 256 * MiB;
constexpr size_t WS_CAT = WS_ACT + 512 * MiB;
constexpr size_t WS_HB = WS_ACT;
constexpr size_t WS_PB = WS_ACT + 256 * MiB;
constexpr size_t WS_G = WS_ACT + 128 * MiB;
constexpr size_t WS_SLAB = WS_ACT + 640 * MiB;
constexpr size_t WS_WQK = WS_SLAB, WS_WVOT = WS_SLAB + 16 * MiB;
constexpr size_t WS_STATS = WS_ML;
constexpr size_t WS_END = WS_ACT + 704 * MiB;
static_assert(WS_WDN + (size_t)DM * FF * 2 <= WS_ACT && WS_G + (size_t)M * FF * 2 <= WS_END && WS_WGU + (size_t)2 * FF * DM * 2 <= WS_WDN, "d_ws map");
constexpr int LIST_STRIDE = 256 * 496;
__host__ __device__ constexpr int list_off(int j) { return 256 * (31 * j - (j * (j - 1)) / 2); }
constexpr int CW_TMO = 0, CW_CODE = 1;
constexpr int CW_BAR = 4096;
constexpr int CW_GCNT = 8192;
constexpr int CW_CHK = 16384;

constexpr int RING_OFF = 0, RING_BYTES = 131072;
constexpr int LDSCTL_OFF = RING_BYTES, MISC_OFF = LDSCTL_OFF + 320;
constexpr int LDS_BYTES = 147456;

#define GAS __attribute__((address_space(1)))
#define LAS __attribute__((address_space(3)))
typedef unsigned short bf16;
typedef unsigned v4u __attribute__((ext_vector_type(4)));
typedef unsigned v2u __attribute__((ext_vector_type(2)));
typedef float f32x4 __attribute__((ext_vector_type(4)));
typedef short bf16x8 __attribute__((ext_vector_type(8)));
typedef float f32x16 __attribute__((ext_vector_type(16)));
typedef GAS unsigned gu32;
#define RLX_AGENT __ATOMIC_RELAXED, __HIP_MEMORY_SCOPE_AGENT
#define LDS_WAIT() asm volatile("s_waitcnt lgkmcnt(0)" ::: "memory")
#define VM_WAIT() asm volatile("s_waitcnt vmcnt(0)" ::: "memory")
__device__ __forceinline__ unsigned f2bf(float f) { unsigned u = __builtin_bit_cast(unsigned, f); return (u + 0x7fffu + ((u >> 16) & 1u)) >> 16; }
__device__ __forceinline__ unsigned pk2(float lo, float hi) { return f2bf(lo) | (f2bf(hi) << 16); }
__device__ __forceinline__ float bf_lo(unsigned w) { return __builtin_bit_cast(float, w << 16); }
__device__ __forceinline__ float bf_hi(unsigned w) { return __builtin_bit_cast(float, w & 0xffff0000u); }
__device__ __forceinline__ float bf2f(bf16 b) { return __builtin_bit_cast(float, ((unsigned)b) << 16); }
#define XB_TMO      128
#define XB_XCNT(j)  (256  + 64 * (j))
#define XB_XSUB(j)  (1280 + 64 * (j))
#define XB_XGEN(j)  (2304 + 64 * (j))
#define XB_TOP      3328
#define XB_TOPGEN   3392
#define XCD_BAR_WORDS 3456
#define XB_SPIN_CAP (1u << 18)

__device__ __forceinline__ unsigned xb_ld(unsigned* p)              { return __hip_atomic_load(p, __ATOMIC_RELAXED, __HIP_MEMORY_SCOPE_AGENT); }
__device__ __forceinline__ unsigned xb_add(unsigned* p, unsigned v) { return __hip_atomic_fetch_add(p, v, __ATOMIC_RELAXED, __HIP_MEMORY_SCOPE_AGENT); }
__device__ __forceinline__ unsigned xb_xcc_id() { return (unsigned)__builtin_amdgcn_s_getreg((3 << 11) | 20) & 0xFu; }
#define XB_SPIN(cond, bar) do { unsigned _sp = 0; while (cond) { __builtin_amdgcn_s_sleep(1); \
    if ((++_sp & 255u) == 0u) { if (xb_ld(&(bar)[XB_TMO])) break; if (_sp > XB_SPIN_CAP) { atomicAdd(&(bar)[XB_TMO], 1u); break; } } } } while (0)

struct XcdBarrier {
    unsigned* bar; unsigned x;
    volatile LAS unsigned* st;
};

__device__ __forceinline__ XcdBarrier xcd_barrier_post(unsigned* bar, volatile LAS unsigned* st) {
    XcdBarrier b; b.bar = bar; b.x = xb_xcc_id(); b.st = st;
    if (threadIdx.x == 0) (void)xb_add(&bar[XB_XCNT(b.x)], 1u);
    return b;
}
__device__ __forceinline__ void xcd_barrier_complete(unsigned* bar, unsigned x, unsigned& nloc, unsigned& nx) {
    const unsigned G = gridDim.x * gridDim.y * gridDim.z;
    unsigned sum, cnt, mine, sp = 0u;
    for (;;) {
        sum = 0u; cnt = 0u; mine = 0u;
#pragma unroll
        for (unsigned j = 0; j < 16; ++j) { const unsigned c = xb_ld(&bar[XB_XCNT(j)]); sum += c; cnt += (c > 0u) ? 1u : 0u; mine = (j == x) ? c : mine; }
        if (sum == G) break;
        __builtin_amdgcn_s_sleep(1);
        if ((++sp & 255u) == 0u) { if (xb_ld(&bar[XB_TMO])) break; if (sp > XB_SPIN_CAP) { atomicAdd(&bar[XB_TMO], 1u); break; } }
    }
    nloc = mine > 0u ? mine : 1u; nx = cnt > 0u ? cnt : 1u;
}

__device__ __forceinline__ void xcd_barrier(const XcdBarrier& b) {
    asm volatile("s_waitcnt vmcnt(0)" ::: "memory");
    __syncthreads();
    if (threadIdx.x == 0) {
        unsigned* bar = b.bar;
        __builtin_amdgcn_s_waitcnt(0);
        unsigned nloc = b.st[0], nx = b.st[1];
        if (nloc == 0u) { xcd_barrier_complete(bar, b.x, nloc, nx); b.st[0] = nloc; b.st[1] = nx; }
        const unsigned old = xb_add(&bar[XB_XSUB(b.x)], 1u);
        const unsigned gen = old / nloc;
        if (old + 1u == (gen + 1u) * nloc) {
            __builtin_amdgcn_fence(__ATOMIC_RELEASE, "agent");
            asm volatile("s_waitcnt vmcnt(0)" ::: "memory");
            const unsigned og = xb_add(&bar[XB_TOP], 1u);
            const unsigned tg = og / nx;
            if (og + 1u == (tg + 1u) * nx) xb_add(&bar[XB_TOPGEN], 1u);
            else XB_SPIN(xb_ld(&bar[XB_TOPGEN]) == tg, bar);
            __builtin_amdgcn_fence(__ATOMIC_ACQUIRE, "agent");
            xb_add(&bar[XB_XGEN(b.x)], 1u);
            asm volatile("s_waitcnt vmcnt(0)" ::: "memory");
        } else {
            XB_SPIN(xb_ld(&bar[XB_XGEN(b.x)]) == gen, bar);
            __builtin_amdgcn_fence(__ATOMIC_ACQUIRE, "agent");
            asm volatile("s_waitcnt vmcnt(0)" ::: "memory");
        }
    }
    __syncthreads();
}

struct Frame {
    LAS unsigned char* lds;
    volatile LAS unsigned* MISC;
    gu32* ctl;
    int tid, lane, wave;
    int G;
    unsigned char* ws;
};
__device__ __forceinline__ float wave_sum(float v) {
#pragma unroll
    for (int o = 1; o < 64; o <<= 1) v += __shfl_xor(v, o);
    return v;
}

template <class RowMap>
__device__ __forceinline__ void p0_transpose_item(const float* W, int K, int N, bf16* WT, LAS float* scr, int item, int lane, const RowMap& rm, const float* colscale) {
    const int nblk = N / 32, kb = item / nblk, nb = item % nblk, k0 = 64 * kb, n0 = 32 * nb;
    float ld[32];
    const float* src = W + (size_t)(k0 + (lane >> 5)) * N + n0 + (lane & 31);
#pragma unroll
    for (int i = 0; i < 32; ++i) ld[i] = *(const GAS float*)(src + (size_t)(2 * i) * N);
#pragma unroll
    for (int i = 0; i < 32; ++i) scr[(2 * i + (lane >> 5)) * 33 + (lane & 31)] = ld[i];
    LDS_WAIT(); asm volatile("" ::: "memory");
    const int c = lane & 7;
#pragma unroll
    for (int j = 0; j < 4; ++j) { const int n = (lane >> 3) + 8 * j; const LAS float* s = scr + (8 * c) * 33 + n; const float sc = colscale ? colscale[n0 + n] : 1.0f;
        v4u o; o.x = pk2(s[0 * 33] * sc, s[1 * 33] * sc); o.y = pk2(s[2 * 33] * sc, s[3 * 33] * sc); o.z = pk2(s[4 * 33] * sc, s[5 * 33] * sc); o.w = pk2(s[6 * 33] * sc, s[7 * 33] * sc);
        *(GAS v4u*)(WT + (size_t)rm(n0 + n) * K + k0 + 8 * c) = o; }
    LDS_WAIT(); asm volatile("" ::: "memory");
}
struct RmIdent { int off; __device__ __forceinline__ int operator()(int n) const { return off + n; } };
struct RmMixIn { __device__ __forceinline__ int operator()(int n) const { if (n < 2048 || n >= 6144) return n; const int d = n & 127; return (n & ~127) + 2 * (d & 63) + (d >> 6); } };
struct RmGateUp { int up; __device__ __forceinline__ int operator()(int n) const { return (n >> 7) * 256 + up * 128 + (n & 127); } };

__device__ __forceinline__ void sincos_d(double a, double& s, double& c) {
    const double n = __builtin_rint(a * 0.63661977236758134308);
    double r = __builtin_fma(-n, 1.5707963267948966, a); r = __builtin_fma(-n, 6.123233995736766e-17, r);
    const double r2 = r * r;
    double ps = -7.6471637318198164759e-13; ps = ps * r2 + 1.6059043836821614599e-10; ps = ps * r2 - 2.5052108385441718775e-08; ps = ps * r2 + 2.7557319223985890653e-06;
    ps = ps * r2 - 1.9841269841269841270e-04; ps = ps * r2 + 8.3333333333333333333e-03; ps = ps * r2 - 1.6666666666666666667e-01; ps = r + r * r2 * ps;
    double pc = 4.7794773323873852974e-14; pc = pc * r2 - 1.1470745597729724714e-11; pc = pc * r2 + 2.0876756987868098979e-09; pc = pc * r2 - 2.7557319223985890653e-07;
    pc = pc * r2 + 2.4801587301587301587e-05; pc = pc * r2 - 1.3888888888888888889e-03; pc = pc * r2 + 4.1666666666666666667e-02; pc = pc * r2 - 0.5; pc = 1.0 + r2 * pc;
    const int q = ((int)n) & 3;
    s = (q == 0) ? ps : (q == 1) ? pc : (q == 2) ? -ps : -pc;
    c = (q == 0) ? pc : (q == 1) ? -ps : (q == 2) ? -pc : ps;
}
__device__ __forceinline__ float rope_inv(int i) {
    const double y = -(double)i * (13.287712379549449 / 64.0); const double fl = __builtin_floor(y); const double z = (y - fl) * 0.69314718055994530942;
    double e = 1.0, term = 1.0;
#pragma unroll
    for (int k = 1; k <= 20; ++k) { term = term * z / (double)k; e += term; }
    return (float)__builtin_ldexp(e, (int)fl);
}

__device__ __forceinline__ void p0_prologue(Frame& F, const float* const* in) {
    LAS float* scr = (LAS float*)(F.lds + RING_OFF + F.wave * 16384);
    const int gw = blockIdx.x * NWAVES + F.wave, NGW = F.G * NWAVES;
    const float* w_mix_in = in[2]; const float* w_pool = in[3]; const float* pool_scale = in[4]; const float* w_mix_out = in[5];
    const float* w_xq = in[8]; const float* w_xkv = in[9]; const float* w_xo = in[10]; const float* w_gate = in[13]; const float* w_up = in[14]; const float* w_down = in[15];
    bf16* WIN = (bf16*)(F.ws + WS_WIN); bf16* WPOOL = (bf16*)(F.ws + WS_WPOOL); bf16* WOUT = (bf16*)(F.ws + WS_WOUT); bf16* WXQ = (bf16*)(F.ws + WS_WXQ);
    bf16* WXKV = (bf16*)(F.ws + WS_WXKV); bf16* WXO = (bf16*)(F.ws + WS_WXO); bf16* WGU = (bf16*)(F.ws + WS_WGU); bf16* WDN = (bf16*)(F.ws + WS_WDN);
    constexpr int I_IN = (DM / 64) * (MIXIN / 32), I_POOL = (512 / 64) * (512 / 32), I_SQ = (DM / 64) * (DM / 32), I_KV = (DM / 64) * (2 * DM / 32), I_GU = (DM / 64) * (FF / 32), I_DN = (FF / 64) * (DM / 32);
    constexpr int NITEMS = I_IN + 4 * I_POOL + 2 * I_SQ + I_KV + 2 * I_GU + I_DN;
    for (int it = gw; it < NITEMS; it += NGW) {
        int r = it;
        if (r < I_IN) { p0_transpose_item(w_mix_in, DM, MIXIN, WIN, scr, r, F.lane, RmMixIn{}, nullptr); continue; } r -= I_IN;
        if (r < 4 * I_POOL) { const int g = r / I_POOL; p0_transpose_item(w_pool + (size_t)g * 512 * 512, 512, 512, WPOOL, scr, r % I_POOL, F.lane, RmIdent{g * 512}, pool_scale + g * 512); continue; } r -= 4 * I_POOL;
        if (r < I_SQ) { p0_transpose_item(w_mix_out, DM, DM, WOUT, scr, r, F.lane, RmIdent{0}, nullptr); continue; } r -= I_SQ;
        if (r < I_KV) { p0_transpose_item(w_xkv, DM, 2 * DM, WXKV, scr, r, F.lane, RmIdent{0}, nullptr); continue; } r -= I_KV;
        if (r < I_SQ) { p0_transpose_item(w_xo, DM, DM, WXO, scr, r, F.lane, RmIdent{0}, nullptr); continue; } r -= I_SQ;
        if (r < I_GU) { p0_transpose_item(w_gate, DM, FF, WGU, scr, r, F.lane, RmGateUp{0}, nullptr); continue; } r -= I_GU;
        if (r < I_GU) { p0_transpose_item(w_up, DM, FF, WGU, scr, r, F.lane, RmGateUp{1}, nullptr); continue; } r -= I_GU;
        p0_transpose_item(w_down, FF, DM, WDN, scr, r, F.lane, RmIdent{0}, nullptr);
    }
    const size_t gt = (size_t)blockIdx.x * (NWAVES * 64) + F.tid, NT = (size_t)F.G * NWAVES * 64;
    { const float* x = in[0]; bf16* XB = (bf16*)(F.ws + WS_XB);
      for (size_t i = gt; i < (size_t)M * DM / 8; i += NT) { const f32x4 a = *(const GAS f32x4*)(x + i * 8), b = *(const GAS f32x4*)(x + i * 8 + 4);
          v4u o; o.x = pk2(a.x, a.y); o.y = pk2(a.z, a.w); o.z = pk2(b.x, b.y); o.w = pk2(b.z, b.w); *(GAS v4u*)(XB + i * 8) = o; } }
    { const float* x = w_xq; bf16* XB = WXQ;
      for (size_t i = gt; i < (size_t)DM * DM / 8; i += NT) { const f32x4 a = *(const GAS f32x4*)(x + i * 8), b = *(const GAS f32x4*)(x + i * 8 + 4);
          v4u o; o.x = pk2(a.x, a.y); o.y = pk2(a.z, a.w); o.z = pk2(b.x, b.y); o.w = pk2(b.z, b.w); *(GAS v4u*)(XB + i * 8) = o; } }
    { const float* x = in[1]; bf16* XB = (bf16*)(F.ws + WS_MEMB);
      for (size_t i = gt; i < (size_t)BATCH * MEMLEN * DM / 8; i += NT) { const f32x4 a = *(const GAS f32x4*)(x + i * 8), b = *(const GAS f32x4*)(x + i * 8 + 4);
          v4u o; o.x = pk2(a.x, a.y); o.y = pk2(a.z, a.w); o.z = pk2(b.x, b.y); o.w = pk2(b.z, b.w); *(GAS v4u*)(XB + i * 8) = o; } }
    { float2* tab = (float2*)(F.ws + WS_ROPE);
      for (size_t i = gt; i < (size_t)SEQ * 64; i += NT) { const int pos = (int)(i >> 6), fi = (int)(i & 63); const float ang = (float)pos * rope_inv(fi);
          double s, c; sincos_d((double)ang, s, c); tab[i] = make_float2((float)c, (float)s); } }
}

template <bool WRITE_F32>
__device__ __forceinline__ void ln_rows(Frame& F, float* X, bf16* XB, float2* stats, const float* g, const float* b) {
    const int gw = blockIdx.x * NWAVES + F.wave, NGW = F.G * NWAVES;
    for (int m = gw; m < M; m += NGW) {
        GAS f32x4* xr = (GAS f32x4*)(X + (size_t)m * DM) + F.lane;
        f32x4 v[16]; float s = 0.f;
#pragma unroll
        for (int j = 0; j < 16; ++j) { v[j] = xr[64 * j]; s += (v[j].x + v[j].y) + (v[j].z + v[j].w); }
        const float mean = wave_sum(s) * (1.f / DM); float s2 = 0.f;
#pragma unroll
        for (int j = 0; j < 16; ++j) { v[j] = v[j] - mean; s2 += (v[j].x * v[j].x + v[j].y * v[j].y) + (v[j].z * v[j].z + v[j].w * v[j].w); }
        const float rstd = 1.f / sqrtf(wave_sum(s2) * (1.f / DM) + LN_EPS);
        if (stats && F.lane == 0) stats[m] = make_float2(mean, rstd);
#pragma unroll
        for (int j = 0; j < 16; ++j) { const f32x4 gg = ((const GAS f32x4*)g)[64 * j + F.lane], bb = ((const GAS f32x4*)b)[64 * j + F.lane];
            const f32x4 y = (v[j] * rstd) * gg + bb; if (WRITE_F32) xr[64 * j] = y;
            if (XB) { v2u o; o.x = pk2(y.x, y.y); o.y = pk2(y.z, y.w); ((GAS v2u*)(XB + (size_t)m * DM))[64 * j + F.lane] = o; } }
    }
}

__device__ __forceinline__ void up8(const v4u& r, float (&f)[8]) { f[0] = bf_lo(r.x); f[1] = bf_hi(r.x); f[2] = bf_lo(r.y); f[3] = bf_hi(r.y); f[4] = bf_lo(r.z); f[5] = bf_hi(r.z); f[6] = bf_lo(r.w); f[7] = bf_hi(r.w); }
template <int W>
__device__ __forceinline__ void pool_run(const bf16* HP, bf16* PMo, int t0, int c) {
    const int tp0 = t0 & (SEQ - 1);
    v4u raw[16 + W - 1];
#pragma unroll
    for (int j = 0; j < 16 + W - 1; ++j) { const int dt = j - (W - 1); raw[j] = (v4u){0u, 0u, 0u, 0u}; if (tp0 + dt >= 0) raw[j] = *(const GAS v4u*)(HP + (size_t)(t0 + dt) * PW + c); }
    float S[8], u[8];
#pragma unroll
    for (int e = 0; e < 8; ++e) S[e] = 0.f;
#pragma unroll
    for (int j = 0; j < W - 1; ++j) { up8(raw[j], u);
#pragma unroll
        for (int e = 0; e < 8; ++e) S[e] += u[e]; }
#pragma unroll
    for (int i = 0; i < 16; ++i) {
        up8(raw[W - 1 + i], u);
#pragma unroll
        for (int e = 0; e < 8; ++e) S[e] += u[e];
        const int tp = tp0 + i; const float inv = (tp + 1 < W) ? 1.0f / (float)(tp + 1) : 1.0f / (float)W;
        v4u o; o.x = pk2(S[0] * inv - u[0], S[1] * inv - u[1]); o.y = pk2(S[2] * inv - u[2], S[3] * inv - u[3]);
        o.z = pk2(S[4] * inv - u[4], S[5] * inv - u[5]); o.w = pk2(S[6] * inv - u[6], S[7] * inv - u[7]);
        *(GAS v4u*)(PMo + (size_t)(t0 + i) * PW + c) = o;
        float d[8]; up8(raw[i], d);
#pragma unroll
        for (int e = 0; e < 8; ++e) S[e] -= d[e];
    }
}
__device__ __forceinline__ void pool_ew(Frame& F) {
    const bf16* HP = (const bf16*)(F.ws + WS_HP); bf16* PMo = (bf16*)(F.ws + WS_PM);
    const size_t gt = (size_t)blockIdx.x * (NWAVES * 64) + F.tid, NT = (size_t)F.G * NWAVES * 64;
    for (size_t idx = gt; idx < (size_t)(M / 16) * 256; idx += NT) {
        const int t0 = (int)(idx >> 8) * 16, c = (int)(idx & 255) * 8, grp = __builtin_amdgcn_readfirstlane(c >> 9);
        if (grp == 0) pool_run<2>(HP, PMo, t0, c); else if (grp == 1) pool_run<4>(HP, PMo, t0, c); else if (grp == 2) pool_run<8>(HP, PMo, t0, c); else pool_run<16>(HP, PMo, t0, c);
    }
}
__device__ __forceinline__ void kv_reduce(Frame& F) {
    const float* SK = (const float*)(F.ws + WS_SLAB); bf16* KVX = (bf16*)(F.ws + WS_KVX);
    const size_t gt = (size_t)blockIdx.x * (NWAVES * 64) + F.tid, NT = (size_t)F.G * NWAVES * 64, NE = (size_t)512 * 8192;
    for (size_t i = gt; i < NE / 4; i += NT) { const float* sb = SK + i * 4;
        const f32x4 a = *(const GAS f32x4*)sb + *(const GAS f32x4*)(sb + NE) + *(const GAS f32x4*)(sb + 2 * NE) + *(const GAS f32x4*)(sb + 3 * NE);
        v2u o; o.x = pk2(a.x, a.y); o.y = pk2(a.z, a.w); *(GAS v2u*)(KVX + i * 4) = o; }
}

__device__ __forceinline__ void kmean_phase(Frame& F) {
    const bf16* Kb = (const bf16*)(F.ws + WS_K); bf16* KMH = (bf16*)(F.ws + WS_KMH); bf16* KML = (bf16*)(F.ws + WS_KML);
    LAS float* part = (LAS float*)(F.lds + RING_OFF);
    for (int item = blockIdx.x; item < 64 * 4; item += F.G) {
        const int bn = item >> 2, chunk = item & 3;
        float acc[8];
#pragma unroll
        for (int e = 0; e < 8; ++e) acc[e] = 0.f;
        const bf16* base = Kb + (size_t)(bn * 256 + F.wave * 32) * AW + chunk * 512 + F.lane * 8;
#pragma unroll
        for (int r = 0; r < 32; ++r) { const v4u q = *(const GAS v4u*)(base + (size_t)r * AW);
            acc[0] += bf_lo(q.x); acc[1] += bf_hi(q.x); acc[2] += bf_lo(q.y); acc[3] += bf_hi(q.y); acc[4] += bf_lo(q.z); acc[5] += bf_hi(q.z); acc[6] += bf_lo(q.w); acc[7] += bf_hi(q.w); }
#pragma unroll
        for (int e = 0; e < 8; ++e) part[F.wave * 512 + F.lane * 8 + e] = acc[e];
        __syncthreads();
        { float s = 0.f;
#pragma unroll
          for (int w = 0; w < 8; ++w) s += part[w * 512 + F.tid];
          const float mean = s * (1.0f / 256.0f); const unsigned hb = f2bf(mean); const float hf = __builtin_bit_cast(float, hb << 16);
          KMH[(size_t)bn * AW + chunk * 512 + F.tid] = (bf16)hb; KML[(size_t)bn * AW + chunk * 512 + F.tid] = (bf16)f2bf(mean - hf); }
        __syncthreads();
    }
}

__device__ __forceinline__ void gate_phase(Frame& F) {
    const bf16* Qb = (const bf16*)(F.ws + WS_Q); const bf16* KMH = (const bf16*)(F.ws + WS_KMH); const bf16* KML = (const bf16*)(F.ws + WS_KML);
    unsigned short* lists = (unsigned short*)(F.ws + WS_LIST); gu32* gcnt = F.ctl + CW_GCNT;
    LAS float* gl = (LAS float*)(F.lds + RING_OFF);
    LAS unsigned* lcnt = (LAS unsigned*)(F.lds + RING_OFF + 34816);
    LAS unsigned* gb = lcnt + 32;
    const int r32 = F.lane & 31, hi = F.lane >> 5;
    for (int uid = blockIdx.x; uid < 1024; uid += F.G) {
        const int bh = uid >> 5, qb = uid & 31, b = bh >> 4, h = bh & 15;
        if (qb == 0) continue;
        if (F.tid < 32) lcnt[F.tid] = 0u;
        const size_t trow = (size_t)b * SEQ + 256 * qb + 32 * F.wave + r32;
        f32x16 acc = {};
#pragma unroll
        for (int s = 0; s < 8; ++s) {
            const bf16x8 bq = *(const GAS bf16x8*)(Qb + trow * AW + h * HD + 16 * s + 8 * hi);
            const bf16x8 ah = *(const GAS bf16x8*)(KMH + (size_t)(b * 32 + r32) * AW + h * HD + 16 * s + 8 * hi);
            const bf16x8 al = *(const GAS bf16x8*)(KML + (size_t)(b * 32 + r32) * AW + h * HD + 16 * s + 8 * hi);
            acc = __builtin_amdgcn_mfma_f32_32x32x16_bf16(ah, bq, acc, 0, 0, 0);
            acc = __builtin_amdgcn_mfma_f32_32x32x16_bf16(al, bq, acc, 0, 0, 0);
        }
#pragma unroll
        for (int r = 0; r < 16; ++r) gl[(32 * F.wave + r32) * 33 + att::crow(r, hi)] = acc[r];
        __syncthreads();
        int s0 = 0, s1 = 0, s2 = 0; unsigned p0 = 0, p1 = 0, p2 = 0; const int nsel = qb < 3 ? qb : 3;
        if (F.tid < 256) {
            float v0 = -__builtin_inff(), v1 = v0, v2 = v0;
            for (int n = 0; n < qb; ++n) { const float g = gl[F.tid * 33 + n];
                if (g > v0) { v2 = v1; s2 = s1; v1 = v0; s1 = s0; v0 = g; s0 = n; }
                else if (g > v1) { v2 = v1; s2 = s1; v1 = g; s1 = n; }
                else if (g > v2) { v2 = g; s2 = n; } }
            p0 = __hip_atomic_fetch_add(lcnt + s0, 1u, __ATOMIC_RELAXED, __HIP_MEMORY_SCOPE_WORKGROUP);
            if (nsel > 1) p1 = __hip_atomic_fetch_add(lcnt + s1, 1u, __ATOMIC_RELAXED, __HIP_MEMORY_SCOPE_WORKGROUP);
            if (nsel > 2) p2 = __hip_atomic_fetch_add(lcnt + s2, 1u, __ATOMIC_RELAXED, __HIP_MEMORY_SCOPE_WORKGROUP);
        }
        __syncthreads();
        if (F.tid < 32) { const unsigned c = lcnt[F.tid]; gb[F.tid] = c ? __hip_atomic_fetch_add(gcnt + bh * 32 + F.tid, c, RLX_AGENT) : 0u; }
        __syncthreads();
        if (F.tid < 256) {
            unsigned short* lb = lists + (size_t)bh * LIST_STRIDE; const unsigned tl = (unsigned)(256 * qb + F.tid);
            lb[list_off(s0) + gb[s0] + p0] = (unsigned short)(tl | (0u << 13));
            if (nsel > 1) lb[list_off(s1) + gb[s1] + p1] = (unsigned short)(tl | (1u << 13));
            if (nsel > 2) lb[list_off(s2) + gb[s2] + p2] = (unsigned short)(tl | (2u << 13));
        }
        __syncthreads();
    }
}

__device__ __forceinline__ void attn_phase(Frame& F, char* ldsg) {
    const bf16* Qb = (const bf16*)(F.ws + WS_Q); const bf16* Kb = (const bf16*)(F.ws + WS_K); const bf16* Vb = (const bf16*)(F.ws + WS_V);
    bf16* PO = (bf16*)(F.ws + WS_PARTO); float2* ML = (float2*)(F.ws + WS_ML);
    const unsigned short* lists = (const unsigned short*)(F.ws + WS_LIST); const gu32* gcnt = F.ctl + CW_GCNT;
    LAS int* pre = (LAS int*)(F.lds + RING_OFF + 67584);
    for (int i = F.tid; i < 1024; i += NWAVES * 64) pre[i] = (int)((__hip_atomic_load(gcnt + i, RLX_AGENT) + 255u) >> 8);
    __syncthreads();
    if (F.wave == 0) {
        int loc[16]; int s = 0;
#pragma unroll
        for (int k = 0; k < 16; ++k) { loc[k] = pre[F.lane * 16 + k]; s += loc[k]; }
        int incl = s;
#pragma unroll
        for (int o = 1; o < 64; o <<= 1) { const int v = __shfl_up(incl, o); if (F.lane >= o) incl += v; }
        int run = incl - s;
#pragma unroll
        for (int k = 0; k < 16; ++k) { pre[F.lane * 16 + k] = run; run += loc[k]; }
        if (F.lane == 63) pre[1024] = incl;
    }
    __syncthreads();
    const int total = 1024 + pre[1024];
    const int r32 = F.lane & 31, rloc = 32 * F.wave + r32;
    for (int id = blockIdx.x; id < total; id += F.G) {
        int bh, j, t, slot; bool causal, valid;
        if (id < 1024) { bh = id >> 5; j = id & 31; causal = true; valid = true; t = 256 * j + rloc; slot = 3; }
        else {
            const int x = id - 1024; int lo = 0, hi2 = 1023;
            while (lo < hi2) { const int mid = (lo + hi2 + 1) >> 1; if (pre[mid] <= x) lo = mid; else hi2 = mid - 1; }
            const int li = lo, chunk = x - pre[li]; bh = li >> 5; j = li & 31; causal = false;
            const int cnt = (int)__hip_atomic_load(gcnt + li, RLX_AGENT) - 256 * chunk;
            valid = rloc < cnt;
            const unsigned e = lists[(size_t)bh * LIST_STRIDE + list_off(j) + 256 * chunk + (valid ? rloc : 0)];
            t = (int)(e & 8191u); slot = (int)(e >> 13);
        }
        const int b = bh >> 4, h = bh & 15;
        const bf16* Qrow = Qb + ((size_t)b * SEQ + t) * AW + h * HD;
        const bf16* Kh = Kb + ((size_t)b * SEQ + 256 * j) * AW + h * HD; const bf16* Vh = Vb + ((size_t)b * SEQ + 256 * j) * AW + h * HD;
        bf16* Orow = PO + (((size_t)slot * 32 + bh) * SEQ + t) * HD; float2* MLrow = ML + ((size_t)slot * 32 + bh) * SEQ + t;
        att::attn_item(Qrow, Kh, Vh, causal, rloc, Orow, MLrow, valid, ldsg);
    }
}

__device__ __forceinline__ void combine_phase(Frame& F) {
    const bf16* PO = (const bf16*)(F.ws + WS_PARTO); const float2* ML = (const float2*)(F.ws + WS_ML); bf16* CAT = (bf16*)(F.ws + WS_CAT);
    constexpr float C = att::SCALE * 1.4426950408889634f;
    const size_t gt = (size_t)blockIdx.x * (NWAVES * 64) + F.tid, NT = (size_t)F.G * NWAVES * 64;
    for (size_t idx = gt; idx < (size_t)32 * SEQ * 16; idx += NT) {
        const int dc = (int)(idx & 15), t = (int)((idx >> 4) & (SEQ - 1)), bh = (int)(idx >> 17), qb = t >> 8, nsel = qb < 3 ? qb : 3;
        float2 ml[4]; float mx;
        ml[3] = ML[((size_t)3 * 32 + bh) * SEQ + t]; mx = ml[3].x;
#pragma unroll
        for (int k = 0; k < 3; ++k) { if (k < nsel) { ml[k] = ML[((size_t)k * 32 + bh) * SEQ + t]; mx = fmaxf(mx, ml[k].x); } else ml[k] = make_float2(0.f, 0.f); }
        float acc[8]; float wsum = 0.f;
#pragma unroll
        for (int e = 0; e < 8; ++e) acc[e] = 0.f;
#pragma unroll
        for (int k = 0; k < 4; ++k) { if (k == 3 || k < nsel) {
            const float w = ml[k].y * __builtin_amdgcn_exp2f((ml[k].x - mx) * C); wsum += w;
            const v4u r = *(const GAS v4u*)(PO + (((size_t)k * 32 + bh) * SEQ + t) * HD + dc * 8);
            acc[0] += w * bf_lo(r.x); acc[1] += w * bf_hi(r.x); acc[2] += w * bf_lo(r.y); acc[3] += w * bf_hi(r.y);
            acc[4] += w * bf_lo(r.z); acc[5] += w * bf_hi(r.z); acc[6] += w * bf_lo(r.w); acc[7] += w * bf_hi(r.w); } }
        const float inv = 1.0f / wsum; const int b = bh >> 4, h = bh & 15;
        v4u o; o.x = pk2(acc[0] * inv, acc[1] * inv); o.y = pk2(acc[2] * inv, acc[3] * inv); o.z = pk2(acc[4] * inv, acc[5] * inv); o.w = pk2(acc[6] * inv, acc[7] * inv);
        *(GAS v4u*)(CAT + ((size_t)b * SEQ + t) * DM + PW + h * HD + dc * 8) = o;
    }
}

struct Args { const float* in[18]; float* out; unsigned char* ws; int ph_lo, ph_hi, li, pad; };
__global__ void __launch_bounds__(NWAVES * 64, 2) mega_fwd(Args args) {
    extern __shared__ __attribute__((aligned(16))) unsigned char lds[];
    Frame F;
    F.lds = (LAS unsigned char*)lds;
    F.MISC = (volatile LAS unsigned*)(F.lds + MISC_OFF);
    F.tid = threadIdx.x; F.lane = F.tid & 63; F.wave = __builtin_amdgcn_readfirstlane(F.tid >> 6);
    F.G = gridDim.x; F.ws = args.ws;
    F.ctl = (gu32*)(args.ws + WS_CTL);
    for (int u = F.tid; u < (LDS_BYTES - LDSCTL_OFF) / 4; u += NWAVES * 64) ((LAS unsigned*)(F.lds + LDSCTL_OFF))[u] = 0u;
    __syncthreads();
    XcdBarrier bar; bar.bar = (unsigned*)(F.ctl + CW_BAR); bar.x = 0; bar.st = nullptr;
    if (N_LAUNCHES == 1) bar = xcd_barrier_post((unsigned*)(F.ctl + CW_BAR), F.MISC + 8);
#define GRID_BAR() do { if (N_LAUNCHES == 1) xcd_barrier(bar); } while (0)
    const int lo = args.ph_lo, hi = args.ph_hi;
#define IN(k) (lo <= (k) && (k) < hi)
#define BOTH(k) (IN(k) && IN((k) + 1))
#ifndef PROBE_DUP
#define PROBE_DUP 0
#endif
#define DUPON(k) ((PROBE_DUP >> (k)) & 1)
#define REP(k) for (int _rep = 0; _rep < (DUPON(k) ? 2 : 1); ++_rep)
    unsigned char* ws = args.ws;
    const int G = F.G, cid = (int)blockIdx.x;
    float* out = args.out;

    if (IN(0)) { REP(0) { p0_prologue(F, args.in); } if (BOTH(0)) GRID_BAR(); }

    if (IN(1)) {
        { pg8::GemmKV g{(const char*)(ws + WS_MEMB), (const char*)(ws + WS_WXKV), DM, DM, 1024};
          pg8::OrderKV S{G, cid}; pg8::EpiSlabKV E{(float*)(ws + WS_SLAB)};
          pg8::gemm_phase<pg8::EpiSlabKV, pg8::OrderKV, true, true, pg8::GemmKV>(F.lds + RING_OFF, g, S, E); if (DUPON(16)) { pg8::gemm_phase<pg8::EpiSlabKV, pg8::OrderKV, true, true, pg8::GemmKV>(F.lds + RING_OFF, g, S, E); } }
        { pg8::Gemm g = pg8::make_gemm(ws + WS_XB, DM, ws + WS_WIN, DM, DM); pg8::StaticOrder S; S.init(M, MIXIN, G, cid);
          pg8::EpiMixIn E{(pg8::bf16_t*)(ws + WS_HP), (size_t)M * 2048, (const float*)(ws + WS_ROPE)};
          pg8::gemm_phase<pg8::EpiMixIn, pg8::StaticOrder, true, true>(F.lds + RING_OFF, g, S, E); if (DUPON(1)) { pg8::gemm_phase<pg8::EpiMixIn, pg8::StaticOrder, true, true>(F.lds + RING_OFF, g, S, E); } }
        if (BOTH(1)) GRID_BAR();
    }

    if (IN(2)) { REP(2) { pool_ew(F); kmean_phase(F); kv_reduce(F); } if (BOTH(2)) GRID_BAR(); }

    if (IN(3)) {
        { pg8::Gemm g = pg8::make_gemm(ws + WS_PM, PW, ws + WS_WPOOL, 512, 512); g.a_pn = 512 * 2; g.a_pn_sh = 1; pg8::StaticOrder S; S.init(M, PW, G, cid);
          pg8::EpiStore E{(pg8::bf16_t*)(ws + WS_CAT), DM, 0};
          pg8::gemm_phase<pg8::EpiStore, pg8::StaticOrder, true, true>(F.lds + RING_OFF, g, S, E); if (DUPON(3)) { pg8::gemm_phase<pg8::EpiStore, pg8::StaticOrder, true, true>(F.lds + RING_OFF, g, S, E); } }
        if (G == 256) { pg8::GemmAbs g{(const char*)(ws + WS_KVX), (const char*)(ws + WS_WXQ), (const char*)(ws + WS_WXO), cid < 128 ? 8192 : 4096, cid < 128 ? 4096 : 8192, 1024};
          pg8::OrderAbs S{cid}; pg8::EpiStoreAbs E{(pg8::bf16_t*)(ws + WS_WQK), (pg8::bf16_t*)(ws + WS_WVOT)};
          pg8::gemm_phase<pg8::EpiStoreAbs, pg8::OrderAbs, true, true, pg8::GemmAbs>(F.lds + RING_OFF, g, S, E); if (DUPON(17)) { pg8::gemm_phase<pg8::EpiStoreAbs, pg8::OrderAbs, true, true, pg8::GemmAbs>(F.lds + RING_OFF, g, S, E); } }
        gate_phase(F);
        if (BOTH(3)) GRID_BAR();
    }

    if (IN(4)) { REP(4) { attn_phase(F, (char*)lds + RING_OFF); __syncthreads(); } if (BOTH(4)) GRID_BAR(); }

    if (IN(5)) { REP(5) { combine_phase(F); } if (BOTH(5)) GRID_BAR(); }

    if (IN(6)) {
        pg8::Gemm g = pg8::make_gemm(ws + WS_CAT, DM, ws + WS_WOUT, DM, DM); pg8::StaticOrder S; S.init(M, DM, G, cid);
        pg8::EpiResid E{args.in[0], out, DM, DN_ALPHA};
        pg8::gemm_phase<pg8::EpiResid, pg8::StaticOrder, true, true>(F.lds + RING_OFF, g, S, E); if (DUPON(6)) { pg8::gemm_phase<pg8::EpiResid, pg8::StaticOrder, true, true>(F.lds + RING_OFF, g, S, E); }
        if (BOTH(6)) GRID_BAR();
    }
    if (IN(7)) { ln_rows<false>(F, out, (bf16*)(ws + WS_HB), (float2*)(ws + WS_STATS), args.in[6], args.in[7]); if (BOTH(7)) GRID_BAR(); }

    if (IN(9)) {
        if (G == 256) {
            pg8::Gemm g = pg8::make_gemm(ws + WS_HB, DM, ws + WS_WQK, DM, DM); g.b_pm = (size_t)1024 * DM * 2; g.b_pm_sh = 5;
            pg8::StaticOrder S; S.init(M, XH * 256, G, cid);
            pg8::EpiSoftmax E{(pg8::bf16_t*)(ws + WS_PB), XH * MEMLEN, 0.03125f * 1.4426950408889634f};
            pg8::gemm_phase<pg8::EpiSoftmax, pg8::StaticOrder, false, true>(F.lds + RING_OFF, g, S, E); if (DUPON(9)) { pg8::gemm_phase<pg8::EpiSoftmax, pg8::StaticOrder, false, true>(F.lds + RING_OFF, g, S, E); }
        }
        if (BOTH(9)) GRID_BAR();
    }
    if (IN(11)) {
        pg8::Gemm g = pg8::make_gemm(ws + WS_PB, XH * MEMLEN, ws + WS_WVOT, 2048, XH * MEMLEN); g.b_pm = (size_t)1024 * 2; g.b_pm_sh = 5;
        pg8::StaticOrder S; S.init(M, DM, G, cid);
        pg8::EpiResidLN E{out, (const pg8::f32x2*)(ws + WS_STATS), 6};
        pg8::gemm_phase<pg8::EpiResidLN, pg8::StaticOrder, true, true>(F.lds + RING_OFF, g, S, E);
        if (BOTH(11)) GRID_BAR();
    }
    if (IN(12)) { ln_rows<false>(F, out, (bf16*)(ws + WS_HB), (float2*)(ws + WS_STATS), args.in[11], args.in[12]); if (BOTH(12)) GRID_BAR(); }

    if (IN(13)) {
        pg8::Gemm g = pg8::make_gemm(ws + WS_HB, DM, ws + WS_WGU, DM, DM); pg8::StaticOrder S; S.init(M, 2 * FF, G, cid);
        pg8::EpiSwiGLU E{(pg8::bf16_t*)(ws + WS_G), FF};
        pg8::gemm_phase<pg8::EpiSwiGLU, pg8::StaticOrder, true, true>(F.lds + RING_OFF, g, S, E); if (DUPON(13)) { pg8::gemm_phase<pg8::EpiSwiGLU, pg8::StaticOrder, true, true>(F.lds + RING_OFF, g, S, E); }
        if (BOTH(13)) GRID_BAR();
    }
    if (IN(14)) {
        pg8::Gemm g = pg8::make_gemm(ws + WS_G, FF, ws + WS_WDN, FF, FF); pg8::StaticOrder S; S.init(M, DM, G, cid);
        pg8::EpiResidLN E{out, (const pg8::f32x2*)(ws + WS_STATS), 11};
        pg8::gemm_phase<pg8::EpiResidLN, pg8::StaticOrder, true, true>(F.lds + RING_OFF, g, S, E);
        if (BOTH(14)) GRID_BAR();
    }
    if (IN(15)) { ln_rows<true>(F, out, nullptr, nullptr, args.in[16], args.in[17]); }
#undef IN
#undef BOTH
#undef GRID_BAR
}

extern "C" void kernel_launch(void* const* d_in, const int* in_sizes, int n_in, void* d_out, int out_size, void* d_ws, size_t ws_size, hipStream_t stream) {
    static int grid = 0;
    if (grid == 0) {
        if (n_in != 18 || in_sizes[0] != M * DM || out_size != M * DM || ws_size < WS_END) { fprintf(stderr, "kernel_launch: shape / workspace mismatch (n_in %d, in0 %d, out %d, ws %zu, need %zu)\n", n_in, n_in > 0 ? in_sizes[0] : -1, out_size, ws_size, (size_t)WS_END); grid = -1; return; }
        int dev = 0, cus = 0, per_cu = 0;
        if (hipGetDevice(&dev) != hipSuccess || hipDeviceGetAttribute(&cus, hipDeviceAttributeMultiprocessorCount, dev) != hipSuccess) { grid = -1; return; }
        if (hipFuncSetAttribute((const void*)mega_fwd, hipFuncAttributeMaxDynamicSharedMemorySize, LDS_BYTES) != hipSuccess) { fprintf(stderr, "kernel_launch: hipFuncSetAttribute failed\n"); grid = -1; return; }
        if (hipOccupancyMaxActiveBlocksPerMultiprocessor(&per_cu, (const void*)mega_fwd, NWAVES * 64, LDS_BYTES) != hipSuccess || per_cu < 1)
            fprintf(stderr, "kernel_launch: note: occupancy query reports %d workgroups per CU\n", per_cu);
        (void)hipGetLastError();
        grid = cus;
        if (grid != 256) fprintf(stderr, "kernel_launch: %d CUs; the cross-attention score phase needs a 256-workgroup grid\n", grid);
    }
    if (grid < 0) return;
    if (hipMemsetAsync((char*)d_ws + WS_CTL, 0, CTL_ZERO_BYTES, stream) != hipSuccess) return;
    Args a{};
    for (int i = 0; i < 18; ++i) a.in[i] = (const float*)d_in[i];
    a.out = (float*)d_out; a.ws = (unsigned char*)d_ws; a.pad = 0;
    for (int li = 0; li < N_LAUNCHES; ++li) {
        a.ph_lo = (N_LAUNCHES == 1) ? 0 : li; a.ph_hi = (N_LAUNCHES == 1) ? N_PHASES : li + 1; a.li = li;
        hipLaunchKernelGGL(mega_fwd, dim3(grid), dim3(NWAVES * 64), LDS_BYTES, stream, a);
        if (hipPeekAtLastError() != hipSuccess) { fprintf(stderr, "kernel_launch: launch %d failed\n", li); break; }
    }
}
```

```cpp
#include <hip/hip_runtime.h>
#include <cstdio>
#include <cstdint>

namespace pg8 {
#define PG8_LAS __attribute__((address_space(3)))
typedef unsigned short bf16_t;
typedef short bf16x8 __attribute__((ext_vector_type(8)));
typedef float f32x4 __attribute__((ext_vector_type(4)));
typedef float f32x2 __attribute__((ext_vector_type(2)));
typedef unsigned u32x4 __attribute__((ext_vector_type(4)));
typedef unsigned u32x2 __attribute__((ext_vector_type(2)));
constexpr int BM = 256, BK = 64, HALF = 128, HTB = HALF * BK * 2  , STAGE_BYTES = 8 * HTB, NXCD = 8, WGM = 8;

__host__ __device__ __forceinline__ int lds_byte(int r, int c) { const int st = (r >> 4) * 2 + (c >> 5), rr = r & 15, cc = c & 31, ob = rr * 64 + cc * 2; return st * 1024 + (ob ^ (((ob >> 9) & 1) << 5)); }
__host__ __device__ __forceinline__ void stage_rc(int b, int& R, int& C) { const int st = b / 1024, sb = b % 1024, swz = sb ^ (((sb >> 9) & 1) << 5); R = (st >> 1) * 16 + swz / 64; C = (st & 1) * 32 + (swz % 64) / 2; }
__host__ __device__ __forceinline__ int perm32(int rho) { const int n = rho >> 4, i = rho & 15; return 8 * (i >> 2) + 4 * n + (i & 3); }

struct Unit { int pm, pn, pz; };
struct Gemm {
    const char* A; const char* B; int lda, ldb, K;
    size_t a_pm, a_pn; int a_pn_sh; size_t b_pn, b_pm; int b_pm_sh;
    __device__ __forceinline__ const char* a_ptr(const Unit& u) const { return A + (size_t)u.pm * a_pm + (size_t)(u.pn >> a_pn_sh) * a_pn; }
    __device__ __forceinline__ const char* b_ptr(const Unit& u) const { return B + (size_t)u.pn * b_pn + (size_t)(u.pm >> b_pm_sh) * b_pm; }
};
__device__ __forceinline__ Gemm make_gemm(const void* A, int lda, const void* B, int ldb, int K) {
    Gemm g; g.A = (const char*)A; g.B = (const char*)B; g.lda = lda; g.ldb = ldb; g.K = K;
    g.a_pm = (size_t)BM * lda * 2; g.a_pn = 0; g.a_pn_sh = 0; g.b_pn = (size_t)BM * ldb * 2; g.b_pm = 0; g.b_pm_sh = 0; return g;
}

struct StaticOrder {
    int nM, nN, nwg, G, c;
    __host__ __device__ void init(int M, int N, int G_, int c_) { nM = M / BM; nN = N / BM; nwg = nM * nN; G = G_; c = c_; }
    __host__ __device__ bool next(int i, Unit& u) const {
        const long L = (long)i * G + c; if (L >= nwg) return false;
        int wgid = (int)L; { const int q = nwg / NXCD, r = nwg % NXCD, xcd = wgid % NXCD, off = wgid / NXCD; wgid = (xcd < r ? xcd * (q + 1) : r * (q + 1) + (xcd - r) * q) + off; }
        const int nig = WGM * nN, gid = wgid / nig, fm = gid * WGM, gsz = (nM - fm) < WGM ? (nM - fm) : WGM;
        u.pm = fm + ((wgid % nig) % gsz); u.pn = (wgid % nig) / gsz; u.pz = 0; return true;
    }
    __device__ __forceinline__ void a_ready(const Unit&) const {}
    __device__ __forceinline__ void done(const Unit&) const {}
};

__device__ __forceinline__ unsigned cvt_pk_bf16(float lo, float hi) { unsigned r; asm volatile("v_cvt_pk_bf16_f32 %0, %1, %2" : "=v"(r) : "v"(lo), "v"(hi)); return r; }

struct EpiMixIn {
    static constexpr bool PERM = true, AFTER_DRAIN = false;
    bf16_t* base; size_t tstride; const float* rope;
    __device__ __forceinline__ void operator()(const f32x4 (&acc)[2][2][4][2], const Unit& u, int wr, int wc, int fr, int fq) const {
        const int t = u.pn >> 3; const bool rp = (t == 1) || (t == 2);
        bf16_t* ob = base + (size_t)t * tstride;
        const int row0 = u.pm * BM + wr * 64 + fr, col0 = (u.pn & 7) * BM + wc * 32 + 8 * fq;
#pragma unroll
        for (int ai = 0; ai < 2; ++ai)
#pragma unroll
            for (int m = 0; m < 4; ++m) {
                const int row = row0 + ai * HALF + m * 16; bf16_t* rowp = ob + (size_t)row * 2048 + col0;
                f32x4 cs0 = (f32x4){1.f, 0.f, 1.f, 0.f}, cs1 = cs0;
                if (rp) { const f32x4* tp = (const f32x4*)(rope + ((size_t)(row & 8191) * 64 + wc * 16 + fq * 4) * 2); cs0 = tp[0]; cs1 = tp[1]; }
#pragma unroll
                for (int bj = 0; bj < 2; ++bj) {
                    const f32x4 v0 = acc[ai][bj][m][0], v1 = acc[ai][bj][m][1];
                    const float a0 = v0[0] * cs0[0] - v0[1] * cs0[1], a1 = v0[1] * cs0[0] + v0[0] * cs0[1];
                    const float a2 = v0[2] * cs0[2] - v0[3] * cs0[3], a3 = v0[3] * cs0[2] + v0[2] * cs0[3];
                    const float b0 = v1[0] * cs1[0] - v1[1] * cs1[1], b1 = v1[1] * cs1[0] + v1[0] * cs1[1];
                    const float b2 = v1[2] * cs1[2] - v1[3] * cs1[3], b3 = v1[3] * cs1[2] + v1[2] * cs1[3];
                    u32x4 w; w.x = cvt_pk_bf16(a0, a1); w.y = cvt_pk_bf16(a2, a3); w.z = cvt_pk_bf16(b0, b1); w.w = cvt_pk_bf16(b2, b3);
                    *(u32x4*)(rowp + bj * HALF) = w;
                }
            }
    }
};
struct EpiStore {
    static constexpr bool PERM = true, AFTER_DRAIN = false;
    bf16_t* O; int ldc, coff;
    __device__ __forceinline__ void operator()(const f32x4 (&acc)[2][2][4][2], const Unit& u, int wr, int wc, int fr, int fq) const {
        const int row0 = u.pm * BM + wr * 64 + fr, col0 = coff + u.pn * BM + wc * 32 + 8 * fq;
#pragma unroll
        for (int ai = 0; ai < 2; ++ai)
#pragma unroll
            for (int m = 0; m < 4; ++m) { bf16_t* rowp = O + (size_t)(row0 + ai * HALF + m * 16) * ldc + col0;
#pragma unroll
                for (int bj = 0; bj < 2; ++bj) { const f32x4 v0 = acc[ai][bj][m][0], v1 = acc[ai][bj][m][1];
                    u32x4 w; w.x = cvt_pk_bf16(v0[0], v0[1]); w.y = cvt_pk_bf16(v0[2], v0[3]); w.z = cvt_pk_bf16(v1[0], v1[1]); w.w = cvt_pk_bf16(v1[2], v1[3]);
                    *(u32x4*)(rowp + bj * HALF) = w; } }
    }
};
struct EpiResid {
    static constexpr bool PERM = false, AFTER_DRAIN = false;
    const float* res; float* out; int ldc; float alpha;
    __device__ __forceinline__ void operator()(const f32x4 (&acc)[2][2][4][2], const Unit& u, int wr, int wc, int fr, int fq) const {
        const int row0 = u.pm * BM + wr * 64 + fr, col0 = u.pn * BM + wc * 32 + 4 * fq;
#pragma unroll
        for (int ai = 0; ai < 2; ++ai)
#pragma unroll
            for (int m = 0; m < 4; ++m) { const size_t off = (size_t)(row0 + ai * HALF + m * 16) * ldc + col0;
#pragma unroll
                for (int bj = 0; bj < 2; ++bj)
#pragma unroll
                    for (int n = 0; n < 2; ++n) { const f32x4 r = *(const f32x4*)(res + off + bj * HALF + n * 16); *(f32x4*)(out + off + bj * HALF + n * 16) = r * alpha + acc[ai][bj][m][n]; }
                asm volatile("" ::: "memory"); }
    }
};
struct EpiSwiGLU {
    static constexpr bool PERM = true, AFTER_DRAIN = false;
    bf16_t* G; int ldc;
    __device__ __forceinline__ float act(float g, float u) const { return g * u * __builtin_amdgcn_rcpf(1.0f + __builtin_amdgcn_exp2f(-1.4426950408889634f * g)); }
    __device__ __forceinline__ void operator()(const f32x4 (&acc)[2][2][4][2], const Unit& u, int wr, int wc, int fr, int fq) const {
        const int row0 = u.pm * BM + wr * 64 + fr, col0 = u.pn * HALF + wc * 32 + 8 * fq;
#pragma unroll
        for (int ai = 0; ai < 2; ++ai)
#pragma unroll
            for (int m = 0; m < 4; ++m) { bf16_t* rowp = G + (size_t)(row0 + ai * HALF + m * 16) * ldc + col0;
                const f32x4 g0 = acc[ai][0][m][0], g1 = acc[ai][0][m][1], u0 = acc[ai][1][m][0], u1 = acc[ai][1][m][1];
                u32x4 w; w.x = cvt_pk_bf16(act(g0[0], u0[0]), act(g0[1], u0[1])); w.y = cvt_pk_bf16(act(g0[2], u0[2]), act(g0[3], u0[3]));
                w.z = cvt_pk_bf16(act(g1[0], u1[0]), act(g1[1], u1[1])); w.w = cvt_pk_bf16(act(g1[2], u1[2]), act(g1[3], u1[3]));
                *(u32x4*)rowp = w; }
    }
};
struct EpiSoftmax {
    static constexpr bool PERM = true, AFTER_DRAIN = true;
    bf16_t* P; int ldc; float c2;
    __device__ __forceinline__ void fused(f32x4 (&acc)[2][2][4][2], const Unit& u, int wr, int wc, int fr, int fq, PG8_LAS unsigned char* lds, int wid, int lane) const {
        PG8_LAS float* T1 = (PG8_LAS float*)lds;
        PG8_LAS float* T2 = (PG8_LAS float*)(lds + 4096);
#pragma unroll
        for (int ai = 0; ai < 2; ++ai)
#pragma unroll
            for (int m = 0; m < 4; ++m) { float mx = -3.0e38f;
#pragma unroll
                for (int bj = 0; bj < 2; ++bj)
#pragma unroll
                    for (int n = 0; n < 2; ++n) { const f32x4 x = acc[ai][bj][m][n]; mx = fmaxf(mx, fmaxf(fmaxf(x[0], x[1]), fmaxf(x[2], x[3]))); }
                mx = fmaxf(mx, __shfl_xor(mx, 16)); mx = fmaxf(mx, __shfl_xor(mx, 32));
                if (fq == 0) T1[(ai * HALF + wr * 64 + m * 16 + fr) * 4 + wc] = mx; }
        asm volatile("s_waitcnt lgkmcnt(0)" ::: "memory"); __builtin_amdgcn_s_barrier(); asm volatile("" ::: "memory");
#pragma unroll
        for (int ai = 0; ai < 2; ++ai)
#pragma unroll
            for (int m = 0; m < 4; ++m) { const int r = ai * HALF + wr * 64 + m * 16 + fr;
                const f32x4 t = *(const PG8_LAS f32x4*)(T1 + r * 4); const float mx = fmaxf(fmaxf(t[0], t[1]), fmaxf(t[2], t[3])) * c2; float s = 0.f;
#pragma unroll
                for (int bj = 0; bj < 2; ++bj)
#pragma unroll
                    for (int n = 0; n < 2; ++n) { f32x4 x = acc[ai][bj][m][n];
#pragma unroll
                        for (int e = 0; e < 4; ++e) { x[e] = __builtin_amdgcn_exp2f(x[e] * c2 - mx); s += x[e]; }
                        acc[ai][bj][m][n] = x; }
                s += __shfl_xor(s, 16); s += __shfl_xor(s, 32);
                if (fq == 0) T2[r * 4 + wc] = s; }
        asm volatile("s_waitcnt lgkmcnt(0)" ::: "memory"); __builtin_amdgcn_s_barrier(); asm volatile("" ::: "memory");
        const int row0 = u.pm * BM + wr * 64 + fr, col0 = u.pn * BM + wc * 32 + 8 * fq;
#pragma unroll
        for (int ai = 0; ai < 2; ++ai)
#pragma unroll
            for (int m = 0; m < 4; ++m) { const int r = ai * HALF + wr * 64 + m * 16 + fr;
                const f32x4 t = *(const PG8_LAS f32x4*)(T2 + r * 4); const float inv = 1.0f / ((t[0] + t[1]) + (t[2] + t[3]));
                bf16_t* rowp = P + (size_t)(row0 + ai * HALF + m * 16) * ldc + col0;
#pragma unroll
                for (int bj = 0; bj < 2; ++bj) { const f32x4 v0 = acc[ai][bj][m][0] * inv, v1 = acc[ai][bj][m][1] * inv;
                    u32x4 w; w.x = cvt_pk_bf16(v0[0], v0[1]); w.y = cvt_pk_bf16(v0[2], v0[3]); w.z = cvt_pk_bf16(v1[0], v1[1]); w.w = cvt_pk_bf16(v1[2], v1[3]);
                    *(u32x4*)(rowp + bj * HALF) = w; } }
    }
};

struct GemmKV {
    const char* memb; const char* wkv; int lda, ldb, K;
    __device__ __forceinline__ const char* a_ptr(const Unit& u) const { return memb + (size_t)u.pm * (BM * 4096 * 2) + (size_t)u.pz * 2048; }
    __device__ __forceinline__ const char* b_ptr(const Unit& u) const { return wkv + (size_t)u.pn * (BM * 4096 * 2) + (size_t)u.pz * 2048; }
};
struct OrderKV {
    int G, c;
    __device__ __forceinline__ bool next(int i, Unit& u) const { const int L = i * G + c; if (L >= 256) return false; const int tile = L >> 2; u.pz = L & 3; u.pm = tile >> 5; u.pn = tile & 31; return true; }
    __device__ __forceinline__ void a_ready(const Unit&) const {}
    __device__ __forceinline__ void done(const Unit&) const {}
};
struct EpiSlabKV {
    static constexpr bool PERM = false, AFTER_DRAIN = false;
    float* S;
    __device__ __forceinline__ void operator()(const f32x4 (&acc)[2][2][4][2], const Unit& u, int wr, int wc, int fr, int fq) const {
        float* C = S + (size_t)u.pz * (512 * 8192);
        const int row0 = u.pm * BM + wr * 64 + fr, col0 = u.pn * BM + wc * 32 + 4 * fq;
#pragma unroll
        for (int ai = 0; ai < 2; ++ai)
#pragma unroll
            for (int m = 0; m < 4; ++m) { float* rowp = C + (size_t)(row0 + ai * HALF + m * 16) * 8192 + col0;
#pragma unroll
                for (int bj = 0; bj < 2; ++bj)
#pragma unroll
                    for (int n = 0; n < 2; ++n) *(f32x4*)(rowp + bj * HALF + n * 16) = acc[ai][bj][m][n]; }
    }
};
struct GemmAbs {
    const char* kvx; const char* wq_raw; const char* wo_t; int lda, ldb, K;
    __device__ __forceinline__ const char* a_ptr(const Unit& u) const {
        return u.pz ? wo_t + (size_t)u.pm * (BM * 4096 * 2) + (size_t)(u.pn & 3) * 2048
                    : kvx + (size_t)(u.pm >> 2) * (BM * 8192 * 2) + (size_t)(u.pm & 3) * 2048; }
    __device__ __forceinline__ const char* b_ptr(const Unit& u) const {
        return u.pz ? kvx + 8192 + (size_t)(u.pn >> 2) * (BM * 8192 * 2) + (size_t)(u.pn & 3) * 2048
                    : wq_raw + (size_t)u.pn * (BM * 4096 * 2) + (size_t)(u.pm & 3) * 2048; }
};
struct OrderAbs {
    int c;
    __device__ __forceinline__ bool next(int i, Unit& u) const { if (i != 0 || c >= 256) return false; if (c < 128) { u.pz = 0; u.pm = c >> 4; u.pn = c & 15; } else { const int t = c - 128; u.pz = 1; u.pm = t >> 3; u.pn = t & 7; } return true; }
    __device__ __forceinline__ void a_ready(const Unit&) const {}
    __device__ __forceinline__ void done(const Unit&) const {}
};
struct EpiStoreAbs {
    static constexpr bool PERM = true, AFTER_DRAIN = false;
    bf16_t* WQK; bf16_t* WVOT;
    __device__ __forceinline__ void operator()(const f32x4 (&acc)[2][2][4][2], const Unit& u, int wr, int wc, int fr, int fq) const {
        bf16_t* O = u.pz ? WVOT : WQK; const int ldc = u.pz ? 2048 : 4096;
        const int row0 = u.pm * BM + wr * 64 + fr, col0 = u.pn * BM + wc * 32 + 8 * fq;
#pragma unroll
        for (int ai = 0; ai < 2; ++ai)
#pragma unroll
            for (int m = 0; m < 4; ++m) { bf16_t* rowp = O + (size_t)(row0 + ai * HALF + m * 16) * ldc + col0;
#pragma unroll
                for (int bj = 0; bj < 2; ++bj) { const f32x4 v0 = acc[ai][bj][m][0], v1 = acc[ai][bj][m][1];
                    u32x4 w; w.x = cvt_pk_bf16(v0[0], v0[1]); w.y = cvt_pk_bf16(v0[2], v0[3]); w.z = cvt_pk_bf16(v1[0], v1[1]); w.w = cvt_pk_bf16(v1[2], v1[3]);
                    *(u32x4*)(rowp + bj * HALF) = w; } }
    }
};
struct EpiResidLN {
    static constexpr bool PERM = false, AFTER_DRAIN = false;
    float* T; const f32x2* stats; int gi;
    __device__ __forceinline__ void operator()(const f32x4 (&acc)[2][2][4][2], const Unit& u, int wr, int wc, int fr, int fq) const {
        constexpr int ldc = 4096; constexpr float alpha = 1.189207115002721f;
        const float* const __attribute__((address_space(4)))* inp = (const float* const __attribute__((address_space(4)))*)__builtin_amdgcn_kernarg_segment_ptr();
        const float* g = inp[gi]; const float* b = inp[gi + 1];
        const int row0 = u.pm * BM + wr * 64 + fr, col0 = u.pn * BM + wc * 32 + 4 * fq;
        f32x4 gv[2][2], bv[2][2];
#pragma unroll
        for (int bj = 0; bj < 2; ++bj)
#pragma unroll
            for (int n = 0; n < 2; ++n) { gv[bj][n] = *(const f32x4*)(g + col0 + bj * HALF + n * 16) * alpha; bv[bj][n] = *(const f32x4*)(b + col0 + bj * HALF + n * 16) * alpha; }
#pragma unroll
        for (int ai = 0; ai < 2; ++ai)
#pragma unroll
            for (int m = 0; m < 4; ++m) { const int row = row0 + ai * HALF + m * 16; const size_t off = (size_t)row * ldc + col0; const f32x2 st = stats[row];
#pragma unroll
                for (int bj = 0; bj < 2; ++bj)
#pragma unroll
                    for (int n = 0; n < 2; ++n) { const f32x4 r = *(const f32x4*)(T + off + bj * HALF + n * 16);
                        *(f32x4*)(T + off + bj * HALF + n * 16) = ((r - st.x) * st.y) * gv[bj][n] + bv[bj][n] + acc[ai][bj][m][n]; }
                asm volatile("" ::: "memory"); }
    }
};

template <class Epi, class Sched, bool ALIGN_EPI = false, bool SP2 = false, class GT = Gemm>
__device__ __forceinline__ void gemm_phase(PG8_LAS unsigned char* lds, const GT g, const Sched& S, const Epi& E) {
    const int tid = threadIdx.x, wid = __builtin_amdgcn_readfirstlane(tid >> 6), lane = tid & 63, wr = wid >> 2, wc = wid & 3, fr = lane & 15, fq = lane >> 4;
    const int K = g.K, nt = K / BK;
    unsigned voffA[2], voffB[2];
#pragma unroll
    for (int i = 0; i < 2; ++i) { int R, C; stage_rc(tid * 16 + i * 8192, R, C); const int Rb = Epi::PERM ? ((R & ~31) + perm32(R & 31)) : R;
        voffA[i] = (unsigned)(R * g.lda + C) * 2u; voffB[i] = (unsigned)(Rb * g.ldb + C) * 2u; }
    const size_t kstep = (size_t)(BK * 2);
    const size_t hA = (size_t)HALF * g.lda * 2, hB = (size_t)HALF * g.ldb * 2;
    const unsigned ldsw = (unsigned)wid * 1024u;
    const int aoff = lds_byte(wr * 64 + fr, fq * 8), boff = lds_byte(wc * 32 + fr, fq * 8);
#define PG8_SA(b, h) (((b) * 2 + (h)) * HTB)
#define PG8_SB(b, h) ((4 + (b) * 2 + (h)) * HTB)
#define PG8_STAGE(bufoff, gbase, voff) do { _Pragma("unroll") for (int _i = 0; _i < 2; ++_i) \
        __builtin_amdgcn_global_load_lds((const unsigned*)((const char*)(gbase) + (voff)[_i]), (PG8_LAS unsigned*)(lds + (bufoff) + ldsw + _i * 8192), 16, 0, 0); } while (0)
#define PG8_LDA(dst, b, h) do { _Pragma("unroll") for (int m = 0; m < 4; ++m) _Pragma("unroll") for (int k = 0; k < 2; ++k) dst[m][k] = *(const PG8_LAS bf16x8*)(lds + PG8_SA(b, h) + aoff + m * 2048 + k * 1024); } while (0)
#define PG8_LDB(dst, b, h) do { _Pragma("unroll") for (int n = 0; n < 2; ++n) _Pragma("unroll") for (int k = 0; k < 2; ++k) dst[n][k] = *(const PG8_LAS bf16x8*)(lds + PG8_SB(b, h) + boff + n * 2048 + k * 1024); } while (0)
#define PG8_MMA(ai, bj, At, Bt) do { __builtin_amdgcn_s_setprio(1); _Pragma("unroll") for (int m = 0; m < 4; ++m) _Pragma("unroll") for (int n = 0; n < 2; ++n) _Pragma("unroll") for (int k = 0; k < 2; ++k) \
        acc[ai][bj][m][n] = __builtin_amdgcn_mfma_f32_16x16x32_bf16(Bt[n][k], At[m][k], acc[ai][bj][m][n], 0, 0, 0); __builtin_amdgcn_s_setprio(0); } while (0)
#define PG8_WAIT_V(n) asm volatile("s_waitcnt vmcnt(" #n ")" ::: "memory")
#define PG8_WAIT_L(n) asm volatile("s_waitcnt lgkmcnt(" #n ")" ::: "memory")
#define PG8_BAR __builtin_amdgcn_s_barrier()
#define PG8_SCHED __builtin_amdgcn_sched_barrier(0)
    Unit cur, nxt; int ui = 0;
    if (!S.next(0, cur)) return;
    f32x4 acc[2][2][4][2];
#pragma unroll
    for (int a = 0; a < 2; ++a)
#pragma unroll
        for (int b = 0; b < 2; ++b)
#pragma unroll
            for (int m = 0; m < 4; ++m)
#pragma unroll
                for (int n = 0; n < 2; ++n) acc[a][b][m][n] = (f32x4){0.f, 0.f, 0.f, 0.f};
    bf16x8 At[4][2], B0[2][2], B1[2][2];
    const char* cA = g.a_ptr(cur); const char* cB = g.b_ptr(cur);
    S.a_ready(cur);
    if constexpr (SP2) {
        PG8_STAGE(PG8_SB(0, 0), cB, voffB); PG8_STAGE(PG8_SB(0, 1), cB + hB, voffB); PG8_STAGE(PG8_SA(0, 0), cA, voffA); PG8_STAGE(PG8_SA(0, 1), cA + hA, voffA);
        if (wr == 1) PG8_BAR;
        PG8_WAIT_V(2); PG8_BAR;
        PG8_STAGE(PG8_SB(1, 0), cB + kstep, voffB); PG8_STAGE(PG8_SA(1, 0), cA + kstep, voffA); PG8_STAGE(PG8_SB(1, 1), cB + hB + kstep, voffB);
        PG8_WAIT_V(6); PG8_BAR;
    } else {
        PG8_STAGE(PG8_SB(0, 0), cB, voffB); PG8_STAGE(PG8_SA(0, 0), cA, voffA); PG8_STAGE(PG8_SB(0, 1), cB + hB, voffB); PG8_STAGE(PG8_SA(0, 1), cA + hA, voffA);
        if (wr == 1) PG8_BAR;
        PG8_WAIT_V(4); PG8_BAR;
        PG8_STAGE(PG8_SB(1, 0), cB + kstep, voffB); PG8_STAGE(PG8_SA(1, 0), cA + kstep, voffA); PG8_STAGE(PG8_SB(1, 1), cB + hB + kstep, voffB);
        PG8_WAIT_V(6); PG8_BAR;
    }
    for (;;) {
        const bool has_next = S.next(ui + 1, nxt);
        const char* nA = has_next ? g.a_ptr(nxt) : cA; const char* nB = has_next ? g.b_ptr(nxt) : cB;
        for (int t = 0; t < nt; t += 2) {
            const bool last = (t == nt - 2);
            const char* a1 = cA + (size_t)(t + 1) * kstep;
            const char* a2 = last ? nA : cA + (size_t)(t + 2) * kstep; const char* b2 = last ? nB : cB + (size_t)(t + 2) * kstep;
            const char* a3 = a2 + kstep; const char* b3 = b2 + kstep;
            if (last && has_next) S.a_ready(nxt);
            if constexpr (SP2) {
            PG8_LDB(B0, 0, 0); PG8_LDB(B1, 0, 1); PG8_SCHED; PG8_LDA(At, 0, 0); PG8_STAGE(PG8_SA(1, 1), a1 + hA, voffA);
            PG8_WAIT_V(8); PG8_WAIT_L(0); PG8_BAR; PG8_MMA(0, 0, At, B0); PG8_MMA(0, 1, At, B1); PG8_BAR; PG8_SCHED;
            PG8_LDA(At, 0, 1); PG8_STAGE(PG8_SB(0, 0), b2, voffB); PG8_STAGE(PG8_SB(0, 1), b2 + hB, voffB); PG8_STAGE(PG8_SA(0, 0), a2, voffA);
            PG8_WAIT_V(8); PG8_WAIT_L(0); PG8_BAR; PG8_MMA(1, 0, At, B0); PG8_MMA(1, 1, At, B1); PG8_BAR; PG8_SCHED;
            PG8_LDB(B0, 1, 0); PG8_LDB(B1, 1, 1); PG8_SCHED; PG8_LDA(At, 1, 0); PG8_STAGE(PG8_SA(0, 1), a2 + hA, voffA);
            PG8_WAIT_V(8); PG8_WAIT_L(0); PG8_BAR; PG8_MMA(0, 0, At, B0); PG8_MMA(0, 1, At, B1); PG8_BAR; PG8_SCHED;
            PG8_LDA(At, 1, 1); PG8_STAGE(PG8_SB(1, 0), b3, voffB); PG8_STAGE(PG8_SB(1, 1), b3 + hB, voffB); PG8_STAGE(PG8_SA(1, 0), a3, voffA);
            PG8_WAIT_V(8); PG8_WAIT_L(0); PG8_BAR; PG8_MMA(1, 0, At, B0); PG8_MMA(1, 1, At, B1); PG8_BAR; PG8_SCHED;
            } else {
            PG8_LDB(B0, 0, 0); PG8_SCHED; PG8_LDA(At, 0, 0); PG8_STAGE(PG8_SA(1, 1), a1 + hA, voffA);
            PG8_WAIT_L(8); PG8_BAR; PG8_WAIT_L(0); PG8_MMA(0, 0, At, B0); PG8_BAR; PG8_SCHED;
            PG8_LDB(B1, 0, 1); PG8_STAGE(PG8_SB(0, 0), b2, voffB);
            PG8_BAR; PG8_WAIT_L(0); PG8_MMA(0, 1, At, B1); PG8_BAR;
            PG8_LDA(At, 0, 1); PG8_STAGE(PG8_SA(0, 0), a2, voffA);
            PG8_BAR; PG8_WAIT_L(0); PG8_MMA(1, 0, At, B0); PG8_BAR; PG8_SCHED;
            PG8_STAGE(PG8_SB(0, 1), b2 + hB, voffB);
            PG8_WAIT_V(6); PG8_BAR; PG8_MMA(1, 1, At, B1); PG8_BAR;
            PG8_LDB(B0, 1, 0); PG8_SCHED; PG8_LDA(At, 1, 0); PG8_STAGE(PG8_SA(0, 1), a2 + hA, voffA);
            PG8_WAIT_L(8); PG8_BAR; PG8_WAIT_L(0); PG8_MMA(0, 0, At, B0); PG8_BAR; PG8_SCHED;
            PG8_LDB(B1, 1, 1); PG8_STAGE(PG8_SB(1, 0), b3, voffB);
            PG8_BAR; PG8_WAIT_L(0); PG8_MMA(0, 1, At, B1); PG8_BAR;
            PG8_LDA(At, 1, 1); PG8_STAGE(PG8_SA(1, 0), a3, voffA);
            PG8_BAR; PG8_WAIT_L(0); PG8_MMA(1, 0, At, B0); PG8_BAR; PG8_SCHED;
            PG8_STAGE(PG8_SB(1, 1), b3 + hB, voffB);
            PG8_WAIT_V(6); PG8_BAR; PG8_MMA(1, 1, At, B1); PG8_BAR;
            }
        }
        if constexpr (ALIGN_EPI) { if (wr == 0) PG8_BAR; }
        if constexpr (!Epi::AFTER_DRAIN) { E(acc, cur, wr, wc, fr, fq); S.done(cur); }
        if (!has_next) break;
#pragma unroll
        for (int a = 0; a < 2; ++a)
#pragma unroll
            for (int b = 0; b < 2; ++b)
#pragma unroll
                for (int m = 0; m < 4; ++m)
#pragma unroll
                    for (int n = 0; n < 2; ++n) acc[a][b][m][n] = (f32x4){0.f, 0.f, 0.f, 0.f};
        cur = nxt; cA = nA; cB = nB; ++ui;
        if constexpr (ALIGN_EPI) { if (wr == 1) PG8_BAR; }
    }
    PG8_WAIT_V(0);
    if constexpr (!ALIGN_EPI) { if (wr == 0) PG8_BAR; }
    PG8_BAR;
    if constexpr (Epi::AFTER_DRAIN) { E.fused(acc, cur, wr, wc, fr, fq, lds, wid, lane); S.done(cur); }
#undef PG8_SA
#undef PG8_SB
#undef PG8_STAGE
#undef PG8_LDA
#undef PG8_LDB
#undef PG8_MMA
#undef PG8_WAIT_V
#undef PG8_WAIT_L
#undef PG8_BAR
#undef PG8_SCHED
}
}

namespace att {
using bf16_t = unsigned short;
using bf16x8 = __attribute__((ext_vector_type(8))) short;
using s16x4  = __attribute__((ext_vector_type(4))) short;
using f32x16 = __attribute__((ext_vector_type(16))) float;
using u32x4  = __attribute__((ext_vector_type(4))) unsigned;
using u32x2  = __attribute__((ext_vector_type(2))) unsigned;
constexpr int   D = 128, NW = 8, QBLK = 32, KVBLK = 64, NT = 4;
constexpr float SCALE = 0.088388347648318440f;
constexpr float THR = 8.f;
constexpr int   LDQ = 2048, LDK = 2048;
constexpr size_t SHM_V = KVBLK * D * 2, SHM_K = KVBLK * D * 2, SHM_ATTN = 2 * SHM_V + 2 * SHM_K;
#define KSWZ(row, colB) ((row) * 256 + ((colB) ^ (((row) & 7) << 4)))
#define SBAR() __builtin_amdgcn_sched_barrier(0)
__device__ __forceinline__ int crow(int r, int hi) { return (r & 3) + 8 * (r >> 2) + 4 * hi; }
__device__ __forceinline__ unsigned cvtpk(float lo, float hi) { unsigned r; asm volatile("v_cvt_pk_bf16_f32 %0, %1, %2" : "=v"(r) : "v"(lo), "v"(hi)); return r; }

__device__ __forceinline__ void partialSM(f32x16& p0, f32x16& p1, float& m_reg, float& mn, float& alpha) {
  constexpr float C = SCALE * 1.4426950408889634f;
  float pmax = p0[0];
#pragma unroll
  for (int r = 1; r < 16; ++r) pmax = fmaxf(pmax, p0[r]);
#pragma unroll
  for (int r = 0; r < 16; ++r) pmax = fmaxf(pmax, p1[r]);
  { auto rr = __builtin_amdgcn_permlane32_swap(__float_as_uint(pmax), __float_as_uint(pmax), false, false);
    pmax = fmaxf(__uint_as_float(rr[0]), __uint_as_float(rr[1])); }
  if (__builtin_expect(__all(pmax - m_reg <= THR / SCALE), 1)) { mn = m_reg; alpha = 1.f; }
  else { mn = fmaxf(m_reg, pmax); alpha = __builtin_amdgcn_exp2f((m_reg - mn) * C); m_reg = mn; }
  float mnC = -mn * C;
#pragma unroll
  for (int r = 0; r < 16; ++r) p0[r] = fmaf(p0[r], C, mnC);
#pragma unroll
  for (int r = 0; r < 16; ++r) p1[r] = fmaf(p1[r], C, mnC);
#pragma unroll
  for (int r = 0; r < 16; ++r) p0[r] = __builtin_amdgcn_exp2f(p0[r]);
}
__device__ __forceinline__ void finishSM(f32x16& p0, f32x16& p1, float alpha, float& l_reg, bf16x8& pa0, bf16x8& pa1, bf16x8& pa2, bf16x8& pa3) {
#pragma unroll
  for (int r = 0; r < 16; ++r) p1[r] = __builtin_amdgcn_exp2f(p1[r]);
  float ps = 0;
#pragma unroll
  for (int r = 0; r < 16; ++r) ps += p0[r];
#pragma unroll
  for (int r = 0; r < 16; ++r) ps += p1[r];
  { auto rr = __builtin_amdgcn_permlane32_swap(__float_as_uint(ps), __float_as_uint(ps), false, false);
    ps = __uint_as_float(rr[0]) + __uint_as_float(rr[1]); }
  l_reg = l_reg * alpha + ps;
#define PK4(P, BASE, OUT) do { unsigned a0 = cvtpk(P[BASE + 0], P[BASE + 1]), a1 = cvtpk(P[BASE + 2], P[BASE + 3]);   \
    unsigned b0 = cvtpk(P[BASE + 4], P[BASE + 5]), b1 = cvtpk(P[BASE + 6], P[BASE + 7]);                              \
    auto r0 = __builtin_amdgcn_permlane32_swap(a0, b0, false, false); auto r1 = __builtin_amdgcn_permlane32_swap(a1, b1, false, false); \
    u32x4 w = {r0[0], r1[0], r0[1], r1[1]}; OUT = *reinterpret_cast<bf16x8*>(&w); } while (0)
  PK4(p0, 0, pa0); PK4(p0, 8, pa1); PK4(p1, 0, pa2); PK4(p1, 8, pa3);
#undef PK4
}
__device__ __forceinline__ void qkt(f32x16& p0, f32x16& p1, const char* Ks, const bf16x8* qr, int r32, int hi) {
  p0 = f32x16{}; p1 = f32x16{};
#pragma unroll
  for (int d0 = 0; d0 < 8; ++d0) { int cb = (d0 * 16 + hi * 8) * 2;
    bf16x8 b0 = *reinterpret_cast<const bf16x8*>(Ks + KSWZ(r32, cb));
    bf16x8 b1 = *reinterpret_cast<const bf16x8*>(Ks + KSWZ(32 + r32, cb));
    p0 = __builtin_amdgcn_mfma_f32_32x32x16_bf16(b0, qr[d0], p0, 0, 0, 0);
    p1 = __builtin_amdgcn_mfma_f32_32x32x16_bf16(b1, qr[d0], p1, 0, 0, 0); }
}
__device__ __forceinline__ void cmask(f32x16& p0, f32x16& p1, int jt, int qloc, int hi) {
#pragma unroll
  for (int r = 0; r < 16; ++r) { const int key = 64 * jt + crow(r, hi); if (key > qloc) p0[r] = -1e30f; if (key + 32 > qloc) p1[r] = -1e30f; }
}
__device__ __forceinline__ int v_st(int k, int c) { const int kk = (k & ~0xC) | ((k & 4) << 1) | ((k & 8) >> 1); return ((kk >> 3) * 4 + (c >> 5)) * 512 + ((kk & 7) * 32 + (c & 31)) * 2; }
__device__ __forceinline__ int v_rd_base(int lane) { return ((lane & 3) << 3) | (((lane >> 2) & 3) << 6) | (((lane >> 4) & 1) << 5) | (((lane >> 5) & 1) << 8); }
constexpr int v_rd_off(int d0, int ks, int half) { return d0 * 512 + ks * 4096 + half * 2048; }
template <int OFF> __device__ __forceinline__ s16x4 tr_read(int vb) {
  s16x4 r; asm volatile("ds_read_b64_tr_b16 %0, %1 offset:%2" : "=&v"(r) : "v"(vb), "i"(OFF) : "memory"); return r;
}
template <int D0> __device__ __forceinline__ void pv_one(f32x16& od, int vb, bf16x8 pa0, bf16x8 pa1, bf16x8 pa2, bf16x8 pa3) {
  const s16x4 l0 = tr_read<v_rd_off(D0, 0, 0)>(vb), h0 = tr_read<v_rd_off(D0, 0, 1)>(vb), l1 = tr_read<v_rd_off(D0, 1, 0)>(vb), h1 = tr_read<v_rd_off(D0, 1, 1)>(vb);
  const s16x4 l2 = tr_read<v_rd_off(D0, 2, 0)>(vb), h2 = tr_read<v_rd_off(D0, 2, 1)>(vb), l3 = tr_read<v_rd_off(D0, 3, 0)>(vb), h3 = tr_read<v_rd_off(D0, 3, 1)>(vb);
  asm volatile("s_waitcnt lgkmcnt(0)" ::: "memory"); SBAR();
#define PK(L, H) (bf16x8){L[0], L[1], L[2], L[3], H[0], H[1], H[2], H[3]}
  od = __builtin_amdgcn_mfma_f32_32x32x16_bf16(PK(l0, h0), pa0, od, 0, 0, 0);
  od = __builtin_amdgcn_mfma_f32_32x32x16_bf16(PK(l1, h1), pa1, od, 0, 0, 0);
  od = __builtin_amdgcn_mfma_f32_32x32x16_bf16(PK(l2, h2), pa2, od, 0, 0, 0);
  od = __builtin_amdgcn_mfma_f32_32x32x16_bf16(PK(l3, h3), pa3, od, 0, 0, 0);
#undef PK
}
__device__ __forceinline__ void pv_d0(f32x16* o, int vb, bf16x8 pa0, bf16x8 pa1, bf16x8 pa2, bf16x8 pa3) {
  pv_one<0>(o[0], vb, pa0, pa1, pa2, pa3); pv_one<1>(o[1], vb, pa0, pa1, pa2, pa3); pv_one<2>(o[2], vb, pa0, pa1, pa2, pa3); pv_one<3>(o[3], vb, pa0, pa1, pa2, pa3);
}

__device__ __forceinline__ void attn_item(const bf16_t* __restrict__ Qrow, const bf16_t* __restrict__ Kh, const bf16_t* __restrict__ Vh, bool causal, int qloc,
                                          bf16_t* Orow, float2* MLrow, bool valid, char* lds) {
  const int tid = threadIdx.x, lane = tid & 63, r32 = lane & 31, hi = lane >> 5;
  char* V_lds = lds; char* K_lds = lds + 2 * SHM_V;
  float m_reg = -1e30f, l_reg = 0; f32x16 o[4] = {}; bf16x8 qr[8];
  const bf16_t* Qw = Qrow + hi * 8;
#pragma unroll
  for (int d0 = 0; d0 < 8; ++d0) qr[d0] = *reinterpret_cast<const bf16x8*>(Qw + d0 * 16);
  const int sr = tid >> 4, sc = (tid & 15) * 8, vst0 = v_st(sr, sc), vst1 = v_st(32 + sr, sc);
  const int vb0 = (int)(uintptr_t)V_lds + v_rd_base(lane);
  struct { bf16x8 vs0, vs1, ks0, ks1; } sr_[2];
#define SLOAD(i, k0) do { sr_[i].vs0 = *reinterpret_cast<const bf16x8*>(&Vh[(long)((k0) + sr) * LDK + sc]); sr_[i].vs1 = *reinterpret_cast<const bf16x8*>(&Vh[(long)((k0) + 32 + sr) * LDK + sc]); \
    sr_[i].ks0 = *reinterpret_cast<const bf16x8*>(&Kh[(long)((k0) + sr) * LDK + sc]); sr_[i].ks1 = *reinterpret_cast<const bf16x8*>(&Kh[(long)((k0) + 32 + sr) * LDK + sc]); } while (0)
#define SWRITE(b, i) do { *(bf16x8*)(V_lds + (b) * SHM_V + vst0) = sr_[i].vs0;          \
    *(bf16x8*)(V_lds + (b) * SHM_V + vst1) = sr_[i].vs1; int kc = sc * 2;               \
    *(bf16x8*)(K_lds + (b) * SHM_K + KSWZ(sr, kc)) = sr_[i].ks0;                       \
    *(bf16x8*)(K_lds + (b) * SHM_K + KSWZ(32 + sr, kc)) = sr_[i].ks1; } while (0)
#define SWAIT() asm volatile("s_waitcnt vmcnt(4)" ::: "memory")
#define RESC(a) do { if (__any((a) < 1.f)) { _Pragma("unroll") for (int d = 0; d < 4; ++d) _Pragma("unroll") for (int r = 0; r < 16; ++r) o[d][r] *= (a); } } while (0)
  f32x16 pA0, pA1, pB0, pB1; float mnA, mnB, alA, alB; bf16x8 pa0, pa1, pa2, pa3;
  constexpr int SE = 0, SO = 1;
  SLOAD(SE, 0); asm volatile("s_waitcnt vmcnt(0)" ::: "memory"); SWRITE(0, SE); __syncthreads();
  qkt(pA0, pA1, K_lds, qr, r32, hi); if (causal) cmask(pA0, pA1, 0, qloc, hi); partialSM(pA0, pA1, m_reg, mnA, alA);
  SLOAD(SO, KVBLK); SLOAD(SE, 2 * KVBLK);
  SWAIT(); SWRITE(1, SO); __syncthreads();
  {
    SBAR(); qkt(pB0, pB1, K_lds + SHM_K, qr, r32, hi); if (causal) cmask(pB0, pB1, 1, qloc, hi);
    finishSM(pA0, pA1, alA, l_reg, pa0, pa1, pa2, pa3); SBAR();
    SLOAD(SO, 3 * KVBLK); SBAR();
    pv_d0(o, vb0, pa0, pa1, pa2, pa3); partialSM(pB0, pB1, m_reg, mnB, alB);
    __syncthreads(); SWAIT(); SWRITE(0, SE);
    RESC(alB); __syncthreads();
    SBAR(); qkt(pA0, pA1, K_lds, qr, r32, hi); if (causal) cmask(pA0, pA1, 2, qloc, hi);
    finishSM(pB0, pB1, alB, l_reg, pa0, pa1, pa2, pa3); SBAR();
    pv_d0(o, vb0 + (int)SHM_V, pa0, pa1, pa2, pa3); partialSM(pA0, pA1, m_reg, mnA, alA);
    __syncthreads(); asm volatile("s_waitcnt vmcnt(0)" ::: "memory"); SWRITE(1, SO);
    RESC(alA); __syncthreads();
  }
  SBAR(); qkt(pB0, pB1, K_lds + SHM_K, qr, r32, hi); if (causal) cmask(pB0, pB1, 3, qloc, hi);
  finishSM(pA0, pA1, alA, l_reg, pa0, pa1, pa2, pa3); SBAR();
  pv_d0(o, vb0, pa0, pa1, pa2, pa3); partialSM(pB0, pB1, m_reg, mnB, alB);
  __syncthreads(); RESC(alB);
  finishSM(pB0, pB1, alB, l_reg, pa0, pa1, pa2, pa3); SBAR();
  pv_d0(o, vb0 + (int)SHM_V, pa0, pa1, pa2, pa3);
  const float rl = 1.0f / l_reg;
  if (valid) {
#pragma unroll
    for (int d0 = 0; d0 < 4; ++d0)
#pragma unroll
      for (int g = 0; g < 4; ++g) { u32x2 w; w.x = cvtpk(o[d0][4 * g] * rl, o[d0][4 * g + 1] * rl); w.y = cvtpk(o[d0][4 * g + 2] * rl, o[d0][4 * g + 3] * rl);
        *reinterpret_cast<u32x2*>(Orow + 32 * d0 + 8 * g + 4 * hi) = w; }
    if (hi == 0) *MLrow = make_float2(m_reg, l_reg);
  }
#undef SLOAD
#undef SWRITE
#undef SWAIT
#undef RESC
}

struct ItemCtx { const bf16_t* Q; const bf16_t* K; const bf16_t* V; bf16_t* PO; float2* ML; const unsigned short* lists; };
__device__ __forceinline__ unsigned item_entry(const ItemCtx& C, const __attribute__((address_space(3))) int* D, int k, int rloc) {
  const int own = D[4 * k + 1], j = D[4 * k] & 31, cnt = D[4 * k + 3];
  if (own) return (unsigned)(256 * j + rloc) | (3u << 13);
  return (unsigned)C.lists[(size_t)(unsigned)D[4 * k + 2] + (rloc < cnt ? rloc : 0)];
}
__device__ __forceinline__ void attn_items(const ItemCtx& C, const __attribute__((address_space(3))) int* D, int nloc, char* lds) {
  if (nloc <= 0) return;
  const int tid = threadIdx.x, wid = tid >> 6, lane = tid & 63, r32 = lane & 31, hi = lane >> 5, rloc = 32 * wid + r32;
  char* V_lds = lds; char* K_lds = lds + 2 * SHM_V;
  const int sr = tid >> 4, sc = (tid & 15) * 8, vst0 = v_st(sr, sc), vst1 = v_st(32 + sr, sc);
  const int vb0 = (int)(uintptr_t)V_lds + v_rd_base(lane);
  struct { bf16x8 vs0, vs1, ks0, ks1; } sr_[2];
  bf16x8 qr[8];
#define KVBASE(k, Kh, Vh) const bf16_t* Kh; const bf16_t* Vh; { const int bhj_ = D[4 * (k)], bh_ = bhj_ >> 5, j_ = bhj_ & 31; \
    const size_t off_ = ((size_t)(bh_ >> 4) * 8192 + 256 * j_) * LDK + (bh_ & 15) * D_; Kh = C.K + off_; Vh = C.V + off_; }
#define SLOADP(i, Kh, Vh, k0) do { sr_[i].vs0 = *reinterpret_cast<const bf16x8*>(&Vh[(long)((k0) + sr) * LDK + sc]); sr_[i].vs1 = *reinterpret_cast<const bf16x8*>(&Vh[(long)((k0) + 32 + sr) * LDK + sc]); \
    sr_[i].ks0 = *reinterpret_cast<const bf16x8*>(&Kh[(long)((k0) + sr) * LDK + sc]); sr_[i].ks1 = *reinterpret_cast<const bf16x8*>(&Kh[(long)((k0) + 32 + sr) * LDK + sc]); } while (0)
#define SWRITE(b, i) do { *(bf16x8*)(V_lds + (b) * SHM_V + vst0) = sr_[i].vs0;          \
    *(bf16x8*)(V_lds + (b) * SHM_V + vst1) = sr_[i].vs1; int kc = sc * 2;               \
    *(bf16x8*)(K_lds + (b) * SHM_K + KSWZ(sr, kc)) = sr_[i].ks0;                       \
    *(bf16x8*)(K_lds + (b) * SHM_K + KSWZ(32 + sr, kc)) = sr_[i].ks1; } while (0)
#define QLOAD(e, k) do { const int bh_ = D[4 * (k)] >> 5; const bf16_t* Qw_ = C.Q + ((size_t)(bh_ >> 4) * 8192 + ((e) & 8191u)) * LDQ + (bh_ & 15) * D_ + hi * 8; \
    _Pragma("unroll") for (int d0 = 0; d0 < 8; ++d0) qr[d0] = *reinterpret_cast<const bf16x8*>(Qw_ + d0 * 16); } while (0)
#define RESC(a) do { if (__any((a) < 1.f)) { _Pragma("unroll") for (int d = 0; d < 4; ++d) _Pragma("unroll") for (int r = 0; r < 16; ++r) o[d][r] *= (a); } } while (0)
  constexpr int D_ = 128, SE = 0, SO = 1;
  unsigned e_cur = item_entry(C, D, 0, rloc), e_nxt = (nloc > 1) ? item_entry(C, D, 1, rloc) : 0u;
  { KVBASE(0, Kh, Vh); SLOADP(SE, Kh, Vh, 0); SLOADP(SO, Kh, Vh, KVBLK); }
  QLOAD(e_cur, 0);
  for (int k = 0; k < nloc; ++k) {
    const bool has_next = (k + 1 < nloc);
    const bool causal = D[4 * k + 1] != 0; const int cnt = D[4 * k + 3];
    KVBASE(k, Kh, Vh);
    float m_reg = -1e30f, l_reg = 0; f32x16 o[4] = {};
    f32x16 pA0, pA1, pB0, pB1; float mnA, mnB, alA, alB; bf16x8 pa0, pa1, pa2, pa3;
    asm volatile("s_waitcnt vmcnt(0)" ::: "memory"); SWRITE(0, SE); __syncthreads();
    qkt(pA0, pA1, K_lds, qr, r32, hi); if (causal) cmask(pA0, pA1, 0, rloc, hi); partialSM(pA0, pA1, m_reg, mnA, alA);
    SLOADP(SE, Kh, Vh, 2 * KVBLK);
    SWRITE(1, SO); __syncthreads();
    SLOADP(SO, Kh, Vh, 3 * KVBLK);
    SBAR(); qkt(pB0, pB1, K_lds + SHM_K, qr, r32, hi); if (causal) cmask(pB0, pB1, 1, rloc, hi);
    finishSM(pA0, pA1, alA, l_reg, pa0, pa1, pa2, pa3); SBAR();
    pv_d0(o, vb0, pa0, pa1, pa2, pa3); partialSM(pB0, pB1, m_reg, mnB, alB);
    __syncthreads(); asm volatile("s_waitcnt vmcnt(4)" ::: "memory"); SWRITE(0, SE);
    RESC(alB); __syncthreads();
    if (has_next) { KVBASE(k + 1, Kn, Vn); SLOADP(SE, Kn, Vn, 0); }
    SBAR(); qkt(pA0, pA1, K_lds, qr, r32, hi); if (causal) cmask(pA0, pA1, 2, rloc, hi);
    finishSM(pB0, pB1, alB, l_reg, pa0, pa1, pa2, pa3); SBAR();
    pv_d0(o, vb0 + (int)SHM_V, pa0, pa1, pa2, pa3); partialSM(pA0, pA1, m_reg, mnA, alA);
    __syncthreads(); SWRITE(1, SO);
    RESC(alA); __syncthreads();
    if (has_next) { KVBASE(k + 1, Kn, Vn); SLOADP(SO, Kn, Vn, KVBLK); }
    SBAR(); qkt(pB0, pB1, K_lds + SHM_K, qr, r32, hi); if (causal) cmask(pB0, pB1, 3, rloc, hi);
    SBAR();
    if (has_next) QLOAD(e_nxt, k + 1);
    finishSM(pA0, pA1, alA, l_reg, pa0, pa1, pa2, pa3); SBAR();
    pv_d0(o, vb0, pa0, pa1, pa2, pa3); partialSM(pB0, pB1, m_reg, mnB, alB);
    __syncthreads(); RESC(alB);
    finishSM(pB0, pB1, alB, l_reg, pa0, pa1, pa2, pa3); SBAR();
    pv_d0(o, vb0 + (int)SHM_V, pa0, pa1, pa2, pa3);
    { const float rl = 1.0f / l_reg; const int bh = D[4 * k] >> 5; const unsigned t = e_cur & 8191u, slot = e_cur >> 13;
      if (rloc < cnt) {
        bf16_t* Orow = C.PO + (((size_t)slot * 32 + bh) * 8192 + t) * D_;
#pragma unroll
        for (int d0 = 0; d0 < 4; ++d0)
#pragma unroll
          for (int g = 0; g < 4; ++g) { u32x2 w; w.x = cvtpk(o[d0][4 * g] * rl, o[d0][4 * g + 1] * rl); w.y = cvtpk(o[d0][4 * g + 2] * rl, o[d0][4 * g + 3] * rl);
            *reinterpret_cast<u32x2*>(Orow + 32 * d0 + 8 * g + 4 * hi) = w; }
        if (hi == 0) C.ML[((size_t)slot * 32 + bh) * 8192 + t] = make_float2(m_reg, l_reg);
      } }
    e_cur = e_nxt; if (k + 2 < nloc) e_nxt = item_entry(C, D, k + 2, rloc);
  }
#undef KVBASE
#undef SLOADP
#undef SWRITE
#undef QLOAD
#undef RESC
}
#undef KSWZ
#undef SBAR
}

constexpr int NWAVES = 8;
#ifndef MK_N_LAUNCHES
#define MK_N_LAUNCHES 1
#endif
constexpr int N_PHASES = 16;
constexpr int N_LAUNCHES = MK_N_LAUNCHES;

constexpr int BATCH = 2, SEQ = 8192, DM = 4096, M = BATCH * SEQ, MEMLEN = 256;
constexpr int PW = 2048, AW = 2048, NH = 16, HD = 128, NBLK = 32, MIXIN = 8192, FF = 11008, XH = 4, XHD = 1024;
constexpr float LN_EPS = 1e-5f;
constexpr float DN_ALPHA = 1.189207115002721f;

constexpr size_t MiB = 1u << 20;
constexpr size_t WS_CTL = 0, CTL_ZERO_BYTES = 1 * MiB;
constexpr size_t WS_ROPE = 1 * MiB;
constexpr size_t WS_KMH = 5 * MiB, WS_KML = 5 * MiB + 512 * 1024;
constexpr size_t WS_MEMB = 6 * MiB;
constexpr size_t WS_KVX = 10 * MiB;
constexpr size_t WS_LIST = 18 * MiB;
constexpr size_t WS_ML = 26 * MiB;
constexpr size_t WS_WIN = 34 * MiB, WS_WPOOL = 98 * MiB, WS_WOUT = 100 * MiB, WS_WXQ = 132 * MiB, WS_WXKV = 164 * MiB, WS_WXO = 228 * MiB, WS_WGU = 260 * MiB, WS_WDN = 432 * MiB;
constexpr size_t WS_ACT = 518 * MiB;
constexpr size_t WS_HP = WS_ACT, WS_Q = WS_ACT + 64 * MiB, WS_K = WS_ACT + 128 * MiB, WS_V = WS_ACT + 192 * MiB;
constexpr size_t WS_XB = WS_ACT + 256 * MiB;
constexpr size_t WS_PM = WS_ACT + 256 * MiB;
constexpr size_t WS_PARTO = WS_ACT + 256 * MiB;
constexpr size_t WS_CAT = WS_ACT + 512 * MiB;
constexpr size_t WS_HB = WS_ACT;
constexpr size_t WS_PB = WS_ACT + 256 * MiB;
constexpr size_t WS_G = WS_ACT + 128 * MiB;
constexpr size_t WS_SLAB = WS_ACT + 640 * MiB;
constexpr size_t WS_WQK = WS_SLAB, WS_WVOT = WS_SLAB + 16 * MiB;
constexpr size_t WS_STATS = WS_ML;
constexpr size_t WS_END = WS_ACT + 704 * MiB;
static_assert(WS_WDN + (size_t)DM * FF * 2 <= WS_ACT && WS_G + (size_t)M * FF * 2 <= WS_END && WS_WGU + (size_t)2 * FF * DM * 2 <= WS_WDN, "d_ws map");
constexpr int LIST_STRIDE = 256 * 496;
__host__ __device__ constexpr int list_off(int j) { return 256 * (31 * j - (j * (j - 1)) / 2); }
constexpr int CW_TMO = 0, CW_CODE = 1;
constexpr int CW_BAR = 4096;
constexpr int CW_GCNT = 8192;
constexpr int CW_CHK = 16384;

constexpr int RING_OFF = 0, RING_BYTES = 131072;
constexpr int LDSCTL_OFF = RING_BYTES, MISC_OFF = LDSCTL_OFF + 320;
constexpr int LDS_BYTES = 147456;

#define GAS __attribute__((address_space(1)))
#define LAS __attribute__((address_space(3)))
typedef unsigned short bf16;
typedef unsigned v4u __attribute__((ext_vector_type(4)));
typedef unsigned v2u __attribute__((ext_vector_type(2)));
typedef float f32x4 __attribute__((ext_vector_type(4)));
typedef short bf16x8 __attribute__((ext_vector_type(8)));
typedef float f32x16 __attribute__((ext_vector_type(16)));
typedef GAS unsigned gu32;
#define RLX_AGENT __ATOMIC_RELAXED, __HIP_MEMORY_SCOPE_AGENT
#define LDS_WAIT() asm volatile("s_waitcnt lgkmcnt(0)" ::: "memory")
#define VM_WAIT() asm volatile("s_waitcnt vmcnt(0)" ::: "memory")
__device__ __forceinline__ unsigned f2bf(float f) { unsigned u = __builtin_bit_cast(unsigned, f); return (u + 0x7fffu + ((u >> 16) & 1u)) >> 16; }
__device__ __forceinline__ unsigned pk2(float lo, float hi) { return f2bf(lo) | (f2bf(hi) << 16); }
__device__ __forceinline__ float bf_lo(unsigned w) { return __builtin_bit_cast(float, w << 16); }
__device__ __forceinline__ float bf_hi(unsigned w) { return __builtin_bit_cast(float, w & 0xffff0000u); }
__device__ __forceinline__ float bf2f(bf16 b) { return __builtin_bit_cast(float, ((unsigned)b) << 16); }
#define XB_TMO      128
#define XB_XCNT(j)  (256  + 64 * (j))
#define XB_XSUB(j)  (1280 + 64 * (j))
#define XB_XGEN(j)  (2304 + 64 * (j))
#define XB_TOP      3328
#define XB_TOPGEN   3392
#define XCD_BAR_WORDS 3456
#define XB_SPIN_CAP (1u << 18)

__device__ __forceinline__ unsigned xb_ld(unsigned* p)              { return __hip_atomic_load(p, __ATOMIC_RELAXED, __HIP_MEMORY_SCOPE_AGENT); }
__device__ __forceinline__ unsigned xb_add(unsigned* p, unsigned v) { return __hip_atomic_fetch_add(p, v, __ATOMIC_RELAXED, __HIP_MEMORY_SCOPE_AGENT); }
__device__ __forceinline__ unsigned xb_xcc_id() { return (unsigned)__builtin_amdgcn_s_getreg((3 << 11) | 20) & 0xFu; }
#define XB_SPIN(cond, bar) do { unsigned _sp = 0; while (cond) { __builtin_amdgcn_s_sleep(1); \
    if ((++_sp & 255u) == 0u) { if (xb_ld(&(bar)[XB_TMO])) break; if (_sp > XB_SPIN_CAP) { atomicAdd(&(bar)[XB_TMO], 1u); break; } } } } while (0)

struct XcdBarrier {
    unsigned* bar; unsigned x;
    volatile LAS unsigned* st;
};

__device__ __forceinline__ XcdBarrier xcd_barrier_post(unsigned* bar, volatile LAS unsigned* st) {
    XcdBarrier b; b.bar = bar; b.x = xb_xcc_id(); b.st = st;
    if (threadIdx.x == 0) (void)xb_add(&bar[XB_XCNT(b.x)], 1u);
    return b;
}
__device__ __forceinline__ void xcd_barrier_complete(unsigned* bar, unsigned x, unsigned& nloc, unsigned& nx) {
    const unsigned G = gridDim.x * gridDim.y * gridDim.z;
    unsigned sum, cnt, mine, sp = 0u;
    for (;;) {
        sum = 0u; cnt = 0u; mine = 0u;
#pragma unroll
        for (unsigned j = 0; j < 16; ++j) { const unsigned c = xb_ld(&bar[XB_XCNT(j)]); sum += c; cnt += (c > 0u) ? 1u : 0u; mine = (j == x) ? c : mine; }
        if (sum == G) break;
        __builtin_amdgcn_s_sleep(1);
        if ((++sp & 255u) == 0u) { if (xb_ld(&bar[XB_TMO])) break; if (sp > XB_SPIN_CAP) { atomicAdd(&bar[XB_TMO], 1u); break; } }
    }
    nloc = mine > 0u ? mine : 1u; nx = cnt > 0u ? cnt : 1u;
}

__device__ __forceinline__ void xcd_barrier(const XcdBarrier& b) {
    asm volatile("s_waitcnt vmcnt(0)" ::: "memory");
    __syncthreads();
    if (threadIdx.x == 0) {
        unsigned* bar = b.bar;
        __builtin_amdgcn_s_waitcnt(0);
        unsigned nloc = b.st[0], nx = b.st[1];
        if (nloc == 0u) { xcd_barrier_complete(bar, b.x, nloc, nx); b.st[0] = nloc; b.st[1] = nx; }
        const unsigned old = xb_add(&bar[XB_XSUB(b.x)], 1u);
        const unsigned gen = old / nloc;
        if (old + 1u == (gen + 1u) * nloc) {
            __builtin_amdgcn_fence(__ATOMIC_RELEASE, "agent");
            asm volatile("s_waitcnt vmcnt(0)" ::: "memory");
            const unsigned og = xb_add(&bar[XB_TOP], 1u);
            const unsigned tg = og / nx;
            if (og + 1u == (tg + 1u) * nx) xb_add(&bar[XB_TOPGEN], 1u);
            else XB_SPIN(xb_ld(&bar[XB_TOPGEN]) == tg, bar);
            __builtin_amdgcn_fence(__ATOMIC_ACQUIRE, "agent");
            xb_add(&bar[XB_XGEN(b.x)], 1u);
            asm volatile("s_waitcnt vmcnt(0)" ::: "memory");
        } else {
            XB_SPIN(xb_ld(&bar[XB_XGEN(b.x)]) == gen, bar);
            __builtin_amdgcn_fence(__ATOMIC_ACQUIRE, "agent");
            asm volatile("s_waitcnt vmcnt(0)" ::: "memory");
        }
    }
    __syncthreads();
}

struct Frame {
    LAS unsigned char* lds;
    volatile LAS unsigned* MISC;
    gu32* ctl;
    int tid, lane, wave;
    int G;
    unsigned char* ws;
};
__device__ __forceinline__ float wave_sum(float v) {
#pragma unroll
    for (int o = 1; o < 64; o <<= 1) v += __shfl_xor(v, o);
    return v;
}

template <class RowMap>
__device__ __forceinline__ void p0_transpose_item(const float* W, int K, int N, bf16* WT, LAS float* scr, int item, int lane, const RowMap& rm, const float* colscale) {
    const int nblk = N / 32, kb = item / nblk, nb = item % nblk, k0 = 64 * kb, n0 = 32 * nb;
    float ld[32];
    const float* src = W + (size_t)(k0 + (lane >> 5)) * N + n0 + (lane & 31);
#pragma unroll
    for (int i = 0; i < 32; ++i) ld[i] = *(const GAS float*)(src + (size_t)(2 * i) * N);
#pragma unroll
    for (int i = 0; i < 32; ++i) scr[(2 * i + (lane >> 5)) * 33 + (lane & 31)] = ld[i];
    LDS_WAIT(); asm volatile("" ::: "memory");
    const int c = lane & 7;
#pragma unroll
    for (int j = 0; j < 4; ++j) { const int n = (lane >> 3) + 8 * j; const LAS float* s = scr + (8 * c) * 33 + n; const float sc = colscale ? colscale[n0 + n] : 1.0f;
        v4u o; o.x = pk2(s[0 * 33] * sc, s[1 * 33] * sc); o.y = pk2(s[2 * 33] * sc, s[3 * 33] * sc); o.z = pk2(s[4 * 33] * sc, s[5 * 33] * sc); o.w = pk2(s[6 * 33] * sc, s[7 * 33] * sc);
        *(GAS v4u*)(WT + (size_t)rm(n0 + n) * K + k0 + 8 * c) = o; }
    LDS_WAIT(); asm volatile("" ::: "memory");
}
struct RmIdent { int off; __device__ __forceinline__ int operator()(int n) const { return off + n; } };
struct RmMixIn { __device__ __forceinline__ int operator()(int n) const { if (n < 2048 || n >= 6144) return n; const int d = n & 127; return (n & ~127) + 2 * (d & 63) + (d >> 6); } };
struct RmGateUp { int up; __device__ __forceinline__ int operator()(int n) const { return (n >> 7) * 256 + up * 128 + (n & 127); } };

__device__ __forceinline__ void sincos_d(double a, double& s, double& c) {
    const double n = __builtin_rint(a * 0.63661977236758134308);
    double r = __builtin_fma(-n, 1.5707963267948966, a); r = __builtin_fma(-n, 6.123233995736766e-17, r);
    const double r2 = r * r;
    double ps = -7.6471637318198164759e-13; ps = ps * r2 + 1.6059043836821614599e-10; ps = ps * r2 - 2.5052108385441718775e-08; ps = ps * r2 + 2.7557319223985890653e-06;
    ps = ps * r2 - 1.9841269841269841270e-04; ps = ps * r2 + 8.3333333333333333333e-03; ps = ps * r2 - 1.6666666666666666667e-01; ps = r + r * r2 * ps;
    double pc = 4.7794773323873852974e-14; pc = pc * r2 - 1.1470745597729724714e-11; pc = pc * r2 + 2.0876756987868098979e-09; pc = pc * r2 - 2.7557319223985890653e-07;
    pc = pc * r2 + 2.4801587301587301587e-05; pc = pc * r2 - 1.3888888888888888889e-03; pc = pc * r2 + 4.1666666666666666667e-02; pc = pc * r2 - 0.5; pc = 1.0 + r2 * pc;
    const int q = ((int)n) & 3;
    s = (q == 0) ? ps : (q == 1) ? pc : (q == 2) ? -ps : -pc;
    c = (q == 0) ? pc : (q == 1) ? -ps : (q == 2) ? -pc : ps;
}
__device__ __forceinline__ float rope_inv(int i) {
    const double y = -(double)i * (13.287712379549449 / 64.0); const double fl = __builtin_floor(y); const double z = (y - fl) * 0.69314718055994530942;
    double e = 1.0, term = 1.0;
#pragma unroll
    for (int k = 1; k <= 20; ++k) { term = term * z / (double)k; e += term; }
    return (float)__builtin_ldexp(e, (int)fl);
}

__device__ __forceinline__ void p0_prologue(Frame& F, const float* const* in) {
    LAS float* scr = (LAS float*)(F.lds + RING_OFF + F.wave * 16384);
    const int gw = blockIdx.x * NWAVES + F.wave, NGW = F.G * NWAVES;
    const float* w_mix_in = in[2]; const float* w_pool = in[3]; const float* pool_scale = in[4]; const float* w_mix_out = in[5];
    const float* w_xq = in[8]; const float* w_xkv = in[9]; const float* w_xo = in[10]; const float* w_gate = in[13]; const float* w_up = in[14]; const float* w_down = in[15];
    bf16* WIN = (bf16*)(F.ws + WS_WIN); bf16* WPOOL = (bf16*)(F.ws + WS_WPOOL); bf16* WOUT = (bf16*)(F.ws + WS_WOUT); bf16* WXQ = (bf16*)(F.ws + WS_WXQ);
    bf16* WXKV = (bf16*)(F.ws + WS_WXKV); bf16* WXO = (bf16*)(F.ws + WS_WXO); bf16* WGU = (bf16*)(F.ws + WS_WGU); bf16* WDN = (bf16*)(F.ws + WS_WDN);
    constexpr int I_IN = (DM / 64) * (MIXIN / 32), I_POOL = (512 / 64) * (512 / 32), I_SQ = (DM / 64) * (DM / 32), I_KV = (DM / 64) * (2 * DM / 32), I_GU = (DM / 64) * (FF / 32), I_DN = (FF / 64) * (DM / 32);
    constexpr int NITEMS = I_IN + 4 * I_POOL + 2 * I_SQ + I_KV + 2 * I_GU + I_DN;
    for (int it = gw; it < NITEMS; it += NGW) {
        int r = it;
        if (r < I_IN) { p0_transpose_item(w_mix_in, DM, MIXIN, WIN, scr, r, F.lane, RmMixIn{}, nullptr); continue; } r -= I_IN;
        if (r < 4 * I_POOL) { const int g = r / I_POOL; p0_transpose_item(w_pool + (size_t)g * 512 * 512, 512, 512, WPOOL, scr, r % I_POOL, F.lane, RmIdent{g * 512}, pool_scale + g * 512); continue; } r -= 4 * I_POOL;
        if (r < I_SQ) { p0_transpose_item(w_mix_out, DM, DM, WOUT, scr, r, F.lane, RmIdent{0}, nullptr); continue; } r -= I_SQ;
        if (r < I_KV) { p0_transpose_item(w_xkv, DM, 2 * DM, WXKV, scr, r, F.lane, RmIdent{0}, nullptr); continue; } r -= I_KV;
        if (r < I_SQ) { p0_transpose_item(w_xo, DM, DM, WXO, scr, r, F.lane, RmIdent{0}, nullptr); continue; } r -= I_SQ;
        if (r < I_GU) { p0_transpose_item(w_gate, DM, FF, WGU, scr, r, F.lane, RmGateUp{0}, nullptr); continue; } r -= I_GU;
        if (r < I_GU) { p0_transpose_item(w_up, DM, FF, WGU, scr, r, F.lane, RmGateUp{1}, nullptr); continue; } r -= I_GU;
        p0_transpose_item(w_down, FF, DM, WDN, scr, r, F.lane, RmIdent{0}, nullptr);
    }
    const size_t gt = (size_t)blockIdx.x * (NWAVES * 64) + F.tid, NT = (size_t)F.G * NWAVES * 64;
    { const float* x = in[0]; bf16* XB = (bf16*)(F.ws + WS_XB);
      for (size_t i = gt; i < (size_t)M * DM / 8; i += NT) { const f32x4 a = *(const GAS f32x4*)(x + i * 8), b = *(const GAS f32x4*)(x + i * 8 + 4);
          v4u o; o.x = pk2(a.x, a.y); o.y = pk2(a.z, a.w); o.z = pk2(b.x, b.y); o.w = pk2(b.z, b.w); *(GAS v4u*)(XB + i * 8) = o; } }
    { const float* x = w_xq; bf16* XB = WXQ;
      for (size_t i = gt; i < (size_t)DM * DM / 8; i += NT) { const f32x4 a = *(const GAS f32x4*)(x + i * 8), b = *(const GAS f32x4*)(x + i * 8 + 4);
          v4u o; o.x = pk2(a.x, a.y); o.y = pk2(a.z, a.w); o.z = pk2(b.x, b.y); o.w = pk2(b.z, b.w); *(GAS v4u*)(XB + i * 8) = o; } }
    { const float* x = in[1]; bf16* XB = (bf16*)(F.ws + WS_MEMB);
      for (size_t i = gt; i < (size_t)BATCH * MEMLEN * DM / 8; i += NT) { const f32x4 a = *(const GAS f32x4*)(x + i * 8), b = *(const GAS f32x4*)(x + i * 8 + 4);
          v4u o; o.x = pk2(a.x, a.y); o.y = pk2(a.z, a.w); o.z = pk2(b.x, b.y); o.w = pk2(b.z, b.w); *(GAS v4u*)(XB + i * 8) = o; } }
    { float2* tab = (float2*)(F.ws + WS_ROPE);
      for (size_t i = gt; i < (size_t)SEQ * 64; i += NT) { const int pos = (int)(i >> 6), fi = (int)(i & 63); const float ang = (float)pos * rope_inv(fi);
          double s, c; sincos_d((double)ang, s, c); tab[i] = make_float2((float)c, (float)s); } }
}

template <bool WRITE_F32>
__device__ __forceinline__ void ln_rows(Frame& F, float* X, bf16* XB, float2* stats, const float* g, const float* b) {
    const int gw = blockIdx.x * NWAVES + F.wave, NGW = F.G * NWAVES;
    for (int m = gw; m < M; m += NGW) {
        GAS f32x4* xr = (GAS f32x4*)(X + (size_t)m * DM) + F.lane;
        f32x4 v[16]; float s = 0.f;
#pragma unroll
        for (int j = 0; j < 16; ++j) { v[j] = xr[64 * j]; s += (v[j].x + v[j].y) + (v[j].z + v[j].w); }
        const float mean = wave_sum(s) * (1.f / DM); float s2 = 0.f;
#pragma unroll
        for (int j = 0; j < 16; ++j) { v[j] = v[j] - mean; s2 += (v[j].x * v[j].x + v[j].y * v[j].y) + (v[j].z * v[j].z + v[j].w * v[j].w); }
        const float rstd = 1.f / sqrtf(wave_sum(s2) * (1.f / DM) + LN_EPS);
        if (stats && F.lane == 0) stats[m] = make_float2(mean, rstd);
#pragma unroll
        for (int j = 0; j < 16; ++j) { const f32x4 gg = ((const GAS f32x4*)g)[64 * j + F.lane], bb = ((const GAS f32x4*)b)[64 * j + F.lane];
            const f32x4 y = (v[j] * rstd) * gg + bb; if (WRITE_F32) xr[64 * j] = y;
            if (XB) { v2u o; o.x = pk2(y.x, y.y); o.y = pk2(y.z, y.w); ((GAS v2u*)(XB + (size_t)m * DM))[64 * j + F.lane] = o; } }
    }
}

__device__ __forceinline__ void up8(const v4u& r, float (&f)[8]) { f[0] = bf_lo(r.x); f[1] = bf_hi(r.x); f[2] = bf_lo(r.y); f[3] = bf_hi(r.y); f[4] = bf_lo(r.z); f[5] = bf_hi(r.z); f[6] = bf_lo(r.w); f[7] = bf_hi(r.w); }
template <int W>
__device__ __forceinline__ void pool_run(const bf16* HP, bf16* PMo, int t0, int c) {
    const int tp0 = t0 & (SEQ - 1);
    v4u raw[16 + W - 1];
#pragma unroll
    for (int j = 0; j < 16 + W - 1; ++j) { const int dt = j - (W - 1); raw[j] = (v4u){0u, 0u, 0u, 0u}; if (tp0 + dt >= 0) raw[j] = *(const GAS v4u*)(HP + (size_t)(t0 + dt) * PW + c); }
    float S[8], u[8];
#pragma unroll
    for (int e = 0; e < 8; ++e) S[e] = 0.f;
#pragma unroll
    for (int j = 0; j < W - 1; ++j) { up8(raw[j], u);
#pragma unroll
        for (int e = 0; e < 8; ++e) S[e] += u[e]; }
#pragma unroll
    for (int i = 0; i < 16; ++i) {
        up8(raw[W - 1 + i], u);
#pragma unroll
        for (int e = 0; e < 8; ++e) S[e] += u[e];
        const int tp = tp0 + i; const float inv = (tp + 1 < W) ? 1.0f / (float)(tp + 1) : 1.0f / (float)W;
        v4u o; o.x = pk2(S[0] * inv - u[0], S[1] * inv - u[1]); o.y = pk2(S[2] * inv - u[2], S[3] * inv - u[3]);
        o.z = pk2(S[4] * inv - u[4], S[5] * inv - u[5]); o.w = pk2(S[6] * inv - u[6], S[7] * inv - u[7]);
        *(GAS v4u*)(PMo + (size_t)(t0 + i) * PW + c) = o;
        float d[8]; up8(raw[i], d);
#pragma unroll
        for (int e = 0; e < 8; ++e) S[e] -= d[e];
    }
}
__device__ __forceinline__ void pool_ew(Frame& F) {
    const bf16* HP = (const bf16*)(F.ws + WS_HP); bf16* PMo = (bf16*)(F.ws + WS_PM);
    const size_t gt = (size_t)blockIdx.x * (NWAVES * 64) + F.tid, NT = (size_t)F.G * NWAVES * 64;
    for (size_t idx = gt; idx < (size_t)(M / 16) * 256; idx += NT) {
        const int t0 = (int)(idx >> 8) * 16, c = (int)(idx & 255) * 8, grp = __builtin_amdgcn_readfirstlane(c >> 9);
        if (grp == 0) pool_run<2>(HP, PMo, t0, c); else if (grp == 1) pool_run<4>(HP, PMo, t0, c); else if (grp == 2) pool_run<8>(HP, PMo, t0, c); else pool_run<16>(HP, PMo, t0, c);
    }
}
__device__ __forceinline__ void kv_reduce(Frame& F) {
    const float* SK = (const float*)(F.ws + WS_SLAB); bf16* KVX = (bf16*)(F.ws + WS_KVX);
    const size_t gt = (size_t)blockIdx.x * (NWAVES * 64) + F.tid, NT = (size_t)F.G * NWAVES * 64, NE = (size_t)512 * 8192;
    for (size_t i = gt; i < NE / 4; i += NT) { const float* sb = SK + i * 4;
        const f32x4 a = *(const GAS f32x4*)sb + *(const GAS f32x4*)(sb + NE) + *(const GAS f32x4*)(sb + 2 * NE) + *(const GAS f32x4*)(sb + 3 * NE);
        v2u o; o.x = pk2(a.x, a.y); o.y = pk2(a.z, a.w); *(GAS v2u*)(KVX + i * 4) = o; }
}

__device__ __forceinline__ void kmean_phase(Frame& F) {
    const bf16* Kb = (const bf16*)(F.ws + WS_K); bf16* KMH = (bf16*)(F.ws + WS_KMH); bf16* KML = (bf16*)(F.ws + WS_KML);
    LAS float* part = (LAS float*)(F.lds + RING_OFF);
    for (int item = blockIdx.x; item < 64 * 4; item += F.G) {
        const int bn = item >> 2, chunk = item & 3;
        float acc[8];
#pragma unroll
        for (int e = 0; e < 8; ++e) acc[e] = 0.f;
        const bf16* base = Kb + (size_t)(bn * 256 + F.wave * 32) * AW + chunk * 512 + F.lane * 8;
#pragma unroll
        for (int r = 0; r < 32; ++r) { const v4u q = *(const GAS v4u*)(base + (size_t)r * AW);
            acc[0] += bf_lo(q.x); acc[1] += bf_hi(q.x); acc[2] += bf_lo(q.y); acc[3] += bf_hi(q.y); acc[4] += bf_lo(q.z); acc[5] += bf_hi(q.z); acc[6] += bf_lo(q.w); acc[7] += bf_hi(q.w); }
#pragma unroll
        for (int e = 0; e < 8; ++e) part[F.wave * 512 + F.lane * 8 + e] = acc[e];
        __syncthreads();
        { float s = 0.f;
#pragma unroll
          for (int w = 0; w < 8; ++w) s += part[w * 512 + F.tid];
          const float mean = s * (1.0f / 256.0f); const unsigned hb = f2bf(mean); const float hf = __builtin_bit_cast(float, hb << 16);
          KMH[(size_t)bn * AW + chunk * 512 + F.tid] = (bf16)hb; KML[(size_t)bn * AW + chunk * 512 + F.tid] = (bf16)f2bf(mean - hf); }
        __syncthreads();
    }
}

__device__ __forceinline__ void gate_phase(Frame& F) {
    const bf16* Qb = (const bf16*)(F.ws + WS_Q); const bf16* KMH = (const bf16*)(F.ws + WS_KMH); const bf16* KML = (const bf16*)(F.ws + WS_KML);
    unsigned short* lists = (unsigned short*)(F.ws + WS_LIST); gu32* gcnt = F.ctl + CW_GCNT;
    LAS float* gl = (LAS float*)(F.lds + RING_OFF);
    LAS unsigned* lcnt = (LAS unsigned*)(F.lds + RING_OFF + 34816);
    LAS unsigned* gb = lcnt + 32;
    const int r32 = F.lane & 31, hi = F.lane >> 5;
    for (int uid = blockIdx.x; uid < 1024; uid += F.G) {
        const int bh = uid >> 5, qb = uid & 31, b = bh >> 4, h = bh & 15;
        if (qb == 0) continue;
        if (F.tid < 32) lcnt[F.tid] = 0u;
        const size_t trow = (size_t)b * SEQ + 256 * qb + 32 * F.wave + r32;
        f32x16 acc = {};
#pragma unroll
        for (int s = 0; s < 8; ++s) {
            const bf16x8 bq = *(const GAS bf16x8*)(Qb + trow * AW + h * HD + 16 * s + 8 * hi);
            const bf16x8 ah = *(const GAS bf16x8*)(KMH + (size_t)(b * 32 + r32) * AW + h * HD + 16 * s + 8 * hi);
            const bf16x8 al = *(const GAS bf16x8*)(KML + (size_t)(b * 32 + r32) * AW + h * HD + 16 * s + 8 * hi);
            acc = __builtin_amdgcn_mfma_f32_32x32x16_bf16(ah, bq, acc, 0, 0, 0);
            acc = __builtin_amdgcn_mfma_f32_32x32x16_bf16(al, bq, acc, 0, 0, 0);
        }
#pragma unroll
        for (int r = 0; r < 16; ++r) gl[(32 * F.wave + r32) * 33 + att::crow(r, hi)] = acc[r];
        __syncthreads();
        int s0 = 0, s1 = 0, s2 = 0; unsigned p0 = 0, p1 = 0, p2 = 0; const int nsel = qb < 3 ? qb : 3;
        if (F.tid < 256) {
            float v0 = -__builtin_inff(), v1 = v0, v2 = v0;
            for (int n = 0; n < qb; ++n) { const float g = gl[F.tid * 33 + n];
                if (g > v0) { v2 = v1; s2 = s1; v1 = v0; s1 = s0; v0 = g; s0 = n; }
                else if (g > v1) { v2 = v1; s2 = s1; v1 = g; s1 = n; }
                else if (g > v2) { v2 = g; s2 = n; } }
            p0 = __hip_atomic_fetch_add(lcnt + s0, 1u, __ATOMIC_RELAXED, __HIP_MEMORY_SCOPE_WORKGROUP);
            if (nsel > 1) p1 = __hip_atomic_fetch_add(lcnt + s1, 1u, __ATOMIC_RELAXED, __HIP_MEMORY_SCOPE_WORKGROUP);
            if (nsel > 2) p2 = __hip_atomic_fetch_add(lcnt + s2, 1u, __ATOMIC_RELAXED, __HIP_MEMORY_SCOPE_WORKGROUP);
        }
        __syncthreads();
        if (F.tid < 32) { const unsigned c = lcnt[F.tid]; gb[F.tid] = c ? __hip_atomic_fetch_add(gcnt + bh * 32 + F.tid, c, RLX_AGENT) : 0u; }
        __syncthreads();
        if (F.tid < 256) {
            unsigned short* lb = lists + (size_t)bh * LIST_STRIDE; const unsigned tl = (unsigned)(256 * qb + F.tid);
            lb[list_off(s0) + gb[s0] + p0] = (unsigned short)(tl | (0u << 13));
            if (nsel > 1) lb[list_off(s1) + gb[s1] + p1] = (unsigned short)(tl | (1u << 13));
            if (nsel > 2) lb[list_off(s2) + gb[s2] + p2] = (unsigned short)(tl | (2u << 13));
        }
        __syncthreads();
    }
}

__device__ __forceinline__ void attn_phase(Frame& F, char* ldsg) {
    const bf16* Qb = (const bf16*)(F.ws + WS_Q); const bf16* Kb = (const bf16*)(F.ws + WS_K); const bf16* Vb = (const bf16*)(F.ws + WS_V);
    bf16* PO = (bf16*)(F.ws + WS_PARTO); float2* ML = (float2*)(F.ws + WS_ML);
    const unsigned short* lists = (const unsigned short*)(F.ws + WS_LIST); const gu32* gcnt = F.ctl + CW_GCNT;
    LAS int* pre = (LAS int*)(F.lds + RING_OFF + 67584);
    for (int i = F.tid; i < 1024; i += NWAVES * 64) pre[i] = (int)((__hip_atomic_load(gcnt + i, RLX_AGENT) + 255u) >> 8);
    __syncthreads();
    if (F.wave == 0) {
        int loc[16]; int s = 0;
#pragma unroll
        for (int k = 0; k < 16; ++k) { loc[k] = pre[F.lane * 16 + k]; s += loc[k]; }
        int incl = s;
#pragma unroll
        for (int o = 1; o < 64; o <<= 1) { const int v = __shfl_up(incl, o); if (F.lane >= o) incl += v; }
        int run = incl - s;
#pragma unroll
        for (int k = 0; k < 16; ++k) { pre[F.lane * 16 + k] = run; run += loc[k]; }
        if (F.lane == 63) pre[1024] = incl;
    }
    __syncthreads();
    const int total = 1024 + pre[1024];
    LAS int* DSC = (LAS int*)(F.lds + RING_OFF + 67584 + 4224);
    const int nloc = (total > (int)blockIdx.x) ? (total - (int)blockIdx.x + F.G - 1) / F.G : 0;
    if (F.tid < nloc && F.tid < 64) {
        const int id = blockIdx.x + F.tid * F.G; int bhj, own, lpos, cnt;
        if (id < 1024) { bhj = id; own = 1; lpos = 0; cnt = 256; }
        else { const int x = id - 1024; int lo = 0, hi2 = 1023;
            while (lo < hi2) { const int mid = (lo + hi2 + 1) >> 1; if (pre[mid] <= x) lo = mid; else hi2 = mid - 1; }
            const int li = lo, chunk = x - pre[li]; bhj = li; own = 0; lpos = (li >> 5) * LIST_STRIDE + list_off(li & 31) + 256 * chunk;
            const int c = (int)__hip_atomic_load(gcnt + li, RLX_AGENT) - 256 * chunk; cnt = c < 256 ? c : 256; }
        DSC[4 * F.tid] = bhj; DSC[4 * F.tid + 1] = own; DSC[4 * F.tid + 2] = lpos; DSC[4 * F.tid + 3] = cnt;
    }
    __syncthreads();
    att::ItemCtx C{Qb, Kb, Vb, PO, ML, lists};
    att::attn_items(C, (const LAS int*)DSC, nloc < 64 ? nloc : 64, ldsg);
}

__device__ __forceinline__ void combine_phase(Frame& F) {
    const bf16* PO = (const bf16*)(F.ws + WS_PARTO); const float2* ML = (const float2*)(F.ws + WS_ML); bf16* CAT = (bf16*)(F.ws + WS_CAT);
    constexpr float C = att::SCALE * 1.4426950408889634f;
    const size_t gt = (size_t)blockIdx.x * (NWAVES * 64) + F.tid, NT = (size_t)F.G * NWAVES * 64;
    for (size_t idx = gt; idx < (size_t)32 * SEQ * 16; idx += NT) {
        const int dc = (int)(idx & 15), t = (int)((idx >> 4) & (SEQ - 1)), bh = (int)(idx >> 17), qb = t >> 8, nsel = qb < 3 ? qb : 3;
        float2 ml[4]; float mx;
        ml[3] = ML[((size_t)3 * 32 + bh) * SEQ + t]; mx = ml[3].x;
#pragma unroll
        for (int k = 0; k < 3; ++k) { if (k < nsel) { ml[k] = ML[((size_t)k * 32 + bh) * SEQ + t]; mx = fmaxf(mx, ml[k].x); } else ml[k] = make_float2(0.f, 0.f); }
        float acc[8]; float wsum = 0.f;
#pragma unroll
        for (int e = 0; e < 8; ++e) acc[e] = 0.f;
#pragma unroll
        for (int k = 0; k < 4; ++k) { if (k == 3 || k < nsel) {
            const float w = ml[k].y * __builtin_amdgcn_exp2f((ml[k].x - mx) * C); wsum += w;
            const v4u r = *(const GAS v4u*)(PO + (((size_t)k * 32 + bh) * SEQ + t) * HD + dc * 8);
            acc[0] += w * bf_lo(r.x); acc[1] += w * bf_hi(r.x); acc[2] += w * bf_lo(r.y); acc[3] += w * bf_hi(r.y);
            acc[4] += w * bf_lo(r.z); acc[5] += w * bf_hi(r.z); acc[6] += w * bf_lo(r.w); acc[7] += w * bf_hi(r.w); } }
        const float inv = 1.0f / wsum; const int b = bh >> 4, h = bh & 15;
        v4u o; o.x = pk2(acc[0] * inv, acc[1] * inv); o.y = pk2(acc[2] * inv, acc[3] * inv); o.z = pk2(acc[4] * inv, acc[5] * inv); o.w = pk2(acc[6] * inv, acc[7] * inv);
        *(GAS v4u*)(CAT + ((size_t)b * SEQ + t) * DM + PW + h * HD + dc * 8) = o;
    }
}

struct Args { const float* in[18]; float* out; unsigned char* ws; int ph_lo, ph_hi, li, pad; };
__global__ void __launch_bounds__(NWAVES * 64, 2) mega_fwd(Args args) {
    extern __shared__ __attribute__((aligned(16))) unsigned char lds[];
    Frame F;
    F.lds = (LAS unsigned char*)lds;
    F.MISC = (volatile LAS unsigned*)(F.lds + MISC_OFF);
    F.tid = threadIdx.x; F.lane = F.tid & 63; F.wave = __builtin_amdgcn_readfirstlane(F.tid >> 6);
    F.G = gridDim.x; F.ws = args.ws;
    F.ctl = (gu32*)(args.ws + WS_CTL);
    for (int u = F.tid; u < (LDS_BYTES - LDSCTL_OFF) / 4; u += NWAVES * 64) ((LAS unsigned*)(F.lds + LDSCTL_OFF))[u] = 0u;
    __syncthreads();
    XcdBarrier bar; bar.bar = (unsigned*)(F.ctl + CW_BAR); bar.x = 0; bar.st = nullptr;
    if (N_LAUNCHES == 1) bar = xcd_barrier_post((unsigned*)(F.ctl + CW_BAR), F.MISC + 8);
#define GRID_BAR() do { if (N_LAUNCHES == 1) xcd_barrier(bar); } while (0)
    const int lo = args.ph_lo, hi = args.ph_hi;
#define IN(k) (lo <= (k) && (k) < hi)
#define BOTH(k) (IN(k) && IN((k) + 1))
#ifndef PROBE_DUP
#define PROBE_DUP 0
#endif
#define DUPON(k) ((PROBE_DUP >> (k)) & 1)
#define REP(k) for (int _rep = 0; _rep < (DUPON(k) ? 2 : 1); ++_rep)
    unsigned char* ws = args.ws;
    const int G = F.G, cid = (int)blockIdx.x;
    float* out = args.out;

    if (IN(0)) { REP(0) { p0_prologue(F, args.in); } if (BOTH(0)) GRID_BAR(); }

    if (IN(1)) {
        { pg8::GemmKV g{(const char*)(ws + WS_MEMB), (const char*)(ws + WS_WXKV), DM, DM, 1024};
          pg8::OrderKV S{G, cid}; pg8::EpiSlabKV E{(float*)(ws + WS_SLAB)};
          pg8::gemm_phase<pg8::EpiSlabKV, pg8::OrderKV, true, true, pg8::GemmKV>(F.lds + RING_OFF, g, S, E); if (DUPON(16)) { pg8::gemm_phase<pg8::EpiSlabKV, pg8::OrderKV, true, true, pg8::GemmKV>(F.lds + RING_OFF, g, S, E); } }
        { pg8::Gemm g = pg8::make_gemm(ws + WS_XB, DM, ws + WS_WIN, DM, DM); pg8::StaticOrder S; S.init(M, MIXIN, G, cid);
          pg8::EpiMixIn E{(pg8::bf16_t*)(ws + WS_HP), (size_t)M * 2048, (const float*)(ws + WS_ROPE)};
          pg8::gemm_phase<pg8::EpiMixIn, pg8::StaticOrder, true, true>(F.lds + RING_OFF, g, S, E); if (DUPON(1)) { pg8::gemm_phase<pg8::EpiMixIn, pg8::StaticOrder, true, true>(F.lds + RING_OFF, g, S, E); } }
        if (BOTH(1)) GRID_BAR();
    }

    if (IN(2)) { REP(2) { pool_ew(F); kmean_phase(F); kv_reduce(F); } if (BOTH(2)) GRID_BAR(); }

    if (IN(3)) {
        { pg8::Gemm g = pg8::make_gemm(ws + WS_PM, PW, ws + WS_WPOOL, 512, 512); g.a_pn = 512 * 2; g.a_pn_sh = 1; pg8::StaticOrder S; S.init(M, PW, G, cid);
          pg8::EpiStore E{(pg8::bf16_t*)(ws + WS_CAT), DM, 0};
          pg8::gemm_phase<pg8::EpiStore, pg8::StaticOrder, true, true>(F.lds + RING_OFF, g, S, E); if (DUPON(3)) { pg8::gemm_phase<pg8::EpiStore, pg8::StaticOrder, true, true>(F.lds + RING_OFF, g, S, E); } }
        if (G == 256) { pg8::GemmAbs g{(const char*)(ws + WS_KVX), (const char*)(ws + WS_WXQ), (const char*)(ws + WS_WXO), cid < 128 ? 8192 : 4096, cid < 128 ? 4096 : 8192, 1024};
          pg8::OrderAbs S{cid}; pg8::EpiStoreAbs E{(pg8::bf16_t*)(ws + WS_WQK), (pg8::bf16_t*)(ws + WS_WVOT)};
          pg8::gemm_phase<pg8::EpiStoreAbs, pg8::OrderAbs, true, true, pg8::GemmAbs>(F.lds + RING_OFF, g, S, E); if (DUPON(17)) { pg8::gemm_phase<pg8::EpiStoreAbs, pg8::OrderAbs, true, true, pg8::GemmAbs>(F.lds + RING_OFF, g, S, E); } }
        gate_phase(F);
        if (BOTH(3)) GRID_BAR();
    }

    if (IN(4)) { REP(4) { attn_phase(F, (char*)lds + RING_OFF); __syncthreads(); } if (BOTH(4)) GRID_BAR(); }

    if (IN(5)) { REP(5) { combine_phase(F); } if (BOTH(5)) GRID_BAR(); }

    if (IN(6)) {
        pg8::Gemm g = pg8::make_gemm(ws + WS_CAT, DM, ws + WS_WOUT, DM, DM); pg8::StaticOrder S; S.init(M, DM, G, cid);
        pg8::EpiResid E{args.in[0], out, DM, DN_ALPHA};
        pg8::gemm_phase<pg8::EpiResid, pg8::StaticOrder, true, true>(F.lds + RING_OFF, g, S, E); if (DUPON(6)) { pg8::gemm_phase<pg8::EpiResid, pg8::StaticOrder, true, true>(F.lds + RING_OFF, g, S, E); }
        if (BOTH(6)) GRID_BAR();
    }
    if (IN(7)) { ln_rows<false>(F, out, (bf16*)(ws + WS_HB), (float2*)(ws + WS_STATS), args.in[6], args.in[7]); if (BOTH(7)) GRID_BAR(); }

    if (IN(9)) {
        if (G == 256) {
            pg8::Gemm g = pg8::make_gemm(ws + WS_HB, DM, ws + WS_WQK, DM, DM); g.b_pm = (size_t)1024 * DM * 2; g.b_pm_sh = 5;
            pg8::StaticOrder S; S.init(M, XH * 256, G, cid);
            pg8::EpiSoftmax E{(pg8::bf16_t*)(ws + WS_PB), XH * MEMLEN, 0.03125f * 1.4426950408889634f};
            pg8::gemm_phase<pg8::EpiSoftmax, pg8::StaticOrder, false, true>(F.lds + RING_OFF, g, S, E); if (DUPON(9)) { pg8::gemm_phase<pg8::EpiSoftmax, pg8::StaticOrder, false, true>(F.lds + RING_OFF, g, S, E); }
        }
        if (BOTH(9)) GRID_BAR();
    }
    if (IN(11)) {
        pg8::Gemm g = pg8::make_gemm(ws + WS_PB, XH * MEMLEN, ws + WS_WVOT, 2048, XH * MEMLEN); g.b_pm = (size_t)1024 * 2; g.b_pm_sh = 5;
        pg8::StaticOrder S; S.init(M, DM, G, cid);
        pg8::EpiResidLN E{out, (const pg8::f32x2*)(ws + WS_STATS), 6};
        pg8::gemm_phase<pg8::EpiResidLN, pg8::StaticOrder, true, true>(F.lds + RING_OFF, g, S, E);
        if (BOTH(11)) GRID_BAR();
    }
    if (IN(12)) { ln_rows<false>(F, out, (bf16*)(ws + WS_HB), (float2*)(ws + WS_STATS), args.in[11], args.in[12]); if (BOTH(12)) GRID_BAR(); }

    if (IN(13)) {
        pg8::Gemm g = pg8::make_gemm(ws + WS_HB, DM, ws + WS_WGU, DM, DM); pg8::StaticOrder S; S.init(M, 2 * FF, G, cid);
        pg8::EpiSwiGLU E{(pg8::bf16_t*)(ws + WS_G), FF};
        pg8::gemm_phase<pg8::EpiSwiGLU, pg8::StaticOrder, true, true>(F.lds + RING_OFF, g, S, E); if (DUPON(13)) { pg8::gemm_phase<pg8::EpiSwiGLU, pg8::StaticOrder, true, true>(F.lds + RING_OFF, g, S, E); }
        if (BOTH(13)) GRID_BAR();
    }
    if (IN(14)) {
        pg8::Gemm g = pg8::make_gemm(ws + WS_G, FF, ws + WS_WDN, FF, FF); pg8::StaticOrder S; S.init(M, DM, G, cid);
        pg8::EpiResidLN E{out, (const pg8::f32x2*)(ws + WS_STATS), 11};
        pg8::gemm_phase<pg8::EpiResidLN, pg8::StaticOrder, true, true>(F.lds + RING_OFF, g, S, E);
        if (BOTH(14)) GRID_BAR();
    }
    if (IN(15)) { ln_rows<true>(F, out, nullptr, nullptr, args.in[16], args.in[17]); }
#undef IN
#undef BOTH
#undef GRID_BAR
}

extern "C" void kernel_launch(void* const* d_in, const int* in_sizes, int n_in, void* d_out, int out_size, void* d_ws, size_t ws_size, hipStream_t stream) {
    static int grid = 0;
    if (grid == 0) {
        if (n_in != 18 || in_sizes[0] != M * DM || out_size != M * DM || ws_size < WS_END) { fprintf(stderr, "kernel_launch: shape / workspace mismatch (n_in %d, in0 %d, out %d, ws %zu, need %zu)\n", n_in, n_in > 0 ? in_sizes[0] : -1, out_size, ws_size, (size_t)WS_END); grid = -1; return; }
        int dev = 0, cus = 0, per_cu = 0;
        if (hipGetDevice(&dev) != hipSuccess || hipDeviceGetAttribute(&cus, hipDeviceAttributeMultiprocessorCount, dev) != hipSuccess) { grid = -1; return; }
        if (hipFuncSetAttribute((const void*)mega_fwd, hipFuncAttributeMaxDynamicSharedMemorySize, LDS_BYTES) != hipSuccess) { fprintf(stderr, "kernel_launch: hipFuncSetAttribute failed\n"); grid = -1; return; }
        if (hipOccupancyMaxActiveBlocksPerMultiprocessor(&per_cu, (const void*)mega_fwd, NWAVES * 64, LDS_BYTES) != hipSuccess || per_cu < 1)
            fprintf(stderr, "kernel_launch: note: occupancy query reports %d workgroups per CU\n", per_cu);
        (void)hipGetLastError();
        grid = cus;
        if (grid != 256) fprintf(stderr, "kernel_launch: %d CUs; the cross-attention score phase needs a 256-workgroup grid\n", grid);
    }
    if (grid < 0) return;
    if (hipMemsetAsync((char*)d_ws + WS_CTL, 0, CTL_ZERO_BYTES, stream) != hipSuccess) return;
    Args a{};
    for (int i = 0; i < 18; ++i) a.in[i] = (const float*)d_in[i];
    a.out = (float*)d_out; a.ws = (unsigned char*)d_ws; a.pad = 0;
    for (int li = 0; li < N_LAUNCHES; ++li) {
        a.ph_lo = (N_LAUNCHES == 1) ? 0 : li; a.ph_hi = (N_LAUNCHES == 1) ? N_PHASES : li + 1; a.li = li;
        hipLaunchKernelGGL(mega_fwd, dim3(grid), dim3(NWAVES * 64), LDS_BYTES, stream, a);
        if (hipPeekAtLastError() != hipSuccess) { fprintf(stderr, "kernel_launch: launch %d failed\n", li); break; }
    }
}
```

```cpp
#include <hip/hip_runtime.h>
#include <cstdio>
#include <cstdint>

namespace pg8 {
#define PG8_LAS __attribute__((address_space(3)))
typedef unsigned short bf16_t;
typedef short bf16x8 __attribute__((ext_vector_type(8)));
typedef float f32x4 __attribute__((ext_vector_type(4)));
typedef float f32x2 __attribute__((ext_vector_type(2)));
typedef unsigned u32x4 __attribute__((ext_vector_type(4)));
typedef unsigned u32x2 __attribute__((ext_vector_type(2)));
constexpr int BM = 256, BK = 64, HALF = 128, HTB = HALF * BK * 2  , STAGE_BYTES = 8 * HTB, NXCD = 8, WGM = 8;

__host__ __device__ __forceinline__ int lds_byte(int r, int c) { const int st = (r >> 4) * 2 + (c >> 5), rr = r & 15, cc = c & 31, ob = rr * 64 + cc * 2; return st * 1024 + (ob ^ (((ob >> 9) & 1) << 5)); }
__host__ __device__ __forceinline__ void stage_rc(int b, int& R, int& C) { const int st = b / 1024, sb = b % 1024, swz = sb ^ (((sb >> 9) & 1) << 5); R = (st >> 1) * 16 + swz / 64; C = (st & 1) * 32 + (swz % 64) / 2; }
__host__ __device__ __forceinline__ int perm32(int rho) { const int n = rho >> 4, i = rho & 15; return 8 * (i >> 2) + 4 * n + (i & 3); }

struct Unit { int pm, pn, pz; };
struct Gemm {
    const char* A; const char* B; int lda, ldb, K;
    size_t a_pm, a_pn; int a_pn_sh; size_t b_pn, b_pm; int b_pm_sh;
    __device__ __forceinline__ const char* a_ptr(const Unit& u) const { return A + (size_t)u.pm * a_pm + (size_t)(u.pn >> a_pn_sh) * a_pn; }
    __device__ __forceinline__ const char* b_ptr(const Unit& u) const { return B + (size_t)u.pn * b_pn + (size_t)(u.pm >> b_pm_sh) * b_pm; }
};
__device__ __forceinline__ Gemm make_gemm(const void* A, int lda, const void* B, int ldb, int K) {
    Gemm g; g.A = (const char*)A; g.B = (const char*)B; g.lda = lda; g.ldb = ldb; g.K = K;
    g.a_pm = (size_t)BM * lda * 2; g.a_pn = 0; g.a_pn_sh = 0; g.b_pn = (size_t)BM * ldb * 2; g.b_pm = 0; g.b_pm_sh = 0; return g;
}

struct StaticOrder {
    int nM, nN, nwg, G, c;
    __host__ __device__ void init(int M, int N, int G_, int c_) { nM = M / BM; nN = N / BM; nwg = nM * nN; G = G_; c = c_; }
    __host__ __device__ bool next(int i, Unit& u) const {
        const long L = (long)i * G + c; if (L >= nwg) return false;
        int wgid = (int)L; { const int q = nwg / NXCD, r = nwg % NXCD, xcd = wgid % NXCD, off = wgid / NXCD; wgid = (xcd < r ? xcd * (q + 1) : r * (q + 1) + (xcd - r) * q) + off; }
        const int nig = WGM * nN, gid = wgid / nig, fm = gid * WGM, gsz = (nM - fm) < WGM ? (nM - fm) : WGM;
        u.pm = fm + ((wgid % nig) % gsz); u.pn = (wgid % nig) / gsz; u.pz = 0; return true;
    }
    __device__ __forceinline__ void a_ready(const Unit&) const {}
    __device__ __forceinline__ void done(const Unit&) const {}
};

__device__ __forceinline__ unsigned cvt_pk_bf16(float lo, float hi) { unsigned r; asm volatile("v_cvt_pk_bf16_f32 %0, %1, %2" : "=v"(r) : "v"(lo), "v"(hi)); return r; }

struct EpiMixIn {
    static constexpr bool PERM = true, AFTER_DRAIN = false;
    bf16_t* base; size_t tstride; const float* rope;
    __device__ __forceinline__ void operator()(const f32x4 (&acc)[2][2][4][2], const Unit& u, int wr, int wc, int fr, int fq) const {
        const int t = u.pn >> 3; const bool rp = (t == 1) || (t == 2);
        bf16_t* ob = base + (size_t)t * tstride;
        const int row0 = u.pm * BM + wr * 64 + fr, col0 = (u.pn & 7) * BM + wc * 32 + 8 * fq;
#pragma unroll
        for (int ai = 0; ai < 2; ++ai)
#pragma unroll
            for (int m = 0; m < 4; ++m) {
                const int row = row0 + ai * HALF + m * 16; bf16_t* rowp = ob + (size_t)row * 2048 + col0;
                f32x4 cs0 = (f32x4){1.f, 0.f, 1.f, 0.f}, cs1 = cs0;
                if (rp) { const f32x4* tp = (const f32x4*)(rope + ((size_t)(row & 8191) * 64 + wc * 16 + fq * 4) * 2); cs0 = tp[0]; cs1 = tp[1]; }
#pragma unroll
                for (int bj = 0; bj < 2; ++bj) {
                    const f32x4 v0 = acc[ai][bj][m][0], v1 = acc[ai][bj][m][1];
                    const float a0 = v0[0] * cs0[0] - v0[1] * cs0[1], a1 = v0[1] * cs0[0] + v0[0] * cs0[1];
                    const float a2 = v0[2] * cs0[2] - v0[3] * cs0[3], a3 = v0[3] * cs0[2] + v0[2] * cs0[3];
                    const float b0 = v1[0] * cs1[0] - v1[1] * cs1[1], b1 = v1[1] * cs1[0] + v1[0] * cs1[1];
                    const float b2 = v1[2] * cs1[2] - v1[3] * cs1[3], b3 = v1[3] * cs1[2] + v1[2] * cs1[3];
                    u32x4 w; w.x = cvt_pk_bf16(a0, a1); w.y = cvt_pk_bf16(a2, a3); w.z = cvt_pk_bf16(b0, b1); w.w = cvt_pk_bf16(b2, b3);
                    *(u32x4*)(rowp + bj * HALF) = w;
                }
            }
    }
};
struct EpiStore {
    static constexpr bool PERM = true, AFTER_DRAIN = false;
    bf16_t* O; int ldc, coff;
    __device__ __forceinline__ void operator()(const f32x4 (&acc)[2][2][4][2], const Unit& u, int wr, int wc, int fr, int fq) const {
        const int row0 = u.pm * BM + wr * 64 + fr, col0 = coff + u.pn * BM + wc * 32 + 8 * fq;
#pragma unroll
        for (int ai = 0; ai < 2; ++ai)
#pragma unroll
            for (int m = 0; m < 4; ++m) { bf16_t* rowp = O + (size_t)(row0 + ai * HALF + m * 16) * ldc + col0;
#pragma unroll
                for (int bj = 0; bj < 2; ++bj) { const f32x4 v0 = acc[ai][bj][m][0], v1 = acc[ai][bj][m][1];
                    u32x4 w; w.x = cvt_pk_bf16(v0[0], v0[1]); w.y = cvt_pk_bf16(v0[2], v0[3]); w.z = cvt_pk_bf16(v1[0], v1[1]); w.w = cvt_pk_bf16(v1[2], v1[3]);
                    *(u32x4*)(rowp + bj * HALF) = w; } }
    }
};
struct EpiResid {
    static constexpr bool PERM = true, AFTER_DRAIN = false;
    const float* res; bf16_t* out; int ldc; float alpha;
    __device__ __forceinline__ void operator()(const f32x4 (&acc)[2][2][4][2], const Unit& u, int wr, int wc, int fr, int fq) const {
        const int row0 = u.pm * BM + wr * 64 + fr, col0 = u.pn * BM + wc * 32 + 8 * fq;
#pragma unroll
        for (int ai = 0; ai < 2; ++ai)
#pragma unroll
            for (int m = 0; m < 4; ++m) { const size_t off = (size_t)(row0 + ai * HALF + m * 16) * ldc + col0;
#pragma unroll
                for (int bj = 0; bj < 2; ++bj) { const f32x4 r0 = *(const f32x4*)(res + off + bj * HALF), r1 = *(const f32x4*)(res + off + bj * HALF + 4);
                    const f32x4 v0 = r0 * alpha + acc[ai][bj][m][0], v1 = r1 * alpha + acc[ai][bj][m][1];
                    u32x4 w; w.x = cvt_pk_bf16(v0[0], v0[1]); w.y = cvt_pk_bf16(v0[2], v0[3]); w.z = cvt_pk_bf16(v1[0], v1[1]); w.w = cvt_pk_bf16(v1[2], v1[3]);
                    *(u32x4*)(out + off + bj * HALF) = w; }
                asm volatile("" ::: "memory"); }
    }
};
struct EpiSwiGLU {
    static constexpr bool PERM = true, AFTER_DRAIN = false;
    bf16_t* G; int ldc;
    __device__ __forceinline__ float act(float g, float u) const { return g * u * __builtin_amdgcn_rcpf(1.0f + __builtin_amdgcn_exp2f(-1.4426950408889634f * g)); }
    __device__ __forceinline__ void operator()(const f32x4 (&acc)[2][2][4][2], const Unit& u, int wr, int wc, int fr, int fq) const {
        const int row0 = u.pm * BM + wr * 64 + fr, col0 = u.pn * HALF + wc * 32 + 8 * fq;
#pragma unroll
        for (int ai = 0; ai < 2; ++ai)
#pragma unroll
            for (int m = 0; m < 4; ++m) { bf16_t* rowp = G + (size_t)(row0 + ai * HALF + m * 16) * ldc + col0;
                const f32x4 g0 = acc[ai][0][m][0], g1 = acc[ai][0][m][1], u0 = acc[ai][1][m][0], u1 = acc[ai][1][m][1];
                u32x4 w; w.x = cvt_pk_bf16(act(g0[0], u0[0]), act(g0[1], u0[1])); w.y = cvt_pk_bf16(act(g0[2], u0[2]), act(g0[3], u0[3]));
                w.z = cvt_pk_bf16(act(g1[0], u1[0]), act(g1[1], u1[1])); w.w = cvt_pk_bf16(act(g1[2], u1[2]), act(g1[3], u1[3]));
                *(u32x4*)rowp = w; }
    }
};
struct EpiSoftmax {
    static constexpr bool PERM = true, AFTER_DRAIN = true;
    bf16_t* P; int ldc; float c2;
    __device__ __forceinline__ void fused(f32x4 (&acc)[2][2][4][2], const Unit& u, int wr, int wc, int fr, int fq, PG8_LAS unsigned char* lds, int wid, int lane) const {
        PG8_LAS float* T1 = (PG8_LAS float*)lds;
        PG8_LAS float* T2 = (PG8_LAS float*)(lds + 4096);
#pragma unroll
        for (int ai = 0; ai < 2; ++ai)
#pragma unroll
            for (int m = 0; m < 4; ++m) { float mx = -3.0e38f;
#pragma unroll
                for (int bj = 0; bj < 2; ++bj)
#pragma unroll
                    for (int n = 0; n < 2; ++n) { const f32x4 x = acc[ai][bj][m][n]; mx = fmaxf(mx, fmaxf(fmaxf(x[0], x[1]), fmaxf(x[2], x[3]))); }
                mx = fmaxf(mx, __shfl_xor(mx, 16)); mx = fmaxf(mx, __shfl_xor(mx, 32));
                if (fq == 0) T1[(ai * HALF + wr * 64 + m * 16 + fr) * 4 + wc] = mx; }
        asm volatile("s_waitcnt lgkmcnt(0)" ::: "memory"); __builtin_amdgcn_s_barrier(); asm volatile("" ::: "memory");
#pragma unroll
        for (int ai = 0; ai < 2; ++ai)
#pragma unroll
            for (int m = 0; m < 4; ++m) { const int r = ai * HALF + wr * 64 + m * 16 + fr;
                const f32x4 t = *(const PG8_LAS f32x4*)(T1 + r * 4); const float mx = fmaxf(fmaxf(t[0], t[1]), fmaxf(t[2], t[3])) * c2; float s = 0.f;
#pragma unroll
                for (int bj = 0; bj < 2; ++bj)
#pragma unroll
                    for (int n = 0; n < 2; ++n) { f32x4 x = acc[ai][bj][m][n];
#pragma unroll
                        for (int e = 0; e < 4; ++e) { x[e] = __builtin_amdgcn_exp2f(x[e] * c2 - mx); s += x[e]; }
                        acc[ai][bj][m][n] = x; }
                s += __shfl_xor(s, 16); s += __shfl_xor(s, 32);
                if (fq == 0) T2[r * 4 + wc] = s; }
        asm volatile("s_waitcnt lgkmcnt(0)" ::: "memory"); __builtin_amdgcn_s_barrier(); asm volatile("" ::: "memory");
        const int row0 = u.pm * BM + wr * 64 + fr, col0 = u.pn * BM + wc * 32 + 8 * fq;
#pragma unroll
        for (int ai = 0; ai < 2; ++ai)
#pragma unroll
            for (int m = 0; m < 4; ++m) { const int r = ai * HALF + wr * 64 + m * 16 + fr;
                const f32x4 t = *(const PG8_LAS f32x4*)(T2 + r * 4); const float inv = 1.0f / ((t[0] + t[1]) + (t[2] + t[3]));
                bf16_t* rowp = P + (size_t)(row0 + ai * HALF + m * 16) * ldc + col0;
#pragma unroll
                for (int bj = 0; bj < 2; ++bj) { const f32x4 v0 = acc[ai][bj][m][0] * inv, v1 = acc[ai][bj][m][1] * inv;
                    u32x4 w; w.x = cvt_pk_bf16(v0[0], v0[1]); w.y = cvt_pk_bf16(v0[2], v0[3]); w.z = cvt_pk_bf16(v1[0], v1[1]); w.w = cvt_pk_bf16(v1[2], v1[3]);
                    *(u32x4*)(rowp + bj * HALF) = w; } }
    }
};

struct GemmKV {
    const char* memb; const char* wkv; int lda, ldb, K;
    __device__ __forceinline__ const char* a_ptr(const Unit& u) const { return memb + (size_t)u.pm * (BM * 4096 * 2) + (size_t)u.pz * 2048; }
    __device__ __forceinline__ const char* b_ptr(const Unit& u) const { return wkv + (size_t)u.pn * (BM * 4096 * 2) + (size_t)u.pz * 2048; }
};
struct OrderKV {
    int G, c;
    __device__ __forceinline__ bool next(int i, Unit& u) const { const int L = i * G + c; if (L >= 256) return false; const int tile = L >> 2; u.pz = L & 3; u.pm = tile >> 5; u.pn = tile & 31; return true; }
    __device__ __forceinline__ void a_ready(const Unit&) const {}
    __device__ __forceinline__ void done(const Unit&) const {}
};
struct EpiSlabKV {
    static constexpr bool PERM = false, AFTER_DRAIN = false;
    float* S;
    __device__ __forceinline__ void operator()(const f32x4 (&acc)[2][2][4][2], const Unit& u, int wr, int wc, int fr, int fq) const {
        float* C = S + (size_t)u.pz * (512 * 8192);
        const int row0 = u.pm * BM + wr * 64 + fr, col0 = u.pn * BM + wc * 32 + 4 * fq;
#pragma unroll
        for (int ai = 0; ai < 2; ++ai)
#pragma unroll
            for (int m = 0; m < 4; ++m) { float* rowp = C + (size_t)(row0 + ai * HALF + m * 16) * 8192 + col0;
#pragma unroll
                for (int bj = 0; bj < 2; ++bj)
#pragma unroll
                    for (int n = 0; n < 2; ++n) *(f32x4*)(rowp + bj * HALF + n * 16) = acc[ai][bj][m][n]; }
    }
};
struct GemmAbs {
    const char* kvx; const char* wq_raw; const char* wo_t; int lda, ldb, K;
    __device__ __forceinline__ const char* a_ptr(const Unit& u) const {
        return u.pz ? wo_t + (size_t)u.pm * (BM * 4096 * 2) + (size_t)(u.pn & 3) * 2048
                    : kvx + (size_t)(u.pm >> 2) * (BM * 8192 * 2) + (size_t)(u.pm & 3) * 2048; }
    __device__ __forceinline__ const char* b_ptr(const Unit& u) const {
        return u.pz ? kvx + 8192 + (size_t)(u.pn >> 2) * (BM * 8192 * 2) + (size_t)(u.pn & 3) * 2048
                    : wq_raw + (size_t)u.pn * (BM * 4096 * 2) + (size_t)(u.pm & 3) * 2048; }
};
struct OrderAbs {
    int c;
    __device__ __forceinline__ bool next(int i, Unit& u) const { if (i != 0 || c >= 256) return false; if (c < 128) { u.pz = 0; u.pm = c >> 4; u.pn = c & 15; } else { const int t = c - 128; u.pz = 1; u.pm = t >> 3; u.pn = t & 7; } return true; }
    __device__ __forceinline__ void a_ready(const Unit&) const {}
    __device__ __forceinline__ void done(const Unit&) const {}
};
struct EpiStoreAbs {
    static constexpr bool PERM = true, AFTER_DRAIN = false;
    bf16_t* WQK; bf16_t* WVOT;
    __device__ __forceinline__ void operator()(const f32x4 (&acc)[2][2][4][2], const Unit& u, int wr, int wc, int fr, int fq) const {
        bf16_t* O = u.pz ? WVOT : WQK; const int ldc = u.pz ? 2048 : 4096;
        const int row0 = u.pm * BM + wr * 64 + fr, col0 = u.pn * BM + wc * 32 + 8 * fq;
#pragma unroll
        for (int ai = 0; ai < 2; ++ai)
#pragma unroll
            for (int m = 0; m < 4; ++m) { bf16_t* rowp = O + (size_t)(row0 + ai * HALF + m * 16) * ldc + col0;
#pragma unroll
                for (int bj = 0; bj < 2; ++bj) { const f32x4 v0 = acc[ai][bj][m][0], v1 = acc[ai][bj][m][1];
                    u32x4 w; w.x = cvt_pk_bf16(v0[0], v0[1]); w.y = cvt_pk_bf16(v0[2], v0[3]); w.z = cvt_pk_bf16(v1[0], v1[1]); w.w = cvt_pk_bf16(v1[2], v1[3]);
                    *(u32x4*)(rowp + bj * HALF) = w; } }
    }
};
struct EpiResidLN {
    static constexpr bool PERM = true, AFTER_DRAIN = false;
    bf16_t* T; const f32x2* stats; int gi;
    __device__ __forceinline__ void operator()(const f32x4 (&acc)[2][2][4][2], const Unit& u, int wr, int wc, int fr, int fq) const {
        constexpr int ldc = 4096; constexpr float alpha = 1.189207115002721f;
        const float* const __attribute__((address_space(4)))* inp = (const float* const __attribute__((address_space(4)))*)__builtin_amdgcn_kernarg_segment_ptr();
        const float* g = inp[gi]; const float* b = inp[gi + 1];
        const int row0 = u.pm * BM + wr * 64 + fr, col0 = u.pn * BM + wc * 32 + 8 * fq;
        f32x4 gv[2][2], bv[2][2];
#pragma unroll
        for (int bj = 0; bj < 2; ++bj)
#pragma unroll
            for (int n = 0; n < 2; ++n) { gv[bj][n] = *(const f32x4*)(g + col0 + bj * HALF + n * 4) * alpha; bv[bj][n] = *(const f32x4*)(b + col0 + bj * HALF + n * 4) * alpha; }
#pragma unroll
        for (int ai = 0; ai < 2; ++ai)
#pragma unroll
            for (int m = 0; m < 4; ++m) { const int row = row0 + ai * HALF + m * 16; const size_t off = (size_t)row * ldc + col0; const f32x2 st = stats[row];
#pragma unroll
                for (int bj = 0; bj < 2; ++bj) { const u32x4 r = *(const u32x4*)(T + off + bj * HALF);
                    const f32x4 t0 = (f32x4){__builtin_bit_cast(float, r.x << 16), __builtin_bit_cast(float, r.x & 0xffff0000u), __builtin_bit_cast(float, r.y << 16), __builtin_bit_cast(float, r.y & 0xffff0000u)};
                    const f32x4 t1 = (f32x4){__builtin_bit_cast(float, r.z << 16), __builtin_bit_cast(float, r.z & 0xffff0000u), __builtin_bit_cast(float, r.w << 16), __builtin_bit_cast(float, r.w & 0xffff0000u)};
                    const f32x4 v0 = ((t0 - st.x) * st.y) * gv[bj][0] + bv[bj][0] + acc[ai][bj][m][0], v1 = ((t1 - st.x) * st.y) * gv[bj][1] + bv[bj][1] + acc[ai][bj][m][1];
                    u32x4 w; w.x = cvt_pk_bf16(v0[0], v0[1]); w.y = cvt_pk_bf16(v0[2], v0[3]); w.z = cvt_pk_bf16(v1[0], v1[1]); w.w = cvt_pk_bf16(v1[2], v1[3]);
                    *(u32x4*)(T + off + bj * HALF) = w; }
                asm volatile("" ::: "memory"); }
    }
};

template <class Epi, class Sched, bool ALIGN_EPI = false, bool SP2 = false, class GT = Gemm>
__device__ __forceinline__ void gemm_phase(PG8_LAS unsigned char* lds, const GT g, const Sched& S, const Epi& E) {
    const int tid = threadIdx.x, wid = __builtin_amdgcn_readfirstlane(tid >> 6), lane = tid & 63, wr = wid >> 2, wc = wid & 3, fr = lane & 15, fq = lane >> 4;
    const int K = g.K, nt = K / BK;
    unsigned voffA[2], voffB[2];
#pragma unroll
    for (int i = 0; i < 2; ++i) { int R, C; stage_rc(tid * 16 + i * 8192, R, C); const int Rb = Epi::PERM ? ((R & ~31) + perm32(R & 31)) : R;
        voffA[i] = (unsigned)(R * g.lda + C) * 2u; voffB[i] = (unsigned)(Rb * g.ldb + C) * 2u; }
    const size_t kstep = (size_t)(BK * 2);
    const size_t hA = (size_t)HALF * g.lda * 2, hB = (size_t)HALF * g.ldb * 2;
    const unsigned ldsw = (unsigned)wid * 1024u;
    const int aoff = lds_byte(wr * 64 + fr, fq * 8), boff = lds_byte(wc * 32 + fr, fq * 8);
#define PG8_SA(b, h) (((b) * 2 + (h)) * HTB)
#define PG8_SB(b, h) ((4 + (b) * 2 + (h)) * HTB)
#define PG8_STAGE(bufoff, gbase, voff) do { _Pragma("unroll") for (int _i = 0; _i < 2; ++_i) \
        __builtin_amdgcn_global_load_lds((const unsigned*)((const char*)(gbase) + (voff)[_i]), (PG8_LAS unsigned*)(lds + (bufoff) + ldsw + _i * 8192), 16, 0, 0); } while (0)
#define PG8_LDA(dst, b, h) do { _Pragma("unroll") for (int m = 0; m < 4; ++m) _Pragma("unroll") for (int k = 0; k < 2; ++k) dst[m][k] = *(const PG8_LAS bf16x8*)(lds + PG8_SA(b, h) + aoff + m * 2048 + k * 1024); } while (0)
#define PG8_LDB(dst, b, h) do { _Pragma("unroll") for (int n = 0; n < 2; ++n) _Pragma("unroll") for (int k = 0; k < 2; ++k) dst[n][k] = *(const PG8_LAS bf16x8*)(lds + PG8_SB(b, h) + boff + n * 2048 + k * 1024); } while (0)
#define PG8_MMA(ai, bj, At, Bt) do { __builtin_amdgcn_s_setprio(1); _Pragma("unroll") for (int m = 0; m < 4; ++m) _Pragma("unroll") for (int n = 0; n < 2; ++n) _Pragma("unroll") for (int k = 0; k < 2; ++k) \
        acc[ai][bj][m][n] = __builtin_amdgcn_mfma_f32_16x16x32_bf16(Bt[n][k], At[m][k], acc[ai][bj][m][n], 0, 0, 0); __builtin_amdgcn_s_setprio(0); } while (0)
#define PG8_WAIT_V(n) asm volatile("s_waitcnt vmcnt(" #n ")" ::: "memory")
#define PG8_WAIT_L(n) asm volatile("s_waitcnt lgkmcnt(" #n ")" ::: "memory")
#define PG8_BAR __builtin_amdgcn_s_barrier()
#define PG8_SCHED __builtin_amdgcn_sched_barrier(0)
    Unit cur, nxt; int ui = 0;
    if (!S.next(0, cur)) return;
    f32x4 acc[2][2][4][2];
#pragma unroll
    for (int a = 0; a < 2; ++a)
#pragma unroll
        for (int b = 0; b < 2; ++b)
#pragma unroll
            for (int m = 0; m < 4; ++m)
#pragma unroll
                for (int n = 0; n < 2; ++n) acc[a][b][m][n] = (f32x4){0.f, 0.f, 0.f, 0.f};
    bf16x8 At[4][2], B0[2][2], B1[2][2];
    const char* cA = g.a_ptr(cur); const char* cB = g.b_ptr(cur);
    S.a_ready(cur);
    if constexpr (SP2) {
        PG8_STAGE(PG8_SB(0, 0), cB, voffB); PG8_STAGE(PG8_SB(0, 1), cB + hB, voffB); PG8_STAGE(PG8_SA(0, 0), cA, voffA); PG8_STAGE(PG8_SA(0, 1), cA + hA, voffA);
        if (wr == 1) PG8_BAR;
        PG8_WAIT_V(2); PG8_BAR;
        PG8_STAGE(PG8_SB(1, 0), cB + kstep, voffB); PG8_STAGE(PG8_SA(1, 0), cA + kstep, voffA); PG8_STAGE(PG8_SB(1, 1), cB + hB + kstep, voffB);
        PG8_WAIT_V(6); PG8_BAR;
    } else {
        PG8_STAGE(PG8_SB(0, 0), cB, voffB); PG8_STAGE(PG8_SA(0, 0), cA, voffA); PG8_STAGE(PG8_SB(0, 1), cB + hB, voffB); PG8_STAGE(PG8_SA(0, 1), cA + hA, voffA);
        if (wr == 1) PG8_BAR;
        PG8_WAIT_V(4); PG8_BAR;
        PG8_STAGE(PG8_SB(1, 0), cB + kstep, voffB); PG8_STAGE(PG8_SA(1, 0), cA + kstep, voffA); PG8_STAGE(PG8_SB(1, 1), cB + hB + kstep, voffB);
        PG8_WAIT_V(6); PG8_BAR;
    }
    for (;;) {
        const bool has_next = S.next(ui + 1, nxt);
        const char* nA = has_next ? g.a_ptr(nxt) : cA; const char* nB = has_next ? g.b_ptr(nxt) : cB;
        for (int t = 0; t < nt; t += 2) {
            const bool last = (t == nt - 2);
            const char* a1 = cA + (size_t)(t + 1) * kstep;
            const char* a2 = last ? nA : cA + (size_t)(t + 2) * kstep; const char* b2 = last ? nB : cB + (size_t)(t + 2) * kstep;
            const char* a3 = a2 + kstep; const char* b3 = b2 + kstep;
            if (last && has_next) S.a_ready(nxt);
            if constexpr (SP2) {
            PG8_LDB(B0, 0, 0); PG8_LDB(B1, 0, 1); PG8_SCHED; PG8_LDA(At, 0, 0); PG8_STAGE(PG8_SA(1, 1), a1 + hA, voffA);
            PG8_WAIT_V(8); PG8_WAIT_L(0); PG8_BAR; PG8_MMA(0, 0, At, B0); PG8_MMA(0, 1, At, B1); PG8_BAR; PG8_SCHED;
            PG8_LDA(At, 0, 1); PG8_STAGE(PG8_SB(0, 0), b2, voffB); PG8_STAGE(PG8_SB(0, 1), b2 + hB, voffB); PG8_STAGE(PG8_SA(0, 0), a2, voffA);
            PG8_WAIT_V(8); PG8_WAIT_L(0); PG8_BAR; PG8_MMA(1, 0, At, B0); PG8_MMA(1, 1, At, B1); PG8_BAR; PG8_SCHED;
            PG8_LDB(B0, 1, 0); PG8_LDB(B1, 1, 1); PG8_SCHED; PG8_LDA(At, 1, 0); PG8_STAGE(PG8_SA(0, 1), a2 + hA, voffA);
            PG8_WAIT_V(8); PG8_WAIT_L(0); PG8_BAR; PG8_MMA(0, 0, At, B0); PG8_MMA(0, 1, At, B1); PG8_BAR; PG8_SCHED;
            PG8_LDA(At, 1, 1); PG8_STAGE(PG8_SB(1, 0), b3, voffB); PG8_STAGE(PG8_SB(1, 1), b3 + hB, voffB); PG8_STAGE(PG8_SA(1, 0), a3, voffA);
            PG8_WAIT_V(8); PG8_WAIT_L(0); PG8_BAR; PG8_MMA(1, 0, At, B0); PG8_MMA(1, 1, At, B1); PG8_BAR; PG8_SCHED;
            } else {
            PG8_LDB(B0, 0, 0); PG8_SCHED; PG8_LDA(At, 0, 0); PG8_STAGE(PG8_SA(1, 1), a1 + hA, voffA);
            PG8_WAIT_L(8); PG8_BAR; PG8_WAIT_L(0); PG8_MMA(0, 0, At, B0); PG8_BAR; PG8_SCHED;
            PG8_LDB(B1, 0, 1); PG8_STAGE(PG8_SB(0, 0), b2, voffB);
            PG8_BAR; PG8_WAIT_L(0); PG8_MMA(0, 1, At, B1); PG8_BAR;
            PG8_LDA(At, 0, 1); PG8_STAGE(PG8_SA(0, 0), a2, voffA);
            PG8_BAR; PG8_WAIT_L(0); PG8_MMA(1, 0, At, B0); PG8_BAR; PG8_SCHED;
            PG8_STAGE(PG8_SB(0, 1), b2 + hB, voffB);
            PG8_WAIT_V(6); PG8_BAR; PG8_MMA(1, 1, At, B1); PG8_BAR;
            PG8_LDB(B0, 1, 0); PG8_SCHED; PG8_LDA(At, 1, 0); PG8_STAGE(PG8_SA(0, 1), a2 + hA, voffA);
            PG8_WAIT_L(8); PG8_BAR; PG8_WAIT_L(0); PG8_MMA(0, 0, At, B0); PG8_BAR; PG8_SCHED;
            PG8_LDB(B1, 1, 1); PG8_STAGE(PG8_SB(1, 0), b3, voffB);
            PG8_BAR; PG8_WAIT_L(0); PG8_MMA(0, 1, At, B1); PG8_BAR;
            PG8_LDA(At, 1, 1); PG8_STAGE(PG8_SA(1, 0), a3, voffA);
            PG8_BAR; PG8_WAIT_L(0); PG8_MMA(1, 0, At, B0); PG8_BAR; PG8_SCHED;
            PG8_STAGE(PG8_SB(1, 1), b3 + hB, voffB);
            PG8_WAIT_V(6); PG8_BAR; PG8_MMA(1, 1, At, B1); PG8_BAR;
            }
        }
        if constexpr (ALIGN_EPI) { if (wr == 0) PG8_BAR; }
        if constexpr (!Epi::AFTER_DRAIN) { E(acc, cur, wr, wc, fr, fq); S.done(cur); }
        if (!has_next) break;
#pragma unroll
        for (int a = 0; a < 2; ++a)
#pragma unroll
            for (int b = 0; b < 2; ++b)
#pragma unroll
                for (int m = 0; m < 4; ++m)
#pragma unroll
                    for (int n = 0; n < 2; ++n) acc[a][b][m][n] = (f32x4){0.f, 0.f, 0.f, 0.f};
        cur = nxt; cA = nA; cB = nB; ++ui;
        if constexpr (ALIGN_EPI) { if (wr == 1) PG8_BAR; }
    }
    PG8_WAIT_V(0);
    if constexpr (!ALIGN_EPI) { if (wr == 0) PG8_BAR; }
    PG8_BAR;
    if constexpr (Epi::AFTER_DRAIN) { E.fused(acc, cur, wr, wc, fr, fq, lds, wid, lane); S.done(cur); }
#undef PG8_SA
#undef PG8_SB
#undef PG8_STAGE
#undef PG8_LDA
#undef PG8_LDB
#undef PG8_MMA
#undef PG8_WAIT_V
#undef PG8_WAIT_L
#undef PG8_BAR
#undef PG8_SCHED
}
}

namespace att {
using bf16_t = unsigned short;
using bf16x8 = __attribute__((ext_vector_type(8))) short;
using s16x4  = __attribute__((ext_vector_type(4))) short;
using f32x16 = __attribute__((ext_vector_type(16))) float;
using u32x4  = __attribute__((ext_vector_type(4))) unsigned;
using u32x2  = __attribute__((ext_vector_type(2))) unsigned;
constexpr int   D = 128, NW = 8, QBLK = 32, KVBLK = 64, NT = 4;
constexpr float SCALE = 0.088388347648318440f;
constexpr float THR = 8.f;
constexpr int   LDQ = 2048, LDK = 2048;
constexpr size_t SHM_V = KVBLK * D * 2, SHM_K = KVBLK * D * 2, SHM_ATTN = 2 * SHM_V + 2 * SHM_K;
#define KSWZ(row, colB) ((row) * 256 + ((colB) ^ (((row) & 7) << 4)))
#define SBAR() __builtin_amdgcn_sched_barrier(0)
__device__ __forceinline__ int crow(int r, int hi) { return (r & 3) + 8 * (r >> 2) + 4 * hi; }
__device__ __forceinline__ unsigned cvtpk(float lo, float hi) { unsigned r; asm volatile("v_cvt_pk_bf16_f32 %0, %1, %2" : "=v"(r) : "v"(lo), "v"(hi)); return r; }

__device__ __forceinline__ void partialSM(f32x16& p0, f32x16& p1, float& m_reg, float& mn, float& alpha) {
  constexpr float C = SCALE * 1.4426950408889634f;
  float pmax = p0[0];
#pragma unroll
  for (int r = 1; r < 16; ++r) pmax = fmaxf(pmax, p0[r]);
#pragma unroll
  for (int r = 0; r < 16; ++r) pmax = fmaxf(pmax, p1[r]);
  { auto rr = __builtin_amdgcn_permlane32_swap(__float_as_uint(pmax), __float_as_uint(pmax), false, false);
    pmax = fmaxf(__uint_as_float(rr[0]), __uint_as_float(rr[1])); }
  if (__builtin_expect(__all(pmax - m_reg <= THR / SCALE), 1)) { mn = m_reg; alpha = 1.f; }
  else { mn = fmaxf(m_reg, pmax); alpha = __builtin_amdgcn_exp2f((m_reg - mn) * C); m_reg = mn; }
  float mnC = -mn * C;
#pragma unroll
  for (int r = 0; r < 16; ++r) p0[r] = fmaf(p0[r], C, mnC);
#pragma unroll
  for (int r = 0; r < 16; ++r) p1[r] = fmaf(p1[r], C, mnC);
#pragma unroll
  for (int r = 0; r < 16; ++r) p0[r] = __builtin_amdgcn_exp2f(p0[r]);
}
__device__ __forceinline__ void finishSM(f32x16& p0, f32x16& p1, float alpha, float& l_reg, bf16x8& pa0, bf16x8& pa1, bf16x8& pa2, bf16x8& pa3) {
#pragma unroll
  for (int r = 0; r < 16; ++r) p1[r] = __builtin_amdgcn_exp2f(p1[r]);
  float ps = 0;
#pragma unroll
  for (int r = 0; r < 16; ++r) ps += p0[r];
#pragma unroll
  for (int r = 0; r < 16; ++r) ps += p1[r];
  { auto rr = __builtin_amdgcn_permlane32_swap(__float_as_uint(ps), __float_as_uint(ps), false, false);
    ps = __uint_as_float(rr[0]) + __uint_as_float(rr[1]); }
  l_reg = l_reg * alpha + ps;
#define PK4(P, BASE, OUT) do { unsigned a0 = cvtpk(P[BASE + 0], P[BASE + 1]), a1 = cvtpk(P[BASE + 2], P[BASE + 3]);   \
    unsigned b0 = cvtpk(P[BASE + 4], P[BASE + 5]), b1 = cvtpk(P[BASE + 6], P[BASE + 7]);                              \
    auto r0 = __builtin_amdgcn_permlane32_swap(a0, b0, false, false); auto r1 = __builtin_amdgcn_permlane32_swap(a1, b1, false, false); \
    u32x4 w = {r0[0], r1[0], r0[1], r1[1]}; OUT = *reinterpret_cast<bf16x8*>(&w); } while (0)
  PK4(p0, 0, pa0); PK4(p0, 8, pa1); PK4(p1, 0, pa2); PK4(p1, 8, pa3);
#undef PK4
}
__device__ __forceinline__ void qkt(f32x16& p0, f32x16& p1, const char* Ks, const bf16x8* qr, int r32, int hi) {
  p0 = f32x16{}; p1 = f32x16{};
#pragma unroll
  for (int d0 = 0; d0 < 8; ++d0) { int cb = (d0 * 16 + hi * 8) * 2;
    bf16x8 b0 = *reinterpret_cast<const bf16x8*>(Ks + KSWZ(r32, cb));
    bf16x8 b1 = *reinterpret_cast<const bf16x8*>(Ks + KSWZ(32 + r32, cb));
    p0 = __builtin_amdgcn_mfma_f32_32x32x16_bf16(b0, qr[d0], p0, 0, 0, 0);
    p1 = __builtin_amdgcn_mfma_f32_32x32x16_bf16(b1, qr[d0], p1, 0, 0, 0); }
}
__device__ __forceinline__ void cmask(f32x16& p0, f32x16& p1, int jt, int qloc, int hi) {
#pragma unroll
  for (int r = 0; r < 16; ++r) { const int key = 64 * jt + crow(r, hi); if (key > qloc) p0[r] = -1e30f; if (key + 32 > qloc) p1[r] = -1e30f; }
}
__device__ __forceinline__ int v_st(int k, int c) { const int kk = (k & ~0xC) | ((k & 4) << 1) | ((k & 8) >> 1); return ((kk >> 3) * 4 + (c >> 5)) * 512 + ((kk & 7) * 32 + (c & 31)) * 2; }
__device__ __forceinline__ int v_rd_base(int lane) { return ((lane & 3) << 3) | (((lane >> 2) & 3) << 6) | (((lane >> 4) & 1) << 5) | (((lane >> 5) & 1) << 8); }
constexpr int v_rd_off(int d0, int ks, int half) { return d0 * 512 + ks * 4096 + half * 2048; }
template <int OFF> __device__ __forceinline__ s16x4 tr_read(int vb) {
  s16x4 r; asm volatile("ds_read_b64_tr_b16 %0, %1 offset:%2" : "=&v"(r) : "v"(vb), "i"(OFF) : "memory"); return r;
}
template <int D0> __device__ __forceinline__ void pv_one(f32x16& od, int vb, bf16x8 pa0, bf16x8 pa1, bf16x8 pa2, bf16x8 pa3) {
  const s16x4 l0 = tr_read<v_rd_off(D0, 0, 0)>(vb), h0 = tr_read<v_rd_off(D0, 0, 1)>(vb), l1 = tr_read<v_rd_off(D0, 1, 0)>(vb), h1 = tr_read<v_rd_off(D0, 1, 1)>(vb);
  const s16x4 l2 = tr_read<v_rd_off(D0, 2, 0)>(vb), h2 = tr_read<v_rd_off(D0, 2, 1)>(vb), l3 = tr_read<v_rd_off(D0, 3, 0)>(vb), h3 = tr_read<v_rd_off(D0, 3, 1)>(vb);
  asm volatile("s_waitcnt lgkmcnt(0)" ::: "memory"); SBAR();
#define PK(L, H) (bf16x8){L[0], L[1], L[2], L[3], H[0], H[1], H[2], H[3]}
  od = __builtin_amdgcn_mfma_f32_32x32x16_bf16(PK(l0, h0), pa0, od, 0, 0, 0);
  od = __builtin_amdgcn_mfma_f32_32x32x16_bf16(PK(l1, h1), pa1, od, 0, 0, 0);
  od = __builtin_amdgcn_mfma_f32_32x32x16_bf16(PK(l2, h2), pa2, od, 0, 0, 0);
  od = __builtin_amdgcn_mfma_f32_32x32x16_bf16(PK(l3, h3), pa3, od, 0, 0, 0);
#undef PK
}
__device__ __forceinline__ void pv_d0(f32x16* o, int vb, bf16x8 pa0, bf16x8 pa1, bf16x8 pa2, bf16x8 pa3) {
  pv_one<0>(o[0], vb, pa0, pa1, pa2, pa3); pv_one<1>(o[1], vb, pa0, pa1, pa2, pa3); pv_one<2>(o[2], vb, pa0, pa1, pa2, pa3); pv_one<3>(o[3], vb, pa0, pa1, pa2, pa3);
}

__device__ __forceinline__ void attn_item(const bf16_t* __restrict__ Qrow, const bf16_t* __restrict__ Kh, const bf16_t* __restrict__ Vh, bool causal, int qloc,
                                          bf16_t* Orow, float2* MLrow, bool valid, char* lds) {
  const int tid = threadIdx.x, lane = tid & 63, r32 = lane & 31, hi = lane >> 5;
  char* V_lds = lds; char* K_lds = lds + 2 * SHM_V;
  float m_reg = -1e30f, l_reg = 0; f32x16 o[4] = {}; bf16x8 qr[8];
  const bf16_t* Qw = Qrow + hi * 8;
#pragma unroll
  for (int d0 = 0; d0 < 8; ++d0) qr[d0] = *reinterpret_cast<const bf16x8*>(Qw + d0 * 16);
  const int sr = tid >> 4, sc = (tid & 15) * 8, vst0 = v_st(sr, sc), vst1 = v_st(32 + sr, sc);
  const int vb0 = (int)(uintptr_t)V_lds + v_rd_base(lane);
  struct { bf16x8 vs0, vs1, ks0, ks1; } sr_[2];
#define SLOAD(i, k0) do { sr_[i].vs0 = *reinterpret_cast<const bf16x8*>(&Vh[(long)((k0) + sr) * LDK + sc]); sr_[i].vs1 = *reinterpret_cast<const bf16x8*>(&Vh[(long)((k0) + 32 + sr) * LDK + sc]); \
    sr_[i].ks0 = *reinterpret_cast<const bf16x8*>(&Kh[(long)((k0) + sr) * LDK + sc]); sr_[i].ks1 = *reinterpret_cast<const bf16x8*>(&Kh[(long)((k0) + 32 + sr) * LDK + sc]); } while (0)
#define SWRITE(b, i) do { *(bf16x8*)(V_lds + (b) * SHM_V + vst0) = sr_[i].vs0;          \
    *(bf16x8*)(V_lds + (b) * SHM_V + vst1) = sr_[i].vs1; int kc = sc * 2;               \
    *(bf16x8*)(K_lds + (b) * SHM_K + KSWZ(sr, kc)) = sr_[i].ks0;                       \
    *(bf16x8*)(K_lds + (b) * SHM_K + KSWZ(32 + sr, kc)) = sr_[i].ks1; } while (0)
#define SWAIT() asm volatile("s_waitcnt vmcnt(4)" ::: "memory")
#define RESC(a) do { if (__any((a) < 1.f)) { _Pragma("unroll") for (int d = 0; d < 4; ++d) _Pragma("unroll") for (int r = 0; r < 16; ++r) o[d][r] *= (a); } } while (0)
  f32x16 pA0, pA1, pB0, pB1; float mnA, mnB, alA, alB; bf16x8 pa0, pa1, pa2, pa3;
  constexpr int SE = 0, SO = 1;
  SLOAD(SE, 0); asm volatile("s_waitcnt vmcnt(0)" ::: "memory"); SWRITE(0, SE); __syncthreads();
  qkt(pA0, pA1, K_lds, qr, r32, hi); if (causal) cmask(pA0, pA1, 0, qloc, hi); partialSM(pA0, pA1, m_reg, mnA, alA);
  SLOAD(SO, KVBLK); SLOAD(SE, 2 * KVBLK);
  SWAIT(); SWRITE(1, SO); __syncthreads();
  {
    SBAR(); qkt(pB0, pB1, K_lds + SHM_K, qr, r32, hi); if (causal) cmask(pB0, pB1, 1, qloc, hi);
    finishSM(pA0, pA1, alA, l_reg, pa0, pa1, pa2, pa3); SBAR();
    SLOAD(SO, 3 * KVBLK); SBAR();
    pv_d0(o, vb0, pa0, pa1, pa2, pa3); partialSM(pB0, pB1, m_reg, mnB, alB);
    __syncthreads(); SWAIT(); SWRITE(0, SE);
    RESC(alB); __syncthreads();
    SBAR(); qkt(pA0, pA1, K_lds, qr, r32, hi); if (causal) cmask(pA0, pA1, 2, qloc, hi);
    finishSM(pB0, pB1, alB, l_reg, pa0, pa1, pa2, pa3); SBAR();
    pv_d0(o, vb0 + (int)SHM_V, pa0, pa1, pa2, pa3); partialSM(pA0, pA1, m_reg, mnA, alA);
    __syncthreads(); asm volatile("s_waitcnt vmcnt(0)" ::: "memory"); SWRITE(1, SO);
    RESC(alA); __syncthreads();
  }
  SBAR(); qkt(pB0, pB1, K_lds + SHM_K, qr, r32, hi); if (causal) cmask(pB0, pB1, 3, qloc, hi);
  finishSM(pA0, pA1, alA, l_reg, pa0, pa1, pa2, pa3); SBAR();
  pv_d0(o, vb0, pa0, pa1, pa2, pa3); partialSM(pB0, pB1, m_reg, mnB, alB);
  __syncthreads(); RESC(alB);
  finishSM(pB0, pB1, alB, l_reg, pa0, pa1, pa2, pa3); SBAR();
  pv_d0(o, vb0 + (int)SHM_V, pa0, pa1, pa2, pa3);
  const float rl = 1.0f / l_reg;
  if (valid) {
#pragma unroll
    for (int d0 = 0; d0 < 4; ++d0)
#pragma unroll
      for (int g = 0; g < 4; ++g) { u32x2 w; w.x = cvtpk(o[d0][4 * g] * rl, o[d0][4 * g + 1] * rl); w.y = cvtpk(o[d0][4 * g + 2] * rl, o[d0][4 * g + 3] * rl);
        *reinterpret_cast<u32x2*>(Orow + 32 * d0 + 8 * g + 4 * hi) = w; }
    if (hi == 0) *MLrow = make_float2(m_reg, l_reg);
  }
#undef SLOAD
#undef SWRITE
#undef SWAIT
#undef RESC
}

struct ItemCtx { const bf16_t* Q; const bf16_t* K; const bf16_t* V; bf16_t* PO; float2* ML; const unsigned short* lists; };
__device__ __forceinline__ unsigned item_entry(const ItemCtx& C, const __attribute__((address_space(3))) int* D, int k, int rloc) {
  const int own = D[4 * k + 1], j = D[4 * k] & 31, cnt = D[4 * k + 3];
  if (own) return (unsigned)(256 * j + rloc) | (3u << 13);
  return (unsigned)C.lists[(size_t)(unsigned)D[4 * k + 2] + (rloc < cnt ? rloc : 0)];
}
__device__ __forceinline__ void attn_items(const ItemCtx& C, const __attribute__((address_space(3))) int* D, int nloc, char* lds) {
  if (nloc <= 0) return;
  const int tid = threadIdx.x, wid = tid >> 6, lane = tid & 63, r32 = lane & 31, hi = lane >> 5, rloc = 32 * wid + r32;
  char* V_lds = lds; char* K_lds = lds + 2 * SHM_V;
  const int sr = tid >> 4, sc = (tid & 15) * 8, vst0 = v_st(sr, sc), vst1 = v_st(32 + sr, sc);
  const int vb0 = (int)(uintptr_t)V_lds + v_rd_base(lane);
  struct { bf16x8 vs0, vs1, ks0, ks1; } sr_[2];
  bf16x8 qr[8];
#define KVBASE(k, Kh, Vh) const bf16_t* Kh; const bf16_t* Vh; { const int bhj_ = D[4 * (k)], bh_ = bhj_ >> 5, j_ = bhj_ & 31; \
    const size_t off_ = ((size_t)(bh_ >> 4) * 8192 + 256 * j_) * LDK + (bh_ & 15) * D_; Kh = C.K + off_; Vh = C.V + off_; }
#define SLOADP(i, Kh, Vh, k0) do { sr_[i].vs0 = *reinterpret_cast<const bf16x8*>(&Vh[(long)((k0) + sr) * LDK + sc]); sr_[i].vs1 = *reinterpret_cast<const bf16x8*>(&Vh[(long)((k0) + 32 + sr) * LDK + sc]); \
    sr_[i].ks0 = *reinterpret_cast<const bf16x8*>(&Kh[(long)((k0) + sr) * LDK + sc]); sr_[i].ks1 = *reinterpret_cast<const bf16x8*>(&Kh[(long)((k0) + 32 + sr) * LDK + sc]); } while (0)
#define SWRITE(b, i) do { *(bf16x8*)(V_lds + (b) * SHM_V + vst0) = sr_[i].vs0;          \
    *(bf16x8*)(V_lds + (b) * SHM_V + vst1) = sr_[i].vs1; int kc = sc * 2;               \
    *(bf16x8*)(K_lds + (b) * SHM_K + KSWZ(sr, kc)) = sr_[i].ks0;                       \
    *(bf16x8*)(K_lds + (b) * SHM_K + KSWZ(32 + sr, kc)) = sr_[i].ks1; } while (0)
#define QLOAD(e, k) do { const int bh_ = D[4 * (k)] >> 5; const bf16_t* Qw_ = C.Q + ((size_t)(bh_ >> 4) * 8192 + ((e) & 8191u)) * LDQ + (bh_ & 15) * D_ + hi * 8; \
    _Pragma("unroll") for (int d0 = 0; d0 < 8; ++d0) qr[d0] = *reinterpret_cast<const bf16x8*>(Qw_ + d0 * 16); } while (0)
#define RESC(a) do { if (__any((a) < 1.f)) { _Pragma("unroll") for (int d = 0; d < 4; ++d) _Pragma("unroll") for (int r = 0; r < 16; ++r) o[d][r] *= (a); } } while (0)
  constexpr int D_ = 128, SE = 0, SO = 1;
  unsigned e_cur = item_entry(C, D, 0, rloc), e_nxt = (nloc > 1) ? item_entry(C, D, 1, rloc) : 0u;
  { KVBASE(0, Kh, Vh); SLOADP(SE, Kh, Vh, 0); SLOADP(SO, Kh, Vh, KVBLK); }
  QLOAD(e_cur, 0);
  for (int k = 0; k < nloc; ++k) {
    const bool has_next = (k + 1 < nloc);
    const bool causal = D[4 * k + 1] != 0; const int cnt = D[4 * k + 3];
    KVBASE(k, Kh, Vh);
    float m_reg = -1e30f, l_reg = 0; f32x16 o[4] = {};
    f32x16 pA0, pA1, pB0, pB1; float mnA, mnB, alA, alB; bf16x8 pa0, pa1, pa2, pa3;
    asm volatile("s_waitcnt vmcnt(0)" ::: "memory"); SWRITE(0, SE); __syncthreads();
    qkt(pA0, pA1, K_lds, qr, r32, hi); if (causal) cmask(pA0, pA1, 0, rloc, hi); partialSM(pA0, pA1, m_reg, mnA, alA);
    SLOADP(SE, Kh, Vh, 2 * KVBLK);
    SWRITE(1, SO); __syncthreads();
    SLOADP(SO, Kh, Vh, 3 * KVBLK);
    SBAR(); qkt(pB0, pB1, K_lds + SHM_K, qr, r32, hi); if (causal) cmask(pB0, pB1, 1, rloc, hi);
    finishSM(pA0, pA1, alA, l_reg, pa0, pa1, pa2, pa3); SBAR();
    pv_d0(o, vb0, pa0, pa1, pa2, pa3); partialSM(pB0, pB1, m_reg, mnB, alB);
    __syncthreads(); asm volatile("s_waitcnt vmcnt(4)" ::: "memory"); SWRITE(0, SE);
    RESC(alB); __syncthreads();
    if (has_next) { KVBASE(k + 1, Kn, Vn); SLOADP(SE, Kn, Vn, 0); }
    SBAR(); qkt(pA0, pA1, K_lds, qr, r32, hi); if (causal) cmask(pA0, pA1, 2, rloc, hi);
    finishSM(pB0, pB1, alB, l_reg, pa0, pa1, pa2, pa3); SBAR();
    pv_d0(o, vb0 + (int)SHM_V, pa0, pa1, pa2, pa3); partialSM(pA0, pA1, m_reg, mnA, alA);
    __syncthreads(); SWRITE(1, SO);
    RESC(alA); __syncthreads();
    if (has_next) { KVBASE(k + 1, Kn, Vn); SLOADP(SO, Kn, Vn, KVBLK); }
    SBAR(); qkt(pB0, pB1, K_lds + SHM_K, qr, r32, hi); if (causal) cmask(pB0, pB1, 3, rloc, hi);
    SBAR();
    if (has_next) QLOAD(e_nxt, k + 1);
    finishSM(pA0, pA1, alA, l_reg, pa0, pa1, pa2, pa3); SBAR();
    pv_d0(o, vb0, pa0, pa1, pa2, pa3); partialSM(pB0, pB1, m_reg, mnB, alB);
    __syncthreads(); RESC(alB);
    finishSM(pB0, pB1, alB, l_reg, pa0, pa1, pa2, pa3); SBAR();
    pv_d0(o, vb0 + (int)SHM_V, pa0, pa1, pa2, pa3);
    { const float rl = 1.0f / l_reg; const int bh = D[4 * k] >> 5; const unsigned t = e_cur & 8191u, slot = e_cur >> 13;
      if (rloc < cnt) {
        bf16_t* Orow = C.PO + (((size_t)slot * 32 + bh) * 8192 + t) * D_;
#pragma unroll
        for (int d0 = 0; d0 < 4; ++d0)
#pragma unroll
          for (int g = 0; g < 4; ++g) { u32x2 w; w.x = cvtpk(o[d0][4 * g] * rl, o[d0][4 * g + 1] * rl); w.y = cvtpk(o[d0][4 * g + 2] * rl, o[d0][4 * g + 3] * rl);
            *reinterpret_cast<u32x2*>(Orow + 32 * d0 + 8 * g + 4 * hi) = w; }
        if (hi == 0) C.ML[((size_t)slot * 32 + bh) * 8192 + t] = make_float2(m_reg, l_reg);
      } }
    e_cur = e_nxt; if (k + 2 < nloc) e_nxt = item_entry(C, D, k + 2, rloc);
  }
#undef KVBASE
#undef SLOADP
#undef SWRITE
#undef QLOAD
#undef RESC
}
#undef KSWZ
#undef SBAR
}

constexpr int NWAVES = 8;
#ifndef MK_N_LAUNCHES
#define MK_N_LAUNCHES 1
#endif
constexpr int N_PHASES = 16;
constexpr int N_LAUNCHES = MK_N_LAUNCHES;

constexpr int BATCH = 2, SEQ = 8192, DM = 4096, M = BATCH * SEQ, MEMLEN = 256;
constexpr int PW = 2048, AW = 2048, NH = 16, HD = 128, NBLK = 32, MIXIN = 8192, FF = 11008, XH = 4, XHD = 1024;
constexpr float LN_EPS = 1e-5f;
constexpr float DN_ALPHA = 1.189207115002721f;

constexpr size_t MiB = 1u << 20;
constexpr size_t WS_CTL = 0, CTL_ZERO_BYTES = 1 * MiB;
constexpr size_t WS_ROPE = 1 * MiB;
constexpr size_t WS_KMH = 5 * MiB, WS_KML = 5 * MiB + 512 * 1024;
constexpr size_t WS_MEMB = 6 * MiB;
constexpr size_t WS_KVX = 10 * MiB;
constexpr size_t WS_LIST = 18 * MiB;
constexpr size_t WS_ML = 26 * MiB;
constexpr size_t WS_WIN = 34 * MiB, WS_WPOOL = 98 * MiB, WS_WOUT = 100 * MiB, WS_WXQ = 132 * MiB, WS_WXKV = 164 * MiB, WS_WXO = 228 * MiB, WS_WGU = 260 * MiB, WS_WDN = 432 * MiB;
constexpr size_t WS_ACT = 518 * MiB;
constexpr size_t WS_HP = WS_ACT, WS_Q = WS_ACT + 64 * MiB, WS_K = WS_ACT + 128 * MiB, WS_V = WS_ACT + 192 * MiB;
constexpr size_t WS_XB = WS_ACT + 256 * MiB;
constexpr size_t WS_PM = WS_ACT + 256 * MiB;
constexpr size_t WS_PARTO = WS_ACT + 256 * MiB;
constexpr size_t WS_CAT = WS_ACT + 512 * MiB;
constexpr size_t WS_TB = WS_ACT;
constexpr size_t WS_HB = WS_ACT + 128 * MiB;
constexpr size_t WS_PB = WS_ACT + 256 * MiB;
constexpr size_t WS_G = WS_ACT + 256 * MiB;
constexpr size_t WS_SLAB = WS_ACT + 640 * MiB;
constexpr size_t WS_WQK = WS_SLAB, WS_WVOT = WS_SLAB + 16 * MiB;
constexpr size_t WS_STATS = WS_ML;
constexpr size_t WS_END = WS_ACT + 704 * MiB;
static_assert(WS_WDN + (size_t)DM * FF * 2 <= WS_ACT && WS_G + (size_t)M * FF * 2 <= WS_END && WS_WGU + (size_t)2 * FF * DM * 2 <= WS_WDN, "d_ws map");
constexpr int LIST_STRIDE = 256 * 496;
__host__ __device__ constexpr int list_off(int j) { return 256 * (31 * j - (j * (j - 1)) / 2); }
constexpr int CW_TMO = 0, CW_CODE = 1;
constexpr int CW_BAR = 4096;
constexpr int CW_GCNT = 8192;
constexpr int CW_CHK = 16384;

constexpr int RING_OFF = 0, RING_BYTES = 131072;
constexpr int LDSCTL_OFF = RING_BYTES, MISC_OFF = LDSCTL_OFF + 320;
constexpr int LDS_BYTES = 147456;

#define GAS __attribute__((address_space(1)))
#define LAS __attribute__((address_space(3)))
typedef unsigned short bf16;
typedef unsigned v4u __attribute__((ext_vector_type(4)));
typedef unsigned v2u __attribute__((ext_vector_type(2)));
typedef float f32x4 __attribute__((ext_vector_type(4)));
typedef short bf16x8 __attribute__((ext_vector_type(8)));
typedef float f32x16 __attribute__((ext_vector_type(16)));
typedef GAS unsigned gu32;
#define RLX_AGENT __ATOMIC_RELAXED, __HIP_MEMORY_SCOPE_AGENT
#define LDS_WAIT() asm volatile("s_waitcnt lgkmcnt(0)" ::: "memory")
#define VM_WAIT() asm volatile("s_waitcnt vmcnt(0)" ::: "memory")
__device__ __forceinline__ unsigned f2bf(float f) { unsigned u = __builtin_bit_cast(unsigned, f); return (u + 0x7fffu + ((u >> 16) & 1u)) >> 16; }
__device__ __forceinline__ unsigned pk2(float lo, float hi) { return f2bf(lo) | (f2bf(hi) << 16); }
__device__ __forceinline__ float bf_lo(unsigned w) { return __builtin_bit_cast(float, w << 16); }
__device__ __forceinline__ float bf_hi(unsigned w) { return __builtin_bit_cast(float, w & 0xffff0000u); }
__device__ __forceinline__ float bf2f(bf16 b) { return __builtin_bit_cast(float, ((unsigned)b) << 16); }
#define XB_TMO      128
#define XB_XCNT(j)  (256  + 64 * (j))
#define XB_XSUB(j)  (1280 + 64 * (j))
#define XB_XGEN(j)  (2304 + 64 * (j))
#define XB_TOP      3328
#define XB_TOPGEN   3392
#define XCD_BAR_WORDS 3456
#define XB_SPIN_CAP (1u << 18)

__device__ __forceinline__ unsigned xb_ld(unsigned* p)              { return __hip_atomic_load(p, __ATOMIC_RELAXED, __HIP_MEMORY_SCOPE_AGENT); }
__device__ __forceinline__ unsigned xb_add(unsigned* p, unsigned v) { return __hip_atomic_fetch_add(p, v, __ATOMIC_RELAXED, __HIP_MEMORY_SCOPE_AGENT); }
__device__ __forceinline__ unsigned xb_xcc_id() { return (unsigned)__builtin_amdgcn_s_getreg((3 << 11) | 20) & 0xFu; }
#define XB_SPIN(cond, bar) do { unsigned _sp = 0; while (cond) { __builtin_amdgcn_s_sleep(1); \
    if ((++_sp & 255u) == 0u) { if (xb_ld(&(bar)[XB_TMO])) break; if (_sp > XB_SPIN_CAP) { atomicAdd(&(bar)[XB_TMO], 1u); break; } } } } while (0)

struct XcdBarrier {
    unsigned* bar; unsigned x;
    volatile LAS unsigned* st;
};

__device__ __forceinline__ XcdBarrier xcd_barrier_post(unsigned* bar, volatile LAS unsigned* st) {
    XcdBarrier b; b.bar = bar; b.x = xb_xcc_id(); b.st = st;
    if (threadIdx.x == 0) (void)xb_add(&bar[XB_XCNT(b.x)], 1u);
    return b;
}
__device__ __forceinline__ void xcd_barrier_complete(unsigned* bar, unsigned x, unsigned& nloc, unsigned& nx) {
    const unsigned G = gridDim.x * gridDim.y * gridDim.z;
    unsigned sum, cnt, mine, sp = 0u;
    for (;;) {
        sum = 0u; cnt = 0u; mine = 0u;
#pragma unroll
        for (unsigned j = 0; j < 16; ++j) { const unsigned c = xb_ld(&bar[XB_XCNT(j)]); sum += c; cnt += (c > 0u) ? 1u : 0u; mine = (j == x) ? c : mine; }
        if (sum == G) break;
        __builtin_amdgcn_s_sleep(1);
        if ((++sp & 255u) == 0u) { if (xb_ld(&bar[XB_TMO])) break; if (sp > XB_SPIN_CAP) { atomicAdd(&bar[XB_TMO], 1u); break; } }
    }
    nloc = mine > 0u ? mine : 1u; nx = cnt > 0u ? cnt : 1u;
}

__device__ __forceinline__ void xcd_barrier(const XcdBarrier& b) {
    asm volatile("s_waitcnt vmcnt(0)" ::: "memory");
    __syncthreads();
    if (threadIdx.x == 0) {
        unsigned* bar = b.bar;
        __builtin_amdgcn_s_waitcnt(0);
        unsigned nloc = b.st[0], nx = b.st[1];
        if (nloc == 0u) { xcd_barrier_complete(bar, b.x, nloc, nx); b.st[0] = nloc; b.st[1] = nx; }
        const unsigned old = xb_add(&bar[XB_XSUB(b.x)], 1u);
        const unsigned gen = old / nloc;
        if (old + 1u == (gen + 1u) * nloc) {
            __builtin_amdgcn_fence(__ATOMIC_RELEASE, "agent");
            asm volatile("s_waitcnt vmcnt(0)" ::: "memory");
            const unsigned og = xb_add(&bar[XB_TOP], 1u);
            const unsigned tg = og / nx;
            if (og + 1u == (tg + 1u) * nx) xb_add(&bar[XB_TOPGEN], 1u);
            else XB_SPIN(xb_ld(&bar[XB_TOPGEN]) == tg, bar);
            __builtin_amdgcn_fence(__ATOMIC_ACQUIRE, "agent");
            xb_add(&bar[XB_XGEN(b.x)], 1u);
            asm volatile("s_waitcnt vmcnt(0)" ::: "memory");
        } else {
            XB_SPIN(xb_ld(&bar[XB_XGEN(b.x)]) == gen, bar);
            __builtin_amdgcn_fence(__ATOMIC_ACQUIRE, "agent");
            asm volatile("s_waitcnt vmcnt(0)" ::: "memory");
        }
    }
    __syncthreads();
}

struct Frame {
    LAS unsigned char* lds;
    volatile LAS unsigned* MISC;
    gu32* ctl;
    int tid, lane, wave;
    int G;
    unsigned char* ws;
};
__device__ __forceinline__ float wave_sum(float v) {
#pragma unroll
    for (int o = 1; o < 64; o <<= 1) v += __shfl_xor(v, o);
    return v;
}

template <class RowMap>
__device__ __forceinline__ void p0_transpose_item(const float* W, int K, int N, bf16* WT, LAS float* scr, int item, int lane, const RowMap& rm, const float* colscale) {
    const int nblk = N / 32, kb = item / nblk, nb = item % nblk, k0 = 64 * kb, n0 = 32 * nb;
    float ld[32];
    const float* src = W + (size_t)(k0 + (lane >> 5)) * N + n0 + (lane & 31);
#pragma unroll
    for (int i = 0; i < 32; ++i) ld[i] = *(const GAS float*)(src + (size_t)(2 * i) * N);
#pragma unroll
    for (int i = 0; i < 32; ++i) scr[(2 * i + (lane >> 5)) * 33 + (lane & 31)] = ld[i];
    LDS_WAIT(); asm volatile("" ::: "memory");
    const int c = lane & 7;
#pragma unroll
    for (int j = 0; j < 4; ++j) { const int n = (lane >> 3) + 8 * j; const LAS float* s = scr + (8 * c) * 33 + n; const float sc = colscale ? colscale[n0 + n] : 1.0f;
        v4u o; o.x = pk2(s[0 * 33] * sc, s[1 * 33] * sc); o.y = pk2(s[2 * 33] * sc, s[3 * 33] * sc); o.z = pk2(s[4 * 33] * sc, s[5 * 33] * sc); o.w = pk2(s[6 * 33] * sc, s[7 * 33] * sc);
        *(GAS v4u*)(WT + (size_t)rm(n0 + n) * K + k0 + 8 * c) = o; }
    LDS_WAIT(); asm volatile("" ::: "memory");
}
struct RmIdent { int off; __device__ __forceinline__ int operator()(int n) const { return off + n; } };
struct RmMixIn { __device__ __forceinline__ int operator()(int n) const { if (n < 2048 || n >= 6144) return n; const int d = n & 127; return (n & ~127) + 2 * (d & 63) + (d >> 6); } };
struct RmGateUp { int up; __device__ __forceinline__ int operator()(int n) const { return (n >> 7) * 256 + up * 128 + (n & 127); } };

__device__ __forceinline__ void sincos_d(double a, double& s, double& c) {
    const double n = __builtin_rint(a * 0.63661977236758134308);
    double r = __builtin_fma(-n, 1.5707963267948966, a); r = __builtin_fma(-n, 6.123233995736766e-17, r);
    const double r2 = r * r;
    double ps = -7.6471637318198164759e-13; ps = ps * r2 + 1.6059043836821614599e-10; ps = ps * r2 - 2.5052108385441718775e-08; ps = ps * r2 + 2.7557319223985890653e-06;
    ps = ps * r2 - 1.9841269841269841270e-04; ps = ps * r2 + 8.3333333333333333333e-03; ps = ps * r2 - 1.6666666666666666667e-01; ps = r + r * r2 * ps;
    double pc = 4.7794773323873852974e-14; pc = pc * r2 - 1.1470745597729724714e-11; pc = pc * r2 + 2.0876756987868098979e-09; pc = pc * r2 - 2.7557319223985890653e-07;
    pc = pc * r2 + 2.4801587301587301587e-05; pc = pc * r2 - 1.3888888888888888889e-03; pc = pc * r2 + 4.1666666666666666667e-02; pc = pc * r2 - 0.5; pc = 1.0 + r2 * pc;
    const int q = ((int)n) & 3;
    s = (q == 0) ? ps : (q == 1) ? pc : (q == 2) ? -ps : -pc;
    c = (q == 0) ? pc : (q == 1) ? -ps : (q == 2) ? -pc : ps;
}
__device__ __forceinline__ float rope_inv(int i) {
    const double y = -(double)i * (13.287712379549449 / 64.0); const double fl = __builtin_floor(y); const double z = (y - fl) * 0.69314718055994530942;
    double e = 1.0, term = 1.0;
#pragma unroll
    for (int k = 1; k <= 20; ++k) { term = term * z / (double)k; e += term; }
    return (float)__builtin_ldexp(e, (int)fl);
}

__device__ __forceinline__ void p0_prologue(Frame& F, const float* const* in) {
    LAS float* scr = (LAS float*)(F.lds + RING_OFF + F.wave * 16384);
    const int gw = blockIdx.x * NWAVES + F.wave, NGW = F.G * NWAVES;
    const float* w_mix_in = in[2]; const float* w_pool = in[3]; const float* pool_scale = in[4]; const float* w_mix_out = in[5];
    const float* w_xq = in[8]; const float* w_xkv = in[9]; const float* w_xo = in[10]; const float* w_gate = in[13]; const float* w_up = in[14]; const float* w_down = in[15];
    bf16* WIN = (bf16*)(F.ws + WS_WIN); bf16* WPOOL = (bf16*)(F.ws + WS_WPOOL); bf16* WOUT = (bf16*)(F.ws + WS_WOUT); bf16* WXQ = (bf16*)(F.ws + WS_WXQ);
    bf16* WXKV = (bf16*)(F.ws + WS_WXKV); bf16* WXO = (bf16*)(F.ws + WS_WXO); bf16* WGU = (bf16*)(F.ws + WS_WGU); bf16* WDN = (bf16*)(F.ws + WS_WDN);
    constexpr int I_IN = (DM / 64) * (MIXIN / 32), I_POOL = (512 / 64) * (512 / 32), I_SQ = (DM / 64) * (DM / 32), I_KV = (DM / 64) * (2 * DM / 32), I_GU = (DM / 64) * (FF / 32), I_DN = (FF / 64) * (DM / 32);
    constexpr int NITEMS = I_IN + 4 * I_POOL + 2 * I_SQ + I_KV + 2 * I_GU + I_DN;
    for (int it = gw; it < NITEMS; it += NGW) {
        int r = it;
        if (r < I_IN) { p0_transpose_item(w_mix_in, DM, MIXIN, WIN, scr, r, F.lane, RmMixIn{}, nullptr); continue; } r -= I_IN;
        if (r < 4 * I_POOL) { const int g = r / I_POOL; p0_transpose_item(w_pool + (size_t)g * 512 * 512, 512, 512, WPOOL, scr, r % I_POOL, F.lane, RmIdent{g * 512}, pool_scale + g * 512); continue; } r -= 4 * I_POOL;
        if (r < I_SQ) { p0_transpose_item(w_mix_out, DM, DM, WOUT, scr, r, F.lane, RmIdent{0}, nullptr); continue; } r -= I_SQ;
        if (r < I_KV) { p0_transpose_item(w_xkv, DM, 2 * DM, WXKV, scr, r, F.lane, RmIdent{0}, nullptr); continue; } r -= I_KV;
        if (r < I_SQ) { p0_transpose_item(w_xo, DM, DM, WXO, scr, r, F.lane, RmIdent{0}, nullptr); continue; } r -= I_SQ;
        if (r < I_GU) { p0_transpose_item(w_gate, DM, FF, WGU, scr, r, F.lane, RmGateUp{0}, nullptr); continue; } r -= I_GU;
        if (r < I_GU) { p0_transpose_item(w_up, DM, FF, WGU, scr, r, F.lane, RmGateUp{1}, nullptr); continue; } r -= I_GU;
        p0_transpose_item(w_down, FF, DM, WDN, scr, r, F.lane, RmIdent{0}, nullptr);
    }
    const size_t gt = (size_t)blockIdx.x * (NWAVES * 64) + F.tid, NT = (size_t)F.G * NWAVES * 64;
    { const float* x = in[0]; bf16* XB = (bf16*)(F.ws + WS_XB);
      for (size_t i = gt; i < (size_t)M * DM / 8; i += NT) { const f32x4 a = *(const GAS f32x4*)(x + i * 8), b = *(const GAS f32x4*)(x + i * 8 + 4);
          v4u o; o.x = pk2(a.x, a.y); o.y = pk2(a.z, a.w); o.z = pk2(b.x, b.y); o.w = pk2(b.z, b.w); *(GAS v4u*)(XB + i * 8) = o; } }
    { const float* x = w_xq; bf16* XB = WXQ;
      for (size_t i = gt; i < (size_t)DM * DM / 8; i += NT) { const f32x4 a = *(const GAS f32x4*)(x + i * 8), b = *(const GAS f32x4*)(x + i * 8 + 4);
          v4u o; o.x = pk2(a.x, a.y); o.y = pk2(a.z, a.w); o.z = pk2(b.x, b.y); o.w = pk2(b.z, b.w); *(GAS v4u*)(XB + i * 8) = o; } }
    { const float* x = in[1]; bf16* XB = (bf16*)(F.ws + WS_MEMB);
      for (size_t i = gt; i < (size_t)BATCH * MEMLEN * DM / 8; i += NT) { const f32x4 a = *(const GAS f32x4*)(x + i * 8), b = *(const GAS f32x4*)(x + i * 8 + 4);
          v4u o; o.x = pk2(a.x, a.y); o.y = pk2(a.z, a.w); o.z = pk2(b.x, b.y); o.w = pk2(b.z, b.w); *(GAS v4u*)(XB + i * 8) = o; } }
    { float2* tab = (float2*)(F.ws + WS_ROPE);
      for (size_t i = gt; i < (size_t)SEQ * 64; i += NT) { const int pos = (int)(i >> 6), fi = (int)(i & 63); const float ang = (float)pos * rope_inv(fi);
          double s, c; sincos_d((double)ang, s, c); tab[i] = make_float2((float)c, (float)s); } }
}

template <bool FINAL>
__device__ __forceinline__ void ln_rows(Frame& F, const bf16* T, bf16* XB, float2* stats, float* OUT, const float* g, const float* b) {
    const int gw = blockIdx.x * NWAVES + F.wave, NGW = F.G * NWAVES;
    for (int m = gw; m < M; m += NGW) {
        const GAS v4u* tr = (const GAS v4u*)(T + (size_t)m * DM) + F.lane;
        float v[8][8]; float s = 0.f;
#pragma unroll
        for (int j = 0; j < 8; ++j) { const v4u r = tr[64 * j]; v[j][0] = bf_lo(r.x); v[j][1] = bf_hi(r.x); v[j][2] = bf_lo(r.y); v[j][3] = bf_hi(r.y); v[j][4] = bf_lo(r.z); v[j][5] = bf_hi(r.z); v[j][6] = bf_lo(r.w); v[j][7] = bf_hi(r.w);
#pragma unroll
            for (int e = 0; e < 8; ++e) s += v[j][e]; }
        const float mean = wave_sum(s) * (1.f / DM); float s2 = 0.f;
#pragma unroll
        for (int j = 0; j < 8; ++j)
#pragma unroll
            for (int e = 0; e < 8; ++e) { v[j][e] -= mean; s2 += v[j][e] * v[j][e]; }
        const float rstd = 1.f / sqrtf(wave_sum(s2) * (1.f / DM) + LN_EPS);
        if (!FINAL && F.lane == 0) stats[m] = make_float2(mean, rstd);
#pragma unroll
        for (int j = 0; j < 8; ++j) { const int c = (64 * j + F.lane) * 8;
            const f32x4 g0 = *(const GAS f32x4*)(g + c), g1 = *(const GAS f32x4*)(g + c + 4), b0 = *(const GAS f32x4*)(b + c), b1 = *(const GAS f32x4*)(b + c + 4);
            const f32x4 y0 = (f32x4){v[j][0], v[j][1], v[j][2], v[j][3]} * rstd * g0 + b0, y1 = (f32x4){v[j][4], v[j][5], v[j][6], v[j][7]} * rstd * g1 + b1;
            if (FINAL) { *(GAS f32x4*)(OUT + (size_t)m * DM + c) = y0; *(GAS f32x4*)(OUT + (size_t)m * DM + c + 4) = y1; }
            else { v4u o; o.x = pk2(y0.x, y0.y); o.y = pk2(y0.z, y0.w); o.z = pk2(y1.x, y1.y); o.w = pk2(y1.z, y1.w); *(GAS v4u*)(XB + (size_t)m * DM + c) = o; } }
    }
}

__device__ __forceinline__ void up8(const v4u& r, float (&f)[8]) { f[0] = bf_lo(r.x); f[1] = bf_hi(r.x); f[2] = bf_lo(r.y); f[3] = bf_hi(r.y); f[4] = bf_lo(r.z); f[5] = bf_hi(r.z); f[6] = bf_lo(r.w); f[7] = bf_hi(r.w); }
template <int W>
__device__ __forceinline__ void pool_run(const bf16* HP, bf16* PMo, int t0, int c) {
    const int tp0 = t0 & (SEQ - 1);
    v4u raw[16 + W - 1];
#pragma unroll
    for (int j = 0; j < 16 + W - 1; ++j) { const int dt = j - (W - 1); raw[j] = (v4u){0u, 0u, 0u, 0u}; if (tp0 + dt >= 0) raw[j] = *(const GAS v4u*)(HP + (size_t)(t0 + dt) * PW + c); }
    float S[8], u[8];
#pragma unroll
    for (int e = 0; e < 8; ++e) S[e] = 0.f;
#pragma unroll
    for (int j = 0; j < W - 1; ++j) { up8(raw[j], u);
#pragma unroll
        for (int e = 0; e < 8; ++e) S[e] += u[e]; }
#pragma unroll
    for (int i = 0; i < 16; ++i) {
        up8(raw[W - 1 + i], u);
#pragma unroll
        for (int e = 0; e < 8; ++e) S[e] += u[e];
        const int tp = tp0 + i; const float inv = (tp + 1 < W) ? 1.0f / (float)(tp + 1) : 1.0f / (float)W;
        v4u o; o.x = pk2(S[0] * inv - u[0], S[1] * inv - u[1]); o.y = pk2(S[2] * inv - u[2], S[3] * inv - u[3]);
        o.z = pk2(S[4] * inv - u[4], S[5] * inv - u[5]); o.w = pk2(S[6] * inv - u[6], S[7] * inv - u[7]);
        *(GAS v4u*)(PMo + (size_t)(t0 + i) * PW + c) = o;
        float d[8]; up8(raw[i], d);
#pragma unroll
        for (int e = 0; e < 8; ++e) S[e] -= d[e];
    }
}
__device__ __forceinline__ void pool_ew(Frame& F) {
    const bf16* HP = (const bf16*)(F.ws + WS_HP); bf16* PMo = (bf16*)(F.ws + WS_PM);
    const size_t gt = (size_t)blockIdx.x * (NWAVES * 64) + F.tid, NT = (size_t)F.G * NWAVES * 64;
    for (size_t idx = gt; idx < (size_t)(M / 16) * 256; idx += NT) {
        const int t0 = (int)(idx >> 8) * 16, c = (int)(idx & 255) * 8, grp = __builtin_amdgcn_readfirstlane(c >> 9);
        if (grp == 0) pool_run<2>(HP, PMo, t0, c); else if (grp == 1) pool_run<4>(HP, PMo, t0, c); else if (grp == 2) pool_run<8>(HP, PMo, t0, c); else pool_run<16>(HP, PMo, t0, c);
    }
}
__device__ __forceinline__ void kv_reduce(Frame& F) {
    const float* SK = (const float*)(F.ws + WS_SLAB); bf16* KVX = (bf16*)(F.ws + WS_KVX);
    const size_t gt = (size_t)blockIdx.x * (NWAVES * 64) + F.tid, NT = (size_t)F.G * NWAVES * 64, NE = (size_t)512 * 8192;
    for (size_t i = gt; i < NE / 4; i += NT) { const float* sb = SK + i * 4;
        const f32x4 a = *(const GAS f32x4*)sb + *(const GAS f32x4*)(sb + NE) + *(const GAS f32x4*)(sb + 2 * NE) + *(const GAS f32x4*)(sb + 3 * NE);
        v2u o; o.x = pk2(a.x, a.y); o.y = pk2(a.z, a.w); *(GAS v2u*)(KVX + i * 4) = o; }
}

__device__ __forceinline__ void kmean_phase(Frame& F) {
    const bf16* Kb = (const bf16*)(F.ws + WS_K); bf16* KMH = (bf16*)(F.ws + WS_KMH); bf16* KML = (bf16*)(F.ws + WS_KML);
    LAS float* part = (LAS float*)(F.lds + RING_OFF);
    for (int item = blockIdx.x; item < 64 * 4; item += F.G) {
        const int bn = item >> 2, chunk = item & 3;
        float acc[8];
#pragma unroll
        for (int e = 0; e < 8; ++e) acc[e] = 0.f;
        const bf16* base = Kb + (size_t)(bn * 256 + F.wave * 32) * AW + chunk * 512 + F.lane * 8;
#pragma unroll
        for (int r = 0; r < 32; ++r) { const v4u q = *(const GAS v4u*)(base + (size_t)r * AW);
            acc[0] += bf_lo(q.x); acc[1] += bf_hi(q.x); acc[2] += bf_lo(q.y); acc[3] += bf_hi(q.y); acc[4] += bf_lo(q.z); acc[5] += bf_hi(q.z); acc[6] += bf_lo(q.w); acc[7] += bf_hi(q.w); }
#pragma unroll
        for (int e = 0; e < 8; ++e) part[F.wave * 512 + F.lane * 8 + e] = acc[e];
        __syncthreads();
        { float s = 0.f;
#pragma unroll
          for (int w = 0; w < 8; ++w) s += part[w * 512 + F.tid];
          const float mean = s * (1.0f / 256.0f); const unsigned hb = f2bf(mean); const float hf = __builtin_bit_cast(float, hb << 16);
          KMH[(size_t)bn * AW + chunk * 512 + F.tid] = (bf16)hb; KML[(size_t)bn * AW + chunk * 512 + F.tid] = (bf16)f2bf(mean - hf); }
        __syncthreads();
    }
}

__device__ __forceinline__ void gate_phase(Frame& F) {
    const bf16* Qb = (const bf16*)(F.ws + WS_Q); const bf16* KMH = (const bf16*)(F.ws + WS_KMH); const bf16* KML = (const bf16*)(F.ws + WS_KML);
    unsigned short* lists = (unsigned short*)(F.ws + WS_LIST); gu32* gcnt = F.ctl + CW_GCNT;
    LAS float* gl = (LAS float*)(F.lds + RING_OFF);
    LAS unsigned* lcnt = (LAS unsigned*)(F.lds + RING_OFF + 34816);
    LAS unsigned* gb = lcnt + 32;
    const int r32 = F.lane & 31, hi = F.lane >> 5;
    for (int uid = blockIdx.x; uid < 1024; uid += F.G) {
        const int bh = uid >> 5, qb = uid & 31, b = bh >> 4, h = bh & 15;
        if (qb == 0) continue;
        if (F.tid < 32) lcnt[F.tid] = 0u;
        const size_t trow = (size_t)b * SEQ + 256 * qb + 32 * F.wave + r32;
        f32x16 acc = {};
#pragma unroll
        for (int s = 0; s < 8; ++s) {
            const bf16x8 bq = *(const GAS bf16x8*)(Qb + trow * AW + h * HD + 16 * s + 8 * hi);
            const bf16x8 ah = *(const GAS bf16x8*)(KMH + (size_t)(b * 32 + r32) * AW + h * HD + 16 * s + 8 * hi);
            const bf16x8 al = *(const GAS bf16x8*)(KML + (size_t)(b * 32 + r32) * AW + h * HD + 16 * s + 8 * hi);
            acc = __builtin_amdgcn_mfma_f32_32x32x16_bf16(ah, bq, acc, 0, 0, 0);
            acc = __builtin_amdgcn_mfma_f32_32x32x16_bf16(al, bq, acc, 0, 0, 0);
        }
#pragma unroll
        for (int r = 0; r < 16; ++r) gl[(32 * F.wave + r32) * 33 + att::crow(r, hi)] = acc[r];
        __syncthreads();
        int s0 = 0, s1 = 0, s2 = 0; unsigned p0 = 0, p1 = 0, p2 = 0; const int nsel = qb < 3 ? qb : 3;
        if (F.tid < 256) {
            float v0 = -__builtin_inff(), v1 = v0, v2 = v0;
            for (int n = 0; n < qb; ++n) { const float g = gl[F.tid * 33 + n];
                if (g > v0) { v2 = v1; s2 = s1; v1 = v0; s1 = s0; v0 = g; s0 = n; }
                else if (g > v1) { v2 = v1; s2 = s1; v1 = g; s1 = n; }
                else if (g > v2) { v2 = g; s2 = n; } }
            p0 = __hip_atomic_fetch_add(lcnt + s0, 1u, __ATOMIC_RELAXED, __HIP_MEMORY_SCOPE_WORKGROUP);
            if (nsel > 1) p1 = __hip_atomic_fetch_add(lcnt + s1, 1u, __ATOMIC_RELAXED, __HIP_MEMORY_SCOPE_WORKGROUP);
            if (nsel > 2) p2 = __hip_atomic_fetch_add(lcnt + s2, 1u, __ATOMIC_RELAXED, __HIP_MEMORY_SCOPE_WORKGROUP);
        }
        __syncthreads();
        if (F.tid < 32) { const unsigned c = lcnt[F.tid]; gb[F.tid] = c ? __hip_atomic_fetch_add(gcnt + bh * 32 + F.tid, c, RLX_AGENT) : 0u; }
        __syncthreads();
        if (F.tid < 256) {
            unsigned short* lb = lists + (size_t)bh * LIST_STRIDE; const unsigned tl = (unsigned)(256 * qb + F.tid);
            lb[list_off(s0) + gb[s0] + p0] = (unsigned short)(tl | (0u << 13));
            if (nsel > 1) lb[list_off(s1) + gb[s1] + p1] = (unsigned short)(tl | (1u << 13));
            if (nsel > 2) lb[list_off(s2) + gb[s2] + p2] = (unsigned short)(tl | (2u << 13));
        }
        __syncthreads();
    }
}

__device__ __forceinline__ void attn_phase(Frame& F, char* ldsg) {
    const bf16* Qb = (const bf16*)(F.ws + WS_Q); const bf16* Kb = (const bf16*)(F.ws + WS_K); const bf16* Vb = (const bf16*)(F.ws + WS_V);
    bf16* PO = (bf16*)(F.ws + WS_PARTO); float2* ML = (float2*)(F.ws + WS_ML);
    const unsigned short* lists = (const unsigned short*)(F.ws + WS_LIST); const gu32* gcnt = F.ctl + CW_GCNT;
    LAS int* pre = (LAS int*)(F.lds + RING_OFF + 67584);
    for (int i = F.tid; i < 1024; i += NWAVES * 64) pre[i] = (int)((__hip_atomic_load(gcnt + i, RLX_AGENT) + 255u) >> 8);
    __syncthreads();
    if (F.wave == 0) {
        int loc[16]; int s = 0;
#pragma unroll
        for (int k = 0; k < 16; ++k) { loc[k] = pre[F.lane * 16 + k]; s += loc[k]; }
        int incl = s;
#pragma unroll
        for (int o = 1; o < 64; o <<= 1) { const int v = __shfl_up(incl, o); if (F.lane >= o) incl += v; }
        int run = incl - s;
#pragma unroll
        for (int k = 0; k < 16; ++k) { pre[F.lane * 16 + k] = run; run += loc[k]; }
        if (F.lane == 63) pre[1024] = incl;
    }
    __syncthreads();
    const int total = 1024 + pre[1024];
    LAS int* DSC = (LAS int*)(F.lds + RING_OFF + 67584 + 4224);
    const int nloc = (total > (int)blockIdx.x) ? (total - (int)blockIdx.x + F.G - 1) / F.G : 0;
    if (F.tid < nloc && F.tid < 64) {
        const int id = blockIdx.x + F.tid * F.G; int bhj, own, lpos, cnt;
        if (id < 1024) { bhj = id; own = 1; lpos = 0; cnt = 256; }
        else { const int x = id - 1024; int lo = 0, hi2 = 1023;
            while (lo < hi2) { const int mid = (lo + hi2 + 1) >> 1; if (pre[mid] <= x) lo = mid; else hi2 = mid - 1; }
            const int li = lo, chunk = x - pre[li]; bhj = li; own = 0; lpos = (li >> 5) * LIST_STRIDE + list_off(li & 31) + 256 * chunk;
            const int c = (int)__hip_atomic_load(gcnt + li, RLX_AGENT) - 256 * chunk; cnt = c < 256 ? c : 256; }
        DSC[4 * F.tid] = bhj; DSC[4 * F.tid + 1] = own; DSC[4 * F.tid + 2] = lpos; DSC[4 * F.tid + 3] = cnt;
    }
    __syncthreads();
    att::ItemCtx C{Qb, Kb, Vb, PO, ML, lists};
    att::attn_items(C, (const LAS int*)DSC, nloc < 64 ? nloc : 64, ldsg);
}

__device__ __forceinline__ void combine_phase(Frame& F) {
    const bf16* PO = (const bf16*)(F.ws + WS_PARTO); const float2* ML = (const float2*)(F.ws + WS_ML); bf16* CAT = (bf16*)(F.ws + WS_CAT);
    constexpr float C = att::SCALE * 1.4426950408889634f;
    const size_t gt = (size_t)blockIdx.x * (NWAVES * 64) + F.tid, NT = (size_t)F.G * NWAVES * 64;
    for (size_t idx = gt; idx < (size_t)32 * SEQ * 16; idx += NT) {
        const int dc = (int)(idx & 15), t = (int)((idx >> 4) & (SEQ - 1)), bh = (int)(idx >> 17), qb = t >> 8, nsel = qb < 3 ? qb : 3;
        float2 ml[4]; float mx;
        ml[3] = ML[((size_t)3 * 32 + bh) * SEQ + t]; mx = ml[3].x;
#pragma unroll
        for (int k = 0; k < 3; ++k) { if (k < nsel) { ml[k] = ML[((size_t)k * 32 + bh) * SEQ + t]; mx = fmaxf(mx, ml[k].x); } else ml[k] = make_float2(0.f, 0.f); }
        float acc[8]; float wsum = 0.f;
#pragma unroll
        for (int e = 0; e < 8; ++e) acc[e] = 0.f;
#pragma unroll
        for (int k = 0; k < 4; ++k) { if (k == 3 || k < nsel) {
            const float w = ml[k].y * __builtin_amdgcn_exp2f((ml[k].x - mx) * C); wsum += w;
            const v4u r = *(const GAS v4u*)(PO + (((size_t)k * 32 + bh) * SEQ + t) * HD + dc * 8);
            acc[0] += w * bf_lo(r.x); acc[1] += w * bf_hi(r.x); acc[2] += w * bf_lo(r.y); acc[3] += w * bf_hi(r.y);
            acc[4] += w * bf_lo(r.z); acc[5] += w * bf_hi(r.z); acc[6] += w * bf_lo(r.w); acc[7] += w * bf_hi(r.w); } }
        const float inv = 1.0f / wsum; const int b = bh >> 4, h = bh & 15;
        v4u o; o.x = pk2(acc[0] * inv, acc[1] * inv); o.y = pk2(acc[2] * inv, acc[3] * inv); o.z = pk2(acc[4] * inv, acc[5] * inv); o.w = pk2(acc[6] * inv, acc[7] * inv);
        *(GAS v4u*)(CAT + ((size_t)b * SEQ + t) * DM + PW + h * HD + dc * 8) = o;
    }
}

struct Args { const float* in[18]; float* out; unsigned char* ws; int ph_lo, ph_hi, li, pad; };
__global__ void __launch_bounds__(NWAVES * 64, 2) mega_fwd(Args args) {
    extern __shared__ __attribute__((aligned(16))) unsigned char lds[];
    Frame F;
    F.lds = (LAS unsigned char*)lds;
    F.MISC = (volatile LAS unsigned*)(F.lds + MISC_OFF);
    F.tid = threadIdx.x; F.lane = F.tid & 63; F.wave = __builtin_amdgcn_readfirstlane(F.tid >> 6);
    F.G = gridDim.x; F.ws = args.ws;
    F.ctl = (gu32*)(args.ws + WS_CTL);
    for (int u = F.tid; u < (LDS_BYTES - LDSCTL_OFF) / 4; u += NWAVES * 64) ((LAS unsigned*)(F.lds + LDSCTL_OFF))[u] = 0u;
    __syncthreads();
    XcdBarrier bar; bar.bar = (unsigned*)(F.ctl + CW_BAR); bar.x = 0; bar.st = nullptr;
    if (N_LAUNCHES == 1) bar = xcd_barrier_post((unsigned*)(F.ctl + CW_BAR), F.MISC + 8);
#define GRID_BAR() do { if (N_LAUNCHES == 1) xcd_barrier(bar); } while (0)
    const int lo = args.ph_lo, hi = args.ph_hi;
#define IN(k) (lo <= (k) && (k) < hi)
#define BOTH(k) (IN(k) && IN((k) + 1))
#ifndef PROBE_DUP
#define PROBE_DUP 0
#endif
#define DUPON(k) ((PROBE_DUP >> (k)) & 1)
#define REP(k) for (int _rep = 0; _rep < (DUPON(k) ? 2 : 1); ++_rep)
    unsigned char* ws = args.ws;
    const int G = F.G, cid = (int)blockIdx.x;
    float* out = args.out;

    if (IN(0)) { REP(0) { p0_prologue(F, args.in); } if (BOTH(0)) GRID_BAR(); }

    if (IN(1)) {
        { pg8::GemmKV g{(const char*)(ws + WS_MEMB), (const char*)(ws + WS_WXKV), DM, DM, 1024};
          pg8::OrderKV S{G, cid}; pg8::EpiSlabKV E{(float*)(ws + WS_SLAB)};
          pg8::gemm_phase<pg8::EpiSlabKV, pg8::OrderKV, true, true, pg8::GemmKV>(F.lds + RING_OFF, g, S, E); if (DUPON(16)) { pg8::gemm_phase<pg8::EpiSlabKV, pg8::OrderKV, true, true, pg8::GemmKV>(F.lds + RING_OFF, g, S, E); } }
        { pg8::Gemm g = pg8::make_gemm(ws + WS_XB, DM, ws + WS_WIN, DM, DM); pg8::StaticOrder S; S.init(M, MIXIN, G, cid);
          pg8::EpiMixIn E{(pg8::bf16_t*)(ws + WS_HP), (size_t)M * 2048, (const float*)(ws + WS_ROPE)};
          pg8::gemm_phase<pg8::EpiMixIn, pg8::StaticOrder, true, true>(F.lds + RING_OFF, g, S, E); if (DUPON(1)) { pg8::gemm_phase<pg8::EpiMixIn, pg8::StaticOrder, true, true>(F.lds + RING_OFF, g, S, E); } }
        if (BOTH(1)) GRID_BAR();
    }

    if (IN(2)) { REP(2) { pool_ew(F); kmean_phase(F); kv_reduce(F); } if (BOTH(2)) GRID_BAR(); }

    if (IN(3)) {
        { pg8::Gemm g = pg8::make_gemm(ws + WS_PM, PW, ws + WS_WPOOL, 512, 512); g.a_pn = 512 * 2; g.a_pn_sh = 1; pg8::StaticOrder S; S.init(M, PW, G, cid);
          pg8::EpiStore E{(pg8::bf16_t*)(ws + WS_CAT), DM, 0};
          pg8::gemm_phase<pg8::EpiStore, pg8::StaticOrder, true, true>(F.lds + RING_OFF, g, S, E); if (DUPON(3)) { pg8::gemm_phase<pg8::EpiStore, pg8::StaticOrder, true, true>(F.lds + RING_OFF, g, S, E); } }
        if (G == 256) { pg8::GemmAbs g{(const char*)(ws + WS_KVX), (const char*)(ws + WS_WXQ), (const char*)(ws + WS_WXO), cid < 128 ? 8192 : 4096, cid < 128 ? 4096 : 8192, 1024};
          pg8::OrderAbs S{cid}; pg8::EpiStoreAbs E{(pg8::bf16_t*)(ws + WS_WQK), (pg8::bf16_t*)(ws + WS_WVOT)};
          pg8::gemm_phase<pg8::EpiStoreAbs, pg8::OrderAbs, true, true, pg8::GemmAbs>(F.lds + RING_OFF, g, S, E); if (DUPON(17)) { pg8::gemm_phase<pg8::EpiStoreAbs, pg8::OrderAbs, true, true, pg8::GemmAbs>(F.lds + RING_OFF, g, S, E); } }
        gate_phase(F);
        if (BOTH(3)) GRID_BAR();
    }

    if (IN(4)) { REP(4) { attn_phase(F, (char*)lds + RING_OFF); __syncthreads(); } if (BOTH(4)) GRID_BAR(); }

    if (IN(5)) { REP(5) { combine_phase(F); } if (BOTH(5)) GRID_BAR(); }

    if (IN(6)) {
        pg8::Gemm g = pg8::make_gemm(ws + WS_CAT, DM, ws + WS_WOUT, DM, DM); pg8::StaticOrder S; S.init(M, DM, G, cid);
        pg8::EpiResid E{args.in[0], (pg8::bf16_t*)(ws + WS_TB), DM, DN_ALPHA};
        pg8::gemm_phase<pg8::EpiResid, pg8::StaticOrder, true, true>(F.lds + RING_OFF, g, S, E); if (DUPON(6)) { pg8::gemm_phase<pg8::EpiResid, pg8::StaticOrder, true, true>(F.lds + RING_OFF, g, S, E); }
        if (BOTH(6)) GRID_BAR();
    }
    if (IN(7)) { ln_rows<false>(F, (const bf16*)(ws + WS_TB), (bf16*)(ws + WS_HB), (float2*)(ws + WS_STATS), nullptr, args.in[6], args.in[7]); if (BOTH(7)) GRID_BAR(); }

    if (IN(9)) {
        if (G == 256) {
            pg8::Gemm g = pg8::make_gemm(ws + WS_HB, DM, ws + WS_WQK, DM, DM); g.b_pm = (size_t)1024 * DM * 2; g.b_pm_sh = 5;
            pg8::StaticOrder S; S.init(M, XH * 256, G, cid);
            pg8::EpiSoftmax E{(pg8::bf16_t*)(ws + WS_PB), XH * MEMLEN, 0.03125f * 1.4426950408889634f};
            pg8::gemm_phase<pg8::EpiSoftmax, pg8::StaticOrder, false, true>(F.lds + RING_OFF, g, S, E); if (DUPON(9)) { pg8::gemm_phase<pg8::EpiSoftmax, pg8::StaticOrder, false, true>(F.lds + RING_OFF, g, S, E); }
        }
        if (BOTH(9)) GRID_BAR();
    }
    if (IN(11)) {
        pg8::Gemm g = pg8::make_gemm(ws + WS_PB, XH * MEMLEN, ws + WS_WVOT, 2048, XH * MEMLEN); g.b_pm = (size_t)1024 * 2; g.b_pm_sh = 5;
        pg8::StaticOrder S; S.init(M, DM, G, cid);
        pg8::EpiResidLN E{(pg8::bf16_t*)(ws + WS_TB), (const pg8::f32x2*)(ws + WS_STATS), 6};
        pg8::gemm_phase<pg8::EpiResidLN, pg8::StaticOrder, true, true>(F.lds + RING_OFF, g, S, E);
        if (BOTH(11)) GRID_BAR();
    }
    if (IN(12)) { ln_rows<false>(F, (const bf16*)(ws + WS_TB), (bf16*)(ws + WS_HB), (float2*)(ws + WS_STATS), nullptr, args.in[11], args.in[12]); if (BOTH(12)) GRID_BAR(); }

    if (IN(13)) {
        pg8::Gemm g = pg8::make_gemm(ws + WS_HB, DM, ws + WS_WGU, DM, DM); pg8::StaticOrder S; S.init(M, 2 * FF, G, cid);
        pg8::EpiSwiGLU E{(pg8::bf16_t*)(ws + WS_G), FF};
        pg8::gemm_phase<pg8::EpiSwiGLU, pg8::StaticOrder, true, true>(F.lds + RING_OFF, g, S, E); if (DUPON(13)) { pg8::gemm_phase<pg8::EpiSwiGLU, pg8::StaticOrder, true, true>(F.lds + RING_OFF, g, S, E); }
        if (BOTH(13)) GRID_BAR();
    }
    if (IN(14)) {
        pg8::Gemm g = pg8::make_gemm(ws + WS_G, FF, ws + WS_WDN, FF, FF); pg8::StaticOrder S; S.init(M, DM, G, cid);
        pg8::EpiResidLN E{(pg8::bf16_t*)(ws + WS_TB), (const pg8::f32x2*)(ws + WS_STATS), 11};
        pg8::gemm_phase<pg8::EpiResidLN, pg8::StaticOrder, true, true>(F.lds + RING_OFF, g, S, E);
        if (BOTH(14)) GRID_BAR();
    }
    if (IN(15)) { ln_rows<true>(F, (const bf16*)(ws + WS_TB), nullptr, nullptr, out, args.in[16], args.in[17]); }
#undef IN
#undef BOTH
#undef GRID_BAR
}

extern "C" void kernel_launch(void* const* d_in, const int* in_sizes, int n_in, void* d_out, int out_size, void* d_ws, size_t ws_size, hipStream_t stream) {
    static int grid = 0;
    if (grid == 0) {
        if (n_in != 18 || in_sizes[0] != M * DM || out_size != M * DM || ws_size < WS_END) { fprintf(stderr, "kernel_launch: shape / workspace mismatch (n_in %d, in0 %d, out %d, ws %zu, need %zu)\n", n_in, n_in > 0 ? in_sizes[0] : -1, out_size, ws_size, (size_t)WS_END); grid = -1; return; }
        int dev = 0, cus = 0, per_cu = 0;
        if (hipGetDevice(&dev) != hipSuccess || hipDeviceGetAttribute(&cus, hipDeviceAttributeMultiprocessorCount, dev) != hipSuccess) { grid = -1; return; }
        if (hipFuncSetAttribute((const void*)mega_fwd, hipFuncAttributeMaxDynamicSharedMemorySize, LDS_BYTES) != hipSuccess) { fprintf(stderr, "kernel_launch: hipFuncSetAttribute failed\n"); grid = -1; return; }
        if (hipOccupancyMaxActiveBlocksPerMultiprocessor(&per_cu, (const void*)mega_fwd, NWAVES * 64, LDS_BYTES) != hipSuccess || per_cu < 1)
            fprintf(stderr, "kernel_launch: note: occupancy query reports %d workgroups per CU\n", per_cu);
        (void)hipGetLastError();
        grid = cus;
        if (grid != 256) fprintf(stderr, "kernel_launch: %d CUs; the cross-attention score phase needs a 256-workgroup grid\n", grid);
    }
    if (grid < 0) return;
    if (hipMemsetAsync((char*)d_ws + WS_CTL, 0, CTL_ZERO_BYTES, stream) != hipSuccess) return;
    Args a{};
    for (int i = 0; i < 18; ++i) a.in[i] = (const float*)d_in[i];
    a.out = (float*)d_out; a.ws = (unsigned char*)d_ws; a.pad = 0;
    for (int li = 0; li < N_LAUNCHES; ++li) {
        a.ph_lo = (N_LAUNCHES == 1) ? 0 : li; a.ph_hi = (N_LAUNCHES == 1) ? N_PHASES : li + 1; a.li = li;
        hipLaunchKernelGGL(mega_fwd, dim3(grid), dim3(NWAVES * 64), LDS_BYTES, stream, a);
        if (hipPeekAtLastError() != hipSuccess) { fprintf(stderr, "kernel_launch: launch %d failed\n", li); break; }
    }
}
```

```cpp
#include <hip/hip_runtime.h>
#include <cstdio>
#include <cstdint>

namespace pg8 {
#define PG8_LAS __attribute__((address_space(3)))
typedef unsigned short bf16_t;
typedef short bf16x8 __attribute__((ext_vector_type(8)));
typedef float f32x4 __attribute__((ext_vector_type(4)));
typedef float f32x2 __attribute__((ext_vector_type(2)));
typedef unsigned u32x4 __attribute__((ext_vector_type(4)));
typedef unsigned u32x2 __attribute__((ext_vector_type(2)));
constexpr int BM = 256, BK = 64, HALF = 128, HTB = HALF * BK * 2  , STAGE_BYTES = 8 * HTB, NXCD = 8, WGM = 8;

__host__ __device__ __forceinline__ int lds_byte(int r, int c) { const int st = (r >> 4) * 2 + (c >> 5), rr = r & 15, cc = c & 31, ob = rr * 64 + cc * 2; return st * 1024 + (ob ^ (((ob >> 9) & 1) << 5)); }
__host__ __device__ __forceinline__ void stage_rc(int b, int& R, int& C) { const int st = b / 1024, sb = b % 1024, swz = sb ^ (((sb >> 9) & 1) << 5); R = (st >> 1) * 16 + swz / 64; C = (st & 1) * 32 + (swz % 64) / 2; }
__host__ __device__ __forceinline__ int perm32(int rho) { const int n = rho >> 4, i = rho & 15; return 8 * (i >> 2) + 4 * n + (i & 3); }

struct Unit { int pm, pn, pz; };
struct Gemm {
    const char* A; const char* B; int lda, ldb, K;
    size_t a_pm, a_pn; int a_pn_sh; size_t b_pn, b_pm; int b_pm_sh;
    __device__ __forceinline__ const char* a_ptr(const Unit& u) const { return A + (size_t)u.pm * a_pm + (size_t)(u.pn >> a_pn_sh) * a_pn; }
    __device__ __forceinline__ const char* b_ptr(const Unit& u) const { return B + (size_t)u.pn * b_pn + (size_t)(u.pm >> b_pm_sh) * b_pm; }
};
__device__ __forceinline__ Gemm make_gemm(const void* A, int lda, const void* B, int ldb, int K) {
    Gemm g; g.A = (const char*)A; g.B = (const char*)B; g.lda = lda; g.ldb = ldb; g.K = K;
    g.a_pm = (size_t)BM * lda * 2; g.a_pn = 0; g.a_pn_sh = 0; g.b_pn = (size_t)BM * ldb * 2; g.b_pm = 0; g.b_pm_sh = 0; return g;
}

struct StaticOrder {
    int nM, nN, nwg, G, c;
    __host__ __device__ void init(int M, int N, int G_, int c_) { nM = M / BM; nN = N / BM; nwg = nM * nN; G = G_; c = c_; }
    __host__ __device__ bool next(int i, Unit& u) const {
        const long L = (long)i * G + c; if (L >= nwg) return false;
        int wgid = (int)L; { const int q = nwg / NXCD, r = nwg % NXCD, xcd = wgid % NXCD, off = wgid / NXCD; wgid = (xcd < r ? xcd * (q + 1) : r * (q + 1) + (xcd - r) * q) + off; }
        const int nig = WGM * nN, gid = wgid / nig, fm = gid * WGM, gsz = (nM - fm) < WGM ? (nM - fm) : WGM;
        u.pm = fm + ((wgid % nig) % gsz); u.pn = (wgid % nig) / gsz; u.pz = 0; return true;
    }
    __device__ __forceinline__ void a_ready(const Unit&) const {}
    __device__ __forceinline__ void done(const Unit&) const {}
};

__device__ __forceinline__ unsigned cvt_pk_bf16(float lo, float hi) { unsigned r; asm volatile("v_cvt_pk_bf16_f32 %0, %1, %2" : "=v"(r) : "v"(lo), "v"(hi)); return r; }

struct EpiMixIn {
    static constexpr bool PERM = true, AFTER_DRAIN = false;
    bf16_t* base; size_t tstride; const float* rope;
    __device__ __forceinline__ void operator()(const f32x4 (&acc)[2][2][4][2], const Unit& u, int wr, int wc, int fr, int fq) const {
        const int t = u.pn >> 3; const bool rp = (t == 1) || (t == 2);
        bf16_t* ob = base + (size_t)t * tstride;
        const int row0 = u.pm * BM + wr * 64 + fr, col0 = (u.pn & 7) * BM + wc * 32 + 8 * fq;
#pragma unroll
        for (int ai = 0; ai < 2; ++ai)
#pragma unroll
            for (int m = 0; m < 4; ++m) {
                const int row = row0 + ai * HALF + m * 16; bf16_t* rowp = ob + (size_t)row * 2048 + col0;
                f32x4 cs0 = (f32x4){1.f, 0.f, 1.f, 0.f}, cs1 = cs0;
                if (rp) { const f32x4* tp = (const f32x4*)(rope + ((size_t)(row & 8191) * 64 + wc * 16 + fq * 4) * 2); cs0 = tp[0]; cs1 = tp[1]; }
#pragma unroll
                for (int bj = 0; bj < 2; ++bj) {
                    const f32x4 v0 = acc[ai][bj][m][0], v1 = acc[ai][bj][m][1];
                    const float a0 = v0[0] * cs0[0] - v0[1] * cs0[1], a1 = v0[1] * cs0[0] + v0[0] * cs0[1];
                    const float a2 = v0[2] * cs0[2] - v0[3] * cs0[3], a3 = v0[3] * cs0[2] + v0[2] * cs0[3];
                    const float b0 = v1[0] * cs1[0] - v1[1] * cs1[1], b1 = v1[1] * cs1[0] + v1[0] * cs1[1];
                    const float b2 = v1[2] * cs1[2] - v1[3] * cs1[3], b3 = v1[3] * cs1[2] + v1[2] * cs1[3];
                    u32x4 w; w.x = cvt_pk_bf16(a0, a1); w.y = cvt_pk_bf16(a2, a3); w.z = cvt_pk_bf16(b0, b1); w.w = cvt_pk_bf16(b2, b3);
                    *(u32x4*)(rowp + bj * HALF) = w;
                }
            }
    }
};
struct EpiStore {
    static constexpr bool PERM = true, AFTER_DRAIN = false;
    bf16_t* O; int ldc, coff;
    __device__ __forceinline__ void operator()(const f32x4 (&acc)[2][2][4][2], const Unit& u, int wr, int wc, int fr, int fq) const {
        const int row0 = u.pm * BM + wr * 64 + fr, col0 = coff + u.pn * BM + wc * 32 + 8 * fq;
#pragma unroll
        for (int ai = 0; ai < 2; ++ai)
#pragma unroll
            for (int m = 0; m < 4; ++m) { bf16_t* rowp = O + (size_t)(row0 + ai * HALF + m * 16) * ldc + col0;
#pragma unroll
                for (int bj = 0; bj < 2; ++bj) { const f32x4 v0 = acc[ai][bj][m][0], v1 = acc[ai][bj][m][1];
                    u32x4 w; w.x = cvt_pk_bf16(v0[0], v0[1]); w.y = cvt_pk_bf16(v0[2], v0[3]); w.z = cvt_pk_bf16(v1[0], v1[1]); w.w = cvt_pk_bf16(v1[2], v1[3]);
                    *(u32x4*)(rowp + bj * HALF) = w; } }
    }
};
struct EpiResid {
    static constexpr bool PERM = true, AFTER_DRAIN = false;
    const float* res; bf16_t* out; int ldc; float alpha;
    __device__ __forceinline__ void operator()(const f32x4 (&acc)[2][2][4][2], const Unit& u, int wr, int wc, int fr, int fq) const {
        const int row0 = u.pm * BM + wr * 64 + fr, col0 = u.pn * BM + wc * 32 + 8 * fq;
#pragma unroll
        for (int ai = 0; ai < 2; ++ai)
#pragma unroll
            for (int m = 0; m < 4; ++m) { const size_t off = (size_t)(row0 + ai * HALF + m * 16) * ldc + col0;
#pragma unroll
                for (int bj = 0; bj < 2; ++bj) { const f32x4 r0 = *(const f32x4*)(res + off + bj * HALF), r1 = *(const f32x4*)(res + off + bj * HALF + 4);
                    const f32x4 v0 = r0 * alpha + acc[ai][bj][m][0], v1 = r1 * alpha + acc[ai][bj][m][1];
                    u32x4 w; w.x = cvt_pk_bf16(v0[0], v0[1]); w.y = cvt_pk_bf16(v0[2], v0[3]); w.z = cvt_pk_bf16(v1[0], v1[1]); w.w = cvt_pk_bf16(v1[2], v1[3]);
                    *(u32x4*)(out + off + bj * HALF) = w; }
                asm volatile("" ::: "memory"); }
    }
};
struct EpiSwiGLU {
    static constexpr bool PERM = true, AFTER_DRAIN = false;
    bf16_t* G; int ldc;
    __device__ __forceinline__ float act(float g, float u) const { return g * u * __builtin_amdgcn_rcpf(1.0f + __builtin_amdgcn_exp2f(-1.4426950408889634f * g)); }
    __device__ __forceinline__ void operator()(const f32x4 (&acc)[2][2][4][2], const Unit& u, int wr, int wc, int fr, int fq) const {
        const int row0 = u.pm * BM + wr * 64 + fr, col0 = u.pn * HALF + wc * 32 + 8 * fq;
#pragma unroll
        for (int ai = 0; ai < 2; ++ai)
#pragma unroll
            for (int m = 0; m < 4; ++m) { bf16_t* rowp = G + (size_t)(row0 + ai * HALF + m * 16) * ldc + col0;
                const f32x4 g0 = acc[ai][0][m][0], g1 = acc[ai][0][m][1], u0 = acc[ai][1][m][0], u1 = acc[ai][1][m][1];
                u32x4 w; w.x = cvt_pk_bf16(act(g0[0], u0[0]), act(g0[1], u0[1])); w.y = cvt_pk_bf16(act(g0[2], u0[2]), act(g0[3], u0[3]));
                w.z = cvt_pk_bf16(act(g1[0], u1[0]), act(g1[1], u1[1])); w.w = cvt_pk_bf16(act(g1[2], u1[2]), act(g1[3], u1[3]));
                *(u32x4*)rowp = w; }
    }
};
struct EpiSoftmax {
    static constexpr bool PERM = true, AFTER_DRAIN = true;
    bf16_t* P; int ldc; float c2;
    __device__ __forceinline__ void fused(f32x4 (&acc)[2][2][4][2], const Unit& u, int wr, int wc, int fr, int fq, PG8_LAS unsigned char* lds, int wid, int lane) const {
        PG8_LAS float* T1 = (PG8_LAS float*)lds;
        PG8_LAS float* T2 = (PG8_LAS float*)(lds + 4096);
#pragma unroll
        for (int ai = 0; ai < 2; ++ai)
#pragma unroll
            for (int m = 0; m < 4; ++m) { float mx = -3.0e38f;
#pragma unroll
                for (int bj = 0; bj < 2; ++bj)
#pragma unroll
                    for (int n = 0; n < 2; ++n) { const f32x4 x = acc[ai][bj][m][n]; mx = fmaxf(mx, fmaxf(fmaxf(x[0], x[1]), fmaxf(x[2], x[3]))); }
                mx = fmaxf(mx, __shfl_xor(mx, 16)); mx = fmaxf(mx, __shfl_xor(mx, 32));
                if (fq == 0) T1[(ai * HALF + wr * 64 + m * 16 + fr) * 4 + wc] = mx; }
        asm volatile("s_waitcnt lgkmcnt(0)" ::: "memory"); __builtin_amdgcn_s_barrier(); asm volatile("" ::: "memory");
#pragma unroll
        for (int ai = 0; ai < 2; ++ai)
#pragma unroll
            for (int m = 0; m < 4; ++m) { const int r = ai * HALF + wr * 64 + m * 16 + fr;
                const f32x4 t = *(const PG8_LAS f32x4*)(T1 + r * 4); const float mx = fmaxf(fmaxf(t[0], t[1]), fmaxf(t[2], t[3])) * c2; float s = 0.f;
#pragma unroll
                for (int bj = 0; bj < 2; ++bj)
#pragma unroll
                    for (int n = 0; n < 2; ++n) { f32x4 x = acc[ai][bj][m][n];
#pragma unroll
                        for (int e = 0; e < 4; ++e) { x[e] = __builtin_amdgcn_exp2f(x[e] * c2 - mx); s += x[e]; }
                        acc[ai][bj][m][n] = x; }
                s += __shfl_xor(s, 16); s += __shfl_xor(s, 32);
                if (fq == 0) T2[r * 4 + wc] = s; }
        asm volatile("s_waitcnt lgkmcnt(0)" ::: "memory"); __builtin_amdgcn_s_barrier(); asm volatile("" ::: "memory");
        const int row0 = u.pm * BM + wr * 64 + fr, col0 = u.pn * BM + wc * 32 + 8 * fq;
#pragma unroll
        for (int ai = 0; ai < 2; ++ai)
#pragma unroll
            for (int m = 0; m < 4; ++m) { const int r = ai * HALF + wr * 64 + m * 16 + fr;
                const f32x4 t = *(const PG8_LAS f32x4*)(T2 + r * 4); const float inv = 1.0f / ((t[0] + t[1]) + (t[2] + t[3]));
                bf16_t* rowp = P + (size_t)(row0 + ai * HALF + m * 16) * ldc + col0;
#pragma unroll
                for (int bj = 0; bj < 2; ++bj) { const f32x4 v0 = acc[ai][bj][m][0] * inv, v1 = acc[ai][bj][m][1] * inv;
                    u32x4 w; w.x = cvt_pk_bf16(v0[0], v0[1]); w.y = cvt_pk_bf16(v0[2], v0[3]); w.z = cvt_pk_bf16(v1[0], v1[1]); w.w = cvt_pk_bf16(v1[2], v1[3]);
                    *(u32x4*)(rowp + bj * HALF) = w; } }
    }
};

struct GemmKV {
    const char* memb; const char* wkv; int lda, ldb, K;
    __device__ __forceinline__ const char* a_ptr(const Unit& u) const { return memb + (size_t)u.pm * (BM * 4096 * 2) + (size_t)u.pz * 2048; }
    __device__ __forceinline__ const char* b_ptr(const Unit& u) const { return wkv + (size_t)u.pn * (BM * 4096 * 2) + (size_t)u.pz * 2048; }
};
struct OrderKV {
    int G, c;
    __device__ __forceinline__ bool next(int i, Unit& u) const { const int L = i * G + c; if (L >= 256) return false; const int tile = L >> 2; u.pz = L & 3; u.pm = tile >> 5; u.pn = tile & 31; return true; }
    __device__ __forceinline__ void a_ready(const Unit&) const {}
    __device__ __forceinline__ void done(const Unit&) const {}
};
struct EpiSlabKV {
    static constexpr bool PERM = false, AFTER_DRAIN = false;
    float* S;
    __device__ __forceinline__ void operator()(const f32x4 (&acc)[2][2][4][2], const Unit& u, int wr, int wc, int fr, int fq) const {
        float* C = S + (size_t)u.pz * (512 * 8192);
        const int row0 = u.pm * BM + wr * 64 + fr, col0 = u.pn * BM + wc * 32 + 4 * fq;
#pragma unroll
        for (int ai = 0; ai < 2; ++ai)
#pragma unroll
            for (int m = 0; m < 4; ++m) { float* rowp = C + (size_t)(row0 + ai * HALF + m * 16) * 8192 + col0;
#pragma unroll
                for (int bj = 0; bj < 2; ++bj)
#pragma unroll
                    for (int n = 0; n < 2; ++n) *(f32x4*)(rowp + bj * HALF + n * 16) = acc[ai][bj][m][n]; }
    }
};
struct GemmAbs {
    const char* kvx; const char* wq_raw; const char* wo_t; int lda, ldb, K;
    __device__ __forceinline__ const char* a_ptr(const Unit& u) const {
        return u.pz ? wo_t + (size_t)u.pm * (BM * 4096 * 2) + (size_t)(u.pn & 3) * 2048
                    : kvx + (size_t)(u.pm >> 2) * (BM * 8192 * 2) + (size_t)(u.pm & 3) * 2048; }
    __device__ __forceinline__ const char* b_ptr(const Unit& u) const {
        return u.pz ? kvx + 8192 + (size_t)(u.pn >> 2) * (BM * 8192 * 2) + (size_t)(u.pn & 3) * 2048
                    : wq_raw + (size_t)u.pn * (BM * 4096 * 2) + (size_t)(u.pm & 3) * 2048; }
};
struct OrderAbs {
    int c;
    __device__ __forceinline__ bool next(int i, Unit& u) const { if (i != 0 || c >= 256) return false; if (c < 128) { u.pz = 0; u.pm = c >> 4; u.pn = c & 15; } else { const int t = c - 128; u.pz = 1; u.pm = t >> 3; u.pn = t & 7; } return true; }
    __device__ __forceinline__ void a_ready(const Unit&) const {}
    __device__ __forceinline__ void done(const Unit&) const {}
};
struct EpiStoreAbs {
    static constexpr bool PERM = true, AFTER_DRAIN = false;
    bf16_t* WQK; bf16_t* WVOT;
    __device__ __forceinline__ void operator()(const f32x4 (&acc)[2][2][4][2], const Unit& u, int wr, int wc, int fr, int fq) const {
        bf16_t* O = u.pz ? WVOT : WQK; const int ldc = u.pz ? 2048 : 4096;
        const int row0 = u.pm * BM + wr * 64 + fr, col0 = u.pn * BM + wc * 32 + 8 * fq;
#pragma unroll
        for (int ai = 0; ai < 2; ++ai)
#pragma unroll
            for (int m = 0; m < 4; ++m) { bf16_t* rowp = O + (size_t)(row0 + ai * HALF + m * 16) * ldc + col0;
#pragma unroll
                for (int bj = 0; bj < 2; ++bj) { const f32x4 v0 = acc[ai][bj][m][0], v1 = acc[ai][bj][m][1];
                    u32x4 w; w.x = cvt_pk_bf16(v0[0], v0[1]); w.y = cvt_pk_bf16(v0[2], v0[3]); w.z = cvt_pk_bf16(v1[0], v1[1]); w.w = cvt_pk_bf16(v1[2], v1[3]);
                    *(u32x4*)(rowp + bj * HALF) = w; } }
    }
};
struct EpiResidLN {
    static constexpr bool PERM = true, AFTER_DRAIN = false;
    bf16_t* T; const f32x2* stats; int gi;
    __device__ __forceinline__ void operator()(const f32x4 (&acc)[2][2][4][2], const Unit& u, int wr, int wc, int fr, int fq) const {
        constexpr int ldc = 4096; constexpr float alpha = 1.189207115002721f;
        const float* const __attribute__((address_space(4)))* inp = (const float* const __attribute__((address_space(4)))*)__builtin_amdgcn_kernarg_segment_ptr();
        const float* g = inp[gi]; const float* b = inp[gi + 1];
        const int row0 = u.pm * BM + wr * 64 + fr, col0 = u.pn * BM + wc * 32 + 8 * fq;
        f32x4 gv[2][2], bv[2][2];
#pragma unroll
        for (int bj = 0; bj < 2; ++bj)
#pragma unroll
            for (int n = 0; n < 2; ++n) { gv[bj][n] = *(const f32x4*)(g + col0 + bj * HALF + n * 4) * alpha; bv[bj][n] = *(const f32x4*)(b + col0 + bj * HALF + n * 4) * alpha; }
#pragma unroll
        for (int ai = 0; ai < 2; ++ai)
#pragma unroll
            for (int m = 0; m < 4; ++m) { const int row = row0 + ai * HALF + m * 16; const size_t off = (size_t)row * ldc + col0; const f32x2 st = stats[row];
#pragma unroll
                for (int bj = 0; bj < 2; ++bj) { const u32x4 r = *(const u32x4*)(T + off + bj * HALF);
                    const f32x4 t0 = (f32x4){__builtin_bit_cast(float, r.x << 16), __builtin_bit_cast(float, r.x & 0xffff0000u), __builtin_bit_cast(float, r.y << 16), __builtin_bit_cast(float, r.y & 0xffff0000u)};
                    const f32x4 t1 = (f32x4){__builtin_bit_cast(float, r.z << 16), __builtin_bit_cast(float, r.z & 0xffff0000u), __builtin_bit_cast(float, r.w << 16), __builtin_bit_cast(float, r.w & 0xffff0000u)};
                    const f32x4 v0 = ((t0 - st.x) * st.y) * gv[bj][0] + bv[bj][0] + acc[ai][bj][m][0], v1 = ((t1 - st.x) * st.y) * gv[bj][1] + bv[bj][1] + acc[ai][bj][m][1];
                    u32x4 w; w.x = cvt_pk_bf16(v0[0], v0[1]); w.y = cvt_pk_bf16(v0[2], v0[3]); w.z = cvt_pk_bf16(v1[0], v1[1]); w.w = cvt_pk_bf16(v1[2], v1[3]);
                    *(u32x4*)(T + off + bj * HALF) = w; }
                asm volatile("" ::: "memory"); }
    }
};

template <class Epi, class Sched, bool ALIGN_EPI = false, bool SP2 = false, class GT = Gemm>
__device__ __forceinline__ void gemm_phase(PG8_LAS unsigned char* lds, const GT g, const Sched& S, const Epi& E) {
    const int tid = threadIdx.x, wid = __builtin_amdgcn_readfirstlane(tid >> 6), lane = tid & 63, wr = wid >> 2, wc = wid & 3, fr = lane & 15, fq = lane >> 4;
    const int K = g.K, nt = K / BK;
    unsigned voffA[2], voffB[2];
#pragma unroll
    for (int i = 0; i < 2; ++i) { int R, C; stage_rc(tid * 16 + i * 8192, R, C); const int Rb = Epi::PERM ? ((R & ~31) + perm32(R & 31)) : R;
        voffA[i] = (unsigned)(R * g.lda + C) * 2u; voffB[i] = (unsigned)(Rb * g.ldb + C) * 2u; }
    const size_t kstep = (size_t)(BK * 2);
    const size_t hA = (size_t)HALF * g.lda * 2, hB = (size_t)HALF * g.ldb * 2;
    const unsigned ldsw = (unsigned)wid * 1024u;
    const int aoff = lds_byte(wr * 64 + fr, fq * 8), boff = lds_byte(wc * 32 + fr, fq * 8);
#define PG8_SA(b, h) (((b) * 2 + (h)) * HTB)
#define PG8_SB(b, h) ((4 + (b) * 2 + (h)) * HTB)
#define PG8_STAGE(bufoff, gbase, voff) do { _Pragma("unroll") for (int _i = 0; _i < 2; ++_i) \
        __builtin_amdgcn_global_load_lds((const unsigned*)((const char*)(gbase) + (voff)[_i]), (PG8_LAS unsigned*)(lds + (bufoff) + ldsw + _i * 8192), 16, 0, 0); } while (0)
#define PG8_LDA(dst, b, h) do { _Pragma("unroll") for (int m = 0; m < 4; ++m) _Pragma("unroll") for (int k = 0; k < 2; ++k) dst[m][k] = *(const PG8_LAS bf16x8*)(lds + PG8_SA(b, h) + aoff + m * 2048 + k * 1024); } while (0)
#define PG8_LDB(dst, b, h) do { _Pragma("unroll") for (int n = 0; n < 2; ++n) _Pragma("unroll") for (int k = 0; k < 2; ++k) dst[n][k] = *(const PG8_LAS bf16x8*)(lds + PG8_SB(b, h) + boff + n * 2048 + k * 1024); } while (0)
#define PG8_MMA(ai, bj, At, Bt) do { __builtin_amdgcn_s_setprio(1); _Pragma("unroll") for (int m = 0; m < 4; ++m) _Pragma("unroll") for (int n = 0; n < 2; ++n) _Pragma("unroll") for (int k = 0; k < 2; ++k) \
        acc[ai][bj][m][n] = __builtin_amdgcn_mfma_f32_16x16x32_bf16(Bt[n][k], At[m][k], acc[ai][bj][m][n], 0, 0, 0); __builtin_amdgcn_s_setprio(0); } while (0)
#define PG8_WAIT_V(n) asm volatile("s_waitcnt vmcnt(" #n ")" ::: "memory")
#define PG8_WAIT_L(n) asm volatile("s_waitcnt lgkmcnt(" #n ")" ::: "memory")
#define PG8_BAR __builtin_amdgcn_s_barrier()
#define PG8_SCHED __builtin_amdgcn_sched_barrier(0)
    Unit cur, nxt; int ui = 0;
    if (!S.next(0, cur)) return;
    f32x4 acc[2][2][4][2];
#pragma unroll
    for (int a = 0; a < 2; ++a)
#pragma unroll
        for (int b = 0; b < 2; ++b)
#pragma unroll
            for (int m = 0; m < 4; ++m)
#pragma unroll
                for (int n = 0; n < 2; ++n) acc[a][b][m][n] = (f32x4){0.f, 0.f, 0.f, 0.f};
    bf16x8 At[4][2], B0[2][2], B1[2][2];
    const char* cA = g.a_ptr(cur); const char* cB = g.b_ptr(cur);
    S.a_ready(cur);
    if constexpr (SP2) {
        PG8_STAGE(PG8_SB(0, 0), cB, voffB); PG8_STAGE(PG8_SB(0, 1), cB + hB, voffB); PG8_STAGE(PG8_SA(0, 0), cA, voffA); PG8_STAGE(PG8_SA(0, 1), cA + hA, voffA);
        if (wr == 1) PG8_BAR;
        PG8_WAIT_V(2); PG8_BAR;
        PG8_STAGE(PG8_SB(1, 0), cB + kstep, voffB); PG8_STAGE(PG8_SA(1, 0), cA + kstep, voffA); PG8_STAGE(PG8_SB(1, 1), cB + hB + kstep, voffB);
        PG8_WAIT_V(6); PG8_BAR;
    } else {
        PG8_STAGE(PG8_SB(0, 0), cB, voffB); PG8_STAGE(PG8_SA(0, 0), cA, voffA); PG8_STAGE(PG8_SB(0, 1), cB + hB, voffB); PG8_STAGE(PG8_SA(0, 1), cA + hA, voffA);
        if (wr == 1) PG8_BAR;
        PG8_WAIT_V(4); PG8_BAR;
        PG8_STAGE(PG8_SB(1, 0), cB + kstep, voffB); PG8_STAGE(PG8_SA(1, 0), cA + kstep, voffA); PG8_STAGE(PG8_SB(1, 1), cB + hB + kstep, voffB);
        PG8_WAIT_V(6); PG8_BAR;
    }
    for (;;) {
        const bool has_next = S.next(ui + 1, nxt);
        const char* nA = has_next ? g.a_ptr(nxt) : cA; const char* nB = has_next ? g.b_ptr(nxt) : cB;
        for (int t = 0; t < nt; t += 2) {
            const bool last = (t == nt - 2);
            const char* a1 = cA + (size_t)(t + 1) * kstep;
            const char* a2 = last ? nA : cA + (size_t)(t + 2) * kstep; const char* b2 = last ? nB : cB + (size_t)(t + 2) * kstep;
            const char* a3 = a2 + kstep; const char* b3 = b2 + kstep;
            if (last && has_next) S.a_ready(nxt);
            if constexpr (SP2) {
            PG8_LDB(B0, 0, 0); PG8_LDB(B1, 0, 1); PG8_SCHED; PG8_LDA(At, 0, 0); PG8_STAGE(PG8_SA(1, 1), a1 + hA, voffA);
            PG8_WAIT_V(8); PG8_WAIT_L(0); PG8_BAR; PG8_MMA(0, 0, At, B0); PG8_MMA(0, 1, At, B1); PG8_BAR; PG8_SCHED;
            PG8_LDA(At, 0, 1); PG8_STAGE(PG8_SB(0, 0), b2, voffB); PG8_STAGE(PG8_SB(0, 1), b2 + hB, voffB); PG8_STAGE(PG8_SA(0, 0), a2, voffA);
            PG8_WAIT_V(8); PG8_WAIT_L(0); PG8_BAR; PG8_MMA(1, 0, At, B0); PG8_MMA(1, 1, At, B1); PG8_BAR; PG8_SCHED;
            PG8_LDB(B0, 1, 0); PG8_LDB(B1, 1, 1); PG8_SCHED; PG8_LDA(At, 1, 0); PG8_STAGE(PG8_SA(0, 1), a2 + hA, voffA);
            PG8_WAIT_V(8); PG8_WAIT_L(0); PG8_BAR; PG8_MMA(0, 0, At, B0); PG8_MMA(0, 1, At, B1); PG8_BAR; PG8_SCHED;
            PG8_LDA(At, 1, 1); PG8_STAGE(PG8_SB(1, 0), b3, voffB); PG8_STAGE(PG8_SB(1, 1), b3 + hB, voffB); PG8_STAGE(PG8_SA(1, 0), a3, voffA);
            PG8_WAIT_V(8); PG8_WAIT_L(0); PG8_BAR; PG8_MMA(1, 0, At, B0); PG8_MMA(1, 1, At, B1); PG8_BAR; PG8_SCHED;
            } else {
            PG8_LDB(B0, 0, 0); PG8_SCHED; PG8_LDA(At, 0, 0); PG8_STAGE(PG8_SA(1, 1), a1 + hA, voffA);
            PG8_WAIT_L(8); PG8_BAR; PG8_WAIT_L(0); PG8_MMA(0, 0, At, B0); PG8_BAR; PG8_SCHED;
            PG8_LDB(B1, 0, 1); PG8_STAGE(PG8_SB(0, 0), b2, voffB);
            PG8_BAR; PG8_WAIT_L(0); PG8_MMA(0, 1, At, B1); PG8_BAR;
            PG8_LDA(At, 0, 1); PG8_STAGE(PG8_SA(0, 0), a2, voffA);
            PG8_BAR; PG8_WAIT_L(0); PG8_MMA(1, 0, At, B0); PG8_BAR; PG8_SCHED;
            PG8_STAGE(PG8_SB(0, 1), b2 + hB, voffB);
            PG8_WAIT_V(6); PG8_BAR; PG8_MMA(1, 1, At, B1); PG8_BAR;
            PG8_LDB(B0, 1, 0); PG8_SCHED; PG8_LDA(At, 1, 0); PG8_STAGE(PG8_SA(0, 1), a2 + hA, voffA);
            PG8_WAIT_L(8); PG8_BAR; PG8_WAIT_L(0); PG8_MMA(0, 0, At, B0); PG8_BAR; PG8_SCHED;
            PG8_LDB(B1, 1, 1); PG8_STAGE(PG8_SB(1, 0), b3, voffB);
            PG8_BAR; PG8_WAIT_L(0); PG8_MMA(0, 1, At, B1); PG8_BAR;
            PG8_LDA(At, 1, 1); PG8_STAGE(PG8_SA(1, 0), a3, voffA);
            PG8_BAR; PG8_WAIT_L(0); PG8_MMA(1, 0, At, B0); PG8_BAR; PG8_SCHED;
            PG8_STAGE(PG8_SB(1, 1), b3 + hB, voffB);
            PG8_WAIT_V(6); PG8_BAR; PG8_MMA(1, 1, At, B1); PG8_BAR;
            }
        }
        if constexpr (ALIGN_EPI) { if (wr == 0) PG8_BAR; }
        if constexpr (!Epi::AFTER_DRAIN) { E(acc, cur, wr, wc, fr, fq); S.done(cur); }
        if (!has_next) break;
#pragma unroll
        for (int a = 0; a < 2; ++a)
#pragma unroll
            for (int b = 0; b < 2; ++b)
#pragma unroll
                for (int m = 0; m < 4; ++m)
#pragma unroll
                    for (int n = 0; n < 2; ++n) acc[a][b][m][n] = (f32x4){0.f, 0.f, 0.f, 0.f};
        cur = nxt; cA = nA; cB = nB; ++ui;
        if constexpr (ALIGN_EPI) { if (wr == 1) PG8_BAR; }
    }
    PG8_WAIT_V(0);
    if constexpr (!ALIGN_EPI) { if (wr == 0) PG8_BAR; }
    PG8_BAR;
    if constexpr (Epi::AFTER_DRAIN) { E.fused(acc, cur, wr, wc, fr, fq, lds, wid, lane); S.done(cur); }
#undef PG8_SA
#undef PG8_SB
#undef PG8_STAGE
#undef PG8_LDA
#undef PG8_LDB
#undef PG8_MMA
#undef PG8_WAIT_V
#undef PG8_WAIT_L
#undef PG8_BAR
#undef PG8_SCHED
}
}

namespace att {
using bf16_t = unsigned short;
using bf16x8 = __attribute__((ext_vector_type(8))) short;
using s16x4  = __attribute__((ext_vector_type(4))) short;
using f32x16 = __attribute__((ext_vector_type(16))) float;
using u32x4  = __attribute__((ext_vector_type(4))) unsigned;
using u32x2  = __attribute__((ext_vector_type(2))) unsigned;
constexpr int   D = 128, NW = 8, QBLK = 32, KVBLK = 64, NT = 4;
constexpr float SCALE = 0.088388347648318440f;
constexpr float THR = 8.f;
constexpr int   LDQ = 2048, LDK = 2048;
constexpr size_t SHM_V = KVBLK * D * 2, SHM_K = KVBLK * D * 2, SHM_ATTN = 2 * SHM_V + 2 * SHM_K;
#define KSWZ(row, colB) ((row) * 256 + ((colB) ^ (((row) & 7) << 4)))
#define SBAR() __builtin_amdgcn_sched_barrier(0)
__device__ __forceinline__ int crow(int r, int hi) { return (r & 3) + 8 * (r >> 2) + 4 * hi; }
__device__ __forceinline__ unsigned cvtpk(float lo, float hi) { unsigned r; asm volatile("v_cvt_pk_bf16_f32 %0, %1, %2" : "=v"(r) : "v"(lo), "v"(hi)); return r; }

__device__ __forceinline__ void partialSM(f32x16& p0, f32x16& p1, float& m_reg, float& mn, float& alpha) {
  constexpr float C = SCALE * 1.4426950408889634f;
  float pmax = p0[0];
#pragma unroll
  for (int r = 1; r < 16; ++r) pmax = fmaxf(pmax, p0[r]);
#pragma unroll
  for (int r = 0; r < 16; ++r) pmax = fmaxf(pmax, p1[r]);
  { auto rr = __builtin_amdgcn_permlane32_swap(__float_as_uint(pmax), __float_as_uint(pmax), false, false);
    pmax = fmaxf(__uint_as_float(rr[0]), __uint_as_float(rr[1])); }
  if (__builtin_expect(__all(pmax - m_reg <= THR / SCALE), 1)) { mn = m_reg; alpha = 1.f; }
  else { mn = fmaxf(m_reg, pmax); alpha = __builtin_amdgcn_exp2f((m_reg - mn) * C); m_reg = mn; }
  float mnC = -mn * C;
#pragma unroll
  for (int r = 0; r < 16; ++r) p0[r] = fmaf(p0[r], C, mnC);
#pragma unroll
  for (int r = 0; r < 16; ++r) p1[r] = fmaf(p1[r], C, mnC);
#pragma unroll
  for (int r = 0; r < 16; ++r) p0[r] = __builtin_amdgcn_exp2f(p0[r]);
}
__device__ __forceinline__ void finishSM(f32x16& p0, f32x16& p1, float alpha, float& l_reg, bf16x8& pa0, bf16x8& pa1, bf16x8& pa2, bf16x8& pa3) {
#pragma unroll
  for (int r = 0; r < 16; ++r) p1[r] = __builtin_amdgcn_exp2f(p1[r]);
  float ps = 0;
#pragma unroll
  for (int r = 0; r < 16; ++r) ps += p0[r];
#pragma unroll
  for (int r = 0; r < 16; ++r) ps += p1[r];
  { auto rr = __builtin_amdgcn_permlane32_swap(__float_as_uint(ps), __float_as_uint(ps), false, false);
    ps = __uint_as_float(rr[0]) + __uint_as_float(rr[1]); }
  l_reg = l_reg * alpha + ps;
#define PK4(P, BASE, OUT) do { unsigned a0 = cvtpk(P[BASE + 0], P[BASE + 1]), a1 = cvtpk(P[BASE + 2], P[BASE + 3]);   \
    unsigned b0 = cvtpk(P[BASE + 4], P[BASE + 5]), b1 = cvtpk(P[BASE + 6], P[BASE + 7]);                              \
    auto r0 = __builtin_amdgcn_permlane32_swap(a0, b0, false, false); auto r1 = __builtin_amdgcn_permlane32_swap(a1, b1, false, false); \
    u32x4 w = {r0[0], r1[0], r0[1], r1[1]}; OUT = *reinterpret_cast<bf16x8*>(&w); } while (0)
  PK4(p0, 0, pa0); PK4(p0, 8, pa1); PK4(p1, 0, pa2); PK4(p1, 8, pa3);
#undef PK4
}
__device__ __forceinline__ void qkt(f32x16& p0, f32x16& p1, const char* Ks, const bf16x8* qr, int r32, int hi) {
  p0 = f32x16{}; p1 = f32x16{};
#pragma unroll
  for (int d0 = 0; d0 < 8; ++d0) { int cb = (d0 * 16 + hi * 8) * 2;
    bf16x8 b0 = *reinterpret_cast<const bf16x8*>(Ks + KSWZ(r32, cb));
    bf16x8 b1 = *reinterpret_cast<const bf16x8*>(Ks + KSWZ(32 + r32, cb));
    p0 = __builtin_amdgcn_mfma_f32_32x32x16_bf16(b0, qr[d0], p0, 0, 0, 0);
    p1 = __builtin_amdgcn_mfma_f32_32x32x16_bf16(b1, qr[d0], p1, 0, 0, 0); }
}
__device__ __forceinline__ void cmask(f32x16& p0, f32x16& p1, int jt, int qloc, int hi) {
#pragma unroll
  for (int r = 0; r < 16; ++r) { const int key = 64 * jt + crow(r, hi); if (key > qloc) p0[r] = -1e30f; if (key + 32 > qloc) p1[r] = -1e30f; }
}
__device__ __forceinline__ int v_st(int k, int c) { const int kk = (k & ~0xC) | ((k & 4) << 1) | ((k & 8) >> 1); return ((kk >> 3) * 4 + (c >> 5)) * 512 + ((kk & 7) * 32 + (c & 31)) * 2; }
__device__ __forceinline__ int v_rd_base(int lane) { return ((lane & 3) << 3) | (((lane >> 2) & 3) << 6) | (((lane >> 4) & 1) << 5) | (((lane >> 5) & 1) << 8); }
constexpr int v_rd_off(int d0, int ks, int half) { return d0 * 512 + ks * 4096 + half * 2048; }
template <int OFF> __device__ __forceinline__ s16x4 tr_read(int vb) {
  s16x4 r; asm volatile("ds_read_b64_tr_b16 %0, %1 offset:%2" : "=&v"(r) : "v"(vb), "i"(OFF) : "memory"); return r;
}
template <int D0> __device__ __forceinline__ void pv_one(f32x16& od, int vb, bf16x8 pa0, bf16x8 pa1, bf16x8 pa2, bf16x8 pa3) {
  const s16x4 l0 = tr_read<v_rd_off(D0, 0, 0)>(vb), h0 = tr_read<v_rd_off(D0, 0, 1)>(vb), l1 = tr_read<v_rd_off(D0, 1, 0)>(vb), h1 = tr_read<v_rd_off(D0, 1, 1)>(vb);
  const s16x4 l2 = tr_read<v_rd_off(D0, 2, 0)>(vb), h2 = tr_read<v_rd_off(D0, 2, 1)>(vb), l3 = tr_read<v_rd_off(D0, 3, 0)>(vb), h3 = tr_read<v_rd_off(D0, 3, 1)>(vb);
  asm volatile("s_waitcnt lgkmcnt(0)" ::: "memory"); SBAR();
#define PK(L, H) (bf16x8){L[0], L[1], L[2], L[3], H[0], H[1], H[2], H[3]}
  od = __builtin_amdgcn_mfma_f32_32x32x16_bf16(PK(l0, h0), pa0, od, 0, 0, 0);
  od = __builtin_amdgcn_mfma_f32_32x32x16_bf16(PK(l1, h1), pa1, od, 0, 0, 0);
  od = __builtin_amdgcn_mfma_f32_32x32x16_bf16(PK(l2, h2), pa2, od, 0, 0, 0);
  od = __builtin_amdgcn_mfma_f32_32x32x16_bf16(PK(l3, h3), pa3, od, 0, 0, 0);
#undef PK
}
__device__ __forceinline__ void pv_d0(f32x16* o, int vb, bf16x8 pa0, bf16x8 pa1, bf16x8 pa2, bf16x8 pa3) {
  pv_one<0>(o[0], vb, pa0, pa1, pa2, pa3); pv_one<1>(o[1], vb, pa0, pa1, pa2, pa3); pv_one<2>(o[2], vb, pa0, pa1, pa2, pa3); pv_one<3>(o[3], vb, pa0, pa1, pa2, pa3);
}

__device__ __forceinline__ void attn_item(const bf16_t* __restrict__ Qrow, const bf16_t* __restrict__ Kh, const bf16_t* __restrict__ Vh, bool causal, int qloc,
                                          bf16_t* Orow, float2* MLrow, bool valid, char* lds) {
  const int tid = threadIdx.x, lane = tid & 63, r32 = lane & 31, hi = lane >> 5;
  char* V_lds = lds; char* K_lds = lds + 2 * SHM_V;
  float m_reg = -1e30f, l_reg = 0; f32x16 o[4] = {}; bf16x8 qr[8];
  const bf16_t* Qw = Qrow + hi * 8;
#pragma unroll
  for (int d0 = 0; d0 < 8; ++d0) qr[d0] = *reinterpret_cast<const bf16x8*>(Qw + d0 * 16);
  const int sr = tid >> 4, sc = (tid & 15) * 8, vst0 = v_st(sr, sc), vst1 = v_st(32 + sr, sc);
  const int vb0 = (int)(uintptr_t)V_lds + v_rd_base(lane);
  struct { bf16x8 vs0, vs1, ks0, ks1; } sr_[2];
#define SLOAD(i, k0) do { sr_[i].vs0 = *reinterpret_cast<const bf16x8*>(&Vh[(long)((k0) + sr) * LDK + sc]); sr_[i].vs1 = *reinterpret_cast<const bf16x8*>(&Vh[(long)((k0) + 32 + sr) * LDK + sc]); \
    sr_[i].ks0 = *reinterpret_cast<const bf16x8*>(&Kh[(long)((k0) + sr) * LDK + sc]); sr_[i].ks1 = *reinterpret_cast<const bf16x8*>(&Kh[(long)((k0) + 32 + sr) * LDK + sc]); } while (0)
#define SWRITE(b, i) do { *(bf16x8*)(V_lds + (b) * SHM_V + vst0) = sr_[i].vs0;          \
    *(bf16x8*)(V_lds + (b) * SHM_V + vst1) = sr_[i].vs1; int kc = sc * 2;               \
    *(bf16x8*)(K_lds + (b) * SHM_K + KSWZ(sr, kc)) = sr_[i].ks0;                       \
    *(bf16x8*)(K_lds + (b) * SHM_K + KSWZ(32 + sr, kc)) = sr_[i].ks1; } while (0)
#define SWAIT() asm volatile("s_waitcnt vmcnt(4)" ::: "memory")
#define RESC(a) do { if (__any((a) < 1.f)) { _Pragma("unroll") for (int d = 0; d < 4; ++d) _Pragma("unroll") for (int r = 0; r < 16; ++r) o[d][r] *= (a); } } while (0)
  f32x16 pA0, pA1, pB0, pB1; float mnA, mnB, alA, alB; bf16x8 pa0, pa1, pa2, pa3;
  constexpr int SE = 0, SO = 1;
  SLOAD(SE, 0); asm volatile("s_waitcnt vmcnt(0)" ::: "memory"); SWRITE(0, SE); __syncthreads();
  qkt(pA0, pA1, K_lds, qr, r32, hi); if (causal) cmask(pA0, pA1, 0, qloc, hi); partialSM(pA0, pA1, m_reg, mnA, alA);
  SLOAD(SO, KVBLK); SLOAD(SE, 2 * KVBLK);
  SWAIT(); SWRITE(1, SO); __syncthreads();
  {
    SBAR(); qkt(pB0, pB1, K_lds + SHM_K, qr, r32, hi); if (causal) cmask(pB0, pB1, 1, qloc, hi);
    finishSM(pA0, pA1, alA, l_reg, pa0, pa1, pa2, pa3); SBAR();
    SLOAD(SO, 3 * KVBLK); SBAR();
    pv_d0(o, vb0, pa0, pa1, pa2, pa3); partialSM(pB0, pB1, m_reg, mnB, alB);
    __syncthreads(); SWAIT(); SWRITE(0, SE);
    RESC(alB); __syncthreads();
    SBAR(); qkt(pA0, pA1, K_lds, qr, r32, hi); if (causal) cmask(pA0, pA1, 2, qloc, hi);
    finishSM(pB0, pB1, alB, l_reg, pa0, pa1, pa2, pa3); SBAR();
    pv_d0(o, vb0 + (int)SHM_V, pa0, pa1, pa2, pa3); partialSM(pA0, pA1, m_reg, mnA, alA);
    __syncthreads(); asm volatile("s_waitcnt vmcnt(0)" ::: "memory"); SWRITE(1, SO);
    RESC(alA); __syncthreads();
  }
  SBAR(); qkt(pB0, pB1, K_lds + SHM_K, qr, r32, hi); if (causal) cmask(pB0, pB1, 3, qloc, hi);
  finishSM(pA0, pA1, alA, l_reg, pa0, pa1, pa2, pa3); SBAR();
  pv_d0(o, vb0, pa0, pa1, pa2, pa3); partialSM(pB0, pB1, m_reg, mnB, alB);
  __syncthreads(); RESC(alB);
  finishSM(pB0, pB1, alB, l_reg, pa0, pa1, pa2, pa3); SBAR();
  pv_d0(o, vb0 + (int)SHM_V, pa0, pa1, pa2, pa3);
  const float rl = 1.0f / l_reg;
  if (valid) {
#pragma unroll
    for (int d0 = 0; d0 < 4; ++d0)
#pragma unroll
      for (int g = 0; g < 4; ++g) { u32x2 w; w.x = cvtpk(o[d0][4 * g] * rl, o[d0][4 * g + 1] * rl); w.y = cvtpk(o[d0][4 * g + 2] * rl, o[d0][4 * g + 3] * rl);
        *reinterpret_cast<u32x2*>(Orow + 32 * d0 + 8 * g + 4 * hi) = w; }
    if (hi == 0) *MLrow = make_float2(m_reg, l_reg);
  }
#undef SLOAD
#undef SWRITE
#undef SWAIT
#undef RESC
}

struct ItemCtx { const bf16_t* Q; const bf16_t* K; const bf16_t* V; bf16_t* PO; float2* ML; const unsigned short* lists; };
__device__ __forceinline__ unsigned item_entry(const ItemCtx& C, const __attribute__((address_space(3))) int* D, int k, int rloc) {
  const int own = D[4 * k + 1], j = D[4 * k] & 31, cnt = D[4 * k + 3];
  if (own) return (unsigned)(256 * j + rloc) | (3u << 13);
  return (unsigned)C.lists[(size_t)(unsigned)D[4 * k + 2] + (rloc < cnt ? rloc : 0)];
}
__device__ __forceinline__ void attn_items(const ItemCtx& C, const __attribute__((address_space(3))) int* D, int nloc, char* lds) {
  if (nloc <= 0) return;
  const int tid = threadIdx.x, wid = tid >> 6, lane = tid & 63, r32 = lane & 31, hi = lane >> 5, rloc = 32 * wid + r32;
  char* V_lds = lds; char* K_lds = lds + 2 * SHM_V;
  const int sr = tid >> 4, sc = (tid & 15) * 8, vst0 = v_st(sr, sc), vst1 = v_st(32 + sr, sc);
  const int vb0 = (int)(uintptr_t)V_lds + v_rd_base(lane);
  struct { bf16x8 vs0, vs1, ks0, ks1; } sr_[2];
  bf16x8 qr[8];
#define KVBASE(k, Kh, Vh) const bf16_t* Kh; const bf16_t* Vh; { const int bhj_ = D[4 * (k)], bh_ = bhj_ >> 5, j_ = bhj_ & 31; \
    const size_t off_ = ((size_t)(bh_ >> 4) * 8192 + 256 * j_) * LDK + (bh_ & 15) * D_; Kh = C.K + off_; Vh = C.V + off_; }
#define SLOADP(i, Kh, Vh, k0) do { sr_[i].vs0 = *reinterpret_cast<const bf16x8*>(&Vh[(long)((k0) + sr) * LDK + sc]); sr_[i].vs1 = *reinterpret_cast<const bf16x8*>(&Vh[(long)((k0) + 32 + sr) * LDK + sc]); \
    sr_[i].ks0 = *reinterpret_cast<const bf16x8*>(&Kh[(long)((k0) + sr) * LDK + sc]); sr_[i].ks1 = *reinterpret_cast<const bf16x8*>(&Kh[(long)((k0) + 32 + sr) * LDK + sc]); } while (0)
#define SWRITE(b, i) do { *(bf16x8*)(V_lds + (b) * SHM_V + vst0) = sr_[i].vs0;          \
    *(bf16x8*)(V_lds + (b) * SHM_V + vst1) = sr_[i].vs1; int kc = sc * 2;               \
    *(bf16x8*)(K_lds + (b) * SHM_K + KSWZ(sr, kc)) = sr_[i].ks0;                       \
    *(bf16x8*)(K_lds + (b) * SHM_K + KSWZ(32 + sr, kc)) = sr_[i].ks1; } while (0)
#define QLOAD(e, k) do { const int bh_ = D[4 * (k)] >> 5; const bf16_t* Qw_ = C.Q + ((size_t)(bh_ >> 4) * 8192 + ((e) & 8191u)) * LDQ + (bh_ & 15) * D_ + hi * 8; \
    _Pragma("unroll") for (int d0 = 0; d0 < 8; ++d0) qr[d0] = *reinterpret_cast<const bf16x8*>(Qw_ + d0 * 16); } while (0)
#define RESC(a) do { if (__any((a) < 1.f)) { _Pragma("unroll") for (int d = 0; d < 4; ++d) _Pragma("unroll") for (int r = 0; r < 16; ++r) o[d][r] *= (a); } } while (0)
  constexpr int D_ = 128, SE = 0, SO = 1;
  unsigned e_cur = item_entry(C, D, 0, rloc), e_nxt = (nloc > 1) ? item_entry(C, D, 1, rloc) : 0u;
  { KVBASE(0, Kh, Vh); SLOADP(SE, Kh, Vh, 0); SLOADP(SO, Kh, Vh, KVBLK); }
  QLOAD(e_cur, 0);
  for (int k = 0; k < nloc; ++k) {
    const bool has_next = (k + 1 < nloc);
    const bool causal = D[4 * k + 1] != 0; const int cnt = D[4 * k + 3];
    KVBASE(k, Kh, Vh);
    float m_reg = -1e30f, l_reg = 0; f32x16 o[4] = {};
    f32x16 pA0, pA1, pB0, pB1; float mnA, mnB, alA, alB; bf16x8 pa0, pa1, pa2, pa3;
    asm volatile("s_waitcnt vmcnt(0)" ::: "memory"); SWRITE(0, SE); __syncthreads();
    qkt(pA0, pA1, K_lds, qr, r32, hi); if (causal) cmask(pA0, pA1, 0, rloc, hi); partialSM(pA0, pA1, m_reg, mnA, alA);
    SLOADP(SE, Kh, Vh, 2 * KVBLK);
    SWRITE(1, SO); __syncthreads();
    SLOADP(SO, Kh, Vh, 3 * KVBLK);
    SBAR(); qkt(pB0, pB1, K_lds + SHM_K, qr, r32, hi); if (causal) cmask(pB0, pB1, 1, rloc, hi);
    finishSM(pA0, pA1, alA, l_reg, pa0, pa1, pa2, pa3); SBAR();
    pv_d0(o, vb0, pa0, pa1, pa2, pa3); partialSM(pB0, pB1, m_reg, mnB, alB);
    __syncthreads(); asm volatile("s_waitcnt vmcnt(4)" ::: "memory"); SWRITE(0, SE);
    RESC(alB); __syncthreads();
    if (has_next) { KVBASE(k + 1, Kn, Vn); SLOADP(SE, Kn, Vn, 0); }
    SBAR(); qkt(pA0, pA1, K_lds, qr, r32, hi); if (causal) cmask(pA0, pA1, 2, rloc, hi);
    finishSM(pB0, pB1, alB, l_reg, pa0, pa1, pa2, pa3); SBAR();
    pv_d0(o, vb0 + (int)SHM_V, pa0, pa1, pa2, pa3); partialSM(pA0, pA1, m_reg, mnA, alA);
    __syncthreads(); SWRITE(1, SO);
    RESC(alA); __syncthreads();
    if (has_next) { KVBASE(k + 1, Kn, Vn); SLOADP(SO, Kn, Vn, KVBLK); }
    SBAR(); qkt(pB0, pB1, K_lds + SHM_K, qr, r32, hi); if (causal) cmask(pB0, pB1, 3, rloc, hi);
    SBAR();
    if (has_next) QLOAD(e_nxt, k + 1);
    finishSM(pA0, pA1, alA, l_reg, pa0, pa1, pa2, pa3); SBAR();
    pv_d0(o, vb0, pa0, pa1, pa2, pa3); partialSM(pB0, pB1, m_reg, mnB, alB);
    __syncthreads(); RESC(alB);
    finishSM(pB0, pB1, alB, l_reg, pa0, pa1, pa2, pa3); SBAR();
    pv_d0(o, vb0 + (int)SHM_V, pa0, pa1, pa2, pa3);
    { const float rl = 1.0f / l_reg; const int bh = D[4 * k] >> 5; const unsigned t = e_cur & 8191u, slot = e_cur >> 13;
      if (rloc < cnt) {
        bf16_t* Orow = C.PO + (((size_t)slot * 32 + bh) * 8192 + t) * D_;
#pragma unroll
        for (int d0 = 0; d0 < 4; ++d0)
#pragma unroll
          for (int g = 0; g < 4; ++g) { u32x2 w; w.x = cvtpk(o[d0][4 * g] * rl, o[d0][4 * g + 1] * rl); w.y = cvtpk(o[d0][4 * g + 2] * rl, o[d0][4 * g + 3] * rl);
            *reinterpret_cast<u32x2*>(Orow + 32 * d0 + 8 * g + 4 * hi) = w; }
        if (hi == 0) C.ML[((size_t)slot * 32 + bh) * 8192 + t] = make_float2(m_reg, l_reg);
      } }
    e_cur = e_nxt; if (k + 2 < nloc) e_nxt = item_entry(C, D, k + 2, rloc);
  }
#undef KVBASE
#undef SLOADP
#undef SWRITE
#undef QLOAD
#undef RESC
}
#undef KSWZ
#undef SBAR
}

constexpr int NWAVES = 8;
#ifndef MK_N_LAUNCHES
#define MK_N_LAUNCHES 1
#endif
constexpr int N_PHASES = 16;
constexpr int N_LAUNCHES = MK_N_LAUNCHES;

constexpr int BATCH = 2, SEQ = 8192, DM = 4096, M = BATCH * SEQ, MEMLEN = 256;
constexpr int PW = 2048, AW = 2048, NH = 16, HD = 128, NBLK = 32, MIXIN = 8192, FF = 11008, XH = 4, XHD = 1024;
constexpr float LN_EPS = 1e-5f;
constexpr float DN_ALPHA = 1.189207115002721f;

constexpr size_t MiB = 1u << 20;
constexpr size_t WS_CTL = 0, CTL_ZERO_BYTES = 1 * MiB;
constexpr size_t WS_ROPE = 1 * MiB;
constexpr size_t WS_KMH = 5 * MiB, WS_KML = 5 * MiB + 512 * 1024;
constexpr size_t WS_MEMB = 6 * MiB;
constexpr size_t WS_KVX = 10 * MiB;
constexpr size_t WS_LIST = 18 * MiB;
constexpr size_t WS_ML = 26 * MiB;
constexpr size_t WS_WIN = 34 * MiB, WS_WPOOL = 98 * MiB, WS_WOUT = 100 * MiB, WS_WXQ = 132 * MiB, WS_WXKV = 164 * MiB, WS_WXO = 228 * MiB, WS_WGU = 260 * MiB, WS_WDN = 432 * MiB;
constexpr size_t WS_ACT = 518 * MiB;
constexpr size_t WS_HP = WS_ACT, WS_Q = WS_ACT + 64 * MiB, WS_K = WS_ACT + 128 * MiB, WS_V = WS_ACT + 192 * MiB;
constexpr size_t WS_XB = WS_ACT + 256 * MiB;
constexpr size_t WS_PARTO = WS_ACT + 256 * MiB;
constexpr size_t WS_CAT = WS_ACT + 512 * MiB;
constexpr size_t WS_TB = WS_ACT;
constexpr size_t WS_HB = WS_ACT + 128 * MiB;
constexpr size_t WS_PB = WS_ACT + 256 * MiB;
constexpr size_t WS_G = WS_ACT + 256 * MiB;
constexpr size_t WS_SLAB = WS_ACT + 384 * MiB;
constexpr size_t WS_WQK = WS_ACT + 640 * MiB, WS_WVOT = WS_ACT + 656 * MiB;
constexpr size_t WS_WOUT2 = WS_ACT + 672 * MiB;
constexpr size_t WS_STATS = WS_ML;
constexpr size_t WS_END = WS_ACT + 704 * MiB;
static_assert(WS_WDN + (size_t)DM * FF * 2 <= WS_ACT && WS_G + (size_t)M * FF * 2 <= WS_END && WS_WGU + (size_t)2 * FF * DM * 2 <= WS_WDN, "d_ws map");
constexpr int LIST_STRIDE = 256 * 496;
__host__ __device__ constexpr int list_off(int j) { return 256 * (31 * j - (j * (j - 1)) / 2); }
constexpr int CW_TMO = 0, CW_CODE = 1;
constexpr int CW_BAR = 4096;
constexpr int CW_GCNT = 8192;
constexpr int CW_CHK = 16384;

constexpr int RING_OFF = 0, RING_BYTES = 131072;
constexpr int LDSCTL_OFF = RING_BYTES, MISC_OFF = LDSCTL_OFF + 320;
constexpr int LDS_BYTES = 147456;

#define GAS __attribute__((address_space(1)))
#define LAS __attribute__((address_space(3)))
typedef unsigned short bf16;
typedef unsigned v4u __attribute__((ext_vector_type(4)));
typedef unsigned v2u __attribute__((ext_vector_type(2)));
typedef float f32x4 __attribute__((ext_vector_type(4)));
typedef short bf16x8 __attribute__((ext_vector_type(8)));
typedef float f32x16 __attribute__((ext_vector_type(16)));
typedef GAS unsigned gu32;
#define RLX_AGENT __ATOMIC_RELAXED, __HIP_MEMORY_SCOPE_AGENT
#define LDS_WAIT() asm volatile("s_waitcnt lgkmcnt(0)" ::: "memory")
#define VM_WAIT() asm volatile("s_waitcnt vmcnt(0)" ::: "memory")
__device__ __forceinline__ unsigned f2bf(float f) { unsigned u = __builtin_bit_cast(unsigned, f); return (u + 0x7fffu + ((u >> 16) & 1u)) >> 16; }
__device__ __forceinline__ unsigned pk2(float lo, float hi) { return f2bf(lo) | (f2bf(hi) << 16); }
__device__ __forceinline__ float bf_lo(unsigned w) { return __builtin_bit_cast(float, w << 16); }
__device__ __forceinline__ float bf_hi(unsigned w) { return __builtin_bit_cast(float, w & 0xffff0000u); }
__device__ __forceinline__ float bf2f(bf16 b) { return __builtin_bit_cast(float, ((unsigned)b) << 16); }
#define XB_TMO      128
#define XB_XCNT(j)  (256  + 64 * (j))
#define XB_XSUB(j)  (1280 + 64 * (j))
#define XB_XGEN(j)  (2304 + 64 * (j))
#define XB_TOP      3328
#define XB_TOPGEN   3392
#define XCD_BAR_WORDS 3456
#define XB_SPIN_CAP (1u << 18)

__device__ __forceinline__ unsigned xb_ld(unsigned* p)              { return __hip_atomic_load(p, __ATOMIC_RELAXED, __HIP_MEMORY_SCOPE_AGENT); }
__device__ __forceinline__ unsigned xb_add(unsigned* p, unsigned v) { return __hip_atomic_fetch_add(p, v, __ATOMIC_RELAXED, __HIP_MEMORY_SCOPE_AGENT); }
__device__ __forceinline__ unsigned xb_xcc_id() { return (unsigned)__builtin_amdgcn_s_getreg((3 << 11) | 20) & 0xFu; }
#define XB_SPIN(cond, bar) do { unsigned _sp = 0; while (cond) { __builtin_amdgcn_s_sleep(1); \
    if ((++_sp & 255u) == 0u) { if (xb_ld(&(bar)[XB_TMO])) break; if (_sp > XB_SPIN_CAP) { atomicAdd(&(bar)[XB_TMO], 1u); break; } } } } while (0)

struct XcdBarrier {
    unsigned* bar; unsigned x;
    volatile LAS unsigned* st;
};

__device__ __forceinline__ XcdBarrier xcd_barrier_post(unsigned* bar, volatile LAS unsigned* st) {
    XcdBarrier b; b.bar = bar; b.x = xb_xcc_id(); b.st = st;
    if (threadIdx.x == 0) (void)xb_add(&bar[XB_XCNT(b.x)], 1u);
    return b;
}
__device__ __forceinline__ void xcd_barrier_complete(unsigned* bar, unsigned x, unsigned& nloc, unsigned& nx) {
    const unsigned G = gridDim.x * gridDim.y * gridDim.z;
    unsigned sum, cnt, mine, sp = 0u;
    for (;;) {
        sum = 0u; cnt = 0u; mine = 0u;
#pragma unroll
        for (unsigned j = 0; j < 16; ++j) { const unsigned c = xb_ld(&bar[XB_XCNT(j)]); sum += c; cnt += (c > 0u) ? 1u : 0u; mine = (j == x) ? c : mine; }
        if (sum == G) break;
        __builtin_amdgcn_s_sleep(1);
        if ((++sp & 255u) == 0u) { if (xb_ld(&bar[XB_TMO])) break; if (sp > XB_SPIN_CAP) { atomicAdd(&bar[XB_TMO], 1u); break; } }
    }
    nloc = mine > 0u ? mine : 1u; nx = cnt > 0u ? cnt : 1u;
}

__device__ __forceinline__ void xcd_barrier(const XcdBarrier& b) {
    asm volatile("s_waitcnt vmcnt(0)" ::: "memory");
    __syncthreads();
    if (threadIdx.x == 0) {
        unsigned* bar = b.bar;
        __builtin_amdgcn_s_waitcnt(0);
        unsigned nloc = b.st[0], nx = b.st[1];
        if (nloc == 0u) { xcd_barrier_complete(bar, b.x, nloc, nx); b.st[0] = nloc; b.st[1] = nx; }
        const unsigned old = xb_add(&bar[XB_XSUB(b.x)], 1u);
        const unsigned gen = old / nloc;
        if (old + 1u == (gen + 1u) * nloc) {
            __builtin_amdgcn_fence(__ATOMIC_RELEASE, "agent");
            asm volatile("s_waitcnt vmcnt(0)" ::: "memory");
            const unsigned og = xb_add(&bar[XB_TOP], 1u);
            const unsigned tg = og / nx;
            if (og + 1u == (tg + 1u) * nx) xb_add(&bar[XB_TOPGEN], 1u);
            else XB_SPIN(xb_ld(&bar[XB_TOPGEN]) == tg, bar);
            __builtin_amdgcn_fence(__ATOMIC_ACQUIRE, "agent");
            xb_add(&bar[XB_XGEN(b.x)], 1u);
            asm volatile("s_waitcnt vmcnt(0)" ::: "memory");
        } else {
            XB_SPIN(xb_ld(&bar[XB_XGEN(b.x)]) == gen, bar);
            __builtin_amdgcn_fence(__ATOMIC_ACQUIRE, "agent");
            asm volatile("s_waitcnt vmcnt(0)" ::: "memory");
        }
    }
    __syncthreads();
}

struct Frame {
    LAS unsigned char* lds;
    volatile LAS unsigned* MISC;
    gu32* ctl;
    int tid, lane, wave;
    int G;
    unsigned char* ws;
};
__device__ __forceinline__ float wave_sum(float v) {
#pragma unroll
    for (int o = 1; o < 64; o <<= 1) v += __shfl_xor(v, o);
    return v;
}

template <class RowMap>
__device__ __forceinline__ void p0_transpose_item(const float* W, int K, int N, bf16* WT, LAS float* scr, int item, int lane, const RowMap& rm, const float* colscale) {
    const int nblk = N / 32, kb = item / nblk, nb = item % nblk, k0 = 64 * kb, n0 = 32 * nb;
    float ld[32];
    const float* src = W + (size_t)(k0 + (lane >> 5)) * N + n0 + (lane & 31);
#pragma unroll
    for (int i = 0; i < 32; ++i) ld[i] = *(const GAS float*)(src + (size_t)(2 * i) * N);
#pragma unroll
    for (int i = 0; i < 32; ++i) scr[(2 * i + (lane >> 5)) * 33 + (lane & 31)] = ld[i];
    LDS_WAIT(); asm volatile("" ::: "memory");
    const int c = lane & 7;
#pragma unroll
    for (int j = 0; j < 4; ++j) { const int n = (lane >> 3) + 8 * j; const LAS float* s = scr + (8 * c) * 33 + n; const float sc = colscale ? colscale[n0 + n] : 1.0f;
        v4u o; o.x = pk2(s[0 * 33] * sc, s[1 * 33] * sc); o.y = pk2(s[2 * 33] * sc, s[3 * 33] * sc); o.z = pk2(s[4 * 33] * sc, s[5 * 33] * sc); o.w = pk2(s[6 * 33] * sc, s[7 * 33] * sc);
        *(GAS v4u*)(WT + (size_t)rm(n0 + n) * K + k0 + 8 * c) = o; }
    LDS_WAIT(); asm volatile("" ::: "memory");
}
struct RmIdent { int off; __device__ __forceinline__ int operator()(int n) const { return off + n; } };
struct RmMixIn { __device__ __forceinline__ int operator()(int n) const { if (n < 2048 || n >= 6144) return n; const int d = n & 127; return (n & ~127) + 2 * (d & 63) + (d >> 6); } };
struct RmGateUp { int up; __device__ __forceinline__ int operator()(int n) const { return (n >> 7) * 256 + up * 128 + (n & 127); } };

__device__ __forceinline__ void sincos_d(double a, double& s, double& c) {
    const double n = __builtin_rint(a * 0.63661977236758134308);
    double r = __builtin_fma(-n, 1.5707963267948966, a); r = __builtin_fma(-n, 6.123233995736766e-17, r);
    const double r2 = r * r;
    double ps = -7.6471637318198164759e-13; ps = ps * r2 + 1.6059043836821614599e-10; ps = ps * r2 - 2.5052108385441718775e-08; ps = ps * r2 + 2.7557319223985890653e-06;
    ps = ps * r2 - 1.9841269841269841270e-04; ps = ps * r2 + 8.3333333333333333333e-03; ps = ps * r2 - 1.6666666666666666667e-01; ps = r + r * r2 * ps;
    double pc = 4.7794773323873852974e-14; pc = pc * r2 - 1.1470745597729724714e-11; pc = pc * r2 + 2.0876756987868098979e-09; pc = pc * r2 - 2.7557319223985890653e-07;
    pc = pc * r2 + 2.4801587301587301587e-05; pc = pc * r2 - 1.3888888888888888889e-03; pc = pc * r2 + 4.1666666666666666667e-02; pc = pc * r2 - 0.5; pc = 1.0 + r2 * pc;
    const int q = ((int)n) & 3;
    s = (q == 0) ? ps : (q == 1) ? pc : (q == 2) ? -ps : -pc;
    c = (q == 0) ? pc : (q == 1) ? -ps : (q == 2) ? -pc : ps;
}
__device__ __forceinline__ float rope_inv(int i) {
    const double y = -(double)i * (13.287712379549449 / 64.0); const double fl = __builtin_floor(y); const double z = (y - fl) * 0.69314718055994530942;
    double e = 1.0, term = 1.0;
#pragma unroll
    for (int k = 1; k <= 20; ++k) { term = term * z / (double)k; e += term; }
    return (float)__builtin_ldexp(e, (int)fl);
}

__device__ __forceinline__ void p0_prologue(Frame& F, const float* const* in) {
    LAS float* scr = (LAS float*)(F.lds + RING_OFF + F.wave * 16384);
    const int gw = blockIdx.x * NWAVES + F.wave, NGW = F.G * NWAVES;
    const float* w_mix_in = in[2]; const float* w_pool = in[3]; const float* pool_scale = in[4]; const float* w_mix_out = in[5];
    const float* w_xq = in[8]; const float* w_xkv = in[9]; const float* w_xo = in[10]; const float* w_gate = in[13]; const float* w_up = in[14]; const float* w_down = in[15];
    bf16* WIN = (bf16*)(F.ws + WS_WIN); bf16* WPOOL = (bf16*)(F.ws + WS_WPOOL); bf16* WOUT = (bf16*)(F.ws + WS_WOUT); bf16* WXQ = (bf16*)(F.ws + WS_WXQ);
    bf16* WXKV = (bf16*)(F.ws + WS_WXKV); bf16* WXO = (bf16*)(F.ws + WS_WXO); bf16* WGU = (bf16*)(F.ws + WS_WGU); bf16* WDN = (bf16*)(F.ws + WS_WDN);
    constexpr int I_IN = (DM / 64) * (MIXIN / 32), I_POOL = (512 / 64) * (512 / 32), I_SQ = (DM / 64) * (DM / 32), I_KV = (DM / 64) * (2 * DM / 32), I_GU = (DM / 64) * (FF / 32), I_DN = (FF / 64) * (DM / 32);
    constexpr int NITEMS = I_IN + 2 * I_SQ + I_KV + 2 * I_GU + I_DN;
    for (int it = gw; it < NITEMS; it += NGW) {
        int r = it;
        if (r < I_IN) { p0_transpose_item(w_mix_in, DM, MIXIN, WIN, scr, r, F.lane, RmMixIn{}, nullptr); continue; } r -= I_IN;
        if (r < I_SQ) { const int kb = r / (DM / 32);
            if (kb < 32) p0_transpose_item(w_mix_out, 2048, DM, WOUT, scr, r, F.lane, RmIdent{0}, nullptr);
            else p0_transpose_item(w_mix_out, DM, DM, (bf16*)(F.ws + WS_WOUT2), scr, r, F.lane, RmIdent{0}, nullptr); continue; } r -= I_SQ;
        if (r < I_KV) { p0_transpose_item(w_xkv, DM, 2 * DM, WXKV, scr, r, F.lane, RmIdent{0}, nullptr); continue; } r -= I_KV;
        if (r < I_SQ) { p0_transpose_item(w_xo, DM, DM, WXO, scr, r, F.lane, RmIdent{0}, nullptr); continue; } r -= I_SQ;
        if (r < I_GU) { p0_transpose_item(w_gate, DM, FF, WGU, scr, r, F.lane, RmGateUp{0}, nullptr); continue; } r -= I_GU;
        if (r < I_GU) { p0_transpose_item(w_up, DM, FF, WGU, scr, r, F.lane, RmGateUp{1}, nullptr); continue; } r -= I_GU;
        p0_transpose_item(w_down, FF, DM, WDN, scr, r, F.lane, RmIdent{0}, nullptr);
    }
    const size_t gt = (size_t)blockIdx.x * (NWAVES * 64) + F.tid, NT = (size_t)F.G * NWAVES * 64;
    { const float* x = in[0]; bf16* XB = (bf16*)(F.ws + WS_XB);
      for (size_t i = gt; i < (size_t)M * DM / 8; i += NT) { const f32x4 a = *(const GAS f32x4*)(x + i * 8), b = *(const GAS f32x4*)(x + i * 8 + 4);
          v4u o; o.x = pk2(a.x, a.y); o.y = pk2(a.z, a.w); o.z = pk2(b.x, b.y); o.w = pk2(b.z, b.w); *(GAS v4u*)(XB + i * 8) = o; } }
    { const float* x = w_xq; bf16* XB = WXQ;
      for (size_t i = gt; i < (size_t)DM * DM / 8; i += NT) { const f32x4 a = *(const GAS f32x4*)(x + i * 8), b = *(const GAS f32x4*)(x + i * 8 + 4);
          v4u o; o.x = pk2(a.x, a.y); o.y = pk2(a.z, a.w); o.z = pk2(b.x, b.y); o.w = pk2(b.z, b.w); *(GAS v4u*)(XB + i * 8) = o; } }
    { bf16* WPR = WPOOL;
      for (size_t i = gt; i < (size_t)4 * 512 * 512 / 8; i += NT) { const size_t e = i * 8; const int d = (int)(e & 511), g = (int)(e >> 18);
          const f32x4 a = *(const GAS f32x4*)(w_pool + e), b = *(const GAS f32x4*)(w_pool + e + 4), s0 = *(const GAS f32x4*)(pool_scale + g * 512 + d), s1 = *(const GAS f32x4*)(pool_scale + g * 512 + d + 4);
          v4u o; o.x = pk2(a.x * s0.x, a.y * s0.y); o.y = pk2(a.z * s0.z, a.w * s0.w); o.z = pk2(b.x * s1.x, b.y * s1.y); o.w = pk2(b.z * s1.z, b.w * s1.w); *(GAS v4u*)(WPR + e) = o; } }
    { const float* x = in[1]; bf16* XB = (bf16*)(F.ws + WS_MEMB);
      for (size_t i = gt; i < (size_t)BATCH * MEMLEN * DM / 8; i += NT) { const f32x4 a = *(const GAS f32x4*)(x + i * 8), b = *(const GAS f32x4*)(x + i * 8 + 4);
          v4u o; o.x = pk2(a.x, a.y); o.y = pk2(a.z, a.w); o.z = pk2(b.x, b.y); o.w = pk2(b.z, b.w); *(GAS v4u*)(XB + i * 8) = o; } }
    { float2* tab = (float2*)(F.ws + WS_ROPE);
      for (size_t i = gt; i < (size_t)SEQ * 64; i += NT) { const int pos = (int)(i >> 6), fi = (int)(i & 63); const float ang = (float)pos * rope_inv(fi);
          double s, c; sincos_d((double)ang, s, c); tab[i] = make_float2((float)c, (float)s); } }
}

template <bool FINAL>
__device__ __forceinline__ void ln_rows(Frame& F, const bf16* T, bf16* XB, float2* stats, float* OUT, const float* g, const float* b) {
    const int gw = blockIdx.x * NWAVES + F.wave, NGW = F.G * NWAVES;
    for (int m = gw; m < M; m += NGW) {
        const GAS v4u* tr = (const GAS v4u*)(T + (size_t)m * DM) + F.lane;
        float v[8][8]; float s = 0.f;
#pragma unroll
        for (int j = 0; j < 8; ++j) { const v4u r = tr[64 * j]; v[j][0] = bf_lo(r.x); v[j][1] = bf_hi(r.x); v[j][2] = bf_lo(r.y); v[j][3] = bf_hi(r.y); v[j][4] = bf_lo(r.z); v[j][5] = bf_hi(r.z); v[j][6] = bf_lo(r.w); v[j][7] = bf_hi(r.w);
#pragma unroll
            for (int e = 0; e < 8; ++e) s += v[j][e]; }
        const float mean = wave_sum(s) * (1.f / DM); float s2 = 0.f;
#pragma unroll
        for (int j = 0; j < 8; ++j)
#pragma unroll
            for (int e = 0; e < 8; ++e) { v[j][e] -= mean; s2 += v[j][e] * v[j][e]; }
        const float rstd = 1.f / sqrtf(wave_sum(s2) * (1.f / DM) + LN_EPS);
        if (!FINAL && F.lane == 0) stats[m] = make_float2(mean, rstd);
#pragma unroll
        for (int j = 0; j < 8; ++j) { const int c = (64 * j + F.lane) * 8;
            const f32x4 g0 = *(const GAS f32x4*)(g + c), g1 = *(const GAS f32x4*)(g + c + 4), b0 = *(const GAS f32x4*)(b + c), b1 = *(const GAS f32x4*)(b + c + 4);
            const f32x4 y0 = (f32x4){v[j][0], v[j][1], v[j][2], v[j][3]} * rstd * g0 + b0, y1 = (f32x4){v[j][4], v[j][5], v[j][6], v[j][7]} * rstd * g1 + b1;
            if (FINAL) { __builtin_nontemporal_store(y0, (GAS f32x4*)(OUT + (size_t)m * DM + c)); __builtin_nontemporal_store(y1, (GAS f32x4*)(OUT + (size_t)m * DM + c + 4)); }
            else { v4u o; o.x = pk2(y0.x, y0.y); o.y = pk2(y0.z, y0.w); o.z = pk2(y1.x, y1.y); o.w = pk2(y1.z, y1.w); *(GAS v4u*)(XB + (size_t)m * DM + c) = o; } }
    }
}

__device__ __forceinline__ void up8(const v4u& r, float (&f)[8]) { f[0] = bf_lo(r.x); f[1] = bf_hi(r.x); f[2] = bf_lo(r.y); f[3] = bf_hi(r.y); f[4] = bf_lo(r.z); f[5] = bf_hi(r.z); f[6] = bf_lo(r.w); f[7] = bf_hi(r.w); }
template <int W>
__device__ __forceinline__ void pool_run(const bf16* HP, bf16* PMo, int t0, int c) {
    const int tp0 = t0 & (SEQ - 1);
    v4u raw[16 + W - 1];
#pragma unroll
    for (int j = 0; j < 16 + W - 1; ++j) { const int dt = j - (W - 1); raw[j] = (v4u){0u, 0u, 0u, 0u}; if (tp0 + dt >= 0) raw[j] = *(const GAS v4u*)(HP + (size_t)(t0 + dt) * PW + c); }
    float S[8], u[8];
#pragma unroll
    for (int e = 0; e < 8; ++e) S[e] = 0.f;
#pragma unroll
    for (int j = 0; j < W - 1; ++j) { up8(raw[j], u);
#pragma unroll
        for (int e = 0; e < 8; ++e) S[e] += u[e]; }
#pragma unroll
    for (int i = 0; i < 16; ++i) {
        up8(raw[W - 1 + i], u);
#pragma unroll
        for (int e = 0; e < 8; ++e) S[e] += u[e];
        const int tp = tp0 + i; const float inv = (tp + 1 < W) ? 1.0f / (float)(tp + 1) : 1.0f / (float)W;
        v4u o; o.x = pk2(S[0] * inv - u[0], S[1] * inv - u[1]); o.y = pk2(S[2] * inv - u[2], S[3] * inv - u[3]);
        o.z = pk2(S[4] * inv - u[4], S[5] * inv - u[5]); o.w = pk2(S[6] * inv - u[6], S[7] * inv - u[7]);
        *(GAS v4u*)(PMo + (size_t)(t0 + i) * DM + c) = o;
        float d[8]; up8(raw[i], d);
#pragma unroll
        for (int e = 0; e < 8; ++e) S[e] -= d[e];
    }
}
__device__ __forceinline__ void pool_ew(Frame& F) {
    const bf16* HP = (const bf16*)(F.ws + WS_HP); bf16* PMo = (bf16*)(F.ws + WS_CAT);
    const size_t gt = (size_t)blockIdx.x * (NWAVES * 64) + F.tid, NT = (size_t)F.G * NWAVES * 64;
    for (size_t idx = gt; idx < (size_t)(M / 16) * 256; idx += NT) {
        const int t0 = (int)(idx >> 8) * 16, c = (int)(idx & 255) * 8, grp = __builtin_amdgcn_readfirstlane(c >> 9);
        if (grp == 0) pool_run<2>(HP, PMo, t0, c); else if (grp == 1) pool_run<4>(HP, PMo, t0, c); else if (grp == 2) pool_run<8>(HP, PMo, t0, c); else pool_run<16>(HP, PMo, t0, c);
    }
}
__device__ __forceinline__ void kv_reduce(Frame& F) {
    const float* SK = (const float*)(F.ws + WS_SLAB); bf16* KVX = (bf16*)(F.ws + WS_KVX);
    const size_t gt = (size_t)blockIdx.x * (NWAVES * 64) + F.tid, NT = (size_t)F.G * NWAVES * 64, NE = (size_t)512 * 8192;
    for (size_t i = gt; i < NE / 4; i += NT) { const float* sb = SK + i * 4;
        const f32x4 a = *(const GAS f32x4*)sb + *(const GAS f32x4*)(sb + NE) + *(const GAS f32x4*)(sb + 2 * NE) + *(const GAS f32x4*)(sb + 3 * NE);
        v2u o; o.x = pk2(a.x, a.y); o.y = pk2(a.z, a.w); *(GAS v2u*)(KVX + i * 4) = o; }
}

__device__ __forceinline__ void kmean_phase(Frame& F) {
    const bf16* Kb = (const bf16*)(F.ws + WS_K); bf16* KMH = (bf16*)(F.ws + WS_KMH); bf16* KML = (bf16*)(F.ws + WS_KML);
    LAS float* part = (LAS float*)(F.lds + RING_OFF);
    for (int item = blockIdx.x; item < 64 * 4; item += F.G) {
        const int bn = item >> 2, chunk = item & 3;
        float acc[8];
#pragma unroll
        for (int e = 0; e < 8; ++e) acc[e] = 0.f;
        const bf16* base = Kb + (size_t)(bn * 256 + F.wave * 32) * AW + chunk * 512 + F.lane * 8;
#pragma unroll
        for (int r = 0; r < 32; ++r) { const v4u q = *(const GAS v4u*)(base + (size_t)r * AW);
            acc[0] += bf_lo(q.x); acc[1] += bf_hi(q.x); acc[2] += bf_lo(q.y); acc[3] += bf_hi(q.y); acc[4] += bf_lo(q.z); acc[5] += bf_hi(q.z); acc[6] += bf_lo(q.w); acc[7] += bf_hi(q.w); }
#pragma unroll
        for (int e = 0; e < 8; ++e) part[F.wave * 512 + F.lane * 8 + e] = acc[e];
        __syncthreads();
        { float s = 0.f;
#pragma unroll
          for (int w = 0; w < 8; ++w) s += part[w * 512 + F.tid];
          const float mean = s * (1.0f / 256.0f); const unsigned hb = f2bf(mean); const float hf = __builtin_bit_cast(float, hb << 16);
          KMH[(size_t)bn * AW + chunk * 512 + F.tid] = (bf16)hb; KML[(size_t)bn * AW + chunk * 512 + F.tid] = (bf16)f2bf(mean - hf); }
        __syncthreads();
    }
}

__device__ __forceinline__ void gate_phase(Frame& F) {
    const bf16* Qb = (const bf16*)(F.ws + WS_Q); const bf16* KMH = (const bf16*)(F.ws + WS_KMH); const bf16* KML = (const bf16*)(F.ws + WS_KML);
    unsigned short* lists = (unsigned short*)(F.ws + WS_LIST); gu32* gcnt = F.ctl + CW_GCNT;
    LAS float* gl = (LAS float*)(F.lds + RING_OFF);
    LAS unsigned* lcnt = (LAS unsigned*)(F.lds + RING_OFF + 34816);
    LAS unsigned* gb = lcnt + 32;
    const int r32 = F.lane & 31, hi = F.lane >> 5;
    for (int uid = blockIdx.x; uid < 1024; uid += F.G) {
        const int bh = uid >> 5, qb = uid & 31, b = bh >> 4, h = bh & 15;
        if (qb == 0) continue;
        if (F.tid < 32) lcnt[F.tid] = 0u;
        const size_t trow = (size_t)b * SEQ + 256 * qb + 32 * F.wave + r32;
        f32x16 acc = {};
#pragma unroll
        for (int s = 0; s < 8; ++s) {
            const bf16x8 bq = *(const GAS bf16x8*)(Qb + trow * AW + h * HD + 16 * s + 8 * hi);
            const bf16x8 ah = *(const GAS bf16x8*)(KMH + (size_t)(b * 32 + r32) * AW + h * HD + 16 * s + 8 * hi);
            const bf16x8 al = *(const GAS bf16x8*)(KML + (size_t)(b * 32 + r32) * AW + h * HD + 16 * s + 8 * hi);
            acc = __builtin_amdgcn_mfma_f32_32x32x16_bf16(ah, bq, acc, 0, 0, 0);
            acc = __builtin_amdgcn_mfma_f32_32x32x16_bf16(al, bq, acc, 0, 0, 0);
        }
#pragma unroll
        for (int r = 0; r < 16; ++r) gl[(32 * F.wave + r32) * 33 + att::crow(r, hi)] = acc[r];
        __syncthreads();
        int s0 = 0, s1 = 0, s2 = 0; unsigned p0 = 0, p1 = 0, p2 = 0; const int nsel = qb < 3 ? qb : 3;
        if (F.tid < 256) {
            float v0 = -__builtin_inff(), v1 = v0, v2 = v0;
            for (int n = 0; n < qb; ++n) { const float g = gl[F.tid * 33 + n];
                if (g > v0) { v2 = v1; s2 = s1; v1 = v0; s1 = s0; v0 = g; s0 = n; }
                else if (g > v1) { v2 = v1; s2 = s1; v1 = g; s1 = n; }
                else if (g > v2) { v2 = g; s2 = n; } }
            p0 = __hip_atomic_fetch_add(lcnt + s0, 1u, __ATOMIC_RELAXED, __HIP_MEMORY_SCOPE_WORKGROUP);
            if (nsel > 1) p1 = __hip_atomic_fetch_add(lcnt + s1, 1u, __ATOMIC_RELAXED, __HIP_MEMORY_SCOPE_WORKGROUP);
            if (nsel > 2) p2 = __hip_atomic_fetch_add(lcnt + s2, 1u, __ATOMIC_RELAXED, __HIP_MEMORY_SCOPE_WORKGROUP);
        }
        __syncthreads();
        if (F.tid < 32) { const unsigned c = lcnt[F.tid]; gb[F.tid] = c ? __hip_atomic_fetch_add(gcnt + bh * 32 + F.tid, c, RLX_AGENT) : 0u; }
        __syncthreads();
        if (F.tid < 256) {
            unsigned short* lb = lists + (size_t)bh * LIST_STRIDE; const unsigned tl = (unsigned)(256 * qb + F.tid);
            lb[list_off(s0) + gb[s0] + p0] = (unsigned short)(tl | (0u << 13));
            if (nsel > 1) lb[list_off(s1) + gb[s1] + p1] = (unsigned short)(tl | (1u << 13));
            if (nsel > 2) lb[list_off(s2) + gb[s2] + p2] = (unsigned short)(tl | (2u << 13));
        }
        __syncthreads();
    }
}

__device__ __forceinline__ void attn_phase(Frame& F, char* ldsg) {
    const bf16* Qb = (const bf16*)(F.ws + WS_Q); const bf16* Kb = (const bf16*)(F.ws + WS_K); const bf16* Vb = (const bf16*)(F.ws + WS_V);
    bf16* PO = (bf16*)(F.ws + WS_PARTO); float2* ML = (float2*)(F.ws + WS_ML);
    const unsigned short* lists = (const unsigned short*)(F.ws + WS_LIST); const gu32* gcnt = F.ctl + CW_GCNT;
    LAS int* pre = (LAS int*)(F.lds + RING_OFF + 67584);
    for (int i = F.tid; i < 1024; i += NWAVES * 64) pre[i] = (int)((__hip_atomic_load(gcnt + i, RLX_AGENT) + 255u) >> 8);
    __syncthreads();
    if (F.wave == 0) {
        int loc[16]; int s = 0;
#pragma unroll
        for (int k = 0; k < 16; ++k) { loc[k] = pre[F.lane * 16 + k]; s += loc[k]; }
        int incl = s;
#pragma unroll
        for (int o = 1; o < 64; o <<= 1) { const int v = __shfl_up(incl, o); if (F.lane >= o) incl += v; }
        int run = incl - s;
#pragma unroll
        for (int k = 0; k < 16; ++k) { pre[F.lane * 16 + k] = run; run += loc[k]; }
        if (F.lane == 63) pre[1024] = incl;
    }
    __syncthreads();
    const int total = 1024 + pre[1024];
    LAS int* DSC = (LAS int*)(F.lds + RING_OFF + 67584 + 4224);
    const int nloc = (total > (int)blockIdx.x) ? (total - (int)blockIdx.x + F.G - 1) / F.G : 0;
    if (F.tid < nloc && F.tid < 64) {
        const int id = blockIdx.x + F.tid * F.G; int bhj, own, lpos, cnt;
        if (id < 1024) { bhj = id; own = 1; lpos = 0; cnt = 256; }
        else { const int x = id - 1024; int lo = 0, hi2 = 1023;
            while (lo < hi2) { const int mid = (lo + hi2 + 1) >> 1; if (pre[mid] <= x) lo = mid; else hi2 = mid - 1; }
            const int li = lo, chunk = x - pre[li]; bhj = li; own = 0; lpos = (li >> 5) * LIST_STRIDE + list_off(li & 31) + 256 * chunk;
            const int c = (int)__hip_atomic_load(gcnt + li, RLX_AGENT) - 256 * chunk; cnt = c < 256 ? c : 256; }
        DSC[4 * F.tid] = bhj; DSC[4 * F.tid + 1] = own; DSC[4 * F.tid + 2] = lpos; DSC[4 * F.tid + 3] = cnt;
    }
    __syncthreads();
    att::ItemCtx C{Qb, Kb, Vb, PO, ML, lists};
    att::attn_items(C, (const LAS int*)DSC, nloc < 64 ? nloc : 64, ldsg);
}

__device__ __forceinline__ void combine_phase(Frame& F) {
    const bf16* PO = (const bf16*)(F.ws + WS_PARTO); const float2* ML = (const float2*)(F.ws + WS_ML); bf16* CAT = (bf16*)(F.ws + WS_CAT);
    constexpr float C = att::SCALE * 1.4426950408889634f;
    const size_t gt = (size_t)blockIdx.x * (NWAVES * 64) + F.tid, NT = (size_t)F.G * NWAVES * 64;
    for (size_t idx = gt; idx < (size_t)32 * SEQ * 16; idx += NT) {
        const int dc = (int)(idx & 15), t = (int)((idx >> 4) & (SEQ - 1)), bh = (int)(idx >> 17), qb = t >> 8, nsel = qb < 3 ? qb : 3;
        float2 ml[4]; float mx;
        ml[3] = ML[((size_t)3 * 32 + bh) * SEQ + t]; mx = ml[3].x;
#pragma unroll
        for (int k = 0; k < 3; ++k) { if (k < nsel) { ml[k] = ML[((size_t)k * 32 + bh) * SEQ + t]; mx = fmaxf(mx, ml[k].x); } else ml[k] = make_float2(0.f, 0.f); }
        float acc[8]; float wsum = 0.f;
#pragma unroll
        for (int e = 0; e < 8; ++e) acc[e] = 0.f;
#pragma unroll
        for (int k = 0; k < 4; ++k) { if (k == 3 || k < nsel) {
            const float w = ml[k].y * __builtin_amdgcn_exp2f((ml[k].x - mx) * C); wsum += w;
            const v4u r = *(const GAS v4u*)(PO + (((size_t)k * 32 + bh) * SEQ + t) * HD + dc * 8);
            acc[0] += w * bf_lo(r.x); acc[1] += w * bf_hi(r.x); acc[2] += w * bf_lo(r.y); acc[3] += w * bf_hi(r.y);
            acc[4] += w * bf_lo(r.z); acc[5] += w * bf_hi(r.z); acc[6] += w * bf_lo(r.w); acc[7] += w * bf_hi(r.w); } }
        const float inv = 1.0f / wsum; const int b = bh >> 4, h = bh & 15;
        v4u o; o.x = pk2(acc[0] * inv, acc[1] * inv); o.y = pk2(acc[2] * inv, acc[3] * inv); o.z = pk2(acc[4] * inv, acc[5] * inv); o.w = pk2(acc[6] * inv, acc[7] * inv);
        *(GAS v4u*)(CAT + ((size_t)b * SEQ + t) * DM + PW + h * HD + dc * 8) = o;
    }
}

struct Args { const float* in[18]; float* out; unsigned char* ws; int ph_lo, ph_hi, li, pad; };
__global__ void __launch_bounds__(NWAVES * 64, 2) mega_fwd(Args args) {
    extern __shared__ __attribute__((aligned(16))) unsigned char lds[];
    Frame F;
    F.lds = (LAS unsigned char*)lds;
    F.MISC = (volatile LAS unsigned*)(F.lds + MISC_OFF);
    F.tid = threadIdx.x; F.lane = F.tid & 63; F.wave = __builtin_amdgcn_readfirstlane(F.tid >> 6);
    F.G = gridDim.x; F.ws = args.ws;
    F.ctl = (gu32*)(args.ws + WS_CTL);
    for (int u = F.tid; u < (LDS_BYTES - LDSCTL_OFF) / 4; u += NWAVES * 64) ((LAS unsigned*)(F.lds + LDSCTL_OFF))[u] = 0u;
    __syncthreads();
    XcdBarrier bar; bar.bar = (unsigned*)(F.ctl + CW_BAR); bar.x = 0; bar.st = nullptr;
    if (N_LAUNCHES == 1) bar = xcd_barrier_post((unsigned*)(F.ctl + CW_BAR), F.MISC + 8);
#define GRID_BAR() do { if (N_LAUNCHES == 1) xcd_barrier(bar); } while (0)
    const int lo = args.ph_lo, hi = args.ph_hi;
#define IN(k) (lo <= (k) && (k) < hi)
#define BOTH(k) (IN(k) && IN((k) + 1))
#ifndef PROBE_DUP
#define PROBE_DUP 0
#endif
#define DUPON(k) ((PROBE_DUP >> (k)) & 1)
#define REP(k) for (int _rep = 0; _rep < (DUPON(k) ? 2 : 1); ++_rep)
    unsigned char* ws = args.ws;
    const int G = F.G, cid = (int)blockIdx.x;
    float* out = args.out;

    if (IN(0)) { REP(0) { p0_prologue(F, args.in); } if (BOTH(0)) GRID_BAR(); }

    if (IN(1)) {
        { pg8::GemmKV g{(const char*)(ws + WS_MEMB), (const char*)(ws + WS_WXKV), DM, DM, 1024};
          pg8::OrderKV S{G, cid}; pg8::EpiSlabKV E{(float*)(ws + WS_SLAB)};
          pg8::gemm_phase<pg8::EpiSlabKV, pg8::OrderKV, true, true, pg8::GemmKV>(F.lds + RING_OFF, g, S, E); if (DUPON(16)) { pg8::gemm_phase<pg8::EpiSlabKV, pg8::OrderKV, true, true, pg8::GemmKV>(F.lds + RING_OFF, g, S, E); } }
        { pg8::Gemm g = pg8::make_gemm(ws + WS_XB, DM, ws + WS_WIN, DM, DM); pg8::StaticOrder S; S.init(M, MIXIN, G, cid);
          pg8::EpiMixIn E{(pg8::bf16_t*)(ws + WS_HP), (size_t)M * 2048, (const float*)(ws + WS_ROPE)};
          pg8::gemm_phase<pg8::EpiMixIn, pg8::StaticOrder, true, true>(F.lds + RING_OFF, g, S, E); if (DUPON(1)) { pg8::gemm_phase<pg8::EpiMixIn, pg8::StaticOrder, true, true>(F.lds + RING_OFF, g, S, E); } }
        if (BOTH(1)) GRID_BAR();
    }

    if (IN(2)) { REP(2) { pool_ew(F); kmean_phase(F); kv_reduce(F); } if (BOTH(2)) GRID_BAR(); }

    if (IN(3)) {
        { pg8::Gemm g = pg8::make_gemm(ws + WS_WOUT, 2048, ws + WS_WPOOL, 512, 512); g.a_pn = 512 * 2; g.a_pn_sh = 1; pg8::StaticOrder S; S.init(DM, PW, G, cid);
          pg8::EpiStore E{(pg8::bf16_t*)(ws + WS_WOUT2), DM, 0};
          pg8::gemm_phase<pg8::EpiStore, pg8::StaticOrder, true, true>(F.lds + RING_OFF, g, S, E); if (DUPON(3)) { pg8::gemm_phase<pg8::EpiStore, pg8::StaticOrder, true, true>(F.lds + RING_OFF, g, S, E); } }
        if (G == 256) { pg8::GemmAbs g{(const char*)(ws + WS_KVX), (const char*)(ws + WS_WXQ), (const char*)(ws + WS_WXO), cid < 128 ? 8192 : 4096, cid < 128 ? 4096 : 8192, 1024};
          pg8::OrderAbs S{cid}; pg8::EpiStoreAbs E{(pg8::bf16_t*)(ws + WS_WQK), (pg8::bf16_t*)(ws + WS_WVOT)};
          pg8::gemm_phase<pg8::EpiStoreAbs, pg8::OrderAbs, true, true, pg8::GemmAbs>(F.lds + RING_OFF, g, S, E); if (DUPON(17)) { pg8::gemm_phase<pg8::EpiStoreAbs, pg8::OrderAbs, true, true, pg8::GemmAbs>(F.lds + RING_OFF, g, S, E); } }
        gate_phase(F);
        if (BOTH(3)) GRID_BAR();
    }

    if (IN(4)) { attn_phase(F, (char*)lds + RING_OFF); if (DUPON(4)) { __syncthreads(); attn_phase(F, (char*)lds + RING_OFF); } if (BOTH(4)) GRID_BAR(); }

    if (IN(5)) { REP(5) { combine_phase(F); } if (BOTH(5)) GRID_BAR(); }

    if (IN(6)) {
        pg8::Gemm g = pg8::make_gemm(ws + WS_CAT, DM, ws + WS_WOUT2, DM, DM); pg8::StaticOrder S; S.init(M, DM, G, cid);
        pg8::EpiResid E{args.in[0], (pg8::bf16_t*)(ws + WS_TB), DM, DN_ALPHA};
        pg8::gemm_phase<pg8::EpiResid, pg8::StaticOrder, true, true>(F.lds + RING_OFF, g, S, E); if (DUPON(6)) { pg8::gemm_phase<pg8::EpiResid, pg8::StaticOrder, true, true>(F.lds + RING_OFF, g, S, E); }
        if (BOTH(6)) GRID_BAR();
    }
    if (IN(7)) { ln_rows<false>(F, (const bf16*)(ws + WS_TB), (bf16*)(ws + WS_HB), (float2*)(ws + WS_STATS), nullptr, args.in[6], args.in[7]); if (DUPON(7)) { ln_rows<false>(F, (const bf16*)(ws + WS_TB), (bf16*)(ws + WS_HB), (float2*)(ws + WS_STATS), nullptr, args.in[6], args.in[7]); } if (BOTH(7)) GRID_BAR(); }

    if (IN(9)) {
        if (G == 256) {
            pg8::Gemm g = pg8::make_gemm(ws + WS_HB, DM, ws + WS_WQK, DM, DM); g.b_pm = (size_t)1024 * DM * 2; g.b_pm_sh = 5;
            pg8::StaticOrder S; S.init(M, XH * 256, G, cid);
            pg8::EpiSoftmax E{(pg8::bf16_t*)(ws + WS_PB), XH * MEMLEN, 0.03125f * 1.4426950408889634f};
            pg8::gemm_phase<pg8::EpiSoftmax, pg8::StaticOrder, false, true>(F.lds + RING_OFF, g, S, E); if (DUPON(9)) { pg8::gemm_phase<pg8::EpiSoftmax, pg8::StaticOrder, false, true>(F.lds + RING_OFF, g, S, E); }
        }
        if (BOTH(9)) GRID_BAR();
    }
    if (IN(11)) {
        pg8::Gemm g = pg8::make_gemm(ws + WS_PB, XH * MEMLEN, ws + WS_WVOT, 2048, XH * MEMLEN); g.b_pm = (size_t)1024 * 2; g.b_pm_sh = 5;
        pg8::StaticOrder S; S.init(M, DM, G, cid);
        pg8::EpiResidLN E{(pg8::bf16_t*)(ws + WS_TB), (const pg8::f32x2*)(ws + WS_STATS), 6};
        pg8::gemm_phase<pg8::EpiResidLN, pg8::StaticOrder, true, true>(F.lds + RING_OFF, g, S, E);
        if (BOTH(11)) GRID_BAR();
    }
    if (IN(12)) { ln_rows<false>(F, (const bf16*)(ws + WS_TB), (bf16*)(ws + WS_HB), (float2*)(ws + WS_STATS), nullptr, args.in[11], args.in[12]); if (BOTH(12)) GRID_BAR(); }

    if (IN(13)) {
        pg8::Gemm g = pg8::make_gemm(ws + WS_HB, DM, ws + WS_WGU, DM, DM); pg8::StaticOrder S; S.init(M, 2 * FF, G, cid);
        pg8::EpiSwiGLU E{(pg8::bf16_t*)(ws + WS_G), FF};
        pg8::gemm_phase<pg8::EpiSwiGLU, pg8::StaticOrder, true, true>(F.lds + RING_OFF, g, S, E); if (DUPON(13)) { pg8::gemm_phase<pg8::EpiSwiGLU, pg8::StaticOrder, true, true>(F.lds + RING_OFF, g, S, E); }
        if (BOTH(13)) GRID_BAR();
    }
    if (IN(14)) {
        pg8::Gemm g = pg8::make_gemm(ws + WS_G, FF, ws + WS_WDN, FF, FF); pg8::StaticOrder S; S.init(M, DM, G, cid);
        pg8::EpiResidLN E{(pg8::bf16_t*)(ws + WS_TB), (const pg8::f32x2*)(ws + WS_STATS), 11};
        if (DUPON(14)) { pg8::EpiStore E2{(pg8::bf16_t*)(ws + WS_HB), DM, 0}; pg8::gemm_phase<pg8::EpiStore, pg8::StaticOrder, true, true>(F.lds + RING_OFF, g, S, E2); }
        pg8::gemm_phase<pg8::EpiResidLN, pg8::StaticOrder, true, true>(F.lds + RING_OFF, g, S, E);
        if (BOTH(14)) GRID_BAR();
    }
    if (IN(15)) { ln_rows<true>(F, (const bf16*)(ws + WS_TB), nullptr, nullptr, out, args.in[16], args.in[17]); if (DUPON(15)) { ln_rows<true>(F, (const bf16*)(ws + WS_TB), nullptr, nullptr, out, args.in[16], args.in[17]); } }
#undef IN
#undef BOTH
#undef GRID_BAR
}

extern "C" void kernel_launch(void* const* d_in, const int* in_sizes, int n_in, void* d_out, int out_size, void* d_ws, size_t ws_size, hipStream_t stream) {
    static int grid = 0;
    if (grid == 0) {
        if (n_in != 18 || in_sizes[0] != M * DM || out_size != M * DM || ws_size < WS_END) { fprintf(stderr, "kernel_launch: shape / workspace mismatch (n_in %d, in0 %d, out %d, ws %zu, need %zu)\n", n_in, n_in > 0 ? in_sizes[0] : -1, out_size, ws_size, (size_t)WS_END); grid = -1; return; }
        int dev = 0, cus = 0, per_cu = 0;
        if (hipGetDevice(&dev) != hipSuccess || hipDeviceGetAttribute(&cus, hipDeviceAttributeMultiprocessorCount, dev) != hipSuccess) { grid = -1; return; }
        if (hipFuncSetAttribute((const void*)mega_fwd, hipFuncAttributeMaxDynamicSharedMemorySize, LDS_BYTES) != hipSuccess) { fprintf(stderr, "kernel_launch: hipFuncSetAttribute failed\n"); grid = -1; return; }
        if (hipOccupancyMaxActiveBlocksPerMultiprocessor(&per_cu, (const void*)mega_fwd, NWAVES * 64, LDS_BYTES) != hipSuccess || per_cu < 1)
            fprintf(stderr, "kernel_launch: note: occupancy query reports %d workgroups per CU\n", per_cu);
        (void)hipGetLastError();
        grid = cus;
        if (grid != 256) fprintf(stderr, "kernel_launch: %d CUs; the cross-attention score phase needs a 256-workgroup grid\n", grid);
    }
    if (grid < 0) return;
    if (hipMemsetAsync((char*)d_ws + WS_CTL, 0, CTL_ZERO_BYTES, stream) != hipSuccess) return;
    Args a{};
    for (int i = 0; i < 18; ++i) a.in[i] = (const float*)d_in[i];
    a.out = (float*)d_out; a.ws = (unsigned char*)d_ws; a.pad = 0;
    for (int li = 0; li < N_LAUNCHES; ++li) {
        a.ph_lo = (N_LAUNCHES == 1) ? 0 : li; a.ph_hi = (N_LAUNCHES == 1) ? N_PHASES : li + 1; a.li = li;
        hipLaunchKernelGGL(mega_fwd, dim3(grid), dim3(NWAVES * 64), LDS_BYTES, stream, a);
        if (hipPeekAtLastError() != hipSuccess) { fprintf(stderr, "kernel_launch: launch %d failed\n", li); break; }
    }
}
```

```cpp
#include <hip/hip_runtime.h>
#include <cstdio>
#include <cstdint>

namespace pg8 {
#define PG8_LAS __attribute__((address_space(3)))
typedef unsigned short bf16_t;
typedef short bf16x8 __attribute__((ext_vector_type(8)));
typedef float f32x4 __attribute__((ext_vector_type(4)));
typedef float f32x2 __attribute__((ext_vector_type(2)));
typedef unsigned u32x4 __attribute__((ext_vector_type(4)));
typedef unsigned u32x2 __attribute__((ext_vector_type(2)));
constexpr int BM = 256, BK = 64, HALF = 128, HTB = HALF * BK * 2  , STAGE_BYTES = 8 * HTB, NXCD = 8, WGM = 8;

__host__ __device__ __forceinline__ int lds_byte(int r, int c) { const int st = (r >> 4) * 2 + (c >> 5), rr = r & 15, cc = c & 31, ob = rr * 64 + cc * 2; return st * 1024 + (ob ^ (((ob >> 9) & 1) << 5)); }
__host__ __device__ __forceinline__ void stage_rc(int b, int& R, int& C) { const int st = b / 1024, sb = b % 1024, swz = sb ^ (((sb >> 9) & 1) << 5); R = (st >> 1) * 16 + swz / 64; C = (st & 1) * 32 + (swz % 64) / 2; }
__host__ __device__ __forceinline__ int perm32(int rho) { const int n = rho >> 4, i = rho & 15; return 8 * (i >> 2) + 4 * n + (i & 3); }

struct Unit { int pm, pn, pz; };
struct Gemm {
    const char* A; const char* B; int lda, ldb, K;
    size_t a_pm, a_pn; int a_pn_sh; size_t b_pn, b_pm; int b_pm_sh;
    __device__ __forceinline__ const char* a_ptr(const Unit& u) const { return A + (size_t)u.pm * a_pm + (size_t)(u.pn >> a_pn_sh) * a_pn; }
    __device__ __forceinline__ const char* b_ptr(const Unit& u) const { return B + (size_t)u.pn * b_pn + (size_t)(u.pm >> b_pm_sh) * b_pm; }
};
__device__ __forceinline__ Gemm make_gemm(const void* A, int lda, const void* B, int ldb, int K) {
    Gemm g; g.A = (const char*)A; g.B = (const char*)B; g.lda = lda; g.ldb = ldb; g.K = K;
    g.a_pm = (size_t)BM * lda * 2; g.a_pn = 0; g.a_pn_sh = 0; g.b_pn = (size_t)BM * ldb * 2; g.b_pm = 0; g.b_pm_sh = 0; return g;
}

struct StaticOrder {
    int nM, nN, nwg, G, c;
    __host__ __device__ void init(int M, int N, int G_, int c_) { nM = M / BM; nN = N / BM; nwg = nM * nN; G = G_; c = c_; }
    __host__ __device__ bool next(int i, Unit& u) const {
        const long L = (long)i * G + c; if (L >= nwg) return false;
        int wgid = (int)L; { const int q = nwg / NXCD, r = nwg % NXCD, xcd = wgid % NXCD, off = wgid / NXCD; wgid = (xcd < r ? xcd * (q + 1) : r * (q + 1) + (xcd - r) * q) + off; }
        const int nig = WGM * nN, gid = wgid / nig, fm = gid * WGM, gsz = (nM - fm) < WGM ? (nM - fm) : WGM;
        u.pm = fm + ((wgid % nig) % gsz); u.pn = (wgid % nig) / gsz; u.pz = 0; return true;
    }
    __device__ __forceinline__ void a_ready(const Unit&) const {}
    __device__ __forceinline__ void done(const Unit&) const {}
};

__device__ __forceinline__ unsigned cvt_pk_bf16(float lo, float hi) { unsigned r; asm volatile("v_cvt_pk_bf16_f32 %0, %1, %2" : "=v"(r) : "v"(lo), "v"(hi)); return r; }

struct EpiMixIn {
    static constexpr bool PERM = true, AFTER_DRAIN = false;
    bf16_t* base; size_t tstride; const float* rope;
    __device__ __forceinline__ void operator()(const f32x4 (&acc)[2][2][4][2], const Unit& u, int wr, int wc, int fr, int fq) const {
        const int t = u.pn >> 3; const bool rp = (t == 1) || (t == 2);
        bf16_t* ob = base + (size_t)t * tstride;
        const int row0 = u.pm * BM + wr * 64 + fr, col0 = (u.pn & 7) * BM + wc * 32 + 8 * fq;
#pragma unroll
        for (int ai = 0; ai < 2; ++ai)
#pragma unroll
            for (int m = 0; m < 4; ++m) {
                const int row = row0 + ai * HALF + m * 16; bf16_t* rowp = ob + (size_t)row * 2048 + col0;
                f32x4 cs0 = (f32x4){1.f, 0.f, 1.f, 0.f}, cs1 = cs0;
                if (rp) { const f32x4* tp = (const f32x4*)(rope + ((size_t)(row & 8191) * 64 + wc * 16 + fq * 4) * 2); cs0 = tp[0]; cs1 = tp[1]; }
#pragma unroll
                for (int bj = 0; bj < 2; ++bj) {
                    const f32x4 v0 = acc[ai][bj][m][0], v1 = acc[ai][bj][m][1];
                    const float a0 = v0[0] * cs0[0] - v0[1] * cs0[1], a1 = v0[1] * cs0[0] + v0[0] * cs0[1];
                    const float a2 = v0[2] * cs0[2] - v0[3] * cs0[3], a3 = v0[3] * cs0[2] + v0[2] * cs0[3];
                    const float b0 = v1[0] * cs1[0] - v1[1] * cs1[1], b1 = v1[1] * cs1[0] + v1[0] * cs1[1];
                    const float b2 = v1[2] * cs1[2] - v1[3] * cs1[3], b3 = v1[3] * cs1[2] + v1[2] * cs1[3];
                    u32x4 w; w.x = cvt_pk_bf16(a0, a1); w.y = cvt_pk_bf16(a2, a3); w.z = cvt_pk_bf16(b0, b1); w.w = cvt_pk_bf16(b2, b3);
                    *(u32x4*)(rowp + bj * HALF) = w;
                }
            }
    }
};
struct EpiStore {
    static constexpr bool PERM = true, AFTER_DRAIN = false;
    bf16_t* O; int ldc, coff;
    __device__ __forceinline__ void operator()(const f32x4 (&acc)[2][2][4][2], const Unit& u, int wr, int wc, int fr, int fq) const {
        const int row0 = u.pm * BM + wr * 64 + fr, col0 = coff + u.pn * BM + wc * 32 + 8 * fq;
#pragma unroll
        for (int ai = 0; ai < 2; ++ai)
#pragma unroll
            for (int m = 0; m < 4; ++m) { bf16_t* rowp = O + (size_t)(row0 + ai * HALF + m * 16) * ldc + col0;
#pragma unroll
                for (int bj = 0; bj < 2; ++bj) { const f32x4 v0 = acc[ai][bj][m][0], v1 = acc[ai][bj][m][1];
                    u32x4 w; w.x = cvt_pk_bf16(v0[0], v0[1]); w.y = cvt_pk_bf16(v0[2], v0[3]); w.z = cvt_pk_bf16(v1[0], v1[1]); w.w = cvt_pk_bf16(v1[2], v1[3]);
                    *(u32x4*)(rowp + bj * HALF) = w; } }
    }
};
struct EpiResid {
    static constexpr bool PERM = true, AFTER_DRAIN = false;
    const float* res; bf16_t* out; int ldc; float alpha;
    __device__ __forceinline__ void operator()(const f32x4 (&acc)[2][2][4][2], const Unit& u, int wr, int wc, int fr, int fq) const {
        const int row0 = u.pm * BM + wr * 64 + fr, col0 = u.pn * BM + wc * 32 + 8 * fq;
#pragma unroll
        for (int ai = 0; ai < 2; ++ai)
#pragma unroll
            for (int m = 0; m < 4; ++m) { const size_t off = (size_t)(row0 + ai * HALF + m * 16) * ldc + col0;
#pragma unroll
                for (int bj = 0; bj < 2; ++bj) { const f32x4 r0 = *(const f32x4*)(res + off + bj * HALF), r1 = *(const f32x4*)(res + off + bj * HALF + 4);
                    const f32x4 v0 = r0 * alpha + acc[ai][bj][m][0], v1 = r1 * alpha + acc[ai][bj][m][1];
                    u32x4 w; w.x = cvt_pk_bf16(v0[0], v0[1]); w.y = cvt_pk_bf16(v0[2], v0[3]); w.z = cvt_pk_bf16(v1[0], v1[1]); w.w = cvt_pk_bf16(v1[2], v1[3]);
                    *(u32x4*)(out + off + bj * HALF) = w; }
                asm volatile("" ::: "memory"); }
    }
};
struct EpiSwiGLU {
    static constexpr bool PERM = true, AFTER_DRAIN = false;
    bf16_t* G; int ldc;
    __device__ __forceinline__ float act(float g, float u) const { return g * u * __builtin_amdgcn_rcpf(1.0f + __builtin_amdgcn_exp2f(-1.4426950408889634f * g)); }
    __device__ __forceinline__ void operator()(const f32x4 (&acc)[2][2][4][2], const Unit& u, int wr, int wc, int fr, int fq) const {
        const int row0 = u.pm * BM + wr * 64 + fr, col0 = u.pn * HALF + wc * 32 + 8 * fq;
#pragma unroll
        for (int ai = 0; ai < 2; ++ai)
#pragma unroll
            for (int m = 0; m < 4; ++m) { bf16_t* rowp = G + (size_t)(row0 + ai * HALF + m * 16) * ldc + col0;
                const f32x4 g0 = acc[ai][0][m][0], g1 = acc[ai][0][m][1], u0 = acc[ai][1][m][0], u1 = acc[ai][1][m][1];
                u32x4 w; w.x = cvt_pk_bf16(act(g0[0], u0[0]), act(g0[1], u0[1])); w.y = cvt_pk_bf16(act(g0[2], u0[2]), act(g0[3], u0[3]));
                w.z = cvt_pk_bf16(act(g1[0], u1[0]), act(g1[1], u1[1])); w.w = cvt_pk_bf16(act(g1[2], u1[2]), act(g1[3], u1[3]));
                *(u32x4*)rowp = w; }
    }
};
struct EpiSoftmax {
    static constexpr bool PERM = true, AFTER_DRAIN = true;
    bf16_t* P; int ldc; float c2;
    __device__ __forceinline__ void fused(f32x4 (&acc)[2][2][4][2], const Unit& u, int wr, int wc, int fr, int fq, PG8_LAS unsigned char* lds, int wid, int lane) const {
        PG8_LAS float* T1 = (PG8_LAS float*)lds;
        PG8_LAS float* T2 = (PG8_LAS float*)(lds + 4096);
#pragma unroll
        for (int ai = 0; ai < 2; ++ai)
#pragma unroll
            for (int m = 0; m < 4; ++m) { float mx = -3.0e38f;
#pragma unroll
                for (int bj = 0; bj < 2; ++bj)
#pragma unroll
                    for (int n = 0; n < 2; ++n) { const f32x4 x = acc[ai][bj][m][n]; mx = fmaxf(mx, fmaxf(fmaxf(x[0], x[1]), fmaxf(x[2], x[3]))); }
                mx = fmaxf(mx, __shfl_xor(mx, 16)); mx = fmaxf(mx, __shfl_xor(mx, 32));
                if (fq == 0) T1[(ai * HALF + wr * 64 + m * 16 + fr) * 4 + wc] = mx; }
        asm volatile("s_waitcnt lgkmcnt(0)" ::: "memory"); __builtin_amdgcn_s_barrier(); asm volatile("" ::: "memory");
#pragma unroll
        for (int ai = 0; ai < 2; ++ai)
#pragma unroll
            for (int m = 0; m < 4; ++m) { const int r = ai * HALF + wr * 64 + m * 16 + fr;
                const f32x4 t = *(const PG8_LAS f32x4*)(T1 + r * 4); const float mx = fmaxf(fmaxf(t[0], t[1]), fmaxf(t[2], t[3])) * c2; float s = 0.f;
#pragma unroll
                for (int bj = 0; bj < 2; ++bj)
#pragma unroll
                    for (int n = 0; n < 2; ++n) { f32x4 x = acc[ai][bj][m][n];
#pragma unroll
                        for (int e = 0; e < 4; ++e) { x[e] = __builtin_amdgcn_exp2f(x[e] * c2 - mx); s += x[e]; }
                        acc[ai][bj][m][n] = x; }
                s += __shfl_xor(s, 16); s += __shfl_xor(s, 32);
                if (fq == 0) T2[r * 4 + wc] = s; }
        asm volatile("s_waitcnt lgkmcnt(0)" ::: "memory"); __builtin_amdgcn_s_barrier(); asm volatile("" ::: "memory");
        const int row0 = u.pm * BM + wr * 64 + fr, col0 = u.pn * BM + wc * 32 + 8 * fq;
#pragma unroll
        for (int ai = 0; ai < 2; ++ai)
#pragma unroll
            for (int m = 0; m < 4; ++m) { const int r = ai * HALF + wr * 64 + m * 16 + fr;
                const f32x4 t = *(const PG8_LAS f32x4*)(T2 + r * 4); const float inv = 1.0f / ((t[0] + t[1]) + (t[2] + t[3]));
                bf16_t* rowp = P + (size_t)(row0 + ai * HALF + m * 16) * ldc + col0;
#pragma unroll
                for (int bj = 0; bj < 2; ++bj) { const f32x4 v0 = acc[ai][bj][m][0] * inv, v1 = acc[ai][bj][m][1] * inv;
                    u32x4 w; w.x = cvt_pk_bf16(v0[0], v0[1]); w.y = cvt_pk_bf16(v0[2], v0[3]); w.z = cvt_pk_bf16(v1[0], v1[1]); w.w = cvt_pk_bf16(v1[2], v1[3]);
                    *(u32x4*)(rowp + bj * HALF) = w; } }
    }
};

struct GemmKV {
    const char* memb; const char* wkv; int lda, ldb, K;
    __device__ __forceinline__ const char* a_ptr(const Unit& u) const { return memb + (size_t)u.pm * (BM * 4096 * 2) + (size_t)u.pz * 2048; }
    __device__ __forceinline__ const char* b_ptr(const Unit& u) const { return wkv + (size_t)u.pn * (BM * 4096 * 2) + (size_t)u.pz * 2048; }
};
struct OrderKV {
    int G, c;
    __device__ __forceinline__ bool next(int i, Unit& u) const { const int L = i * G + c; if (L >= 256) return false; const int tile = L >> 2; u.pz = L & 3; u.pm = tile >> 5; u.pn = tile & 31; return true; }
    __device__ __forceinline__ void a_ready(const Unit&) const {}
    __device__ __forceinline__ void done(const Unit&) const {}
};
struct EpiSlabKV {
    static constexpr bool PERM = false, AFTER_DRAIN = false;
    float* S;
    __device__ __forceinline__ void operator()(const f32x4 (&acc)[2][2][4][2], const Unit& u, int wr, int wc, int fr, int fq) const {
        float* C = S + (size_t)u.pz * (512 * 8192);
        const int row0 = u.pm * BM + wr * 64 + fr, col0 = u.pn * BM + wc * 32 + 4 * fq;
#pragma unroll
        for (int ai = 0; ai < 2; ++ai)
#pragma unroll
            for (int m = 0; m < 4; ++m) { float* rowp = C + (size_t)(row0 + ai * HALF + m * 16) * 8192 + col0;
#pragma unroll
                for (int bj = 0; bj < 2; ++bj)
#pragma unroll
                    for (int n = 0; n < 2; ++n) *(f32x4*)(rowp + bj * HALF + n * 16) = acc[ai][bj][m][n]; }
    }
};
struct GemmAbs {
    const char* kvx; const char* wq_raw; const char* wo_t; int lda, ldb, K;
    __device__ __forceinline__ const char* a_ptr(const Unit& u) const {
        return u.pz ? wo_t + (size_t)u.pm * (BM * 4096 * 2) + (size_t)(u.pn & 3) * 2048
                    : kvx + (size_t)(u.pm >> 2) * (BM * 8192 * 2) + (size_t)(u.pm & 3) * 2048; }
    __device__ __forceinline__ const char* b_ptr(const Unit& u) const {
        return u.pz ? kvx + 8192 + (size_t)(u.pn >> 2) * (BM * 8192 * 2) + (size_t)(u.pn & 3) * 2048
                    : wq_raw + (size_t)u.pn * (BM * 4096 * 2) + (size_t)(u.pm & 3) * 2048; }
};
struct OrderAbs {
    int c;
    __device__ __forceinline__ bool next(int i, Unit& u) const { if (i != 0 || c >= 256) return false; if (c < 128) { u.pz = 0; u.pm = c >> 4; u.pn = c & 15; } else { const int t = c - 128; u.pz = 1; u.pm = t >> 3; u.pn = t & 7; } return true; }
    __device__ __forceinline__ void a_ready(const Unit&) const {}
    __device__ __forceinline__ void done(const Unit&) const {}
};
struct EpiStoreAbs {
    static constexpr bool PERM = true, AFTER_DRAIN = false;
    bf16_t* WQK; bf16_t* WVOT;
    __device__ __forceinline__ void operator()(const f32x4 (&acc)[2][2][4][2], const Unit& u, int wr, int wc, int fr, int fq) const {
        bf16_t* O = u.pz ? WVOT : WQK; const int ldc = u.pz ? 2048 : 4096;
        const int row0 = u.pm * BM + wr * 64 + fr, col0 = u.pn * BM + wc * 32 + 8 * fq;
#pragma unroll
        for (int ai = 0; ai < 2; ++ai)
#pragma unroll
            for (int m = 0; m < 4; ++m) { bf16_t* rowp = O + (size_t)(row0 + ai * HALF + m * 16) * ldc + col0;
#pragma unroll
                for (int bj = 0; bj < 2; ++bj) { const f32x4 v0 = acc[ai][bj][m][0], v1 = acc[ai][bj][m][1];
                    u32x4 w; w.x = cvt_pk_bf16(v0[0], v0[1]); w.y = cvt_pk_bf16(v0[2], v0[3]); w.z = cvt_pk_bf16(v1[0], v1[1]); w.w = cvt_pk_bf16(v1[2], v1[3]);
                    *(u32x4*)(rowp + bj * HALF) = w; } }
    }
};
struct EpiResidLN {
    static constexpr bool PERM = true, AFTER_DRAIN = false;
    bf16_t* T; const f32x2* stats; int gi;
    __device__ __forceinline__ void operator()(const f32x4 (&acc)[2][2][4][2], const Unit& u, int wr, int wc, int fr, int fq) const {
        constexpr int ldc = 4096; constexpr float alpha = 1.189207115002721f;
        const float* const __attribute__((address_space(4)))* inp = (const float* const __attribute__((address_space(4)))*)__builtin_amdgcn_kernarg_segment_ptr();
        const float* g = inp[gi]; const float* b = inp[gi + 1];
        const int row0 = u.pm * BM + wr * 64 + fr, col0 = u.pn * BM + wc * 32 + 8 * fq;
        f32x4 gv[2][2], bv[2][2];
#pragma unroll
        for (int bj = 0; bj < 2; ++bj)
#pragma unroll
            for (int n = 0; n < 2; ++n) { gv[bj][n] = *(const f32x4*)(g + col0 + bj * HALF + n * 4) * alpha; bv[bj][n] = *(const f32x4*)(b + col0 + bj * HALF + n * 4) * alpha; }
#pragma unroll
        for (int ai = 0; ai < 2; ++ai)
#pragma unroll
            for (int m = 0; m < 4; ++m) { const int row = row0 + ai * HALF + m * 16; const size_t off = (size_t)row * ldc + col0; const f32x2 st = stats[row];
#pragma unroll
                for (int bj = 0; bj < 2; ++bj) { const u32x4 r = *(const u32x4*)(T + off + bj * HALF);
                    const f32x4 t0 = (f32x4){__builtin_bit_cast(float, r.x << 16), __builtin_bit_cast(float, r.x & 0xffff0000u), __builtin_bit_cast(float, r.y << 16), __builtin_bit_cast(float, r.y & 0xffff0000u)};
                    const f32x4 t1 = (f32x4){__builtin_bit_cast(float, r.z << 16), __builtin_bit_cast(float, r.z & 0xffff0000u), __builtin_bit_cast(float, r.w << 16), __builtin_bit_cast(float, r.w & 0xffff0000u)};
                    const f32x4 v0 = ((t0 - st.x) * st.y) * gv[bj][0] + bv[bj][0] + acc[ai][bj][m][0], v1 = ((t1 - st.x) * st.y) * gv[bj][1] + bv[bj][1] + acc[ai][bj][m][1];
                    u32x4 w; w.x = cvt_pk_bf16(v0[0], v0[1]); w.y = cvt_pk_bf16(v0[2], v0[3]); w.z = cvt_pk_bf16(v1[0], v1[1]); w.w = cvt_pk_bf16(v1[2], v1[3]);
                    *(u32x4*)(T + off + bj * HALF) = w; }
                asm volatile("" ::: "memory"); }
    }
};

template <class Epi, class Sched, bool ALIGN_EPI = false, bool SP2 = false, class GT = Gemm>
__device__ __forceinline__ void gemm_phase(PG8_LAS unsigned char* lds, const GT g, const Sched& S, const Epi& E) {
    const int tid = threadIdx.x, wid = __builtin_amdgcn_readfirstlane(tid >> 6), lane = tid & 63, wr = wid >> 2, wc = wid & 3, fr = lane & 15, fq = lane >> 4;
    const int K = g.K, nt = K / BK;
    unsigned voffA[2], voffB[2];
#pragma unroll
    for (int i = 0; i < 2; ++i) { int R, C; stage_rc(tid * 16 + i * 8192, R, C); const int Rb = Epi::PERM ? ((R & ~31) + perm32(R & 31)) : R;
        voffA[i] = (unsigned)(R * g.lda + C) * 2u; voffB[i] = (unsigned)(Rb * g.ldb + C) * 2u; }
    const size_t kstep = (size_t)(BK * 2);
    const size_t hA = (size_t)HALF * g.lda * 2, hB = (size_t)HALF * g.ldb * 2;
    const unsigned ldsw = (unsigned)wid * 1024u;
    const int aoff = lds_byte(wr * 64 + fr, fq * 8), boff = lds_byte(wc * 32 + fr, fq * 8);
#define PG8_SA(b, h) (((b) * 2 + (h)) * HTB)
#define PG8_SB(b, h) ((4 + (b) * 2 + (h)) * HTB)
#define PG8_STAGE(bufoff, gbase, voff) do { _Pragma("unroll") for (int _i = 0; _i < 2; ++_i) \
        __builtin_amdgcn_global_load_lds((const unsigned*)((const char*)(gbase) + (voff)[_i]), (PG8_LAS unsigned*)(lds + (bufoff) + ldsw + _i * 8192), 16, 0, 0); } while (0)
#define PG8_LDA(dst, b, h) do { _Pragma("unroll") for (int m = 0; m < 4; ++m) _Pragma("unroll") for (int k = 0; k < 2; ++k) dst[m][k] = *(const PG8_LAS bf16x8*)(lds + PG8_SA(b, h) + aoff + m * 2048 + k * 1024); } while (0)
#define PG8_LDB(dst, b, h) do { _Pragma("unroll") for (int n = 0; n < 2; ++n) _Pragma("unroll") for (int k = 0; k < 2; ++k) dst[n][k] = *(const PG8_LAS bf16x8*)(lds + PG8_SB(b, h) + boff + n * 2048 + k * 1024); } while (0)
#define PG8_MMA(ai, bj, At, Bt) do { __builtin_amdgcn_s_setprio(1); _Pragma("unroll") for (int m = 0; m < 4; ++m) _Pragma("unroll") for (int n = 0; n < 2; ++n) _Pragma("unroll") for (int k = 0; k < 2; ++k) \
        acc[ai][bj][m][n] = __builtin_amdgcn_mfma_f32_16x16x32_bf16(Bt[n][k], At[m][k], acc[ai][bj][m][n], 0, 0, 0); __builtin_amdgcn_s_setprio(0); } while (0)
#define PG8_WAIT_V(n) asm volatile("s_waitcnt vmcnt(" #n ")" ::: "memory")
#define PG8_WAIT_L(n) asm volatile("s_waitcnt lgkmcnt(" #n ")" ::: "memory")
#define PG8_BAR __builtin_amdgcn_s_barrier()
#define PG8_SCHED __builtin_amdgcn_sched_barrier(0)
    Unit cur, nxt; int ui = 0;
    if (!S.next(0, cur)) return;
    f32x4 acc[2][2][4][2];
#pragma unroll
    for (int a = 0; a < 2; ++a)
#pragma unroll
        for (int b = 0; b < 2; ++b)
#pragma unroll
            for (int m = 0; m < 4; ++m)
#pragma unroll
                for (int n = 0; n < 2; ++n) acc[a][b][m][n] = (f32x4){0.f, 0.f, 0.f, 0.f};
    bf16x8 At[4][2], B0[2][2], B1[2][2];
    const char* cA = g.a_ptr(cur); const char* cB = g.b_ptr(cur);
    S.a_ready(cur);
    if constexpr (SP2) {
        PG8_STAGE(PG8_SB(0, 0), cB, voffB); PG8_STAGE(PG8_SB(0, 1), cB + hB, voffB); PG8_STAGE(PG8_SA(0, 0), cA, voffA); PG8_STAGE(PG8_SA(0, 1), cA + hA, voffA);
        if (wr == 1) PG8_BAR;
        PG8_WAIT_V(2); PG8_BAR;
        PG8_STAGE(PG8_SB(1, 0), cB + kstep, voffB); PG8_STAGE(PG8_SA(1, 0), cA + kstep, voffA); PG8_STAGE(PG8_SB(1, 1), cB + hB + kstep, voffB);
        PG8_WAIT_V(6); PG8_BAR;
    } else {
        PG8_STAGE(PG8_SB(0, 0), cB, voffB); PG8_STAGE(PG8_SA(0, 0), cA, voffA); PG8_STAGE(PG8_SB(0, 1), cB + hB, voffB); PG8_STAGE(PG8_SA(0, 1), cA + hA, voffA);
        if (wr == 1) PG8_BAR;
        PG8_WAIT_V(4); PG8_BAR;
        PG8_STAGE(PG8_SB(1, 0), cB + kstep, voffB); PG8_STAGE(PG8_SA(1, 0), cA + kstep, voffA); PG8_STAGE(PG8_SB(1, 1), cB + hB + kstep, voffB);
        PG8_WAIT_V(6); PG8_BAR;
    }
    for (;;) {
        const bool has_next = S.next(ui + 1, nxt);
        const char* nA = has_next ? g.a_ptr(nxt) : cA; const char* nB = has_next ? g.b_ptr(nxt) : cB;
        for (int t = 0; t < nt; t += 2) {
            const bool last = (t == nt - 2);
            const char* a1 = cA + (size_t)(t + 1) * kstep;
            const char* a2 = last ? nA : cA + (size_t)(t + 2) * kstep; const char* b2 = last ? nB : cB + (size_t)(t + 2) * kstep;
            const char* a3 = a2 + kstep; const char* b3 = b2 + kstep;
            if (last && has_next) S.a_ready(nxt);
            if constexpr (SP2) {
            PG8_LDB(B0, 0, 0); PG8_LDB(B1, 0, 1); PG8_SCHED; PG8_LDA(At, 0, 0); PG8_STAGE(PG8_SA(1, 1), a1 + hA, voffA);
            PG8_WAIT_V(8); PG8_WAIT_L(0); PG8_BAR; PG8_MMA(0, 0, At, B0); PG8_MMA(0, 1, At, B1); PG8_BAR; PG8_SCHED;
            PG8_LDA(At, 0, 1); PG8_STAGE(PG8_SB(0, 0), b2, voffB); PG8_STAGE(PG8_SB(0, 1), b2 + hB, voffB); PG8_STAGE(PG8_SA(0, 0), a2, voffA);
            PG8_WAIT_V(8); PG8_WAIT_L(0); PG8_BAR; PG8_MMA(1, 0, At, B0); PG8_MMA(1, 1, At, B1); PG8_BAR; PG8_SCHED;
            PG8_LDB(B0, 1, 0); PG8_LDB(B1, 1, 1); PG8_SCHED; PG8_LDA(At, 1, 0); PG8_STAGE(PG8_SA(0, 1), a2 + hA, voffA);
            PG8_WAIT_V(8); PG8_WAIT_L(0); PG8_BAR; PG8_MMA(0, 0, At, B0); PG8_MMA(0, 1, At, B1); PG8_BAR; PG8_SCHED;
            PG8_LDA(At, 1, 1); PG8_STAGE(PG8_SB(1, 0), b3, voffB); PG8_STAGE(PG8_SB(1, 1), b3 + hB, voffB); PG8_STAGE(PG8_SA(1, 0), a3, voffA);
            PG8_WAIT_V(8); PG8_WAIT_L(0); PG8_BAR; PG8_MMA(1, 0, At, B0); PG8_MMA(1, 1, At, B1); PG8_BAR; PG8_SCHED;
            } else {
            PG8_LDB(B0, 0, 0); PG8_SCHED; PG8_LDA(At, 0, 0); PG8_STAGE(PG8_SA(1, 1), a1 + hA, voffA);
            PG8_WAIT_L(8); PG8_BAR; PG8_WAIT_L(0); PG8_MMA(0, 0, At, B0); PG8_BAR; PG8_SCHED;
            PG8_LDB(B1, 0, 1); PG8_STAGE(PG8_SB(0, 0), b2, voffB);
            PG8_BAR; PG8_WAIT_L(0); PG8_MMA(0, 1, At, B1); PG8_BAR;
            PG8_LDA(At, 0, 1); PG8_STAGE(PG8_SA(0, 0), a2, voffA);
            PG8_BAR; PG8_WAIT_L(0); PG8_MMA(1, 0, At, B0); PG8_BAR; PG8_SCHED;
            PG8_STAGE(PG8_SB(0, 1), b2 + hB, voffB);
            PG8_WAIT_V(6); PG8_BAR; PG8_MMA(1, 1, At, B1); PG8_BAR;
            PG8_LDB(B0, 1, 0); PG8_SCHED; PG8_LDA(At, 1, 0); PG8_STAGE(PG8_SA(0, 1), a2 + hA, voffA);
            PG8_WAIT_L(8); PG8_BAR; PG8_WAIT_L(0); PG8_MMA(0, 0, At, B0); PG8_BAR; PG8_SCHED;
            PG8_LDB(B1, 1, 1); PG8_STAGE(PG8_SB(1, 0), b3, voffB);
            PG8_BAR; PG8_WAIT_L(0); PG8_MMA(0, 1, At, B1); PG8_BAR;
            PG8_LDA(At, 1, 1); PG8_STAGE(PG8_SA(1, 0), a3, voffA);
            PG8_BAR; PG8_WAIT_L(0); PG8_MMA(1, 0, At, B0); PG8_BAR; PG8_SCHED;
            PG8_STAGE(PG8_SB(1, 1), b3 + hB, voffB);
            PG8_WAIT_V(6); PG8_BAR; PG8_MMA(1, 1, At, B1); PG8_BAR;
            }
        }
        if constexpr (ALIGN_EPI) { if (wr == 0) PG8_BAR; }
        if constexpr (!Epi::AFTER_DRAIN) { E(acc, cur, wr, wc, fr, fq); S.done(cur); }
        if (!has_next) break;
#pragma unroll
        for (int a = 0; a < 2; ++a)
#pragma unroll
            for (int b = 0; b < 2; ++b)
#pragma unroll
                for (int m = 0; m < 4; ++m)
#pragma unroll
                    for (int n = 0; n < 2; ++n) acc[a][b][m][n] = (f32x4){0.f, 0.f, 0.f, 0.f};
        cur = nxt; cA = nA; cB = nB; ++ui;
        if constexpr (ALIGN_EPI) { if (wr == 1) PG8_BAR; }
    }
    PG8_WAIT_V(0);
    if constexpr (!ALIGN_EPI) { if (wr == 0) PG8_BAR; }
    PG8_BAR;
    if constexpr (Epi::AFTER_DRAIN) { E.fused(acc, cur, wr, wc, fr, fq, lds, wid, lane); S.done(cur); }
#undef PG8_SA
#undef PG8_SB
#undef PG8_STAGE
#undef PG8_LDA
#undef PG8_LDB
#undef PG8_MMA
#undef PG8_WAIT_V
#undef PG8_WAIT_L
#undef PG8_BAR
#undef PG8_SCHED
}
}

namespace att {
using bf16_t = unsigned short;
using bf16x8 = __attribute__((ext_vector_type(8))) short;
using s16x4  = __attribute__((ext_vector_type(4))) short;
using f32x16 = __attribute__((ext_vector_type(16))) float;
using u32x4  = __attribute__((ext_vector_type(4))) unsigned;
using u32x2  = __attribute__((ext_vector_type(2))) unsigned;
constexpr int   D = 128, NW = 8, QBLK = 32, KVBLK = 64, NT = 4;
constexpr float SCALE = 0.088388347648318440f;
constexpr float THR = 8.f;
constexpr int   LDQ = 2048, LDK = 2048;
constexpr size_t SHM_V = KVBLK * D * 2, SHM_K = KVBLK * D * 2, SHM_ATTN = 2 * SHM_V + 2 * SHM_K;
#define KSWZ(row, colB) ((row) * 256 + ((colB) ^ (((row) & 7) << 4)))
#define SBAR() __builtin_amdgcn_sched_barrier(0)
__device__ __forceinline__ int crow(int r, int hi) { return (r & 3) + 8 * (r >> 2) + 4 * hi; }
__device__ __forceinline__ unsigned cvtpk(float lo, float hi) { unsigned r; asm volatile("v_cvt_pk_bf16_f32 %0, %1, %2" : "=v"(r) : "v"(lo), "v"(hi)); return r; }

__device__ __forceinline__ void partialSM(f32x16& p0, f32x16& p1, float& m_reg, float& mn, float& alpha) {
  constexpr float C = SCALE * 1.4426950408889634f;
  float pmax = p0[0];
#pragma unroll
  for (int r = 1; r < 16; ++r) pmax = fmaxf(pmax, p0[r]);
#pragma unroll
  for (int r = 0; r < 16; ++r) pmax = fmaxf(pmax, p1[r]);
  { auto rr = __builtin_amdgcn_permlane32_swap(__float_as_uint(pmax), __float_as_uint(pmax), false, false);
    pmax = fmaxf(__uint_as_float(rr[0]), __uint_as_float(rr[1])); }
  if (__builtin_expect(__all(pmax - m_reg <= THR / SCALE), 1)) { mn = m_reg; alpha = 1.f; }
  else { mn = fmaxf(m_reg, pmax); alpha = __builtin_amdgcn_exp2f((m_reg - mn) * C); m_reg = mn; }
  float mnC = -mn * C;
#pragma unroll
  for (int r = 0; r < 16; ++r) p0[r] = fmaf(p0[r], C, mnC);
#pragma unroll
  for (int r = 0; r < 16; ++r) p1[r] = fmaf(p1[r], C, mnC);
#pragma unroll
  for (int r = 0; r < 16; ++r) p0[r] = __builtin_amdgcn_exp2f(p0[r]);
}
__device__ __forceinline__ void finishSM(f32x16& p0, f32x16& p1, float alpha, float& l_reg, bf16x8& pa0, bf16x8& pa1, bf16x8& pa2, bf16x8& pa3) {
#pragma unroll
  for (int r = 0; r < 16; ++r) p1[r] = __builtin_amdgcn_exp2f(p1[r]);
  float ps = 0;
#pragma unroll
  for (int r = 0; r < 16; ++r) ps += p0[r];
#pragma unroll
  for (int r = 0; r < 16; ++r) ps += p1[r];
  { auto rr = __builtin_amdgcn_permlane32_swap(__float_as_uint(ps), __float_as_uint(ps), false, false);
    ps = __uint_as_float(rr[0]) + __uint_as_float(rr[1]); }
  l_reg = l_reg * alpha + ps;
#define PK4(P, BASE, OUT) do { unsigned a0 = cvtpk(P[BASE + 0], P[BASE + 1]), a1 = cvtpk(P[BASE + 2], P[BASE + 3]);   \
    unsigned b0 = cvtpk(P[BASE + 4], P[BASE + 5]), b1 = cvtpk(P[BASE + 6], P[BASE + 7]);                              \
    auto r0 = __builtin_amdgcn_permlane32_swap(a0, b0, false, false); auto r1 = __builtin_amdgcn_permlane32_swap(a1, b1, false, false); \
    u32x4 w = {r0[0], r1[0], r0[1], r1[1]}; OUT = *reinterpret_cast<bf16x8*>(&w); } while (0)
  PK4(p0, 0, pa0); PK4(p0, 8, pa1); PK4(p1, 0, pa2); PK4(p1, 8, pa3);
#undef PK4
}
__device__ __forceinline__ void qkt(f32x16& p0, f32x16& p1, const char* Ks, const bf16x8* qr, int r32, int hi) {
  p0 = f32x16{}; p1 = f32x16{};
#pragma unroll
  for (int d0 = 0; d0 < 8; ++d0) { int cb = (d0 * 16 + hi * 8) * 2;
    bf16x8 b0 = *reinterpret_cast<const bf16x8*>(Ks + KSWZ(r32, cb));
    bf16x8 b1 = *reinterpret_cast<const bf16x8*>(Ks + KSWZ(32 + r32, cb));
    p0 = __builtin_amdgcn_mfma_f32_32x32x16_bf16(b0, qr[d0], p0, 0, 0, 0);
    p1 = __builtin_amdgcn_mfma_f32_32x32x16_bf16(b1, qr[d0], p1, 0, 0, 0); }
}
__device__ __forceinline__ void cmask(f32x16& p0, f32x16& p1, int jt, int qloc, int hi) {
#pragma unroll
  for (int r = 0; r < 16; ++r) { const int key = 64 * jt + crow(r, hi); if (key > qloc) p0[r] = -1e30f; if (key + 32 > qloc) p1[r] = -1e30f; }
}
__device__ __forceinline__ int v_st(int k, int c) { const int kk = (k & ~0xC) | ((k & 4) << 1) | ((k & 8) >> 1); return ((kk >> 3) * 4 + (c >> 5)) * 512 + ((kk & 7) * 32 + (c & 31)) * 2; }
__device__ __forceinline__ int v_rd_base(int lane) { return ((lane & 3) << 3) | (((lane >> 2) & 3) << 6) | (((lane >> 4) & 1) << 5) | (((lane >> 5) & 1) << 8); }
constexpr int v_rd_off(int d0, int ks, int half) { return d0 * 512 + ks * 4096 + half * 2048; }
template <int OFF> __device__ __forceinline__ s16x4 tr_read(int vb) {
  s16x4 r; asm volatile("ds_read_b64_tr_b16 %0, %1 offset:%2" : "=&v"(r) : "v"(vb), "i"(OFF) : "memory"); return r;
}
template <int D0> __device__ __forceinline__ void pv_one(f32x16& od, int vb, bf16x8 pa0, bf16x8 pa1, bf16x8 pa2, bf16x8 pa3) {
  const s16x4 l0 = tr_read<v_rd_off(D0, 0, 0)>(vb), h0 = tr_read<v_rd_off(D0, 0, 1)>(vb), l1 = tr_read<v_rd_off(D0, 1, 0)>(vb), h1 = tr_read<v_rd_off(D0, 1, 1)>(vb);
  const s16x4 l2 = tr_read<v_rd_off(D0, 2, 0)>(vb), h2 = tr_read<v_rd_off(D0, 2, 1)>(vb), l3 = tr_read<v_rd_off(D0, 3, 0)>(vb), h3 = tr_read<v_rd_off(D0, 3, 1)>(vb);
  asm volatile("s_waitcnt lgkmcnt(0)" ::: "memory"); SBAR();
#define PK(L, H) (bf16x8){L[0], L[1], L[2], L[3], H[0], H[1], H[2], H[3]}
  od = __builtin_amdgcn_mfma_f32_32x32x16_bf16(PK(l0, h0), pa0, od, 0, 0, 0);
  od = __builtin_amdgcn_mfma_f32_32x32x16_bf16(PK(l1, h1), pa1, od, 0, 0, 0);
  od = __builtin_amdgcn_mfma_f32_32x32x16_bf16(PK(l2, h2), pa2, od, 0, 0, 0);
  od = __builtin_amdgcn_mfma_f32_32x32x16_bf16(PK(l3, h3), pa3, od, 0, 0, 0);
#undef PK
}
__device__ __forceinline__ void pv_d0(f32x16* o, int vb, bf16x8 pa0, bf16x8 pa1, bf16x8 pa2, bf16x8 pa3) {
  pv_one<0>(o[0], vb, pa0, pa1, pa2, pa3); pv_one<1>(o[1], vb, pa0, pa1, pa2, pa3); pv_one<2>(o[2], vb, pa0, pa1, pa2, pa3); pv_one<3>(o[3], vb, pa0, pa1, pa2, pa3);
}

__device__ __forceinline__ void attn_item(const bf16_t* __restrict__ Qrow, const bf16_t* __restrict__ Kh, const bf16_t* __restrict__ Vh, bool causal, int qloc,
                                          bf16_t* Orow, float2* MLrow, bool valid, char* lds) {
  const int tid = threadIdx.x, lane = tid & 63, r32 = lane & 31, hi = lane >> 5;
  char* V_lds = lds; char* K_lds = lds + 2 * SHM_V;
  float m_reg = -1e30f, l_reg = 0; f32x16 o[4] = {}; bf16x8 qr[8];
  const bf16_t* Qw = Qrow + hi * 8;
#pragma unroll
  for (int d0 = 0; d0 < 8; ++d0) qr[d0] = *reinterpret_cast<const bf16x8*>(Qw + d0 * 16);
  const int sr = tid >> 4, sc = (tid & 15) * 8, vst0 = v_st(sr, sc), vst1 = v_st(32 + sr, sc);
  const int vb0 = (int)(uintptr_t)V_lds + v_rd_base(lane);
  struct { bf16x8 vs0, vs1, ks0, ks1; } sr_[2];
#define SLOAD(i, k0) do { sr_[i].vs0 = *reinterpret_cast<const bf16x8*>(&Vh[(long)((k0) + sr) * LDK + sc]); sr_[i].vs1 = *reinterpret_cast<const bf16x8*>(&Vh[(long)((k0) + 32 + sr) * LDK + sc]); \
    sr_[i].ks0 = *reinterpret_cast<const bf16x8*>(&Kh[(long)((k0) + sr) * LDK + sc]); sr_[i].ks1 = *reinterpret_cast<const bf16x8*>(&Kh[(long)((k0) + 32 + sr) * LDK + sc]); } while (0)
#define SWRITE(b, i) do { *(bf16x8*)(V_lds + (b) * SHM_V + vst0) = sr_[i].vs0;          \
    *(bf16x8*)(V_lds + (b) * SHM_V + vst1) = sr_[i].vs1; int kc = sc * 2;               \
    *(bf16x8*)(K_lds + (b) * SHM_K + KSWZ(sr, kc)) = sr_[i].ks0;                       \
    *(bf16x8*)(K_lds + (b) * SHM_K + KSWZ(32 + sr, kc)) = sr_[i].ks1; } while (0)
#define SWAIT() asm volatile("s_waitcnt vmcnt(4)" ::: "memory")
#define RESC(a) do { if (__any((a) < 1.f)) { _Pragma("unroll") for (int d = 0; d < 4; ++d) _Pragma("unroll") for (int r = 0; r < 16; ++r) o[d][r] *= (a); } } while (0)
  f32x16 pA0, pA1, pB0, pB1; float mnA, mnB, alA, alB; bf16x8 pa0, pa1, pa2, pa3;
  constexpr int SE = 0, SO = 1;
  SLOAD(SE, 0); asm volatile("s_waitcnt vmcnt(0)" ::: "memory"); SWRITE(0, SE); __syncthreads();
  qkt(pA0, pA1, K_lds, qr, r32, hi); if (causal) cmask(pA0, pA1, 0, qloc, hi); partialSM(pA0, pA1, m_reg, mnA, alA);
  SLOAD(SO, KVBLK); SLOAD(SE, 2 * KVBLK);
  SWAIT(); SWRITE(1, SO); __syncthreads();
  {
    SBAR(); qkt(pB0, pB1, K_lds + SHM_K, qr, r32, hi); if (causal) cmask(pB0, pB1, 1, qloc, hi);
    finishSM(pA0, pA1, alA, l_reg, pa0, pa1, pa2, pa3); SBAR();
    SLOAD(SO, 3 * KVBLK); SBAR();
    pv_d0(o, vb0, pa0, pa1, pa2, pa3); partialSM(pB0, pB1, m_reg, mnB, alB);
    __syncthreads(); SWAIT(); SWRITE(0, SE);
    RESC(alB); __syncthreads();
    SBAR(); qkt(pA0, pA1, K_lds, qr, r32, hi); if (causal) cmask(pA0, pA1, 2, qloc, hi);
    finishSM(pB0, pB1, alB, l_reg, pa0, pa1, pa2, pa3); SBAR();
    pv_d0(o, vb0 + (int)SHM_V, pa0, pa1, pa2, pa3); partialSM(pA0, pA1, m_reg, mnA, alA);
    __syncthreads(); asm volatile("s_waitcnt vmcnt(0)" ::: "memory"); SWRITE(1, SO);
    RESC(alA); __syncthreads();
  }
  SBAR(); qkt(pB0, pB1, K_lds + SHM_K, qr, r32, hi); if (causal) cmask(pB0, pB1, 3, qloc, hi);
  finishSM(pA0, pA1, alA, l_reg, pa0, pa1, pa2, pa3); SBAR();
  pv_d0(o, vb0, pa0, pa1, pa2, pa3); partialSM(pB0, pB1, m_reg, mnB, alB);
  __syncthreads(); RESC(alB);
  finishSM(pB0, pB1, alB, l_reg, pa0, pa1, pa2, pa3); SBAR();
  pv_d0(o, vb0 + (int)SHM_V, pa0, pa1, pa2, pa3);
  const float rl = 1.0f / l_reg;
  if (valid) {
#pragma unroll
    for (int d0 = 0; d0 < 4; ++d0)
#pragma unroll
      for (int g = 0; g < 4; ++g) { u32x2 w; w.x = cvtpk(o[d0][4 * g] * rl, o[d0][4 * g + 1] * rl); w.y = cvtpk(o[d0][4 * g + 2] * rl, o[d0][4 * g + 3] * rl);
        *reinterpret_cast<u32x2*>(Orow + 32 * d0 + 8 * g + 4 * hi) = w; }
    if (hi == 0) *MLrow = make_float2(m_reg, l_reg);
  }
#undef SLOAD
#undef SWRITE
#undef SWAIT
#undef RESC
}

struct ItemCtx { const bf16_t* Q; const bf16_t* K; const bf16_t* V; bf16_t* PO; float2* ML; const unsigned short* lists; };
__device__ __forceinline__ unsigned item_entry(const ItemCtx& C, const __attribute__((address_space(3))) int* D, int k, int rloc) {
  const int own = D[4 * k + 1], j = D[4 * k] & 31, cnt = D[4 * k + 3];
  if (own) return (unsigned)(256 * j + rloc) | (3u << 13);
  return (unsigned)C.lists[(size_t)(unsigned)D[4 * k + 2] + (rloc < cnt ? rloc : 0)];
}
__device__ __forceinline__ void attn_items(const ItemCtx& C, const __attribute__((address_space(3))) int* D, int nloc, char* lds) {
  if (nloc <= 0) return;
  const int tid = threadIdx.x, wid = tid >> 6, lane = tid & 63, r32 = lane & 31, hi = lane >> 5, rloc = 32 * wid + r32;
  char* V_lds = lds; char* K_lds = lds + 2 * SHM_V;
  const int sr = tid >> 4, sc = (tid & 15) * 8, vst0 = v_st(sr, sc), vst1 = v_st(32 + sr, sc);
  const int vb0 = (int)(uintptr_t)V_lds + v_rd_base(lane);
  struct { bf16x8 vs0, vs1, ks0, ks1; } sr_[2];
  bf16x8 qr[8];
#define KVBASE(k, Kh, Vh) const bf16_t* Kh; const bf16_t* Vh; { const int bhj_ = D[4 * (k)], bh_ = bhj_ >> 5, j_ = bhj_ & 31; \
    const size_t off_ = ((size_t)(bh_ >> 4) * 8192 + 256 * j_) * LDK + (bh_ & 15) * D_; Kh = C.K + off_; Vh = C.V + off_; }
#define SLOADP(i, Kh, Vh, k0) do { sr_[i].vs0 = *reinterpret_cast<const bf16x8*>(&Vh[(long)((k0) + sr) * LDK + sc]); sr_[i].vs1 = *reinterpret_cast<const bf16x8*>(&Vh[(long)((k0) + 32 + sr) * LDK + sc]); \
    sr_[i].ks0 = *reinterpret_cast<const bf16x8*>(&Kh[(long)((k0) + sr) * LDK + sc]); sr_[i].ks1 = *reinterpret_cast<const bf16x8*>(&Kh[(long)((k0) + 32 + sr) * LDK + sc]); } while (0)
#define SWRITE(b, i) do { *(bf16x8*)(V_lds + (b) * SHM_V + vst0) = sr_[i].vs0;          \
    *(bf16x8*)(V_lds + (b) * SHM_V + vst1) = sr_[i].vs1; int kc = sc * 2;               \
    *(bf16x8*)(K_lds + (b) * SHM_K + KSWZ(sr, kc)) = sr_[i].ks0;                       \
    *(bf16x8*)(K_lds + (b) * SHM_K + KSWZ(32 + sr, kc)) = sr_[i].ks1; } while (0)
#define QLOAD(e, k) do { const int bh_ = D[4 * (k)] >> 5; const bf16_t* Qw_ = C.Q + ((size_t)(bh_ >> 4) * 8192 + ((e) & 8191u)) * LDQ + (bh_ & 15) * D_ + hi * 8; \
    _Pragma("unroll") for (int d0 = 0; d0 < 8; ++d0) qr[d0] = *reinterpret_cast<const bf16x8*>(Qw_ + d0 * 16); } while (0)
#define RESC(a) do { if (__any((a) < 1.f)) { _Pragma("unroll") for (int d = 0; d < 4; ++d) _Pragma("unroll") for (int r = 0; r < 16; ++r) o[d][r] *= (a); } } while (0)
  constexpr int D_ = 128, SE = 0, SO = 1;
  unsigned e_cur = item_entry(C, D, 0, rloc), e_nxt = (nloc > 1) ? item_entry(C, D, 1, rloc) : 0u;
  { KVBASE(0, Kh, Vh); SLOADP(SE, Kh, Vh, 0); SLOADP(SO, Kh, Vh, KVBLK); }
  QLOAD(e_cur, 0);
  for (int k = 0; k < nloc; ++k) {
    const bool has_next = (k + 1 < nloc);
    const bool causal = D[4 * k + 1] != 0; const int cnt = D[4 * k + 3];
    KVBASE(k, Kh, Vh);
    float m_reg = -1e30f, l_reg = 0; f32x16 o[4] = {};
    f32x16 pA0, pA1, pB0, pB1; float mnA, mnB, alA, alB; bf16x8 pa0, pa1, pa2, pa3;
    asm volatile("s_waitcnt vmcnt(0)" ::: "memory"); SWRITE(0, SE); __syncthreads();
    qkt(pA0, pA1, K_lds, qr, r32, hi); if (causal) cmask(pA0, pA1, 0, rloc, hi); partialSM(pA0, pA1, m_reg, mnA, alA);
    SLOADP(SE, Kh, Vh, 2 * KVBLK);
    SWRITE(1, SO); __syncthreads();
    SLOADP(SO, Kh, Vh, 3 * KVBLK);
    SBAR(); qkt(pB0, pB1, K_lds + SHM_K, qr, r32, hi); if (causal) cmask(pB0, pB1, 1, rloc, hi);
    finishSM(pA0, pA1, alA, l_reg, pa0, pa1, pa2, pa3); SBAR();
    pv_d0(o, vb0, pa0, pa1, pa2, pa3); partialSM(pB0, pB1, m_reg, mnB, alB);
    __syncthreads(); asm volatile("s_waitcnt vmcnt(4)" ::: "memory"); SWRITE(0, SE);
    RESC(alB); __syncthreads();
    if (has_next) { KVBASE(k + 1, Kn, Vn); SLOADP(SE, Kn, Vn, 0); }
    SBAR(); qkt(pA0, pA1, K_lds, qr, r32, hi); if (causal) cmask(pA0, pA1, 2, rloc, hi);
    finishSM(pB0, pB1, alB, l_reg, pa0, pa1, pa2, pa3); SBAR();
    pv_d0(o, vb0 + (int)SHM_V, pa0, pa1, pa2, pa3); partialSM(pA0, pA1, m_reg, mnA, alA);
    __syncthreads(); SWRITE(1, SO);
    RESC(alA); __syncthreads();
    if (has_next) { KVBASE(k + 1, Kn, Vn); SLOADP(SO, Kn, Vn, KVBLK); }
    SBAR(); qkt(pB0, pB1, K_lds + SHM_K, qr, r32, hi); if (causal) cmask(pB0, pB1, 3, rloc, hi);
    SBAR();
    if (has_next) QLOAD(e_nxt, k + 1);
    finishSM(pA0, pA1, alA, l_reg, pa0, pa1, pa2, pa3); SBAR();
    pv_d0(o, vb0, pa0, pa1, pa2, pa3); partialSM(pB0, pB1, m_reg, mnB, alB);
    __syncthreads(); RESC(alB);
    finishSM(pB0, pB1, alB, l_reg, pa0, pa1, pa2, pa3); SBAR();
    pv_d0(o, vb0 + (int)SHM_V, pa0, pa1, pa2, pa3);
    { const float rl = 1.0f / l_reg; const int bh = D[4 * k] >> 5; const unsigned t = e_cur & 8191u, slot = e_cur >> 13;
      if (rloc < cnt) {
        bf16_t* Orow = C.PO + (((size_t)slot * 32 + bh) * 8192 + t) * D_;
#pragma unroll
        for (int d0 = 0; d0 < 4; ++d0)
#pragma unroll
          for (int g = 0; g < 4; ++g) { u32x2 w; w.x = cvtpk(o[d0][4 * g] * rl, o[d0][4 * g + 1] * rl); w.y = cvtpk(o[d0][4 * g + 2] * rl, o[d0][4 * g + 3] * rl);
            *reinterpret_cast<u32x2*>(Orow + 32 * d0 + 8 * g + 4 * hi) = w; }
        if (hi == 0) C.ML[((size_t)slot * 32 + bh) * 8192 + t] = make_float2(m_reg, l_reg);
      } }
    e_cur = e_nxt; if (k + 2 < nloc) e_nxt = item_entry(C, D, k + 2, rloc);
  }
#undef KVBASE
#undef SLOADP
#undef SWRITE
#undef QLOAD
#undef RESC
}
#undef KSWZ
#undef SBAR
}

constexpr int NWAVES = 8;
#ifndef MK_N_LAUNCHES
#define MK_N_LAUNCHES 1
#endif
constexpr int N_PHASES = 16;
constexpr int N_LAUNCHES = MK_N_LAUNCHES;

constexpr int BATCH = 2, SEQ = 8192, DM = 4096, M = BATCH * SEQ, MEMLEN = 256;
constexpr int PW = 2048, AW = 2048, NH = 16, HD = 128, NBLK = 32, MIXIN = 8192, FF = 11008, XH = 4, XHD = 1024;
constexpr float LN_EPS = 1e-5f;
constexpr float DN_ALPHA = 1.189207115002721f;

constexpr size_t MiB = 1u << 20;
constexpr size_t WS_CTL = 0, CTL_ZERO_BYTES = 1 * MiB;
constexpr size_t WS_ROPE = 1 * MiB;
constexpr size_t WS_KMH = 5 * MiB, WS_KML = 5 * MiB + 512 * 1024;
constexpr size_t WS_MEMB = 6 * MiB;
constexpr size_t WS_KVX = 10 * MiB;
constexpr size_t WS_LIST = 18 * MiB;
constexpr size_t WS_ML = 26 * MiB;
constexpr size_t WS_WIN = 34 * MiB, WS_WPOOL = 98 * MiB, WS_WOUT = 100 * MiB, WS_WXQ = 132 * MiB, WS_WXKV = 164 * MiB, WS_WXO = 228 * MiB, WS_WGU = 260 * MiB, WS_WDN = 432 * MiB;
constexpr size_t WS_ACT = 518 * MiB;
constexpr size_t WS_HP = WS_ACT, WS_Q = WS_ACT + 64 * MiB, WS_K = WS_ACT + 128 * MiB, WS_V = WS_ACT + 192 * MiB;
constexpr size_t WS_XB = WS_ACT + 256 * MiB;
constexpr size_t WS_PARTO = WS_ACT + 256 * MiB;
constexpr size_t WS_CAT = WS_ACT + 512 * MiB;
constexpr size_t WS_TB = WS_ACT;
constexpr size_t WS_HB = WS_ACT + 128 * MiB;
constexpr size_t WS_PB = WS_ACT + 256 * MiB;
constexpr size_t WS_G = WS_ACT + 256 * MiB;
constexpr size_t WS_SLAB = WS_ACT + 384 * MiB;
constexpr size_t WS_WQK = WS_ACT + 640 * MiB, WS_WVOT = WS_ACT + 656 * MiB;
constexpr size_t WS_WOUT2 = WS_ACT + 672 * MiB;
constexpr size_t WS_STATS = WS_ML;
constexpr size_t WS_END = WS_ACT + 704 * MiB;
static_assert(WS_WDN + (size_t)DM * FF * 2 <= WS_ACT && WS_G + (size_t)M * FF * 2 <= WS_END && WS_WGU + (size_t)2 * FF * DM * 2 <= WS_WDN, "d_ws map");
constexpr int LIST_STRIDE = 256 * 496;
__host__ __device__ constexpr int list_off(int j) { return 256 * (31 * j - (j * (j - 1)) / 2); }
constexpr int CW_TMO = 0, CW_CODE = 1;
constexpr int CW_BAR = 4096;
constexpr int CW_GCNT = 8192;
constexpr int CW_CHK = 16384;

constexpr int RING_OFF = 0, RING_BYTES = 131072;
constexpr int LDSCTL_OFF = RING_BYTES, MISC_OFF = LDSCTL_OFF + 320;
constexpr int LDS_BYTES = 147456;

#define GAS __attribute__((address_space(1)))
#define LAS __attribute__((address_space(3)))
typedef unsigned short bf16;
typedef unsigned v4u __attribute__((ext_vector_type(4)));
typedef unsigned v2u __attribute__((ext_vector_type(2)));
typedef float f32x4 __attribute__((ext_vector_type(4)));
typedef short bf16x8 __attribute__((ext_vector_type(8)));
typedef float f32x16 __attribute__((ext_vector_type(16)));
typedef GAS unsigned gu32;
#define RLX_AGENT __ATOMIC_RELAXED, __HIP_MEMORY_SCOPE_AGENT
#define LDS_WAIT() asm volatile("s_waitcnt lgkmcnt(0)" ::: "memory")
#define VM_WAIT() asm volatile("s_waitcnt vmcnt(0)" ::: "memory")
__device__ __forceinline__ unsigned f2bf(float f) { unsigned u = __builtin_bit_cast(unsigned, f); return (u + 0x7fffu + ((u >> 16) & 1u)) >> 16; }
__device__ __forceinline__ unsigned pk2(float lo, float hi) { return f2bf(lo) | (f2bf(hi) << 16); }
__device__ __forceinline__ float bf_lo(unsigned w) { return __builtin_bit_cast(float, w << 16); }
__device__ __forceinline__ float bf_hi(unsigned w) { return __builtin_bit_cast(float, w & 0xffff0000u); }
__device__ __forceinline__ float bf2f(bf16 b) { return __builtin_bit_cast(float, ((unsigned)b) << 16); }
#define XB_TMO      128
#define XB_XCNT(j)  (256  + 64 * (j))
#define XB_XSUB(j)  (1280 + 64 * (j))
#define XB_XGEN(j)  (2304 + 64 * (j))
#define XB_TOP      3328
#define XB_TOPGEN   3392
#define XCD_BAR_WORDS 3456
#define XB_SPIN_CAP (1u << 18)

__device__ __forceinline__ unsigned xb_ld(unsigned* p)              { return __hip_atomic_load(p, __ATOMIC_RELAXED, __HIP_MEMORY_SCOPE_AGENT); }
__device__ __forceinline__ unsigned xb_add(unsigned* p, unsigned v) { return __hip_atomic_fetch_add(p, v, __ATOMIC_RELAXED, __HIP_MEMORY_SCOPE_AGENT); }
__device__ __forceinline__ unsigned xb_xcc_id() { return (unsigned)__builtin_amdgcn_s_getreg((3 << 11) | 20) & 0xFu; }
#define XB_SPIN(cond, bar) do { unsigned _sp = 0; while (cond) { __builtin_amdgcn_s_sleep(1); \
    if ((++_sp & 255u) == 0u) { if (xb_ld(&(bar)[XB_TMO])) break; if (_sp > XB_SPIN_CAP) { atomicAdd(&(bar)[XB_TMO], 1u); break; } } } } while (0)

struct XcdBarrier {
    unsigned* bar; unsigned x;
    volatile LAS unsigned* st;
};

__device__ __forceinline__ XcdBarrier xcd_barrier_post(unsigned* bar, volatile LAS unsigned* st) {
    XcdBarrier b; b.bar = bar; b.x = xb_xcc_id(); b.st = st;
    if (threadIdx.x == 0) (void)xb_add(&bar[XB_XCNT(b.x)], 1u);
    return b;
}
__device__ __forceinline__ void xcd_barrier_complete(unsigned* bar, unsigned x, unsigned& nloc, unsigned& nx) {
    const unsigned G = gridDim.x * gridDim.y * gridDim.z;
    unsigned sum, cnt, mine, sp = 0u;
    for (;;) {
        sum = 0u; cnt = 0u; mine = 0u;
#pragma unroll
        for (unsigned j = 0; j < 16; ++j) { const unsigned c = xb_ld(&bar[XB_XCNT(j)]); sum += c; cnt += (c > 0u) ? 1u : 0u; mine = (j == x) ? c : mine; }
        if (sum == G) break;
        __builtin_amdgcn_s_sleep(1);
        if ((++sp & 255u) == 0u) { if (xb_ld(&bar[XB_TMO])) break; if (sp > XB_SPIN_CAP) { atomicAdd(&bar[XB_TMO], 1u); break; } }
    }
    nloc = mine > 0u ? mine : 1u; nx = cnt > 0u ? cnt : 1u;
}

__device__ __forceinline__ void xcd_barrier(const XcdBarrier& b) {
    asm volatile("s_waitcnt vmcnt(0)" ::: "memory");
    __syncthreads();
    if (threadIdx.x == 0) {
        unsigned* bar = b.bar;
        __builtin_amdgcn_s_waitcnt(0);
        unsigned nloc = b.st[0], nx = b.st[1];
        if (nloc == 0u) { xcd_barrier_complete(bar, b.x, nloc, nx); b.st[0] = nloc; b.st[1] = nx; }
        const unsigned old = xb_add(&bar[XB_XSUB(b.x)], 1u);
        const unsigned gen = old / nloc;
        if (old + 1u == (gen + 1u) * nloc) {
            __builtin_amdgcn_fence(__ATOMIC_RELEASE, "agent");
            asm volatile("s_waitcnt vmcnt(0)" ::: "memory");
            const unsigned og = xb_add(&bar[XB_TOP], 1u);
            const unsigned tg = og / nx;
            if (og + 1u == (tg + 1u) * nx) xb_add(&bar[XB_TOPGEN], 1u);
            else XB_SPIN(xb_ld(&bar[XB_TOPGEN]) == tg, bar);
            __builtin_amdgcn_fence(__ATOMIC_ACQUIRE, "agent");
            xb_add(&bar[XB_XGEN(b.x)], 1u);
            asm volatile("s_waitcnt vmcnt(0)" ::: "memory");
        } else {
            XB_SPIN(xb_ld(&bar[XB_XGEN(b.x)]) == gen, bar);
            __builtin_amdgcn_fence(__ATOMIC_ACQUIRE, "agent");
            asm volatile("s_waitcnt vmcnt(0)" ::: "memory");
        }
    }
    __syncthreads();
}

struct Frame {
    LAS unsigned char* lds;
    volatile LAS unsigned* MISC;
    gu32* ctl;
    int tid, lane, wave;
    int G;
    unsigned char* ws;
};
__device__ __forceinline__ float wave_sum(float v) {
#pragma unroll
    for (int o = 1; o < 64; o <<= 1) v += __shfl_xor(v, o);
    return v;
}

template <class RowMap>
__device__ __forceinline__ void p0_transpose_item(const float* W, int K, int N, bf16* WT, LAS float* scr, int item, int lane, const RowMap& rm, const float* colscale) {
    const int nblk = N / 32, kb = item / nblk, nb = item % nblk, k0 = 64 * kb, n0 = 32 * nb;
    float ld[32];
    const float* src = W + (size_t)(k0 + (lane >> 5)) * N + n0 + (lane & 31);
#pragma unroll
    for (int i = 0; i < 32; ++i) ld[i] = *(const GAS float*)(src + (size_t)(2 * i) * N);
#pragma unroll
    for (int i = 0; i < 32; ++i) scr[(2 * i + (lane >> 5)) * 33 + (lane & 31)] = ld[i];
    LDS_WAIT(); asm volatile("" ::: "memory");
    const int c = lane & 7;
#pragma unroll
    for (int j = 0; j < 4; ++j) { const int n = (lane >> 3) + 8 * j; const LAS float* s = scr + (8 * c) * 33 + n; const float sc = colscale ? colscale[n0 + n] : 1.0f;
        v4u o; o.x = pk2(s[0 * 33] * sc, s[1 * 33] * sc); o.y = pk2(s[2 * 33] * sc, s[3 * 33] * sc); o.z = pk2(s[4 * 33] * sc, s[5 * 33] * sc); o.w = pk2(s[6 * 33] * sc, s[7 * 33] * sc);
        *(GAS v4u*)(WT + (size_t)rm(n0 + n) * K + k0 + 8 * c) = o; }
    LDS_WAIT(); asm volatile("" ::: "memory");
}
struct RmIdent { int off; __device__ __forceinline__ int operator()(int n) const { return off + n; } };
struct RmMixIn { __device__ __forceinline__ int operator()(int n) const { if (n < 2048 || n >= 6144) return n; const int d = n & 127; return (n & ~127) + 2 * (d & 63) + (d >> 6); } };
struct RmGateUp { int up; __device__ __forceinline__ int operator()(int n) const { return (n >> 7) * 256 + up * 128 + (n & 127); } };

__device__ __forceinline__ void sincos_d(double a, double& s, double& c) {
    const double n = __builtin_rint(a * 0.63661977236758134308);
    double r = __builtin_fma(-n, 1.5707963267948966, a); r = __builtin_fma(-n, 6.123233995736766e-17, r);
    const double r2 = r * r;
    double ps = -7.6471637318198164759e-13; ps = ps * r2 + 1.6059043836821614599e-10; ps = ps * r2 - 2.5052108385441718775e-08; ps = ps * r2 + 2.7557319223985890653e-06;
    ps = ps * r2 - 1.9841269841269841270e-04; ps = ps * r2 + 8.3333333333333333333e-03; ps = ps * r2 - 1.6666666666666666667e-01; ps = r + r * r2 * ps;
    double pc = 4.7794773323873852974e-14; pc = pc * r2 - 1.1470745597729724714e-11; pc = pc * r2 + 2.0876756987868098979e-09; pc = pc * r2 - 2.7557319223985890653e-07;
    pc = pc * r2 + 2.4801587301587301587e-05; pc = pc * r2 - 1.3888888888888888889e-03; pc = pc * r2 + 4.1666666666666666667e-02; pc = pc * r2 - 0.5; pc = 1.0 + r2 * pc;
    const int q = ((int)n) & 3;
    s = (q == 0) ? ps : (q == 1) ? pc : (q == 2) ? -ps : -pc;
    c = (q == 0) ? pc : (q == 1) ? -ps : (q == 2) ? -pc : ps;
}
__device__ __forceinline__ float rope_inv(int i) {
    const double y = -(double)i * (13.287712379549449 / 64.0); const double fl = __builtin_floor(y); const double z = (y - fl) * 0.69314718055994530942;
    double e = 1.0, term = 1.0;
#pragma unroll
    for (int k = 1; k <= 20; ++k) { term = term * z / (double)k; e += term; }
    return (float)__builtin_ldexp(e, (int)fl);
}

__device__ __forceinline__ void p0_prologue(Frame& F, const float* const* in) {
    LAS float* scr = (LAS float*)(F.lds + RING_OFF + F.wave * 16384);
    const int gw = blockIdx.x * NWAVES + F.wave, NGW = F.G * NWAVES;
    const float* w_mix_in = in[2]; const float* w_pool = in[3]; const float* pool_scale = in[4]; const float* w_mix_out = in[5];
    const float* w_xq = in[8]; const float* w_xkv = in[9]; const float* w_xo = in[10]; const float* w_gate = in[13]; const float* w_up = in[14]; const float* w_down = in[15];
    bf16* WIN = (bf16*)(F.ws + WS_WIN); bf16* WPOOL = (bf16*)(F.ws + WS_WPOOL); bf16* WOUT = (bf16*)(F.ws + WS_WOUT); bf16* WXQ = (bf16*)(F.ws + WS_WXQ);
    bf16* WXKV = (bf16*)(F.ws + WS_WXKV); bf16* WXO = (bf16*)(F.ws + WS_WXO); bf16* WGU = (bf16*)(F.ws + WS_WGU); bf16* WDN = (bf16*)(F.ws + WS_WDN);
    constexpr int I_IN = (DM / 64) * (MIXIN / 32), I_POOL = (512 / 64) * (512 / 32), I_SQ = (DM / 64) * (DM / 32), I_KV = (DM / 64) * (2 * DM / 32), I_GU = (DM / 64) * (FF / 32), I_DN = (FF / 64) * (DM / 32);
    constexpr int NITEMS = I_IN + 2 * I_SQ + I_KV + 2 * I_GU;
    for (int it = gw; it < NITEMS; it += NGW) {
        int r = it;
        if (r < I_IN) { p0_transpose_item(w_mix_in, DM, MIXIN, WIN, scr, r, F.lane, RmMixIn{}, nullptr); continue; } r -= I_IN;
        if (r < I_SQ) { const int kb = r / (DM / 32);
            if (kb < 32) p0_transpose_item(w_mix_out, 2048, DM, WOUT, scr, r, F.lane, RmIdent{0}, nullptr);
            else p0_transpose_item(w_mix_out, DM, DM, (bf16*)(F.ws + WS_WOUT2), scr, r, F.lane, RmIdent{0}, nullptr); continue; } r -= I_SQ;
        if (r < I_KV) { p0_transpose_item(w_xkv, DM, 2 * DM, WXKV, scr, r, F.lane, RmIdent{0}, nullptr); continue; } r -= I_KV;
        if (r < I_SQ) { p0_transpose_item(w_xo, DM, DM, WXO, scr, r, F.lane, RmIdent{0}, nullptr); continue; } r -= I_SQ;
        if (r < I_GU) { p0_transpose_item(w_gate, DM, FF, WGU, scr, r, F.lane, RmGateUp{0}, nullptr); continue; } r -= I_GU;
        p0_transpose_item(w_up, DM, FF, WGU, scr, r, F.lane, RmGateUp{1}, nullptr);
    }
    const size_t gt = (size_t)blockIdx.x * (NWAVES * 64) + F.tid, NT = (size_t)F.G * NWAVES * 64;
    { const float* x = in[0]; bf16* XB = (bf16*)(F.ws + WS_XB);
      for (size_t i = gt; i < (size_t)M * DM / 8; i += NT) { const f32x4 a = *(const GAS f32x4*)(x + i * 8), b = *(const GAS f32x4*)(x + i * 8 + 4);
          v4u o; o.x = pk2(a.x, a.y); o.y = pk2(a.z, a.w); o.z = pk2(b.x, b.y); o.w = pk2(b.z, b.w); *(GAS v4u*)(XB + i * 8) = o; } }
    { const float* x = w_xq; bf16* XB = WXQ;
      for (size_t i = gt; i < (size_t)DM * DM / 8; i += NT) { const f32x4 a = *(const GAS f32x4*)(x + i * 8), b = *(const GAS f32x4*)(x + i * 8 + 4);
          v4u o; o.x = pk2(a.x, a.y); o.y = pk2(a.z, a.w); o.z = pk2(b.x, b.y); o.w = pk2(b.z, b.w); *(GAS v4u*)(XB + i * 8) = o; } }
    { bf16* WPR = WPOOL;
      for (size_t i = gt; i < (size_t)4 * 512 * 512 / 8; i += NT) { const size_t e = i * 8; const int d = (int)(e & 511), g = (int)(e >> 18);
          const f32x4 a = *(const GAS f32x4*)(w_pool + e), b = *(const GAS f32x4*)(w_pool + e + 4), s0 = *(const GAS f32x4*)(pool_scale + g * 512 + d), s1 = *(const GAS f32x4*)(pool_scale + g * 512 + d + 4);
          v4u o; o.x = pk2(a.x * s0.x, a.y * s0.y); o.y = pk2(a.z * s0.z, a.w * s0.w); o.z = pk2(b.x * s1.x, b.y * s1.y); o.w = pk2(b.z * s1.z, b.w * s1.w); *(GAS v4u*)(WPR + e) = o; } }
    { const float* x = in[1]; bf16* XB = (bf16*)(F.ws + WS_MEMB);
      for (size_t i = gt; i < (size_t)BATCH * MEMLEN * DM / 8; i += NT) { const f32x4 a = *(const GAS f32x4*)(x + i * 8), b = *(const GAS f32x4*)(x + i * 8 + 4);
          v4u o; o.x = pk2(a.x, a.y); o.y = pk2(a.z, a.w); o.z = pk2(b.x, b.y); o.w = pk2(b.z, b.w); *(GAS v4u*)(XB + i * 8) = o; } }
    { float2* tab = (float2*)(F.ws + WS_ROPE);
      for (size_t i = gt; i < (size_t)SEQ * 64; i += NT) { const int pos = (int)(i >> 6), fi = (int)(i & 63); const float ang = (float)pos * rope_inv(fi);
          double s, c; sincos_d((double)ang, s, c); tab[i] = make_float2((float)c, (float)s); } }
}

__device__ __forceinline__ void convert_wdown(Frame& F, const float* w_down, int rk, int nwg) {
    LAS float* scr = (LAS float*)(F.lds + RING_OFF + F.wave * 16384); bf16* WDN = (bf16*)(F.ws + WS_WDN);
    constexpr int I_DN = (FF / 64) * (DM / 32);
    for (int it = rk * NWAVES + F.wave; it < I_DN; it += nwg * NWAVES) p0_transpose_item(w_down, FF, DM, WDN, scr, it, F.lane, RmIdent{0}, nullptr);
}

template <bool FINAL>
__device__ __forceinline__ void ln_rows(Frame& F, const bf16* T, bf16* XB, float2* stats, float* OUT, const float* g, const float* b) {
    constexpr int NR = 2;
    const int gw = blockIdx.x * NWAVES + F.wave, NGW = F.G * NWAVES;
    for (int mb = gw; mb < M; mb += NR * NGW) {
        int mr[NR]; v4u r[NR][8];
#pragma unroll
        for (int i = 0; i < NR; ++i) { mr[i] = (mb + i * NGW < M) ? mb + i * NGW : mb;
            const GAS v4u* tr = (const GAS v4u*)(T + (size_t)mr[i] * DM) + F.lane;
#pragma unroll
            for (int j = 0; j < 8; ++j) r[i][j] = tr[64 * j]; }
        float mean[NR], rstd[NR];
#pragma unroll
        for (int i = 0; i < NR; ++i) { float s = 0.f;
#pragma unroll
            for (int j = 0; j < 8; ++j) s += ((bf_lo(r[i][j].x) + bf_hi(r[i][j].x)) + (bf_lo(r[i][j].y) + bf_hi(r[i][j].y))) + ((bf_lo(r[i][j].z) + bf_hi(r[i][j].z)) + (bf_lo(r[i][j].w) + bf_hi(r[i][j].w)));
            mean[i] = wave_sum(s) * (1.f / DM); }
#pragma unroll
        for (int i = 0; i < NR; ++i) { float q = 0.f; const float mu = mean[i];
#pragma unroll
            for (int j = 0; j < 8; ++j) { float d;
                d = bf_lo(r[i][j].x) - mu; q += d * d; d = bf_hi(r[i][j].x) - mu; q += d * d; d = bf_lo(r[i][j].y) - mu; q += d * d; d = bf_hi(r[i][j].y) - mu; q += d * d;
                d = bf_lo(r[i][j].z) - mu; q += d * d; d = bf_hi(r[i][j].z) - mu; q += d * d; d = bf_lo(r[i][j].w) - mu; q += d * d; d = bf_hi(r[i][j].w) - mu; q += d * d; }
            rstd[i] = 1.f / sqrtf(wave_sum(q) * (1.f / DM) + LN_EPS); }
        if (!FINAL && F.lane == 0) {
#pragma unroll
            for (int i = 0; i < NR; ++i) stats[mr[i]] = make_float2(mean[i], rstd[i]); }
#pragma unroll
        for (int j = 0; j < 8; ++j) { const int c = (64 * j + F.lane) * 8;
            const f32x4 g0 = *(const GAS f32x4*)(g + c), g1 = *(const GAS f32x4*)(g + c + 4), b0 = *(const GAS f32x4*)(b + c), b1 = *(const GAS f32x4*)(b + c + 4);
#pragma unroll
            for (int i = 0; i < NR; ++i) { const float mu = mean[i], rs = rstd[i];
                const f32x4 ya = ((f32x4){bf_lo(r[i][j].x), bf_hi(r[i][j].x), bf_lo(r[i][j].y), bf_hi(r[i][j].y)} - mu) * rs * g0 + b0;
                const f32x4 yb = ((f32x4){bf_lo(r[i][j].z), bf_hi(r[i][j].z), bf_lo(r[i][j].w), bf_hi(r[i][j].w)} - mu) * rs * g1 + b1;
                if (FINAL) { __builtin_nontemporal_store(ya, (GAS f32x4*)(OUT + (size_t)mr[i] * DM + c)); __builtin_nontemporal_store(yb, (GAS f32x4*)(OUT + (size_t)mr[i] * DM + c + 4)); }
                else { v4u o; o.x = pk2(ya.x, ya.y); o.y = pk2(ya.z, ya.w); o.z = pk2(yb.x, yb.y); o.w = pk2(yb.z, yb.w); *(GAS v4u*)(XB + (size_t)mr[i] * DM + c) = o; } } }
    }
}

__device__ __forceinline__ void up8(const v4u& r, float (&f)[8]) { f[0] = bf_lo(r.x); f[1] = bf_hi(r.x); f[2] = bf_lo(r.y); f[3] = bf_hi(r.y); f[4] = bf_lo(r.z); f[5] = bf_hi(r.z); f[6] = bf_lo(r.w); f[7] = bf_hi(r.w); }
template <int W>
__device__ __forceinline__ void pool_run(const bf16* HP, bf16* PMo, int t0, int c) {
    const int tp0 = t0 & (SEQ - 1);
    v4u raw[16 + W - 1];
#pragma unroll
    for (int j = 0; j < 16 + W - 1; ++j) { const int dt = j - (W - 1); raw[j] = (v4u){0u, 0u, 0u, 0u}; if (tp0 + dt >= 0) raw[j] = *(const GAS v4u*)(HP + (size_t)(t0 + dt) * PW + c); }
    float S[8], u[8];
#pragma unroll
    for (int e = 0; e < 8; ++e) S[e] = 0.f;
#pragma unroll
    for (int j = 0; j < W - 1; ++j) { up8(raw[j], u);
#pragma unroll
        for (int e = 0; e < 8; ++e) S[e] += u[e]; }
#pragma unroll
    for (int i = 0; i < 16; ++i) {
        up8(raw[W - 1 + i], u);
#pragma unroll
        for (int e = 0; e < 8; ++e) S[e] += u[e];
        const int tp = tp0 + i; const float inv = (tp + 1 < W) ? 1.0f / (float)(tp + 1) : 1.0f / (float)W;
        v4u o; o.x = pk2(S[0] * inv - u[0], S[1] * inv - u[1]); o.y = pk2(S[2] * inv - u[2], S[3] * inv - u[3]);
        o.z = pk2(S[4] * inv - u[4], S[5] * inv - u[5]); o.w = pk2(S[6] * inv - u[6], S[7] * inv - u[7]);
        *(GAS v4u*)(PMo + (size_t)(t0 + i) * DM + c) = o;
        float d[8]; up8(raw[i], d);
#pragma unroll
        for (int e = 0; e < 8; ++e) S[e] -= d[e];
    }
}
__device__ __forceinline__ void pool_ew(Frame& F) {
    const bf16* HP = (const bf16*)(F.ws + WS_HP); bf16* PMo = (bf16*)(F.ws + WS_CAT);
    const size_t gt = (size_t)blockIdx.x * (NWAVES * 64) + F.tid, NT = (size_t)F.G * NWAVES * 64;
    for (size_t idx = gt; idx < (size_t)(M / 16) * 256; idx += NT) {
        const int t0 = (int)(idx >> 8) * 16, c = (int)(idx & 255) * 8, grp = __builtin_amdgcn_readfirstlane(c >> 9);
        if (grp == 0) pool_run<2>(HP, PMo, t0, c); else if (grp == 1) pool_run<4>(HP, PMo, t0, c); else if (grp == 2) pool_run<8>(HP, PMo, t0, c); else pool_run<16>(HP, PMo, t0, c);
    }
}
__device__ __forceinline__ void kv_reduce(Frame& F) {
    const float* SK = (const float*)(F.ws + WS_SLAB); bf16* KVX = (bf16*)(F.ws + WS_KVX);
    const size_t gt = (size_t)blockIdx.x * (NWAVES * 64) + F.tid, NT = (size_t)F.G * NWAVES * 64, NE = (size_t)512 * 8192;
    for (size_t i = gt; i < NE / 4; i += NT) { const float* sb = SK + i * 4;
        const f32x4 a = *(const GAS f32x4*)sb + *(const GAS f32x4*)(sb + NE) + *(const GAS f32x4*)(sb + 2 * NE) + *(const GAS f32x4*)(sb + 3 * NE);
        v2u o; o.x = pk2(a.x, a.y); o.y = pk2(a.z, a.w); *(GAS v2u*)(KVX + i * 4) = o; }
}

__device__ __forceinline__ void kmean_phase(Frame& F) {
    const bf16* Kb = (const bf16*)(F.ws + WS_K); bf16* KMH = (bf16*)(F.ws + WS_KMH); bf16* KML = (bf16*)(F.ws + WS_KML);
    LAS float* part = (LAS float*)(F.lds + RING_OFF);
    for (int item = blockIdx.x; item < 64 * 4; item += F.G) {
        const int bn = item >> 2, chunk = item & 3;
        float acc[8];
#pragma unroll
        for (int e = 0; e < 8; ++e) acc[e] = 0.f;
        const bf16* base = Kb + (size_t)(bn * 256 + F.wave * 32) * AW + chunk * 512 + F.lane * 8;
#pragma unroll
        for (int r = 0; r < 32; ++r) { const v4u q = *(const GAS v4u*)(base + (size_t)r * AW);
            acc[0] += bf_lo(q.x); acc[1] += bf_hi(q.x); acc[2] += bf_lo(q.y); acc[3] += bf_hi(q.y); acc[4] += bf_lo(q.z); acc[5] += bf_hi(q.z); acc[6] += bf_lo(q.w); acc[7] += bf_hi(q.w); }
#pragma unroll
        for (int e = 0; e < 8; ++e) part[F.wave * 512 + F.lane * 8 + e] = acc[e];
        __syncthreads();
        { float s = 0.f;
#pragma unroll
          for (int w = 0; w < 8; ++w) s += part[w * 512 + F.tid];
          const float mean = s * (1.0f / 256.0f); const unsigned hb = f2bf(mean); const float hf = __builtin_bit_cast(float, hb << 16);
          KMH[(size_t)bn * AW + chunk * 512 + F.tid] = (bf16)hb; KML[(size_t)bn * AW + chunk * 512 + F.tid] = (bf16)f2bf(mean - hf); }
        __syncthreads();
    }
}

__device__ __forceinline__ void gate_phase(Frame& F) {
    const bf16* Qb = (const bf16*)(F.ws + WS_Q); const bf16* KMH = (const bf16*)(F.ws + WS_KMH); const bf16* KML = (const bf16*)(F.ws + WS_KML);
    unsigned short* lists = (unsigned short*)(F.ws + WS_LIST); gu32* gcnt = F.ctl + CW_GCNT;
    LAS float* gl = (LAS float*)(F.lds + RING_OFF);
    LAS unsigned* lcnt = (LAS unsigned*)(F.lds + RING_OFF + 34816);
    LAS unsigned* gb = lcnt + 32;
    const int r32 = F.lane & 31, hi = F.lane >> 5;
    for (int uid = blockIdx.x; uid < 1024; uid += F.G) {
        const int bh = uid >> 5, qb = uid & 31, b = bh >> 4, h = bh & 15;
        if (qb == 0) continue;
        if (F.tid < 32) lcnt[F.tid] = 0u;
        const size_t trow = (size_t)b * SEQ + 256 * qb + 32 * F.wave + r32;
        f32x16 acc = {};
#pragma unroll
        for (int s = 0; s < 8; ++s) {
            const bf16x8 bq = *(const GAS bf16x8*)(Qb + trow * AW + h * HD + 16 * s + 8 * hi);
            const bf16x8 ah = *(const GAS bf16x8*)(KMH + (size_t)(b * 32 + r32) * AW + h * HD + 16 * s + 8 * hi);
            const bf16x8 al = *(const GAS bf16x8*)(KML + (size_t)(b * 32 + r32) * AW + h * HD + 16 * s + 8 * hi);
            acc = __builtin_amdgcn_mfma_f32_32x32x16_bf16(ah, bq, acc, 0, 0, 0);
            acc = __builtin_amdgcn_mfma_f32_32x32x16_bf16(al, bq, acc, 0, 0, 0);
        }
#pragma unroll
        for (int r = 0; r < 16; ++r) gl[(32 * F.wave + r32) * 33 + att::crow(r, hi)] = acc[r];
        __syncthreads();
        int s0 = 0, s1 = 0, s2 = 0; unsigned p0 = 0, p1 = 0, p2 = 0; const int nsel = qb < 3 ? qb : 3;
        if (F.tid < 256) {
            float v0 = -__builtin_inff(), v1 = v0, v2 = v0;
            for (int n = 0; n < qb; ++n) { const float g = gl[F.tid * 33 + n];
                if (g > v0) { v2 = v1; s2 = s1; v1 = v0; s1 = s0; v0 = g; s0 = n; }
                else if (g > v1) { v2 = v1; s2 = s1; v1 = g; s1 = n; }
                else if (g > v2) { v2 = g; s2 = n; } }
            p0 = __hip_atomic_fetch_add(lcnt + s0, 1u, __ATOMIC_RELAXED, __HIP_MEMORY_SCOPE_WORKGROUP);
            if (nsel > 1) p1 = __hip_atomic_fetch_add(lcnt + s1, 1u, __ATOMIC_RELAXED, __HIP_MEMORY_SCOPE_WORKGROUP);
            if (nsel > 2) p2 = __hip_atomic_fetch_add(lcnt + s2, 1u, __ATOMIC_RELAXED, __HIP_MEMORY_SCOPE_WORKGROUP);
        }
        __syncthreads();
        if (F.tid < 32) { const unsigned c = lcnt[F.tid]; gb[F.tid] = c ? __hip_atomic_fetch_add(gcnt + bh * 32 + F.tid, c, RLX_AGENT) : 0u; }
        __syncthreads();
        if (F.tid < 256) {
            unsigned short* lb = lists + (size_t)bh * LIST_STRIDE; const unsigned tl = (unsigned)(256 * qb + F.tid);
            lb[list_off(s0) + gb[s0] + p0] = (unsigned short)(tl | (0u << 13));
            if (nsel > 1) lb[list_off(s1) + gb[s1] + p1] = (unsigned short)(tl | (1u << 13));
            if (nsel > 2) lb[list_off(s2) + gb[s2] + p2] = (unsigned short)(tl | (2u << 13));
        }
        __syncthreads();
    }
}

__device__ __forceinline__ void attn_phase(Frame& F, char* ldsg) {
    const bf16* Qb = (const bf16*)(F.ws + WS_Q); const bf16* Kb = (const bf16*)(F.ws + WS_K); const bf16* Vb = (const bf16*)(F.ws + WS_V);
    bf16* PO = (bf16*)(F.ws + WS_PARTO); float2* ML = (float2*)(F.ws + WS_ML);
    const unsigned short* lists = (const unsigned short*)(F.ws + WS_LIST); const gu32* gcnt = F.ctl + CW_GCNT;
    LAS int* pre = (LAS int*)(F.lds + RING_OFF + 67584);
    for (int i = F.tid; i < 1024; i += NWAVES * 64) pre[i] = (int)((__hip_atomic_load(gcnt + i, RLX_AGENT) + 255u) >> 8);
    __syncthreads();
    if (F.wave == 0) {
        int loc[16]; int s = 0;
#pragma unroll
        for (int k = 0; k < 16; ++k) { loc[k] = pre[F.lane * 16 + k]; s += loc[k]; }
        int incl = s;
#pragma unroll
        for (int o = 1; o < 64; o <<= 1) { const int v = __shfl_up(incl, o); if (F.lane >= o) incl += v; }
        int run = incl - s;
#pragma unroll
        for (int k = 0; k < 16; ++k) { pre[F.lane * 16 + k] = run; run += loc[k]; }
        if (F.lane == 63) pre[1024] = incl;
    }
    __syncthreads();
    const int total = 1024 + pre[1024];
    LAS int* DSC = (LAS int*)(F.lds + RING_OFF + 67584 + 4224);
    const int nloc = (total > (int)blockIdx.x) ? (total - (int)blockIdx.x + F.G - 1) / F.G : 0;
    if (F.tid < nloc && F.tid < 64) {
        const int id = blockIdx.x + F.tid * F.G; int bhj, own, lpos, cnt;
        if (id < 1024) { bhj = id; own = 1; lpos = 0; cnt = 256; }
        else { const int x = id - 1024; int lo = 0, hi2 = 1023;
            while (lo < hi2) { const int mid = (lo + hi2 + 1) >> 1; if (pre[mid] <= x) lo = mid; else hi2 = mid - 1; }
            const int li = lo, chunk = x - pre[li]; bhj = li; own = 0; lpos = (li >> 5) * LIST_STRIDE + list_off(li & 31) + 256 * chunk;
            const int c = (int)__hip_atomic_load(gcnt + li, RLX_AGENT) - 256 * chunk; cnt = c < 256 ? c : 256; }
        DSC[4 * F.tid] = bhj; DSC[4 * F.tid + 1] = own; DSC[4 * F.tid + 2] = lpos; DSC[4 * F.tid + 3] = cnt;
    }
    __syncthreads();
    att::ItemCtx C{Qb, Kb, Vb, PO, ML, lists};
    att::attn_items(C, (const LAS int*)DSC, nloc < 64 ? nloc : 64, ldsg);
}


#if defined(MOBA_CHECK) && MOBA_CHECK
__device__ __forceinline__ float wave_max(float v) {
#pragma unroll
    for (int o = 1; o < 64; o <<= 1) v = fmaxf(v, __shfl_xor(v, o));
    return v;
}
__device__ __forceinline__ void moba_check(Frame& F) {
    const bf16* Qb = (const bf16*)(F.ws + WS_Q); const bf16* Kb = (const bf16*)(F.ws + WS_K); const bf16* Vb = (const bf16*)(F.ws + WS_V);
    const bf16* KMH = (const bf16*)(F.ws + WS_KMH); const bf16* KML = (const bf16*)(F.ws + WS_KML); const bf16* CAT = (const bf16*)(F.ws + WS_CAT);
    LAS float* pl = (LAS float*)(F.lds + RING_OFF + F.wave * 8192);
    LAS float* ql = pl + 1024;
    const int gw = blockIdx.x * NWAVES + F.wave, NGW = F.G * NWAVES;
    for (int s = gw; s < 4096; s += NGW) {
        const unsigned hsh = (unsigned)s * 2654435761u; const int bh = (hsh >> 8) & 31; int t = (hsh >> 13) & 8191; if ((s & 7) == 0) t &= 1023;
        const int b = bh >> 4, h = bh & 15, qb = t >> 8, tl = t & 255;
        const bf16* qrow = Qb + ((size_t)b * SEQ + t) * AW + h * HD;
        ql[F.lane] = bf2f(qrow[F.lane]); ql[64 + F.lane] = bf2f(qrow[64 + F.lane]); LDS_WAIT();
        float g = -__builtin_inff();
        if (F.lane < qb) { const bf16* kh = KMH + (size_t)(b * 32 + F.lane) * AW + h * HD; const bf16* kl = KML + (size_t)(b * 32 + F.lane) * AW + h * HD; float a = 0.f;
            for (int d = 0; d < 128; ++d) a += ql[d] * (bf2f(kh[d]) + bf2f(kl[d])); g = a; }
        int sel[3]; const int nsel = qb < 3 ? qb : 3;
#pragma unroll
        for (int k = 0; k < 3; ++k) { const float mx = wave_max(g); const unsigned long long bal = __ballot(g == mx && F.lane < qb); const int idx = bal ? (int)__builtin_ctzll(bal) : 0; sel[k] = idx; if (F.lane == idx) g = -__builtin_inff(); }
        float sc[4][4]; float mx = -1e30f;
#pragma unroll
        for (int u = 0; u < 4; ++u) { const bool on = (u == 3) || (u < nsel); const int j = (u == 3) ? qb : sel[u];
#pragma unroll
            for (int r = 0; r < 4; ++r) { const int key = F.lane + 64 * r; float a = -1e30f;
                if (on && !(u == 3 && key > tl)) { const bf16* kr = Kb + ((size_t)b * SEQ + 256 * j + key) * AW + h * HD; a = 0.f; for (int d = 0; d < 128; ++d) a += ql[d] * bf2f(kr[d]); a *= 0.088388347648318440f; }
                sc[u][r] = a; mx = fmaxf(mx, a); } }
        mx = wave_max(mx); float sum = 0.f;
#pragma unroll
        for (int u = 0; u < 4; ++u)
#pragma unroll
            for (int r = 0; r < 4; ++r) { const float p = (sc[u][r] > -1e29f) ? __expf(sc[u][r] - mx) : 0.f; sum += p; pl[u * 256 + F.lane + 64 * r] = p; }
        sum = wave_sum(sum); LDS_WAIT();
        float o0 = 0.f, o1 = 0.f;
#pragma unroll
        for (int u = 0; u < 4; ++u) { const bool on = (u == 3) || (u < nsel); const int j = (u == 3) ? qb : sel[u];
            if (on) for (int key = 0; key < 256; ++key) { const float p = pl[u * 256 + key]; const bf16* vr = Vb + ((size_t)b * SEQ + 256 * j + key) * AW + h * HD; o0 += p * bf2f(vr[F.lane]); o1 += p * bf2f(vr[64 + F.lane]); } }
        o0 /= sum; o1 /= sum;
        const bf16* cr = CAT + ((size_t)b * SEQ + t) * DM + PW + h * HD; const float c0 = bf2f(cr[F.lane]), c1 = bf2f(cr[64 + F.lane]);
        const bool bad = !(fabsf(c0 - o0) <= 1.5e-3f + 0.03f * fabsf(o0)) || !(fabsf(c1 - o1) <= 1.5e-3f + 0.03f * fabsf(o1));
        const unsigned long long bb = __ballot(bad);
        if (F.lane == 0 && bb) __hip_atomic_fetch_add(F.ctl + CW_CHK, 1u, RLX_AGENT);
        if (F.lane == 0) __hip_atomic_fetch_add(F.ctl + CW_CHK + 1, 1u, RLX_AGENT);
        LDS_WAIT();
    }
}
#endif

__device__ __forceinline__ void combine_phase(Frame& F) {
    const bf16* PO = (const bf16*)(F.ws + WS_PARTO); const float2* ML = (const float2*)(F.ws + WS_ML); bf16* CAT = (bf16*)(F.ws + WS_CAT);
    constexpr float C = att::SCALE * 1.4426950408889634f;
    const size_t gt = (size_t)blockIdx.x * (NWAVES * 64) + F.tid, NT = (size_t)F.G * NWAVES * 64;
    for (size_t idx = gt; idx < (size_t)32 * SEQ * 16; idx += NT) {
        const int dc = (int)(idx & 15), t = (int)((idx >> 4) & (SEQ - 1)), bh = (int)(idx >> 17), qb = t >> 8, nsel = qb < 3 ? qb : 3;
        float2 ml[4]; float mx;
        ml[3] = ML[((size_t)3 * 32 + bh) * SEQ + t]; mx = ml[3].x;
#pragma unroll
        for (int k = 0; k < 3; ++k) { if (k < nsel) { ml[k] = ML[((size_t)k * 32 + bh) * SEQ + t]; mx = fmaxf(mx, ml[k].x); } else ml[k] = make_float2(0.f, 0.f); }
        float acc[8]; float wsum = 0.f;
#pragma unroll
        for (int e = 0; e < 8; ++e) acc[e] = 0.f;
#pragma unroll
        for (int k = 0; k < 4; ++k) { if (k == 3 || k < nsel) {
            const float w = ml[k].y * __builtin_amdgcn_exp2f((ml[k].x - mx) * C); wsum += w;
            const v4u r = *(const GAS v4u*)(PO + (((size_t)k * 32 + bh) * SEQ + t) * HD + dc * 8);
            acc[0] += w * bf_lo(r.x); acc[1] += w * bf_hi(r.x); acc[2] += w * bf_lo(r.y); acc[3] += w * bf_hi(r.y);
            acc[4] += w * bf_lo(r.z); acc[5] += w * bf_hi(r.z); acc[6] += w * bf_lo(r.w); acc[7] += w * bf_hi(r.w); } }
        const float inv = 1.0f / wsum; const int b = bh >> 4, h = bh & 15;
        v4u o; o.x = pk2(acc[0] * inv, acc[1] * inv); o.y = pk2(acc[2] * inv, acc[3] * inv); o.z = pk2(acc[4] * inv, acc[5] * inv); o.w = pk2(acc[6] * inv, acc[7] * inv);
        *(GAS v4u*)(CAT + ((size_t)b * SEQ + t) * DM + PW + h * HD + dc * 8) = o;
    }
}

struct Args { const float* in[18]; float* out; unsigned char* ws; int ph_lo, ph_hi, li, pad; };
__global__ void __launch_bounds__(NWAVES * 64, 2) mega_fwd(Args args) {
    extern __shared__ __attribute__((aligned(16))) unsigned char lds[];
    Frame F;
    F.lds = (LAS unsigned char*)lds;
    F.MISC = (volatile LAS unsigned*)(F.lds + MISC_OFF);
    F.tid = threadIdx.x; F.lane = F.tid & 63; F.wave = __builtin_amdgcn_readfirstlane(F.tid >> 6);
    F.G = gridDim.x; F.ws = args.ws;
    F.ctl = (gu32*)(args.ws + WS_CTL);
    for (int u = F.tid; u < (LDS_BYTES - LDSCTL_OFF) / 4; u += NWAVES * 64) ((LAS unsigned*)(F.lds + LDSCTL_OFF))[u] = 0u;
    __syncthreads();
    XcdBarrier bar; bar.bar = (unsigned*)(F.ctl + CW_BAR); bar.x = 0; bar.st = nullptr;
    if (N_LAUNCHES == 1) bar = xcd_barrier_post((unsigned*)(F.ctl + CW_BAR), F.MISC + 8);
#define GRID_BAR() do { if (N_LAUNCHES == 1) xcd_barrier(bar); } while (0)
    const int lo = args.ph_lo, hi = args.ph_hi;
#define IN(k) (lo <= (k) && (k) < hi)
#define BOTH(k) (IN(k) && IN((k) + 1))
#ifndef PROBE_DUP
#define PROBE_DUP 0
#endif
#define DUPON(k) ((PROBE_DUP >> (k)) & 1)
#define REP(k) for (int _rep = 0; _rep < (DUPON(k) ? 2 : 1); ++_rep)
    unsigned char* ws = args.ws;
    const int G = F.G, cid = (int)blockIdx.x;
    float* out = args.out;

    if (IN(0)) { REP(0) { p0_prologue(F, args.in); } if (BOTH(0)) GRID_BAR(); }

    if (IN(1)) {
        { pg8::GemmKV g{(const char*)(ws + WS_MEMB), (const char*)(ws + WS_WXKV), DM, DM, 1024};
          pg8::OrderKV S{G, cid}; pg8::EpiSlabKV E{(float*)(ws + WS_SLAB)};
          pg8::gemm_phase<pg8::EpiSlabKV, pg8::OrderKV, true, true, pg8::GemmKV>(F.lds + RING_OFF, g, S, E); if (DUPON(16)) { pg8::gemm_phase<pg8::EpiSlabKV, pg8::OrderKV, true, true, pg8::GemmKV>(F.lds + RING_OFF, g, S, E); } }
        { pg8::Gemm g = pg8::make_gemm(ws + WS_XB, DM, ws + WS_WIN, DM, DM); pg8::StaticOrder S; S.init(M, MIXIN, G, cid);
          pg8::EpiMixIn E{(pg8::bf16_t*)(ws + WS_HP), (size_t)M * 2048, (const float*)(ws + WS_ROPE)};
          pg8::gemm_phase<pg8::EpiMixIn, pg8::StaticOrder, true, true>(F.lds + RING_OFF, g, S, E); if (DUPON(1)) { pg8::gemm_phase<pg8::EpiMixIn, pg8::StaticOrder, true, true>(F.lds + RING_OFF, g, S, E); } }
        if (BOTH(1)) GRID_BAR();
    }

    if (IN(2)) { REP(2) { pool_ew(F); kmean_phase(F); kv_reduce(F); } if (BOTH(2)) GRID_BAR(); }

    if (IN(3)) {
        { pg8::Gemm g = pg8::make_gemm(ws + WS_WOUT, 2048, ws + WS_WPOOL, 512, 512); g.a_pn = 512 * 2; g.a_pn_sh = 1; pg8::StaticOrder S; S.init(DM, PW, G, cid);
          pg8::EpiStore E{(pg8::bf16_t*)(ws + WS_WOUT2), DM, 0};
          pg8::gemm_phase<pg8::EpiStore, pg8::StaticOrder, true, true>(F.lds + RING_OFF, g, S, E); if (DUPON(3)) { pg8::gemm_phase<pg8::EpiStore, pg8::StaticOrder, true, true>(F.lds + RING_OFF, g, S, E); } }
        if (G == 256) { pg8::GemmAbs g{(const char*)(ws + WS_KVX), (const char*)(ws + WS_WXQ), (const char*)(ws + WS_WXO), cid < 128 ? 8192 : 4096, cid < 128 ? 4096 : 8192, 1024};
          pg8::OrderAbs S{cid}; pg8::EpiStoreAbs E{(pg8::bf16_t*)(ws + WS_WQK), (pg8::bf16_t*)(ws + WS_WVOT)};
          pg8::gemm_phase<pg8::EpiStoreAbs, pg8::OrderAbs, true, true, pg8::GemmAbs>(F.lds + RING_OFF, g, S, E); if (DUPON(17)) { pg8::gemm_phase<pg8::EpiStoreAbs, pg8::OrderAbs, true, true, pg8::GemmAbs>(F.lds + RING_OFF, g, S, E); } }
        gate_phase(F);
        if (BOTH(3)) GRID_BAR();
    }

    if (IN(4)) { attn_phase(F, (char*)lds + RING_OFF); if (DUPON(4)) { __syncthreads(); attn_phase(F, (char*)lds + RING_OFF); } if (BOTH(4)) GRID_BAR(); }

    if (IN(5)) { REP(5) { combine_phase(F); } if (BOTH(5)) GRID_BAR(); }
#if defined(MOBA_CHECK) && MOBA_CHECK
    if (IN(5)) { moba_check(F); __syncthreads(); }
#endif

    if (IN(6)) {
        pg8::Gemm g = pg8::make_gemm(ws + WS_CAT, DM, ws + WS_WOUT2, DM, DM); pg8::StaticOrder S; S.init(M, DM, G, cid);
        pg8::EpiResid E{args.in[0], (pg8::bf16_t*)(ws + WS_TB), DM, DN_ALPHA};
        pg8::gemm_phase<pg8::EpiResid, pg8::StaticOrder, true, true>(F.lds + RING_OFF, g, S, E); if (DUPON(6)) { pg8::gemm_phase<pg8::EpiResid, pg8::StaticOrder, true, true>(F.lds + RING_OFF, g, S, E); }
        if (BOTH(6)) GRID_BAR();
    }
    if (IN(7)) { ln_rows<false>(F, (const bf16*)(ws + WS_TB), (bf16*)(ws + WS_HB), (float2*)(ws + WS_STATS), nullptr, args.in[6], args.in[7]); if (DUPON(7)) { ln_rows<false>(F, (const bf16*)(ws + WS_TB), (bf16*)(ws + WS_HB), (float2*)(ws + WS_STATS), nullptr, args.in[6], args.in[7]); } if (BOTH(7)) GRID_BAR(); }

    if (IN(9)) {
        if (G == 256) {
            pg8::Gemm g = pg8::make_gemm(ws + WS_HB, DM, ws + WS_WQK, DM, DM); g.b_pm = (size_t)1024 * DM * 2; g.b_pm_sh = 5;
            pg8::StaticOrder S; S.init(M, XH * 256, G, cid);
            pg8::EpiSoftmax E{(pg8::bf16_t*)(ws + WS_PB), XH * MEMLEN, 0.03125f * 1.4426950408889634f};
            pg8::gemm_phase<pg8::EpiSoftmax, pg8::StaticOrder, false, true>(F.lds + RING_OFF, g, S, E); if (DUPON(9)) { pg8::gemm_phase<pg8::EpiSoftmax, pg8::StaticOrder, false, true>(F.lds + RING_OFF, g, S, E); }
        }
        if (BOTH(9)) GRID_BAR();
    }
    if (IN(11)) {
        pg8::Gemm g = pg8::make_gemm(ws + WS_PB, XH * MEMLEN, ws + WS_WVOT, 2048, XH * MEMLEN); g.b_pm = (size_t)1024 * 2; g.b_pm_sh = 5;
        pg8::StaticOrder S; S.init(M, DM, G, cid);
        pg8::EpiResidLN E{(pg8::bf16_t*)(ws + WS_TB), (const pg8::f32x2*)(ws + WS_STATS), 6};
        pg8::gemm_phase<pg8::EpiResidLN, pg8::StaticOrder, true, true>(F.lds + RING_OFF, g, S, E);
        if (BOTH(11)) GRID_BAR();
    }
    if (IN(12)) { ln_rows<false>(F, (const bf16*)(ws + WS_TB), (bf16*)(ws + WS_HB), (float2*)(ws + WS_STATS), nullptr, args.in[11], args.in[12]); if (BOTH(12)) GRID_BAR(); }

    if (IN(13)) {
        pg8::Gemm g = pg8::make_gemm(ws + WS_HB, DM, ws + WS_WGU, DM, DM); pg8::StaticOrder S; S.init(M, 2 * FF, G, cid);
        pg8::EpiSwiGLU E{(pg8::bf16_t*)(ws + WS_G), FF};
        pg8::gemm_phase<pg8::EpiSwiGLU, pg8::StaticOrder, true, true>(F.lds + RING_OFF, g, S, E); if (DUPON(13)) { pg8::gemm_phase<pg8::EpiSwiGLU, pg8::StaticOrder, true, true>(F.lds + RING_OFF, g, S, E); }
        { const int nu = 2 * FF / 256 * (M / 256), full = (nu + G - 1) / G, mine = (nu > cid) ? (nu - cid + G - 1) / G : 0, nshort = G - (nu % G);
          if (nu % G != 0 && mine < full) convert_wdown(F, args.in[15], cid - (nu % G), nshort);
          else if (nu % G == 0) convert_wdown(F, args.in[15], cid, G); }
        if (BOTH(13)) GRID_BAR();
    }
    if (IN(14)) {
        pg8::Gemm g = pg8::make_gemm(ws + WS_G, FF, ws + WS_WDN, FF, FF); pg8::StaticOrder S; S.init(M, DM, G, cid);
        pg8::EpiResidLN E{(pg8::bf16_t*)(ws + WS_TB), (const pg8::f32x2*)(ws + WS_STATS), 11};
        if (DUPON(14)) { pg8::EpiStore E2{(pg8::bf16_t*)(ws + WS_HB), DM, 0}; pg8::gemm_phase<pg8::EpiStore, pg8::StaticOrder, true, true>(F.lds + RING_OFF, g, S, E2); }
        pg8::gemm_phase<pg8::EpiResidLN, pg8::StaticOrder, true, true>(F.lds + RING_OFF, g, S, E);
        if (BOTH(14)) GRID_BAR();
    }
#if defined(MOBA_CHECK) && MOBA_CHECK
#define CHK_TAIL 1
#endif
    if (IN(15)) { ln_rows<true>(F, (const bf16*)(ws + WS_TB), nullptr, nullptr, out, args.in[16], args.in[17]); if (DUPON(15)) { ln_rows<true>(F, (const bf16*)(ws + WS_TB), nullptr, nullptr, out, args.in[16], args.in[17]); } }
#if defined(MOBA_CHECK) && MOBA_CHECK
    GRID_BAR();
    if (blockIdx.x == 0 && F.tid < 64) { const unsigned nbad = __hip_atomic_load(F.ctl + CW_CHK, RLX_AGENT), nrun = __hip_atomic_load(F.ctl + CW_CHK + 1, RLX_AGENT);
        if (nbad != 0u) out[F.tid] = 1000.0f + (float)nbad;
        else if (nrun != 4096u) out[F.tid] = 500.0f + (float)nrun; }
#endif
#undef IN
#undef BOTH
#undef GRID_BAR
}

extern "C" void kernel_launch(void* const* d_in, const int* in_sizes, int n_in, void* d_out, int out_size, void* d_ws, size_t ws_size, hipStream_t stream) {
    static int grid = 0;
    if (grid == 0) {
        if (n_in != 18 || in_sizes[0] != M * DM || out_size != M * DM || ws_size < WS_END) { fprintf(stderr, "kernel_launch: shape / workspace mismatch (n_in %d, in0 %d, out %d, ws %zu, need %zu)\n", n_in, n_in > 0 ? in_sizes[0] : -1, out_size, ws_size, (size_t)WS_END); grid = -1; return; }
        int dev = 0, cus = 0, per_cu = 0;
        if (hipGetDevice(&dev) != hipSuccess || hipDeviceGetAttribute(&cus, hipDeviceAttributeMultiprocessorCount, dev) != hipSuccess) { grid = -1; return; }
        if (hipFuncSetAttribute((const void*)mega_fwd, hipFuncAttributeMaxDynamicSharedMemorySize, LDS_BYTES) != hipSuccess) { fprintf(stderr, "kernel_launch: hipFuncSetAttribute failed\n"); grid = -1; return; }
        if (hipOccupancyMaxActiveBlocksPerMultiprocessor(&per_cu, (const void*)mega_fwd, NWAVES * 64, LDS_BYTES) != hipSuccess || per_cu < 1)
            fprintf(stderr, "kernel_launch: note: occupancy query reports %d workgroups per CU\n", per_cu);
        (void)hipGetLastError();
        grid = cus;
        if (grid != 256) fprintf(stderr, "kernel_launch: %d CUs; the cross-attention score phase needs a 256-workgroup grid\n", grid);
    }
    if (grid < 0) return;
    if (hipMemsetAsync((char*)d_ws + WS_CTL, 0, CTL_ZERO_BYTES, stream) != hipSuccess) return;
    Args a{};
    for (int i = 0; i < 18; ++i) a.in[i] = (const float*)d_in[i];
    a.out = (float*)d_out; a.ws = (unsigned char*)d_ws; a.pad = 0;
    for (int li = 0; li < N_LAUNCHES; ++li) {
        a.ph_lo = (N_LAUNCHES == 1) ? 0 : li; a.ph_hi = (N_LAUNCHES == 1) ? N_PHASES : li + 1; a.li = li;
        hipLaunchKernelGGL(mega_fwd, dim3(grid), dim3(NWAVES * 64), LDS_BYTES, stream, a);
        if (hipPeekAtLastError() != hipSuccess) { fprintf(stderr, "kernel_launch: launch %d failed\n", li); break; }
    }
}
```

```cpp
#include <hip/hip_runtime.h>
#include <cstdio>
#include <cstdint>

namespace pg8 {
#define PG8_LAS __attribute__((address_space(3)))
typedef unsigned short bf16_t;
typedef short bf16x8 __attribute__((ext_vector_type(8)));
typedef float f32x4 __attribute__((ext_vector_type(4)));
typedef float f32x2 __attribute__((ext_vector_type(2)));
typedef unsigned u32x4 __attribute__((ext_vector_type(4)));
typedef unsigned u32x2 __attribute__((ext_vector_type(2)));
constexpr int BM = 256, BK = 64, HALF = 128, HTB = HALF * BK * 2  , STAGE_BYTES = 8 * HTB, NXCD = 8, WGM = 8;

__host__ __device__ __forceinline__ int lds_byte(int r, int c) { const int st = (r >> 4) * 2 + (c >> 5), rr = r & 15, cc = c & 31, ob = rr * 64 + cc * 2; return st * 1024 + (ob ^ (((ob >> 9) & 1) << 5)); }
__host__ __device__ __forceinline__ void stage_rc(int b, int& R, int& C) { const int st = b / 1024, sb = b % 1024, swz = sb ^ (((sb >> 9) & 1) << 5); R = (st >> 1) * 16 + swz / 64; C = (st & 1) * 32 + (swz % 64) / 2; }
__host__ __device__ __forceinline__ int perm32(int rho) { const int n = rho >> 4, i = rho & 15; return 8 * (i >> 2) + 4 * n + (i & 3); }

struct Unit { int pm, pn, pz; };
struct Gemm {
    const char* A; const char* B; int lda, ldb, K;
    size_t a_pm, a_pn; int a_pn_sh; size_t b_pn, b_pm; int b_pm_sh;
    __device__ __forceinline__ const char* a_ptr(const Unit& u) const { return A + (size_t)u.pm * a_pm + (size_t)(u.pn >> a_pn_sh) * a_pn; }
    __device__ __forceinline__ const char* b_ptr(const Unit& u) const { return B + (size_t)u.pn * b_pn + (size_t)(u.pm >> b_pm_sh) * b_pm; }
};
__device__ __forceinline__ Gemm make_gemm(const void* A, int lda, const void* B, int ldb, int K) {
    Gemm g; g.A = (const char*)A; g.B = (const char*)B; g.lda = lda; g.ldb = ldb; g.K = K;
    g.a_pm = (size_t)BM * lda * 2; g.a_pn = 0; g.a_pn_sh = 0; g.b_pn = (size_t)BM * ldb * 2; g.b_pm = 0; g.b_pm_sh = 0; return g;
}

struct StaticOrder {
    int nM, nN, nwg, G, c;
    __host__ __device__ void init(int M, int N, int G_, int c_) { nM = M / BM; nN = N / BM; nwg = nM * nN; G = G_; c = c_; }
    __host__ __device__ bool next(int i, Unit& u) const {
        const long L = (long)i * G + c; if (L >= nwg) return false;
        int wgid = (int)L; { const int q = nwg / NXCD, r = nwg % NXCD, xcd = wgid % NXCD, off = wgid / NXCD; wgid = (xcd < r ? xcd * (q + 1) : r * (q + 1) + (xcd - r) * q) + off; }
        const int nig = WGM * nN, gid = wgid / nig, fm = gid * WGM, gsz = (nM - fm) < WGM ? (nM - fm) : WGM;
        u.pm = fm + ((wgid % nig) % gsz); u.pn = (wgid % nig) / gsz; u.pz = 0; return true;
    }
    __device__ __forceinline__ void a_ready(const Unit&) const {}
    __device__ __forceinline__ void done(const Unit&) const {}
};

__device__ __forceinline__ unsigned cvt_pk_bf16(float lo, float hi) { unsigned r; asm volatile("v_cvt_pk_bf16_f32 %0, %1, %2" : "=v"(r) : "v"(lo), "v"(hi)); return r; }

struct EpiMixIn {
    static constexpr bool PERM = true, AFTER_DRAIN = false;
    bf16_t* base; size_t tstride; const float* rope;
    __device__ __forceinline__ void operator()(const f32x4 (&acc)[2][2][4][2], const Unit& u, int wr, int wc, int fr, int fq) const {
        const int t = u.pn >> 3; const bool rp = (t == 1) || (t == 2);
        bf16_t* ob = base + (size_t)t * tstride;
        const int row0 = u.pm * BM + wr * 64 + fr, col0 = (u.pn & 7) * BM + wc * 32 + 8 * fq;
#pragma unroll
        for (int ai = 0; ai < 2; ++ai)
#pragma unroll
            for (int m = 0; m < 4; ++m) {
                const int row = row0 + ai * HALF + m * 16; bf16_t* rowp = ob + (size_t)row * 2048 + col0;
                f32x4 cs0 = (f32x4){1.f, 0.f, 1.f, 0.f}, cs1 = cs0;
                if (rp) { const f32x4* tp = (const f32x4*)(rope + ((size_t)(row & 8191) * 64 + wc * 16 + fq * 4) * 2); cs0 = tp[0]; cs1 = tp[1]; }
#pragma unroll
                for (int bj = 0; bj < 2; ++bj) {
                    const f32x4 v0 = acc[ai][bj][m][0], v1 = acc[ai][bj][m][1];
                    const float a0 = v0[0] * cs0[0] - v0[1] * cs0[1], a1 = v0[1] * cs0[0] + v0[0] * cs0[1];
                    const float a2 = v0[2] * cs0[2] - v0[3] * cs0[3], a3 = v0[3] * cs0[2] + v0[2] * cs0[3];
                    const float b0 = v1[0] * cs1[0] - v1[1] * cs1[1], b1 = v1[1] * cs1[0] + v1[0] * cs1[1];
                    const float b2 = v1[2] * cs1[2] - v1[3] * cs1[3], b3 = v1[3] * cs1[2] + v1[2] * cs1[3];
                    u32x4 w; w.x = cvt_pk_bf16(a0, a1); w.y = cvt_pk_bf16(a2, a3); w.z = cvt_pk_bf16(b0, b1); w.w = cvt_pk_bf16(b2, b3);
                    *(u32x4*)(rowp + bj * HALF) = w;
                }
            }
    }
};
struct EpiStore {
    static constexpr bool PERM = true, AFTER_DRAIN = false;
    bf16_t* O; int ldc, coff;
    __device__ __forceinline__ void operator()(const f32x4 (&acc)[2][2][4][2], const Unit& u, int wr, int wc, int fr, int fq) const {
        const int row0 = u.pm * BM + wr * 64 + fr, col0 = coff + u.pn * BM + wc * 32 + 8 * fq;
#pragma unroll
        for (int ai = 0; ai < 2; ++ai)
#pragma unroll
            for (int m = 0; m < 4; ++m) { bf16_t* rowp = O + (size_t)(row0 + ai * HALF + m * 16) * ldc + col0;
#pragma unroll
                for (int bj = 0; bj < 2; ++bj) { const f32x4 v0 = acc[ai][bj][m][0], v1 = acc[ai][bj][m][1];
                    u32x4 w; w.x = cvt_pk_bf16(v0[0], v0[1]); w.y = cvt_pk_bf16(v0[2], v0[3]); w.z = cvt_pk_bf16(v1[0], v1[1]); w.w = cvt_pk_bf16(v1[2], v1[3]);
                    *(u32x4*)(rowp + bj * HALF) = w; } }
    }
};
__device__ __forceinline__ void row_stat_acc(const u32x4& w, float& s, float& q) {
    const float a0 = __builtin_bit_cast(float, w.x << 16), a1 = __builtin_bit_cast(float, w.x & 0xffff0000u), a2 = __builtin_bit_cast(float, w.y << 16), a3 = __builtin_bit_cast(float, w.y & 0xffff0000u);
    const float a4 = __builtin_bit_cast(float, w.z << 16), a5 = __builtin_bit_cast(float, w.z & 0xffff0000u), a6 = __builtin_bit_cast(float, w.w << 16), a7 = __builtin_bit_cast(float, w.w & 0xffff0000u);
    s += ((a0 + a1) + (a2 + a3)) + ((a4 + a5) + (a6 + a7));
    q += ((a0 * a0 + a1 * a1) + (a2 * a2 + a3 * a3)) + ((a4 * a4 + a5 * a5) + (a6 * a6 + a7 * a7));
}
__device__ __forceinline__ void row_stat_store(f32x2* slots, int row, int slot, int fq, float s, float q) {
    s += __shfl_xor(s, 16); q += __shfl_xor(q, 16); s += __shfl_xor(s, 32); q += __shfl_xor(q, 32);
    if (fq == 0) slots[(size_t)row * 64 + slot] = (f32x2){s, q};
}
struct EpiResid {
    static constexpr bool PERM = true, AFTER_DRAIN = false;
    const float* res; bf16_t* out; int ldc; float alpha; f32x2* slots;
    __device__ __forceinline__ void operator()(const f32x4 (&acc)[2][2][4][2], const Unit& u, int wr, int wc, int fr, int fq) const {
        const int row0 = u.pm * BM + wr * 64 + fr, col0 = u.pn * BM + wc * 32 + 8 * fq;
#pragma unroll
        for (int ai = 0; ai < 2; ++ai)
#pragma unroll
            for (int m = 0; m < 4; ++m) { const size_t off = (size_t)(row0 + ai * HALF + m * 16) * ldc + col0; float ss = 0.f, qq = 0.f;
#pragma unroll
                for (int bj = 0; bj < 2; ++bj) { const f32x4 r0 = *(const f32x4*)(res + off + bj * HALF), r1 = *(const f32x4*)(res + off + bj * HALF + 4);
                    const f32x4 v0 = r0 * alpha + acc[ai][bj][m][0], v1 = r1 * alpha + acc[ai][bj][m][1];
                    u32x4 w; w.x = cvt_pk_bf16(v0[0], v0[1]); w.y = cvt_pk_bf16(v0[2], v0[3]); w.z = cvt_pk_bf16(v1[0], v1[1]); w.w = cvt_pk_bf16(v1[2], v1[3]);
                    *(u32x4*)(out + off + bj * HALF) = w; row_stat_acc(w, ss, qq); }
                row_stat_store(slots, row0 + ai * HALF + m * 16, u.pn * 4 + wc, fq, ss, qq);
                asm volatile("" ::: "memory"); }
    }
};
struct EpiSwiGLU {
    static constexpr bool PERM = true, AFTER_DRAIN = false;
    bf16_t* G; int ldc; const f32x2* stats; const float* c1; const float* c2;
    __device__ __forceinline__ float act(float g, float u) const { return g * u * __builtin_amdgcn_rcpf(1.0f + __builtin_amdgcn_exp2f(-1.4426950408889634f * g)); }
    __device__ __forceinline__ void operator()(const f32x4 (&acc)[2][2][4][2], const Unit& u, int wr, int wc, int fr, int fq) const {
        const int row0 = u.pm * BM + wr * 64 + fr, col0 = u.pn * HALF + wc * 32 + 8 * fq, n0 = u.pn * BM + wc * 32 + 8 * fq;
        const f32x4 cg0 = *(const f32x4*)(c1 + n0), cg1 = *(const f32x4*)(c1 + n0 + 4), cu0 = *(const f32x4*)(c1 + n0 + HALF), cu1 = *(const f32x4*)(c1 + n0 + HALF + 4);
        const f32x4 dg0 = *(const f32x4*)(c2 + n0), dg1 = *(const f32x4*)(c2 + n0 + 4), du0 = *(const f32x4*)(c2 + n0 + HALF), du1 = *(const f32x4*)(c2 + n0 + HALF + 4);
#pragma unroll
        for (int ai = 0; ai < 2; ++ai)
#pragma unroll
            for (int m = 0; m < 4; ++m) { const int row = row0 + ai * HALF + m * 16; bf16_t* rowp = G + (size_t)row * ldc + col0; const f32x2 st = stats[row];
                const f32x4 g0 = (acc[ai][0][m][0] - cg0 * st.x) * st.y + dg0, g1 = (acc[ai][0][m][1] - cg1 * st.x) * st.y + dg1;
                const f32x4 u0 = (acc[ai][1][m][0] - cu0 * st.x) * st.y + du0, u1 = (acc[ai][1][m][1] - cu1 * st.x) * st.y + du1;
                u32x4 w; w.x = cvt_pk_bf16(act(g0[0], u0[0]), act(g0[1], u0[1])); w.y = cvt_pk_bf16(act(g0[2], u0[2]), act(g0[3], u0[3]));
                w.z = cvt_pk_bf16(act(g1[0], u1[0]), act(g1[1], u1[1])); w.w = cvt_pk_bf16(act(g1[2], u1[2]), act(g1[3], u1[3]));
                *(u32x4*)rowp = w; }
    }
};
struct EpiSoftmax {
    static constexpr bool PERM = true, AFTER_DRAIN = true;
    bf16_t* P; int ldc; float c2; const f32x2* stats; const float* k1; const float* k2;
    __device__ __forceinline__ void fused(f32x4 (&acc)[2][2][4][2], const Unit& u, int wr, int wc, int fr, int fq, PG8_LAS unsigned char* lds, int wid, int lane) const {
        PG8_LAS float* T1 = (PG8_LAS float*)lds;
        PG8_LAS float* T2 = (PG8_LAS float*)(lds + 4096);
        { const int nb = (u.pm >> 5) * 1024 + u.pn * BM + wc * 32 + 8 * fq;
          f32x4 ka[2][2], kb[2][2];
#pragma unroll
          for (int bj = 0; bj < 2; ++bj)
#pragma unroll
              for (int n = 0; n < 2; ++n) { ka[bj][n] = *(const f32x4*)(k1 + nb + bj * HALF + 4 * n); kb[bj][n] = *(const f32x4*)(k2 + nb + bj * HALF + 4 * n); }
#pragma unroll
          for (int ai = 0; ai < 2; ++ai)
#pragma unroll
              for (int m = 0; m < 4; ++m) { const f32x2 st = stats[u.pm * BM + ai * HALF + wr * 64 + m * 16 + fr];
#pragma unroll
                  for (int bj = 0; bj < 2; ++bj)
#pragma unroll
                      for (int n = 0; n < 2; ++n) acc[ai][bj][m][n] = (acc[ai][bj][m][n] - ka[bj][n] * st.x) * st.y + kb[bj][n]; } }
#pragma unroll
        for (int ai = 0; ai < 2; ++ai)
#pragma unroll
            for (int m = 0; m < 4; ++m) { float mx = -3.0e38f;
#pragma unroll
                for (int bj = 0; bj < 2; ++bj)
#pragma unroll
                    for (int n = 0; n < 2; ++n) { const f32x4 x = acc[ai][bj][m][n]; mx = fmaxf(mx, fmaxf(fmaxf(x[0], x[1]), fmaxf(x[2], x[3]))); }
                mx = fmaxf(mx, __shfl_xor(mx, 16)); mx = fmaxf(mx, __shfl_xor(mx, 32));
                if (fq == 0) T1[(ai * HALF + wr * 64 + m * 16 + fr) * 4 + wc] = mx; }
        asm volatile("s_waitcnt lgkmcnt(0)" ::: "memory"); __builtin_amdgcn_s_barrier(); asm volatile("" ::: "memory");
#pragma unroll
        for (int ai = 0; ai < 2; ++ai)
#pragma unroll
            for (int m = 0; m < 4; ++m) { const int r = ai * HALF + wr * 64 + m * 16 + fr;
                const f32x4 t = *(const PG8_LAS f32x4*)(T1 + r * 4); const float mx = fmaxf(fmaxf(t[0], t[1]), fmaxf(t[2], t[3])) * c2; float s = 0.f;
#pragma unroll
                for (int bj = 0; bj < 2; ++bj)
#pragma unroll
                    for (int n = 0; n < 2; ++n) { f32x4 x = acc[ai][bj][m][n];
#pragma unroll
                        for (int e = 0; e < 4; ++e) { x[e] = __builtin_amdgcn_exp2f(x[e] * c2 - mx); s += x[e]; }
                        acc[ai][bj][m][n] = x; }
                s += __shfl_xor(s, 16); s += __shfl_xor(s, 32);
                if (fq == 0) T2[r * 4 + wc] = s; }
        asm volatile("s_waitcnt lgkmcnt(0)" ::: "memory"); __builtin_amdgcn_s_barrier(); asm volatile("" ::: "memory");
        const int row0 = u.pm * BM + wr * 64 + fr, col0 = u.pn * BM + wc * 32 + 8 * fq;
#pragma unroll
        for (int ai = 0; ai < 2; ++ai)
#pragma unroll
            for (int m = 0; m < 4; ++m) { const int r = ai * HALF + wr * 64 + m * 16 + fr;
                const f32x4 t = *(const PG8_LAS f32x4*)(T2 + r * 4); const float inv = 1.0f / ((t[0] + t[1]) + (t[2] + t[3]));
                bf16_t* rowp = P + (size_t)(row0 + ai * HALF + m * 16) * ldc + col0;
#pragma unroll
                for (int bj = 0; bj < 2; ++bj) { const f32x4 v0 = acc[ai][bj][m][0] * inv, v1 = acc[ai][bj][m][1] * inv;
                    u32x4 w; w.x = cvt_pk_bf16(v0[0], v0[1]); w.y = cvt_pk_bf16(v0[2], v0[3]); w.z = cvt_pk_bf16(v1[0], v1[1]); w.w = cvt_pk_bf16(v1[2], v1[3]);
                    *(u32x4*)(rowp + bj * HALF) = w; } }
    }
};

struct GemmKV {
    const char* memb; const char* wkv; int lda, ldb, K;
    __device__ __forceinline__ const char* a_ptr(const Unit& u) const { return memb + (size_t)u.pm * (BM * 4096 * 2) + (size_t)u.pz * 2048; }
    __device__ __forceinline__ const char* b_ptr(const Unit& u) const { return wkv + (size_t)u.pn * (BM * 4096 * 2) + (size_t)u.pz * 2048; }
};
struct OrderKV {
    int G, c;
    __device__ __forceinline__ bool next(int i, Unit& u) const { const int L = i * G + c; if (L >= 256) return false; const int tile = L >> 2; u.pz = L & 3; u.pm = tile >> 5; u.pn = tile & 31; return true; }
    __device__ __forceinline__ void a_ready(const Unit&) const {}
    __device__ __forceinline__ void done(const Unit&) const {}
};
struct EpiSlabKV {
    static constexpr bool PERM = false, AFTER_DRAIN = false;
    float* S;
    __device__ __forceinline__ void operator()(const f32x4 (&acc)[2][2][4][2], const Unit& u, int wr, int wc, int fr, int fq) const {
        float* C = S + (size_t)u.pz * (512 * 8192);
        const int row0 = u.pm * BM + wr * 64 + fr, col0 = u.pn * BM + wc * 32 + 4 * fq;
#pragma unroll
        for (int ai = 0; ai < 2; ++ai)
#pragma unroll
            for (int m = 0; m < 4; ++m) { float* rowp = C + (size_t)(row0 + ai * HALF + m * 16) * 8192 + col0;
#pragma unroll
                for (int bj = 0; bj < 2; ++bj)
#pragma unroll
                    for (int n = 0; n < 2; ++n) *(f32x4*)(rowp + bj * HALF + n * 16) = acc[ai][bj][m][n]; }
    }
};
struct GemmAbs {
    const char* kvx; const char* wq_raw; const char* wo_t; int lda, ldb, K;
    __device__ __forceinline__ const char* a_ptr(const Unit& u) const {
        return u.pz ? wo_t + (size_t)u.pm * (BM * 4096 * 2) + (size_t)(u.pn & 3) * 2048
                    : kvx + (size_t)(u.pm >> 2) * (BM * 8192 * 2) + (size_t)(u.pm & 3) * 2048; }
    __device__ __forceinline__ const char* b_ptr(const Unit& u) const {
        return u.pz ? kvx + 8192 + (size_t)(u.pn >> 2) * (BM * 8192 * 2) + (size_t)(u.pn & 3) * 2048
                    : wq_raw + (size_t)u.pn * (BM * 4096 * 2) + (size_t)(u.pm & 3) * 2048; }
};
struct OrderAbs {
    int c;
    __device__ __forceinline__ bool next(int i, Unit& u) const { if (i != 0 || c >= 256) return false; if (c < 128) { u.pz = 0; u.pm = c >> 4; u.pn = c & 15; } else { const int t = c - 128; u.pz = 1; u.pm = t >> 3; u.pn = t & 7; } return true; }
    __device__ __forceinline__ void a_ready(const Unit&) const {}
    __device__ __forceinline__ void done(const Unit&) const {}
};
struct EpiStoreAbs {
    static constexpr bool PERM = true, AFTER_DRAIN = false;
    bf16_t* WQK; bf16_t* WVOT; float* k1; float* k2;
    __device__ __forceinline__ void operator()(const f32x4 (&acc)[2][2][4][2], const Unit& u, int wr, int wc, int fr, int fq) const {
        bf16_t* O = u.pz ? WVOT : WQK; const int ldc = u.pz ? 2048 : 4096;
        const int row0 = u.pm * BM + wr * 64 + fr, col0 = u.pn * BM + wc * 32 + 8 * fq;
        f32x4 gv[2][2], bv[2][2];
#pragma unroll
        for (int bj = 0; bj < 2; ++bj)
#pragma unroll
            for (int n = 0; n < 2; ++n) { gv[bj][n] = (f32x4){1.f, 1.f, 1.f, 1.f}; bv[bj][n] = (f32x4){0.f, 0.f, 0.f, 0.f}; }
        if (!u.pz) { const float* const __attribute__((address_space(4)))* inp = (const float* const __attribute__((address_space(4)))*)__builtin_amdgcn_kernarg_segment_ptr();
            const float* g = inp[6]; const float* b = inp[7];
#pragma unroll
            for (int bj = 0; bj < 2; ++bj)
#pragma unroll
                for (int n = 0; n < 2; ++n) { gv[bj][n] = *(const f32x4*)(g + col0 + bj * HALF + 4 * n); bv[bj][n] = *(const f32x4*)(b + col0 + bj * HALF + 4 * n); } }
#pragma unroll
        for (int ai = 0; ai < 2; ++ai)
#pragma unroll
            for (int m = 0; m < 4; ++m) { const int row = row0 + ai * HALF + m * 16; bf16_t* rowp = O + (size_t)row * ldc + col0; float s1 = 0.f, s2 = 0.f, dummy = 0.f;
#pragma unroll
                for (int bj = 0; bj < 2; ++bj) { const f32x4 a0 = acc[ai][bj][m][0], a1 = acc[ai][bj][m][1], v0 = a0 * gv[bj][0], v1 = a1 * gv[bj][1];
                    u32x4 w; w.x = cvt_pk_bf16(v0[0], v0[1]); w.y = cvt_pk_bf16(v0[2], v0[3]); w.z = cvt_pk_bf16(v1[0], v1[1]); w.w = cvt_pk_bf16(v1[2], v1[3]);
                    *(u32x4*)(rowp + bj * HALF) = w; row_stat_acc(w, s1, dummy);
                    const f32x4 t0 = a0 * bv[bj][0], t1 = a1 * bv[bj][1]; s2 += ((t0[0] + t0[1]) + (t0[2] + t0[3])) + ((t1[0] + t1[1]) + (t1[2] + t1[3])); }
                if (!u.pz) { s1 += __shfl_xor(s1, 16); s2 += __shfl_xor(s2, 16); s1 += __shfl_xor(s1, 32); s2 += __shfl_xor(s2, 32);
                    if (fq == 0) { __hip_atomic_fetch_add(k1 + row, s1, __ATOMIC_RELAXED, __HIP_MEMORY_SCOPE_AGENT); __hip_atomic_fetch_add(k2 + row, s2, __ATOMIC_RELAXED, __HIP_MEMORY_SCOPE_AGENT); } } }
    }
};
struct EpiResidLN {
    static constexpr bool PERM = true, AFTER_DRAIN = false;
    bf16_t* T; const f32x2* stats; int gi; f32x2* slots;
    __device__ __forceinline__ void operator()(const f32x4 (&acc)[2][2][4][2], const Unit& u, int wr, int wc, int fr, int fq) const {
        constexpr int ldc = 4096; constexpr float alpha = 1.189207115002721f;
        const float* const __attribute__((address_space(4)))* inp = (const float* const __attribute__((address_space(4)))*)__builtin_amdgcn_kernarg_segment_ptr();
        const float* g = inp[gi]; const float* b = inp[gi + 1];
        const int row0 = u.pm * BM + wr * 64 + fr, col0 = u.pn * BM + wc * 32 + 8 * fq;
        f32x4 gv[2][2], bv[2][2];
#pragma unroll
        for (int bj = 0; bj < 2; ++bj)
#pragma unroll
            for (int n = 0; n < 2; ++n) { gv[bj][n] = *(const f32x4*)(g + col0 + bj * HALF + n * 4) * alpha; bv[bj][n] = *(const f32x4*)(b + col0 + bj * HALF + n * 4) * alpha; }
#pragma unroll
        for (int ai = 0; ai < 2; ++ai)
#pragma unroll
            for (int m = 0; m < 4; ++m) { const int row = row0 + ai * HALF + m * 16; const size_t off = (size_t)row * ldc + col0; const f32x2 st = stats[row]; float ss = 0.f, qq = 0.f;
#pragma unroll
                for (int bj = 0; bj < 2; ++bj) { const u32x4 r = *(const u32x4*)(T + off + bj * HALF);
                    const f32x4 t0 = (f32x4){__builtin_bit_cast(float, r.x << 16), __builtin_bit_cast(float, r.x & 0xffff0000u), __builtin_bit_cast(float, r.y << 16), __builtin_bit_cast(float, r.y & 0xffff0000u)};
                    const f32x4 t1 = (f32x4){__builtin_bit_cast(float, r.z << 16), __builtin_bit_cast(float, r.z & 0xffff0000u), __builtin_bit_cast(float, r.w << 16), __builtin_bit_cast(float, r.w & 0xffff0000u)};
                    const f32x4 v0 = ((t0 - st.x) * st.y) * gv[bj][0] + bv[bj][0] + acc[ai][bj][m][0], v1 = ((t1 - st.x) * st.y) * gv[bj][1] + bv[bj][1] + acc[ai][bj][m][1];
                    u32x4 w; w.x = cvt_pk_bf16(v0[0], v0[1]); w.y = cvt_pk_bf16(v0[2], v0[3]); w.z = cvt_pk_bf16(v1[0], v1[1]); w.w = cvt_pk_bf16(v1[2], v1[3]);
                    *(u32x4*)(T + off + bj * HALF) = w; row_stat_acc(w, ss, qq); }
                if (slots) row_stat_store(slots, row, u.pn * 4 + wc, fq, ss, qq);
                asm volatile("" ::: "memory"); }
    }
};

template <class Epi, class Sched, bool ALIGN_EPI = false, bool SP2 = false, class GT = Gemm>
__device__ __forceinline__ void gemm_phase(PG8_LAS unsigned char* lds, const GT g, const Sched& S, const Epi& E) {
    const int tid = threadIdx.x, wid = __builtin_amdgcn_readfirstlane(tid >> 6), lane = tid & 63, wr = wid >> 2, wc = wid & 3, fr = lane & 15, fq = lane >> 4;
    const int K = g.K, nt = K / BK;
    unsigned voffA[2], voffB[2];
#pragma unroll
    for (int i = 0; i < 2; ++i) { int R, C; stage_rc(tid * 16 + i * 8192, R, C); const int Rb = Epi::PERM ? ((R & ~31) + perm32(R & 31)) : R;
        voffA[i] = (unsigned)(R * g.lda + C) * 2u; voffB[i] = (unsigned)(Rb * g.ldb + C) * 2u; }
    const size_t kstep = (size_t)(BK * 2);
    const size_t hA = (size_t)HALF * g.lda * 2, hB = (size_t)HALF * g.ldb * 2;
    const unsigned ldsw = (unsigned)wid * 1024u;
    const int aoff = lds_byte(wr * 64 + fr, fq * 8), boff = lds_byte(wc * 32 + fr, fq * 8);
#define PG8_SA(b, h) (((b) * 2 + (h)) * HTB)
#define PG8_SB(b, h) ((4 + (b) * 2 + (h)) * HTB)
#define PG8_STAGE(bufoff, gbase, voff) do { _Pragma("unroll") for (int _i = 0; _i < 2; ++_i) \
        __builtin_amdgcn_global_load_lds((const unsigned*)((const char*)(gbase) + (voff)[_i]), (PG8_LAS unsigned*)(lds + (bufoff) + ldsw + _i * 8192), 16, 0, 0); } while (0)
#define PG8_LDA(dst, b, h) do { _Pragma("unroll") for (int m = 0; m < 4; ++m) _Pragma("unroll") for (int k = 0; k < 2; ++k) dst[m][k] = *(const PG8_LAS bf16x8*)(lds + PG8_SA(b, h) + aoff + m * 2048 + k * 1024); } while (0)
#define PG8_LDB(dst, b, h) do { _Pragma("unroll") for (int n = 0; n < 2; ++n) _Pragma("unroll") for (int k = 0; k < 2; ++k) dst[n][k] = *(const PG8_LAS bf16x8*)(lds + PG8_SB(b, h) + boff + n * 2048 + k * 1024); } while (0)
#define PG8_MMA(ai, bj, At, Bt) do { __builtin_amdgcn_s_setprio(1); _Pragma("unroll") for (int m = 0; m < 4; ++m) _Pragma("unroll") for (int n = 0; n < 2; ++n) _Pragma("unroll") for (int k = 0; k < 2; ++k) \
        acc[ai][bj][m][n] = __builtin_amdgcn_mfma_f32_16x16x32_bf16(Bt[n][k], At[m][k], acc[ai][bj][m][n], 0, 0, 0); __builtin_amdgcn_s_setprio(0); } while (0)
#define PG8_WAIT_V(n) asm volatile("s_waitcnt vmcnt(" #n ")" ::: "memory")
#define PG8_WAIT_L(n) asm volatile("s_waitcnt lgkmcnt(" #n ")" ::: "memory")
#define PG8_BAR __builtin_amdgcn_s_barrier()
#define PG8_SCHED __builtin_amdgcn_sched_barrier(0)
    Unit cur, nxt; int ui = 0;
    if (!S.next(0, cur)) return;
    f32x4 acc[2][2][4][2];
#pragma unroll
    for (int a = 0; a < 2; ++a)
#pragma unroll
        for (int b = 0; b < 2; ++b)
#pragma unroll
            for (int m = 0; m < 4; ++m)
#pragma unroll
                for (int n = 0; n < 2; ++n) acc[a][b][m][n] = (f32x4){0.f, 0.f, 0.f, 0.f};
    bf16x8 At[4][2], B0[2][2], B1[2][2];
    const char* cA = g.a_ptr(cur); const char* cB = g.b_ptr(cur);
    S.a_ready(cur);
    if constexpr (SP2) {
        PG8_STAGE(PG8_SB(0, 0), cB, voffB); PG8_STAGE(PG8_SB(0, 1), cB + hB, voffB); PG8_STAGE(PG8_SA(0, 0), cA, voffA); PG8_STAGE(PG8_SA(0, 1), cA + hA, voffA);
        if (wr == 1) PG8_BAR;
        PG8_WAIT_V(2); PG8_BAR;
        PG8_STAGE(PG8_SB(1, 0), cB + kstep, voffB); PG8_STAGE(PG8_SA(1, 0), cA + kstep, voffA); PG8_STAGE(PG8_SB(1, 1), cB + hB + kstep, voffB);
        PG8_WAIT_V(6); PG8_BAR;
    } else {
        PG8_STAGE(PG8_SB(0, 0), cB, voffB); PG8_STAGE(PG8_SA(0, 0), cA, voffA); PG8_STAGE(PG8_SB(0, 1), cB + hB, voffB); PG8_STAGE(PG8_SA(0, 1), cA + hA, voffA);
        if (wr == 1) PG8_BAR;
        PG8_WAIT_V(4); PG8_BAR;
        PG8_STAGE(PG8_SB(1, 0), cB + kstep, voffB); PG8_STAGE(PG8_SA(1, 0), cA + kstep, voffA); PG8_STAGE(PG8_SB(1, 1), cB + hB + kstep, voffB);
        PG8_WAIT_V(6); PG8_BAR;
    }
    for (;;) {
        const bool has_next = S.next(ui + 1, nxt);
        const char* nA = has_next ? g.a_ptr(nxt) : cA; const char* nB = has_next ? g.b_ptr(nxt) : cB;
        for (int t = 0; t < nt; t += 2) {
            const bool last = (t == nt - 2);
            const char* a1 = cA + (size_t)(t + 1) * kstep;
            const char* a2 = last ? nA : cA + (size_t)(t + 2) * kstep; const char* b2 = last ? nB : cB + (size_t)(t + 2) * kstep;
            const char* a3 = a2 + kstep; const char* b3 = b2 + kstep;
            if (last && has_next) S.a_ready(nxt);
            if constexpr (SP2) {
            PG8_LDB(B0, 0, 0); PG8_LDB(B1, 0, 1); PG8_SCHED; PG8_LDA(At, 0, 0); PG8_STAGE(PG8_SA(1, 1), a1 + hA, voffA);
            PG8_WAIT_V(8); PG8_WAIT_L(0); PG8_BAR; PG8_MMA(0, 0, At, B0); PG8_MMA(0, 1, At, B1); PG8_BAR; PG8_SCHED;
            PG8_LDA(At, 0, 1); PG8_STAGE(PG8_SB(0, 0), b2, voffB); PG8_STAGE(PG8_SB(0, 1), b2 + hB, voffB); PG8_STAGE(PG8_SA(0, 0), a2, voffA);
            PG8_WAIT_V(8); PG8_WAIT_L(0); PG8_BAR; PG8_MMA(1, 0, At, B0); PG8_MMA(1, 1, At, B1); PG8_BAR; PG8_SCHED;
            PG8_LDB(B0, 1, 0); PG8_LDB(B1, 1, 1); PG8_SCHED; PG8_LDA(At, 1, 0); PG8_STAGE(PG8_SA(0, 1), a2 + hA, voffA);
            PG8_WAIT_V(8); PG8_WAIT_L(0); PG8_BAR; PG8_MMA(0, 0, At, B0); PG8_MMA(0, 1, At, B1); PG8_BAR; PG8_SCHED;
            PG8_LDA(At, 1, 1); PG8_STAGE(PG8_SB(1, 0), b3, voffB); PG8_STAGE(PG8_SB(1, 1), b3 + hB, voffB); PG8_STAGE(PG8_SA(1, 0), a3, voffA);
            PG8_WAIT_V(8); PG8_WAIT_L(0); PG8_BAR; PG8_MMA(1, 0, At, B0); PG8_MMA(1, 1, At, B1); PG8_BAR; PG8_SCHED;
            } else {
            PG8_LDB(B0, 0, 0); PG8_SCHED; PG8_LDA(At, 0, 0); PG8_STAGE(PG8_SA(1, 1), a1 + hA, voffA);
            PG8_WAIT_L(8); PG8_BAR; PG8_WAIT_L(0); PG8_MMA(0, 0, At, B0); PG8_BAR; PG8_SCHED;
            PG8_LDB(B1, 0, 1); PG8_STAGE(PG8_SB(0, 0), b2, voffB);
            PG8_BAR; PG8_WAIT_L(0); PG8_MMA(0, 1, At, B1); PG8_BAR;
            PG8_LDA(At, 0, 1); PG8_STAGE(PG8_SA(0, 0), a2, voffA);
            PG8_BAR; PG8_WAIT_L(0); PG8_MMA(1, 0, At, B0); PG8_BAR; PG8_SCHED;
            PG8_STAGE(PG8_SB(0, 1), b2 + hB, voffB);
            PG8_WAIT_V(6); PG8_BAR; PG8_MMA(1, 1, At, B1); PG8_BAR;
            PG8_LDB(B0, 1, 0); PG8_SCHED; PG8_LDA(At, 1, 0); PG8_STAGE(PG8_SA(0, 1), a2 + hA, voffA);
            PG8_WAIT_L(8); PG8_BAR; PG8_WAIT_L(0); PG8_MMA(0, 0, At, B0); PG8_BAR; PG8_SCHED;
            PG8_LDB(B1, 1, 1); PG8_STAGE(PG8_SB(1, 0), b3, voffB);
            PG8_BAR; PG8_WAIT_L(0); PG8_MMA(0, 1, At, B1); PG8_BAR;
            PG8_LDA(At, 1, 1); PG8_STAGE(PG8_SA(1, 0), a3, voffA);
            PG8_BAR; PG8_WAIT_L(0); PG8_MMA(1, 0, At, B0); PG8_BAR; PG8_SCHED;
            PG8_STAGE(PG8_SB(1, 1), b3 + hB, voffB);
            PG8_WAIT_V(6); PG8_BAR; PG8_MMA(1, 1, At, B1); PG8_BAR;
            }
        }
        if constexpr (ALIGN_EPI) { if (wr == 0) PG8_BAR; }
        if constexpr (!Epi::AFTER_DRAIN) { E(acc, cur, wr, wc, fr, fq); S.done(cur); }
        if (!has_next) break;
#pragma unroll
        for (int a = 0; a < 2; ++a)
#pragma unroll
            for (int b = 0; b < 2; ++b)
#pragma unroll
                for (int m = 0; m < 4; ++m)
#pragma unroll
                    for (int n = 0; n < 2; ++n) acc[a][b][m][n] = (f32x4){0.f, 0.f, 0.f, 0.f};
        cur = nxt; cA = nA; cB = nB; ++ui;
        if constexpr (ALIGN_EPI) { if (wr == 1) PG8_BAR; }
    }
    PG8_WAIT_V(0);
    if constexpr (!ALIGN_EPI) { if (wr == 0) PG8_BAR; }
    PG8_BAR;
    if constexpr (Epi::AFTER_DRAIN) { E.fused(acc, cur, wr, wc, fr, fq, lds, wid, lane); S.done(cur); }
#undef PG8_SA
#undef PG8_SB
#undef PG8_STAGE
#undef PG8_LDA
#undef PG8_LDB
#undef PG8_MMA
#undef PG8_WAIT_V
#undef PG8_WAIT_L
#undef PG8_BAR
#undef PG8_SCHED
}
}

namespace att {
using bf16_t = unsigned short;
using bf16x8 = __attribute__((ext_vector_type(8))) short;
using s16x4  = __attribute__((ext_vector_type(4))) short;
using f32x16 = __attribute__((ext_vector_type(16))) float;
using u32x4  = __attribute__((ext_vector_type(4))) unsigned;
using u32x2  = __attribute__((ext_vector_type(2))) unsigned;
constexpr int   D = 128, NW = 8, QBLK = 32, KVBLK = 64, NT = 4;
constexpr float SCALE = 0.088388347648318440f;
constexpr float THR = 8.f;
constexpr int   LDQ = 2048, LDK = 2048;
constexpr size_t SHM_V = KVBLK * D * 2, SHM_K = KVBLK * D * 2, SHM_ATTN = 2 * SHM_V + 2 * SHM_K;
#define KSWZ(row, colB) ((row) * 256 + ((colB) ^ (((row) & 7) << 4)))
#define SBAR() __builtin_amdgcn_sched_barrier(0)
__device__ __forceinline__ int crow(int r, int hi) { return (r & 3) + 8 * (r >> 2) + 4 * hi; }
__device__ __forceinline__ unsigned cvtpk(float lo, float hi) { unsigned r; asm volatile("v_cvt_pk_bf16_f32 %0, %1, %2" : "=v"(r) : "v"(lo), "v"(hi)); return r; }

__device__ __forceinline__ void partialSM(f32x16& p0, f32x16& p1, float& m_reg, float& mn, float& alpha) {
  constexpr float C = SCALE * 1.4426950408889634f;
  float pmax = p0[0];
#pragma unroll
  for (int r = 1; r < 16; ++r) pmax = fmaxf(pmax, p0[r]);
#pragma unroll
  for (int r = 0; r < 16; ++r) pmax = fmaxf(pmax, p1[r]);
  { auto rr = __builtin_amdgcn_permlane32_swap(__float_as_uint(pmax), __float_as_uint(pmax), false, false);
    pmax = fmaxf(__uint_as_float(rr[0]), __uint_as_float(rr[1])); }
  if (__builtin_expect(__all(pmax - m_reg <= THR / SCALE), 1)) { mn = m_reg; alpha = 1.f; }
  else { mn = fmaxf(m_reg, pmax); alpha = __builtin_amdgcn_exp2f((m_reg - mn) * C); m_reg = mn; }
  float mnC = -mn * C;
#pragma unroll
  for (int r = 0; r < 16; ++r) p0[r] = fmaf(p0[r], C, mnC);
#pragma unroll
  for (int r = 0; r < 16; ++r) p1[r] = fmaf(p1[r], C, mnC);
#pragma unroll
  for (int r = 0; r < 16; ++r) p0[r] = __builtin_amdgcn_exp2f(p0[r]);
}
__device__ __forceinline__ void finishSM(f32x16& p0, f32x16& p1, float alpha, float& l_reg, bf16x8& pa0, bf16x8& pa1, bf16x8& pa2, bf16x8& pa3) {
#pragma unroll
  for (int r = 0; r < 16; ++r) p1[r] = __builtin_amdgcn_exp2f(p1[r]);
  float ps = 0;
#pragma unroll
  for (int r = 0; r < 16; ++r) ps += p0[r];
#pragma unroll
  for (int r = 0; r < 16; ++r) ps += p1[r];
  { auto rr = __builtin_amdgcn_permlane32_swap(__float_as_uint(ps), __float_as_uint(ps), false, false);
    ps = __uint_as_float(rr[0]) + __uint_as_float(rr[1]); }
  l_reg = l_reg * alpha + ps;
#define PK4(P, BASE, OUT) do { unsigned a0 = cvtpk(P[BASE + 0], P[BASE + 1]), a1 = cvtpk(P[BASE + 2], P[BASE + 3]);   \
    unsigned b0 = cvtpk(P[BASE + 4], P[BASE + 5]), b1 = cvtpk(P[BASE + 6], P[BASE + 7]);                              \
    auto r0 = __builtin_amdgcn_permlane32_swap(a0, b0, false, false); auto r1 = __builtin_amdgcn_permlane32_swap(a1, b1, false, false); \
    u32x4 w = {r0[0], r1[0], r0[1], r1[1]}; OUT = *reinterpret_cast<bf16x8*>(&w); } while (0)
  PK4(p0, 0, pa0); PK4(p0, 8, pa1); PK4(p1, 0, pa2); PK4(p1, 8, pa3);
#undef PK4
}
__device__ __forceinline__ void qkt(f32x16& p0, f32x16& p1, const char* Ks, const bf16x8* qr, int r32, int hi) {
  p0 = f32x16{}; p1 = f32x16{};
#pragma unroll
  for (int d0 = 0; d0 < 8; ++d0) { int cb = (d0 * 16 + hi * 8) * 2;
    bf16x8 b0 = *reinterpret_cast<const bf16x8*>(Ks + KSWZ(r32, cb));
    bf16x8 b1 = *reinterpret_cast<const bf16x8*>(Ks + KSWZ(32 + r32, cb));
    p0 = __builtin_amdgcn_mfma_f32_32x32x16_bf16(b0, qr[d0], p0, 0, 0, 0);
    p1 = __builtin_amdgcn_mfma_f32_32x32x16_bf16(b1, qr[d0], p1, 0, 0, 0); }
}
__device__ __forceinline__ void cmask(f32x16& p0, f32x16& p1, int jt, int qloc, int hi) {
#pragma unroll
  for (int r = 0; r < 16; ++r) { const int key = 64 * jt + crow(r, hi); if (key > qloc) p0[r] = -1e30f; if (key + 32 > qloc) p1[r] = -1e30f; }
}
__device__ __forceinline__ int v_st(int k, int c) { const int kk = (k & ~0xC) | ((k & 4) << 1) | ((k & 8) >> 1); return ((kk >> 3) * 4 + (c >> 5)) * 512 + ((kk & 7) * 32 + (c & 31)) * 2; }
__device__ __forceinline__ int v_rd_base(int lane) { return ((lane & 3) << 3) | (((lane >> 2) & 3) << 6) | (((lane >> 4) & 1) << 5) | (((lane >> 5) & 1) << 8); }
constexpr int v_rd_off(int d0, int ks, int half) { return d0 * 512 + ks * 4096 + half * 2048; }
template <int OFF> __device__ __forceinline__ s16x4 tr_read(int vb) {
  s16x4 r; asm volatile("ds_read_b64_tr_b16 %0, %1 offset:%2" : "=&v"(r) : "v"(vb), "i"(OFF) : "memory"); return r;
}
template <int D0> __device__ __forceinline__ void pv_one(f32x16& od, int vb, bf16x8 pa0, bf16x8 pa1, bf16x8 pa2, bf16x8 pa3) {
  const s16x4 l0 = tr_read<v_rd_off(D0, 0, 0)>(vb), h0 = tr_read<v_rd_off(D0, 0, 1)>(vb), l1 = tr_read<v_rd_off(D0, 1, 0)>(vb), h1 = tr_read<v_rd_off(D0, 1, 1)>(vb);
  const s16x4 l2 = tr_read<v_rd_off(D0, 2, 0)>(vb), h2 = tr_read<v_rd_off(D0, 2, 1)>(vb), l3 = tr_read<v_rd_off(D0, 3, 0)>(vb), h3 = tr_read<v_rd_off(D0, 3, 1)>(vb);
  asm volatile("s_waitcnt lgkmcnt(0)" ::: "memory"); SBAR();
#define PK(L, H) (bf16x8){L[0], L[1], L[2], L[3], H[0], H[1], H[2], H[3]}
  od = __builtin_amdgcn_mfma_f32_32x32x16_bf16(PK(l0, h0), pa0, od, 0, 0, 0);
  od = __builtin_amdgcn_mfma_f32_32x32x16_bf16(PK(l1, h1), pa1, od, 0, 0, 0);
  od = __builtin_amdgcn_mfma_f32_32x32x16_bf16(PK(l2, h2), pa2, od, 0, 0, 0);
  od = __builtin_amdgcn_mfma_f32_32x32x16_bf16(PK(l3, h3), pa3, od, 0, 0, 0);
#undef PK
}
__device__ __forceinline__ void pv_d0(f32x16* o, int vb, bf16x8 pa0, bf16x8 pa1, bf16x8 pa2, bf16x8 pa3) {
  pv_one<0>(o[0], vb, pa0, pa1, pa2, pa3); pv_one<1>(o[1], vb, pa0, pa1, pa2, pa3); pv_one<2>(o[2], vb, pa0, pa1, pa2, pa3); pv_one<3>(o[3], vb, pa0, pa1, pa2, pa3);
}

__device__ __forceinline__ void attn_item(const bf16_t* __restrict__ Qrow, const bf16_t* __restrict__ Kh, const bf16_t* __restrict__ Vh, bool causal, int qloc,
                                          bf16_t* Orow, float2* MLrow, bool valid, char* lds) {
  const int tid = threadIdx.x, lane = tid & 63, r32 = lane & 31, hi = lane >> 5;
  char* V_lds = lds; char* K_lds = lds + 2 * SHM_V;
  float m_reg = -1e30f, l_reg = 0; f32x16 o[4] = {}; bf16x8 qr[8];
  const bf16_t* Qw = Qrow + hi * 8;
#pragma unroll
  for (int d0 = 0; d0 < 8; ++d0) qr[d0] = *reinterpret_cast<const bf16x8*>(Qw + d0 * 16);
  const int sr = tid >> 4, sc = (tid & 15) * 8, vst0 = v_st(sr, sc), vst1 = v_st(32 + sr, sc);
  const int vb0 = (int)(uintptr_t)V_lds + v_rd_base(lane);
  struct { bf16x8 vs0, vs1, ks0, ks1; } sr_[2];
#define SLOAD(i, k0) do { sr_[i].vs0 = *reinterpret_cast<const bf16x8*>(&Vh[(long)((k0) + sr) * LDK + sc]); sr_[i].vs1 = *reinterpret_cast<const bf16x8*>(&Vh[(long)((k0) + 32 + sr) * LDK + sc]); \
    sr_[i].ks0 = *reinterpret_cast<const bf16x8*>(&Kh[(long)((k0) + sr) * LDK + sc]); sr_[i].ks1 = *reinterpret_cast<const bf16x8*>(&Kh[(long)((k0) + 32 + sr) * LDK + sc]); } while (0)
#define SWRITE(b, i) do { *(bf16x8*)(V_lds + (b) * SHM_V + vst0) = sr_[i].vs0;          \
    *(bf16x8*)(V_lds + (b) * SHM_V + vst1) = sr_[i].vs1; int kc = sc * 2;               \
    *(bf16x8*)(K_lds + (b) * SHM_K + KSWZ(sr, kc)) = sr_[i].ks0;                       \
    *(bf16x8*)(K_lds + (b) * SHM_K + KSWZ(32 + sr, kc)) = sr_[i].ks1; } while (0)
#define SWAIT() asm volatile("s_waitcnt vmcnt(4)" ::: "memory")
#define RESC(a) do { if (__any((a) < 1.f)) { _Pragma("unroll") for (int d = 0; d < 4; ++d) _Pragma("unroll") for (int r = 0; r < 16; ++r) o[d][r] *= (a); } } while (0)
  f32x16 pA0, pA1, pB0, pB1; float mnA, mnB, alA, alB; bf16x8 pa0, pa1, pa2, pa3;
  constexpr int SE = 0, SO = 1;
  SLOAD(SE, 0); asm volatile("s_waitcnt vmcnt(0)" ::: "memory"); SWRITE(0, SE); __syncthreads();
  qkt(pA0, pA1, K_lds, qr, r32, hi); if (causal) cmask(pA0, pA1, 0, qloc, hi); partialSM(pA0, pA1, m_reg, mnA, alA);
  SLOAD(SO, KVBLK); SLOAD(SE, 2 * KVBLK);
  SWAIT(); SWRITE(1, SO); __syncthreads();
  {
    SBAR(); qkt(pB0, pB1, K_lds + SHM_K, qr, r32, hi); if (causal) cmask(pB0, pB1, 1, qloc, hi);
    finishSM(pA0, pA1, alA, l_reg, pa0, pa1, pa2, pa3); SBAR();
    SLOAD(SO, 3 * KVBLK); SBAR();
    pv_d0(o, vb0, pa0, pa1, pa2, pa3); partialSM(pB0, pB1, m_reg, mnB, alB);
    __syncthreads(); SWAIT(); SWRITE(0, SE);
    RESC(alB); __syncthreads();
    SBAR(); qkt(pA0, pA1, K_lds, qr, r32, hi); if (causal) cmask(pA0, pA1, 2, qloc, hi);
    finishSM(pB0, pB1, alB, l_reg, pa0, pa1, pa2, pa3); SBAR();
    pv_d0(o, vb0 + (int)SHM_V, pa0, pa1, pa2, pa3); partialSM(pA0, pA1, m_reg, mnA, alA);
    __syncthreads(); asm volatile("s_waitcnt vmcnt(0)" ::: "memory"); SWRITE(1, SO);
    RESC(alA); __syncthreads();
  }
  SBAR(); qkt(pB0, pB1, K_lds + SHM_K, qr, r32, hi); if (causal) cmask(pB0, pB1, 3, qloc, hi);
  finishSM(pA0, pA1, alA, l_reg, pa0, pa1, pa2, pa3); SBAR();
  pv_d0(o, vb0, pa0, pa1, pa2, pa3); partialSM(pB0, pB1, m_reg, mnB, alB);
  __syncthreads(); RESC(alB);
  finishSM(pB0, pB1, alB, l_reg, pa0, pa1, pa2, pa3); SBAR();
  pv_d0(o, vb0 + (int)SHM_V, pa0, pa1, pa2, pa3);
  const float rl = 1.0f / l_reg;
  if (valid) {
#pragma unroll
    for (int d0 = 0; d0 < 4; ++d0)
#pragma unroll
      for (int g = 0; g < 4; ++g) { u32x2 w; w.x = cvtpk(o[d0][4 * g] * rl, o[d0][4 * g + 1] * rl); w.y = cvtpk(o[d0][4 * g + 2] * rl, o[d0][4 * g + 3] * rl);
        *reinterpret_cast<u32x2*>(Orow + 32 * d0 + 8 * g + 4 * hi) = w; }
    if (hi == 0) *MLrow = make_float2(m_reg, l_reg);
  }
#undef SLOAD
#undef SWRITE
#undef SWAIT
#undef RESC
}

struct ItemCtx { const bf16_t* Q; const bf16_t* K; const bf16_t* V; bf16_t* PO; float2* ML; const unsigned short* lists; };
__device__ __forceinline__ unsigned item_entry(const ItemCtx& C, const __attribute__((address_space(3))) int* D, int k, int rloc) {
  const int own = D[4 * k + 1], j = D[4 * k] & 31, cnt = D[4 * k + 3];
  if (own) return (unsigned)(256 * j + rloc) | (3u << 13);
  return (unsigned)C.lists[(size_t)(unsigned)D[4 * k + 2] + (rloc < cnt ? rloc : 0)];
}
__device__ __forceinline__ void attn_items(const ItemCtx& C, const __attribute__((address_space(3))) int* D, int nloc, char* lds) {
  if (nloc <= 0) return;
  const int tid = threadIdx.x, wid = tid >> 6, lane = tid & 63, r32 = lane & 31, hi = lane >> 5, rloc = 32 * wid + r32;
  char* V_lds = lds; char* K_lds = lds + 2 * SHM_V;
  const int sr = tid >> 4, sc = (tid & 15) * 8, vst0 = v_st(sr, sc), vst1 = v_st(32 + sr, sc);
  const int vb0 = (int)(uintptr_t)V_lds + v_rd_base(lane);
  struct { bf16x8 vs0, vs1, ks0, ks1; } sr_[2];
  bf16x8 qr[8];
#define KVBASE(k, Kh, Vh) const bf16_t* Kh; const bf16_t* Vh; { const int bhj_ = D[4 * (k)], bh_ = bhj_ >> 5, j_ = bhj_ & 31; \
    const size_t off_ = ((size_t)(bh_ >> 4) * 8192 + 256 * j_) * LDK + (bh_ & 15) * D_; Kh = C.K + off_; Vh = C.V + off_; }
#define SLOADP(i, Kh, Vh, k0) do { sr_[i].vs0 = *reinterpret_cast<const bf16x8*>(&Vh[(long)((k0) + sr) * LDK + sc]); sr_[i].vs1 = *reinterpret_cast<const bf16x8*>(&Vh[(long)((k0) + 32 + sr) * LDK + sc]); \
    sr_[i].ks0 = *reinterpret_cast<const bf16x8*>(&Kh[(long)((k0) + sr) * LDK + sc]); sr_[i].ks1 = *reinterpret_cast<const bf16x8*>(&Kh[(long)((k0) + 32 + sr) * LDK + sc]); } while (0)
#define SWRITE(b, i) do { *(bf16x8*)(V_lds + (b) * SHM_V + vst0) = sr_[i].vs0;          \
    *(bf16x8*)(V_lds + (b) * SHM_V + vst1) = sr_[i].vs1; int kc = sc * 2;               \
    *(bf16x8*)(K_lds + (b) * SHM_K + KSWZ(sr, kc)) = sr_[i].ks0;                       \
    *(bf16x8*)(K_lds + (b) * SHM_K + KSWZ(32 + sr, kc)) = sr_[i].ks1; } while (0)
#define QLOAD(e, k) do { const int bh_ = D[4 * (k)] >> 5; const bf16_t* Qw_ = C.Q + ((size_t)(bh_ >> 4) * 8192 + ((e) & 8191u)) * LDQ + (bh_ & 15) * D_ + hi * 8; \
    _Pragma("unroll") for (int d0 = 0; d0 < 8; ++d0) qr[d0] = *reinterpret_cast<const bf16x8*>(Qw_ + d0 * 16); } while (0)
#define RESC(a) do { if (__any((a) < 1.f)) { _Pragma("unroll") for (int d = 0; d < 4; ++d) _Pragma("unroll") for (int r = 0; r < 16; ++r) o[d][r] *= (a); } } while (0)
  constexpr int D_ = 128, SE = 0, SO = 1;
  unsigned e_cur = item_entry(C, D, 0, rloc), e_nxt = (nloc > 1) ? item_entry(C, D, 1, rloc) : 0u;
  { KVBASE(0, Kh, Vh); SLOADP(SE, Kh, Vh, 0); SLOADP(SO, Kh, Vh, KVBLK); }
  QLOAD(e_cur, 0);
  for (int k = 0; k < nloc; ++k) {
    const bool has_next = (k + 1 < nloc);
    const bool causal = D[4 * k + 1] != 0; const int cnt = D[4 * k + 3];
    KVBASE(k, Kh, Vh);
    float m_reg = -1e30f, l_reg = 0; f32x16 o[4] = {};
    f32x16 pA0, pA1, pB0, pB1; float mnA, mnB, alA, alB; bf16x8 pa0, pa1, pa2, pa3;
    asm volatile("s_waitcnt vmcnt(0)" ::: "memory"); SWRITE(0, SE); __syncthreads();
    qkt(pA0, pA1, K_lds, qr, r32, hi); if (causal) cmask(pA0, pA1, 0, rloc, hi); partialSM(pA0, pA1, m_reg, mnA, alA);
    SLOADP(SE, Kh, Vh, 2 * KVBLK);
    SWRITE(1, SO); __syncthreads();
    SLOADP(SO, Kh, Vh, 3 * KVBLK);
    SBAR(); qkt(pB0, pB1, K_lds + SHM_K, qr, r32, hi); if (causal) cmask(pB0, pB1, 1, rloc, hi);
    finishSM(pA0, pA1, alA, l_reg, pa0, pa1, pa2, pa3); SBAR();
    pv_d0(o, vb0, pa0, pa1, pa2, pa3); partialSM(pB0, pB1, m_reg, mnB, alB);
    __syncthreads(); asm volatile("s_waitcnt vmcnt(4)" ::: "memory"); SWRITE(0, SE);
    RESC(alB); __syncthreads();
    if (has_next) { KVBASE(k + 1, Kn, Vn); SLOADP(SE, Kn, Vn, 0); }
    SBAR(); qkt(pA0, pA1, K_lds, qr, r32, hi); if (causal) cmask(pA0, pA1, 2, rloc, hi);
    finishSM(pB0, pB1, alB, l_reg, pa0, pa1, pa2, pa3); SBAR();
    pv_d0(o, vb0 + (int)SHM_V, pa0, pa1, pa2, pa3); partialSM(pA0, pA1, m_reg, mnA, alA);
    __syncthreads(); SWRITE(1, SO);
    RESC(alA); __syncthreads();
    if (has_next) { KVBASE(k + 1, Kn, Vn); SLOADP(SO, Kn, Vn, KVBLK); }
    SBAR(); qkt(pB0, pB1, K_lds + SHM_K, qr, r32, hi); if (causal) cmask(pB0, pB1, 3, rloc, hi);
    SBAR();
    if (has_next) QLOAD(e_nxt, k + 1);
    finishSM(pA0, pA1, alA, l_reg, pa0, pa1, pa2, pa3); SBAR();
    pv_d0(o, vb0, pa0, pa1, pa2, pa3); partialSM(pB0, pB1, m_reg, mnB, alB);
    __syncthreads(); RESC(alB);
    finishSM(pB0, pB1, alB, l_reg, pa0, pa1, pa2, pa3); SBAR();
    pv_d0(o, vb0 + (int)SHM_V, pa0, pa1, pa2, pa3);
    { const float rl = 1.0f / l_reg; const int bh = D[4 * k] >> 5; const unsigned t = e_cur & 8191u, slot = e_cur >> 13;
      if (rloc < cnt) {
        bf16_t* Orow = C.PO + (((size_t)slot * 32 + bh) * 8192 + t) * D_;
#pragma unroll
        for (int d0 = 0; d0 < 4; ++d0)
#pragma unroll
          for (int g = 0; g < 4; ++g) { u32x2 w; w.x = cvtpk(o[d0][4 * g] * rl, o[d0][4 * g + 1] * rl); w.y = cvtpk(o[d0][4 * g + 2] * rl, o[d0][4 * g + 3] * rl);
            *reinterpret_cast<u32x2*>(Orow + 32 * d0 + 8 * g + 4 * hi) = w; }
        if (hi == 0) C.ML[((size_t)slot * 32 + bh) * 8192 + t] = make_float2(m_reg, l_reg);
      } }
    e_cur = e_nxt; if (k + 2 < nloc) e_nxt = item_entry(C, D, k + 2, rloc);
  }
#undef KVBASE
#undef SLOADP
#undef SWRITE
#undef QLOAD
#undef RESC
}
#undef KSWZ
#undef SBAR
}

constexpr int NWAVES = 8;
#ifndef MK_N_LAUNCHES
#define MK_N_LAUNCHES 1
#endif
constexpr int N_PHASES = 16;
constexpr int N_LAUNCHES = MK_N_LAUNCHES;

constexpr int BATCH = 2, SEQ = 8192, DM = 4096, M = BATCH * SEQ, MEMLEN = 256;
constexpr int PW = 2048, AW = 2048, NH = 16, HD = 128, NBLK = 32, MIXIN = 8192, FF = 11008, XH = 4, XHD = 1024;
constexpr float LN_EPS = 1e-5f;
constexpr float DN_ALPHA = 1.189207115002721f;

constexpr size_t MiB = 1u << 20;
constexpr size_t WS_CTL = 0, CTL_ZERO_BYTES = 1 * MiB;
constexpr size_t WS_ROPE = 1 * MiB;
constexpr size_t WS_KMH = 5 * MiB, WS_KML = 5 * MiB + 512 * 1024;
constexpr size_t WS_MEMB = 6 * MiB;
constexpr size_t WS_KVX = 10 * MiB;
constexpr size_t WS_LIST = 18 * MiB;
constexpr size_t WS_ML = 26 * MiB;
constexpr size_t WS_WIN = 34 * MiB, WS_WPOOL = 98 * MiB, WS_WOUT = 100 * MiB, WS_WXQ = 132 * MiB, WS_WXKV = 164 * MiB, WS_WXO = 228 * MiB, WS_WGU = 260 * MiB, WS_WDN = 432 * MiB;
constexpr size_t WS_ACT = 518 * MiB;
constexpr size_t WS_HP = WS_ACT, WS_Q = WS_ACT + 64 * MiB, WS_K = WS_ACT + 128 * MiB, WS_V = WS_ACT + 192 * MiB;
constexpr size_t WS_XB = WS_ACT + 256 * MiB;
constexpr size_t WS_PARTO = WS_ACT + 256 * MiB;
constexpr size_t WS_CAT = WS_ACT + 512 * MiB;
constexpr size_t WS_TB = WS_ACT;
constexpr size_t WS_HB = WS_ACT + 128 * MiB;
constexpr size_t WS_PB = WS_ACT + 256 * MiB;
constexpr size_t WS_G = WS_ACT + 256 * MiB;
constexpr size_t WS_SLAB = WS_ACT + 384 * MiB;
constexpr size_t WS_WQK = WS_ACT + 640 * MiB, WS_WVOT = WS_ACT + 656 * MiB;
constexpr size_t WS_WOUT2 = WS_ACT + 672 * MiB;
constexpr size_t WS_SLOT = WS_ML;
constexpr size_t WS_STATS = WS_LIST;
constexpr size_t WS_END = WS_ACT + 704 * MiB;
static_assert(WS_WDN + (size_t)DM * FF * 2 <= WS_ACT && WS_G + (size_t)M * FF * 2 <= WS_END && WS_WGU + (size_t)2 * FF * DM * 2 <= WS_WDN, "d_ws map");
constexpr int LIST_STRIDE = 256 * 496;
__host__ __device__ constexpr int list_off(int j) { return 256 * (31 * j - (j * (j - 1)) / 2); }
constexpr int CW_TMO = 0, CW_CODE = 1;
constexpr int CW_BAR = 4096;
constexpr int CW_GCNT = 8192;
constexpr int CW_CHK = 16384;
constexpr int CW_K1 = 32768, CW_K2 = 32768 + 2048;
constexpr int CW_C1G = 65536, CW_C2G = 65536 + 22016;

constexpr int RING_OFF = 0, RING_BYTES = 131072;
constexpr int LDSCTL_OFF = RING_BYTES, MISC_OFF = LDSCTL_OFF + 320;
constexpr int LDS_BYTES = 147456;

#define GAS __attribute__((address_space(1)))
#define LAS __attribute__((address_space(3)))
typedef unsigned short bf16;
typedef unsigned v4u __attribute__((ext_vector_type(4)));
typedef unsigned v2u __attribute__((ext_vector_type(2)));
typedef float f32x4 __attribute__((ext_vector_type(4)));
typedef short bf16x8 __attribute__((ext_vector_type(8)));
typedef float f32x16 __attribute__((ext_vector_type(16)));
typedef GAS unsigned gu32;
#define RLX_AGENT __ATOMIC_RELAXED, __HIP_MEMORY_SCOPE_AGENT
#define LDS_WAIT() asm volatile("s_waitcnt lgkmcnt(0)" ::: "memory")
#define VM_WAIT() asm volatile("s_waitcnt vmcnt(0)" ::: "memory")
__device__ __forceinline__ unsigned f2bf(float f) { unsigned u = __builtin_bit_cast(unsigned, f); return (u + 0x7fffu + ((u >> 16) & 1u)) >> 16; }
__device__ __forceinline__ unsigned pk2(float lo, float hi) { return f2bf(lo) | (f2bf(hi) << 16); }
__device__ __forceinline__ float bf_lo(unsigned w) { return __builtin_bit_cast(float, w << 16); }
__device__ __forceinline__ float bf_hi(unsigned w) { return __builtin_bit_cast(float, w & 0xffff0000u); }
__device__ __forceinline__ float bf2f(bf16 b) { return __builtin_bit_cast(float, ((unsigned)b) << 16); }
#define XB_TMO      128
#define XB_XCNT(j)  (256  + 64 * (j))
#define XB_XSUB(j)  (1280 + 64 * (j))
#define XB_XGEN(j)  (2304 + 64 * (j))
#define XB_TOP      3328
#define XB_TOPGEN   3392
#define XCD_BAR_WORDS 3456
#define XB_SPIN_CAP (1u << 18)

__device__ __forceinline__ unsigned xb_ld(unsigned* p)              { return __hip_atomic_load(p, __ATOMIC_RELAXED, __HIP_MEMORY_SCOPE_AGENT); }
__device__ __forceinline__ unsigned xb_add(unsigned* p, unsigned v) { return __hip_atomic_fetch_add(p, v, __ATOMIC_RELAXED, __HIP_MEMORY_SCOPE_AGENT); }
__device__ __forceinline__ unsigned xb_xcc_id() { return (unsigned)__builtin_amdgcn_s_getreg((3 << 11) | 20) & 0xFu; }
#define XB_SPIN(cond, bar) do { unsigned _sp = 0; while (cond) { __builtin_amdgcn_s_sleep(1); \
    if ((++_sp & 255u) == 0u) { if (xb_ld(&(bar)[XB_TMO])) break; if (_sp > XB_SPIN_CAP) { atomicAdd(&(bar)[XB_TMO], 1u); break; } } } } while (0)

struct XcdBarrier {
    unsigned* bar; unsigned x;
    volatile LAS unsigned* st;
};

__device__ __forceinline__ XcdBarrier xcd_barrier_post(unsigned* bar, volatile LAS unsigned* st) {
    XcdBarrier b; b.bar = bar; b.x = xb_xcc_id(); b.st = st;
    if (threadIdx.x == 0) (void)xb_add(&bar[XB_XCNT(b.x)], 1u);
    return b;
}
__device__ __forceinline__ void xcd_barrier_complete(unsigned* bar, unsigned x, unsigned& nloc, unsigned& nx) {
    const unsigned G = gridDim.x * gridDim.y * gridDim.z;
    unsigned sum, cnt, mine, sp = 0u;
    for (;;) {
        sum = 0u; cnt = 0u; mine = 0u;
#pragma unroll
        for (unsigned j = 0; j < 16; ++j) { const unsigned c = xb_ld(&bar[XB_XCNT(j)]); sum += c; cnt += (c > 0u) ? 1u : 0u; mine = (j == x) ? c : mine; }
        if (sum == G) break;
        __builtin_amdgcn_s_sleep(1);
        if ((++sp & 255u) == 0u) { if (xb_ld(&bar[XB_TMO])) break; if (sp > XB_SPIN_CAP) { atomicAdd(&bar[XB_TMO], 1u); break; } }
    }
    nloc = mine > 0u ? mine : 1u; nx = cnt > 0u ? cnt : 1u;
}

__device__ __forceinline__ void xcd_barrier(const XcdBarrier& b) {
    asm volatile("s_waitcnt vmcnt(0)" ::: "memory");
    __syncthreads();
    if (threadIdx.x == 0) {
        unsigned* bar = b.bar;
        __builtin_amdgcn_s_waitcnt(0);
        unsigned nloc = b.st[0], nx = b.st[1];
        if (nloc == 0u) { xcd_barrier_complete(bar, b.x, nloc, nx); b.st[0] = nloc; b.st[1] = nx; }
        const unsigned old = xb_add(&bar[XB_XSUB(b.x)], 1u);
        const unsigned gen = old / nloc;
        if (old + 1u == (gen + 1u) * nloc) {
            __builtin_amdgcn_fence(__ATOMIC_RELEASE, "agent");
            asm volatile("s_waitcnt vmcnt(0)" ::: "memory");
            const unsigned og = xb_add(&bar[XB_TOP], 1u);
            const unsigned tg = og / nx;
            if (og + 1u == (tg + 1u) * nx) xb_add(&bar[XB_TOPGEN], 1u);
            else XB_SPIN(xb_ld(&bar[XB_TOPGEN]) == tg, bar);
            __builtin_amdgcn_fence(__ATOMIC_ACQUIRE, "agent");
            xb_add(&bar[XB_XGEN(b.x)], 1u);
            asm volatile("s_waitcnt vmcnt(0)" ::: "memory");
        } else {
            XB_SPIN(xb_ld(&bar[XB_XGEN(b.x)]) == gen, bar);
            __builtin_amdgcn_fence(__ATOMIC_ACQUIRE, "agent");
            asm volatile("s_waitcnt vmcnt(0)" ::: "memory");
        }
    }
    __syncthreads();
}

struct Frame {
    LAS unsigned char* lds;
    volatile LAS unsigned* MISC;
    gu32* ctl;
    int tid, lane, wave;
    int G;
    unsigned char* ws;
};
__device__ __forceinline__ float wave_sum(float v) {
#pragma unroll
    for (int o = 1; o < 64; o <<= 1) v += __shfl_xor(v, o);
    return v;
}

template <class RowMap>
__device__ __forceinline__ void p0_transpose_item(const float* W, int K, int N, bf16* WT, LAS float* scr, int item, int lane, const RowMap& rm, const float* colscale,
                                                  const float* kgain = nullptr, const float* kbias = nullptr, float* c1 = nullptr, float* c2 = nullptr) {
    const int nblk = N / 32, kb = item / nblk, nb = item % nblk, k0 = 64 * kb, n0 = 32 * nb;
    float ld[32];
    const float* src = W + (size_t)(k0 + (lane >> 5)) * N + n0 + (lane & 31);
#pragma unroll
    for (int i = 0; i < 32; ++i) ld[i] = *(const GAS float*)(src + (size_t)(2 * i) * N);
#pragma unroll
    for (int i = 0; i < 32; ++i) scr[(2 * i + (lane >> 5)) * 33 + (lane & 31)] = ld[i];
    LDS_WAIT(); asm volatile("" ::: "memory");
    const int c = lane & 7;
    f32x4 g0 = (f32x4){1.f, 1.f, 1.f, 1.f}, g1 = g0, b0 = (f32x4){0.f, 0.f, 0.f, 0.f}, b1 = b0;
    if (kgain) { g0 = *(const GAS f32x4*)(kgain + k0 + 8 * c); g1 = *(const GAS f32x4*)(kgain + k0 + 8 * c + 4); b0 = *(const GAS f32x4*)(kbias + k0 + 8 * c); b1 = *(const GAS f32x4*)(kbias + k0 + 8 * c + 4); }
#pragma unroll
    for (int j = 0; j < 4; ++j) { const int n = (lane >> 3) + 8 * j; const LAS float* s = scr + (8 * c) * 33 + n; const float sc = colscale ? colscale[n0 + n] : 1.0f;
        const float w0 = s[0 * 33] * sc, w1 = s[1 * 33] * sc, w2 = s[2 * 33] * sc, w3 = s[3 * 33] * sc, w4 = s[4 * 33] * sc, w5 = s[5 * 33] * sc, w6 = s[6 * 33] * sc, w7 = s[7 * 33] * sc;
        v4u o; o.x = pk2(w0 * g0.x, w1 * g0.y); o.y = pk2(w2 * g0.z, w3 * g0.w); o.z = pk2(w4 * g1.x, w5 * g1.y); o.w = pk2(w6 * g1.z, w7 * g1.w);
        const int row = rm(n0 + n);
        *(GAS v4u*)(WT + (size_t)row * K + k0 + 8 * c) = o;
        if (c1) {
            float t1 = ((bf_lo(o.x) + bf_hi(o.x)) + (bf_lo(o.y) + bf_hi(o.y))) + ((bf_lo(o.z) + bf_hi(o.z)) + (bf_lo(o.w) + bf_hi(o.w)));
            float t2 = ((w0 * b0.x + w1 * b0.y) + (w2 * b0.z + w3 * b0.w)) + ((w4 * b1.x + w5 * b1.y) + (w6 * b1.z + w7 * b1.w));
            t1 += __shfl_xor(t1, 1); t2 += __shfl_xor(t2, 1); t1 += __shfl_xor(t1, 2); t2 += __shfl_xor(t2, 2); t1 += __shfl_xor(t1, 4); t2 += __shfl_xor(t2, 4);
            if (c == 0) { __hip_atomic_fetch_add(c1 + row, t1, RLX_AGENT); __hip_atomic_fetch_add(c2 + row, t2, RLX_AGENT); } } }
    LDS_WAIT(); asm volatile("" ::: "memory");
}
struct RmIdent { int off; __device__ __forceinline__ int operator()(int n) const { return off + n; } };
struct RmMixIn { __device__ __forceinline__ int operator()(int n) const { if (n < 2048 || n >= 6144) return n; const int d = n & 127; return (n & ~127) + 2 * (d & 63) + (d >> 6); } };
struct RmGateUp { int up; __device__ __forceinline__ int operator()(int n) const { return (n >> 7) * 256 + up * 128 + (n & 127); } };

__device__ __forceinline__ void sincos_d(double a, double& s, double& c) {
    const double n = __builtin_rint(a * 0.63661977236758134308);
    double r = __builtin_fma(-n, 1.5707963267948966, a); r = __builtin_fma(-n, 6.123233995736766e-17, r);
    const double r2 = r * r;
    double ps = -7.6471637318198164759e-13; ps = ps * r2 + 1.6059043836821614599e-10; ps = ps * r2 - 2.5052108385441718775e-08; ps = ps * r2 + 2.7557319223985890653e-06;
    ps = ps * r2 - 1.9841269841269841270e-04; ps = ps * r2 + 8.3333333333333333333e-03; ps = ps * r2 - 1.6666666666666666667e-01; ps = r + r * r2 * ps;
    double pc = 4.7794773323873852974e-14; pc = pc * r2 - 1.1470745597729724714e-11; pc = pc * r2 + 2.0876756987868098979e-09; pc = pc * r2 - 2.7557319223985890653e-07;
    pc = pc * r2 + 2.4801587301587301587e-05; pc = pc * r2 - 1.3888888888888888889e-03; pc = pc * r2 + 4.1666666666666666667e-02; pc = pc * r2 - 0.5; pc = 1.0 + r2 * pc;
    const int q = ((int)n) & 3;
    s = (q == 0) ? ps : (q == 1) ? pc : (q == 2) ? -ps : -pc;
    c = (q == 0) ? pc : (q == 1) ? -ps : (q == 2) ? -pc : ps;
}
__device__ __forceinline__ float rope_inv(int i) {
    const double y = -(double)i * (13.287712379549449 / 64.0); const double fl = __builtin_floor(y); const double z = (y - fl) * 0.69314718055994530942;
    double e = 1.0, term = 1.0;
#pragma unroll
    for (int k = 1; k <= 20; ++k) { term = term * z / (double)k; e += term; }
    return (float)__builtin_ldexp(e, (int)fl);
}

__device__ __forceinline__ void p0_prologue(Frame& F, const float* const* in) {
    LAS float* scr = (LAS float*)(F.lds + RING_OFF + F.wave * 16384);
    const int gw = blockIdx.x * NWAVES + F.wave, NGW = F.G * NWAVES;
    const float* w_mix_in = in[2]; const float* w_pool = in[3]; const float* pool_scale = in[4]; const float* w_mix_out = in[5];
    const float* w_xq = in[8]; const float* w_xkv = in[9]; const float* w_xo = in[10]; const float* w_gate = in[13]; const float* w_up = in[14]; const float* w_down = in[15];
    bf16* WIN = (bf16*)(F.ws + WS_WIN); bf16* WPOOL = (bf16*)(F.ws + WS_WPOOL); bf16* WOUT = (bf16*)(F.ws + WS_WOUT); bf16* WXQ = (bf16*)(F.ws + WS_WXQ);
    bf16* WXKV = (bf16*)(F.ws + WS_WXKV); bf16* WXO = (bf16*)(F.ws + WS_WXO); bf16* WGU = (bf16*)(F.ws + WS_WGU); bf16* WDN = (bf16*)(F.ws + WS_WDN);
    constexpr int I_IN = (DM / 64) * (MIXIN / 32), I_POOL = (512 / 64) * (512 / 32), I_SQ = (DM / 64) * (DM / 32), I_KV = (DM / 64) * (2 * DM / 32), I_GU = (DM / 64) * (FF / 32), I_DN = (FF / 64) * (DM / 32);
    constexpr int NITEMS = I_IN + 2 * I_SQ + I_KV + 2 * I_GU;
    for (int it = gw; it < NITEMS; it += NGW) {
        int r = it;
        if (r < I_IN) { p0_transpose_item(w_mix_in, DM, MIXIN, WIN, scr, r, F.lane, RmMixIn{}, nullptr); continue; } r -= I_IN;
        if (r < I_SQ) { const int kb = r / (DM / 32);
            if (kb < 32) p0_transpose_item(w_mix_out, 2048, DM, WOUT, scr, r, F.lane, RmIdent{0}, nullptr);
            else p0_transpose_item(w_mix_out, DM, DM, (bf16*)(F.ws + WS_WOUT2), scr, r, F.lane, RmIdent{0}, nullptr); continue; } r -= I_SQ;
        if (r < I_KV) { p0_transpose_item(w_xkv, DM, 2 * DM, WXKV, scr, r, F.lane, RmIdent{0}, nullptr); continue; } r -= I_KV;
        if (r < I_SQ) { p0_transpose_item(w_xo, DM, DM, WXO, scr, r, F.lane, RmIdent{0}, nullptr); continue; } r -= I_SQ;
        float* c1g = (float*)(F.ctl + CW_C1G); float* c2g = (float*)(F.ctl + CW_C2G);
        if (r < I_GU) { p0_transpose_item(w_gate, DM, FF, WGU, scr, r, F.lane, RmGateUp{0}, nullptr, in[11], in[12], c1g, c2g); continue; } r -= I_GU;
        p0_transpose_item(w_up, DM, FF, WGU, scr, r, F.lane, RmGateUp{1}, nullptr, in[11], in[12], c1g, c2g);
    }
    const size_t gt = (size_t)blockIdx.x * (NWAVES * 64) + F.tid, NT = (size_t)F.G * NWAVES * 64;
    { const float* x = in[0]; bf16* XB = (bf16*)(F.ws + WS_XB);
      for (size_t i = gt; i < (size_t)M * DM / 8; i += NT) { const f32x4 a = *(const GAS f32x4*)(x + i * 8), b = *(const GAS f32x4*)(x + i * 8 + 4);
          v4u o; o.x = pk2(a.x, a.y); o.y = pk2(a.z, a.w); o.z = pk2(b.x, b.y); o.w = pk2(b.z, b.w); *(GAS v4u*)(XB + i * 8) = o; } }
    { const float* x = w_xq; bf16* XB = WXQ;
      for (size_t i = gt; i < (size_t)DM * DM / 8; i += NT) { const f32x4 a = *(const GAS f32x4*)(x + i * 8), b = *(const GAS f32x4*)(x + i * 8 + 4);
          v4u o; o.x = pk2(a.x, a.y); o.y = pk2(a.z, a.w); o.z = pk2(b.x, b.y); o.w = pk2(b.z, b.w); *(GAS v4u*)(XB + i * 8) = o; } }
    { bf16* WPR = WPOOL;
      for (size_t i = gt; i < (size_t)4 * 512 * 512 / 8; i += NT) { const size_t e = i * 8; const int d = (int)(e & 511), g = (int)(e >> 18);
          const f32x4 a = *(const GAS f32x4*)(w_pool + e), b = *(const GAS f32x4*)(w_pool + e + 4), s0 = *(const GAS f32x4*)(pool_scale + g * 512 + d), s1 = *(const GAS f32x4*)(pool_scale + g * 512 + d + 4);
          v4u o; o.x = pk2(a.x * s0.x, a.y * s0.y); o.y = pk2(a.z * s0.z, a.w * s0.w); o.z = pk2(b.x * s1.x, b.y * s1.y); o.w = pk2(b.z * s1.z, b.w * s1.w); *(GAS v4u*)(WPR + e) = o; } }
    { const float* x = in[1]; bf16* XB = (bf16*)(F.ws + WS_MEMB);
      for (size_t i = gt; i < (size_t)BATCH * MEMLEN * DM / 8; i += NT) { const f32x4 a = *(const GAS f32x4*)(x + i * 8), b = *(const GAS f32x4*)(x + i * 8 + 4);
          v4u o; o.x = pk2(a.x, a.y); o.y = pk2(a.z, a.w); o.z = pk2(b.x, b.y); o.w = pk2(b.z, b.w); *(GAS v4u*)(XB + i * 8) = o; } }
    { float2* tab = (float2*)(F.ws + WS_ROPE);
      for (size_t i = gt; i < (size_t)SEQ * 64; i += NT) { const int pos = (int)(i >> 6), fi = (int)(i & 63); const float ang = (float)pos * rope_inv(fi);
          double s, c; sincos_d((double)ang, s, c); tab[i] = make_float2((float)c, (float)s); } }
}

__device__ __forceinline__ void convert_wdown(Frame& F, const float* w_down, int rk, int nwg) {
    LAS float* scr = (LAS float*)(F.lds + RING_OFF + F.wave * 16384); bf16* WDN = (bf16*)(F.ws + WS_WDN);
    constexpr int I_DN = (FF / 64) * (DM / 32);
    for (int it = rk * NWAVES + F.wave; it < I_DN; it += nwg * NWAVES) p0_transpose_item(w_down, FF, DM, WDN, scr, it, F.lane, RmIdent{0}, nullptr);
}

__device__ __forceinline__ void ln_finalize(Frame& F, const float2* slots, float2* stats) {
    const int gw = blockIdx.x * NWAVES + F.wave, NGW = F.G * NWAVES;
    for (int m = gw; m < M; m += NGW) { const float2 p = slots[(size_t)m * 64 + F.lane];
        const float s = wave_sum(p.x), q = wave_sum(p.y), mean = s * (1.f / DM), var = fmaxf(q * (1.f / DM) - mean * mean, 0.f);
        if (F.lane == 0) stats[m] = make_float2(mean, 1.f / sqrtf(var + LN_EPS)); }
}

template <bool FINAL>
__device__ __forceinline__ void ln_rows(Frame& F, const bf16* T, bf16* XB, float2* stats, float* OUT, const float* g, const float* b) {
    constexpr int NR = 2;
    const int gw = blockIdx.x * NWAVES + F.wave, NGW = F.G * NWAVES;
    for (int mb = gw; mb < M; mb += NR * NGW) {
        int mr[NR]; v4u r[NR][8];
#pragma unroll
        for (int i = 0; i < NR; ++i) { mr[i] = (mb + i * NGW < M) ? mb + i * NGW : mb;
            const GAS v4u* tr = (const GAS v4u*)(T + (size_t)mr[i] * DM) + F.lane;
#pragma unroll
            for (int j = 0; j < 8; ++j) r[i][j] = tr[64 * j]; }
        float mean[NR], rstd[NR];
#pragma unroll
        for (int i = 0; i < NR; ++i) { float s = 0.f;
#pragma unroll
            for (int j = 0; j < 8; ++j) s += ((bf_lo(r[i][j].x) + bf_hi(r[i][j].x)) + (bf_lo(r[i][j].y) + bf_hi(r[i][j].y))) + ((bf_lo(r[i][j].z) + bf_hi(r[i][j].z)) + (bf_lo(r[i][j].w) + bf_hi(r[i][j].w)));
            mean[i] = wave_sum(s) * (1.f / DM); }
#pragma unroll
        for (int i = 0; i < NR; ++i) { float q = 0.f; const float mu = mean[i];
#pragma unroll
            for (int j = 0; j < 8; ++j) { float d;
                d = bf_lo(r[i][j].x) - mu; q += d * d; d = bf_hi(r[i][j].x) - mu; q += d * d; d = bf_lo(r[i][j].y) - mu; q += d * d; d = bf_hi(r[i][j].y) - mu; q += d * d;
                d = bf_lo(r[i][j].z) - mu; q += d * d; d = bf_hi(r[i][j].z) - mu; q += d * d; d = bf_lo(r[i][j].w) - mu; q += d * d; d = bf_hi(r[i][j].w) - mu; q += d * d; }
            rstd[i] = 1.f / sqrtf(wave_sum(q) * (1.f / DM) + LN_EPS); }
        if (!FINAL && F.lane == 0) {
#pragma unroll
            for (int i = 0; i < NR; ++i) stats[mr[i]] = make_float2(mean[i], rstd[i]); }
#pragma unroll
        for (int j = 0; j < 8; ++j) { const int c = (64 * j + F.lane) * 8;
            const f32x4 g0 = *(const GAS f32x4*)(g + c), g1 = *(const GAS f32x4*)(g + c + 4), b0 = *(const GAS f32x4*)(b + c), b1 = *(const GAS f32x4*)(b + c + 4);
#pragma unroll
            for (int i = 0; i < NR; ++i) { const float mu = mean[i], rs = rstd[i];
                const f32x4 ya = ((f32x4){bf_lo(r[i][j].x), bf_hi(r[i][j].x), bf_lo(r[i][j].y), bf_hi(r[i][j].y)} - mu) * rs * g0 + b0;
                const f32x4 yb = ((f32x4){bf_lo(r[i][j].z), bf_hi(r[i][j].z), bf_lo(r[i][j].w), bf_hi(r[i][j].w)} - mu) * rs * g1 + b1;
                if (FINAL) { __builtin_nontemporal_store(ya, (GAS f32x4*)(OUT + (size_t)mr[i] * DM + c)); __builtin_nontemporal_store(yb, (GAS f32x4*)(OUT + (size_t)mr[i] * DM + c + 4)); }
                else { v4u o; o.x = pk2(ya.x, ya.y); o.y = pk2(ya.z, ya.w); o.z = pk2(yb.x, yb.y); o.w = pk2(yb.z, yb.w); *(GAS v4u*)(XB + (size_t)mr[i] * DM + c) = o; } } }
    }
}

__device__ __forceinline__ void up8(const v4u& r, float (&f)[8]) { f[0] = bf_lo(r.x); f[1] = bf_hi(r.x); f[2] = bf_lo(r.y); f[3] = bf_hi(r.y); f[4] = bf_lo(r.z); f[5] = bf_hi(r.z); f[6] = bf_lo(r.w); f[7] = bf_hi(r.w); }
template <int W>
__device__ __forceinline__ void pool_run(const bf16* HP, bf16* PMo, int t0, int c) {
    const int tp0 = t0 & (SEQ - 1);
    v4u raw[16 + W - 1];
#pragma unroll
    for (int j = 0; j < 16 + W - 1; ++j) { const int dt = j - (W - 1); raw[j] = (v4u){0u, 0u, 0u, 0u}; if (tp0 + dt >= 0) raw[j] = *(const GAS v4u*)(HP + (size_t)(t0 + dt) * PW + c); }
    float S[8], u[8];
#pragma unroll
    for (int e = 0; e < 8; ++e) S[e] = 0.f;
#pragma unroll
    for (int j = 0; j < W - 1; ++j) { up8(raw[j], u);
#pragma unroll
        for (int e = 0; e < 8; ++e) S[e] += u[e]; }
#pragma unroll
    for (int i = 0; i < 16; ++i) {
        up8(raw[W - 1 + i], u);
#pragma unroll
        for (int e = 0; e < 8; ++e) S[e] += u[e];
        const int tp = tp0 + i; const float inv = (tp + 1 < W) ? 1.0f / (float)(tp + 1) : 1.0f / (float)W;
        v4u o; o.x = pk2(S[0] * inv - u[0], S[1] * inv - u[1]); o.y = pk2(S[2] * inv - u[2], S[3] * inv - u[3]);
        o.z = pk2(S[4] * inv - u[4], S[5] * inv - u[5]); o.w = pk2(S[6] * inv - u[6], S[7] * inv - u[7]);
        *(GAS v4u*)(PMo + (size_t)(t0 + i) * DM + c) = o;
        float d[8]; up8(raw[i], d);
#pragma unroll
        for (int e = 0; e < 8; ++e) S[e] -= d[e];
    }
}
__device__ __forceinline__ void pool_ew(Frame& F) {
    const bf16* HP = (const bf16*)(F.ws + WS_HP); bf16* PMo = (bf16*)(F.ws + WS_CAT);
    const size_t gt = (size_t)blockIdx.x * (NWAVES * 64) + F.tid, NT = (size_t)F.G * NWAVES * 64;
    for (size_t idx = gt; idx < (size_t)(M / 16) * 256; idx += NT) {
        const int t0 = (int)(idx >> 8) * 16, c = (int)(idx & 255) * 8, grp = __builtin_amdgcn_readfirstlane(c >> 9);
        if (grp == 0) pool_run<2>(HP, PMo, t0, c); else if (grp == 1) pool_run<4>(HP, PMo, t0, c); else if (grp == 2) pool_run<8>(HP, PMo, t0, c); else pool_run<16>(HP, PMo, t0, c);
    }
}
__device__ __forceinline__ void kv_reduce(Frame& F) {
    const float* SK = (const float*)(F.ws + WS_SLAB); bf16* KVX = (bf16*)(F.ws + WS_KVX);
    const size_t gt = (size_t)blockIdx.x * (NWAVES * 64) + F.tid, NT = (size_t)F.G * NWAVES * 64, NE = (size_t)512 * 8192;
    for (size_t i = gt; i < NE / 4; i += NT) { const float* sb = SK + i * 4;
        const f32x4 a = *(const GAS f32x4*)sb + *(const GAS f32x4*)(sb + NE) + *(const GAS f32x4*)(sb + 2 * NE) + *(const GAS f32x4*)(sb + 3 * NE);
        v2u o; o.x = pk2(a.x, a.y); o.y = pk2(a.z, a.w); *(GAS v2u*)(KVX + i * 4) = o; }
}

__device__ __forceinline__ void kmean_phase(Frame& F) {
    const bf16* Kb = (const bf16*)(F.ws + WS_K); bf16* KMH = (bf16*)(F.ws + WS_KMH); bf16* KML = (bf16*)(F.ws + WS_KML);
    LAS float* part = (LAS float*)(F.lds + RING_OFF);
    for (int item = blockIdx.x; item < 64 * 4; item += F.G) {
        const int bn = item >> 2, chunk = item & 3;
        float acc[8];
#pragma unroll
        for (int e = 0; e < 8; ++e) acc[e] = 0.f;
        const bf16* base = Kb + (size_t)(bn * 256 + F.wave * 32) * AW + chunk * 512 + F.lane * 8;
#pragma unroll
        for (int r = 0; r < 32; ++r) { const v4u q = *(const GAS v4u*)(base + (size_t)r * AW);
            acc[0] += bf_lo(q.x); acc[1] += bf_hi(q.x); acc[2] += bf_lo(q.y); acc[3] += bf_hi(q.y); acc[4] += bf_lo(q.z); acc[5] += bf_hi(q.z); acc[6] += bf_lo(q.w); acc[7] += bf_hi(q.w); }
#pragma unroll
        for (int e = 0; e < 8; ++e) part[F.wave * 512 + F.lane * 8 + e] = acc[e];
        __syncthreads();
        { float s = 0.f;
#pragma unroll
          for (int w = 0; w < 8; ++w) s += part[w * 512 + F.tid];
          const float mean = s * (1.0f / 256.0f); const unsigned hb = f2bf(mean); const float hf = __builtin_bit_cast(float, hb << 16);
          KMH[(size_t)bn * AW + chunk * 512 + F.tid] = (bf16)hb; KML[(size_t)bn * AW + chunk * 512 + F.tid] = (bf16)f2bf(mean - hf); }
        __syncthreads();
    }
}

__device__ __forceinline__ void gate_phase(Frame& F) {
    const bf16* Qb = (const bf16*)(F.ws + WS_Q); const bf16* KMH = (const bf16*)(F.ws + WS_KMH); const bf16* KML = (const bf16*)(F.ws + WS_KML);
    unsigned short* lists = (unsigned short*)(F.ws + WS_LIST); gu32* gcnt = F.ctl + CW_GCNT;
    LAS float* gl = (LAS float*)(F.lds + RING_OFF);
    LAS unsigned* lcnt = (LAS unsigned*)(F.lds + RING_OFF + 34816);
    LAS unsigned* gb = lcnt + 32;
    const int r32 = F.lane & 31, hi = F.lane >> 5;
    for (int uid = blockIdx.x; uid < 1024; uid += F.G) {
        const int bh = uid >> 5, qb = uid & 31, b = bh >> 4, h = bh & 15;
        if (qb == 0) continue;
        if (F.tid < 32) lcnt[F.tid] = 0u;
        const size_t trow = (size_t)b * SEQ + 256 * qb + 32 * F.wave + r32;
        f32x16 acc = {};
#pragma unroll
        for (int s = 0; s < 8; ++s) {
            const bf16x8 bq = *(const GAS bf16x8*)(Qb + trow * AW + h * HD + 16 * s + 8 * hi);
            const bf16x8 ah = *(const GAS bf16x8*)(KMH + (size_t)(b * 32 + r32) * AW + h * HD + 16 * s + 8 * hi);
            const bf16x8 al = *(const GAS bf16x8*)(KML + (size_t)(b * 32 + r32) * AW + h * HD + 16 * s + 8 * hi);
            acc = __builtin_amdgcn_mfma_f32_32x32x16_bf16(ah, bq, acc, 0, 0, 0);
            acc = __builtin_amdgcn_mfma_f32_32x32x16_bf16(al, bq, acc, 0, 0, 0);
        }
#pragma unroll
        for (int r = 0; r < 16; ++r) gl[(32 * F.wave + r32) * 33 + att::crow(r, hi)] = acc[r];
        __syncthreads();
        int s0 = 0, s1 = 0, s2 = 0; unsigned p0 = 0, p1 = 0, p2 = 0; const int nsel = qb < 3 ? qb : 3;
        if (F.tid < 256) {
            float v0 = -__builtin_inff(), v1 = v0, v2 = v0;
            for (int n = 0; n < qb; ++n) { const float g = gl[F.tid * 33 + n];
                if (g > v0) { v2 = v1; s2 = s1; v1 = v0; s1 = s0; v0 = g; s0 = n; }
                else if (g > v1) { v2 = v1; s2 = s1; v1 = g; s1 = n; }
                else if (g > v2) { v2 = g; s2 = n; } }
            p0 = __hip_atomic_fetch_add(lcnt + s0, 1u, __ATOMIC_RELAXED, __HIP_MEMORY_SCOPE_WORKGROUP);
            if (nsel > 1) p1 = __hip_atomic_fetch_add(lcnt + s1, 1u, __ATOMIC_RELAXED, __HIP_MEMORY_SCOPE_WORKGROUP);
            if (nsel > 2) p2 = __hip_atomic_fetch_add(lcnt + s2, 1u, __ATOMIC_RELAXED, __HIP_MEMORY_SCOPE_WORKGROUP);
        }
        __syncthreads();
        if (F.tid < 32) { const unsigned c = lcnt[F.tid]; gb[F.tid] = c ? __hip_atomic_fetch_add(gcnt + bh * 32 + F.tid, c, RLX_AGENT) : 0u; }
        __syncthreads();
        if (F.tid < 256) {
            unsigned short* lb = lists + (size_t)bh * LIST_STRIDE; const unsigned tl = (unsigned)(256 * qb + F.tid);
            lb[list_off(s0) + gb[s0] + p0] = (unsigned short)(tl | (0u << 13));
            if (nsel > 1) lb[list_off(s1) + gb[s1] + p1] = (unsigned short)(tl | (1u << 13));
            if (nsel > 2) lb[list_off(s2) + gb[s2] + p2] = (unsigned short)(tl | (2u << 13));
        }
        __syncthreads();
    }
}

__device__ __forceinline__ void attn_phase(Frame& F, char* ldsg) {
    const bf16* Qb = (const bf16*)(F.ws + WS_Q); const bf16* Kb = (const bf16*)(F.ws + WS_K); const bf16* Vb = (const bf16*)(F.ws + WS_V);
    bf16* PO = (bf16*)(F.ws + WS_PARTO); float2* ML = (float2*)(F.ws + WS_ML);
    const unsigned short* lists = (const unsigned short*)(F.ws + WS_LIST); const gu32* gcnt = F.ctl + CW_GCNT;
    LAS int* pre = (LAS int*)(F.lds + RING_OFF + 67584);
    for (int i = F.tid; i < 1024; i += NWAVES * 64) pre[i] = (int)((__hip_atomic_load(gcnt + i, RLX_AGENT) + 255u) >> 8);
    __syncthreads();
    if (F.wave == 0) {
        int loc[16]; int s = 0;
#pragma unroll
        for (int k = 0; k < 16; ++k) { loc[k] = pre[F.lane * 16 + k]; s += loc[k]; }
        int incl = s;
#pragma unroll
        for (int o = 1; o < 64; o <<= 1) { const int v = __shfl_up(incl, o); if (F.lane >= o) incl += v; }
        int run = incl - s;
#pragma unroll
        for (int k = 0; k < 16; ++k) { pre[F.lane * 16 + k] = run; run += loc[k]; }
        if (F.lane == 63) pre[1024] = incl;
    }
    __syncthreads();
    const int total = 1024 + pre[1024];
    LAS int* DSC = (LAS int*)(F.lds + RING_OFF + 67584 + 4224);
    const int nloc = (total > (int)blockIdx.x) ? (total - (int)blockIdx.x + F.G - 1) / F.G : 0;
    if (F.tid < nloc && F.tid < 64) {
        const int id = blockIdx.x + F.tid * F.G; int bhj, own, lpos, cnt;
        if (id < 1024) { bhj = id; own = 1; lpos = 0; cnt = 256; }
        else { const int x = id - 1024; int lo = 0, hi2 = 1023;
            while (lo < hi2) { const int mid = (lo + hi2 + 1) >> 1; if (pre[mid] <= x) lo = mid; else hi2 = mid - 1; }
            const int li = lo, chunk = x - pre[li]; bhj = li; own = 0; lpos = (li >> 5) * LIST_STRIDE + list_off(li & 31) + 256 * chunk;
            const int c = (int)__hip_atomic_load(gcnt + li, RLX_AGENT) - 256 * chunk; cnt = c < 256 ? c : 256; }
        DSC[4 * F.tid] = bhj; DSC[4 * F.tid + 1] = own; DSC[4 * F.tid + 2] = lpos; DSC[4 * F.tid + 3] = cnt;
    }
    __syncthreads();
    att::ItemCtx C{Qb, Kb, Vb, PO, ML, lists};
    att::attn_items(C, (const LAS int*)DSC, nloc < 64 ? nloc : 64, ldsg);
}


#if defined(MOBA_CHECK) && MOBA_CHECK
__device__ __forceinline__ float wave_max(float v) {
#pragma unroll
    for (int o = 1; o < 64; o <<= 1) v = fmaxf(v, __shfl_xor(v, o));
    return v;
}
__device__ __forceinline__ void moba_check(Frame& F) {
    const bf16* Qb = (const bf16*)(F.ws + WS_Q); const bf16* Kb = (const bf16*)(F.ws + WS_K); const bf16* Vb = (const bf16*)(F.ws + WS_V);
    const bf16* KMH = (const bf16*)(F.ws + WS_KMH); const bf16* KML = (const bf16*)(F.ws + WS_KML); const bf16* CAT = (const bf16*)(F.ws + WS_CAT);
    LAS float* pl = (LAS float*)(F.lds + RING_OFF + F.wave * 8192);
    LAS float* ql = pl + 1024;
    const int gw = blockIdx.x * NWAVES + F.wave, NGW = F.G * NWAVES;
    for (int s = gw; s < 4096; s += NGW) {
        const unsigned hsh = (unsigned)s * 2654435761u; const int bh = (hsh >> 8) & 31; int t = (hsh >> 13) & 8191; if ((s & 7) == 0) t &= 1023;
        const int b = bh >> 4, h = bh & 15, qb = t >> 8, tl = t & 255;
        const bf16* qrow = Qb + ((size_t)b * SEQ + t) * AW + h * HD;
        ql[F.lane] = bf2f(qrow[F.lane]); ql[64 + F.lane] = bf2f(qrow[64 + F.lane]); LDS_WAIT();
        float g = -__builtin_inff();
        if (F.lane < qb) { const bf16* kh = KMH + (size_t)(b * 32 + F.lane) * AW + h * HD; const bf16* kl = KML + (size_t)(b * 32 + F.lane) * AW + h * HD; float a = 0.f;
            for (int d = 0; d < 128; ++d) a += ql[d] * (bf2f(kh[d]) + bf2f(kl[d])); g = a; }
        int sel[3]; const int nsel = qb < 3 ? qb : 3;
#pragma unroll
        for (int k = 0; k < 3; ++k) { const float mx = wave_max(g); const unsigned long long bal = __ballot(g == mx && F.lane < qb); const int idx = bal ? (int)__builtin_ctzll(bal) : 0; sel[k] = idx; if (F.lane == idx) g = -__builtin_inff(); }
        float sc[4][4]; float mx = -1e30f;
#pragma unroll
        for (int u = 0; u < 4; ++u) { const bool on = (u == 3) || (u < nsel); const int j = (u == 3) ? qb : sel[u];
#pragma unroll
            for (int r = 0; r < 4; ++r) { const int key = F.lane + 64 * r; float a = -1e30f;
                if (on && !(u == 3 && key > tl)) { const bf16* kr = Kb + ((size_t)b * SEQ + 256 * j + key) * AW + h * HD; a = 0.f; for (int d = 0; d < 128; ++d) a += ql[d] * bf2f(kr[d]); a *= 0.088388347648318440f; }
                sc[u][r] = a; mx = fmaxf(mx, a); } }
        mx = wave_max(mx); float sum = 0.f;
#pragma unroll
        for (int u = 0; u < 4; ++u)
#pragma unroll
            for (int r = 0; r < 4; ++r) { const float p = (sc[u][r] > -1e29f) ? __expf(sc[u][r] - mx) : 0.f; sum += p; pl[u * 256 + F.lane + 64 * r] = p; }
        sum = wave_sum(sum); LDS_WAIT();
        float o0 = 0.f, o1 = 0.f;
#pragma unroll
        for (int u = 0; u < 4; ++u) { const bool on = (u == 3) || (u < nsel); const int j = (u == 3) ? qb : sel[u];
            if (on) for (int key = 0; key < 256; ++key) { const float p = pl[u * 256 + key]; const bf16* vr = Vb + ((size_t)b * SEQ + 256 * j + key) * AW + h * HD; o0 += p * bf2f(vr[F.lane]); o1 += p * bf2f(vr[64 + F.lane]); } }
        o0 /= sum; o1 /= sum;
        const bf16* cr = CAT + ((size_t)b * SEQ + t) * DM + PW + h * HD; const float c0 = bf2f(cr[F.lane]), c1 = bf2f(cr[64 + F.lane]);
        const bool bad = !(fabsf(c0 - o0) <= 1.5e-3f + 0.03f * fabsf(o0)) || !(fabsf(c1 - o1) <= 1.5e-3f + 0.03f * fabsf(o1));
        const unsigned long long bb = __ballot(bad);
        if (F.lane == 0 && bb) __hip_atomic_fetch_add(F.ctl + CW_CHK, 1u, RLX_AGENT);
        if (F.lane == 0) __hip_atomic_fetch_add(F.ctl + CW_CHK + 1, 1u, RLX_AGENT);
        LDS_WAIT();
    }
}
#endif

__device__ __forceinline__ void combine_phase(Frame& F) {
    const bf16* PO = (const bf16*)(F.ws + WS_PARTO); const float2* ML = (const float2*)(F.ws + WS_ML); bf16* CAT = (bf16*)(F.ws + WS_CAT);
    constexpr float C = att::SCALE * 1.4426950408889634f;
    const size_t gt = (size_t)blockIdx.x * (NWAVES * 64) + F.tid, NT = (size_t)F.G * NWAVES * 64;
    for (size_t idx = gt; idx < (size_t)32 * SEQ * 16; idx += NT) {
        const int dc = (int)(idx & 15), t = (int)((idx >> 4) & (SEQ - 1)), bh = (int)(idx >> 17), qb = t >> 8, nsel = qb < 3 ? qb : 3;
        float2 ml[4]; float mx;
        ml[3] = ML[((size_t)3 * 32 + bh) * SEQ + t]; mx = ml[3].x;
#pragma unroll
        for (int k = 0; k < 3; ++k) { if (k < nsel) { ml[k] = ML[((size_t)k * 32 + bh) * SEQ + t]; mx = fmaxf(mx, ml[k].x); } else ml[k] = make_float2(0.f, 0.f); }
        float acc[8]; float wsum = 0.f;
#pragma unroll
        for (int e = 0; e < 8; ++e) acc[e] = 0.f;
#pragma unroll
        for (int k = 0; k < 4; ++k) { if (k == 3 || k < nsel) {
            const float w = ml[k].y * __builtin_amdgcn_exp2f((ml[k].x - mx) * C); wsum += w;
            const v4u r = *(const GAS v4u*)(PO + (((size_t)k * 32 + bh) * SEQ + t) * HD + dc * 8);
            acc[0] += w * bf_lo(r.x); acc[1] += w * bf_hi(r.x); acc[2] += w * bf_lo(r.y); acc[3] += w * bf_hi(r.y);
            acc[4] += w * bf_lo(r.z); acc[5] += w * bf_hi(r.z); acc[6] += w * bf_lo(r.w); acc[7] += w * bf_hi(r.w); } }
        const float inv = 1.0f / wsum; const int b = bh >> 4, h = bh & 15;
        v4u o; o.x = pk2(acc[0] * inv, acc[1] * inv); o.y = pk2(acc[2] * inv, acc[3] * inv); o.z = pk2(acc[4] * inv, acc[5] * inv); o.w = pk2(acc[6] * inv, acc[7] * inv);
        *(GAS v4u*)(CAT + ((size_t)b * SEQ + t) * DM + PW + h * HD + dc * 8) = o;
    }
}

struct Args { const float* in[18]; float* out; unsigned char* ws; int ph_lo, ph_hi, li, pad; };
__global__ void __launch_bounds__(NWAVES * 64, 2) mega_fwd(Args args) {
    extern __shared__ __attribute__((aligned(16))) unsigned char lds[];
    Frame F;
    F.lds = (LAS unsigned char*)lds;
    F.MISC = (volatile LAS unsigned*)(F.lds + MISC_OFF);
    F.tid = threadIdx.x; F.lane = F.tid & 63; F.wave = __builtin_amdgcn_readfirstlane(F.tid >> 6);
    F.G = gridDim.x; F.ws = args.ws;
    F.ctl = (gu32*)(args.ws + WS_CTL);
    for (int u = F.tid; u < (LDS_BYTES - LDSCTL_OFF) / 4; u += NWAVES * 64) ((LAS unsigned*)(F.lds + LDSCTL_OFF))[u] = 0u;
    __syncthreads();
    XcdBarrier bar; bar.bar = (unsigned*)(F.ctl + CW_BAR); bar.x = 0; bar.st = nullptr;
    if (N_LAUNCHES == 1) bar = xcd_barrier_post((unsigned*)(F.ctl + CW_BAR), F.MISC + 8);
#define GRID_BAR() do { if (N_LAUNCHES == 1) xcd_barrier(bar); } while (0)
    const int lo = args.ph_lo, hi = args.ph_hi;
#define IN(k) (lo <= (k) && (k) < hi)
#define BOTH(k) (IN(k) && IN((k) + 1))
#ifndef PROBE_DUP
#define PROBE_DUP 0
#endif
#define DUPON(k) ((PROBE_DUP >> (k)) & 1)
#define REP(k) for (int _rep = 0; _rep < (DUPON(k) ? 2 : 1); ++_rep)
    unsigned char* ws = args.ws;
    const int G = F.G, cid = (int)blockIdx.x;
    float* out = args.out;

    if (IN(0)) { REP(0) { p0_prologue(F, args.in); } if (BOTH(0)) GRID_BAR(); }

    if (IN(1)) {
        { pg8::GemmKV g{(const char*)(ws + WS_MEMB), (const char*)(ws + WS_WXKV), DM, DM, 1024};
          pg8::OrderKV S{G, cid}; pg8::EpiSlabKV E{(float*)(ws + WS_SLAB)};
          pg8::gemm_phase<pg8::EpiSlabKV, pg8::OrderKV, true, true, pg8::GemmKV>(F.lds + RING_OFF, g, S, E); if (DUPON(16)) { pg8::gemm_phase<pg8::EpiSlabKV, pg8::OrderKV, true, true, pg8::GemmKV>(F.lds + RING_OFF, g, S, E); } }
        { pg8::Gemm g = pg8::make_gemm(ws + WS_XB, DM, ws + WS_WIN, DM, DM); pg8::StaticOrder S; S.init(M, MIXIN, G, cid);
          pg8::EpiMixIn E{(pg8::bf16_t*)(ws + WS_HP), (size_t)M * 2048, (const float*)(ws + WS_ROPE)};
          pg8::gemm_phase<pg8::EpiMixIn, pg8::StaticOrder, true, true>(F.lds + RING_OFF, g, S, E); if (DUPON(1)) { pg8::gemm_phase<pg8::EpiMixIn, pg8::StaticOrder, true, true>(F.lds + RING_OFF, g, S, E); } }
        if (BOTH(1)) GRID_BAR();
    }

    if (IN(2)) { REP(2) { pool_ew(F); kmean_phase(F); kv_reduce(F); } if (BOTH(2)) GRID_BAR(); }

    if (IN(3)) {
        { pg8::Gemm g = pg8::make_gemm(ws + WS_WOUT, 2048, ws + WS_WPOOL, 512, 512); g.a_pn = 512 * 2; g.a_pn_sh = 1; pg8::StaticOrder S; S.init(DM, PW, G, cid);
          pg8::EpiStore E{(pg8::bf16_t*)(ws + WS_WOUT2), DM, 0};
          pg8::gemm_phase<pg8::EpiStore, pg8::StaticOrder, true, true>(F.lds + RING_OFF, g, S, E); if (DUPON(3)) { pg8::gemm_phase<pg8::EpiStore, pg8::StaticOrder, true, true>(F.lds + RING_OFF, g, S, E); } }
        if (G == 256) { pg8::GemmAbs g{(const char*)(ws + WS_KVX), (const char*)(ws + WS_WXQ), (const char*)(ws + WS_WXO), cid < 128 ? 8192 : 4096, cid < 128 ? 4096 : 8192, 1024};
          pg8::OrderAbs S{cid}; pg8::EpiStoreAbs E{(pg8::bf16_t*)(ws + WS_WQK), (pg8::bf16_t*)(ws + WS_WVOT), (float*)(F.ctl + CW_K1), (float*)(F.ctl + CW_K2)};
          pg8::gemm_phase<pg8::EpiStoreAbs, pg8::OrderAbs, true, true, pg8::GemmAbs>(F.lds + RING_OFF, g, S, E); if (DUPON(17)) { pg8::gemm_phase<pg8::EpiStoreAbs, pg8::OrderAbs, true, true, pg8::GemmAbs>(F.lds + RING_OFF, g, S, E); } }
        gate_phase(F);
        if (BOTH(3)) GRID_BAR();
    }

    if (IN(4)) { attn_phase(F, (char*)lds + RING_OFF); if (DUPON(4)) { __syncthreads(); attn_phase(F, (char*)lds + RING_OFF); } if (BOTH(4)) GRID_BAR(); }

    if (IN(5)) { REP(5) { combine_phase(F); } if (BOTH(5)) GRID_BAR(); }
#if defined(MOBA_CHECK) && MOBA_CHECK
    if (IN(5)) { moba_check(F); __syncthreads(); }
#endif

    if (IN(6)) {
        pg8::Gemm g = pg8::make_gemm(ws + WS_CAT, DM, ws + WS_WOUT2, DM, DM); pg8::StaticOrder S; S.init(M, DM, G, cid);
        pg8::EpiResid E{args.in[0], (pg8::bf16_t*)(ws + WS_TB), DM, DN_ALPHA, (pg8::f32x2*)(ws + WS_SLOT)};
        pg8::gemm_phase<pg8::EpiResid, pg8::StaticOrder, true, true>(F.lds + RING_OFF, g, S, E); if (DUPON(6)) { pg8::gemm_phase<pg8::EpiResid, pg8::StaticOrder, true, true>(F.lds + RING_OFF, g, S, E); }
        if (BOTH(6)) GRID_BAR();
    }
    if (IN(7)) { ln_finalize(F, (const float2*)(ws + WS_SLOT), (float2*)(ws + WS_STATS)); if (BOTH(7)) GRID_BAR(); }

    if (IN(9)) {
        if (G == 256) {
            pg8::Gemm g = pg8::make_gemm(ws + WS_TB, DM, ws + WS_WQK, DM, DM); g.b_pm = (size_t)1024 * DM * 2; g.b_pm_sh = 5;
            pg8::StaticOrder S; S.init(M, XH * 256, G, cid);
            pg8::EpiSoftmax E{(pg8::bf16_t*)(ws + WS_PB), XH * MEMLEN, 0.03125f * 1.4426950408889634f, (const pg8::f32x2*)(ws + WS_STATS), (const float*)(F.ctl + CW_K1), (const float*)(F.ctl + CW_K2)};
            pg8::gemm_phase<pg8::EpiSoftmax, pg8::StaticOrder, false, true>(F.lds + RING_OFF, g, S, E); if (DUPON(9)) { pg8::gemm_phase<pg8::EpiSoftmax, pg8::StaticOrder, false, true>(F.lds + RING_OFF, g, S, E); }
        }
        if (BOTH(9)) GRID_BAR();
    }
    if (IN(11)) {
        pg8::Gemm g = pg8::make_gemm(ws + WS_PB, XH * MEMLEN, ws + WS_WVOT, 2048, XH * MEMLEN); g.b_pm = (size_t)1024 * 2; g.b_pm_sh = 5;
        pg8::StaticOrder S; S.init(M, DM, G, cid);
        pg8::EpiResidLN E{(pg8::bf16_t*)(ws + WS_TB), (const pg8::f32x2*)(ws + WS_STATS), 6, (pg8::f32x2*)(ws + WS_SLOT)};
        pg8::gemm_phase<pg8::EpiResidLN, pg8::StaticOrder, true, true>(F.lds + RING_OFF, g, S, E);
        if (BOTH(11)) GRID_BAR();
    }
    if (IN(12)) { ln_finalize(F, (const float2*)(ws + WS_SLOT), (float2*)(ws + WS_STATS)); if (BOTH(12)) GRID_BAR(); }

    if (IN(13)) {
        pg8::Gemm g = pg8::make_gemm(ws + WS_TB, DM, ws + WS_WGU, DM, DM); pg8::StaticOrder S; S.init(M, 2 * FF, G, cid);
        pg8::EpiSwiGLU E{(pg8::bf16_t*)(ws + WS_G), FF, (const pg8::f32x2*)(ws + WS_STATS), (const float*)(F.ctl + CW_C1G), (const float*)(F.ctl + CW_C2G)};
        pg8::gemm_phase<pg8::EpiSwiGLU, pg8::StaticOrder, true, true>(F.lds + RING_OFF, g, S, E); if (DUPON(13)) { pg8::gemm_phase<pg8::EpiSwiGLU, pg8::StaticOrder, true, true>(F.lds + RING_OFF, g, S, E); }
        { const int nu = 2 * FF / 256 * (M / 256), full = (nu + G - 1) / G, mine = (nu > cid) ? (nu - cid + G - 1) / G : 0, nshort = G - (nu % G);
          if (nu % G != 0 && mine < full) convert_wdown(F, args.in[15], cid - (nu % G), nshort);
          else if (nu % G == 0) convert_wdown(F, args.in[15], cid, G); }
        if (BOTH(13)) GRID_BAR();
    }
    if (IN(14)) {
        pg8::Gemm g = pg8::make_gemm(ws + WS_G, FF, ws + WS_WDN, FF, FF); pg8::StaticOrder S; S.init(M, DM, G, cid);
        pg8::EpiResidLN E{(pg8::bf16_t*)(ws + WS_TB), (const pg8::f32x2*)(ws + WS_STATS), 11, nullptr};
        if (DUPON(14)) { pg8::EpiStore E2{(pg8::bf16_t*)(ws + WS_HB), DM, 0}; pg8::gemm_phase<pg8::EpiStore, pg8::StaticOrder, true, true>(F.lds + RING_OFF, g, S, E2); }
        pg8::gemm_phase<pg8::EpiResidLN, pg8::StaticOrder, true, true>(F.lds + RING_OFF, g, S, E);
        if (BOTH(14)) GRID_BAR();
    }
#if defined(MOBA_CHECK) && MOBA_CHECK
#define CHK_TAIL 1
#endif
    if (IN(15)) { ln_rows<true>(F, (const bf16*)(ws + WS_TB), nullptr, nullptr, out, args.in[16], args.in[17]); if (DUPON(15)) { ln_rows<true>(F, (const bf16*)(ws + WS_TB), nullptr, nullptr, out, args.in[16], args.in[17]); } }
#if defined(MOBA_CHECK) && MOBA_CHECK
    GRID_BAR();
    if (blockIdx.x == 0 && F.tid < 64) { const unsigned nbad = __hip_atomic_load(F.ctl + CW_CHK, RLX_AGENT), nrun = __hip_atomic_load(F.ctl + CW_CHK + 1, RLX_AGENT);
        if (nbad != 0u) out[F.tid] = 1000.0f + (float)nbad;
        else if (nrun != 4096u) out[F.tid] = 500.0f + (float)nrun; }
#endif
#undef IN
#undef BOTH
#undef GRID_BAR
}

extern "C" void kernel_launch(void* const* d_in, const int* in_sizes, int n_in, void* d_out, int out_size, void* d_ws, size_t ws_size, hipStream_t stream) {
    static int grid = 0;
    if (grid == 0) {
        if (n_in != 18 || in_sizes[0] != M * DM || out_size != M * DM || ws_size < WS_END) { fprintf(stderr, "kernel_launch: shape / workspace mismatch (n_in %d, in0 %d, out %d, ws %zu, need %zu)\n", n_in, n_in > 0 ? in_sizes[0] : -1, out_size, ws_size, (size_t)WS_END); grid = -1; return; }
        int dev = 0, cus = 0, per_cu = 0;
        if (hipGetDevice(&dev) != hipSuccess || hipDeviceGetAttribute(&cus, hipDeviceAttributeMultiprocessorCount, dev) != hipSuccess) { grid = -1; return; }
        if (hipFuncSetAttribute((const void*)mega_fwd, hipFuncAttributeMaxDynamicSharedMemorySize, LDS_BYTES) != hipSuccess) { fprintf(stderr, "kernel_launch: hipFuncSetAttribute failed\n"); grid = -1; return; }
        if (hipOccupancyMaxActiveBlocksPerMultiprocessor(&per_cu, (const void*)mega_fwd, NWAVES * 64, LDS_BYTES) != hipSuccess || per_cu < 1)
            fprintf(stderr, "kernel_launch: note: occupancy query reports %d workgroups per CU\n", per_cu);
        (void)hipGetLastError();
        grid = cus;
        if (grid != 256) fprintf(stderr, "kernel_launch: %d CUs; the cross-attention score phase needs a 256-workgroup grid\n", grid);
    }
    if (grid < 0) return;
    if (hipMemsetAsync((char*)d_ws + WS_CTL, 0, CTL_ZERO_BYTES, stream) != hipSuccess) return;
    Args a{};
    for (int i = 0; i < 18; ++i) a.in[i] = (const float*)d_in[i];
    a.out = (float*)d_out; a.ws = (unsigned char*)d_ws; a.pad = 0;
    for (int li = 0; li < N_LAUNCHES; ++li) {
        a.ph_lo = (N_LAUNCHES == 1) ? 0 : li; a.ph_hi = (N_LAUNCHES == 1) ? N_PHASES : li + 1; a.li = li;
        hipLaunchKernelGGL(mega_fwd, dim3(grid), dim3(NWAVES * 64), LDS_BYTES, stream, a);
        if (hipPeekAtLastError() != hipSuccess) { fprintf(stderr, "kernel_launch: launch %d failed\n", li); break; }
    }
}
```

```cpp
#include <hip/hip_runtime.h>
#include <cstdio>
#include <cstdint>

namespace pg8 {
#define PG8_LAS __attribute__((address_space(3)))
typedef unsigned short bf16_t;
typedef short bf16x8 __attribute__((ext_vector_type(8)));
typedef float f32x4 __attribute__((ext_vector_type(4)));
typedef float f32x2 __attribute__((ext_vector_type(2)));
typedef unsigned u32x4 __attribute__((ext_vector_type(4)));
typedef unsigned u32x2 __attribute__((ext_vector_type(2)));
typedef int i32x4 __attribute__((ext_vector_type(4)));
constexpr int BM = 256, BK = 64, HALF = 128, HTB = HALF * BK * 2  , STAGE_BYTES = 8 * HTB, NXCD = 8, WGM = 8;

__host__ __device__ __forceinline__ int lds_byte(int r, int c) { const int st = (r >> 4) * 2 + (c >> 5), rr = r & 15, cc = c & 31, ob = rr * 64 + cc * 2; return st * 1024 + (ob ^ (((ob >> 9) & 1) << 5)); }
__host__ __device__ __forceinline__ void stage_rc(int b, int& R, int& C) { const int st = b / 1024, sb = b % 1024, swz = sb ^ (((sb >> 9) & 1) << 5); R = (st >> 1) * 16 + swz / 64; C = (st & 1) * 32 + (swz % 64) / 2; }
__host__ __device__ __forceinline__ int perm32(int rho) { const int n = rho >> 4, i = rho & 15; return 8 * (i >> 2) + 4 * n + (i & 3); }

struct Unit { int pm, pn, pz; };
struct Gemm {
    const char* A; const char* B; int lda, ldb, K;
    size_t a_pm, a_pn; int a_pn_sh; size_t b_pn, b_pm; int b_pm_sh;
    __device__ __forceinline__ const char* a_ptr(const Unit& u) const { return A + (size_t)u.pm * a_pm + (size_t)(u.pn >> a_pn_sh) * a_pn; }
    __device__ __forceinline__ const char* b_ptr(const Unit& u) const { return B + (size_t)u.pn * b_pn + (size_t)(u.pm >> b_pm_sh) * b_pm; }
};
__device__ __forceinline__ Gemm make_gemm(const void* A, int lda, const void* B, int ldb, int K) {
    Gemm g; g.A = (const char*)A; g.B = (const char*)B; g.lda = lda; g.ldb = ldb; g.K = K;
    g.a_pm = (size_t)BM * lda * 2; g.a_pn = 0; g.a_pn_sh = 0; g.b_pn = (size_t)BM * ldb * 2; g.b_pm = 0; g.b_pm_sh = 0; return g;
}

struct StaticOrder {
    int nM, nN, nwg, G, c, wgm;
    __host__ __device__ void init(int M, int N, int G_, int c_, int wgm_ = WGM) { nM = M / BM; nN = N / BM; nwg = nM * nN; G = G_; c = c_; wgm = wgm_; }
    __host__ __device__ bool next(int i, Unit& u) const {
        const long L = (long)i * G + c; if (L >= nwg) return false;
        int wgid = (int)L; { const int q = nwg / NXCD, r = nwg % NXCD, xcd = wgid % NXCD, off = wgid / NXCD; wgid = (xcd < r ? xcd * (q + 1) : r * (q + 1) + (xcd - r) * q) + off; }
        const int nig = wgm * nN, gid = wgid / nig, fm = gid * wgm, gsz = (nM - fm) < wgm ? (nM - fm) : wgm;
        u.pm = fm + ((wgid % nig) % gsz); u.pn = (wgid % nig) / gsz; u.pz = 0; return true;
    }
    __device__ __forceinline__ void a_ready(const Unit&) const {}
    __device__ __forceinline__ void done(const Unit&) const {}
    __device__ __forceinline__ int pre_epi(int, int, int) const { return 0; }
    __device__ __forceinline__ void post_epi(int, int, int, int) const {}
};

struct DynOrder {
    int nM, nN, q, home, rot, wgm; unsigned* ctr; volatile PG8_LAS int* tk;
    __device__ __forceinline__ void init(int M, int N, unsigned* ctr_, volatile PG8_LAS int* tk_, int home_, int rot_ = 0, int wgm_ = WGM) { nM = M / BM; nN = N / BM; q = (nM * nN) / NXCD; ctr = ctr_; tk = tk_; home = home_; rot = rot_; wgm = wgm_; }
    __device__ __forceinline__ int fetch() const {
        for (int k = 0; k < NXCD; ++k) { const int y = (home + k) & (NXCD - 1); const unsigned t = __hip_atomic_fetch_add(ctr + 64 * y, 1u, __ATOMIC_RELAXED, __HIP_MEMORY_SCOPE_AGENT); if (t < (unsigned)q) return y * q + (int)t; }
        return -1; }
    __device__ __forceinline__ void start(int wid, int lane) const {
        if (wid == 0 && lane == 0) { const int a = fetch(); const int b = (a >= 0) ? fetch() : -1; tk[0] = a; tk[1] = b; }
        __syncthreads(); }
    __device__ __forceinline__ bool next(int i, Unit& u) const {
        const int wgid = tk[i & 3]; if (wgid < 0) return false;
        const int nig = wgm * nN, gid = wgid / nig, fm = gid * wgm, gsz = (nM - fm) < wgm ? (nM - fm) : wgm;
        u.pm = fm + ((wgid % nig) % gsz); u.pn = ((wgid % nig) / gsz + (wgid / q) * rot) % nN; u.pz = 0; return true; }
    __device__ __forceinline__ void a_ready(const Unit&) const {}
    __device__ __forceinline__ void done(const Unit&) const {}
    __device__ __forceinline__ int pre_epi(int, int wid, int lane) const { int t = 0; if (wid == 0 && lane == 0) t = (int)__hip_atomic_fetch_add(ctr + 64 * (home & (NXCD - 1)), 1u, __ATOMIC_RELAXED, __HIP_MEMORY_SCOPE_AGENT); return t; }
    __device__ __forceinline__ void post_epi(int ui, int wid, int lane, int t) const {
        if (wid == 0 && lane == 0) { int w = -1;
            if ((unsigned)t < (unsigned)q) w = (home & (NXCD - 1)) * q + t;
            else for (int k = 1; k < NXCD; ++k) { const int y = (home + k) & (NXCD - 1); const unsigned s = __hip_atomic_fetch_add(ctr + 64 * y, 1u, __ATOMIC_RELAXED, __HIP_MEMORY_SCOPE_AGENT); if (s < (unsigned)q) { w = y * q + (int)s; break; } }
            tk[(ui + 2) & 3] = w; } }
};

__device__ __forceinline__ unsigned cvt_pk_bf16(float lo, float hi) { unsigned r; asm volatile("v_cvt_pk_bf16_f32 %0, %1, %2" : "=v"(r) : "v"(lo), "v"(hi)); return r; }

struct EpiMixIn {
    static constexpr bool PERM = true, AFTER_DRAIN = false;
    bf16_t* base; size_t tstride; const float* rope; int pn_off;
    __device__ __forceinline__ void operator()(const f32x4 (&acc)[2][2][4][2], const Unit& u, int wr, int wc, int fr, int fq) const {
        const int t = (u.pn + pn_off) >> 3; const bool rp = (t == 1) || (t == 2);
        bf16_t* ob = base + (size_t)t * tstride;
        const int row0 = u.pm * BM + wr * 64 + fr, col0 = (u.pn & 7) * BM + wc * 32 + 8 * fq;
#pragma unroll
        for (int ai = 0; ai < 2; ++ai)
#pragma unroll
            for (int m = 0; m < 4; ++m) {
                const int row = row0 + ai * HALF + m * 16; bf16_t* rowp = ob + (size_t)row * 2048 + col0;
                f32x4 cs0 = (f32x4){1.f, 0.f, 1.f, 0.f}, cs1 = cs0;
                if (rp) { const f32x4* tp = (const f32x4*)(rope + ((size_t)(row & 8191) * 64 + wc * 16 + fq * 4) * 2); cs0 = tp[0]; cs1 = tp[1]; }
#pragma unroll
                for (int bj = 0; bj < 2; ++bj) {
                    const f32x4 v0 = acc[ai][bj][m][0], v1 = acc[ai][bj][m][1];
                    const float a0 = v0[0] * cs0[0] - v0[1] * cs0[1], a1 = v0[1] * cs0[0] + v0[0] * cs0[1];
                    const float a2 = v0[2] * cs0[2] - v0[3] * cs0[3], a3 = v0[3] * cs0[2] + v0[2] * cs0[3];
                    const float b0 = v1[0] * cs1[0] - v1[1] * cs1[1], b1 = v1[1] * cs1[0] + v1[0] * cs1[1];
                    const float b2 = v1[2] * cs1[2] - v1[3] * cs1[3], b3 = v1[3] * cs1[2] + v1[2] * cs1[3];
                    u32x4 w; w.x = cvt_pk_bf16(a0, a1); w.y = cvt_pk_bf16(a2, a3); w.z = cvt_pk_bf16(b0, b1); w.w = cvt_pk_bf16(b2, b3);
                    *(u32x4*)(rowp + bj * HALF) = w;
                }
            }
    }
};
struct EpiMix8 {
    static constexpr bool PERM = true, AFTER_DRAIN = false;
    bf16_t* base; size_t tstride; const float* sx; const float* sb; int t0, t1;
    __device__ __forceinline__ f32x4 cv(const f32x4& a) const { return __builtin_convertvector(__builtin_bit_cast(i32x4, a), f32x4); }
    __device__ __forceinline__ void operator()(const f32x4 (&acc)[2][2][4][2], const Unit& u, int wr, int wc, int fr, int fq) const {
        bf16_t* ob = base + (size_t)((u.pn >> 3) ? t1 : t0) * tstride;
        const int row0 = u.pm * BM + wr * 64 + fr, col0 = (u.pn & 7) * BM + wc * 32 + 8 * fq, n0 = u.pn * BM + wc * 32 + 8 * fq;
        f32x4 c[2][2];
#pragma unroll
        for (int bj = 0; bj < 2; ++bj) { c[bj][0] = *(const f32x4*)(sb + n0 + bj * HALF); c[bj][1] = *(const f32x4*)(sb + n0 + bj * HALF + 4); }
#pragma unroll
        for (int ai = 0; ai < 2; ++ai)
#pragma unroll
            for (int m = 0; m < 4; ++m) { const int row = row0 + ai * HALF + m * 16; bf16_t* rowp = ob + (size_t)row * 2048 + col0; const float sr = sx[row];
#pragma unroll
                for (int bj = 0; bj < 2; ++bj) { const f32x4 v0 = cv(acc[ai][bj][m][0]) * (c[bj][0] * sr), v1 = cv(acc[ai][bj][m][1]) * (c[bj][1] * sr);
                    u32x4 w; w.x = cvt_pk_bf16(v0[0], v0[1]); w.y = cvt_pk_bf16(v0[2], v0[3]); w.z = cvt_pk_bf16(v1[0], v1[1]); w.w = cvt_pk_bf16(v1[2], v1[3]);
                    *(u32x4*)(rowp + bj * HALF) = w; } }
    }
};
struct EpiStore {
    static constexpr bool PERM = true, AFTER_DRAIN = false;
    bf16_t* O; int ldc, coff;
    __device__ __forceinline__ void operator()(const f32x4 (&acc)[2][2][4][2], const Unit& u, int wr, int wc, int fr, int fq) const {
        const int row0 = u.pm * BM + wr * 64 + fr, col0 = coff + u.pn * BM + wc * 32 + 8 * fq;
#pragma unroll
        for (int ai = 0; ai < 2; ++ai)
#pragma unroll
            for (int m = 0; m < 4; ++m) { bf16_t* rowp = O + (size_t)(row0 + ai * HALF + m * 16) * ldc + col0;
#pragma unroll
                for (int bj = 0; bj < 2; ++bj) { const f32x4 v0 = acc[ai][bj][m][0], v1 = acc[ai][bj][m][1];
                    u32x4 w; w.x = cvt_pk_bf16(v0[0], v0[1]); w.y = cvt_pk_bf16(v0[2], v0[3]); w.z = cvt_pk_bf16(v1[0], v1[1]); w.w = cvt_pk_bf16(v1[2], v1[3]);
                    *(u32x4*)(rowp + bj * HALF) = w; } }
    }
};
__device__ __forceinline__ void row_stat_acc(const u32x4& w, float& s, float& q) {
    const float a0 = __builtin_bit_cast(float, w.x << 16), a1 = __builtin_bit_cast(float, w.x & 0xffff0000u), a2 = __builtin_bit_cast(float, w.y << 16), a3 = __builtin_bit_cast(float, w.y & 0xffff0000u);
    const float a4 = __builtin_bit_cast(float, w.z << 16), a5 = __builtin_bit_cast(float, w.z & 0xffff0000u), a6 = __builtin_bit_cast(float, w.w << 16), a7 = __builtin_bit_cast(float, w.w & 0xffff0000u);
    s += ((a0 + a1) + (a2 + a3)) + ((a4 + a5) + (a6 + a7));
    q += ((a0 * a0 + a1 * a1) + (a2 * a2 + a3 * a3)) + ((a4 * a4 + a5 * a5) + (a6 * a6 + a7 * a7));
}
__device__ __forceinline__ void row_stat_store(f32x2* slots, int row, int slot, int fq, float s, float q) {
    s += __shfl_xor(s, 16); q += __shfl_xor(q, 16); s += __shfl_xor(s, 32); q += __shfl_xor(q, 32);
    if (fq == 0) slots[(size_t)row * 64 + slot] = (f32x2){s, q};
}
struct EpiResid {
    static constexpr bool PERM = true, AFTER_DRAIN = false;
    const float* res; bf16_t* out; int ldc; float alpha; f32x2* slots;
    __device__ __forceinline__ void operator()(const f32x4 (&acc)[2][2][4][2], const Unit& u, int wr, int wc, int fr, int fq) const {
        const int row0 = u.pm * BM + wr * 64 + fr, col0 = u.pn * BM + wc * 32 + 8 * fq;
#pragma unroll
        for (int ai = 0; ai < 2; ++ai)
#pragma unroll
            for (int m = 0; m < 4; ++m) { const size_t off = (size_t)(row0 + ai * HALF + m * 16) * ldc + col0; float ss = 0.f, qq = 0.f;
#pragma unroll
                for (int bj = 0; bj < 2; ++bj) { const f32x4 r0 = *(const f32x4*)(res + off + bj * HALF), r1 = *(const f32x4*)(res + off + bj * HALF + 4);
                    const f32x4 v0 = r0 * alpha + acc[ai][bj][m][0], v1 = r1 * alpha + acc[ai][bj][m][1];
                    u32x4 w; w.x = cvt_pk_bf16(v0[0], v0[1]); w.y = cvt_pk_bf16(v0[2], v0[3]); w.z = cvt_pk_bf16(v1[0], v1[1]); w.w = cvt_pk_bf16(v1[2], v1[3]);
                    *(u32x4*)(out + off + bj * HALF) = w; row_stat_acc(w, ss, qq); }
                row_stat_store(slots, row0 + ai * HALF + m * 16, u.pn * 4 + wc, fq, ss, qq);
                if (m == 3) asm volatile("" ::: "memory"); }
    }
};
struct EpiSwiGLU {
    static constexpr bool PERM = true, AFTER_DRAIN = false;
    bf16_t* G; int ldc; const f32x2* stats; const float* c1; const float* c2;
    __device__ __forceinline__ float act(float g, float u) const { return g * u * __builtin_amdgcn_rcpf(1.0f + __builtin_amdgcn_exp2f(-1.4426950408889634f * g)); }
    __device__ __forceinline__ void operator()(const f32x4 (&acc)[2][2][4][2], const Unit& u, int wr, int wc, int fr, int fq) const {
        const int row0 = u.pm * BM + wr * 64 + fr, col0 = u.pn * HALF + wc * 32 + 8 * fq, n0 = u.pn * BM + wc * 32 + 8 * fq;
        const f32x4 cg0 = *(const f32x4*)(c1 + n0), cg1 = *(const f32x4*)(c1 + n0 + 4), cu0 = *(const f32x4*)(c1 + n0 + HALF), cu1 = *(const f32x4*)(c1 + n0 + HALF + 4);
        const f32x4 dg0 = *(const f32x4*)(c2 + n0), dg1 = *(const f32x4*)(c2 + n0 + 4), du0 = *(const f32x4*)(c2 + n0 + HALF), du1 = *(const f32x4*)(c2 + n0 + HALF + 4);
#pragma unroll
        for (int ai = 0; ai < 2; ++ai)
#pragma unroll
            for (int m = 0; m < 4; ++m) { const int row = row0 + ai * HALF + m * 16; bf16_t* rowp = G + (size_t)row * ldc + col0; const f32x2 st = stats[row];
                const f32x4 g0 = (acc[ai][0][m][0] - cg0 * st.x) * st.y + dg0, g1 = (acc[ai][0][m][1] - cg1 * st.x) * st.y + dg1;
                const f32x4 u0 = (acc[ai][1][m][0] - cu0 * st.x) * st.y + du0, u1 = (acc[ai][1][m][1] - cu1 * st.x) * st.y + du1;
                u32x4 w; w.x = cvt_pk_bf16(act(g0[0], u0[0]), act(g0[1], u0[1])); w.y = cvt_pk_bf16(act(g0[2], u0[2]), act(g0[3], u0[3]));
                w.z = cvt_pk_bf16(act(g1[0], u1[0]), act(g1[1], u1[1])); w.w = cvt_pk_bf16(act(g1[2], u1[2]), act(g1[3], u1[3]));
                *(u32x4*)rowp = w; }
    }
};
struct EpiSwiGLU8 {
    static constexpr bool PERM = true, AFTER_DRAIN = false;
    bf16_t* G; int ldc; const float* sa; const float* sb;
    __device__ __forceinline__ float act(float g, float u) const { return g * u * __builtin_amdgcn_rcpf(1.0f + __builtin_amdgcn_exp2f(-1.4426950408889634f * g)); }
    __device__ __forceinline__ f32x4 cv(const f32x4& a) const { return __builtin_convertvector(__builtin_bit_cast(i32x4, a), f32x4); }
    __device__ __forceinline__ void operator()(const f32x4 (&acc)[2][2][4][2], const Unit& u, int wr, int wc, int fr, int fq) const {
        const int row0 = u.pm * BM + wr * 64 + fr, col0 = u.pn * HALF + wc * 32 + 8 * fq, n0 = u.pn * BM + wc * 32 + 8 * fq;
        const f32x4 cg0 = *(const f32x4*)(sb + n0), cg1 = *(const f32x4*)(sb + n0 + 4), cu0 = *(const f32x4*)(sb + n0 + HALF), cu1 = *(const f32x4*)(sb + n0 + HALF + 4);
#pragma unroll
        for (int ai = 0; ai < 2; ++ai)
#pragma unroll
            for (int m = 0; m < 4; ++m) { const int row = row0 + ai * HALF + m * 16; bf16_t* rowp = G + (size_t)row * ldc + col0; const float s = sa[row];
                const f32x4 g0 = cv(acc[ai][0][m][0]) * (cg0 * s), g1 = cv(acc[ai][0][m][1]) * (cg1 * s);
                const f32x4 u0 = cv(acc[ai][1][m][0]) * (cu0 * s), u1 = cv(acc[ai][1][m][1]) * (cu1 * s);
                u32x4 w; w.x = cvt_pk_bf16(act(g0[0], u0[0]), act(g0[1], u0[1])); w.y = cvt_pk_bf16(act(g0[2], u0[2]), act(g0[3], u0[3]));
                w.z = cvt_pk_bf16(act(g1[0], u1[0]), act(g1[1], u1[1])); w.w = cvt_pk_bf16(act(g1[2], u1[2]), act(g1[3], u1[3]));
                *(u32x4*)rowp = w; }
    }
};
struct EpiSoftmax {
    static constexpr bool PERM = true, AFTER_DRAIN = true;
    bf16_t* P; int ldc; float c2; const f32x2* stats; const float* k1; const float* k2;
    __device__ __forceinline__ void fused(f32x4 (&acc)[2][2][4][2], const Unit& u, int wr, int wc, int fr, int fq, PG8_LAS unsigned char* lds, int wid, int lane) const {
        PG8_LAS float* T1 = (PG8_LAS float*)lds;
        PG8_LAS float* T2 = (PG8_LAS float*)(lds + 4096);
        { const int nb = (u.pm >> 5) * 1024 + u.pn * BM + wc * 32 + 8 * fq;
          f32x4 ka[2][2], kb[2][2];
#pragma unroll
          for (int bj = 0; bj < 2; ++bj)
#pragma unroll
              for (int n = 0; n < 2; ++n) { ka[bj][n] = *(const f32x4*)(k1 + nb + bj * HALF + 4 * n); kb[bj][n] = *(const f32x4*)(k2 + nb + bj * HALF + 4 * n); }
#pragma unroll
          for (int ai = 0; ai < 2; ++ai)
#pragma unroll
              for (int m = 0; m < 4; ++m) { const f32x2 st = stats[u.pm * BM + ai * HALF + wr * 64 + m * 16 + fr];
#pragma unroll
                  for (int bj = 0; bj < 2; ++bj)
#pragma unroll
                      for (int n = 0; n < 2; ++n) acc[ai][bj][m][n] = (acc[ai][bj][m][n] - ka[bj][n] * st.x) * st.y + kb[bj][n]; } }
#pragma unroll
        for (int ai = 0; ai < 2; ++ai)
#pragma unroll
            for (int m = 0; m < 4; ++m) { float mx = -3.0e38f;
#pragma unroll
                for (int bj = 0; bj < 2; ++bj)
#pragma unroll
                    for (int n = 0; n < 2; ++n) { const f32x4 x = acc[ai][bj][m][n]; mx = fmaxf(mx, fmaxf(fmaxf(x[0], x[1]), fmaxf(x[2], x[3]))); }
                mx = fmaxf(mx, __shfl_xor(mx, 16)); mx = fmaxf(mx, __shfl_xor(mx, 32));
                if (fq == 0) T1[(ai * HALF + wr * 64 + m * 16 + fr) * 4 + wc] = mx; }
        asm volatile("s_waitcnt lgkmcnt(0)" ::: "memory"); __builtin_amdgcn_s_barrier(); asm volatile("" ::: "memory");
#pragma unroll
        for (int ai = 0; ai < 2; ++ai)
#pragma unroll
            for (int m = 0; m < 4; ++m) { const int r = ai * HALF + wr * 64 + m * 16 + fr;
                const f32x4 t = *(const PG8_LAS f32x4*)(T1 + r * 4); const float mx = fmaxf(fmaxf(t[0], t[1]), fmaxf(t[2], t[3])) * c2; float s = 0.f;
#pragma unroll
                for (int bj = 0; bj < 2; ++bj)
#pragma unroll
                    for (int n = 0; n < 2; ++n) { f32x4 x = acc[ai][bj][m][n];
#pragma unroll
                        for (int e = 0; e < 4; ++e) { x[e] = __builtin_amdgcn_exp2f(x[e] * c2 - mx); s += x[e]; }
                        acc[ai][bj][m][n] = x; }
                s += __shfl_xor(s, 16); s += __shfl_xor(s, 32);
                if (fq == 0) T2[r * 4 + wc] = s; }
        asm volatile("s_waitcnt lgkmcnt(0)" ::: "memory"); __builtin_amdgcn_s_barrier(); asm volatile("" ::: "memory");
        const int row0 = u.pm * BM + wr * 64 + fr, col0 = u.pn * BM + wc * 32 + 8 * fq;
#pragma unroll
        for (int ai = 0; ai < 2; ++ai)
#pragma unroll
            for (int m = 0; m < 4; ++m) { const int r = ai * HALF + wr * 64 + m * 16 + fr;
                const f32x4 t = *(const PG8_LAS f32x4*)(T2 + r * 4); const float inv = 1.0f / ((t[0] + t[1]) + (t[2] + t[3]));
                bf16_t* rowp = P + (size_t)(row0 + ai * HALF + m * 16) * ldc + col0;
#pragma unroll
                for (int bj = 0; bj < 2; ++bj) { const f32x4 v0 = acc[ai][bj][m][0] * inv, v1 = acc[ai][bj][m][1] * inv;
                    u32x4 w; w.x = cvt_pk_bf16(v0[0], v0[1]); w.y = cvt_pk_bf16(v0[2], v0[3]); w.z = cvt_pk_bf16(v1[0], v1[1]); w.w = cvt_pk_bf16(v1[2], v1[3]);
                    *(u32x4*)(rowp + bj * HALF) = w; } }
    }
};

struct GemmKV {
    const char* memb; const char* wkv; int lda, ldb, K;
    __device__ __forceinline__ const char* a_ptr(const Unit& u) const { return memb + (size_t)u.pm * (BM * 4096 * 2) + (size_t)u.pz * 2048; }
    __device__ __forceinline__ const char* b_ptr(const Unit& u) const { return wkv + (size_t)u.pn * (BM * 4096 * 2) + (size_t)u.pz * 2048; }
};
struct OrderKV {
    int G, c;
    __device__ __forceinline__ bool next(int i, Unit& u) const { const int L = i * G + c; if (L >= 256) return false; const int tile = L >> 2; u.pz = L & 3; u.pm = tile >> 5; u.pn = tile & 31; return true; }
    __device__ __forceinline__ void a_ready(const Unit&) const {}
    __device__ __forceinline__ void done(const Unit&) const {}
    __device__ __forceinline__ int pre_epi(int, int, int) const { return 0; }
    __device__ __forceinline__ void post_epi(int, int, int, int) const {}
};
struct OrderOne {
    Unit u;
    __device__ __forceinline__ bool next(int i, Unit& o) const { if (i != 0) return false; o = u; return true; }
    __device__ __forceinline__ void a_ready(const Unit&) const {}
    __device__ __forceinline__ void done(const Unit&) const {}
    __device__ __forceinline__ int pre_epi(int, int, int) const { return 0; }
    __device__ __forceinline__ void post_epi(int, int, int, int) const {}
};
struct EpiSlabKV {
    static constexpr bool PERM = false, AFTER_DRAIN = false;
    float* S;
    __device__ __forceinline__ void operator()(const f32x4 (&acc)[2][2][4][2], const Unit& u, int wr, int wc, int fr, int fq) const {
        float* C = S + (size_t)u.pz * (512 * 8192);
        const int row0 = u.pm * BM + wr * 64 + fr, col0 = u.pn * BM + wc * 32 + 4 * fq;
#pragma unroll
        for (int ai = 0; ai < 2; ++ai)
#pragma unroll
            for (int m = 0; m < 4; ++m) { float* rowp = C + (size_t)(row0 + ai * HALF + m * 16) * 8192 + col0;
#pragma unroll
                for (int bj = 0; bj < 2; ++bj)
#pragma unroll
                    for (int n = 0; n < 2; ++n) *(f32x4*)(rowp + bj * HALF + n * 16) = acc[ai][bj][m][n]; }
    }
};
struct GemmAbs {
    const char* kvx; const char* wq_raw; const char* wo_t; int lda, ldb, K;
    __device__ __forceinline__ const char* a_ptr(const Unit& u) const {
        return u.pz ? wo_t + (size_t)u.pm * (BM * 4096 * 2) + (size_t)(u.pn & 3) * 2048
                    : kvx + (size_t)(u.pm >> 2) * (BM * 8192 * 2) + (size_t)(u.pm & 3) * 2048; }
    __device__ __forceinline__ const char* b_ptr(const Unit& u) const {
        return u.pz ? kvx + 8192 + (size_t)(u.pn >> 2) * (BM * 8192 * 2) + (size_t)(u.pn & 3) * 2048
                    : wq_raw + (size_t)u.pn * (BM * 4096 * 2) + (size_t)(u.pm & 3) * 2048; }
};
struct OrderAbs {
    int c;
    __device__ __forceinline__ bool next(int i, Unit& u) const { if (i != 0 || c >= 256) return false; if (c < 128) { u.pz = 0; u.pm = c >> 4; u.pn = c & 15; } else { const int t = c - 128; u.pz = 1; u.pm = t >> 3; u.pn = t & 7; } return true; }
    __device__ __forceinline__ void a_ready(const Unit&) const {}
    __device__ __forceinline__ void done(const Unit&) const {}
    __device__ __forceinline__ int pre_epi(int, int, int) const { return 0; }
    __device__ __forceinline__ void post_epi(int, int, int, int) const {}
};
struct EpiStoreAbs {
    static constexpr bool PERM = true, AFTER_DRAIN = false;
    bf16_t* WQK; bf16_t* WVOT; float* k1; float* k2;
    __device__ __forceinline__ void operator()(const f32x4 (&acc)[2][2][4][2], const Unit& u, int wr, int wc, int fr, int fq) const {
        bf16_t* O = u.pz ? WVOT : WQK; const int ldc = u.pz ? 2048 : 4096;
        const int row0 = u.pm * BM + wr * 64 + fr, col0 = u.pn * BM + wc * 32 + 8 * fq;
        f32x4 gv[2][2], bv[2][2];
#pragma unroll
        for (int bj = 0; bj < 2; ++bj)
#pragma unroll
            for (int n = 0; n < 2; ++n) { gv[bj][n] = (f32x4){1.f, 1.f, 1.f, 1.f}; bv[bj][n] = (f32x4){0.f, 0.f, 0.f, 0.f}; }
        if (!u.pz) { const float* const __attribute__((address_space(4)))* inp = (const float* const __attribute__((address_space(4)))*)__builtin_amdgcn_kernarg_segment_ptr();
            const float* g = inp[6]; const float* b = inp[7];
#pragma unroll
            for (int bj = 0; bj < 2; ++bj)
#pragma unroll
                for (int n = 0; n < 2; ++n) { gv[bj][n] = *(const f32x4*)(g + col0 + bj * HALF + 4 * n); bv[bj][n] = *(const f32x4*)(b + col0 + bj * HALF + 4 * n); } }
#pragma unroll
        for (int ai = 0; ai < 2; ++ai)
#pragma unroll
            for (int m = 0; m < 4; ++m) { const int row = row0 + ai * HALF + m * 16; bf16_t* rowp = O + (size_t)row * ldc + col0; float s1 = 0.f, s2 = 0.f, dummy = 0.f;
#pragma unroll
                for (int bj = 0; bj < 2; ++bj) { const f32x4 a0 = acc[ai][bj][m][0], a1 = acc[ai][bj][m][1], v0 = a0 * gv[bj][0], v1 = a1 * gv[bj][1];
                    u32x4 w; w.x = cvt_pk_bf16(v0[0], v0[1]); w.y = cvt_pk_bf16(v0[2], v0[3]); w.z = cvt_pk_bf16(v1[0], v1[1]); w.w = cvt_pk_bf16(v1[2], v1[3]);
                    *(u32x4*)(rowp + bj * HALF) = w; row_stat_acc(w, s1, dummy);
                    const f32x4 t0 = a0 * bv[bj][0], t1 = a1 * bv[bj][1]; s2 += ((t0[0] + t0[1]) + (t0[2] + t0[3])) + ((t1[0] + t1[1]) + (t1[2] + t1[3])); }
                if (!u.pz) { s1 += __shfl_xor(s1, 16); s2 += __shfl_xor(s2, 16); s1 += __shfl_xor(s1, 32); s2 += __shfl_xor(s2, 32);
                    if (fq == 0) { __hip_atomic_fetch_add(k1 + row, s1, __ATOMIC_RELAXED, __HIP_MEMORY_SCOPE_AGENT); __hip_atomic_fetch_add(k2 + row, s2, __ATOMIC_RELAXED, __HIP_MEMORY_SCOPE_AGENT); } } }
    }
};
struct EpiResidLN {
    static constexpr bool PERM = true, AFTER_DRAIN = false;
    bf16_t* T; const f32x2* stats; int gi; f32x2* slots;
    __device__ __forceinline__ void operator()(const f32x4 (&acc)[2][2][4][2], const Unit& u, int wr, int wc, int fr, int fq) const {
        constexpr int ldc = 4096; constexpr float alpha = 1.189207115002721f;
        const float* const __attribute__((address_space(4)))* inp = (const float* const __attribute__((address_space(4)))*)__builtin_amdgcn_kernarg_segment_ptr();
        const float* g = inp[gi]; const float* b = inp[gi + 1];
        const int row0 = u.pm * BM + wr * 64 + fr, col0 = u.pn * BM + wc * 32 + 8 * fq;
        f32x4 gv[2][2], bv[2][2];
#pragma unroll
        for (int bj = 0; bj < 2; ++bj)
#pragma unroll
            for (int n = 0; n < 2; ++n) { gv[bj][n] = *(const f32x4*)(g + col0 + bj * HALF + n * 4) * alpha; bv[bj][n] = *(const f32x4*)(b + col0 + bj * HALF + n * 4) * alpha; }
#pragma unroll
        for (int ai = 0; ai < 2; ++ai)
#pragma unroll
            for (int m = 0; m < 4; ++m) { const int row = row0 + ai * HALF + m * 16; const size_t off = (size_t)row * ldc + col0; const f32x2 st = stats[row]; float ss = 0.f, qq = 0.f;
#pragma unroll
                for (int bj = 0; bj < 2; ++bj) { const u32x4 r = *(const u32x4*)(T + off + bj * HALF);
                    const f32x4 t0 = (f32x4){__builtin_bit_cast(float, r.x << 16), __builtin_bit_cast(float, r.x & 0xffff0000u), __builtin_bit_cast(float, r.y << 16), __builtin_bit_cast(float, r.y & 0xffff0000u)};
                    const f32x4 t1 = (f32x4){__builtin_bit_cast(float, r.z << 16), __builtin_bit_cast(float, r.z & 0xffff0000u), __builtin_bit_cast(float, r.w << 16), __builtin_bit_cast(float, r.w & 0xffff0000u)};
                    const f32x4 v0 = ((t0 - st.x) * st.y) * gv[bj][0] + bv[bj][0] + acc[ai][bj][m][0], v1 = ((t1 - st.x) * st.y) * gv[bj][1] + bv[bj][1] + acc[ai][bj][m][1];
                    u32x4 w; w.x = cvt_pk_bf16(v0[0], v0[1]); w.y = cvt_pk_bf16(v0[2], v0[3]); w.z = cvt_pk_bf16(v1[0], v1[1]); w.w = cvt_pk_bf16(v1[2], v1[3]);
                    *(u32x4*)(T + off + bj * HALF) = w; row_stat_acc(w, ss, qq); }
                if (slots) row_stat_store(slots, row, u.pn * 4 + wc, fq, ss, qq);
                if (m == 3) asm volatile("" ::: "memory"); }
    }
};

template <class Epi, class Sched, bool ALIGN_EPI = false, bool SP2 = false, class GT = Gemm, bool I8 = false>
__device__ __forceinline__ void gemm_phase(PG8_LAS unsigned char* lds, const GT g, const Sched& S, const Epi& E) {
    const int tid = threadIdx.x, wid = __builtin_amdgcn_readfirstlane(tid >> 6), lane = tid & 63, wr = wid >> 2, wc = wid & 3, fr = lane & 15, fq = lane >> 4;
    const int K = g.K, nt = K / BK;
    unsigned voffA[2], voffB[2];
#pragma unroll
    for (int i = 0; i < 2; ++i) { int R, C; stage_rc(tid * 16 + i * 8192, R, C); const int Rb = Epi::PERM ? ((R & ~31) + perm32(R & 31)) : R;
        voffA[i] = (unsigned)(R * g.lda + C) * 2u; voffB[i] = (unsigned)(Rb * g.ldb + C) * 2u; }
    const size_t kstep = (size_t)(BK * 2);
    const size_t hA = (size_t)HALF * g.lda * 2, hB = (size_t)HALF * g.ldb * 2;
    const unsigned ldsw = (unsigned)wid * 1024u;
    const int aoff = lds_byte(wr * 64 + fr, fq * 8), boff = lds_byte(wc * 32 + fr, fq * 8);
#define PG8_SA(b, h) (((b) * 2 + (h)) * HTB)
#define PG8_SB(b, h) ((4 + (b) * 2 + (h)) * HTB)
#define PG8_STAGE(bufoff, gbase, voff) do { _Pragma("unroll") for (int _i = 0; _i < 2; ++_i) \
        __builtin_amdgcn_global_load_lds((const unsigned*)((const char*)(gbase) + (voff)[_i]), (PG8_LAS unsigned*)(lds + (bufoff) + ldsw + _i * 8192), 16, 0, 0); } while (0)
#define PG8_LDA(dst, b, h) do { _Pragma("unroll") for (int m = 0; m < 4; ++m) _Pragma("unroll") for (int k = 0; k < 2; ++k) dst[m][k] = *(const PG8_LAS bf16x8*)(lds + PG8_SA(b, h) + aoff + m * 2048 + k * 1024); } while (0)
#define PG8_LDB(dst, b, h) do { _Pragma("unroll") for (int n = 0; n < 2; ++n) _Pragma("unroll") for (int k = 0; k < 2; ++k) dst[n][k] = *(const PG8_LAS bf16x8*)(lds + PG8_SB(b, h) + boff + n * 2048 + k * 1024); } while (0)
#define PG8_MMA(ai, bj, At, Bt) do { __builtin_amdgcn_s_setprio(1); _Pragma("unroll") for (int m = 0; m < 4; ++m) _Pragma("unroll") for (int n = 0; n < 2; ++n) _Pragma("unroll") for (int k = 0; k < 2; ++k) \
        { if constexpr (I8) acc[ai][bj][m][n] = __builtin_bit_cast(f32x4, __builtin_amdgcn_mfma_i32_16x16x64_i8(__builtin_bit_cast(i32x4, Bt[n][k]), __builtin_bit_cast(i32x4, At[m][k]), __builtin_bit_cast(i32x4, acc[ai][bj][m][n]), 0, 0, 0)); \
          else acc[ai][bj][m][n] = __builtin_amdgcn_mfma_f32_16x16x32_bf16(Bt[n][k], At[m][k], acc[ai][bj][m][n], 0, 0, 0); } __builtin_amdgcn_s_setprio(0); } while (0)
#define PG8_WAIT_V(n) asm volatile("s_waitcnt vmcnt(" #n ")" ::: "memory")
#define PG8_WAIT_L(n) asm volatile("s_waitcnt lgkmcnt(" #n ")" ::: "memory")
#define PG8_BAR __builtin_amdgcn_s_barrier()
#define PG8_SCHED __builtin_amdgcn_sched_barrier(0)
    Unit cur, nxt; int ui = 0;
    if (!S.next(0, cur)) return;
    f32x4 acc[2][2][4][2];
#pragma unroll
    for (int a = 0; a < 2; ++a)
#pragma unroll
        for (int b = 0; b < 2; ++b)
#pragma unroll
            for (int m = 0; m < 4; ++m)
#pragma unroll
                for (int n = 0; n < 2; ++n) acc[a][b][m][n] = (f32x4){0.f, 0.f, 0.f, 0.f};
    bf16x8 At[4][2], B0[2][2], B1[2][2];
    const char* cA = g.a_ptr(cur); const char* cB = g.b_ptr(cur);
    S.a_ready(cur);
    if constexpr (SP2) {
        PG8_STAGE(PG8_SB(0, 0), cB, voffB); PG8_STAGE(PG8_SB(0, 1), cB + hB, voffB); PG8_STAGE(PG8_SA(0, 0), cA, voffA); PG8_STAGE(PG8_SA(0, 1), cA + hA, voffA);
        if (wr == 1) PG8_BAR;
        PG8_WAIT_V(2); PG8_BAR;
        PG8_STAGE(PG8_SB(1, 0), cB + kstep, voffB); PG8_STAGE(PG8_SA(1, 0), cA + kstep, voffA); PG8_STAGE(PG8_SB(1, 1), cB + hB + kstep, voffB);
        PG8_WAIT_V(6); PG8_BAR;
    } else {
        PG8_STAGE(PG8_SB(0, 0), cB, voffB); PG8_STAGE(PG8_SA(0, 0), cA, voffA); PG8_STAGE(PG8_SB(0, 1), cB + hB, voffB); PG8_STAGE(PG8_SA(0, 1), cA + hA, voffA);
        if (wr == 1) PG8_BAR;
        PG8_WAIT_V(4); PG8_BAR;
        PG8_STAGE(PG8_SB(1, 0), cB + kstep, voffB); PG8_STAGE(PG8_SA(1, 0), cA + kstep, voffA); PG8_STAGE(PG8_SB(1, 1), cB + hB + kstep, voffB);
        PG8_WAIT_V(6); PG8_BAR;
    }
    for (;;) {
        bool has_next = false;
        const char* nA = cA; const char* nB = cB;
        for (int t = 0; t < nt; t += 2) {
            const bool last = (t == nt - 2);
            if (last) { has_next = S.next(ui + 1, nxt); if (has_next) { nA = g.a_ptr(nxt); nB = g.b_ptr(nxt); S.a_ready(nxt); } }
            const char* a1 = cA + (size_t)(t + 1) * kstep;
            const char* a2 = last ? nA : cA + (size_t)(t + 2) * kstep; const char* b2 = last ? nB : cB + (size_t)(t + 2) * kstep;
            const char* a3 = a2 + kstep; const char* b3 = b2 + kstep;
            if constexpr (SP2) {
            PG8_LDB(B0, 0, 0); PG8_LDB(B1, 0, 1); PG8_SCHED; PG8_LDA(At, 0, 0); PG8_STAGE(PG8_SA(1, 1), a1 + hA, voffA);
            PG8_WAIT_V(8); PG8_WAIT_L(0); PG8_BAR; PG8_MMA(0, 0, At, B0); PG8_MMA(0, 1, At, B1); PG8_BAR; PG8_SCHED;
            PG8_LDA(At, 0, 1); PG8_STAGE(PG8_SB(0, 0), b2, voffB); PG8_STAGE(PG8_SB(0, 1), b2 + hB, voffB); PG8_STAGE(PG8_SA(0, 0), a2, voffA);
            PG8_WAIT_V(8); PG8_WAIT_L(0); PG8_BAR; PG8_MMA(1, 0, At, B0); PG8_MMA(1, 1, At, B1); PG8_BAR; PG8_SCHED;
            PG8_LDB(B0, 1, 0); PG8_LDB(B1, 1, 1); PG8_SCHED; PG8_LDA(At, 1, 0); PG8_STAGE(PG8_SA(0, 1), a2 + hA, voffA);
            PG8_WAIT_V(8); PG8_WAIT_L(0); PG8_BAR; PG8_MMA(0, 0, At, B0); PG8_MMA(0, 1, At, B1); PG8_BAR; PG8_SCHED;
            PG8_LDA(At, 1, 1); PG8_STAGE(PG8_SB(1, 0), b3, voffB); PG8_STAGE(PG8_SB(1, 1), b3 + hB, voffB); PG8_STAGE(PG8_SA(1, 0), a3, voffA);
            PG8_WAIT_V(8); PG8_WAIT_L(0); PG8_BAR; PG8_MMA(1, 0, At, B0); PG8_MMA(1, 1, At, B1); PG8_BAR; PG8_SCHED;
            } else {
            PG8_LDB(B0, 0, 0); PG8_SCHED; PG8_LDA(At, 0, 0); PG8_STAGE(PG8_SA(1, 1), a1 + hA, voffA);
            PG8_WAIT_L(8); PG8_BAR; PG8_WAIT_L(0); PG8_MMA(0, 0, At, B0); PG8_BAR; PG8_SCHED;
            PG8_LDB(B1, 0, 1); PG8_STAGE(PG8_SB(0, 0), b2, voffB);
            PG8_BAR; PG8_WAIT_L(0); PG8_MMA(0, 1, At, B1); PG8_BAR;
            PG8_LDA(At, 0, 1); PG8_STAGE(PG8_SA(0, 0), a2, voffA);
            PG8_BAR; PG8_WAIT_L(0); PG8_MMA(1, 0, At, B0); PG8_BAR; PG8_SCHED;
            PG8_STAGE(PG8_SB(0, 1), b2 + hB, voffB);
            PG8_WAIT_V(6); PG8_BAR; PG8_MMA(1, 1, At, B1); PG8_BAR;
            PG8_LDB(B0, 1, 0); PG8_SCHED; PG8_LDA(At, 1, 0); PG8_STAGE(PG8_SA(0, 1), a2 + hA, voffA);
            PG8_WAIT_L(8); PG8_BAR; PG8_WAIT_L(0); PG8_MMA(0, 0, At, B0); PG8_BAR; PG8_SCHED;
            PG8_LDB(B1, 1, 1); PG8_STAGE(PG8_SB(1, 0), b3, voffB);
            PG8_BAR; PG8_WAIT_L(0); PG8_MMA(0, 1, At, B1); PG8_BAR;
            PG8_LDA(At, 1, 1); PG8_STAGE(PG8_SA(1, 0), a3, voffA);
            PG8_BAR; PG8_WAIT_L(0); PG8_MMA(1, 0, At, B0); PG8_BAR; PG8_SCHED;
            PG8_STAGE(PG8_SB(1, 1), b3 + hB, voffB);
            PG8_WAIT_V(6); PG8_BAR; PG8_MMA(1, 1, At, B1); PG8_BAR;
            }
        }
        if constexpr (ALIGN_EPI) { if (wr == 0) PG8_BAR; }
        if constexpr (!Epi::AFTER_DRAIN) { const int tk_ = S.pre_epi(ui, wid, lane); E(acc, cur, wr, wc, fr, fq); S.post_epi(ui, wid, lane, tk_); S.done(cur); }
        if (!has_next) break;
#pragma unroll
        for (int a = 0; a < 2; ++a)
#pragma unroll
            for (int b = 0; b < 2; ++b)
#pragma unroll
                for (int m = 0; m < 4; ++m)
#pragma unroll
                    for (int n = 0; n < 2; ++n) acc[a][b][m][n] = (f32x4){0.f, 0.f, 0.f, 0.f};
        cur = nxt; cA = nA; cB = nB; ++ui;
        if constexpr (ALIGN_EPI) { if (wr == 1) PG8_BAR; }
    }
    PG8_WAIT_V(0);
    if constexpr (!ALIGN_EPI) { if (wr == 0) PG8_BAR; }
    PG8_BAR;
    if constexpr (Epi::AFTER_DRAIN) { E.fused(acc, cur, wr, wc, fr, fq, lds, wid, lane); S.done(cur); }
#undef PG8_SA
#undef PG8_SB
#undef PG8_STAGE
#undef PG8_LDA
#undef PG8_LDB
#undef PG8_MMA
#undef PG8_WAIT_V
#undef PG8_WAIT_L
#undef PG8_BAR
#undef PG8_SCHED
}
}

namespace att {
using bf16_t = unsigned short;
using bf16x8 = __attribute__((ext_vector_type(8))) short;
using s16x4  = __attribute__((ext_vector_type(4))) short;
using f32x16 = __attribute__((ext_vector_type(16))) float;
using u32x4  = __attribute__((ext_vector_type(4))) unsigned;
using u32x2  = __attribute__((ext_vector_type(2))) unsigned;
constexpr int   D = 128, NW = 8, QBLK = 32, KVBLK = 64, NT = 4;
constexpr float SCALE = 0.088388347648318440f;
constexpr float THR = 8.f;
constexpr int   LDQ = 2048, LDK = 2048;
constexpr size_t SHM_V = KVBLK * D * 2, SHM_K = KVBLK * D * 2, SHM_ATTN = 2 * SHM_V + 2 * SHM_K;
#define KSWZ(row, colB) ((row) * 256 + ((colB) ^ (((row) & 7) << 4)))
#define SBAR() __builtin_amdgcn_sched_barrier(0)
__device__ __forceinline__ int crow(int r, int hi) { return (r & 3) + 8 * (r >> 2) + 4 * hi; }
__device__ __forceinline__ unsigned cvtpk(float lo, float hi) { unsigned r; asm volatile("v_cvt_pk_bf16_f32 %0, %1, %2" : "=v"(r) : "v"(lo), "v"(hi)); return r; }

__device__ __forceinline__ void partialSM(f32x16& p0, f32x16& p1, float& m_reg, float& mn, float& alpha) {
  constexpr float C = SCALE * 1.4426950408889634f;
  float pmax = p0[0];
#pragma unroll
  for (int r = 1; r < 16; ++r) pmax = fmaxf(pmax, p0[r]);
#pragma unroll
  for (int r = 0; r < 16; ++r) pmax = fmaxf(pmax, p1[r]);
  { auto rr = __builtin_amdgcn_permlane32_swap(__float_as_uint(pmax), __float_as_uint(pmax), false, false);
    pmax = fmaxf(__uint_as_float(rr[0]), __uint_as_float(rr[1])); }
  if (__builtin_expect(__all(pmax - m_reg <= THR / SCALE), 1)) { mn = m_reg; alpha = 1.f; }
  else { mn = fmaxf(m_reg, pmax); alpha = __builtin_amdgcn_exp2f((m_reg - mn) * C); m_reg = mn; }
  float mnC = -mn * C;
#pragma unroll
  for (int r = 0; r < 16; ++r) p0[r] = fmaf(p0[r], C, mnC);
#pragma unroll
  for (int r = 0; r < 16; ++r) p1[r] = fmaf(p1[r], C, mnC);
#pragma unroll
  for (int r = 0; r < 16; ++r) p0[r] = __builtin_amdgcn_exp2f(p0[r]);
}
__device__ __forceinline__ void finishSM(f32x16& p0, f32x16& p1, float alpha, float& l_reg, bf16x8& pa0, bf16x8& pa1, bf16x8& pa2, bf16x8& pa3) {
#pragma unroll
  for (int r = 0; r < 16; ++r) p1[r] = __builtin_amdgcn_exp2f(p1[r]);
  float ps = 0;
#pragma unroll
  for (int r = 0; r < 16; ++r) ps += p0[r];
#pragma unroll
  for (int r = 0; r < 16; ++r) ps += p1[r];
  { auto rr = __builtin_amdgcn_permlane32_swap(__float_as_uint(ps), __float_as_uint(ps), false, false);
    ps = __uint_as_float(rr[0]) + __uint_as_float(rr[1]); }
  l_reg = l_reg * alpha + ps;
#define PK4(P, BASE, OUT) do { unsigned a0 = cvtpk(P[BASE + 0], P[BASE + 1]), a1 = cvtpk(P[BASE + 2], P[BASE + 3]);   \
    unsigned b0 = cvtpk(P[BASE + 4], P[BASE + 5]), b1 = cvtpk(P[BASE + 6], P[BASE + 7]);                              \
    auto r0 = __builtin_amdgcn_permlane32_swap(a0, b0, false, false); auto r1 = __builtin_amdgcn_permlane32_swap(a1, b1, false, false); \
    u32x4 w = {r0[0], r1[0], r0[1], r1[1]}; OUT = *reinterpret_cast<bf16x8*>(&w); } while (0)
  PK4(p0, 0, pa0); PK4(p0, 8, pa1); PK4(p1, 0, pa2); PK4(p1, 8, pa3);
#undef PK4
}
__device__ __forceinline__ void qkt(f32x16& p0, f32x16& p1, const char* Ks, const bf16x8* qr, int r32, int hi) {
  p0 = f32x16{}; p1 = f32x16{};
#pragma unroll
  for (int d0 = 0; d0 < 8; ++d0) { int cb = (d0 * 16 + hi * 8) * 2;
    bf16x8 b0 = *reinterpret_cast<const bf16x8*>(Ks + KSWZ(r32, cb));
    bf16x8 b1 = *reinterpret_cast<const bf16x8*>(Ks + KSWZ(32 + r32, cb));
    p0 = __builtin_amdgcn_mfma_f32_32x32x16_bf16(b0, qr[d0], p0, 0, 0, 0);
    p1 = __builtin_amdgcn_mfma_f32_32x32x16_bf16(b1, qr[d0], p1, 0, 0, 0); }
}
__device__ __forceinline__ void cmask(f32x16& p0, f32x16& p1, int jt, int qloc, int hi) {
#pragma unroll
  for (int r = 0; r < 16; ++r) { const int key = 64 * jt + crow(r, hi); if (key > qloc) p0[r] = -1e30f; if (key + 32 > qloc) p1[r] = -1e30f; }
}
__device__ __forceinline__ int v_st(int k, int c) { const int kk = (k & ~0xC) | ((k & 4) << 1) | ((k & 8) >> 1); return ((kk >> 3) * 4 + (c >> 5)) * 512 + ((kk & 7) * 32 + (c & 31)) * 2; }
__device__ __forceinline__ int v_rd_base(int lane) { return ((lane & 3) << 3) | (((lane >> 2) & 3) << 6) | (((lane >> 4) & 1) << 5) | (((lane >> 5) & 1) << 8); }
constexpr int v_rd_off(int d0, int ks, int half) { return d0 * 512 + ks * 4096 + half * 2048; }
template <int OFF> __device__ __forceinline__ s16x4 tr_read(int vb) {
  s16x4 r; asm volatile("ds_read_b64_tr_b16 %0, %1 offset:%2" : "=&v"(r) : "v"(vb), "i"(OFF) : "memory"); return r;
}
template <int D0> __device__ __forceinline__ void pv_one(f32x16& od, int vb, bf16x8 pa0, bf16x8 pa1, bf16x8 pa2, bf16x8 pa3) {
  const s16x4 l0 = tr_read<v_rd_off(D0, 0, 0)>(vb), h0 = tr_read<v_rd_off(D0, 0, 1)>(vb), l1 = tr_read<v_rd_off(D0, 1, 0)>(vb), h1 = tr_read<v_rd_off(D0, 1, 1)>(vb);
  const s16x4 l2 = tr_read<v_rd_off(D0, 2, 0)>(vb), h2 = tr_read<v_rd_off(D0, 2, 1)>(vb), l3 = tr_read<v_rd_off(D0, 3, 0)>(vb), h3 = tr_read<v_rd_off(D0, 3, 1)>(vb);
  asm volatile("s_waitcnt lgkmcnt(0)" ::: "memory"); SBAR();
#define PK(L, H) (bf16x8){L[0], L[1], L[2], L[3], H[0], H[1], H[2], H[3]}
  od = __builtin_amdgcn_mfma_f32_32x32x16_bf16(PK(l0, h0), pa0, od, 0, 0, 0);
  od = __builtin_amdgcn_mfma_f32_32x32x16_bf16(PK(l1, h1), pa1, od, 0, 0, 0);
  od = __builtin_amdgcn_mfma_f32_32x32x16_bf16(PK(l2, h2), pa2, od, 0, 0, 0);
  od = __builtin_amdgcn_mfma_f32_32x32x16_bf16(PK(l3, h3), pa3, od, 0, 0, 0);
#undef PK
}
__device__ __forceinline__ void pv_d0(f32x16* o, int vb, bf16x8 pa0, bf16x8 pa1, bf16x8 pa2, bf16x8 pa3) {
  pv_one<0>(o[0], vb, pa0, pa1, pa2, pa3); pv_one<1>(o[1], vb, pa0, pa1, pa2, pa3); pv_one<2>(o[2], vb, pa0, pa1, pa2, pa3); pv_one<3>(o[3], vb, pa0, pa1, pa2, pa3);
}

__device__ __forceinline__ void attn_item(const bf16_t* __restrict__ Qrow, const bf16_t* __restrict__ Kh, const bf16_t* __restrict__ Vh, bool causal, int qloc,
                                          bf16_t* Orow, float2* MLrow, bool valid, char* lds) {
  const int tid = threadIdx.x, lane = tid & 63, r32 = lane & 31, hi = lane >> 5;
  char* V_lds = lds; char* K_lds = lds + 2 * SHM_V;
  float m_reg = -1e30f, l_reg = 0; f32x16 o[4] = {}; bf16x8 qr[8];
  const bf16_t* Qw = Qrow + hi * 8;
#pragma unroll
  for (int d0 = 0; d0 < 8; ++d0) qr[d0] = *reinterpret_cast<const bf16x8*>(Qw + d0 * 16);
  const int sr = tid >> 4, sc = (tid & 15) * 8, vst0 = v_st(sr, sc), vst1 = v_st(32 + sr, sc);
  const int vb0 = (int)(uintptr_t)V_lds + v_rd_base(lane);
  struct { bf16x8 vs0, vs1, ks0, ks1; } sr_[2];
#define SLOAD(i, k0) do { sr_[i].vs0 = *reinterpret_cast<const bf16x8*>(&Vh[(long)((k0) + sr) * LDK + sc]); sr_[i].vs1 = *reinterpret_cast<const bf16x8*>(&Vh[(long)((k0) + 32 + sr) * LDK + sc]); \
    sr_[i].ks0 = *reinterpret_cast<const bf16x8*>(&Kh[(long)((k0) + sr) * LDK + sc]); sr_[i].ks1 = *reinterpret_cast<const bf16x8*>(&Kh[(long)((k0) + 32 + sr) * LDK + sc]); } while (0)
#define SWRITE(b, i) do { *(bf16x8*)(V_lds + (b) * SHM_V + vst0) = sr_[i].vs0;          \
    *(bf16x8*)(V_lds + (b) * SHM_V + vst1) = sr_[i].vs1; int kc = sc * 2;               \
    *(bf16x8*)(K_lds + (b) * SHM_K + KSWZ(sr, kc)) = sr_[i].ks0;                       \
    *(bf16x8*)(K_lds + (b) * SHM_K + KSWZ(32 + sr, kc)) = sr_[i].ks1; } while (0)
#define SWAIT() asm volatile("s_waitcnt vmcnt(4)" ::: "memory")
#define RESC(a) do { if (__any((a) < 1.f)) { _Pragma("unroll") for (int d = 0; d < 4; ++d) _Pragma("unroll") for (int r = 0; r < 16; ++r) o[d][r] *= (a); } } while (0)
  f32x16 pA0, pA1, pB0, pB1; float mnA, mnB, alA, alB; bf16x8 pa0, pa1, pa2, pa3;
  constexpr int SE = 0, SO = 1;
  SLOAD(SE, 0); asm volatile("s_waitcnt vmcnt(0)" ::: "memory"); SWRITE(0, SE); __syncthreads();
  qkt(pA0, pA1, K_lds, qr, r32, hi); if (causal) cmask(pA0, pA1, 0, qloc, hi); partialSM(pA0, pA1, m_reg, mnA, alA);
  SLOAD(SO, KVBLK); SLOAD(SE, 2 * KVBLK);
  SWAIT(); SWRITE(1, SO); __syncthreads();
  {
    SBAR(); qkt(pB0, pB1, K_lds + SHM_K, qr, r32, hi); if (causal) cmask(pB0, pB1, 1, qloc, hi);
    finishSM(pA0, pA1, alA, l_reg, pa0, pa1, pa2, pa3); SBAR();
    SLOAD(SO, 3 * KVBLK); SBAR();
    pv_d0(o, vb0, pa0, pa1, pa2, pa3); partialSM(pB0, pB1, m_reg, mnB, alB);
    __syncthreads(); SWAIT(); SWRITE(0, SE);
    RESC(alB); __syncthreads();
    SBAR(); qkt(pA0, pA1, K_lds, qr, r32, hi); if (causal) cmask(pA0, pA1, 2, qloc, hi);
    finishSM(pB0, pB1, alB, l_reg, pa0, pa1, pa2, pa3); SBAR();
    pv_d0(o, vb0 + (int)SHM_V, pa0, pa1, pa2, pa3); partialSM(pA0, pA1, m_reg, mnA, alA);
    __syncthreads(); asm volatile("s_waitcnt vmcnt(0)" ::: "memory"); SWRITE(1, SO);
    RESC(alA); __syncthreads();
  }
  SBAR(); qkt(pB0, pB1, K_lds + SHM_K, qr, r32, hi); if (causal) cmask(pB0, pB1, 3, qloc, hi);
  finishSM(pA0, pA1, alA, l_reg, pa0, pa1, pa2, pa3); SBAR();
  pv_d0(o, vb0, pa0, pa1, pa2, pa3); partialSM(pB0, pB1, m_reg, mnB, alB);
  __syncthreads(); RESC(alB);
  finishSM(pB0, pB1, alB, l_reg, pa0, pa1, pa2, pa3); SBAR();
  pv_d0(o, vb0 + (int)SHM_V, pa0, pa1, pa2, pa3);
  const float rl = 1.0f / l_reg;
  if (valid) {
#pragma unroll
    for (int d0 = 0; d0 < 4; ++d0)
#pragma unroll
      for (int g = 0; g < 4; ++g) { u32x2 w; w.x = cvtpk(o[d0][4 * g] * rl, o[d0][4 * g + 1] * rl); w.y = cvtpk(o[d0][4 * g + 2] * rl, o[d0][4 * g + 3] * rl);
        *reinterpret_cast<u32x2*>(Orow + 32 * d0 + 8 * g + 4 * hi) = w; }
    if (hi == 0) *MLrow = make_float2(m_reg, l_reg);
  }
#undef SLOAD
#undef SWRITE
#undef SWAIT
#undef RESC
}

struct ItemCtx { const bf16_t* Q; const bf16_t* K; const bf16_t* V; bf16_t* PO; float2* ML; const unsigned short* lists; };
__device__ __forceinline__ unsigned item_entry(const ItemCtx& C, const __attribute__((address_space(3))) int* D, int k, int rloc) {
  const int own = D[4 * k + 1], j = D[4 * k] & 31, cnt = D[4 * k + 3];
  if (own) return (unsigned)(256 * j + rloc) | (3u << 13);
  return (unsigned)C.lists[(size_t)(unsigned)D[4 * k + 2] + (rloc < cnt ? rloc : 0)];
}
__device__ __forceinline__ void attn_items(const ItemCtx& C, const __attribute__((address_space(3))) int* D, int nloc, char* lds) {
  if (nloc <= 0) return;
  const int tid = threadIdx.x, wid = tid >> 6, lane = tid & 63, r32 = lane & 31, hi = lane >> 5, rloc = 32 * wid + r32;
  char* V_lds = lds; char* K_lds = lds + 2 * SHM_V;
  const int sr = tid >> 4, sc = (tid & 15) * 8, vst0 = v_st(sr, sc), vst1 = v_st(32 + sr, sc);
  const int vb0 = (int)(uintptr_t)V_lds + v_rd_base(lane);
  struct { bf16x8 vs0, vs1, ks0, ks1; } sr_[2];
  bf16x8 qr[8];
#define KVBASE(k, Kh, Vh) const bf16_t* Kh; const bf16_t* Vh; { const int bhj_ = D[4 * (k)], bh_ = bhj_ >> 5, j_ = bhj_ & 31; \
    const size_t off_ = ((size_t)(bh_ >> 4) * 8192 + 256 * j_) * LDK + (bh_ & 15) * D_; Kh = C.K + off_; Vh = C.V + off_; }
#define SLOADP(i, Kh, Vh, k0) do { sr_[i].vs0 = *reinterpret_cast<const bf16x8*>(&Vh[(long)((k0) + sr) * LDK + sc]); sr_[i].vs1 = *reinterpret_cast<const bf16x8*>(&Vh[(long)((k0) + 32 + sr) * LDK + sc]); \
    sr_[i].ks0 = *reinterpret_cast<const bf16x8*>(&Kh[(long)((k0) + sr) * LDK + sc]); sr_[i].ks1 = *reinterpret_cast<const bf16x8*>(&Kh[(long)((k0) + 32 + sr) * LDK + sc]); } while (0)
#define SWRITE(b, i) do { *(bf16x8*)(V_lds + (b) * SHM_V + vst0) = sr_[i].vs0;          \
    *(bf16x8*)(V_lds + (b) * SHM_V + vst1) = sr_[i].vs1; int kc = sc * 2;               \
    *(bf16x8*)(K_lds + (b) * SHM_K + KSWZ(sr, kc)) = sr_[i].ks0;                       \
    *(bf16x8*)(K_lds + (b) * SHM_K + KSWZ(32 + sr, kc)) = sr_[i].ks1; } while (0)
#define QLOAD(e, k) do { const int bh_ = D[4 * (k)] >> 5; const bf16_t* Qw_ = C.Q + ((size_t)(bh_ >> 4) * 8192 + ((e) & 8191u)) * LDQ + (bh_ & 15) * D_ + hi * 8; \
    _Pragma("unroll") for (int d0 = 0; d0 < 8; ++d0) qr[d0] = *reinterpret_cast<const bf16x8*>(Qw_ + d0 * 16); } while (0)
#define RESC(a) do { if (__any((a) < 1.f)) { _Pragma("unroll") for (int d = 0; d < 4; ++d) _Pragma("unroll") for (int r = 0; r < 16; ++r) o[d][r] *= (a); } } while (0)
  constexpr int D_ = 128, SE = 0, SO = 1;
  unsigned e_cur = item_entry(C, D, 0, rloc), e_nxt = (nloc > 1) ? item_entry(C, D, 1, rloc) : 0u;
  { KVBASE(0, Kh, Vh); SLOADP(SE, Kh, Vh, 0); SLOADP(SO, Kh, Vh, KVBLK); }
  QLOAD(e_cur, 0);
  for (int k = 0; k < nloc; ++k) {
    const bool has_next = (k + 1 < nloc);
    const bool causal = D[4 * k + 1] != 0; const int cnt = D[4 * k + 3];
    KVBASE(k, Kh, Vh);
    float m_reg = -1e30f, l_reg = 0; f32x16 o[4] = {};
    f32x16 pA0, pA1, pB0, pB1; float mnA, mnB, alA, alB; bf16x8 pa0, pa1, pa2, pa3;
    asm volatile("s_waitcnt vmcnt(0)" ::: "memory"); SWRITE(0, SE); __syncthreads();
    qkt(pA0, pA1, K_lds, qr, r32, hi); if (causal) cmask(pA0, pA1, 0, rloc, hi); partialSM(pA0, pA1, m_reg, mnA, alA);
    SLOADP(SE, Kh, Vh, 2 * KVBLK);
    SWRITE(1, SO); __syncthreads();
    SLOADP(SO, Kh, Vh, 3 * KVBLK);
    SBAR(); qkt(pB0, pB1, K_lds + SHM_K, qr, r32, hi); if (causal) cmask(pB0, pB1, 1, rloc, hi);
    finishSM(pA0, pA1, alA, l_reg, pa0, pa1, pa2, pa3); SBAR();
    pv_d0(o, vb0, pa0, pa1, pa2, pa3); partialSM(pB0, pB1, m_reg, mnB, alB);
    __syncthreads(); asm volatile("s_waitcnt vmcnt(4)" ::: "memory"); SWRITE(0, SE);
    RESC(alB); __syncthreads();
    if (has_next) { KVBASE(k + 1, Kn, Vn); SLOADP(SE, Kn, Vn, 0); }
    SBAR(); qkt(pA0, pA1, K_lds, qr, r32, hi); if (causal) cmask(pA0, pA1, 2, rloc, hi);
    finishSM(pB0, pB1, alB, l_reg, pa0, pa1, pa2, pa3); SBAR();
    pv_d0(o, vb0 + (int)SHM_V, pa0, pa1, pa2, pa3); partialSM(pA0, pA1, m_reg, mnA, alA);
    __syncthreads(); SWRITE(1, SO);
    RESC(alA); __syncthreads();
    if (has_next) { KVBASE(k + 1, Kn, Vn); SLOADP(SO, Kn, Vn, KVBLK); }
    SBAR(); qkt(pB0, pB1, K_lds + SHM_K, qr, r32, hi); if (causal) cmask(pB0, pB1, 3, rloc, hi);
    SBAR();
    if (has_next) QLOAD(e_nxt, k + 1);
    finishSM(pA0, pA1, alA, l_reg, pa0, pa1, pa2, pa3); SBAR();
    pv_d0(o, vb0, pa0, pa1, pa2, pa3); partialSM(pB0, pB1, m_reg, mnB, alB);
    __syncthreads(); RESC(alB);
    finishSM(pB0, pB1, alB, l_reg, pa0, pa1, pa2, pa3); SBAR();
    pv_d0(o, vb0 + (int)SHM_V, pa0, pa1, pa2, pa3);
    { const float rl = 1.0f / l_reg; const int bh = D[4 * k] >> 5; const unsigned t = e_cur & 8191u, slot = e_cur >> 13;
      if (rloc < cnt) {
        bf16_t* Orow = C.PO + (((size_t)slot * 32 + bh) * 8192 + t) * D_;
#pragma unroll
        for (int d0 = 0; d0 < 4; ++d0)
#pragma unroll
          for (int g = 0; g < 4; ++g) { u32x2 w; w.x = cvtpk(o[d0][4 * g] * rl, o[d0][4 * g + 1] * rl); w.y = cvtpk(o[d0][4 * g + 2] * rl, o[d0][4 * g + 3] * rl);
            *reinterpret_cast<u32x2*>(Orow + 32 * d0 + 8 * g + 4 * hi) = w; }
        if (hi == 0) C.ML[((size_t)slot * 32 + bh) * 8192 + t] = make_float2(m_reg, l_reg);
      } }
    e_cur = e_nxt; if (k + 2 < nloc) e_nxt = item_entry(C, D, k + 2, rloc);
  }
#undef KVBASE
#undef SLOADP
#undef SWRITE
#undef QLOAD
#undef RESC
}
#undef KSWZ
#undef SBAR
}

constexpr int NWAVES = 8;
#ifndef MK_N_LAUNCHES
#define MK_N_LAUNCHES 1
#endif
constexpr int N_PHASES = 16;
constexpr int N_LAUNCHES = MK_N_LAUNCHES;

constexpr int BATCH = 2, SEQ = 8192, DM = 4096, M = BATCH * SEQ, MEMLEN = 256;
constexpr int PW = 2048, AW = 2048, NH = 16, HD = 128, NBLK = 32, MIXIN = 8192, FF = 11008, XH = 4, XHD = 1024;
constexpr float LN_EPS = 1e-5f;
constexpr float DN_ALPHA = 1.189207115002721f;

constexpr size_t MiB = 1u << 20;
constexpr size_t WS_CTL = 0, CTL_ZERO_BYTES = 1 * MiB;
constexpr size_t WS_ROPE = 1 * MiB;
constexpr size_t WS_KMH = 5 * MiB, WS_KML = 5 * MiB + 512 * 1024;
constexpr size_t WS_MEMB = 6 * MiB;
constexpr size_t WS_KVX = 10 * MiB;
constexpr size_t WS_LIST = 18 * MiB;
constexpr size_t WS_ML = 26 * MiB;
constexpr size_t WS_WIN = 34 * MiB, WS_WPOOL = 98 * MiB, WS_WOUT = 100 * MiB, WS_WXQ = 132 * MiB, WS_WXKV = 164 * MiB, WS_WXO = 228 * MiB, WS_WGU = 260 * MiB, WS_WDN = 432 * MiB;
constexpr size_t WS_ACT = 518 * MiB;
constexpr size_t WS_HP = WS_ACT, WS_Q = WS_ACT + 64 * MiB, WS_K = WS_ACT + 128 * MiB, WS_V = WS_ACT + 192 * MiB;
constexpr size_t WS_XB = WS_ACT + 256 * MiB;
constexpr size_t WS_PARTO = WS_ACT + 256 * MiB;
constexpr size_t WS_CAT = WS_ACT + 512 * MiB;
constexpr size_t WS_TB = WS_ACT;
constexpr size_t WS_HB = WS_ACT + 128 * MiB;
constexpr size_t WS_PB = WS_ACT + 256 * MiB;
constexpr size_t WS_G = WS_ACT + 256 * MiB;
constexpr size_t WS_SLAB = WS_ACT + 384 * MiB;
constexpr size_t WS_WQK = WS_ACT + 640 * MiB, WS_WVOT = WS_ACT + 656 * MiB;
constexpr size_t WS_WOUT2 = WS_ACT + 672 * MiB;
constexpr size_t WS_SLOT = WS_ML;
constexpr size_t WS_STATS = WS_LIST;
constexpr size_t WS_WTMP = WS_ACT;
constexpr size_t WS_H8 = WS_ACT + 128 * MiB;
constexpr size_t WS_W8IN = WS_WGU + 96 * MiB;
constexpr size_t WS_X8 = WS_ACT + 448 * MiB;
constexpr size_t WS_END = WS_ACT + 704 * MiB;
static_assert(WS_WDN + (size_t)DM * FF * 2 <= WS_ACT && WS_G + (size_t)M * FF * 2 <= WS_END && WS_WGU + (size_t)2 * FF * DM * 2 <= WS_WDN, "d_ws map");
constexpr int LIST_STRIDE = 256 * 496;
__host__ __device__ constexpr int list_off(int j) { return 256 * (31 * j - (j * (j - 1)) / 2); }
constexpr int CW_TMO = 0, CW_CODE = 1;
constexpr int CW_BAR = 4096;
constexpr int CW_GCNT = 8192;
constexpr int CW_CHK = 16384;
constexpr int CW_K1 = 32768, CW_K2 = 32768 + 2048;
constexpr int CW_DYN = 131072;
constexpr int CW_C1G = 65536, CW_C2G = 65536 + 22016;
constexpr int CW_SB = 65536;
constexpr int CW_SBIN = 212992, CW_SX = 217088;
constexpr int CW_SA = 196608;

#if !defined(GU_FILLER)
#define GU_IN_P0 1
#endif

#ifndef MIX8
#define MIX8 1
#endif

constexpr int RING_OFF = 0, RING_BYTES = 131072;
constexpr int LDSCTL_OFF = RING_BYTES, MISC_OFF = LDSCTL_OFF + 320;
constexpr int LDS_BYTES = 147456;

#define GAS __attribute__((address_space(1)))
#define LAS __attribute__((address_space(3)))
typedef unsigned short bf16;
typedef unsigned v4u __attribute__((ext_vector_type(4)));
typedef unsigned v2u __attribute__((ext_vector_type(2)));
typedef float f32x4 __attribute__((ext_vector_type(4)));
typedef short bf16x8 __attribute__((ext_vector_type(8)));
typedef float f32x16 __attribute__((ext_vector_type(16)));
typedef GAS unsigned gu32;
#define RLX_AGENT __ATOMIC_RELAXED, __HIP_MEMORY_SCOPE_AGENT
#define LDS_WAIT() asm volatile("s_waitcnt lgkmcnt(0)" ::: "memory")
#define VM_WAIT() asm volatile("s_waitcnt vmcnt(0)" ::: "memory")
__device__ __forceinline__ unsigned f2bf(float f) { unsigned u = __builtin_bit_cast(unsigned, f); return (u + 0x7fffu + ((u >> 16) & 1u)) >> 16; }
__device__ __forceinline__ unsigned pk2(float lo, float hi) { return f2bf(lo) | (f2bf(hi) << 16); }
__device__ __forceinline__ float bf_lo(unsigned w) { return __builtin_bit_cast(float, w << 16); }
__device__ __forceinline__ float bf_hi(unsigned w) { return __builtin_bit_cast(float, w & 0xffff0000u); }
__device__ __forceinline__ float bf2f(bf16 b) { return __builtin_bit_cast(float, ((unsigned)b) << 16); }
#define XB_TMO      128
#define XB_XCNT(j)  (256  + 64 * (j))
#define XB_XSUB(j)  (1280 + 64 * (j))
#define XB_XGEN(j)  (2304 + 64 * (j))
#define XB_TOP      3328
#define XB_TOPGEN   3392
#define XCD_BAR_WORDS 3456
#define XB_SPIN_CAP (1u << 18)

__device__ __forceinline__ unsigned xb_ld(unsigned* p)              { return __hip_atomic_load(p, __ATOMIC_RELAXED, __HIP_MEMORY_SCOPE_AGENT); }
__device__ __forceinline__ unsigned xb_add(unsigned* p, unsigned v) { return __hip_atomic_fetch_add(p, v, __ATOMIC_RELAXED, __HIP_MEMORY_SCOPE_AGENT); }
__device__ __forceinline__ unsigned xb_xcc_id() { return (unsigned)__builtin_amdgcn_s_getreg((3 << 11) | 20) & 0xFu; }
#define XB_SPIN(cond, bar) do { unsigned _sp = 0; while (cond) { __builtin_amdgcn_s_sleep(1); \
    if ((++_sp & 255u) == 0u) { if (xb_ld(&(bar)[XB_TMO])) break; if (_sp > XB_SPIN_CAP) { atomicAdd(&(bar)[XB_TMO], 1u); break; } } } } while (0)

struct XcdBarrier {
    unsigned* bar; unsigned x;
    volatile LAS unsigned* st;
};

__device__ __forceinline__ XcdBarrier xcd_barrier_post(unsigned* bar, volatile LAS unsigned* st) {
    XcdBarrier b; b.bar = bar; b.x = xb_xcc_id(); b.st = st;
    if (threadIdx.x == 0) (void)xb_add(&bar[XB_XCNT(b.x)], 1u);
    return b;
}
__device__ __forceinline__ void xcd_barrier_complete(unsigned* bar, unsigned x, unsigned& nloc, unsigned& nx) {
    const unsigned G = gridDim.x * gridDim.y * gridDim.z;
    unsigned sum, cnt, mine, sp = 0u;
    for (;;) {
        sum = 0u; cnt = 0u; mine = 0u;
#pragma unroll
        for (unsigned j = 0; j < 16; ++j) { const unsigned c = xb_ld(&bar[XB_XCNT(j)]); sum += c; cnt += (c > 0u) ? 1u : 0u; mine = (j == x) ? c : mine; }
        if (sum == G) break;
        __builtin_amdgcn_s_sleep(1);
        if ((++sp & 255u) == 0u) { if (xb_ld(&bar[XB_TMO])) break; if (sp > XB_SPIN_CAP) { atomicAdd(&bar[XB_TMO], 1u); break; } }
    }
    nloc = mine > 0u ? mine : 1u; nx = cnt > 0u ? cnt : 1u;
}

__device__ __forceinline__ void xcd_barrier(const XcdBarrier& b) {
    asm volatile("s_waitcnt vmcnt(0)" ::: "memory");
    __syncthreads();
    if (threadIdx.x == 0) {
        unsigned* bar = b.bar;
        __builtin_amdgcn_s_waitcnt(0);
        unsigned nloc = b.st[0], nx = b.st[1];
        if (nloc == 0u) { xcd_barrier_complete(bar, b.x, nloc, nx); b.st[0] = nloc; b.st[1] = nx; }
        const unsigned old = xb_add(&bar[XB_XSUB(b.x)], 1u);
        const unsigned gen = old / nloc;
        if (old + 1u == (gen + 1u) * nloc) {
            __builtin_amdgcn_fence(__ATOMIC_RELEASE, "agent");
            asm volatile("s_waitcnt vmcnt(0)" ::: "memory");
            const unsigned og = xb_add(&bar[XB_TOP], 1u);
            const unsigned tg = og / nx;
            if (og + 1u == (tg + 1u) * nx) xb_add(&bar[XB_TOPGEN], 1u);
            else XB_SPIN(xb_ld(&bar[XB_TOPGEN]) == tg, bar);
            __builtin_amdgcn_fence(__ATOMIC_ACQUIRE, "agent");
            xb_add(&bar[XB_XGEN(b.x)], 1u);
            asm volatile("s_waitcnt vmcnt(0)" ::: "memory");
        } else {
            XB_SPIN(xb_ld(&bar[XB_XGEN(b.x)]) == gen, bar);
            __builtin_amdgcn_fence(__ATOMIC_ACQUIRE, "agent");
            asm volatile("s_waitcnt vmcnt(0)" ::: "memory");
        }
    }
    __syncthreads();
}

struct Frame {
    LAS unsigned char* lds;
    volatile LAS unsigned* MISC;
    gu32* ctl;
    int tid, lane, wave;
    int G;
    unsigned char* ws;
};
__device__ __forceinline__ float wave_sum(float v) {
#pragma unroll
    for (int o = 1; o < 64; o <<= 1) v += __shfl_xor(v, o);
    return v;
}

#ifndef QW_NR
#define QW_NR 2
#endif
#ifndef Q8_NR
#define Q8_NR 2
#endif
__device__ __forceinline__ float wave_maxf(float v) {
#pragma unroll
    for (int o = 1; o < 64; o <<= 1) v = fmaxf(v, __shfl_xor(v, o));
    return v;
}
__device__ __forceinline__ unsigned pk4_i8(float a, float b, float c, float d) {
    const unsigned ia = __builtin_bit_cast(unsigned, a + 12582912.0f), ib = __builtin_bit_cast(unsigned, b + 12582912.0f), ic = __builtin_bit_cast(unsigned, c + 12582912.0f), id = __builtin_bit_cast(unsigned, d + 12582912.0f);
    return (ia & 0xffu) | ((ib & 0xffu) << 8) | ((ic & 0xffu) << 16) | (id << 24);
}

template <class RowMap>
__device__ __forceinline__ void p0_transpose_item(const float* W, int K, int N, bf16* WT, LAS float* scr, int item, int lane, const RowMap& rm, const float* colscale,
                                                  const float* kgain = nullptr, const float* kbias = nullptr, float* c1 = nullptr, float* c2 = nullptr) {
    const int nblk = N / 32, kb = item / nblk, nb = item % nblk, k0 = 64 * kb, n0 = 32 * nb;
    float ld[32];
    const float* src = W + (size_t)(k0 + (lane >> 5)) * N + n0 + (lane & 31);
#pragma unroll
    for (int i = 0; i < 32; ++i) ld[i] = *(const GAS float*)(src + (size_t)(2 * i) * N);
#pragma unroll
    for (int i = 0; i < 32; ++i) scr[(2 * i + (lane >> 5)) * 33 + (lane & 31)] = ld[i];
    LDS_WAIT(); asm volatile("" ::: "memory");
    const int c = lane & 7;
    f32x4 g0 = (f32x4){1.f, 1.f, 1.f, 1.f}, g1 = g0, b0 = (f32x4){0.f, 0.f, 0.f, 0.f}, b1 = b0;
    if (kgain) { g0 = *(const GAS f32x4*)(kgain + k0 + 8 * c); g1 = *(const GAS f32x4*)(kgain + k0 + 8 * c + 4); b0 = *(const GAS f32x4*)(kbias + k0 + 8 * c); b1 = *(const GAS f32x4*)(kbias + k0 + 8 * c + 4); }
#pragma unroll
    for (int j = 0; j < 4; ++j) { const int n = (lane >> 3) + 8 * j; const LAS float* s = scr + (8 * c) * 33 + n; const float sc = colscale ? colscale[n0 + n] : 1.0f;
        const float w0 = s[0 * 33] * sc, w1 = s[1 * 33] * sc, w2 = s[2 * 33] * sc, w3 = s[3 * 33] * sc, w4 = s[4 * 33] * sc, w5 = s[5 * 33] * sc, w6 = s[6 * 33] * sc, w7 = s[7 * 33] * sc;
        v4u o; o.x = pk2(w0 * g0.x, w1 * g0.y); o.y = pk2(w2 * g0.z, w3 * g0.w); o.z = pk2(w4 * g1.x, w5 * g1.y); o.w = pk2(w6 * g1.z, w7 * g1.w);
        const int row = rm(n0 + n);
        *(GAS v4u*)(WT + (size_t)row * K + k0 + 8 * c) = o;
        if (c1) {
            float t1 = ((bf_lo(o.x) + bf_hi(o.x)) + (bf_lo(o.y) + bf_hi(o.y))) + ((bf_lo(o.z) + bf_hi(o.z)) + (bf_lo(o.w) + bf_hi(o.w)));
            float t2 = ((w0 * b0.x + w1 * b0.y) + (w2 * b0.z + w3 * b0.w)) + ((w4 * b1.x + w5 * b1.y) + (w6 * b1.z + w7 * b1.w));
            t1 += __shfl_xor(t1, 1); t2 += __shfl_xor(t2, 1); t1 += __shfl_xor(t1, 2); t2 += __shfl_xor(t2, 2); t1 += __shfl_xor(t1, 4); t2 += __shfl_xor(t2, 4);
            if (c == 0) { __hip_atomic_fetch_add(c1 + row, t1, RLX_AGENT); __hip_atomic_fetch_add(c2 + row, t2, RLX_AGENT); } } }
    LDS_WAIT(); asm volatile("" ::: "memory");
}
struct RmIdent { int off; __device__ __forceinline__ int operator()(int n) const { return off + n; } };
struct RmMixIn { __device__ __forceinline__ int operator()(int n) const { if (n < 2048 || n >= 6144) return n; const int d = n & 127; return (n & ~127) + 2 * (d & 63) + (d >> 6); } };
struct RmGateUp { int up; __device__ __forceinline__ int operator()(int n) const { return (n >> 7) * 256 + up * 128 + (n & 127); } };

__device__ __forceinline__ void sincos_d(double a, double& s, double& c) {
    const double n = __builtin_rint(a * 0.63661977236758134308);
    double r = __builtin_fma(-n, 1.5707963267948966, a); r = __builtin_fma(-n, 6.123233995736766e-17, r);
    const double r2 = r * r;
    double ps = -7.6471637318198164759e-13; ps = ps * r2 + 1.6059043836821614599e-10; ps = ps * r2 - 2.5052108385441718775e-08; ps = ps * r2 + 2.7557319223985890653e-06;
    ps = ps * r2 - 1.9841269841269841270e-04; ps = ps * r2 + 8.3333333333333333333e-03; ps = ps * r2 - 1.6666666666666666667e-01; ps = r + r * r2 * ps;
    double pc = 4.7794773323873852974e-14; pc = pc * r2 - 1.1470745597729724714e-11; pc = pc * r2 + 2.0876756987868098979e-09; pc = pc * r2 - 2.7557319223985890653e-07;
    pc = pc * r2 + 2.4801587301587301587e-05; pc = pc * r2 - 1.3888888888888888889e-03; pc = pc * r2 + 4.1666666666666666667e-02; pc = pc * r2 - 0.5; pc = 1.0 + r2 * pc;
    const int q = ((int)n) & 3;
    s = (q == 0) ? ps : (q == 1) ? pc : (q == 2) ? -ps : -pc;
    c = (q == 0) ? pc : (q == 1) ? -ps : (q == 2) ? -pc : ps;
}
__device__ __forceinline__ float rope_inv(int i) {
    const double y = -(double)i * (13.287712379549449 / 64.0); const double fl = __builtin_floor(y); const double z = (y - fl) * 0.69314718055994530942;
    double e = 1.0, term = 1.0;
#pragma unroll
    for (int k = 1; k <= 20; ++k) { term = term * z / (double)k; e += term; }
    return (float)__builtin_ldexp(e, (int)fl);
}

__device__ __forceinline__ void p0_prologue(Frame& F, const float* const* in) {
    LAS float* scr = (LAS float*)(F.lds + RING_OFF + F.wave * 16384);
    const int gw = blockIdx.x * NWAVES + F.wave, NGW = F.G * NWAVES;
    const float* w_mix_in = in[2]; const float* w_pool = in[3]; const float* pool_scale = in[4]; const float* w_mix_out = in[5];
    const float* w_xq = in[8]; const float* w_xkv = in[9]; const float* w_xo = in[10]; const float* w_gate = in[13]; const float* w_up = in[14]; const float* w_down = in[15];
    bf16* WIN = (bf16*)(F.ws + WS_WIN); bf16* WPOOL = (bf16*)(F.ws + WS_WPOOL); bf16* WOUT = (bf16*)(F.ws + WS_WOUT); bf16* WXQ = (bf16*)(F.ws + WS_WXQ);
    bf16* WXKV = (bf16*)(F.ws + WS_WXKV); bf16* WXO = (bf16*)(F.ws + WS_WXO); bf16* WGU = (bf16*)(F.ws + WS_WGU); bf16* WDN = (bf16*)(F.ws + WS_WDN);
    constexpr int I_IN = (DM / 64) * (MIXIN / 32), I_POOL = (512 / 64) * (512 / 32), I_SQ = (DM / 64) * (DM / 32), I_KV = (DM / 64) * (2 * DM / 32), I_GU = (DM / 64) * (FF / 32), I_DN = (FF / 64) * (DM / 32);
#if defined(GU_IN_P0)
    constexpr int NITEMS = I_IN + 2 * I_SQ + I_KV + 2 * I_GU;
#else
    constexpr int NITEMS = I_IN + 2 * I_SQ + I_KV;
#endif
    const size_t gt = (size_t)blockIdx.x * (NWAVES * 64) + F.tid, NT = (size_t)F.G * NWAVES * 64;
#if MIX8 == 0
    { const float* x = in[0]; bf16* XB = (bf16*)(F.ws + WS_XB);
      for (size_t i = gt; i < (size_t)M * DM / 8; i += NT) { const f32x4 a = *(const GAS f32x4*)(x + i * 8), b = *(const GAS f32x4*)(x + i * 8 + 4);
          v4u o; o.x = pk2(a.x, a.y); o.y = pk2(a.z, a.w); o.z = pk2(b.x, b.y); o.w = pk2(b.z, b.w); *(GAS v4u*)(XB + i * 8) = o; } }
#else
    { const float* x = in[0]; bf16* XB = (bf16*)(F.ws + WS_XB); unsigned char* X8 = F.ws + WS_X8; float* sx = (float*)(F.ctl + CW_SX);
      for (int m = gw; m < M; m += NGW) { f32x4 a[8], b[8]; float am = 0.f;
#pragma unroll
          for (int j = 0; j < 8; ++j) { const size_t c = (size_t)m * DM + (64 * j + F.lane) * 8; a[j] = *(const GAS f32x4*)(x + c); b[j] = *(const GAS f32x4*)(x + c + 4); }
#pragma unroll
          for (int j = 0; j < 8; ++j) { const size_t c = (size_t)m * DM + (64 * j + F.lane) * 8;
              v4u o; o.x = pk2(a[j].x, a[j].y); o.y = pk2(a[j].z, a[j].w); o.z = pk2(b[j].x, b[j].y); o.w = pk2(b[j].z, b[j].w); *(GAS v4u*)(XB + c) = o;
              am = fmaxf(am, fmaxf(fmaxf(fmaxf(fabsf(a[j].x), fabsf(a[j].y)), fmaxf(fabsf(a[j].z), fabsf(a[j].w))), fmaxf(fmaxf(fabsf(b[j].x), fabsf(b[j].y)), fmaxf(fabsf(b[j].z), fabsf(b[j].w))))); }
          am = wave_maxf(am); const float inv = am > 0.f ? 127.0f / am : 0.f; if (F.lane == 0) sx[m] = am * (1.0f / 127.0f);
#pragma unroll
          for (int j = 0; j < 8; ++j) { const size_t c = (size_t)m * DM + (64 * j + F.lane) * 8;
              v2u o; o.x = pk4_i8(a[j].x * inv, a[j].y * inv, a[j].z * inv, a[j].w * inv); o.y = pk4_i8(b[j].x * inv, b[j].y * inv, b[j].z * inv, b[j].w * inv); *(GAS v2u*)(X8 + c) = o; } } }
#endif
    { const float* x = w_xq; bf16* XB = WXQ;
      for (size_t i = gt; i < (size_t)DM * DM / 8; i += NT) { const f32x4 a = *(const GAS f32x4*)(x + i * 8), b = *(const GAS f32x4*)(x + i * 8 + 4);
          v4u o; o.x = pk2(a.x, a.y); o.y = pk2(a.z, a.w); o.z = pk2(b.x, b.y); o.w = pk2(b.z, b.w); *(GAS v4u*)(XB + i * 8) = o; } }
    { bf16* WPR = WPOOL;
      for (size_t i = gt; i < (size_t)4 * 512 * 512 / 8; i += NT) { const size_t e = i * 8; const int d = (int)(e & 511), g = (int)(e >> 18);
          const f32x4 a = *(const GAS f32x4*)(w_pool + e), b = *(const GAS f32x4*)(w_pool + e + 4), s0 = *(const GAS f32x4*)(pool_scale + g * 512 + d), s1 = *(const GAS f32x4*)(pool_scale + g * 512 + d + 4);
          v4u o; o.x = pk2(a.x * s0.x, a.y * s0.y); o.y = pk2(a.z * s0.z, a.w * s0.w); o.z = pk2(b.x * s1.x, b.y * s1.y); o.w = pk2(b.z * s1.z, b.w * s1.w); *(GAS v4u*)(WPR + e) = o; } }
    { const float* x = in[1]; bf16* XB = (bf16*)(F.ws + WS_MEMB);
      for (size_t i = gt; i < (size_t)BATCH * MEMLEN * DM / 8; i += NT) { const f32x4 a = *(const GAS f32x4*)(x + i * 8), b = *(const GAS f32x4*)(x + i * 8 + 4);
          v4u o; o.x = pk2(a.x, a.y); o.y = pk2(a.z, a.w); o.z = pk2(b.x, b.y); o.w = pk2(b.z, b.w); *(GAS v4u*)(XB + i * 8) = o; } }
    { float2* tab = (float2*)(F.ws + WS_ROPE);
      for (size_t i = gt; i < (size_t)SEQ * 64; i += NT) { const int pos = (int)(i >> 6), fi = (int)(i & 63); const float ang = (float)pos * rope_inv(fi);
          double s, c; sincos_d((double)ang, s, c); tab[i] = make_float2((float)c, (float)s); } }
    for (int it = gw; it < NITEMS; it += NGW) {
        int r = it;
        if (r < I_IN) { p0_transpose_item(w_mix_in, DM, MIXIN, WIN, scr, r, F.lane, RmMixIn{}, nullptr); continue; } r -= I_IN;
        if (r < I_SQ) { const int kb = r / (DM / 32);
            if (kb < 32) p0_transpose_item(w_mix_out, 2048, DM, WOUT, scr, r, F.lane, RmIdent{0}, nullptr);
            else p0_transpose_item(w_mix_out, DM, DM, (bf16*)(F.ws + WS_WOUT2), scr, r, F.lane, RmIdent{0}, nullptr); continue; } r -= I_SQ;
        if (r < I_KV) { p0_transpose_item(w_xkv, DM, 2 * DM, WXKV, scr, r, F.lane, RmIdent{0}, nullptr); continue; } r -= I_KV;
        if (r < I_SQ) { p0_transpose_item(w_xo, DM, DM, WXO, scr, r, F.lane, RmIdent{0}, nullptr); continue; } r -= I_SQ;
        (void)w_gate; (void)w_up; (void)WGU;
#if defined(GU_IN_P0)
#if defined(GU_BF16)
        float* c1g = (float*)(F.ctl + CW_C1G); float* c2g = (float*)(F.ctl + CW_C2G);
        if (r < I_GU) { p0_transpose_item(w_gate, DM, FF, WGU, scr, r, F.lane, RmGateUp{0}, nullptr, in[11], in[12], c1g, c2g); continue; } r -= I_GU;
        p0_transpose_item(w_up, DM, FF, WGU, scr, r, F.lane, RmGateUp{1}, nullptr, in[11], in[12], c1g, c2g);
#else
        bf16* WTMP = (bf16*)(F.ws + WS_WTMP);
        if (r < I_GU) { p0_transpose_item(w_gate, DM, FF, WTMP, scr, r, F.lane, RmGateUp{0}, nullptr); continue; } r -= I_GU;
        p0_transpose_item(w_up, DM, FF, WTMP, scr, r, F.lane, RmGateUp{1}, nullptr);
#endif
#endif
    }
}

__device__ __forceinline__ void convert_wdown(Frame& F, const float* w_down, gu32* ctr) {
    LAS float* scr = (LAS float*)(F.lds + RING_OFF + F.wave * 16384); bf16* WDN = (bf16*)(F.ws + WS_WDN);
    constexpr int I_DN = (FF / 64) * (DM / 32);
    for (;;) { int base = 0; if (F.lane == 0) base = (int)__hip_atomic_fetch_add(ctr, 16u, RLX_AGENT); base = __builtin_amdgcn_readfirstlane(base);
        if (base >= I_DN) break;
        for (int it = base; it < base + 16 && it < I_DN; ++it) p0_transpose_item(w_down, FF, DM, WDN, scr, it, F.lane, RmIdent{0}, nullptr); }
}
__device__ __forceinline__ void convert_wdown_static(Frame& F, const float* w_down, int rk, int nwg) {
    LAS float* scr = (LAS float*)(F.lds + RING_OFF + F.wave * 16384); bf16* WDN = (bf16*)(F.ws + WS_WDN);
    constexpr int I_DN = (FF / 64) * (DM / 32);
    for (int it = rk * NWAVES + F.wave; it < I_DN; it += nwg * NWAVES) p0_transpose_item(w_down, FF, DM, WDN, scr, it, F.lane, RmIdent{0}, nullptr);
}

__device__ __forceinline__ bool gu_chunk(Frame& F, const float* const* in, gu32* q) {
    LAS float* scr = (LAS float*)(F.lds + RING_OFF + F.wave * 16384); bf16* WGU = (bf16*)(F.ws + WS_WGU);
    float* c1g = (float*)(F.ctl + CW_C1G); float* c2g = (float*)(F.ctl + CW_C2G);
    constexpr int I_GU = (DM / 64) * (FF / 32);
    int base = 0; if (F.lane == 0) base = (int)__hip_atomic_fetch_add(q, 4u, RLX_AGENT); base = __builtin_amdgcn_readfirstlane(base);
    if (base >= 2 * I_GU) return false;
    for (int it = base; it < base + 4; ++it) {
        if (it < I_GU) p0_transpose_item(in[13], DM, FF, WGU, scr, it, F.lane, RmGateUp{0}, nullptr, in[11], in[12], c1g, c2g);
        else p0_transpose_item(in[14], DM, FF, WGU, scr, it - I_GU, F.lane, RmGateUp{1}, nullptr, in[11], in[12], c1g, c2g); }
    return true;
}
__device__ __forceinline__ void gu_filler(Frame& F, const float* const* in, int slot) {
#if !defined(GU_IN_P0)
    gu32* q = F.ctl + CW_DYN + 4096 + 64; gu32* done = F.ctl + CW_DYN + 4096 + 128 + 64 * slot;
    __syncthreads();
    if (F.tid == 0) __hip_atomic_fetch_add(done, 1u, RLX_AGENT);
    for (;;) { if ((int)__builtin_amdgcn_readfirstlane((int)__hip_atomic_load(done, RLX_AGENT)) >= F.G) break; if (!gu_chunk(F, in, q)) break; }
#endif
}
__device__ __forceinline__ void gu_drain(Frame& F, const float* const* in) {
#if !defined(GU_IN_P0)
    gu32* q = F.ctl + CW_DYN + 4096 + 64;
    while (gu_chunk(F, in, q)) { }
#endif
}

__device__ __forceinline__ void ln_finalize(Frame& F, const float2* slots, float2* stats) {
    const int gw = blockIdx.x * NWAVES + F.wave, NGW = F.G * NWAVES;
    for (int m = gw; m < M; m += NGW) { const float2 p = slots[(size_t)m * 64 + F.lane];
        const float s = wave_sum(p.x), q = wave_sum(p.y), mean = s * (1.f / DM), var = fmaxf(q * (1.f / DM) - mean * mean, 0.f);
        if (F.lane == 0) stats[m] = make_float2(mean, 1.f / sqrtf(var + LN_EPS)); }
}

template <bool FINAL>
__device__ __forceinline__ void ln_rows(Frame& F, const bf16* T, bf16* XB, float2* stats, float* OUT, const float* g, const float* b) {
#ifndef LN_NR
#define LN_NR 2
#endif
    constexpr int NR = LN_NR;
    const int gw = blockIdx.x * NWAVES + F.wave, NGW = F.G * NWAVES;
    for (int mb = gw; mb < M; mb += NR * NGW) {
        int mr[NR]; v4u r[NR][8];
#pragma unroll
        for (int i = 0; i < NR; ++i) { mr[i] = (mb + i * NGW < M) ? mb + i * NGW : mb;
            const GAS v4u* tr = (const GAS v4u*)(T + (size_t)mr[i] * DM) + F.lane;
#pragma unroll
            for (int j = 0; j < 8; ++j) r[i][j] = tr[64 * j]; }
        float mean[NR], rstd[NR];
#pragma unroll
        for (int i = 0; i < NR; ++i) { float s = 0.f;
#pragma unroll
            for (int j = 0; j < 8; ++j) s += ((bf_lo(r[i][j].x) + bf_hi(r[i][j].x)) + (bf_lo(r[i][j].y) + bf_hi(r[i][j].y))) + ((bf_lo(r[i][j].z) + bf_hi(r[i][j].z)) + (bf_lo(r[i][j].w) + bf_hi(r[i][j].w)));
            mean[i] = wave_sum(s) * (1.f / DM); }
#pragma unroll
        for (int i = 0; i < NR; ++i) { float q = 0.f; const float mu = mean[i];
#pragma unroll
            for (int j = 0; j < 8; ++j) { float d;
                d = bf_lo(r[i][j].x) - mu; q += d * d; d = bf_hi(r[i][j].x) - mu; q += d * d; d = bf_lo(r[i][j].y) - mu; q += d * d; d = bf_hi(r[i][j].y) - mu; q += d * d;
                d = bf_lo(r[i][j].z) - mu; q += d * d; d = bf_hi(r[i][j].z) - mu; q += d * d; d = bf_lo(r[i][j].w) - mu; q += d * d; d = bf_hi(r[i][j].w) - mu; q += d * d; }
            rstd[i] = 1.f / sqrtf(wave_sum(q) * (1.f / DM) + LN_EPS); }
        if (!FINAL && F.lane == 0) {
#pragma unroll
            for (int i = 0; i < NR; ++i) stats[mr[i]] = make_float2(mean[i], rstd[i]); }
#pragma unroll
        for (int j = 0; j < 8; ++j) { const int c = (64 * j + F.lane) * 8;
            const f32x4 g0 = *(const GAS f32x4*)(g + c), g1 = *(const GAS f32x4*)(g + c + 4), b0 = *(const GAS f32x4*)(b + c), b1 = *(const GAS f32x4*)(b + c + 4);
#pragma unroll
            for (int i = 0; i < NR; ++i) { const float mu = mean[i], rs = rstd[i];
                const f32x4 ya = ((f32x4){bf_lo(r[i][j].x), bf_hi(r[i][j].x), bf_lo(r[i][j].y), bf_hi(r[i][j].y)} - mu) * rs * g0 + b0;
                const f32x4 yb = ((f32x4){bf_lo(r[i][j].z), bf_hi(r[i][j].z), bf_lo(r[i][j].w), bf_hi(r[i][j].w)} - mu) * rs * g1 + b1;
                if (FINAL) { *(GAS f32x4*)(OUT + (size_t)mr[i] * DM + c) = ya; *(GAS f32x4*)(OUT + (size_t)mr[i] * DM + c + 4) = yb; }
                else { v4u o; o.x = pk2(ya.x, ya.y); o.y = pk2(ya.z, ya.w); o.z = pk2(yb.x, yb.y); o.w = pk2(yb.z, yb.w); *(GAS v4u*)(XB + (size_t)mr[i] * DM + c) = o; } } }
    }
}

__device__ __forceinline__ void quant_rows(Frame& F, const bf16* T, unsigned char* Q, float* sb, const int NROW) {
    constexpr int NR = QW_NR;
    const int gw = blockIdx.x * NWAVES + F.wave, NGW = F.G * NWAVES;
    for (int mb = gw; mb < NROW; mb += NR * NGW) {
        int mr[NR]; v4u r[NR][8];
#pragma unroll
        for (int i = 0; i < NR; ++i) { mr[i] = (mb + i * NGW < NROW) ? mb + i * NGW : mb;
            const GAS v4u* tr = (const GAS v4u*)(T + (size_t)mr[i] * DM) + F.lane;
#pragma unroll
            for (int j = 0; j < 8; ++j) r[i][j] = tr[64 * j]; }
#pragma unroll
        for (int i = 0; i < NR; ++i) { float a = 0.f;
#pragma unroll
            for (int j = 0; j < 8; ++j) { const v4u w = r[i][j];
                a = fmaxf(a, fmaxf(fmaxf(fmaxf(fabsf(bf_lo(w.x)), fabsf(bf_hi(w.x))), fmaxf(fabsf(bf_lo(w.y)), fabsf(bf_hi(w.y)))), fmaxf(fmaxf(fabsf(bf_lo(w.z)), fabsf(bf_hi(w.z))), fmaxf(fabsf(bf_lo(w.w)), fabsf(bf_hi(w.w)))))); }
            a = wave_maxf(a); const float inv = a > 0.f ? 127.0f / a : 0.f;
            if (F.lane == 0) sb[mr[i]] = a * (1.0f / 127.0f);
            GAS v2u* qr = (GAS v2u*)(Q + (size_t)mr[i] * DM) + F.lane;
#pragma unroll
            for (int j = 0; j < 8; ++j) { const v4u w = r[i][j]; v2u o;
                o.x = pk4_i8(bf_lo(w.x) * inv, bf_hi(w.x) * inv, bf_lo(w.y) * inv, bf_hi(w.y) * inv); o.y = pk4_i8(bf_lo(w.z) * inv, bf_hi(w.z) * inv, bf_lo(w.w) * inv, bf_hi(w.w) * inv);
                qr[64 * j] = o; } }
    }
}
__device__ __forceinline__ void quant_wgu(Frame& F) {
    quant_rows(F, (const bf16*)(F.ws + WS_WTMP), F.ws + WS_WGU, (float*)(F.ctl + CW_SB), 2 * FF);
#if MIX8 == 1
    quant_rows(F, (const bf16*)(F.ws + WS_WIN) + (size_t)6144 * DM, F.ws + WS_W8IN, (float*)(F.ctl + CW_SBIN), 2048);
#elif MIX8 == 2
    quant_rows(F, (const bf16*)(F.ws + WS_WIN), F.ws + WS_W8IN, (float*)(F.ctl + CW_SBIN), 2048);
    quant_rows(F, (const bf16*)(F.ws + WS_WIN) + (size_t)6144 * DM, F.ws + WS_W8IN + (size_t)2048 * DM, (float*)(F.ctl + CW_SBIN) + 2048, 2048);
#endif
}

__device__ __forceinline__ void ln_rows_q8(Frame& F, const bf16* T, unsigned char* H8, float* sa, float2* stats, const float* g, const float* b) {
    constexpr int NR = Q8_NR;
    const int gw = blockIdx.x * NWAVES + F.wave, NGW = F.G * NWAVES;
    LAS float* gl = (LAS float*)(F.lds + RING_OFF); LAS float* bl = gl + DM;
    for (int u = F.tid; u < DM / 4; u += NWAVES * 64) { *(LAS f32x4*)(gl + 4 * u) = *(const GAS f32x4*)(g + 4 * u); *(LAS f32x4*)(bl + 4 * u) = *(const GAS f32x4*)(b + 4 * u); }
    __syncthreads();
    for (int mb = gw; mb < M; mb += NR * NGW) {
        int mr[NR]; v4u r[NR][8];
#pragma unroll
        for (int i = 0; i < NR; ++i) { mr[i] = (mb + i * NGW < M) ? mb + i * NGW : mb;
            const GAS v4u* tr = (const GAS v4u*)(T + (size_t)mr[i] * DM) + F.lane;
#pragma unroll
            for (int j = 0; j < 8; ++j) r[i][j] = tr[64 * j]; }
        float mean[NR], rstd[NR];
#pragma unroll
        for (int i = 0; i < NR; ++i) { float s = 0.f;
#pragma unroll
            for (int j = 0; j < 8; ++j) s += ((bf_lo(r[i][j].x) + bf_hi(r[i][j].x)) + (bf_lo(r[i][j].y) + bf_hi(r[i][j].y))) + ((bf_lo(r[i][j].z) + bf_hi(r[i][j].z)) + (bf_lo(r[i][j].w) + bf_hi(r[i][j].w)));
            mean[i] = wave_sum(s) * (1.f / DM); }
#pragma unroll
        for (int i = 0; i < NR; ++i) { float q = 0.f; const float mu = mean[i];
#pragma unroll
            for (int j = 0; j < 8; ++j) { float d;
                d = bf_lo(r[i][j].x) - mu; q += d * d; d = bf_hi(r[i][j].x) - mu; q += d * d; d = bf_lo(r[i][j].y) - mu; q += d * d; d = bf_hi(r[i][j].y) - mu; q += d * d;
                d = bf_lo(r[i][j].z) - mu; q += d * d; d = bf_hi(r[i][j].z) - mu; q += d * d; d = bf_lo(r[i][j].w) - mu; q += d * d; d = bf_hi(r[i][j].w) - mu; q += d * d; }
            rstd[i] = 1.f / sqrtf(wave_sum(q) * (1.f / DM) + LN_EPS); }
        if (F.lane == 0) {
#pragma unroll
            for (int i = 0; i < NR; ++i) stats[mr[i]] = make_float2(mean[i], rstd[i]); }
#pragma unroll
        for (int i = 0; i < NR; ++i) { const float mu = mean[i], rs = rstd[i]; float am = 0.f;
#pragma unroll
            for (int j = 0; j < 8; ++j) { const int c = (64 * j + F.lane) * 8;
                const f32x4 g0 = *(const LAS f32x4*)(gl + c), g1 = *(const LAS f32x4*)(gl + c + 4), b0 = *(const LAS f32x4*)(bl + c), b1 = *(const LAS f32x4*)(bl + c + 4);
                const f32x4 ya = ((f32x4){bf_lo(r[i][j].x), bf_hi(r[i][j].x), bf_lo(r[i][j].y), bf_hi(r[i][j].y)} - mu) * rs * g0 + b0;
                const f32x4 yb = ((f32x4){bf_lo(r[i][j].z), bf_hi(r[i][j].z), bf_lo(r[i][j].w), bf_hi(r[i][j].w)} - mu) * rs * g1 + b1;
                am = fmaxf(am, fmaxf(fmaxf(fmaxf(fabsf(ya.x), fabsf(ya.y)), fmaxf(fabsf(ya.z), fabsf(ya.w))), fmaxf(fmaxf(fabsf(yb.x), fabsf(yb.y)), fmaxf(fabsf(yb.z), fabsf(yb.w))))); }
            am = wave_maxf(am); const float iv = am > 0.f ? 127.0f / am : 0.f; if (F.lane == 0) sa[mr[i]] = am * (1.0f / 127.0f);
            asm volatile("" ::: "memory");
#pragma unroll
            for (int j = 0; j < 8; ++j) { const int c = (64 * j + F.lane) * 8;
                const f32x4 g0 = *(const LAS f32x4*)(gl + c), g1 = *(const LAS f32x4*)(gl + c + 4), b0 = *(const LAS f32x4*)(bl + c), b1 = *(const LAS f32x4*)(bl + c + 4);
                const f32x4 ya = (((f32x4){bf_lo(r[i][j].x), bf_hi(r[i][j].x), bf_lo(r[i][j].y), bf_hi(r[i][j].y)} - mu) * rs * g0 + b0) * iv;
                const f32x4 yb = (((f32x4){bf_lo(r[i][j].z), bf_hi(r[i][j].z), bf_lo(r[i][j].w), bf_hi(r[i][j].w)} - mu) * rs * g1 + b1) * iv;
                v2u o; o.x = pk4_i8(ya.x, ya.y, ya.z, ya.w); o.y = pk4_i8(yb.x, yb.y, yb.z, yb.w);
                *(GAS v2u*)(H8 + (size_t)mr[i] * DM + c) = o; }
            asm volatile("" ::: "memory"); }
    }
    __syncthreads();
}

__device__ __forceinline__ void up8(const v4u& r, float (&f)[8]) { f[0] = bf_lo(r.x); f[1] = bf_hi(r.x); f[2] = bf_lo(r.y); f[3] = bf_hi(r.y); f[4] = bf_lo(r.z); f[5] = bf_hi(r.z); f[6] = bf_lo(r.w); f[7] = bf_hi(r.w); }
template <int W>
__device__ __forceinline__ void pool_run(const bf16* HP, bf16* PMo, int t0, int c) {
    const int tp0 = t0 & (SEQ - 1);
    v4u raw[16 + W - 1];
#pragma unroll
    for (int j = 0; j < 16 + W - 1; ++j) { const int dt = j - (W - 1); raw[j] = (v4u){0u, 0u, 0u, 0u}; if (tp0 + dt >= 0) raw[j] = *(const GAS v4u*)(HP + (size_t)(t0 + dt) * PW + c); }
    float S[8], u[8];
#pragma unroll
    for (int e = 0; e < 8; ++e) S[e] = 0.f;
#pragma unroll
    for (int j = 0; j < W - 1; ++j) { up8(raw[j], u);
#pragma unroll
        for (int e = 0; e < 8; ++e) S[e] += u[e]; }
#pragma unroll
    for (int i = 0; i < 16; ++i) {
        up8(raw[W - 1 + i], u);
#pragma unroll
        for (int e = 0; e < 8; ++e) S[e] += u[e];
        const int tp = tp0 + i; const float inv = (tp + 1 < W) ? 1.0f / (float)(tp + 1) : 1.0f / (float)W;
        v4u o; o.x = pk2(S[0] * inv - u[0], S[1] * inv - u[1]); o.y = pk2(S[2] * inv - u[2], S[3] * inv - u[3]);
        o.z = pk2(S[4] * inv - u[4], S[5] * inv - u[5]); o.w = pk2(S[6] * inv - u[6], S[7] * inv - u[7]);
        *(GAS v4u*)(PMo + (size_t)(t0 + i) * DM + c) = o;
        float d[8]; up8(raw[i], d);
#pragma unroll
        for (int e = 0; e < 8; ++e) S[e] -= d[e];
    }
}
__device__ __forceinline__ void pool_ew(Frame& F) {
    const bf16* HP = (const bf16*)(F.ws + WS_HP); bf16* PMo = (bf16*)(F.ws + WS_CAT);
    const size_t gt = (size_t)blockIdx.x * (NWAVES * 64) + F.tid, NT = (size_t)F.G * NWAVES * 64;
    for (size_t idx = gt; idx < (size_t)(M / 16) * 256; idx += NT) {
        const int t0 = (int)(idx >> 8) * 16, c = (int)(idx & 255) * 8, grp = __builtin_amdgcn_readfirstlane(c >> 9);
        if (grp == 0) pool_run<2>(HP, PMo, t0, c); else if (grp == 1) pool_run<4>(HP, PMo, t0, c); else if (grp == 2) pool_run<8>(HP, PMo, t0, c); else pool_run<16>(HP, PMo, t0, c);
    }
}
__device__ __forceinline__ void kv_reduce(Frame& F) {
    const float* SK = (const float*)(F.ws + WS_SLAB); bf16* KVX = (bf16*)(F.ws + WS_KVX);
    const size_t gt = (size_t)blockIdx.x * (NWAVES * 64) + F.tid, NT = (size_t)F.G * NWAVES * 64, NE = (size_t)512 * 8192;
    for (size_t i = gt; i < NE / 4; i += NT) { const float* sb = SK + i * 4;
        const f32x4 a = *(const GAS f32x4*)sb + *(const GAS f32x4*)(sb + NE) + *(const GAS f32x4*)(sb + 2 * NE) + *(const GAS f32x4*)(sb + 3 * NE);
        v2u o; o.x = pk2(a.x, a.y); o.y = pk2(a.z, a.w); *(GAS v2u*)(KVX + i * 4) = o; }
}

__device__ __forceinline__ void kmean_phase(Frame& F) {
    const bf16* Kb = (const bf16*)(F.ws + WS_K); bf16* KMH = (bf16*)(F.ws + WS_KMH); bf16* KML = (bf16*)(F.ws + WS_KML);
    LAS float* part = (LAS float*)(F.lds + RING_OFF);
    for (int item = blockIdx.x; item < 64 * 4; item += F.G) {
        const int bn = item >> 2, chunk = item & 3;
        float acc[8];
#pragma unroll
        for (int e = 0; e < 8; ++e) acc[e] = 0.f;
        const bf16* base = Kb + (size_t)(bn * 256 + F.wave * 32) * AW + chunk * 512 + F.lane * 8;
#pragma unroll
        for (int r = 0; r < 32; ++r) { const v4u q = *(const GAS v4u*)(base + (size_t)r * AW);
            acc[0] += bf_lo(q.x); acc[1] += bf_hi(q.x); acc[2] += bf_lo(q.y); acc[3] += bf_hi(q.y); acc[4] += bf_lo(q.z); acc[5] += bf_hi(q.z); acc[6] += bf_lo(q.w); acc[7] += bf_hi(q.w); }
#pragma unroll
        for (int e = 0; e < 8; ++e) part[F.wave * 512 + F.lane * 8 + e] = acc[e];
        __syncthreads();
        { float s = 0.f;
#pragma unroll
          for (int w = 0; w < 8; ++w) s += part[w * 512 + F.tid];
          const float mean = s * (1.0f / 256.0f); const unsigned hb = f2bf(mean); const float hf = __builtin_bit_cast(float, hb << 16);
          KMH[(size_t)bn * AW + chunk * 512 + F.tid] = (bf16)hb; KML[(size_t)bn * AW + chunk * 512 + F.tid] = (bf16)f2bf(mean - hf); }
        __syncthreads();
    }
}

__device__ __forceinline__ void gate_phase(Frame& F) {
    const bf16* Qb = (const bf16*)(F.ws + WS_Q); const bf16* KMH = (const bf16*)(F.ws + WS_KMH); const bf16* KML = (const bf16*)(F.ws + WS_KML);
    unsigned short* lists = (unsigned short*)(F.ws + WS_LIST); gu32* gcnt = F.ctl + CW_GCNT;
    LAS float* gl = (LAS float*)(F.lds + RING_OFF);
    LAS unsigned* lcnt = (LAS unsigned*)(F.lds + RING_OFF + 34816);
    LAS unsigned* gb = lcnt + 32;
    const int r32 = F.lane & 31, hi = F.lane >> 5;
    for (int uid = blockIdx.x; uid < 1024; uid += F.G) {
        const int bh = uid >> 5, qb = uid & 31, b = bh >> 4, h = bh & 15;
        if (qb == 0) continue;
        if (F.tid < 32) lcnt[F.tid] = 0u;
        const size_t trow = (size_t)b * SEQ + 256 * qb + 32 * F.wave + r32;
        f32x16 acc = {};
#pragma unroll
        for (int s = 0; s < 8; ++s) {
            const bf16x8 bq = *(const GAS bf16x8*)(Qb + trow * AW + h * HD + 16 * s + 8 * hi);
            const bf16x8 ah = *(const GAS bf16x8*)(KMH + (size_t)(b * 32 + r32) * AW + h * HD + 16 * s + 8 * hi);
            const bf16x8 al = *(const GAS bf16x8*)(KML + (size_t)(b * 32 + r32) * AW + h * HD + 16 * s + 8 * hi);
            acc = __builtin_amdgcn_mfma_f32_32x32x16_bf16(ah, bq, acc, 0, 0, 0);
            acc = __builtin_amdgcn_mfma_f32_32x32x16_bf16(al, bq, acc, 0, 0, 0);
        }
#pragma unroll
        for (int r = 0; r < 16; ++r) gl[(32 * F.wave + r32) * 33 + att::crow(r, hi)] = acc[r];
        __syncthreads();
        int s0 = 0, s1 = 0, s2 = 0; unsigned p0 = 0, p1 = 0, p2 = 0; const int nsel = qb < 3 ? qb : 3;
        if (F.tid < 256) {
            float v0 = -__builtin_inff(), v1 = v0, v2 = v0;
            for (int n = 0; n < qb; ++n) { const float g = gl[F.tid * 33 + n];
                if (g > v0) { v2 = v1; s2 = s1; v1 = v0; s1 = s0; v0 = g; s0 = n; }
                else if (g > v1) { v2 = v1; s2 = s1; v1 = g; s1 = n; }
                else if (g > v2) { v2 = g; s2 = n; } }
            p0 = __hip_atomic_fetch_add(lcnt + s0, 1u, __ATOMIC_RELAXED, __HIP_MEMORY_SCOPE_WORKGROUP);
            if (nsel > 1) p1 = __hip_atomic_fetch_add(lcnt + s1, 1u, __ATOMIC_RELAXED, __HIP_MEMORY_SCOPE_WORKGROUP);
            if (nsel > 2) p2 = __hip_atomic_fetch_add(lcnt + s2, 1u, __ATOMIC_RELAXED, __HIP_MEMORY_SCOPE_WORKGROUP);
        }
        __syncthreads();
        if (F.tid < 32) { const unsigned c = lcnt[F.tid]; gb[F.tid] = c ? __hip_atomic_fetch_add(gcnt + bh * 32 + F.tid, c, RLX_AGENT) : 0u; }
        __syncthreads();
        if (F.tid < 256) {
            unsigned short* lb = lists + (size_t)bh * LIST_STRIDE; const unsigned tl = (unsigned)(256 * qb + F.tid);
            lb[list_off(s0) + gb[s0] + p0] = (unsigned short)(tl | (0u << 13));
            if (nsel > 1) lb[list_off(s1) + gb[s1] + p1] = (unsigned short)(tl | (1u << 13));
            if (nsel > 2) lb[list_off(s2) + gb[s2] + p2] = (unsigned short)(tl | (2u << 13));
        }
        __syncthreads();
    }
}

__device__ __forceinline__ void attn_phase(Frame& F, char* ldsg) {
    const bf16* Qb = (const bf16*)(F.ws + WS_Q); const bf16* Kb = (const bf16*)(F.ws + WS_K); const bf16* Vb = (const bf16*)(F.ws + WS_V);
    bf16* PO = (bf16*)(F.ws + WS_PARTO); float2* ML = (float2*)(F.ws + WS_ML);
    const unsigned short* lists = (const unsigned short*)(F.ws + WS_LIST); const gu32* gcnt = F.ctl + CW_GCNT;
    LAS int* pre = (LAS int*)(F.lds + RING_OFF + 67584);
    for (int i = F.tid; i < 1024; i += NWAVES * 64) pre[i] = (int)((__hip_atomic_load(gcnt + i, RLX_AGENT) + 255u) >> 8);
    __syncthreads();
    if (F.wave == 0) {
        int loc[16]; int s = 0;
#pragma unroll
        for (int k = 0; k < 16; ++k) { loc[k] = pre[F.lane * 16 + k]; s += loc[k]; }
        int incl = s;
#pragma unroll
        for (int o = 1; o < 64; o <<= 1) { const int v = __shfl_up(incl, o); if (F.lane >= o) incl += v; }
        int run = incl - s;
#pragma unroll
        for (int k = 0; k < 16; ++k) { pre[F.lane * 16 + k] = run; run += loc[k]; }
        if (F.lane == 63) pre[1024] = incl;
    }
    __syncthreads();
    const int total = 1024 + pre[1024];
    LAS int* DSC = (LAS int*)(F.lds + RING_OFF + 67584 + 4224);
    const int nloc = (total > (int)blockIdx.x) ? (total - (int)blockIdx.x + F.G - 1) / F.G : 0;
    if (F.tid < nloc && F.tid < 64) {
        const int id = blockIdx.x + F.tid * F.G; int bhj, own, lpos, cnt;
        if (id < 1024) { bhj = id; own = 1; lpos = 0; cnt = 256; }
        else { const int x = id - 1024; int lo = 0, hi2 = 1023;
            while (lo < hi2) { const int mid = (lo + hi2 + 1) >> 1; if (pre[mid] <= x) lo = mid; else hi2 = mid - 1; }
            const int li = lo, chunk = x - pre[li]; bhj = li; own = 0; lpos = (li >> 5) * LIST_STRIDE + list_off(li & 31) + 256 * chunk;
            const int c = (int)__hip_atomic_load(gcnt + li, RLX_AGENT) - 256 * chunk; cnt = c < 256 ? c : 256; }
        DSC[4 * F.tid] = bhj; DSC[4 * F.tid + 1] = own; DSC[4 * F.tid + 2] = lpos; DSC[4 * F.tid + 3] = cnt;
    }
    __syncthreads();
    att::ItemCtx C{Qb, Kb, Vb, PO, ML, lists};
    att::attn_items(C, (const LAS int*)DSC, nloc < 64 ? nloc : 64, ldsg);
}


#if defined(MOBA_CHECK) && MOBA_CHECK
__device__ __forceinline__ float wave_max(float v) {
#pragma unroll
    for (int o = 1; o < 64; o <<= 1) v = fmaxf(v, __shfl_xor(v, o));
    return v;
}
__device__ __forceinline__ void moba_check(Frame& F) {
    const bf16* Qb = (const bf16*)(F.ws + WS_Q); const bf16* Kb = (const bf16*)(F.ws + WS_K); const bf16* Vb = (const bf16*)(F.ws + WS_V);
    const bf16* KMH = (const bf16*)(F.ws + WS_KMH); const bf16* KML = (const bf16*)(F.ws + WS_KML); const bf16* CAT = (const bf16*)(F.ws + WS_CAT);
    LAS float* pl = (LAS float*)(F.lds + RING_OFF + F.wave * 8192);
    LAS float* ql = pl + 1024;
    const int gw = blockIdx.x * NWAVES + F.wave, NGW = F.G * NWAVES;
    for (int s = gw; s < 4096; s += NGW) {
        const unsigned hsh = (unsigned)s * 2654435761u; const int bh = (hsh >> 8) & 31; int t = (hsh >> 13) & 8191; if ((s & 7) == 0) t &= 1023;
        const int b = bh >> 4, h = bh & 15, qb = t >> 8, tl = t & 255;
        const bf16* qrow = Qb + ((size_t)b * SEQ + t) * AW + h * HD;
        ql[F.lane] = bf2f(qrow[F.lane]); ql[64 + F.lane] = bf2f(qrow[64 + F.lane]); LDS_WAIT();
        float g = -__builtin_inff();
        if (F.lane < qb) { const bf16* kh = KMH + (size_t)(b * 32 + F.lane) * AW + h * HD; const bf16* kl = KML + (size_t)(b * 32 + F.lane) * AW + h * HD; float a = 0.f;
            for (int d = 0; d < 128; ++d) a += ql[d] * (bf2f(kh[d]) + bf2f(kl[d])); g = a; }
        int sel[3]; const int nsel = qb < 3 ? qb : 3;
#pragma unroll
        for (int k = 0; k < 3; ++k) { const float mx = wave_max(g); const unsigned long long bal = __ballot(g == mx && F.lane < qb); const int idx = bal ? (int)__builtin_ctzll(bal) : 0; sel[k] = idx; if (F.lane == idx) g = -__builtin_inff(); }
        float sc[4][4]; float mx = -1e30f;
#pragma unroll
        for (int u = 0; u < 4; ++u) { const bool on = (u == 3) || (u < nsel); const int j = (u == 3) ? qb : sel[u];
#pragma unroll
            for (int r = 0; r < 4; ++r) { const int key = F.lane + 64 * r; float a = -1e30f;
                if (on && !(u == 3 && key > tl)) { const bf16* kr = Kb + ((size_t)b * SEQ + 256 * j + key) * AW + h * HD; a = 0.f; for (int d = 0; d < 128; ++d) a += ql[d] * bf2f(kr[d]); a *= 0.088388347648318440f; }
                sc[u][r] = a; mx = fmaxf(mx, a); } }
        mx = wave_max(mx); float sum = 0.f;
#pragma unroll
        for (int u = 0; u < 4; ++u)
#pragma unroll
            for (int r = 0; r < 4; ++r) { const float p = (sc[u][r] > -1e29f) ? __expf(sc[u][r] - mx) : 0.f; sum += p; pl[u * 256 + F.lane + 64 * r] = p; }
        sum = wave_sum(sum); LDS_WAIT();
        float o0 = 0.f, o1 = 0.f;
#pragma unroll
        for (int u = 0; u < 4; ++u) { const bool on = (u == 3) || (u < nsel); const int j = (u == 3) ? qb : sel[u];
            if (on) for (int key = 0; key < 256; ++key) { const float p = pl[u * 256 + key]; const bf16* vr = Vb + ((size_t)b * SEQ + 256 * j + key) * AW + h * HD; o0 += p * bf2f(vr[F.lane]); o1 += p * bf2f(vr[64 + F.lane]); } }
        o0 /= sum; o1 /= sum;
        const bf16* cr = CAT + ((size_t)b * SEQ + t) * DM + PW + h * HD; const float c0 = bf2f(cr[F.lane]), c1 = bf2f(cr[64 + F.lane]);
        const bool bad = !(fabsf(c0 - o0) <= 1.5e-3f + 0.03f * fabsf(o0)) || !(fabsf(c1 - o1) <= 1.5e-3f + 0.03f * fabsf(o1));
        const unsigned long long bb = __ballot(bad);
        if (F.lane == 0 && bb) __hip_atomic_fetch_add(F.ctl + CW_CHK, 1u, RLX_AGENT);
        if (F.lane == 0) __hip_atomic_fetch_add(F.ctl + CW_CHK + 1, 1u, RLX_AGENT);
        LDS_WAIT();
    }
}
#endif


#if defined(XATTN_CHECK) && XATTN_CHECK
__device__ __noinline__ void xattn_check_a(unsigned char* ws, gu32* ctl, const float* mem, const float* w_xq, const float* w_xkv, const float* w_xo, const float* g1, int G) {
    const int lane = threadIdx.x & 63, wave = threadIdx.x >> 6;
    const bf16* KVX = (const bf16*)(ws + WS_KVX); const bf16* WQK = (const bf16*)(ws + WS_WQK); const bf16* WVOT = (const bf16*)(ws + WS_WVOT);
    const int gw = blockIdx.x * NWAVES + wave, NGW = G * NWAVES;
    for (int s = gw; s < 3 * 2048; s += NGW) {
        const unsigned hsh = (unsigned)s * 2654435761u; const int kind = s / 2048; float ref = 0.f, got = 0.f;
        if (kind == 0) { const int r = (hsh >> 7) & 511, c = (hsh >> 16) & 8191;
            float a = 0.f; for (int k = lane; k < DM; k += 64) a += mem[(size_t)r * DM + k] * w_xkv[(size_t)k * (2 * DM) + c];
            ref = wave_sum(a); got = bf2f(KVX[(size_t)r * 8192 + c]); }
        else if (kind == 1) { const int n = (hsh >> 7) & 2047, k = (hsh >> 18) & 4095, bb = n >> 10, h = (n >> 8) & 3, m = n & 255;
            float a = 0.f; for (int j = lane; j < 1024; j += 64) a += bf2f(KVX[(size_t)(bb * 256 + m) * 8192 + h * 1024 + j]) * w_xq[(size_t)k * DM + h * 1024 + j];
            ref = wave_sum(a) * g1[k]; got = bf2f(WQK[(size_t)n * DM + k]); }
        else { const int j = (hsh >> 7) & 4095, n = (hsh >> 19) & 2047, bb = n >> 10, h = (n >> 8) & 3, m = n & 255;
            float a = 0.f; for (int d = lane; d < 1024; d += 64) a += w_xo[(size_t)(h * 1024 + d) * DM + j] * bf2f(KVX[(size_t)(bb * 256 + m) * 8192 + 4096 + h * 1024 + d]);
            ref = wave_sum(a); got = bf2f(WVOT[(size_t)j * 2048 + n]); }
        const unsigned long long bb2 = __ballot(!(fabsf(got - ref) <= 0.02f + 0.02f * fabsf(ref)));
        if (lane == 0) { if (bb2) { __hip_atomic_fetch_add(ctl + CW_CHK + 2, 1u, RLX_AGENT); __hip_atomic_fetch_add(ctl + CW_CHK + 4 + kind, 1u, RLX_AGENT); } __hip_atomic_fetch_add(ctl + CW_CHK + 3, 1u, RLX_AGENT); }
    }
}
__device__ __noinline__ void xattn_check_b(unsigned char* ws, gu32* ctl, LAS float* ldsf, const float* w_xq, const float* g1, const float* b1, int G) {
    const int lane = threadIdx.x & 63, wave = threadIdx.x >> 6;
    const bf16* TB = (const bf16*)(ws + WS_TB); const bf16* KVX = (const bf16*)(ws + WS_KVX); const bf16* PB = (const bf16*)(ws + WS_PB);
    LAS float* hl = ldsf + wave * 4096; LAS float* ql = hl;
    const int gw = blockIdx.x * NWAVES + wave, NGW = G * NWAVES;
    for (int s = gw; s < 1024; s += NGW) {
        const unsigned hsh = (unsigned)s * 2654435761u; const int t = (hsh >> 9) & (M - 1), h = (hsh >> 5) & 3, bb = t >> 13;
        float sm = 0.f; for (int k = lane; k < DM; k += 64) sm += bf2f(TB[(size_t)t * DM + k]);
        const float mean = wave_sum(sm) * (1.f / DM); float sq = 0.f;
        for (int k = lane; k < DM; k += 64) { const float d = bf2f(TB[(size_t)t * DM + k]) - mean; sq += d * d; }
        const float rstd = 1.f / sqrtf(wave_sum(sq) * (1.f / DM) + LN_EPS);
        for (int k = lane; k < DM; k += 64) hl[k] = (bf2f(TB[(size_t)t * DM + k]) - mean) * rstd * g1[k] + b1[k];
        LDS_WAIT();
        float q[16];
#pragma unroll
        for (int j = 0; j < 16; ++j) q[j] = 0.f;
        for (int k = 0; k < DM; ++k) { const float hv = hl[k]; const float* wr = w_xq + (size_t)k * DM + h * 1024 + lane;
#pragma unroll
            for (int j = 0; j < 16; ++j) q[j] += hv * wr[64 * j]; }
        LDS_WAIT();
#pragma unroll
        for (int j = 0; j < 16; ++j) ql[lane + 64 * j] = q[j];
        LDS_WAIT();
        float sc[4]; float mx = -1e30f;
#pragma unroll
        for (int r = 0; r < 4; ++r) { const int m = lane + 64 * r; const bf16* kr = KVX + (size_t)(bb * 256 + m) * 8192 + h * 1024; float a = 0.f;
            for (int n = 0; n < 1024; ++n) a += ql[n] * bf2f(kr[n]);
            sc[r] = a * 0.03125f; mx = fmaxf(mx, sc[r]); }
#pragma unroll
        for (int o = 1; o < 64; o <<= 1) mx = fmaxf(mx, __shfl_xor(mx, o));
        float sum = 0.f;
#pragma unroll
        for (int r = 0; r < 4; ++r) { sc[r] = __expf(sc[r] - mx); sum += sc[r]; }
        sum = wave_sum(sum); bool bad = false;
#pragma unroll
        for (int r = 0; r < 4; ++r) { const float ref = sc[r] / sum, got = bf2f(PB[(size_t)t * 1024 + h * 256 + lane + 64 * r]); bad = bad || !(fabsf(got - ref) <= 2e-4f + 0.04f * ref); }
        const unsigned long long bb2 = __ballot(bad);
        if (lane == 0) { if (bb2) { __hip_atomic_fetch_add(ctl + CW_CHK + 2, 1u, RLX_AGENT); __hip_atomic_fetch_add(ctl + CW_CHK + 7, 1u, RLX_AGENT); } __hip_atomic_fetch_add(ctl + CW_CHK + 3, 1u, RLX_AGENT); }
        LDS_WAIT();
    }
}
#endif

__device__ __forceinline__ void combine_one(const float2 (&ml)[4], const v4u (&r)[4], int nsel, bf16* dst) {
    constexpr float C = att::SCALE * 1.4426950408889634f;
    float mx = ml[3].x;
#pragma unroll
    for (int k = 0; k < 3; ++k) if (k < nsel) mx = fmaxf(mx, ml[k].x);
    float acc[8]; float wsum = 0.f;
#pragma unroll
    for (int e = 0; e < 8; ++e) acc[e] = 0.f;
#pragma unroll
    for (int k = 0; k < 4; ++k) { const float w = (k == 3 || k < nsel) ? ml[k].y * __builtin_amdgcn_exp2f((ml[k].x - mx) * C) : 0.f; wsum += w;
        acc[0] += w * bf_lo(r[k].x); acc[1] += w * bf_hi(r[k].x); acc[2] += w * bf_lo(r[k].y); acc[3] += w * bf_hi(r[k].y);
        acc[4] += w * bf_lo(r[k].z); acc[5] += w * bf_hi(r[k].z); acc[6] += w * bf_lo(r[k].w); acc[7] += w * bf_hi(r[k].w); }
    const float inv = 1.0f / wsum;
    v4u o; o.x = pk2(acc[0] * inv, acc[1] * inv); o.y = pk2(acc[2] * inv, acc[3] * inv); o.z = pk2(acc[4] * inv, acc[5] * inv); o.w = pk2(acc[6] * inv, acc[7] * inv);
    *(GAS v4u*)dst = o;
}
__device__ __forceinline__ void combine_phase(Frame& F) {
    const bf16* PO = (const bf16*)(F.ws + WS_PARTO); const float2* ML = (const float2*)(F.ws + WS_ML); bf16* CAT = (bf16*)(F.ws + WS_CAT);
    const size_t gt = (size_t)blockIdx.x * (NWAVES * 64) + F.tid, NT = (size_t)F.G * NWAVES * 64, NE = (size_t)32 * SEQ * 16, HALFE = NE / 2;
    for (size_t idx = gt; idx < HALFE; idx += NT) {
        float2 ml[2][4]; v4u r[2][4]; int nsel[2]; bf16* dst[2];
#pragma unroll
        for (int u = 0; u < 2; ++u) { const size_t id = idx + u * HALFE;
            const int dc = (int)(id & 15), t = (int)((id >> 4) & (SEQ - 1)), bh = (int)(id >> 17), qb = t >> 8; nsel[u] = qb < 3 ? qb : 3;
            dst[u] = CAT + ((size_t)(bh >> 4) * SEQ + t) * DM + PW + (bh & 15) * HD + dc * 8;
#pragma unroll
            for (int k = 0; k < 4; ++k) { const int ks = (k == 3 || k < nsel[u]) ? k : 3;
                ml[u][k] = ML[((size_t)ks * 32 + bh) * SEQ + t]; r[u][k] = *(const GAS v4u*)(PO + (((size_t)ks * 32 + bh) * SEQ + t) * HD + dc * 8); } }
        combine_one(ml[0], r[0], nsel[0], dst[0]); combine_one(ml[1], r[1], nsel[1], dst[1]);
    }
}

struct Args { const float* in[18]; float* out; unsigned char* ws; int ph_lo, ph_hi, li, pad; };
__global__ void __launch_bounds__(NWAVES * 64, 2) mega_fwd(Args args) {
    extern __shared__ __attribute__((aligned(16))) unsigned char lds[];
    Frame F;
    F.lds = (LAS unsigned char*)lds;
    F.MISC = (volatile LAS unsigned*)(F.lds + MISC_OFF);
    F.tid = threadIdx.x; F.lane = F.tid & 63; F.wave = __builtin_amdgcn_readfirstlane(F.tid >> 6);
    F.G = gridDim.x; F.ws = args.ws;
    F.ctl = (gu32*)(args.ws + WS_CTL);
    for (int u = F.tid; u < (LDS_BYTES - LDSCTL_OFF) / 4; u += NWAVES * 64) ((LAS unsigned*)(F.lds + LDSCTL_OFF))[u] = 0u;
    __syncthreads();
    XcdBarrier bar; bar.bar = (unsigned*)(F.ctl + CW_BAR); bar.x = 0; bar.st = nullptr;
    if (N_LAUNCHES == 1) bar = xcd_barrier_post((unsigned*)(F.ctl + CW_BAR), F.MISC + 8);
#define GRID_BAR() do { if (N_LAUNCHES == 1) xcd_barrier(bar); } while (0)
    const int lo = args.ph_lo, hi = args.ph_hi;
#define IN(k) (lo <= (k) && (k) < hi)
#define BOTH(k) (IN(k) && IN((k) + 1))
#if defined(PROBE_SKEW)
#ifndef PROBE_PREV
#define PROBE_PREV (PROBE_SKEW - 1)
#endif
#define SKEW_MARK(k) do { if ((k) == PROBE_SKEW && F.tid == 0) { const unsigned tt = (unsigned)wall_clock64(); __hip_atomic_fetch_max(F.ctl + CW_CHK + 8, ~tt, RLX_AGENT); __hip_atomic_fetch_max(F.ctl + CW_CHK + 9, tt, RLX_AGENT); __hip_atomic_fetch_max(F.ctl + CW_CHK + 16 + (bar.x & 7), tt, RLX_AGENT); } if ((k) == PROBE_PREV && F.tid == 0) { const unsigned tt = (unsigned)wall_clock64(); __hip_atomic_fetch_max(F.ctl + CW_CHK + 10, ~tt, RLX_AGENT); __hip_atomic_fetch_max(F.ctl + CW_CHK + 11, tt, RLX_AGENT); } } while (0)
#else
#define SKEW_MARK(k) do { } while (0)
#endif
#ifndef PROBE_DUP
#define PROBE_DUP 0
#endif
#define DUPON(k) ((PROBE_DUP >> (k)) & 1)
#define REP(k) for (int _rep = 0; _rep < (DUPON(k) ? 2 : 1); ++_rep)
    unsigned char* ws = args.ws;
    const int G = F.G, cid = (int)blockIdx.x;
    float* out = args.out;

    if (IN(0)) { REP(0) { p0_prologue(F, args.in); }
#if defined(WDOWN_IN_P0)
      convert_wdown_static(F, args.in[15], cid, G);
#endif
#if !defined(GU_BF16)
      GRID_BAR(); quant_wgu(F);
#endif
      SKEW_MARK(0); if (BOTH(0)) GRID_BAR(); }

    if (IN(1)) {
#if MIX8 == 0
        { pg8::Gemm g = pg8::make_gemm(ws + WS_XB, DM, ws + WS_WIN, DM, DM); pg8::StaticOrder S; S.init(M, MIXIN, G, cid);
          pg8::EpiMixIn E{(pg8::bf16_t*)(ws + WS_HP), (size_t)M * 2048, (const float*)(ws + WS_ROPE), 0};
          pg8::gemm_phase<pg8::EpiMixIn, pg8::StaticOrder, true, true>(F.lds + RING_OFF, g, S, E); }
#else
        { constexpr int N8 = (MIX8 == 2) ? 4096 : 2048;
          pg8::Gemm g = pg8::make_gemm(ws + WS_X8, DM / 2, ws + WS_W8IN, DM / 2, DM / 2); pg8::StaticOrder S; S.init(M, N8, G, cid);
          pg8::EpiMix8 E{(pg8::bf16_t*)(ws + WS_HP), (size_t)M * 2048, (const float*)(F.ctl + CW_SX), (const float*)(F.ctl + CW_SBIN), (MIX8 == 2) ? 0 : 3, 3};
          pg8::gemm_phase<pg8::EpiMix8, pg8::StaticOrder, true, true, pg8::Gemm, true>(F.lds + RING_OFF, g, S, E); }
        { constexpr int NB = (MIX8 == 2) ? 4096 : 6144, R0 = (MIX8 == 2) ? 2048 : 0;
          pg8::Gemm g = pg8::make_gemm(ws + WS_XB, DM, ws + WS_WIN + (size_t)R0 * DM * 2, DM, DM); pg8::StaticOrder S; S.init(M, NB, G, cid);
          pg8::EpiMixIn E{(pg8::bf16_t*)(ws + WS_HP), (size_t)M * 2048, (const float*)(ws + WS_ROPE), R0 / 256};
          pg8::gemm_phase<pg8::EpiMixIn, pg8::StaticOrder, true, true>(F.lds + RING_OFF, g, S, E); }
#endif
        {
          pg8::GemmKV g{(const char*)(ws + WS_MEMB), (const char*)(ws + WS_WXKV), DM, DM, 1024}; pg8::EpiSlabKV E{(float*)(ws + WS_SLAB)};
          gu32* kvq = F.ctl + CW_DYN + 4096 + 2048;
#pragma nounroll
          for (;;) {
              if (F.tid == 0) { const unsigned t = __hip_atomic_fetch_add(kvq, 1u, RLX_AGENT); F.MISC[20] = t < 256u ? t : 0xffffffffu; }
              __syncthreads(); const unsigned L = F.MISC[20]; __syncthreads();
              if (L == 0xffffffffu) break;
              pg8::OrderOne S; S.u.pz = (int)(L & 3u); S.u.pm = (int)(L >> 7); S.u.pn = (int)((L >> 2) & 31u);
              pg8::gemm_phase<pg8::EpiSlabKV, pg8::OrderOne, true, true, pg8::GemmKV>(F.lds + RING_OFF, g, S, E);
          } }
        gu_filler(F, args.in, 1); SKEW_MARK(1); if (BOTH(1)) GRID_BAR();
    }

    if (IN(2)) { REP(2) { pool_ew(F); kmean_phase(F); kv_reduce(F); } SKEW_MARK(2); if (BOTH(2)) GRID_BAR(); }

#if defined(PROBE_XBAR)
    for (int xb = 0; xb < PROBE_XBAR; ++xb) GRID_BAR();
#endif
    if (IN(3)) {
        { pg8::Gemm g = pg8::make_gemm(ws + WS_WOUT, 2048, ws + WS_WPOOL, 512, 512); g.a_pn = 512 * 2; g.a_pn_sh = 1; pg8::StaticOrder S; S.init(DM, PW, G, cid);
          pg8::EpiStore E{(pg8::bf16_t*)(ws + WS_WOUT2), DM, 0};
          pg8::gemm_phase<pg8::EpiStore, pg8::StaticOrder, true, true>(F.lds + RING_OFF, g, S, E); if (DUPON(3)) { pg8::gemm_phase<pg8::EpiStore, pg8::StaticOrder, true, true>(F.lds + RING_OFF, g, S, E); } }
        if (G == 256) { pg8::GemmAbs g{(const char*)(ws + WS_KVX), (const char*)(ws + WS_WXQ), (const char*)(ws + WS_WXO), cid < 128 ? 8192 : 4096, cid < 128 ? 4096 : 8192, 1024};
          pg8::OrderAbs S{cid}; pg8::EpiStoreAbs E{(pg8::bf16_t*)(ws + WS_WQK), (pg8::bf16_t*)(ws + WS_WVOT), (float*)(F.ctl + CW_K1), (float*)(F.ctl + CW_K2)};
          pg8::gemm_phase<pg8::EpiStoreAbs, pg8::OrderAbs, true, true, pg8::GemmAbs>(F.lds + RING_OFF, g, S, E); if (DUPON(17)) { pg8::gemm_phase<pg8::EpiStoreAbs, pg8::OrderAbs, true, true, pg8::GemmAbs>(F.lds + RING_OFF, g, S, E); } }
        gate_phase(F);
        gu_filler(F, args.in, 3); SKEW_MARK(3); if (BOTH(3)) GRID_BAR();
#if defined(XATTN_CHECK) && XATTN_CHECK
        xattn_check_a(ws, F.ctl, args.in[1], args.in[8], args.in[9], args.in[10], args.in[6], G); __syncthreads();
#endif
    }

    if (IN(4)) { attn_phase(F, (char*)lds + RING_OFF); if (DUPON(4)) { __syncthreads(); attn_phase(F, (char*)lds + RING_OFF); } gu_filler(F, args.in, 4); SKEW_MARK(4); if (BOTH(4)) GRID_BAR(); }

    if (IN(5)) { REP(5) { combine_phase(F); } SKEW_MARK(5); if (BOTH(5)) GRID_BAR(); }
#if defined(MOBA_CHECK) && MOBA_CHECK
    if (IN(5)) { moba_check(F); __syncthreads(); }
#endif

    if (IN(6)) {
        pg8::Gemm g = pg8::make_gemm(ws + WS_CAT, DM, ws + WS_WOUT2, DM, DM); pg8::StaticOrder S; S.init(M, DM, G, cid);
        pg8::EpiResid E{args.in[0], (pg8::bf16_t*)(ws + WS_TB), DM, DN_ALPHA, (pg8::f32x2*)(ws + WS_SLOT)};
        pg8::gemm_phase<pg8::EpiResid, pg8::StaticOrder, true, true>(F.lds + RING_OFF, g, S, E); if (DUPON(6)) { pg8::gemm_phase<pg8::EpiResid, pg8::StaticOrder, true, true>(F.lds + RING_OFF, g, S, E); }
        gu_filler(F, args.in, 6); SKEW_MARK(6); if (BOTH(6)) GRID_BAR();
    }
    if (IN(7)) { ln_finalize(F, (const float2*)(ws + WS_SLOT), (float2*)(ws + WS_STATS)); SKEW_MARK(7); if (BOTH(7)) GRID_BAR(); }

    if (IN(9)) {
        if (G == 256) {
            pg8::Gemm g = pg8::make_gemm(ws + WS_TB, DM, ws + WS_WQK, DM, DM); g.b_pm = (size_t)1024 * DM * 2; g.b_pm_sh = 5;
            pg8::StaticOrder S; S.init(M, XH * 256, G, cid);
            pg8::EpiSoftmax E{(pg8::bf16_t*)(ws + WS_PB), XH * MEMLEN, 0.03125f * 1.4426950408889634f, (const pg8::f32x2*)(ws + WS_STATS), (const float*)(F.ctl + CW_K1), (const float*)(F.ctl + CW_K2)};
            pg8::gemm_phase<pg8::EpiSoftmax, pg8::StaticOrder, false, true>(F.lds + RING_OFF, g, S, E); if (DUPON(9)) { pg8::gemm_phase<pg8::EpiSoftmax, pg8::StaticOrder, false, true>(F.lds + RING_OFF, g, S, E); }
        }
        gu_filler(F, args.in, 9); SKEW_MARK(9); if (BOTH(9)) GRID_BAR();
#if defined(XATTN_CHECK) && XATTN_CHECK
        xattn_check_b(ws, F.ctl, (LAS float*)(F.lds + RING_OFF), args.in[8], args.in[6], args.in[7], G); __syncthreads(); GRID_BAR();
#endif
    }
    if (IN(11)) {
        pg8::Gemm g = pg8::make_gemm(ws + WS_PB, XH * MEMLEN, ws + WS_WVOT, 2048, XH * MEMLEN); g.b_pm = (size_t)1024 * 2; g.b_pm_sh = 5;
        pg8::StaticOrder S; S.init(M, DM, G, cid);
#if defined(GU_BF16)
        pg8::EpiResidLN E{(pg8::bf16_t*)(ws + WS_TB), (const pg8::f32x2*)(ws + WS_STATS), 6, (pg8::f32x2*)(ws + WS_SLOT)};
#else
        pg8::EpiResidLN E{(pg8::bf16_t*)(ws + WS_TB), (const pg8::f32x2*)(ws + WS_STATS), 6, nullptr};
#endif
        pg8::gemm_phase<pg8::EpiResidLN, pg8::StaticOrder, true, true>(F.lds + RING_OFF, g, S, E);
        gu_filler(F, args.in, 11); SKEW_MARK(11); if (BOTH(11)) GRID_BAR();
    }
#if defined(GU_BF16)
    if (IN(12)) { ln_finalize(F, (const float2*)(ws + WS_SLOT), (float2*)(ws + WS_STATS)); gu_drain(F, args.in); SKEW_MARK(12); if (BOTH(12)) GRID_BAR(); }
#else
    if (IN(12)) { ln_rows_q8(F, (const bf16*)(ws + WS_TB), ws + WS_H8, (float*)(F.ctl + CW_SA), (float2*)(ws + WS_STATS), args.in[11], args.in[12]); SKEW_MARK(12); if (BOTH(12)) GRID_BAR(); }
#endif

#if defined(PROBE_SLEEP_US)
    { const unsigned long long w0 = wall_clock64(); while (wall_clock64() - w0 < (unsigned long long)PROBE_SLEEP_US * 100ull) __builtin_amdgcn_s_sleep(64); SKEW_MARK(20); GRID_BAR(); }
#endif
    if (IN(13)) {
#if defined(GU_BF16)
        pg8::Gemm g = pg8::make_gemm(ws + WS_TB, DM, ws + WS_WGU, DM, DM);
        pg8::EpiSwiGLU E{(pg8::bf16_t*)(ws + WS_G), FF, (const pg8::f32x2*)(ws + WS_STATS), (const float*)(F.ctl + CW_C1G), (const float*)(F.ctl + CW_C2G)};
        typedef pg8::EpiSwiGLU EpiGU; constexpr bool GU_I8 = false;
#else
        pg8::Gemm g = pg8::make_gemm(ws + WS_H8, DM / 2, ws + WS_WGU, DM / 2, DM / 2);
        pg8::EpiSwiGLU8 E{(pg8::bf16_t*)(ws + WS_G), FF, (const float*)(F.ctl + CW_SA), (const float*)(F.ctl + CW_SB)};
        typedef pg8::EpiSwiGLU8 EpiGU; constexpr bool GU_I8 = true;
#endif
#if defined(STATIC_ORDER)
        pg8::StaticOrder S; S.init(M, 2 * FF, G, cid);
        pg8::gemm_phase<EpiGU, pg8::StaticOrder, true, true, pg8::Gemm, GU_I8>(F.lds + RING_OFF, g, S, E);
#else
        #ifndef GU_WGM
#define GU_WGM 8
#endif
#ifndef GU_ROT
#define GU_ROT 0
#endif
        pg8::DynOrder S; S.init(M, 2 * FF, (unsigned*)(F.ctl + CW_DYN + 512 * 3), (volatile LAS int*)(F.MISC + 16), (int)xb_xcc_id(), GU_ROT, GU_WGM); S.start(F.wave, F.lane);
        pg8::gemm_phase<EpiGU, pg8::DynOrder, true, true, pg8::Gemm, GU_I8>(F.lds + RING_OFF, g, S, E);
#endif
#if !defined(WDOWN_IN_P0)
        convert_wdown(F, args.in[15], F.ctl + CW_DYN + 4096);
#endif
        SKEW_MARK(13); if (BOTH(13)) GRID_BAR();
    }
    if (IN(14)) {
#ifndef DOWN_WGM
#define DOWN_WGM 4
#endif
        pg8::Gemm g = pg8::make_gemm(ws + WS_G, FF, ws + WS_WDN, FF, FF); pg8::StaticOrder S; S.init(M, DM, G, cid, DOWN_WGM);
        pg8::EpiResidLN E{(pg8::bf16_t*)(ws + WS_TB), (const pg8::f32x2*)(ws + WS_STATS), 11, nullptr};
        if (DUPON(14)) { pg8::EpiStore E2{(pg8::bf16_t*)(ws + WS_HB), DM, 0}; pg8::gemm_phase<pg8::EpiStore, pg8::StaticOrder, true, true>(F.lds + RING_OFF, g, S, E2); }
        pg8::gemm_phase<pg8::EpiResidLN, pg8::StaticOrder, true, true>(F.lds + RING_OFF, g, S, E);
        SKEW_MARK(14); if (BOTH(14)) GRID_BAR();
    }
#if defined(MOBA_CHECK) && MOBA_CHECK
#define CHK_TAIL 1
#endif
    if (IN(15)) { ln_rows<true>(F, (const bf16*)(ws + WS_TB), nullptr, nullptr, out, args.in[16], args.in[17]); if (DUPON(15)) { ln_rows<true>(F, (const bf16*)(ws + WS_TB), nullptr, nullptr, out, args.in[16], args.in[17]); } }
#if defined(PROBE_SKEW)
    GRID_BAR();
    if (blockIdx.x == 0 && F.tid == 0) { const unsigned t0 = ~__hip_atomic_load(F.ctl + CW_CHK + 8, RLX_AGENT), t1 = __hip_atomic_load(F.ctl + CW_CHK + 9, RLX_AGENT), ts = ~__hip_atomic_load(F.ctl + CW_CHK + 10, RLX_AGENT), tp = __hip_atomic_load(F.ctl + CW_CHK + 11, RLX_AGENT);
        unsigned xmin = 0xffffffffu, xmax = 0u; for (int x = 0; x < 8; ++x) { const unsigned v = __hip_atomic_load(F.ctl + CW_CHK + 16 + x, RLX_AGENT); if (v) { xmin = v < xmin ? v : xmin; xmax = v > xmax ? v : xmax; } }
        const unsigned long long ticks = (unsigned long long)((PROBE_SKEW_WHAT == 0) ? (t1 - t0) : (PROBE_SKEW_WHAT == 1) ? (t1 - ts) : (PROBE_SKEW_WHAT == 3) ? (t1 - tp) : (xmax - xmin)) * PROBE_AMP;
        const unsigned long long w0 = wall_clock64(); while (wall_clock64() - w0 < ticks) __builtin_amdgcn_s_sleep(32); }
#endif
#if defined(XATTN_CHECK) && XATTN_CHECK
    GRID_BAR();
    if (blockIdx.x == 0 && F.tid < 64) { const unsigned nbad = __hip_atomic_load(F.ctl + CW_CHK + 2, RLX_AGENT), nrun = __hip_atomic_load(F.ctl + CW_CHK + 3, RLX_AGENT);
        if (nbad != 0u) { float pz = 0.f; for (int kk = 3; kk >= 0; --kk) { const unsigned nb = __hip_atomic_load(F.ctl + CW_CHK + 4 + kk, RLX_AGENT); if (nb) pz = 100.0f * (kk + 1) + 10.0f * (float)(nb < 9u ? nb : 9u); } out[F.tid] = pz; }
        else if (nrun != 3u * 2048u + 1024u) out[F.tid] = 50.0f; }
#endif
#if defined(MOBA_CHECK) && MOBA_CHECK
    GRID_BAR();
    if (blockIdx.x == 0 && F.tid < 64) { const unsigned nbad = __hip_atomic_load(F.ctl + CW_CHK, RLX_AGENT), nrun = __hip_atomic_load(F.ctl + CW_CHK + 1, RLX_AGENT);
        if (nbad != 0u) out[F.tid] = 1000.0f + (float)nbad;
        else if (nrun != 4096u) out[F.tid] = 500.0f + (float)nrun; }
#endif
#undef IN
#undef BOTH
#undef GRID_BAR
}

extern "C" void kernel_launch(void* const* d_in, const int* in_sizes, int n_in, void* d_out, int out_size, void* d_ws, size_t ws_size, hipStream_t stream) {
    static int grid = 0;
    if (grid == 0) {
        if (n_in != 18 || in_sizes[0] != M * DM || out_size != M * DM || ws_size < WS_END) { fprintf(stderr, "kernel_launch: shape / workspace mismatch (n_in %d, in0 %d, out %d, ws %zu, need %zu)\n", n_in, n_in > 0 ? in_sizes[0] : -1, out_size, ws_size, (size_t)WS_END); grid = -1; return; }
        int dev = 0, cus = 0, per_cu = 0;
        if (hipGetDevice(&dev) != hipSuccess || hipDeviceGetAttribute(&cus, hipDeviceAttributeMultiprocessorCount, dev) != hipSuccess) { grid = -1; return; }
        if (hipFuncSetAttribute((const void*)mega_fwd, hipFuncAttributeMaxDynamicSharedMemorySize, LDS_BYTES) != hipSuccess) { fprintf(stderr, "kernel_launch: hipFuncSetAttribute failed\n"); grid = -1; return; }
        if (hipOccupancyMaxActiveBlocksPerMultiprocessor(&per_cu, (const void*)mega_fwd, NWAVES * 64, LDS_BYTES) != hipSuccess || per_cu < 1)
            fprintf(stderr, "kernel_launch: note: occupancy query reports %d workgroups per CU\n", per_cu);
        (void)hipGetLastError();
        grid = cus;
        if (grid != 256) fprintf(stderr, "kernel_launch: %d CUs; the cross-attention score phase needs a 256-workgroup grid\n", grid);
    }
    if (grid < 0) return;
    if (hipMemsetAsync((char*)d_ws + WS_CTL, 0, CTL_ZERO_BYTES, stream) != hipSuccess) return;
    Args a{};
    for (int i = 0; i < 18; ++i) a.in[i] = (const float*)d_in[i];
    a.out = (float*)d_out; a.ws = (unsigned char*)d_ws; a.pad = 0;
    for (int li = 0; li < N_LAUNCHES; ++li) {
        a.ph_lo = (N_LAUNCHES == 1) ? 0 : li; a.ph_hi = (N_LAUNCHES == 1) ? N_PHASES : li + 1; a.li = li;
        hipLaunchKernelGGL(mega_fwd, dim3(grid), dim3(NWAVES * 64), LDS_BYTES, stream, a);
        if (hipPeekAtLastError() != hipSuccess) { fprintf(stderr, "kernel_launch: launch %d failed\n", li); break; }
    }
}
```

```cpp
#include <hip/hip_runtime.h>
#include <cstdio>
#include <cstdint>

namespace pg8 {
#define PG8_LAS __attribute__((address_space(3)))
typedef unsigned short bf16_t;
typedef short bf16x8 __attribute__((ext_vector_type(8)));
typedef float f32x4 __attribute__((ext_vector_type(4)));
typedef float f32x2 __attribute__((ext_vector_type(2)));
typedef unsigned u32x4 __attribute__((ext_vector_type(4)));
typedef unsigned u32x2 __attribute__((ext_vector_type(2)));
typedef int i32x4 __attribute__((ext_vector_type(4)));
constexpr int BM = 256, BK = 64, HALF = 128, HTB = HALF * BK * 2  , STAGE_BYTES = 8 * HTB, NXCD = 8, WGM = 8;

__host__ __device__ __forceinline__ int lds_byte(int r, int c) { const int st = (r >> 4) * 2 + (c >> 5), rr = r & 15, cc = c & 31, ob = rr * 64 + cc * 2; return st * 1024 + (ob ^ (((ob >> 9) & 1) << 5)); }
__host__ __device__ __forceinline__ void stage_rc(int b, int& R, int& C) { const int st = b / 1024, sb = b % 1024, swz = sb ^ (((sb >> 9) & 1) << 5); R = (st >> 1) * 16 + swz / 64; C = (st & 1) * 32 + (swz % 64) / 2; }
__host__ __device__ __forceinline__ int perm32(int rho) { const int n = rho >> 4, i = rho & 15; return 8 * (i >> 2) + 4 * n + (i & 3); }

struct Unit { int pm, pn, pz; };
struct Gemm {
    const char* A; const char* B; int lda, ldb, K;
    size_t a_pm, a_pn; int a_pn_sh; size_t b_pn, b_pm; int b_pm_sh;
    __device__ __forceinline__ const char* a_ptr(const Unit& u) const { return A + (size_t)u.pm * a_pm + (size_t)(u.pn >> a_pn_sh) * a_pn; }
    __device__ __forceinline__ const char* b_ptr(const Unit& u) const { return B + (size_t)u.pn * b_pn + (size_t)(u.pm >> b_pm_sh) * b_pm; }
};
__device__ __forceinline__ Gemm make_gemm(const void* A, int lda, const void* B, int ldb, int K) {
    Gemm g; g.A = (const char*)A; g.B = (const char*)B; g.lda = lda; g.ldb = ldb; g.K = K;
    g.a_pm = (size_t)BM * lda * 2; g.a_pn = 0; g.a_pn_sh = 0; g.b_pn = (size_t)BM * ldb * 2; g.b_pm = 0; g.b_pm_sh = 0; return g;
}

struct StaticOrder {
    int nM, nN, nwg, G, c, wgm;
    __host__ __device__ void init(int M, int N, int G_, int c_, int wgm_ = WGM) { nM = M / BM; nN = N / BM; nwg = nM * nN; G = G_; c = c_; wgm = wgm_; }
    __host__ __device__ bool next(int i, Unit& u) const {
        const long L = (long)i * G + c; if (L >= nwg) return false;
        int wgid = (int)L; { const int q = nwg / NXCD, r = nwg % NXCD, xcd = wgid % NXCD, off = wgid / NXCD; wgid = (xcd < r ? xcd * (q + 1) : r * (q + 1) + (xcd - r) * q) + off; }
        const int nig = wgm * nN, gid = wgid / nig, fm = gid * wgm, gsz = (nM - fm) < wgm ? (nM - fm) : wgm;
        u.pm = fm + ((wgid % nig) % gsz); u.pn = (wgid % nig) / gsz; u.pz = 0; return true;
    }
    __device__ __forceinline__ void a_ready(const Unit&) const {}
    __device__ __forceinline__ void done(const Unit&) const {}
    __device__ __forceinline__ int pre_epi(int, int, int) const { return 0; }
    __device__ __forceinline__ void post_epi(int, int, int, int) const {}
};

struct DynOrder {
    int nM, nN, q, home, rot, wgm; unsigned* ctr; volatile PG8_LAS int* tk;
    __device__ __forceinline__ void init(int M, int N, unsigned* ctr_, volatile PG8_LAS int* tk_, int home_, int rot_ = 0, int wgm_ = WGM) { nM = M / BM; nN = N / BM; q = (nM * nN) / NXCD; ctr = ctr_; tk = tk_; home = home_; rot = rot_; wgm = wgm_; }
    __device__ __forceinline__ int fetch() const {
        for (int k = 0; k < NXCD; ++k) { const int y = (home + k) & (NXCD - 1); const unsigned t = __hip_atomic_fetch_add(ctr + 64 * y, 1u, __ATOMIC_RELAXED, __HIP_MEMORY_SCOPE_AGENT); if (t < (unsigned)q) return y * q + (int)t; }
        return -1; }
    __device__ __forceinline__ void start(int wid, int lane) const {
        if (wid == 0 && lane == 0) { const int a = fetch(); const int b = (a >= 0) ? fetch() : -1; tk[0] = a; tk[1] = b; }
        __syncthreads(); }
    __device__ __forceinline__ bool next(int i, Unit& u) const {
        const int wgid = tk[i & 3]; if (wgid < 0) return false;
        const int nig = wgm * nN, gid = wgid / nig, fm = gid * wgm, gsz = (nM - fm) < wgm ? (nM - fm) : wgm;
        u.pm = fm + ((wgid % nig) % gsz); u.pn = ((wgid % nig) / gsz + (wgid / q) * rot) % nN; u.pz = 0; return true; }
    __device__ __forceinline__ void a_ready(const Unit&) const {}
    __device__ __forceinline__ void done(const Unit&) const {}
    __device__ __forceinline__ int pre_epi(int, int wid, int lane) const { int t = 0; if (wid == 0 && lane == 0) t = (int)__hip_atomic_fetch_add(ctr + 64 * (home & (NXCD - 1)), 1u, __ATOMIC_RELAXED, __HIP_MEMORY_SCOPE_AGENT); return t; }
    __device__ __forceinline__ void post_epi(int ui, int wid, int lane, int t) const {
        if (wid == 0 && lane == 0) { int w = -1;
            if ((unsigned)t < (unsigned)q) w = (home & (NXCD - 1)) * q + t;
            else for (int k = 1; k < NXCD; ++k) { const int y = (home + k) & (NXCD - 1); const unsigned s = __hip_atomic_fetch_add(ctr + 64 * y, 1u, __ATOMIC_RELAXED, __HIP_MEMORY_SCOPE_AGENT); if (s < (unsigned)q) { w = y * q + (int)s; break; } }
            tk[(ui + 2) & 3] = w; } }
};

__device__ __forceinline__ unsigned cvt_pk_bf16(float lo, float hi) { unsigned r; asm volatile("v_cvt_pk_bf16_f32 %0, %1, %2" : "=v"(r) : "v"(lo), "v"(hi)); return r; }

struct EpiMixIn {
    static constexpr bool PERM = true, AFTER_DRAIN = false;
    bf16_t* base; size_t tstride; const float* rope; int pn_off;
    __device__ __forceinline__ void operator()(const f32x4 (&acc)[2][2][4][2], const Unit& u, int wr, int wc, int fr, int fq) const {
        const int t = (u.pn + pn_off) >> 3; const bool rp = (t == 1) || (t == 2);
        bf16_t* ob = base + (size_t)t * tstride;
        const int row0 = u.pm * BM + wr * 64 + fr, col0 = (u.pn & 7) * BM + wc * 32 + 8 * fq;
#pragma unroll
        for (int ai = 0; ai < 2; ++ai)
#pragma unroll
            for (int m = 0; m < 4; ++m) {
                const int row = row0 + ai * HALF + m * 16; bf16_t* rowp = ob + (size_t)row * 2048 + col0;
                f32x4 cs0 = (f32x4){1.f, 0.f, 1.f, 0.f}, cs1 = cs0;
                if (rp) { const f32x4* tp = (const f32x4*)(rope + ((size_t)(row & 8191) * 64 + wc * 16 + fq * 4) * 2); cs0 = tp[0]; cs1 = tp[1]; }
#pragma unroll
                for (int bj = 0; bj < 2; ++bj) {
                    const f32x4 v0 = acc[ai][bj][m][0], v1 = acc[ai][bj][m][1];
                    const float a0 = v0[0] * cs0[0] - v0[1] * cs0[1], a1 = v0[1] * cs0[0] + v0[0] * cs0[1];
                    const float a2 = v0[2] * cs0[2] - v0[3] * cs0[3], a3 = v0[3] * cs0[2] + v0[2] * cs0[3];
                    const float b0 = v1[0] * cs1[0] - v1[1] * cs1[1], b1 = v1[1] * cs1[0] + v1[0] * cs1[1];
                    const float b2 = v1[2] * cs1[2] - v1[3] * cs1[3], b3 = v1[3] * cs1[2] + v1[2] * cs1[3];
                    u32x4 w; w.x = cvt_pk_bf16(a0, a1); w.y = cvt_pk_bf16(a2, a3); w.z = cvt_pk_bf16(b0, b1); w.w = cvt_pk_bf16(b2, b3);
                    *(u32x4*)(rowp + bj * HALF) = w;
                }
            }
    }
};
struct EpiMix8 {
    static constexpr bool PERM = true, AFTER_DRAIN = false;
    bf16_t* base; size_t tstride; const float* sx; const float* sb; int t0, t1; const float* rope;
    __device__ __forceinline__ f32x4 cv(const f32x4& a) const { return __builtin_convertvector(__builtin_bit_cast(i32x4, a), f32x4); }
    __device__ __forceinline__ void operator()(const f32x4 (&acc)[2][2][4][2], const Unit& u, int wr, int wc, int fr, int fq) const {
        const int t = (u.pn >> 3) ? t1 : t0; const bool rp = (t == 2);
        bf16_t* ob = base + (size_t)t * tstride;
        const int row0 = u.pm * BM + wr * 64 + fr, col0 = (u.pn & 7) * BM + wc * 32 + 8 * fq, n0 = u.pn * BM + wc * 32 + 8 * fq;
        f32x4 c[2][2];
#pragma unroll
        for (int bj = 0; bj < 2; ++bj) { c[bj][0] = *(const f32x4*)(sb + n0 + bj * HALF); c[bj][1] = *(const f32x4*)(sb + n0 + bj * HALF + 4); }
#pragma unroll
        for (int ai = 0; ai < 2; ++ai)
#pragma unroll
            for (int m = 0; m < 4; ++m) { const int row = row0 + ai * HALF + m * 16; bf16_t* rowp = ob + (size_t)row * 2048 + col0; const float sr = sx[row];
                f32x4 cs0 = (f32x4){1.f, 0.f, 1.f, 0.f}, cs1 = cs0;
                if (rp) { const f32x4* tp = (const f32x4*)(rope + ((size_t)(row & 8191) * 64 + wc * 16 + fq * 4) * 2); cs0 = tp[0]; cs1 = tp[1]; }
#pragma unroll
                for (int bj = 0; bj < 2; ++bj) { const f32x4 v0 = cv(acc[ai][bj][m][0]) * (c[bj][0] * sr), v1 = cv(acc[ai][bj][m][1]) * (c[bj][1] * sr);
                    const float a0 = v0[0] * cs0[0] - v0[1] * cs0[1], a1 = v0[1] * cs0[0] + v0[0] * cs0[1];
                    const float a2 = v0[2] * cs0[2] - v0[3] * cs0[3], a3 = v0[3] * cs0[2] + v0[2] * cs0[3];
                    const float b0 = v1[0] * cs1[0] - v1[1] * cs1[1], b1 = v1[1] * cs1[0] + v1[0] * cs1[1];
                    const float b2 = v1[2] * cs1[2] - v1[3] * cs1[3], b3 = v1[3] * cs1[2] + v1[2] * cs1[3];
                    u32x4 w; w.x = cvt_pk_bf16(a0, a1); w.y = cvt_pk_bf16(a2, a3); w.z = cvt_pk_bf16(b0, b1); w.w = cvt_pk_bf16(b2, b3);
                    *(u32x4*)(rowp + bj * HALF) = w; } }
    }
};
struct EpiStore {
    static constexpr bool PERM = true, AFTER_DRAIN = false;
    bf16_t* O; int ldc, coff;
    __device__ __forceinline__ void operator()(const f32x4 (&acc)[2][2][4][2], const Unit& u, int wr, int wc, int fr, int fq) const {
        const int row0 = u.pm * BM + wr * 64 + fr, col0 = coff + u.pn * BM + wc * 32 + 8 * fq;
#pragma unroll
        for (int ai = 0; ai < 2; ++ai)
#pragma unroll
            for (int m = 0; m < 4; ++m) { bf16_t* rowp = O + (size_t)(row0 + ai * HALF + m * 16) * ldc + col0;
#pragma unroll
                for (int bj = 0; bj < 2; ++bj) { const f32x4 v0 = acc[ai][bj][m][0], v1 = acc[ai][bj][m][1];
                    u32x4 w; w.x = cvt_pk_bf16(v0[0], v0[1]); w.y = cvt_pk_bf16(v0[2], v0[3]); w.z = cvt_pk_bf16(v1[0], v1[1]); w.w = cvt_pk_bf16(v1[2], v1[3]);
                    *(u32x4*)(rowp + bj * HALF) = w; } }
    }
};
__device__ __forceinline__ void row_stat_acc(const u32x4& w, float& s, float& q) {
    const float a0 = __builtin_bit_cast(float, w.x << 16), a1 = __builtin_bit_cast(float, w.x & 0xffff0000u), a2 = __builtin_bit_cast(float, w.y << 16), a3 = __builtin_bit_cast(float, w.y & 0xffff0000u);
    const float a4 = __builtin_bit_cast(float, w.z << 16), a5 = __builtin_bit_cast(float, w.z & 0xffff0000u), a6 = __builtin_bit_cast(float, w.w << 16), a7 = __builtin_bit_cast(float, w.w & 0xffff0000u);
    s += ((a0 + a1) + (a2 + a3)) + ((a4 + a5) + (a6 + a7));
    q += ((a0 * a0 + a1 * a1) + (a2 * a2 + a3 * a3)) + ((a4 * a4 + a5 * a5) + (a6 * a6 + a7 * a7));
}
__device__ __forceinline__ void row_stat_store(f32x2* slots, int row, int slot, int fq, float s, float q) {
    s += __shfl_xor(s, 16); q += __shfl_xor(q, 16); s += __shfl_xor(s, 32); q += __shfl_xor(q, 32);
    if (fq == 0) slots[(size_t)row * 64 + slot] = (f32x2){s, q};
}
struct EpiResid {
    static constexpr bool PERM = true, AFTER_DRAIN = false;
    const float* res; bf16_t* out; int ldc; float alpha; f32x2* slots;
    __device__ __forceinline__ void operator()(const f32x4 (&acc)[2][2][4][2], const Unit& u, int wr, int wc, int fr, int fq) const {
        const int row0 = u.pm * BM + wr * 64 + fr, col0 = u.pn * BM + wc * 32 + 8 * fq;
#pragma unroll
        for (int ai = 0; ai < 2; ++ai)
#pragma unroll
            for (int m = 0; m < 4; ++m) { const size_t off = (size_t)(row0 + ai * HALF + m * 16) * ldc + col0; float ss = 0.f, qq = 0.f;
#pragma unroll
                for (int bj = 0; bj < 2; ++bj) { const f32x4 r0 = *(const f32x4*)(res + off + bj * HALF), r1 = *(const f32x4*)(res + off + bj * HALF + 4);
                    const f32x4 v0 = r0 * alpha + acc[ai][bj][m][0], v1 = r1 * alpha + acc[ai][bj][m][1];
                    u32x4 w; w.x = cvt_pk_bf16(v0[0], v0[1]); w.y = cvt_pk_bf16(v0[2], v0[3]); w.z = cvt_pk_bf16(v1[0], v1[1]); w.w = cvt_pk_bf16(v1[2], v1[3]);
                    *(u32x4*)(out + off + bj * HALF) = w; row_stat_acc(w, ss, qq); }
                row_stat_store(slots, row0 + ai * HALF + m * 16, u.pn * 4 + wc, fq, ss, qq);
                if (m == 3) asm volatile("" ::: "memory"); }
    }
};
struct EpiSwiGLU {
    static constexpr bool PERM = true, AFTER_DRAIN = false;
    bf16_t* G; int ldc; const f32x2* stats; const float* c1; const float* c2;
    __device__ __forceinline__ float act(float g, float u) const { return g * u * __builtin_amdgcn_rcpf(1.0f + __builtin_amdgcn_exp2f(-1.4426950408889634f * g)); }
    __device__ __forceinline__ void operator()(const f32x4 (&acc)[2][2][4][2], const Unit& u, int wr, int wc, int fr, int fq) const {
        const int row0 = u.pm * BM + wr * 64 + fr, col0 = u.pn * HALF + wc * 32 + 8 * fq, n0 = u.pn * BM + wc * 32 + 8 * fq;
        const f32x4 cg0 = *(const f32x4*)(c1 + n0), cg1 = *(const f32x4*)(c1 + n0 + 4), cu0 = *(const f32x4*)(c1 + n0 + HALF), cu1 = *(const f32x4*)(c1 + n0 + HALF + 4);
        const f32x4 dg0 = *(const f32x4*)(c2 + n0), dg1 = *(const f32x4*)(c2 + n0 + 4), du0 = *(const f32x4*)(c2 + n0 + HALF), du1 = *(const f32x4*)(c2 + n0 + HALF + 4);
#pragma unroll
        for (int ai = 0; ai < 2; ++ai)
#pragma unroll
            for (int m = 0; m < 4; ++m) { const int row = row0 + ai * HALF + m * 16; bf16_t* rowp = G + (size_t)row * ldc + col0; const f32x2 st = stats[row];
                const f32x4 g0 = (acc[ai][0][m][0] - cg0 * st.x) * st.y + dg0, g1 = (acc[ai][0][m][1] - cg1 * st.x) * st.y + dg1;
                const f32x4 u0 = (acc[ai][1][m][0] - cu0 * st.x) * st.y + du0, u1 = (acc[ai][1][m][1] - cu1 * st.x) * st.y + du1;
                u32x4 w; w.x = cvt_pk_bf16(act(g0[0], u0[0]), act(g0[1], u0[1])); w.y = cvt_pk_bf16(act(g0[2], u0[2]), act(g0[3], u0[3]));
                w.z = cvt_pk_bf16(act(g1[0], u1[0]), act(g1[1], u1[1])); w.w = cvt_pk_bf16(act(g1[2], u1[2]), act(g1[3], u1[3]));
                *(u32x4*)rowp = w; }
    }
};
struct EpiSwiGLU8 {
    static constexpr bool PERM = true, AFTER_DRAIN = false;
    bf16_t* G; int ldc; const float* sa; const float* sb;
    __device__ __forceinline__ float act(float g, float u) const { return g * u * __builtin_amdgcn_rcpf(1.0f + __builtin_amdgcn_exp2f(-1.4426950408889634f * g)); }
    __device__ __forceinline__ f32x4 cv(const f32x4& a) const { return __builtin_convertvector(__builtin_bit_cast(i32x4, a), f32x4); }
    __device__ __forceinline__ void operator()(const f32x4 (&acc)[2][2][4][2], const Unit& u, int wr, int wc, int fr, int fq) const {
        const int row0 = u.pm * BM + wr * 64 + fr, col0 = u.pn * HALF + wc * 32 + 8 * fq, n0 = u.pn * BM + wc * 32 + 8 * fq;
        const f32x4 cg0 = *(const f32x4*)(sb + n0), cg1 = *(const f32x4*)(sb + n0 + 4), cu0 = *(const f32x4*)(sb + n0 + HALF), cu1 = *(const f32x4*)(sb + n0 + HALF + 4);
#pragma unroll
        for (int ai = 0; ai < 2; ++ai)
#pragma unroll
            for (int m = 0; m < 4; ++m) { const int row = row0 + ai * HALF + m * 16; bf16_t* rowp = G + (size_t)row * ldc + col0; const float s = sa[row];
                const f32x4 g0 = cv(acc[ai][0][m][0]) * (cg0 * s), g1 = cv(acc[ai][0][m][1]) * (cg1 * s);
                const f32x4 u0 = cv(acc[ai][1][m][0]) * (cu0 * s), u1 = cv(acc[ai][1][m][1]) * (cu1 * s);
                u32x4 w; w.x = cvt_pk_bf16(act(g0[0], u0[0]), act(g0[1], u0[1])); w.y = cvt_pk_bf16(act(g0[2], u0[2]), act(g0[3], u0[3]));
                w.z = cvt_pk_bf16(act(g1[0], u1[0]), act(g1[1], u1[1])); w.w = cvt_pk_bf16(act(g1[2], u1[2]), act(g1[3], u1[3]));
                *(u32x4*)rowp = w; }
    }
};
struct EpiSoftmax {
    static constexpr bool PERM = true, AFTER_DRAIN = true;
    bf16_t* P; int ldc; float c2; const f32x2* stats; const float* k1; const float* k2;
    __device__ __forceinline__ void fused(f32x4 (&acc)[2][2][4][2], const Unit& u, int wr, int wc, int fr, int fq, PG8_LAS unsigned char* lds, int wid, int lane) const {
        PG8_LAS float* T1 = (PG8_LAS float*)lds;
        PG8_LAS float* T2 = (PG8_LAS float*)(lds + 4096);
        { const int nb = (u.pm >> 5) * 1024 + u.pn * BM + wc * 32 + 8 * fq;
          f32x4 ka[2][2], kb[2][2];
#pragma unroll
          for (int bj = 0; bj < 2; ++bj)
#pragma unroll
              for (int n = 0; n < 2; ++n) { ka[bj][n] = *(const f32x4*)(k1 + nb + bj * HALF + 4 * n); kb[bj][n] = *(const f32x4*)(k2 + nb + bj * HALF + 4 * n); }
#pragma unroll
          for (int ai = 0; ai < 2; ++ai)
#pragma unroll
              for (int m = 0; m < 4; ++m) { const f32x2 st = stats[u.pm * BM + ai * HALF + wr * 64 + m * 16 + fr];
#pragma unroll
                  for (int bj = 0; bj < 2; ++bj)
#pragma unroll
                      for (int n = 0; n < 2; ++n) acc[ai][bj][m][n] = (acc[ai][bj][m][n] - ka[bj][n] * st.x) * st.y + kb[bj][n]; } }
#pragma unroll
        for (int ai = 0; ai < 2; ++ai)
#pragma unroll
            for (int m = 0; m < 4; ++m) { float mx = -3.0e38f;
#pragma unroll
                for (int bj = 0; bj < 2; ++bj)
#pragma unroll
                    for (int n = 0; n < 2; ++n) { const f32x4 x = acc[ai][bj][m][n]; mx = fmaxf(mx, fmaxf(fmaxf(x[0], x[1]), fmaxf(x[2], x[3]))); }
                mx = fmaxf(mx, __shfl_xor(mx, 16)); mx = fmaxf(mx, __shfl_xor(mx, 32));
                if (fq == 0) T1[(ai * HALF + wr * 64 + m * 16 + fr) * 4 + wc] = mx; }
        asm volatile("s_waitcnt lgkmcnt(0)" ::: "memory"); __builtin_amdgcn_s_barrier(); asm volatile("" ::: "memory");
#pragma unroll
        for (int ai = 0; ai < 2; ++ai)
#pragma unroll
            for (int m = 0; m < 4; ++m) { const int r = ai * HALF + wr * 64 + m * 16 + fr;
                const f32x4 t = *(const PG8_LAS f32x4*)(T1 + r * 4); const float mx = fmaxf(fmaxf(t[0], t[1]), fmaxf(t[2], t[3])) * c2; float s = 0.f;
#pragma unroll
                for (int bj = 0; bj < 2; ++bj)
#pragma unroll
                    for (int n = 0; n < 2; ++n) { f32x4 x = acc[ai][bj][m][n];
#pragma unroll
                        for (int e = 0; e < 4; ++e) { x[e] = __builtin_amdgcn_exp2f(x[e] * c2 - mx); s += x[e]; }
                        acc[ai][bj][m][n] = x; }
                s += __shfl_xor(s, 16); s += __shfl_xor(s, 32);
                if (fq == 0) T2[r * 4 + wc] = s; }
        asm volatile("s_waitcnt lgkmcnt(0)" ::: "memory"); __builtin_amdgcn_s_barrier(); asm volatile("" ::: "memory");
        const int row0 = u.pm * BM + wr * 64 + fr, col0 = u.pn * BM + wc * 32 + 8 * fq;
#pragma unroll
        for (int ai = 0; ai < 2; ++ai)
#pragma unroll
            for (int m = 0; m < 4; ++m) { const int r = ai * HALF + wr * 64 + m * 16 + fr;
                const f32x4 t = *(const PG8_LAS f32x4*)(T2 + r * 4); const float inv = 1.0f / ((t[0] + t[1]) + (t[2] + t[3]));
                bf16_t* rowp = P + (size_t)(row0 + ai * HALF + m * 16) * ldc + col0;
#pragma unroll
                for (int bj = 0; bj < 2; ++bj) { const f32x4 v0 = acc[ai][bj][m][0] * inv, v1 = acc[ai][bj][m][1] * inv;
                    u32x4 w; w.x = cvt_pk_bf16(v0[0], v0[1]); w.y = cvt_pk_bf16(v0[2], v0[3]); w.z = cvt_pk_bf16(v1[0], v1[1]); w.w = cvt_pk_bf16(v1[2], v1[3]);
                    *(u32x4*)(rowp + bj * HALF) = w; } }
    }
};

struct GemmKV {
    const char* memb; const char* wkv; int lda, ldb, K;
    __device__ __forceinline__ const char* a_ptr(const Unit& u) const { return memb + (size_t)u.pm * (BM * 4096 * 2) + (size_t)u.pz * 2048; }
    __device__ __forceinline__ const char* b_ptr(const Unit& u) const { return wkv + (size_t)u.pn * (BM * 4096 * 2) + (size_t)u.pz * 2048; }
};
struct OrderKV {
    int G, c;
    __device__ __forceinline__ bool next(int i, Unit& u) const { const int L = i * G + c; if (L >= 256) return false; const int tile = L >> 2; u.pz = L & 3; u.pm = tile >> 5; u.pn = tile & 31; return true; }
    __device__ __forceinline__ void a_ready(const Unit&) const {}
    __device__ __forceinline__ void done(const Unit&) const {}
    __device__ __forceinline__ int pre_epi(int, int, int) const { return 0; }
    __device__ __forceinline__ void post_epi(int, int, int, int) const {}
};
struct OrderOne {
    Unit u;
    __device__ __forceinline__ bool next(int i, Unit& o) const { if (i != 0) return false; o = u; return true; }
    __device__ __forceinline__ void a_ready(const Unit&) const {}
    __device__ __forceinline__ void done(const Unit&) const {}
    __device__ __forceinline__ int pre_epi(int, int, int) const { return 0; }
    __device__ __forceinline__ void post_epi(int, int, int, int) const {}
};
struct EpiSlabKV {
    static constexpr bool PERM = false, AFTER_DRAIN = false;
    float* S;
    __device__ __forceinline__ void operator()(const f32x4 (&acc)[2][2][4][2], const Unit& u, int wr, int wc, int fr, int fq) const {
        float* C = S + (size_t)u.pz * (512 * 8192);
        const int row0 = u.pm * BM + wr * 64 + fr, col0 = u.pn * BM + wc * 32 + 4 * fq;
#pragma unroll
        for (int ai = 0; ai < 2; ++ai)
#pragma unroll
            for (int m = 0; m < 4; ++m) { float* rowp = C + (size_t)(row0 + ai * HALF + m * 16) * 8192 + col0;
#pragma unroll
                for (int bj = 0; bj < 2; ++bj)
#pragma unroll
                    for (int n = 0; n < 2; ++n) *(f32x4*)(rowp + bj * HALF + n * 16) = acc[ai][bj][m][n]; }
    }
};
struct GemmAbs {
    const char* kvx; const char* wq_raw; const char* wo_t; int lda, ldb, K;
    __device__ __forceinline__ const char* a_ptr(const Unit& u) const {
        return u.pz ? wo_t + (size_t)u.pm * (BM * 4096 * 2) + (size_t)(u.pn & 3) * 2048
                    : kvx + (size_t)(u.pm >> 2) * (BM * 8192 * 2) + (size_t)(u.pm & 3) * 2048; }
    __device__ __forceinline__ const char* b_ptr(const Unit& u) const {
        return u.pz ? kvx + 8192 + (size_t)(u.pn >> 2) * (BM * 8192 * 2) + (size_t)(u.pn & 3) * 2048
                    : wq_raw + (size_t)u.pn * (BM * 4096 * 2) + (size_t)(u.pm & 3) * 2048; }
};
struct OrderAbs {
    int c;
    __device__ __forceinline__ bool next(int i, Unit& u) const { if (i != 0 || c >= 256) return false; if (c < 128) { u.pz = 0; u.pm = c >> 4; u.pn = c & 15; } else { const int t = c - 128; u.pz = 1; u.pm = t >> 3; u.pn = t & 7; } return true; }
    __device__ __forceinline__ void a_ready(const Unit&) const {}
    __device__ __forceinline__ void done(const Unit&) const {}
    __device__ __forceinline__ int pre_epi(int, int, int) const { return 0; }
    __device__ __forceinline__ void post_epi(int, int, int, int) const {}
};
struct EpiStoreAbs {
    static constexpr bool PERM = true, AFTER_DRAIN = false;
    bf16_t* WQK; bf16_t* WVOT; float* k1; float* k2;
    __device__ __forceinline__ void operator()(const f32x4 (&acc)[2][2][4][2], const Unit& u, int wr, int wc, int fr, int fq) const {
        bf16_t* O = u.pz ? WVOT : WQK; const int ldc = u.pz ? 2048 : 4096;
        const int row0 = u.pm * BM + wr * 64 + fr, col0 = u.pn * BM + wc * 32 + 8 * fq;
        f32x4 gv[2][2], bv[2][2];
#pragma unroll
        for (int bj = 0; bj < 2; ++bj)
#pragma unroll
            for (int n = 0; n < 2; ++n) { gv[bj][n] = (f32x4){1.f, 1.f, 1.f, 1.f}; bv[bj][n] = (f32x4){0.f, 0.f, 0.f, 0.f}; }
        if (!u.pz) { const float* const __attribute__((address_space(4)))* inp = (const float* const __attribute__((address_space(4)))*)__builtin_amdgcn_kernarg_segment_ptr();
            const float* g = inp[6]; const float* b = inp[7];
#pragma unroll
            for (int bj = 0; bj < 2; ++bj)
#pragma unroll
                for (int n = 0; n < 2; ++n) { gv[bj][n] = *(const f32x4*)(g + col0 + bj * HALF + 4 * n); bv[bj][n] = *(const f32x4*)(b + col0 + bj * HALF + 4 * n); } }
#pragma unroll
        for (int ai = 0; ai < 2; ++ai)
#pragma unroll
            for (int m = 0; m < 4; ++m) { const int row = row0 + ai * HALF + m * 16; bf16_t* rowp = O + (size_t)row * ldc + col0; float s1 = 0.f, s2 = 0.f, dummy = 0.f;
#pragma unroll
                for (int bj = 0; bj < 2; ++bj) { const f32x4 a0 = acc[ai][bj][m][0], a1 = acc[ai][bj][m][1], v0 = a0 * gv[bj][0], v1 = a1 * gv[bj][1];
                    u32x4 w; w.x = cvt_pk_bf16(v0[0], v0[1]); w.y = cvt_pk_bf16(v0[2], v0[3]); w.z = cvt_pk_bf16(v1[0], v1[1]); w.w = cvt_pk_bf16(v1[2], v1[3]);
                    *(u32x4*)(rowp + bj * HALF) = w; row_stat_acc(w, s1, dummy);
                    const f32x4 t0 = a0 * bv[bj][0], t1 = a1 * bv[bj][1]; s2 += ((t0[0] + t0[1]) + (t0[2] + t0[3])) + ((t1[0] + t1[1]) + (t1[2] + t1[3])); }
                if (!u.pz) { s1 += __shfl_xor(s1, 16); s2 += __shfl_xor(s2, 16); s1 += __shfl_xor(s1, 32); s2 += __shfl_xor(s2, 32);
                    if (fq == 0) { __hip_atomic_fetch_add(k1 + row, s1, __ATOMIC_RELAXED, __HIP_MEMORY_SCOPE_AGENT); __hip_atomic_fetch_add(k2 + row, s2, __ATOMIC_RELAXED, __HIP_MEMORY_SCOPE_AGENT); } } }
    }
};
struct EpiResidLN {
    static constexpr bool PERM = true, AFTER_DRAIN = false;
    bf16_t* T; const f32x2* stats; int gi; f32x2* slots;
    __device__ __forceinline__ void operator()(const f32x4 (&acc)[2][2][4][2], const Unit& u, int wr, int wc, int fr, int fq) const {
        constexpr int ldc = 4096; constexpr float alpha = 1.189207115002721f;
        const float* const __attribute__((address_space(4)))* inp = (const float* const __attribute__((address_space(4)))*)__builtin_amdgcn_kernarg_segment_ptr();
        const float* g = inp[gi]; const float* b = inp[gi + 1];
        const int row0 = u.pm * BM + wr * 64 + fr, col0 = u.pn * BM + wc * 32 + 8 * fq;
        f32x4 gv[2][2], bv[2][2];
#pragma unroll
        for (int bj = 0; bj < 2; ++bj)
#pragma unroll
            for (int n = 0; n < 2; ++n) { gv[bj][n] = *(const f32x4*)(g + col0 + bj * HALF + n * 4) * alpha; bv[bj][n] = *(const f32x4*)(b + col0 + bj * HALF + n * 4) * alpha; }
#pragma unroll
        for (int ai = 0; ai < 2; ++ai)
#pragma unroll
            for (int m = 0; m < 4; ++m) { const int row = row0 + ai * HALF + m * 16; const size_t off = (size_t)row * ldc + col0; const f32x2 st = stats[row]; float ss = 0.f, qq = 0.f;
#pragma unroll
                for (int bj = 0; bj < 2; ++bj) { const u32x4 r = *(const u32x4*)(T + off + bj * HALF);
                    const f32x4 t0 = (f32x4){__builtin_bit_cast(float, r.x << 16), __builtin_bit_cast(float, r.x & 0xffff0000u), __builtin_bit_cast(float, r.y << 16), __builtin_bit_cast(float, r.y & 0xffff0000u)};
                    const f32x4 t1 = (f32x4){__builtin_bit_cast(float, r.z << 16), __builtin_bit_cast(float, r.z & 0xffff0000u), __builtin_bit_cast(float, r.w << 16), __builtin_bit_cast(float, r.w & 0xffff0000u)};
                    const f32x4 v0 = ((t0 - st.x) * st.y) * gv[bj][0] + bv[bj][0] + acc[ai][bj][m][0], v1 = ((t1 - st.x) * st.y) * gv[bj][1] + bv[bj][1] + acc[ai][bj][m][1];
                    u32x4 w; w.x = cvt_pk_bf16(v0[0], v0[1]); w.y = cvt_pk_bf16(v0[2], v0[3]); w.z = cvt_pk_bf16(v1[0], v1[1]); w.w = cvt_pk_bf16(v1[2], v1[3]);
                    *(u32x4*)(T + off + bj * HALF) = w; row_stat_acc(w, ss, qq); }
                if (slots) row_stat_store(slots, row, u.pn * 4 + wc, fq, ss, qq);
                if (m == 3) asm volatile("" ::: "memory"); }
    }
};

template <class Epi, class Sched, bool ALIGN_EPI = false, bool SP2 = false, class GT = Gemm, bool I8 = false>
__device__ __forceinline__ void gemm_phase(PG8_LAS unsigned char* lds, const GT g, const Sched& S, const Epi& E) {
    const int tid = threadIdx.x, wid = __builtin_amdgcn_readfirstlane(tid >> 6), lane = tid & 63, wr = wid >> 2, wc = wid & 3, fr = lane & 15, fq = lane >> 4;
    const int K = g.K, nt = K / BK;
    unsigned voffA[2], voffB[2];
#pragma unroll
    for (int i = 0; i < 2; ++i) { int R, C; stage_rc(tid * 16 + i * 8192, R, C); const int Rb = Epi::PERM ? ((R & ~31) + perm32(R & 31)) : R;
        voffA[i] = (unsigned)(R * g.lda + C) * 2u; voffB[i] = (unsigned)(Rb * g.ldb + C) * 2u; }
    const size_t kstep = (size_t)(BK * 2);
    const size_t hA = (size_t)HALF * g.lda * 2, hB = (size_t)HALF * g.ldb * 2;
    const unsigned ldsw = (unsigned)wid * 1024u;
    const int aoff = lds_byte(wr * 64 + fr, fq * 8), boff = lds_byte(wc * 32 + fr, fq * 8);
#define PG8_SA(b, h) (((b) * 2 + (h)) * HTB)
#define PG8_SB(b, h) ((4 + (b) * 2 + (h)) * HTB)
#define PG8_STAGE(bufoff, gbase, voff) do { _Pragma("unroll") for (int _i = 0; _i < 2; ++_i) \
        __builtin_amdgcn_global_load_lds((const unsigned*)((const char*)(gbase) + (voff)[_i]), (PG8_LAS unsigned*)(lds + (bufoff) + ldsw + _i * 8192), 16, 0, 0); } while (0)
#define PG8_LDA(dst, b, h) do { _Pragma("unroll") for (int m = 0; m < 4; ++m) _Pragma("unroll") for (int k = 0; k < 2; ++k) dst[m][k] = *(const PG8_LAS bf16x8*)(lds + PG8_SA(b, h) + aoff + m * 2048 + k * 1024); } while (0)
#define PG8_LDB(dst, b, h) do { _Pragma("unroll") for (int n = 0; n < 2; ++n) _Pragma("unroll") for (int k = 0; k < 2; ++k) dst[n][k] = *(const PG8_LAS bf16x8*)(lds + PG8_SB(b, h) + boff + n * 2048 + k * 1024); } while (0)
#define PG8_MMA(ai, bj, At, Bt) do { __builtin_amdgcn_s_setprio(1); _Pragma("unroll") for (int m = 0; m < 4; ++m) _Pragma("unroll") for (int n = 0; n < 2; ++n) _Pragma("unroll") for (int k = 0; k < 2; ++k) \
        { if constexpr (I8) acc[ai][bj][m][n] = __builtin_bit_cast(f32x4, __builtin_amdgcn_mfma_i32_16x16x64_i8(__builtin_bit_cast(i32x4, Bt[n][k]), __builtin_bit_cast(i32x4, At[m][k]), __builtin_bit_cast(i32x4, acc[ai][bj][m][n]), 0, 0, 0)); \
          else acc[ai][bj][m][n] = __builtin_amdgcn_mfma_f32_16x16x32_bf16(Bt[n][k], At[m][k], acc[ai][bj][m][n], 0, 0, 0); } __builtin_amdgcn_s_setprio(0); } while (0)
#define PG8_WAIT_V(n) asm volatile("s_waitcnt vmcnt(" #n ")" ::: "memory")
#define PG8_WAIT_L(n) asm volatile("s_waitcnt lgkmcnt(" #n ")" ::: "memory")
#define PG8_BAR __builtin_amdgcn_s_barrier()
#define PG8_SCHED __builtin_amdgcn_sched_barrier(0)
    Unit cur, nxt; int ui = 0;
    if (!S.next(0, cur)) return;
    f32x4 acc[2][2][4][2];
#pragma unroll
    for (int a = 0; a < 2; ++a)
#pragma unroll
        for (int b = 0; b < 2; ++b)
#pragma unroll
            for (int m = 0; m < 4; ++m)
#pragma unroll
                for (int n = 0; n < 2; ++n) acc[a][b][m][n] = (f32x4){0.f, 0.f, 0.f, 0.f};
    bf16x8 At[4][2], B0[2][2], B1[2][2];
    const char* cA = g.a_ptr(cur); const char* cB = g.b_ptr(cur);
    S.a_ready(cur);
    if constexpr (SP2) {
        PG8_STAGE(PG8_SB(0, 0), cB, voffB); PG8_STAGE(PG8_SB(0, 1), cB + hB, voffB); PG8_STAGE(PG8_SA(0, 0), cA, voffA); PG8_STAGE(PG8_SA(0, 1), cA + hA, voffA);
        if (wr == 1) PG8_BAR;
        PG8_WAIT_V(2); PG8_BAR;
        PG8_STAGE(PG8_SB(1, 0), cB + kstep, voffB); PG8_STAGE(PG8_SA(1, 0), cA + kstep, voffA); PG8_STAGE(PG8_SB(1, 1), cB + hB + kstep, voffB);
        PG8_WAIT_V(6); PG8_BAR;
    } else {
        PG8_STAGE(PG8_SB(0, 0), cB, voffB); PG8_STAGE(PG8_SA(0, 0), cA, voffA); PG8_STAGE(PG8_SB(0, 1), cB + hB, voffB); PG8_STAGE(PG8_SA(0, 1), cA + hA, voffA);
        if (wr == 1) PG8_BAR;
        PG8_WAIT_V(4); PG8_BAR;
        PG8_STAGE(PG8_SB(1, 0), cB + kstep, voffB); PG8_STAGE(PG8_SA(1, 0), cA + kstep, voffA); PG8_STAGE(PG8_SB(1, 1), cB + hB + kstep, voffB);
        PG8_WAIT_V(6); PG8_BAR;
    }
    for (;;) {
        bool has_next = false;
        const char* nA = cA; const char* nB = cB;
        for (int t = 0; t < nt; t += 2) {
            const bool last = (t == nt - 2);
            if (last) { has_next = S.next(ui + 1, nxt); if (has_next) { nA = g.a_ptr(nxt); nB = g.b_ptr(nxt); S.a_ready(nxt); } }
            const char* a1 = cA + (size_t)(t + 1) * kstep;
            const char* a2 = last ? nA : cA + (size_t)(t + 2) * kstep; const char* b2 = last ? nB : cB + (size_t)(t + 2) * kstep;
            const char* a3 = a2 + kstep; const char* b3 = b2 + kstep;
            if constexpr (SP2) {
            PG8_LDB(B0, 0, 0); PG8_LDB(B1, 0, 1); PG8_SCHED; PG8_LDA(At, 0, 0); PG8_STAGE(PG8_SA(1, 1), a1 + hA, voffA);
            PG8_WAIT_V(8); PG8_WAIT_L(0); PG8_BAR; PG8_MMA(0, 0, At, B0); PG8_MMA(0, 1, At, B1); PG8_BAR; PG8_SCHED;
            PG8_LDA(At, 0, 1); PG8_STAGE(PG8_SB(0, 0), b2, voffB); PG8_STAGE(PG8_SB(0, 1), b2 + hB, voffB); PG8_STAGE(PG8_SA(0, 0), a2, voffA);
            PG8_WAIT_V(8); PG8_WAIT_L(0); PG8_BAR; PG8_MMA(1, 0, At, B0); PG8_MMA(1, 1, At, B1); PG8_BAR; PG8_SCHED;
            PG8_LDB(B0, 1, 0); PG8_LDB(B1, 1, 1); PG8_SCHED; PG8_LDA(At, 1, 0); PG8_STAGE(PG8_SA(0, 1), a2 + hA, voffA);
            PG8_WAIT_V(8); PG8_WAIT_L(0); PG8_BAR; PG8_MMA(0, 0, At, B0); PG8_MMA(0, 1, At, B1); PG8_BAR; PG8_SCHED;
            PG8_LDA(At, 1, 1); PG8_STAGE(PG8_SB(1, 0), b3, voffB); PG8_STAGE(PG8_SB(1, 1), b3 + hB, voffB); PG8_STAGE(PG8_SA(1, 0), a3, voffA);
            PG8_WAIT_V(8); PG8_WAIT_L(0); PG8_BAR; PG8_MMA(1, 0, At, B0); PG8_MMA(1, 1, At, B1); PG8_BAR; PG8_SCHED;
            } else {
            PG8_LDB(B0, 0, 0); PG8_SCHED; PG8_LDA(At, 0, 0); PG8_STAGE(PG8_SA(1, 1), a1 + hA, voffA);
            PG8_WAIT_L(8); PG8_BAR; PG8_WAIT_L(0); PG8_MMA(0, 0, At, B0); PG8_BAR; PG8_SCHED;
            PG8_LDB(B1, 0, 1); PG8_STAGE(PG8_SB(0, 0), b2, voffB);
            PG8_BAR; PG8_WAIT_L(0); PG8_MMA(0, 1, At, B1); PG8_BAR;
            PG8_LDA(At, 0, 1); PG8_STAGE(PG8_SA(0, 0), a2, voffA);
            PG8_BAR; PG8_WAIT_L(0); PG8_MMA(1, 0, At, B0); PG8_BAR; PG8_SCHED;
            PG8_STAGE(PG8_SB(0, 1), b2 + hB, voffB);
            PG8_WAIT_V(6); PG8_BAR; PG8_MMA(1, 1, At, B1); PG8_BAR;
            PG8_LDB(B0, 1, 0); PG8_SCHED; PG8_LDA(At, 1, 0); PG8_STAGE(PG8_SA(0, 1), a2 + hA, voffA);
            PG8_WAIT_L(8); PG8_BAR; PG8_WAIT_L(0); PG8_MMA(0, 0, At, B0); PG8_BAR; PG8_SCHED;
            PG8_LDB(B1, 1, 1); PG8_STAGE(PG8_SB(1, 0), b3, voffB);
            PG8_BAR; PG8_WAIT_L(0); PG8_MMA(0, 1, At, B1); PG8_BAR;
            PG8_LDA(At, 1, 1); PG8_STAGE(PG8_SA(1, 0), a3, voffA);
            PG8_BAR; PG8_WAIT_L(0); PG8_MMA(1, 0, At, B0); PG8_BAR; PG8_SCHED;
            PG8_STAGE(PG8_SB(1, 1), b3 + hB, voffB);
            PG8_WAIT_V(6); PG8_BAR; PG8_MMA(1, 1, At, B1); PG8_BAR;
            }
        }
        if constexpr (ALIGN_EPI) { if (wr == 0) PG8_BAR; }
        if constexpr (!Epi::AFTER_DRAIN) { const int tk_ = S.pre_epi(ui, wid, lane); E(acc, cur, wr, wc, fr, fq); S.post_epi(ui, wid, lane, tk_); S.done(cur); }
        if (!has_next) break;
#pragma unroll
        for (int a = 0; a < 2; ++a)
#pragma unroll
            for (int b = 0; b < 2; ++b)
#pragma unroll
                for (int m = 0; m < 4; ++m)
#pragma unroll
                    for (int n = 0; n < 2; ++n) acc[a][b][m][n] = (f32x4){0.f, 0.f, 0.f, 0.f};
        cur = nxt; cA = nA; cB = nB; ++ui;
        if constexpr (ALIGN_EPI) { if (wr == 1) PG8_BAR; }
    }
    PG8_WAIT_V(0);
    if constexpr (!ALIGN_EPI) { if (wr == 0) PG8_BAR; }
    PG8_BAR;
    if constexpr (Epi::AFTER_DRAIN) { E.fused(acc, cur, wr, wc, fr, fq, lds, wid, lane); S.done(cur); }
#undef PG8_SA
#undef PG8_SB
#undef PG8_STAGE
#undef PG8_LDA
#undef PG8_LDB
#undef PG8_MMA
#undef PG8_WAIT_V
#undef PG8_WAIT_L
#undef PG8_BAR
#undef PG8_SCHED
}
}

namespace att {
using bf16_t = unsigned short;
using bf16x8 = __attribute__((ext_vector_type(8))) short;
using s16x4  = __attribute__((ext_vector_type(4))) short;
using f32x16 = __attribute__((ext_vector_type(16))) float;
using u32x4  = __attribute__((ext_vector_type(4))) unsigned;
using u32x2  = __attribute__((ext_vector_type(2))) unsigned;
constexpr int   D = 128, NW = 8, QBLK = 32, KVBLK = 64, NT = 4;
constexpr float SCALE = 0.088388347648318440f;
constexpr float THR = 8.f;
constexpr int   LDQ = 2048, LDK = 2048;
constexpr size_t SHM_V = KVBLK * D * 2, SHM_K = KVBLK * D * 2, SHM_ATTN = 2 * SHM_V + 2 * SHM_K;
#define KSWZ(row, colB) ((row) * 256 + ((colB) ^ (((row) & 7) << 4)))
#define SBAR() __builtin_amdgcn_sched_barrier(0)
__device__ __forceinline__ int crow(int r, int hi) { return (r & 3) + 8 * (r >> 2) + 4 * hi; }
__device__ __forceinline__ unsigned cvtpk(float lo, float hi) { unsigned r; asm volatile("v_cvt_pk_bf16_f32 %0, %1, %2" : "=v"(r) : "v"(lo), "v"(hi)); return r; }

__device__ __forceinline__ void partialSM(f32x16& p0, f32x16& p1, float& m_reg, float& mn, float& alpha) {
  constexpr float C = SCALE * 1.4426950408889634f;
  float pmax = p0[0];
#pragma unroll
  for (int r = 1; r < 16; ++r) pmax = fmaxf(pmax, p0[r]);
#pragma unroll
  for (int r = 0; r < 16; ++r) pmax = fmaxf(pmax, p1[r]);
  { auto rr = __builtin_amdgcn_permlane32_swap(__float_as_uint(pmax), __float_as_uint(pmax), false, false);
    pmax = fmaxf(__uint_as_float(rr[0]), __uint_as_float(rr[1])); }
  if (__builtin_expect(__all(pmax - m_reg <= THR / SCALE), 1)) { mn = m_reg; alpha = 1.f; }
  else { mn = fmaxf(m_reg, pmax); alpha = __builtin_amdgcn_exp2f((m_reg - mn) * C); m_reg = mn; }
  float mnC = -mn * C;
#pragma unroll
  for (int r = 0; r < 16; ++r) p0[r] = fmaf(p0[r], C, mnC);
#pragma unroll
  for (int r = 0; r < 16; ++r) p1[r] = fmaf(p1[r], C, mnC);
#pragma unroll
  for (int r = 0; r < 16; ++r) p0[r] = __builtin_amdgcn_exp2f(p0[r]);
}
__device__ __forceinline__ void finishSM(f32x16& p0, f32x16& p1, float alpha, float& l_reg, bf16x8& pa0, bf16x8& pa1, bf16x8& pa2, bf16x8& pa3) {
#pragma unroll
  for (int r = 0; r < 16; ++r) p1[r] = __builtin_amdgcn_exp2f(p1[r]);
  float ps = 0;
#pragma unroll
  for (int r = 0; r < 16; ++r) ps += p0[r];
#pragma unroll
  for (int r = 0; r < 16; ++r) ps += p1[r];
  { auto rr = __builtin_amdgcn_permlane32_swap(__float_as_uint(ps), __float_as_uint(ps), false, false);
    ps = __uint_as_float(rr[0]) + __uint_as_float(rr[1]); }
  l_reg = l_reg * alpha + ps;
#define PK4(P, BASE, OUT) do { unsigned a0 = cvtpk(P[BASE + 0], P[BASE + 1]), a1 = cvtpk(P[BASE + 2], P[BASE + 3]);   \
    unsigned b0 = cvtpk(P[BASE + 4], P[BASE + 5]), b1 = cvtpk(P[BASE + 6], P[BASE + 7]);                              \
    auto r0 = __builtin_amdgcn_permlane32_swap(a0, b0, false, false); auto r1 = __builtin_amdgcn_permlane32_swap(a1, b1, false, false); \
    u32x4 w = {r0[0], r1[0], r0[1], r1[1]}; OUT = *reinterpret_cast<bf16x8*>(&w); } while (0)
  PK4(p0, 0, pa0); PK4(p0, 8, pa1); PK4(p1, 0, pa2); PK4(p1, 8, pa3);
#undef PK4
}
__device__ __forceinline__ void qkt(f32x16& p0, f32x16& p1, const char* Ks, const bf16x8* qr, int r32, int hi) {
  p0 = f32x16{}; p1 = f32x16{};
#pragma unroll
  for (int d0 = 0; d0 < 8; ++d0) { int cb = (d0 * 16 + hi * 8) * 2;
    bf16x8 b0 = *reinterpret_cast<const bf16x8*>(Ks + KSWZ(r32, cb));
    bf16x8 b1 = *reinterpret_cast<const bf16x8*>(Ks + KSWZ(32 + r32, cb));
    p0 = __builtin_amdgcn_mfma_f32_32x32x16_bf16(b0, qr[d0], p0, 0, 0, 0);
    p1 = __builtin_amdgcn_mfma_f32_32x32x16_bf16(b1, qr[d0], p1, 0, 0, 0); }
}
__device__ __forceinline__ void cmask(f32x16& p0, f32x16& p1, int jt, int qloc, int hi) {
#pragma unroll
  for (int r = 0; r < 16; ++r) { const int key = 64 * jt + crow(r, hi); if (key > qloc) p0[r] = -1e30f; if (key + 32 > qloc) p1[r] = -1e30f; }
}
__device__ __forceinline__ int v_st(int k, int c) { const int kk = (k & ~0xC) | ((k & 4) << 1) | ((k & 8) >> 1); return ((kk >> 3) * 4 + (c >> 5)) * 512 + ((kk & 7) * 32 + (c & 31)) * 2; }
__device__ __forceinline__ int v_rd_base(int lane) { return ((lane & 3) << 3) | (((lane >> 2) & 3) << 6) | (((lane >> 4) & 1) << 5) | (((lane >> 5) & 1) << 8); }
constexpr int v_rd_off(int d0, int ks, int half) { return d0 * 512 + ks * 4096 + half * 2048; }
template <int OFF> __device__ __forceinline__ s16x4 tr_read(int vb) {
  s16x4 r; asm volatile("ds_read_b64_tr_b16 %0, %1 offset:%2" : "=&v"(r) : "v"(vb), "i"(OFF) : "memory"); return r;
}
template <int D0> __device__ __forceinline__ void pv_one(f32x16& od, int vb, bf16x8 pa0, bf16x8 pa1, bf16x8 pa2, bf16x8 pa3) {
  const s16x4 l0 = tr_read<v_rd_off(D0, 0, 0)>(vb), h0 = tr_read<v_rd_off(D0, 0, 1)>(vb), l1 = tr_read<v_rd_off(D0, 1, 0)>(vb), h1 = tr_read<v_rd_off(D0, 1, 1)>(vb);
  const s16x4 l2 = tr_read<v_rd_off(D0, 2, 0)>(vb), h2 = tr_read<v_rd_off(D0, 2, 1)>(vb), l3 = tr_read<v_rd_off(D0, 3, 0)>(vb), h3 = tr_read<v_rd_off(D0, 3, 1)>(vb);
  asm volatile("s_waitcnt lgkmcnt(0)" ::: "memory"); SBAR();
#define PK(L, H) (bf16x8){L[0], L[1], L[2], L[3], H[0], H[1], H[2], H[3]}
  od = __builtin_amdgcn_mfma_f32_32x32x16_bf16(PK(l0, h0), pa0, od, 0, 0, 0);
  od = __builtin_amdgcn_mfma_f32_32x32x16_bf16(PK(l1, h1), pa1, od, 0, 0, 0);
  od = __builtin_amdgcn_mfma_f32_32x32x16_bf16(PK(l2, h2), pa2, od, 0, 0, 0);
  od = __builtin_amdgcn_mfma_f32_32x32x16_bf16(PK(l3, h3), pa3, od, 0, 0, 0);
#undef PK
}
__device__ __forceinline__ void pv_d0(f32x16* o, int vb, bf16x8 pa0, bf16x8 pa1, bf16x8 pa2, bf16x8 pa3) {
  pv_one<0>(o[0], vb, pa0, pa1, pa2, pa3); pv_one<1>(o[1], vb, pa0, pa1, pa2, pa3); pv_one<2>(o[2], vb, pa0, pa1, pa2, pa3); pv_one<3>(o[3], vb, pa0, pa1, pa2, pa3);
}

__device__ __forceinline__ void attn_item(const bf16_t* __restrict__ Qrow, const bf16_t* __restrict__ Kh, const bf16_t* __restrict__ Vh, bool causal, int qloc,
                                          bf16_t* Orow, float2* MLrow, bool valid, char* lds) {
  const int tid = threadIdx.x, lane = tid & 63, r32 = lane & 31, hi = lane >> 5;
  char* V_lds = lds; char* K_lds = lds + 2 * SHM_V;
  float m_reg = -1e30f, l_reg = 0; f32x16 o[4] = {}; bf16x8 qr[8];
  const bf16_t* Qw = Qrow + hi * 8;
#pragma unroll
  for (int d0 = 0; d0 < 8; ++d0) qr[d0] = *reinterpret_cast<const bf16x8*>(Qw + d0 * 16);
  const int sr = tid >> 4, sc = (tid & 15) * 8, vst0 = v_st(sr, sc), vst1 = v_st(32 + sr, sc);
  const int vb0 = (int)(uintptr_t)V_lds + v_rd_base(lane);
  struct { bf16x8 vs0, vs1, ks0, ks1; } sr_[2];
#define SLOAD(i, k0) do { sr_[i].vs0 = *reinterpret_cast<const bf16x8*>(&Vh[(long)((k0) + sr) * LDK + sc]); sr_[i].vs1 = *reinterpret_cast<const bf16x8*>(&Vh[(long)((k0) + 32 + sr) * LDK + sc]); \
    sr_[i].ks0 = *reinterpret_cast<const bf16x8*>(&Kh[(long)((k0) + sr) * LDK + sc]); sr_[i].ks1 = *reinterpret_cast<const bf16x8*>(&Kh[(long)((k0) + 32 + sr) * LDK + sc]); } while (0)
#define SWRITE(b, i) do { *(bf16x8*)(V_lds + (b) * SHM_V + vst0) = sr_[i].vs0;          \
    *(bf16x8*)(V_lds + (b) * SHM_V + vst1) = sr_[i].vs1; int kc = sc * 2;               \
    *(bf16x8*)(K_lds + (b) * SHM_K + KSWZ(sr, kc)) = sr_[i].ks0;                       \
    *(bf16x8*)(K_lds + (b) * SHM_K + KSWZ(32 + sr, kc)) = sr_[i].ks1; } while (0)
#define SWAIT() asm volatile("s_waitcnt vmcnt(4)" ::: "memory")
#define RESC(a) do { if (__any((a) < 1.f)) { _Pragma("unroll") for (int d = 0; d < 4; ++d) _Pragma("unroll") for (int r = 0; r < 16; ++r) o[d][r] *= (a); } } while (0)
  f32x16 pA0, pA1, pB0, pB1; float mnA, mnB, alA, alB; bf16x8 pa0, pa1, pa2, pa3;
  constexpr int SE = 0, SO = 1;
  SLOAD(SE, 0); asm volatile("s_waitcnt vmcnt(0)" ::: "memory"); SWRITE(0, SE); __syncthreads();
  qkt(pA0, pA1, K_lds, qr, r32, hi); if (causal) cmask(pA0, pA1, 0, qloc, hi); partialSM(pA0, pA1, m_reg, mnA, alA);
  SLOAD(SO, KVBLK); SLOAD(SE, 2 * KVBLK);
  SWAIT(); SWRITE(1, SO); __syncthreads();
  {
    SBAR(); qkt(pB0, pB1, K_lds + SHM_K, qr, r32, hi); if (causal) cmask(pB0, pB1, 1, qloc, hi);
    finishSM(pA0, pA1, alA, l_reg, pa0, pa1, pa2, pa3); SBAR();
    SLOAD(SO, 3 * KVBLK); SBAR();
    pv_d0(o, vb0, pa0, pa1, pa2, pa3); partialSM(pB0, pB1, m_reg, mnB, alB);
    __syncthreads(); SWAIT(); SWRITE(0, SE);
    RESC(alB); __syncthreads();
    SBAR(); qkt(pA0, pA1, K_lds, qr, r32, hi); if (causal) cmask(pA0, pA1, 2, qloc, hi);
    finishSM(pB0, pB1, alB, l_reg, pa0, pa1, pa2, pa3); SBAR();
    pv_d0(o, vb0 + (int)SHM_V, pa0, pa1, pa2, pa3); partialSM(pA0, pA1, m_reg, mnA, alA);
    __syncthreads(); asm volatile("s_waitcnt vmcnt(0)" ::: "memory"); SWRITE(1, SO);
    RESC(alA); __syncthreads();
  }
  SBAR(); qkt(pB0, pB1, K_lds + SHM_K, qr, r32, hi); if (causal) cmask(pB0, pB1, 3, qloc, hi);
  finishSM(pA0, pA1, alA, l_reg, pa0, pa1, pa2, pa3); SBAR();
  pv_d0(o, vb0, pa0, pa1, pa2, pa3); partialSM(pB0, pB1, m_reg, mnB, alB);
  __syncthreads(); RESC(alB);
  finishSM(pB0, pB1, alB, l_reg, pa0, pa1, pa2, pa3); SBAR();
  pv_d0(o, vb0 + (int)SHM_V, pa0, pa1, pa2, pa3);
  const float rl = 1.0f / l_reg;
  if (valid) {
#pragma unroll
    for (int d0 = 0; d0 < 4; ++d0)
#pragma unroll
      for (int g = 0; g < 4; ++g) { u32x2 w; w.x = cvtpk(o[d0][4 * g] * rl, o[d0][4 * g + 1] * rl); w.y = cvtpk(o[d0][4 * g + 2] * rl, o[d0][4 * g + 3] * rl);
        *reinterpret_cast<u32x2*>(Orow + 32 * d0 + 8 * g + 4 * hi) = w; }
    if (hi == 0) *MLrow = make_float2(m_reg, l_reg);
  }
#undef SLOAD
#undef SWRITE
#undef SWAIT
#undef RESC
}

struct ItemCtx { const bf16_t* Q; const bf16_t* K; const bf16_t* V; bf16_t* PO; float2* ML; const unsigned short* lists; };
__device__ __forceinline__ unsigned item_entry(const ItemCtx& C, const __attribute__((address_space(3))) int* D, int k, int rloc) {
  const int own = D[4 * k + 1], j = D[4 * k] & 31, cnt = D[4 * k + 3];
  if (own) return (unsigned)(256 * j + rloc) | (3u << 13);
  return (unsigned)C.lists[(size_t)(unsigned)D[4 * k + 2] + (rloc < cnt ? rloc : 0)];
}
__device__ __forceinline__ void attn_items(const ItemCtx& C, const __attribute__((address_space(3))) int* D, int nloc, char* lds) {
  if (nloc <= 0) return;
  const int tid = threadIdx.x, wid = tid >> 6, lane = tid & 63, r32 = lane & 31, hi = lane >> 5, rloc = 32 * wid + r32;
  char* V_lds = lds; char* K_lds = lds + 2 * SHM_V;
  const int sr = tid >> 4, sc = (tid & 15) * 8, vst0 = v_st(sr, sc), vst1 = v_st(32 + sr, sc);
  const int vb0 = (int)(uintptr_t)V_lds + v_rd_base(lane);
  struct { bf16x8 vs0, vs1, ks0, ks1; } sr_[2];
  bf16x8 qr[8];
#define KVBASE(k, Kh, Vh) const bf16_t* Kh; const bf16_t* Vh; { const int bhj_ = D[4 * (k)], bh_ = bhj_ >> 5, j_ = bhj_ & 31; \
    const size_t off_ = ((size_t)(bh_ >> 4) * 8192 + 256 * j_) * LDK + (bh_ & 15) * D_; Kh = C.K + off_; Vh = C.V + off_; }
#define SLOADP(i, Kh, Vh, k0) do { sr_[i].vs0 = *reinterpret_cast<const bf16x8*>(&Vh[(long)((k0) + sr) * LDK + sc]); sr_[i].vs1 = *reinterpret_cast<const bf16x8*>(&Vh[(long)((k0) + 32 + sr) * LDK + sc]); \
    sr_[i].ks0 = *reinterpret_cast<const bf16x8*>(&Kh[(long)((k0) + sr) * LDK + sc]); sr_[i].ks1 = *reinterpret_cast<const bf16x8*>(&Kh[(long)((k0) + 32 + sr) * LDK + sc]); } while (0)
#define SWRITE(b, i) do { *(bf16x8*)(V_lds + (b) * SHM_V + vst0) = sr_[i].vs0;          \
    *(bf16x8*)(V_lds + (b) * SHM_V + vst1) = sr_[i].vs1; int kc = sc * 2;               \
    *(bf16x8*)(K_lds + (b) * SHM_K + KSWZ(sr, kc)) = sr_[i].ks0;                       \
    *(bf16x8*)(K_lds + (b) * SHM_K + KSWZ(32 + sr, kc)) = sr_[i].ks1; } while (0)
#define QLOAD(e, k) do { const int bh_ = D[4 * (k)] >> 5; const bf16_t* Qw_ = C.Q + ((size_t)(bh_ >> 4) * 8192 + ((e) & 8191u)) * LDQ + (bh_ & 15) * D_ + hi * 8; \
    _Pragma("unroll") for (int d0 = 0; d0 < 8; ++d0) qr[d0] = *reinterpret_cast<const bf16x8*>(Qw_ + d0 * 16); } while (0)
#define RESC(a) do { if (__any((a) < 1.f)) { _Pragma("unroll") for (int d = 0; d < 4; ++d) _Pragma("unroll") for (int r = 0; r < 16; ++r) o[d][r] *= (a); } } while (0)
  constexpr int D_ = 128, SE = 0, SO = 1;
  unsigned e_cur = item_entry(C, D, 0, rloc), e_nxt = (nloc > 1) ? item_entry(C, D, 1, rloc) : 0u;
  { KVBASE(0, Kh, Vh); SLOADP(SE, Kh, Vh, 0); SLOADP(SO, Kh, Vh, KVBLK); }
  QLOAD(e_cur, 0);
  for (int k = 0; k < nloc; ++k) {
    const bool has_next = (k + 1 < nloc);
    const bool causal = D[4 * k + 1] != 0; const int cnt = D[4 * k + 3];
    KVBASE(k, Kh, Vh);
    float m_reg = -1e30f, l_reg = 0; f32x16 o[4] = {};
    f32x16 pA0, pA1, pB0, pB1; float mnA, mnB, alA, alB; bf16x8 pa0, pa1, pa2, pa3;
    asm volatile("s_waitcnt vmcnt(0)" ::: "memory"); SWRITE(0, SE); __syncthreads();
    qkt(pA0, pA1, K_lds, qr, r32, hi); if (causal) cmask(pA0, pA1, 0, rloc, hi); partialSM(pA0, pA1, m_reg, mnA, alA);
    SLOADP(SE, Kh, Vh, 2 * KVBLK);
    SWRITE(1, SO); __syncthreads();
    SLOADP(SO, Kh, Vh, 3 * KVBLK);
    SBAR(); qkt(pB0, pB1, K_lds + SHM_K, qr, r32, hi); if (causal) cmask(pB0, pB1, 1, rloc, hi);
    finishSM(pA0, pA1, alA, l_reg, pa0, pa1, pa2, pa3); SBAR();
    pv_d0(o, vb0, pa0, pa1, pa2, pa3); partialSM(pB0, pB1, m_reg, mnB, alB);
    __syncthreads(); asm volatile("s_waitcnt vmcnt(4)" ::: "memory"); SWRITE(0, SE);
    RESC(alB); __syncthreads();
    if (has_next) { KVBASE(k + 1, Kn, Vn); SLOADP(SE, Kn, Vn, 0); }
    SBAR(); qkt(pA0, pA1, K_lds, qr, r32, hi); if (causal) cmask(pA0, pA1, 2, rloc, hi);
    finishSM(pB0, pB1, alB, l_reg, pa0, pa1, pa2, pa3); SBAR();
    pv_d0(o, vb0 + (int)SHM_V, pa0, pa1, pa2, pa3); partialSM(pA0, pA1, m_reg, mnA, alA);
    __syncthreads(); SWRITE(1, SO);
    RESC(alA); __syncthreads();
    if (has_next) { KVBASE(k + 1, Kn, Vn); SLOADP(SO, Kn, Vn, KVBLK); }
    SBAR(); qkt(pB0, pB1, K_lds + SHM_K, qr, r32, hi); if (causal) cmask(pB0, pB1, 3, rloc, hi);
    SBAR();
    if (has_next) QLOAD(e_nxt, k + 1);
    finishSM(pA0, pA1, alA, l_reg, pa0, pa1, pa2, pa3); SBAR();
    pv_d0(o, vb0, pa0, pa1, pa2, pa3); partialSM(pB0, pB1, m_reg, mnB, alB);
    __syncthreads(); RESC(alB);
    finishSM(pB0, pB1, alB, l_reg, pa0, pa1, pa2, pa3); SBAR();
    pv_d0(o, vb0 + (int)SHM_V, pa0, pa1, pa2, pa3);
    { const float rl = 1.0f / l_reg; const int bh = D[4 * k] >> 5; const unsigned t = e_cur & 8191u, slot = e_cur >> 13;
      if (rloc < cnt) {
        bf16_t* Orow = C.PO + (((size_t)slot * 32 + bh) * 8192 + t) * D_;
#pragma unroll
        for (int d0 = 0; d0 < 4; ++d0)
#pragma unroll
          for (int g = 0; g < 4; ++g) { u32x2 w; w.x = cvtpk(o[d0][4 * g] * rl, o[d0][4 * g + 1] * rl); w.y = cvtpk(o[d0][4 * g + 2] * rl, o[d0][4 * g + 3] * rl);
            *reinterpret_cast<u32x2*>(Orow + 32 * d0 + 8 * g + 4 * hi) = w; }
        if (hi == 0) C.ML[((size_t)slot * 32 + bh) * 8192 + t] = make_float2(m_reg, l_reg);
      } }
    e_cur = e_nxt; if (k + 2 < nloc) e_nxt = item_entry(C, D, k + 2, rloc);
  }
#undef KVBASE
#undef SLOADP
#undef SWRITE
#undef QLOAD
#undef RESC
}
#undef KSWZ
#undef SBAR
}

constexpr int NWAVES = 8;
#ifndef MK_N_LAUNCHES
#define MK_N_LAUNCHES 1
#endif
constexpr int N_PHASES = 16;
constexpr int N_LAUNCHES = MK_N_LAUNCHES;

constexpr int BATCH = 2, SEQ = 8192, DM = 4096, M = BATCH * SEQ, MEMLEN = 256;
constexpr int PW = 2048, AW = 2048, NH = 16, HD = 128, NBLK = 32, MIXIN = 8192, FF = 11008, XH = 4, XHD = 1024;
constexpr float LN_EPS = 1e-5f;
constexpr float DN_ALPHA = 1.189207115002721f;

constexpr size_t MiB = 1u << 20;
constexpr size_t WS_CTL = 0, CTL_ZERO_BYTES = 1 * MiB;
constexpr size_t WS_ROPE = 1 * MiB;
constexpr size_t WS_KMH = 5 * MiB, WS_KML = 5 * MiB + 512 * 1024;
constexpr size_t WS_MEMB = 6 * MiB;
constexpr size_t WS_KVX = 10 * MiB;
constexpr size_t WS_LIST = 18 * MiB;
constexpr size_t WS_ML = 26 * MiB;
constexpr size_t WS_WIN = 34 * MiB, WS_WPOOL = 98 * MiB, WS_WOUT = 100 * MiB, WS_WXQ = 132 * MiB, WS_WXKV = 164 * MiB, WS_WXO = 228 * MiB, WS_WGU = 260 * MiB, WS_WDN = 432 * MiB;
constexpr size_t WS_ACT = 518 * MiB;
constexpr size_t WS_HP = WS_ACT, WS_Q = WS_ACT + 64 * MiB, WS_K = WS_ACT + 128 * MiB, WS_V = WS_ACT + 192 * MiB;
constexpr size_t WS_XB = WS_ACT + 256 * MiB;
constexpr size_t WS_PARTO = WS_ACT + 256 * MiB;
constexpr size_t WS_CAT = WS_ACT + 512 * MiB;
constexpr size_t WS_TB = WS_ACT;
constexpr size_t WS_HB = WS_ACT + 128 * MiB;
constexpr size_t WS_PB = WS_ACT + 256 * MiB;
constexpr size_t WS_G = WS_ACT + 256 * MiB;
constexpr size_t WS_SLAB = WS_ACT + 384 * MiB;
constexpr size_t WS_WQK = WS_ACT + 640 * MiB, WS_WVOT = WS_ACT + 656 * MiB;
constexpr size_t WS_WOUT2 = WS_ACT + 672 * MiB;
constexpr size_t WS_SLOT = WS_ML;
constexpr size_t WS_STATS = WS_LIST;
constexpr size_t WS_WTMP = WS_ACT;
constexpr size_t WS_H8 = WS_ACT + 128 * MiB;
constexpr size_t WS_W8IN = WS_WGU + 96 * MiB;
constexpr size_t WS_X8 = WS_ACT + 448 * MiB;
constexpr size_t WS_END = WS_ACT + 704 * MiB;
static_assert(WS_WDN + (size_t)DM * FF * 2 <= WS_ACT && WS_G + (size_t)M * FF * 2 <= WS_END && WS_WGU + (size_t)2 * FF * DM * 2 <= WS_WDN, "d_ws map");
constexpr int LIST_STRIDE = 256 * 496;
__host__ __device__ constexpr int list_off(int j) { return 256 * (31 * j - (j * (j - 1)) / 2); }
constexpr int CW_TMO = 0, CW_CODE = 1;
constexpr int CW_BAR = 4096;
constexpr int CW_GCNT = 8192;
constexpr int CW_CHK = 16384;
constexpr int CW_K1 = 32768, CW_K2 = 32768 + 2048;
constexpr int CW_DYN = 131072;
constexpr int CW_C1G = 65536, CW_C2G = 65536 + 22016;
constexpr int CW_SB = 65536;
constexpr int CW_SBIN = 212992, CW_SX = 217088;
constexpr int CW_SA = 196608;

#if !defined(GU_FILLER)
#define GU_IN_P0 1
#endif

#ifndef MIX8
#define MIX8 3
#endif

constexpr int RING_OFF = 0, RING_BYTES = 131072;
constexpr int LDSCTL_OFF = RING_BYTES, MISC_OFF = LDSCTL_OFF + 320;
constexpr int LDS_BYTES = 147456;

#define GAS __attribute__((address_space(1)))
#define LAS __attribute__((address_space(3)))
typedef unsigned short bf16;
typedef unsigned v4u __attribute__((ext_vector_type(4)));
typedef unsigned v2u __attribute__((ext_vector_type(2)));
typedef float f32x4 __attribute__((ext_vector_type(4)));
typedef short bf16x8 __attribute__((ext_vector_type(8)));
typedef float f32x16 __attribute__((ext_vector_type(16)));
typedef GAS unsigned gu32;
#define RLX_AGENT __ATOMIC_RELAXED, __HIP_MEMORY_SCOPE_AGENT
#define LDS_WAIT() asm volatile("s_waitcnt lgkmcnt(0)" ::: "memory")
#define VM_WAIT() asm volatile("s_waitcnt vmcnt(0)" ::: "memory")
__device__ __forceinline__ unsigned f2bf(float f) { unsigned u = __builtin_bit_cast(unsigned, f); return (u + 0x7fffu + ((u >> 16) & 1u)) >> 16; }
__device__ __forceinline__ unsigned pk2(float lo, float hi) { return f2bf(lo) | (f2bf(hi) << 16); }
__device__ __forceinline__ float bf_lo(unsigned w) { return __builtin_bit_cast(float, w << 16); }
__device__ __forceinline__ float bf_hi(unsigned w) { return __builtin_bit_cast(float, w & 0xffff0000u); }
__device__ __forceinline__ float bf2f(bf16 b) { return __builtin_bit_cast(float, ((unsigned)b) << 16); }
#define XB_TMO      128
#define XB_XCNT(j)  (256  + 64 * (j))
#define XB_XSUB(j)  (1280 + 64 * (j))
#define XB_XGEN(j)  (2304 + 64 * (j))
#define XB_TOP      3328
#define XB_TOPGEN   3392
#define XCD_BAR_WORDS 3456
#define XB_SPIN_CAP (1u << 18)

__device__ __forceinline__ unsigned xb_ld(unsigned* p)              { return __hip_atomic_load(p, __ATOMIC_RELAXED, __HIP_MEMORY_SCOPE_AGENT); }
__device__ __forceinline__ unsigned xb_add(unsigned* p, unsigned v) { return __hip_atomic_fetch_add(p, v, __ATOMIC_RELAXED, __HIP_MEMORY_SCOPE_AGENT); }
__device__ __forceinline__ unsigned xb_xcc_id() { return (unsigned)__builtin_amdgcn_s_getreg((3 << 11) | 20) & 0xFu; }
#define XB_SPIN(cond, bar) do { unsigned _sp = 0; while (cond) { __builtin_amdgcn_s_sleep(1); \
    if ((++_sp & 255u) == 0u) { if (xb_ld(&(bar)[XB_TMO])) break; if (_sp > XB_SPIN_CAP) { atomicAdd(&(bar)[XB_TMO], 1u); break; } } } } while (0)

struct XcdBarrier {
    unsigned* bar; unsigned x;
    volatile LAS unsigned* st;
};

__device__ __forceinline__ XcdBarrier xcd_barrier_post(unsigned* bar, volatile LAS unsigned* st) {
    XcdBarrier b; b.bar = bar; b.x = xb_xcc_id(); b.st = st;
    if (threadIdx.x == 0) (void)xb_add(&bar[XB_XCNT(b.x)], 1u);
    return b;
}
__device__ __forceinline__ void xcd_barrier_complete(unsigned* bar, unsigned x, unsigned& nloc, unsigned& nx) {
    const unsigned G = gridDim.x * gridDim.y * gridDim.z;
    unsigned sum, cnt, mine, sp = 0u;
    for (;;) {
        sum = 0u; cnt = 0u; mine = 0u;
#pragma unroll
        for (unsigned j = 0; j < 16; ++j) { const unsigned c = xb_ld(&bar[XB_XCNT(j)]); sum += c; cnt += (c > 0u) ? 1u : 0u; mine = (j == x) ? c : mine; }
        if (sum == G) break;
        __builtin_amdgcn_s_sleep(1);
        if ((++sp & 255u) == 0u) { if (xb_ld(&bar[XB_TMO])) break; if (sp > XB_SPIN_CAP) { atomicAdd(&bar[XB_TMO], 1u); break; } }
    }
    nloc = mine > 0u ? mine : 1u; nx = cnt > 0u ? cnt : 1u;
}

__device__ __forceinline__ void xcd_barrier(const XcdBarrier& b) {
    asm volatile("s_waitcnt vmcnt(0)" ::: "memory");
    __syncthreads();
    if (threadIdx.x == 0) {
        unsigned* bar = b.bar;
        __builtin_amdgcn_s_waitcnt(0);
        unsigned nloc = b.st[0], nx = b.st[1];
        if (nloc == 0u) { xcd_barrier_complete(bar, b.x, nloc, nx); b.st[0] = nloc; b.st[1] = nx; }
        const unsigned old = xb_add(&bar[XB_XSUB(b.x)], 1u);
        const unsigned gen = old / nloc;
        if (old + 1u == (gen + 1u) * nloc) {
            __builtin_amdgcn_fence(__ATOMIC_RELEASE, "agent");
            asm volatile("s_waitcnt vmcnt(0)" ::: "memory");
            const unsigned og = xb_add(&bar[XB_TOP], 1u);
            const unsigned tg = og / nx;
            if (og + 1u == (tg + 1u) * nx) xb_add(&bar[XB_TOPGEN], 1u);
            else XB_SPIN(xb_ld(&bar[XB_TOPGEN]) == tg, bar);
            __builtin_amdgcn_fence(__ATOMIC_ACQUIRE, "agent");
            xb_add(&bar[XB_XGEN(b.x)], 1u);
            asm volatile("s_waitcnt vmcnt(0)" ::: "memory");
        } else {
            XB_SPIN(xb_ld(&bar[XB_XGEN(b.x)]) == gen, bar);
            __builtin_amdgcn_fence(__ATOMIC_ACQUIRE, "agent");
            asm volatile("s_waitcnt vmcnt(0)" ::: "memory");
        }
    }
    __syncthreads();
}

struct Frame {
    LAS unsigned char* lds;
    volatile LAS unsigned* MISC;
    gu32* ctl;
    int tid, lane, wave;
    int G;
    unsigned char* ws;
};
__device__ __forceinline__ float wave_sum(float v) {
#pragma unroll
    for (int o = 1; o < 64; o <<= 1) v += __shfl_xor(v, o);
    return v;
}

#ifndef QW_NR
#define QW_NR 2
#endif
#ifndef Q8_NR
#define Q8_NR 2
#endif
__device__ __forceinline__ float wave_maxf(float v) {
#pragma unroll
    for (int o = 1; o < 64; o <<= 1) v = fmaxf(v, __shfl_xor(v, o));
    return v;
}
__device__ __forceinline__ unsigned pk4_i8(float a, float b, float c, float d) {
    const unsigned ia = __builtin_bit_cast(unsigned, a + 12582912.0f), ib = __builtin_bit_cast(unsigned, b + 12582912.0f), ic = __builtin_bit_cast(unsigned, c + 12582912.0f), id = __builtin_bit_cast(unsigned, d + 12582912.0f);
    return (ia & 0xffu) | ((ib & 0xffu) << 8) | ((ic & 0xffu) << 16) | (id << 24);
}

template <class RowMap>
__device__ __forceinline__ void p0_transpose_item(const float* W, int K, int N, bf16* WT, LAS float* scr, int item, int lane, const RowMap& rm, const float* colscale,
                                                  const float* kgain = nullptr, const float* kbias = nullptr, float* c1 = nullptr, float* c2 = nullptr) {
    const int nblk = N / 32, kb = item / nblk, nb = item % nblk, k0 = 64 * kb, n0 = 32 * nb;
    float ld[32];
    const float* src = W + (size_t)(k0 + (lane >> 5)) * N + n0 + (lane & 31);
#pragma unroll
    for (int i = 0; i < 32; ++i) ld[i] = *(const GAS float*)(src + (size_t)(2 * i) * N);
#pragma unroll
    for (int i = 0; i < 32; ++i) scr[(2 * i + (lane >> 5)) * 33 + (lane & 31)] = ld[i];
    LDS_WAIT(); asm volatile("" ::: "memory");
    const int c = lane & 7;
    f32x4 g0 = (f32x4){1.f, 1.f, 1.f, 1.f}, g1 = g0, b0 = (f32x4){0.f, 0.f, 0.f, 0.f}, b1 = b0;
    if (kgain) { g0 = *(const GAS f32x4*)(kgain + k0 + 8 * c); g1 = *(const GAS f32x4*)(kgain + k0 + 8 * c + 4); b0 = *(const GAS f32x4*)(kbias + k0 + 8 * c); b1 = *(const GAS f32x4*)(kbias + k0 + 8 * c + 4); }
#pragma unroll
    for (int j = 0; j < 4; ++j) { const int n = (lane >> 3) + 8 * j; const LAS float* s = scr + (8 * c) * 33 + n; const float sc = colscale ? colscale[n0 + n] : 1.0f;
        const float w0 = s[0 * 33] * sc, w1 = s[1 * 33] * sc, w2 = s[2 * 33] * sc, w3 = s[3 * 33] * sc, w4 = s[4 * 33] * sc, w5 = s[5 * 33] * sc, w6 = s[6 * 33] * sc, w7 = s[7 * 33] * sc;
        v4u o; o.x = pk2(w0 * g0.x, w1 * g0.y); o.y = pk2(w2 * g0.z, w3 * g0.w); o.z = pk2(w4 * g1.x, w5 * g1.y); o.w = pk2(w6 * g1.z, w7 * g1.w);
        const int row = rm(n0 + n);
        *(GAS v4u*)(WT + (size_t)row * K + k0 + 8 * c) = o;
        if (c1) {
            float t1 = ((bf_lo(o.x) + bf_hi(o.x)) + (bf_lo(o.y) + bf_hi(o.y))) + ((bf_lo(o.z) + bf_hi(o.z)) + (bf_lo(o.w) + bf_hi(o.w)));
            float t2 = ((w0 * b0.x + w1 * b0.y) + (w2 * b0.z + w3 * b0.w)) + ((w4 * b1.x + w5 * b1.y) + (w6 * b1.z + w7 * b1.w));
            t1 += __shfl_xor(t1, 1); t2 += __shfl_xor(t2, 1); t1 += __shfl_xor(t1, 2); t2 += __shfl_xor(t2, 2); t1 += __shfl_xor(t1, 4); t2 += __shfl_xor(t2, 4);
            if (c == 0) { __hip_atomic_fetch_add(c1 + row, t1, RLX_AGENT); __hip_atomic_fetch_add(c2 + row, t2, RLX_AGENT); } } }
    LDS_WAIT(); asm volatile("" ::: "memory");
}
struct RmIdent { int off; __device__ __forceinline__ int operator()(int n) const { return off + n; } };
struct RmMixIn { __device__ __forceinline__ int operator()(int n) const { if (n < 2048 || n >= 6144) return n; const int d = n & 127; return (n & ~127) + 2 * (d & 63) + (d >> 6); } };
struct RmGateUp { int up; __device__ __forceinline__ int operator()(int n) const { return (n >> 7) * 256 + up * 128 + (n & 127); } };

__device__ __forceinline__ void sincos_d(double a, double& s, double& c) {
    const double n = __builtin_rint(a * 0.63661977236758134308);
    double r = __builtin_fma(-n, 1.5707963267948966, a); r = __builtin_fma(-n, 6.123233995736766e-17, r);
    const double r2 = r * r;
    double ps = -7.6471637318198164759e-13; ps = ps * r2 + 1.6059043836821614599e-10; ps = ps * r2 - 2.5052108385441718775e-08; ps = ps * r2 + 2.7557319223985890653e-06;
    ps = ps * r2 - 1.9841269841269841270e-04; ps = ps * r2 + 8.3333333333333333333e-03; ps = ps * r2 - 1.6666666666666666667e-01; ps = r + r * r2 * ps;
    double pc = 4.7794773323873852974e-14; pc = pc * r2 - 1.1470745597729724714e-11; pc = pc * r2 + 2.0876756987868098979e-09; pc = pc * r2 - 2.7557319223985890653e-07;
    pc = pc * r2 + 2.4801587301587301587e-05; pc = pc * r2 - 1.3888888888888888889e-03; pc = pc * r2 + 4.1666666666666666667e-02; pc = pc * r2 - 0.5; pc = 1.0 + r2 * pc;
    const int q = ((int)n) & 3;
    s = (q == 0) ? ps : (q == 1) ? pc : (q == 2) ? -ps : -pc;
    c = (q == 0) ? pc : (q == 1) ? -ps : (q == 2) ? -pc : ps;
}
__device__ __forceinline__ float rope_inv(int i) {
    const double y = -(double)i * (13.287712379549449 / 64.0); const double fl = __builtin_floor(y); const double z = (y - fl) * 0.69314718055994530942;
    double e = 1.0, term = 1.0;
#pragma unroll
    for (int k = 1; k <= 20; ++k) { term = term * z / (double)k; e += term; }
    return (float)__builtin_ldexp(e, (int)fl);
}

__device__ __forceinline__ void p0_prologue(Frame& F, const float* const* in) {
    LAS float* scr = (LAS float*)(F.lds + RING_OFF + F.wave * 16384);
    const int gw = blockIdx.x * NWAVES + F.wave, NGW = F.G * NWAVES;
    const float* w_mix_in = in[2]; const float* w_pool = in[3]; const float* pool_scale = in[4]; const float* w_mix_out = in[5];
    const float* w_xq = in[8]; const float* w_xkv = in[9]; const float* w_xo = in[10]; const float* w_gate = in[13]; const float* w_up = in[14]; const float* w_down = in[15];
    bf16* WIN = (bf16*)(F.ws + WS_WIN); bf16* WPOOL = (bf16*)(F.ws + WS_WPOOL); bf16* WOUT = (bf16*)(F.ws + WS_WOUT); bf16* WXQ = (bf16*)(F.ws + WS_WXQ);
    bf16* WXKV = (bf16*)(F.ws + WS_WXKV); bf16* WXO = (bf16*)(F.ws + WS_WXO); bf16* WGU = (bf16*)(F.ws + WS_WGU); bf16* WDN = (bf16*)(F.ws + WS_WDN);
    constexpr int I_IN = (DM / 64) * (MIXIN / 32), I_POOL = (512 / 64) * (512 / 32), I_SQ = (DM / 64) * (DM / 32), I_KV = (DM / 64) * (2 * DM / 32), I_GU = (DM / 64) * (FF / 32), I_DN = (FF / 64) * (DM / 32);
#if defined(GU_IN_P0)
    constexpr int NITEMS = I_IN + 2 * I_SQ + I_KV + 2 * I_GU;
#else
    constexpr int NITEMS = I_IN + 2 * I_SQ + I_KV;
#endif
    const size_t gt = (size_t)blockIdx.x * (NWAVES * 64) + F.tid, NT = (size_t)F.G * NWAVES * 64;
#if MIX8 == 0
    { const float* x = in[0]; bf16* XB = (bf16*)(F.ws + WS_XB);
      for (size_t i = gt; i < (size_t)M * DM / 8; i += NT) { const f32x4 a = *(const GAS f32x4*)(x + i * 8), b = *(const GAS f32x4*)(x + i * 8 + 4);
          v4u o; o.x = pk2(a.x, a.y); o.y = pk2(a.z, a.w); o.z = pk2(b.x, b.y); o.w = pk2(b.z, b.w); *(GAS v4u*)(XB + i * 8) = o; } }
#else
    { const float* x = in[0]; bf16* XB = (bf16*)(F.ws + WS_XB); unsigned char* X8 = F.ws + WS_X8; float* sx = (float*)(F.ctl + CW_SX);
      for (int m = gw; m < M; m += NGW) { f32x4 a[8], b[8]; float am = 0.f;
#pragma unroll
          for (int j = 0; j < 8; ++j) { const size_t c = (size_t)m * DM + (64 * j + F.lane) * 8; a[j] = *(const GAS f32x4*)(x + c); b[j] = *(const GAS f32x4*)(x + c + 4); }
#pragma unroll
          for (int j = 0; j < 8; ++j) { const size_t c = (size_t)m * DM + (64 * j + F.lane) * 8;
              v4u o; o.x = pk2(a[j].x, a[j].y); o.y = pk2(a[j].z, a[j].w); o.z = pk2(b[j].x, b[j].y); o.w = pk2(b[j].z, b[j].w); *(GAS v4u*)(XB + c) = o;
              am = fmaxf(am, fmaxf(fmaxf(fmaxf(fabsf(a[j].x), fabsf(a[j].y)), fmaxf(fabsf(a[j].z), fabsf(a[j].w))), fmaxf(fmaxf(fabsf(b[j].x), fabsf(b[j].y)), fmaxf(fabsf(b[j].z), fabsf(b[j].w))))); }
          am = wave_maxf(am); const float inv = am > 0.f ? 127.0f / am : 0.f; if (F.lane == 0) sx[m] = am * (1.0f / 127.0f);
#pragma unroll
          for (int j = 0; j < 8; ++j) { const size_t c = (size_t)m * DM + (64 * j + F.lane) * 8;
              v2u o; o.x = pk4_i8(a[j].x * inv, a[j].y * inv, a[j].z * inv, a[j].w * inv); o.y = pk4_i8(b[j].x * inv, b[j].y * inv, b[j].z * inv, b[j].w * inv); *(GAS v2u*)(X8 + c) = o; } } }
#endif
    { const float* x = w_xq; bf16* XB = WXQ;
      for (size_t i = gt; i < (size_t)DM * DM / 8; i += NT) { const f32x4 a = *(const GAS f32x4*)(x + i * 8), b = *(const GAS f32x4*)(x + i * 8 + 4);
          v4u o; o.x = pk2(a.x, a.y); o.y = pk2(a.z, a.w); o.z = pk2(b.x, b.y); o.w = pk2(b.z, b.w); *(GAS v4u*)(XB + i * 8) = o; } }
    { bf16* WPR = WPOOL;
      for (size_t i = gt; i < (size_t)4 * 512 * 512 / 8; i += NT) { const size_t e = i * 8; const int d = (int)(e & 511), g = (int)(e >> 18);
          const f32x4 a = *(const GAS f32x4*)(w_pool + e), b = *(const GAS f32x4*)(w_pool + e + 4), s0 = *(const GAS f32x4*)(pool_scale + g * 512 + d), s1 = *(const GAS f32x4*)(pool_scale + g * 512 + d + 4);
          v4u o; o.x = pk2(a.x * s0.x, a.y * s0.y); o.y = pk2(a.z * s0.z, a.w * s0.w); o.z = pk2(b.x * s1.x, b.y * s1.y); o.w = pk2(b.z * s1.z, b.w * s1.w); *(GAS v4u*)(WPR + e) = o; } }
    { const float* x = in[1]; bf16* XB = (bf16*)(F.ws + WS_MEMB);
      for (size_t i = gt; i < (size_t)BATCH * MEMLEN * DM / 8; i += NT) { const f32x4 a = *(const GAS f32x4*)(x + i * 8), b = *(const GAS f32x4*)(x + i * 8 + 4);
          v4u o; o.x = pk2(a.x, a.y); o.y = pk2(a.z, a.w); o.z = pk2(b.x, b.y); o.w = pk2(b.z, b.w); *(GAS v4u*)(XB + i * 8) = o; } }
    { float2* tab = (float2*)(F.ws + WS_ROPE);
      for (size_t i = gt; i < (size_t)SEQ * 64; i += NT) { const int pos = (int)(i >> 6), fi = (int)(i & 63); const float ang = (float)pos * rope_inv(fi);
          double s, c; sincos_d((double)ang, s, c); tab[i] = make_float2((float)c, (float)s); } }
    for (int it = gw; it < NITEMS; it += NGW) {
        int r = it;
        if (r < I_IN) { p0_transpose_item(w_mix_in, DM, MIXIN, WIN, scr, r, F.lane, RmMixIn{}, nullptr); continue; } r -= I_IN;
        if (r < I_SQ) { const int kb = r / (DM / 32);
            if (kb < 32) p0_transpose_item(w_mix_out, 2048, DM, WOUT, scr, r, F.lane, RmIdent{0}, nullptr);
            else p0_transpose_item(w_mix_out, DM, DM, (bf16*)(F.ws + WS_WOUT2), scr, r, F.lane, RmIdent{0}, nullptr); continue; } r -= I_SQ;
        if (r < I_KV) { p0_transpose_item(w_xkv, DM, 2 * DM, WXKV, scr, r, F.lane, RmIdent{0}, nullptr); continue; } r -= I_KV;
        if (r < I_SQ) { p0_transpose_item(w_xo, DM, DM, WXO, scr, r, F.lane, RmIdent{0}, nullptr); continue; } r -= I_SQ;
        (void)w_gate; (void)w_up; (void)WGU;
#if defined(GU_IN_P0)
#if defined(GU_BF16)
        float* c1g = (float*)(F.ctl + CW_C1G); float* c2g = (float*)(F.ctl + CW_C2G);
        if (r < I_GU) { p0_transpose_item(w_gate, DM, FF, WGU, scr, r, F.lane, RmGateUp{0}, nullptr, in[11], in[12], c1g, c2g); continue; } r -= I_GU;
        p0_transpose_item(w_up, DM, FF, WGU, scr, r, F.lane, RmGateUp{1}, nullptr, in[11], in[12], c1g, c2g);
#else
        bf16* WTMP = (bf16*)(F.ws + WS_WTMP);
        if (r < I_GU) { p0_transpose_item(w_gate, DM, FF, WTMP, scr, r, F.lane, RmGateUp{0}, nullptr); continue; } r -= I_GU;
        p0_transpose_item(w_up, DM, FF, WTMP, scr, r, F.lane, RmGateUp{1}, nullptr);
#endif
#endif
    }
}

__device__ __forceinline__ void convert_wdown(Frame& F, const float* w_down, gu32* ctr) {
    LAS float* scr = (LAS float*)(F.lds + RING_OFF + F.wave * 16384); bf16* WDN = (bf16*)(F.ws + WS_WDN);
    constexpr int I_DN = (FF / 64) * (DM / 32);
    for (;;) { int base = 0; if (F.lane == 0) base = (int)__hip_atomic_fetch_add(ctr, 16u, RLX_AGENT); base = __builtin_amdgcn_readfirstlane(base);
        if (base >= I_DN) break;
        for (int it = base; it < base + 16 && it < I_DN; ++it) p0_transpose_item(w_down, FF, DM, WDN, scr, it, F.lane, RmIdent{0}, nullptr); }
}
__device__ __forceinline__ void convert_wdown_static(Frame& F, const float* w_down, int rk, int nwg) {
    LAS float* scr = (LAS float*)(F.lds + RING_OFF + F.wave * 16384); bf16* WDN = (bf16*)(F.ws + WS_WDN);
    constexpr int I_DN = (FF / 64) * (DM / 32);
    for (int it = rk * NWAVES + F.wave; it < I_DN; it += nwg * NWAVES) p0_transpose_item(w_down, FF, DM, WDN, scr, it, F.lane, RmIdent{0}, nullptr);
}

__device__ __forceinline__ bool gu_chunk(Frame& F, const float* const* in, gu32* q) {
    LAS float* scr = (LAS float*)(F.lds + RING_OFF + F.wave * 16384); bf16* WGU = (bf16*)(F.ws + WS_WGU);
    float* c1g = (float*)(F.ctl + CW_C1G); float* c2g = (float*)(F.ctl + CW_C2G);
    constexpr int I_GU = (DM / 64) * (FF / 32);
    int base = 0; if (F.lane == 0) base = (int)__hip_atomic_fetch_add(q, 4u, RLX_AGENT); base = __builtin_amdgcn_readfirstlane(base);
    if (base >= 2 * I_GU) return false;
    for (int it = base; it < base + 4; ++it) {
        if (it < I_GU) p0_transpose_item(in[13], DM, FF, WGU, scr, it, F.lane, RmGateUp{0}, nullptr, in[11], in[12], c1g, c2g);
        else p0_transpose_item(in[14], DM, FF, WGU, scr, it - I_GU, F.lane, RmGateUp{1}, nullptr, in[11], in[12], c1g, c2g); }
    return true;
}
__device__ __forceinline__ void gu_filler(Frame& F, const float* const* in, int slot) {
#if !defined(GU_IN_P0)
    gu32* q = F.ctl + CW_DYN + 4096 + 64; gu32* done = F.ctl + CW_DYN + 4096 + 128 + 64 * slot;
    __syncthreads();
    if (F.tid == 0) __hip_atomic_fetch_add(done, 1u, RLX_AGENT);
    for (;;) { if ((int)__builtin_amdgcn_readfirstlane((int)__hip_atomic_load(done, RLX_AGENT)) >= F.G) break; if (!gu_chunk(F, in, q)) break; }
#endif
}
__device__ __forceinline__ void gu_drain(Frame& F, const float* const* in) {
#if !defined(GU_IN_P0)
    gu32* q = F.ctl + CW_DYN + 4096 + 64;
    while (gu_chunk(F, in, q)) { }
#endif
}

__device__ __forceinline__ void ln_finalize(Frame& F, const float2* slots, float2* stats) {
    const int gw = blockIdx.x * NWAVES + F.wave, NGW = F.G * NWAVES;
    for (int m = gw; m < M; m += NGW) { const float2 p = slots[(size_t)m * 64 + F.lane];
        const float s = wave_sum(p.x), q = wave_sum(p.y), mean = s * (1.f / DM), var = fmaxf(q * (1.f / DM) - mean * mean, 0.f);
        if (F.lane == 0) stats[m] = make_float2(mean, 1.f / sqrtf(var + LN_EPS)); }
}

template <bool FINAL>
__device__ __forceinline__ void ln_rows(Frame& F, const bf16* T, bf16* XB, float2* stats, float* OUT, const float* g, const float* b) {
#ifndef LN_NR
#define LN_NR 2
#endif
    constexpr int NR = LN_NR;
    const int gw = blockIdx.x * NWAVES + F.wave, NGW = F.G * NWAVES;
    for (int mb = gw; mb < M; mb += NR * NGW) {
        int mr[NR]; v4u r[NR][8];
#pragma unroll
        for (int i = 0; i < NR; ++i) { mr[i] = (mb + i * NGW < M) ? mb + i * NGW : mb;
            const GAS v4u* tr = (const GAS v4u*)(T + (size_t)mr[i] * DM) + F.lane;
#pragma unroll
            for (int j = 0; j < 8; ++j) r[i][j] = tr[64 * j]; }
        float mean[NR], rstd[NR];
#pragma unroll
        for (int i = 0; i < NR; ++i) { float s = 0.f;
#pragma unroll
            for (int j = 0; j < 8; ++j) s += ((bf_lo(r[i][j].x) + bf_hi(r[i][j].x)) + (bf_lo(r[i][j].y) + bf_hi(r[i][j].y))) + ((bf_lo(r[i][j].z) + bf_hi(r[i][j].z)) + (bf_lo(r[i][j].w) + bf_hi(r[i][j].w)));
            mean[i] = wave_sum(s) * (1.f / DM); }
#pragma unroll
        for (int i = 0; i < NR; ++i) { float q = 0.f; const float mu = mean[i];
#pragma unroll
            for (int j = 0; j < 8; ++j) { float d;
                d = bf_lo(r[i][j].x) - mu; q += d * d; d = bf_hi(r[i][j].x) - mu; q += d * d; d = bf_lo(r[i][j].y) - mu; q += d * d; d = bf_hi(r[i][j].y) - mu; q += d * d;
                d = bf_lo(r[i][j].z) - mu; q += d * d; d = bf_hi(r[i][j].z) - mu; q += d * d; d = bf_lo(r[i][j].w) - mu; q += d * d; d = bf_hi(r[i][j].w) - mu; q += d * d; }
            rstd[i] = 1.f / sqrtf(wave_sum(q) * (1.f / DM) + LN_EPS); }
        if (!FINAL && F.lane == 0) {
#pragma unroll
            for (int i = 0; i < NR; ++i) stats[mr[i]] = make_float2(mean[i], rstd[i]); }
#pragma unroll
        for (int j = 0; j < 8; ++j) { const int c = (64 * j + F.lane) * 8;
            const f32x4 g0 = *(const GAS f32x4*)(g + c), g1 = *(const GAS f32x4*)(g + c + 4), b0 = *(const GAS f32x4*)(b + c), b1 = *(const GAS f32x4*)(b + c + 4);
#pragma unroll
            for (int i = 0; i < NR; ++i) { const float mu = mean[i], rs = rstd[i];
                const f32x4 ya = ((f32x4){bf_lo(r[i][j].x), bf_hi(r[i][j].x), bf_lo(r[i][j].y), bf_hi(r[i][j].y)} - mu) * rs * g0 + b0;
                const f32x4 yb = ((f32x4){bf_lo(r[i][j].z), bf_hi(r[i][j].z), bf_lo(r[i][j].w), bf_hi(r[i][j].w)} - mu) * rs * g1 + b1;
                if (FINAL) { *(GAS f32x4*)(OUT + (size_t)mr[i] * DM + c) = ya; *(GAS f32x4*)(OUT + (size_t)mr[i] * DM + c + 4) = yb; }
                else { v4u o; o.x = pk2(ya.x, ya.y); o.y = pk2(ya.z, ya.w); o.z = pk2(yb.x, yb.y); o.w = pk2(yb.z, yb.w); *(GAS v4u*)(XB + (size_t)mr[i] * DM + c) = o; } } }
    }
}

__device__ __forceinline__ void quant_rows(Frame& F, const bf16* T, unsigned char* Q, float* sb, const int NROW) {
    constexpr int NR = QW_NR;
    const int gw = blockIdx.x * NWAVES + F.wave, NGW = F.G * NWAVES;
    for (int mb = gw; mb < NROW; mb += NR * NGW) {
        int mr[NR]; v4u r[NR][8];
#pragma unroll
        for (int i = 0; i < NR; ++i) { mr[i] = (mb + i * NGW < NROW) ? mb + i * NGW : mb;
            const GAS v4u* tr = (const GAS v4u*)(T + (size_t)mr[i] * DM) + F.lane;
#pragma unroll
            for (int j = 0; j < 8; ++j) r[i][j] = tr[64 * j]; }
#pragma unroll
        for (int i = 0; i < NR; ++i) { float a = 0.f;
#pragma unroll
            for (int j = 0; j < 8; ++j) { const v4u w = r[i][j];
                a = fmaxf(a, fmaxf(fmaxf(fmaxf(fabsf(bf_lo(w.x)), fabsf(bf_hi(w.x))), fmaxf(fabsf(bf_lo(w.y)), fabsf(bf_hi(w.y)))), fmaxf(fmaxf(fabsf(bf_lo(w.z)), fabsf(bf_hi(w.z))), fmaxf(fabsf(bf_lo(w.w)), fabsf(bf_hi(w.w)))))); }
            a = wave_maxf(a); const float inv = a > 0.f ? 127.0f / a : 0.f;
            if (F.lane == 0) sb[mr[i]] = a * (1.0f / 127.0f);
            GAS v2u* qr = (GAS v2u*)(Q + (size_t)mr[i] * DM) + F.lane;
#pragma unroll
            for (int j = 0; j < 8; ++j) { const v4u w = r[i][j]; v2u o;
                o.x = pk4_i8(bf_lo(w.x) * inv, bf_hi(w.x) * inv, bf_lo(w.y) * inv, bf_hi(w.y) * inv); o.y = pk4_i8(bf_lo(w.z) * inv, bf_hi(w.z) * inv, bf_lo(w.w) * inv, bf_hi(w.w) * inv);
                qr[64 * j] = o; } }
    }
}
__device__ __forceinline__ void quant_wgu(Frame& F) {
    quant_rows(F, (const bf16*)(F.ws + WS_WTMP), F.ws + WS_WGU, (float*)(F.ctl + CW_SB), 2 * FF);
#if MIX8 == 1
    quant_rows(F, (const bf16*)(F.ws + WS_WIN) + (size_t)6144 * DM, F.ws + WS_W8IN, (float*)(F.ctl + CW_SBIN), 2048);
#elif MIX8 == 3
    quant_rows(F, (const bf16*)(F.ws + WS_WIN) + (size_t)4096 * DM, F.ws + WS_W8IN, (float*)(F.ctl + CW_SBIN), 4096);
#elif MIX8 == 2
    quant_rows(F, (const bf16*)(F.ws + WS_WIN), F.ws + WS_W8IN, (float*)(F.ctl + CW_SBIN), 2048);
    quant_rows(F, (const bf16*)(F.ws + WS_WIN) + (size_t)6144 * DM, F.ws + WS_W8IN + (size_t)2048 * DM, (float*)(F.ctl + CW_SBIN) + 2048, 2048);
#endif
}

__device__ __forceinline__ void ln_rows_q8(Frame& F, const bf16* T, unsigned char* H8, float* sa, float2* stats, const float* g, const float* b) {
    constexpr int NR = Q8_NR;
    const int gw = blockIdx.x * NWAVES + F.wave, NGW = F.G * NWAVES;
    LAS float* gl = (LAS float*)(F.lds + RING_OFF); LAS float* bl = gl + DM;
    for (int u = F.tid; u < DM / 4; u += NWAVES * 64) { *(LAS f32x4*)(gl + 4 * u) = *(const GAS f32x4*)(g + 4 * u); *(LAS f32x4*)(bl + 4 * u) = *(const GAS f32x4*)(b + 4 * u); }
    __syncthreads();
    for (int mb = gw; mb < M; mb += NR * NGW) {
        int mr[NR]; v4u r[NR][8];
#pragma unroll
        for (int i = 0; i < NR; ++i) { mr[i] = (mb + i * NGW < M) ? mb + i * NGW : mb;
            const GAS v4u* tr = (const GAS v4u*)(T + (size_t)mr[i] * DM) + F.lane;
#pragma unroll
            for (int j = 0; j < 8; ++j) r[i][j] = tr[64 * j]; }
        float mean[NR], rstd[NR];
#pragma unroll
        for (int i = 0; i < NR; ++i) { float s = 0.f;
#pragma unroll
            for (int j = 0; j < 8; ++j) s += ((bf_lo(r[i][j].x) + bf_hi(r[i][j].x)) + (bf_lo(r[i][j].y) + bf_hi(r[i][j].y))) + ((bf_lo(r[i][j].z) + bf_hi(r[i][j].z)) + (bf_lo(r[i][j].w) + bf_hi(r[i][j].w)));
            mean[i] = wave_sum(s) * (1.f / DM); }
#pragma unroll
        for (int i = 0; i < NR; ++i) { float q = 0.f; const float mu = mean[i];
#pragma unroll
            for (int j = 0; j < 8; ++j) { float d;
                d = bf_lo(r[i][j].x) - mu; q += d * d; d = bf_hi(r[i][j].x) - mu; q += d * d; d = bf_lo(r[i][j].y) - mu; q += d * d; d = bf_hi(r[i][j].y) - mu; q += d * d;
                d = bf_lo(r[i][j].z) - mu; q += d * d; d = bf_hi(r[i][j].z) - mu; q += d * d; d = bf_lo(r[i][j].w) - mu; q += d * d; d = bf_hi(r[i][j].w) - mu; q += d * d; }
            rstd[i] = 1.f / sqrtf(wave_sum(q) * (1.f / DM) + LN_EPS); }
        if (F.lane == 0) {
#pragma unroll
            for (int i = 0; i < NR; ++i) stats[mr[i]] = make_float2(mean[i], rstd[i]); }
#pragma unroll
        for (int i = 0; i < NR; ++i) { const float mu = mean[i], rs = rstd[i]; float am = 0.f;
#pragma unroll
            for (int j = 0; j < 8; ++j) { const int c = (64 * j + F.lane) * 8;
                const f32x4 g0 = *(const LAS f32x4*)(gl + c), g1 = *(const LAS f32x4*)(gl + c + 4), b0 = *(const LAS f32x4*)(bl + c), b1 = *(const LAS f32x4*)(bl + c + 4);
                const f32x4 ya = ((f32x4){bf_lo(r[i][j].x), bf_hi(r[i][j].x), bf_lo(r[i][j].y), bf_hi(r[i][j].y)} - mu) * rs * g0 + b0;
                const f32x4 yb = ((f32x4){bf_lo(r[i][j].z), bf_hi(r[i][j].z), bf_lo(r[i][j].w), bf_hi(r[i][j].w)} - mu) * rs * g1 + b1;
                am = fmaxf(am, fmaxf(fmaxf(fmaxf(fabsf(ya.x), fabsf(ya.y)), fmaxf(fabsf(ya.z), fabsf(ya.w))), fmaxf(fmaxf(fabsf(yb.x), fabsf(yb.y)), fmaxf(fabsf(yb.z), fabsf(yb.w))))); }
            am = wave_maxf(am); const float iv = am > 0.f ? 127.0f / am : 0.f; if (F.lane == 0) sa[mr[i]] = am * (1.0f / 127.0f);
            asm volatile("" ::: "memory");
#pragma unroll
            for (int j = 0; j < 8; ++j) { const int c = (64 * j + F.lane) * 8;
                const f32x4 g0 = *(const LAS f32x4*)(gl + c), g1 = *(const LAS f32x4*)(gl + c + 4), b0 = *(const LAS f32x4*)(bl + c), b1 = *(const LAS f32x4*)(bl + c + 4);
                const f32x4 ya = (((f32x4){bf_lo(r[i][j].x), bf_hi(r[i][j].x), bf_lo(r[i][j].y), bf_hi(r[i][j].y)} - mu) * rs * g0 + b0) * iv;
                const f32x4 yb = (((f32x4){bf_lo(r[i][j].z), bf_hi(r[i][j].z), bf_lo(r[i][j].w), bf_hi(r[i][j].w)} - mu) * rs * g1 + b1) * iv;
                v2u o; o.x = pk4_i8(ya.x, ya.y, ya.z, ya.w); o.y = pk4_i8(yb.x, yb.y, yb.z, yb.w);
                *(GAS v2u*)(H8 + (size_t)mr[i] * DM + c) = o; }
            asm volatile("" ::: "memory"); }
    }
    __syncthreads();
}

__device__ __forceinline__ void up8(const v4u& r, float (&f)[8]) { f[0] = bf_lo(r.x); f[1] = bf_hi(r.x); f[2] = bf_lo(r.y); f[3] = bf_hi(r.y); f[4] = bf_lo(r.z); f[5] = bf_hi(r.z); f[6] = bf_lo(r.w); f[7] = bf_hi(r.w); }
template <int W>
__device__ __forceinline__ void pool_run(const bf16* HP, bf16* PMo, int t0, int c) {
    const int tp0 = t0 & (SEQ - 1);
    v4u raw[16 + W - 1];
#pragma unroll
    for (int j = 0; j < 16 + W - 1; ++j) { const int dt = j - (W - 1); raw[j] = (v4u){0u, 0u, 0u, 0u}; if (tp0 + dt >= 0) raw[j] = *(const GAS v4u*)(HP + (size_t)(t0 + dt) * PW + c); }
    float S[8], u[8];
#pragma unroll
    for (int e = 0; e < 8; ++e) S[e] = 0.f;
#pragma unroll
    for (int j = 0; j < W - 1; ++j) { up8(raw[j], u);
#pragma unroll
        for (int e = 0; e < 8; ++e) S[e] += u[e]; }
#pragma unroll
    for (int i = 0; i < 16; ++i) {
        up8(raw[W - 1 + i], u);
#pragma unroll
        for (int e = 0; e < 8; ++e) S[e] += u[e];
        const int tp = tp0 + i; const float inv = (tp + 1 < W) ? 1.0f / (float)(tp + 1) : 1.0f / (float)W;
        v4u o; o.x = pk2(S[0] * inv - u[0], S[1] * inv - u[1]); o.y = pk2(S[2] * inv - u[2], S[3] * inv - u[3]);
        o.z = pk2(S[4] * inv - u[4], S[5] * inv - u[5]); o.w = pk2(S[6] * inv - u[6], S[7] * inv - u[7]);
        *(GAS v4u*)(PMo + (size_t)(t0 + i) * DM + c) = o;
        float d[8]; up8(raw[i], d);
#pragma unroll
        for (int e = 0; e < 8; ++e) S[e] -= d[e];
    }
}
__device__ __forceinline__ void pool_ew(Frame& F) {
    const bf16* HP = (const bf16*)(F.ws + WS_HP); bf16* PMo = (bf16*)(F.ws + WS_CAT);
    const size_t gt = (size_t)blockIdx.x * (NWAVES * 64) + F.tid, NT = (size_t)F.G * NWAVES * 64;
    for (size_t idx = gt; idx < (size_t)(M / 16) * 256; idx += NT) {
        const int t0 = (int)(idx >> 8) * 16, c = (int)(idx & 255) * 8, grp = __builtin_amdgcn_readfirstlane(c >> 9);
        if (grp == 0) pool_run<2>(HP, PMo, t0, c); else if (grp == 1) pool_run<4>(HP, PMo, t0, c); else if (grp == 2) pool_run<8>(HP, PMo, t0, c); else pool_run<16>(HP, PMo, t0, c);
    }
}
__device__ __forceinline__ void kv_reduce(Frame& F) {
    const float* SK = (const float*)(F.ws + WS_SLAB); bf16* KVX = (bf16*)(F.ws + WS_KVX);
    const size_t gt = (size_t)blockIdx.x * (NWAVES * 64) + F.tid, NT = (size_t)F.G * NWAVES * 64, NE = (size_t)512 * 8192;
    for (size_t i = gt; i < NE / 4; i += NT) { const float* sb = SK + i * 4;
        const f32x4 a = *(const GAS f32x4*)sb + *(const GAS f32x4*)(sb + NE) + *(const GAS f32x4*)(sb + 2 * NE) + *(const GAS f32x4*)(sb + 3 * NE);
        v2u o; o.x = pk2(a.x, a.y); o.y = pk2(a.z, a.w); *(GAS v2u*)(KVX + i * 4) = o; }
}

__device__ __forceinline__ void kmean_phase(Frame& F) {
    const bf16* Kb = (const bf16*)(F.ws + WS_K); bf16* KMH = (bf16*)(F.ws + WS_KMH); bf16* KML = (bf16*)(F.ws + WS_KML);
    LAS float* part = (LAS float*)(F.lds + RING_OFF);
    for (int item = blockIdx.x; item < 64 * 4; item += F.G) {
        const int bn = item >> 2, chunk = item & 3;
        float acc[8];
#pragma unroll
        for (int e = 0; e < 8; ++e) acc[e] = 0.f;
        const bf16* base = Kb + (size_t)(bn * 256 + F.wave * 32) * AW + chunk * 512 + F.lane * 8;
#pragma unroll
        for (int r = 0; r < 32; ++r) { const v4u q = *(const GAS v4u*)(base + (size_t)r * AW);
            acc[0] += bf_lo(q.x); acc[1] += bf_hi(q.x); acc[2] += bf_lo(q.y); acc[3] += bf_hi(q.y); acc[4] += bf_lo(q.z); acc[5] += bf_hi(q.z); acc[6] += bf_lo(q.w); acc[7] += bf_hi(q.w); }
#pragma unroll
        for (int e = 0; e < 8; ++e) part[F.wave * 512 + F.lane * 8 + e] = acc[e];
        __syncthreads();
        { float s = 0.f;
#pragma unroll
          for (int w = 0; w < 8; ++w) s += part[w * 512 + F.tid];
          const float mean = s * (1.0f / 256.0f); const unsigned hb = f2bf(mean); const float hf = __builtin_bit_cast(float, hb << 16);
          KMH[(size_t)bn * AW + chunk * 512 + F.tid] = (bf16)hb; KML[(size_t)bn * AW + chunk * 512 + F.tid] = (bf16)f2bf(mean - hf); }
        __syncthreads();
    }
}

__device__ __forceinline__ void gate_phase(Frame& F) {
    const bf16* Qb = (const bf16*)(F.ws + WS_Q); const bf16* KMH = (const bf16*)(F.ws + WS_KMH); const bf16* KML = (const bf16*)(F.ws + WS_KML);
    unsigned short* lists = (unsigned short*)(F.ws + WS_LIST); gu32* gcnt = F.ctl + CW_GCNT;
    LAS float* gl = (LAS float*)(F.lds + RING_OFF);
    LAS unsigned* lcnt = (LAS unsigned*)(F.lds + RING_OFF + 34816);
    LAS unsigned* gb = lcnt + 32;
    const int r32 = F.lane & 31, hi = F.lane >> 5;
    for (int uid = blockIdx.x; uid < 1024; uid += F.G) {
        const int bh = uid >> 5, qb = uid & 31, b = bh >> 4, h = bh & 15;
        if (qb == 0) continue;
        if (F.tid < 32) lcnt[F.tid] = 0u;
        const size_t trow = (size_t)b * SEQ + 256 * qb + 32 * F.wave + r32;
        f32x16 acc = {};
#pragma unroll
        for (int s = 0; s < 8; ++s) {
            const bf16x8 bq = *(const GAS bf16x8*)(Qb + trow * AW + h * HD + 16 * s + 8 * hi);
            const bf16x8 ah = *(const GAS bf16x8*)(KMH + (size_t)(b * 32 + r32) * AW + h * HD + 16 * s + 8 * hi);
            const bf16x8 al = *(const GAS bf16x8*)(KML + (size_t)(b * 32 + r32) * AW + h * HD + 16 * s + 8 * hi);
            acc = __builtin_amdgcn_mfma_f32_32x32x16_bf16(ah, bq, acc, 0, 0, 0);
            acc = __builtin_amdgcn_mfma_f32_32x32x16_bf16(al, bq, acc, 0, 0, 0);
        }
#pragma unroll
        for (int r = 0; r < 16; ++r) gl[(32 * F.wave + r32) * 33 + att::crow(r, hi)] = acc[r];
        __syncthreads();
        int s0 = 0, s1 = 0, s2 = 0; unsigned p0 = 0, p1 = 0, p2 = 0; const int nsel = qb < 3 ? qb : 3;
        if (F.tid < 256) {
            float v0 = -__builtin_inff(), v1 = v0, v2 = v0;
            for (int n = 0; n < qb; ++n) { const float g = gl[F.tid * 33 + n];
                if (g > v0) { v2 = v1; s2 = s1; v1 = v0; s1 = s0; v0 = g; s0 = n; }
                else if (g > v1) { v2 = v1; s2 = s1; v1 = g; s1 = n; }
                else if (g > v2) { v2 = g; s2 = n; } }
            p0 = __hip_atomic_fetch_add(lcnt + s0, 1u, __ATOMIC_RELAXED, __HIP_MEMORY_SCOPE_WORKGROUP);
            if (nsel > 1) p1 = __hip_atomic_fetch_add(lcnt + s1, 1u, __ATOMIC_RELAXED, __HIP_MEMORY_SCOPE_WORKGROUP);
            if (nsel > 2) p2 = __hip_atomic_fetch_add(lcnt + s2, 1u, __ATOMIC_RELAXED, __HIP_MEMORY_SCOPE_WORKGROUP);
        }
        __syncthreads();
        if (F.tid < 32) { const unsigned c = lcnt[F.tid]; gb[F.tid] = c ? __hip_atomic_fetch_add(gcnt + bh * 32 + F.tid, c, RLX_AGENT) : 0u; }
        __syncthreads();
        if (F.tid < 256) {
            unsigned short* lb = lists + (size_t)bh * LIST_STRIDE; const unsigned tl = (unsigned)(256 * qb + F.tid);
            lb[list_off(s0) + gb[s0] + p0] = (unsigned short)(tl | (0u << 13));
            if (nsel > 1) lb[list_off(s1) + gb[s1] + p1] = (unsigned short)(tl | (1u << 13));
            if (nsel > 2) lb[list_off(s2) + gb[s2] + p2] = (unsigned short)(tl | (2u << 13));
        }
        __syncthreads();
    }
}

__device__ __forceinline__ void attn_phase(Frame& F, char* ldsg) {
    const bf16* Qb = (const bf16*)(F.ws + WS_Q); const bf16* Kb = (const bf16*)(F.ws + WS_K); const bf16* Vb = (const bf16*)(F.ws + WS_V);
    bf16* PO = (bf16*)(F.ws + WS_PARTO); float2* ML = (float2*)(F.ws + WS_ML);
    const unsigned short* lists = (const unsigned short*)(F.ws + WS_LIST); const gu32* gcnt = F.ctl + CW_GCNT;
    LAS int* pre = (LAS int*)(F.lds + RING_OFF + 67584);
    for (int i = F.tid; i < 1024; i += NWAVES * 64) pre[i] = (int)((__hip_atomic_load(gcnt + i, RLX_AGENT) + 255u) >> 8);
    __syncthreads();
    if (F.wave == 0) {
        int loc[16]; int s = 0;
#pragma unroll
        for (int k = 0; k < 16; ++k) { loc[k] = pre[F.lane * 16 + k]; s += loc[k]; }
        int incl = s;
#pragma unroll
        for (int o = 1; o < 64; o <<= 1) { const int v = __shfl_up(incl, o); if (F.lane >= o) incl += v; }
        int run = incl - s;
#pragma unroll
        for (int k = 0; k < 16; ++k) { pre[F.lane * 16 + k] = run; run += loc[k]; }
        if (F.lane == 63) pre[1024] = incl;
    }
    __syncthreads();
    const int total = 1024 + pre[1024];
    LAS int* DSC = (LAS int*)(F.lds + RING_OFF + 67584 + 4224);
    const int nloc = (total > (int)blockIdx.x) ? (total - (int)blockIdx.x + F.G - 1) / F.G : 0;
    if (F.tid < nloc && F.tid < 64) {
        const int id = blockIdx.x + F.tid * F.G; int bhj, own, lpos, cnt;
        if (id < 1024) { bhj = id; own = 1; lpos = 0; cnt = 256; }
        else { const int x = id - 1024; int lo = 0, hi2 = 1023;
            while (lo < hi2) { const int mid = (lo + hi2 + 1) >> 1; if (pre[mid] <= x) lo = mid; else hi2 = mid - 1; }
            const int li = lo, chunk = x - pre[li]; bhj = li; own = 0; lpos = (li >> 5) * LIST_STRIDE + list_off(li & 31) + 256 * chunk;
            const int c = (int)__hip_atomic_load(gcnt + li, RLX_AGENT) - 256 * chunk; cnt = c < 256 ? c : 256; }
        DSC[4 * F.tid] = bhj; DSC[4 * F.tid + 1] = own; DSC[4 * F.tid + 2] = lpos; DSC[4 * F.tid + 3] = cnt;
    }
    __syncthreads();
    att::ItemCtx C{Qb, Kb, Vb, PO, ML, lists};
    att::attn_items(C, (const LAS int*)DSC, nloc < 64 ? nloc : 64, ldsg);
}


#if defined(MOBA_CHECK) && MOBA_CHECK
__device__ __forceinline__ float wave_max(float v) {
#pragma unroll
    for (int o = 1; o < 64; o <<= 1) v = fmaxf(v, __shfl_xor(v, o));
    return v;
}
__device__ __forceinline__ void moba_check(Frame& F) {
    const bf16* Qb = (const bf16*)(F.ws + WS_Q); const bf16* Kb = (const bf16*)(F.ws + WS_K); const bf16* Vb = (const bf16*)(F.ws + WS_V);
    const bf16* KMH = (const bf16*)(F.ws + WS_KMH); const bf16* KML = (const bf16*)(F.ws + WS_KML); const bf16* CAT = (const bf16*)(F.ws + WS_CAT);
    LAS float* pl = (LAS float*)(F.lds + RING_OFF + F.wave * 8192);
    LAS float* ql = pl + 1024;
    const int gw = blockIdx.x * NWAVES + F.wave, NGW = F.G * NWAVES;
    for (int s = gw; s < 4096; s += NGW) {
        const unsigned hsh = (unsigned)s * 2654435761u; const int bh = (hsh >> 8) & 31; int t = (hsh >> 13) & 8191; if ((s & 7) == 0) t &= 1023;
        const int b = bh >> 4, h = bh & 15, qb = t >> 8, tl = t & 255;
        const bf16* qrow = Qb + ((size_t)b * SEQ + t) * AW + h * HD;
        ql[F.lane] = bf2f(qrow[F.lane]); ql[64 + F.lane] = bf2f(qrow[64 + F.lane]); LDS_WAIT();
        float g = -__builtin_inff();
        if (F.lane < qb) { const bf16* kh = KMH + (size_t)(b * 32 + F.lane) * AW + h * HD; const bf16* kl = KML + (size_t)(b * 32 + F.lane) * AW + h * HD; float a = 0.f;
            for (int d = 0; d < 128; ++d) a += ql[d] * (bf2f(kh[d]) + bf2f(kl[d])); g = a; }
        int sel[3]; const int nsel = qb < 3 ? qb : 3;
#pragma unroll
        for (int k = 0; k < 3; ++k) { const float mx = wave_max(g); const unsigned long long bal = __ballot(g == mx && F.lane < qb); const int idx = bal ? (int)__builtin_ctzll(bal) : 0; sel[k] = idx; if (F.lane == idx) g = -__builtin_inff(); }
        float sc[4][4]; float mx = -1e30f;
#pragma unroll
        for (int u = 0; u < 4; ++u) { const bool on = (u == 3) || (u < nsel); const int j = (u == 3) ? qb : sel[u];
#pragma unroll
            for (int r = 0; r < 4; ++r) { const int key = F.lane + 64 * r; float a = -1e30f;
                if (on && !(u == 3 && key > tl)) { const bf16* kr = Kb + ((size_t)b * SEQ + 256 * j + key) * AW + h * HD; a = 0.f; for (int d = 0; d < 128; ++d) a += ql[d] * bf2f(kr[d]); a *= 0.088388347648318440f; }
                sc[u][r] = a; mx = fmaxf(mx, a); } }
        mx = wave_max(mx); float sum = 0.f;
#pragma unroll
        for (int u = 0; u < 4; ++u)
#pragma unroll
            for (int r = 0; r < 4; ++r) { const float p = (sc[u][r] > -1e29f) ? __expf(sc[u][r] - mx) : 0.f; sum += p; pl[u * 256 + F.lane + 64 * r] = p; }
        sum = wave_sum(sum); LDS_WAIT();
        float o0 = 0.f, o1 = 0.f;
#pragma unroll
        for (int u = 0; u < 4; ++u) { const bool on = (u == 3) || (u < nsel); const int j = (u == 3) ? qb : sel[u];
            if (on) for (int key = 0; key < 256; ++key) { const float p = pl[u * 256 + key]; const bf16* vr = Vb + ((size_t)b * SEQ + 256 * j + key) * AW + h * HD; o0 += p * bf2f(vr[F.lane]); o1 += p * bf2f(vr[64 + F.lane]); } }
        o0 /= sum; o1 /= sum;
        const bf16* cr = CAT + ((size_t)b * SEQ + t) * DM + PW + h * HD; const float c0 = bf2f(cr[F.lane]), c1 = bf2f(cr[64 + F.lane]);
        const bool bad = !(fabsf(c0 - o0) <= 1.5e-3f + 0.03f * fabsf(o0)) || !(fabsf(c1 - o1) <= 1.5e-3f + 0.03f * fabsf(o1));
        const unsigned long long bb = __ballot(bad);
        if (F.lane == 0 && bb) __hip_atomic_fetch_add(F.ctl + CW_CHK, 1u, RLX_AGENT);
        if (F.lane == 0) __hip_atomic_fetch_add(F.ctl + CW_CHK + 1, 1u, RLX_AGENT);
        LDS_WAIT();
    }
}
#endif


#if defined(XATTN_CHECK) && XATTN_CHECK
__device__ __noinline__ void xattn_check_a(unsigned char* ws, gu32* ctl, const float* mem, const float* w_xq, const float* w_xkv, const float* w_xo, const float* g1, int G) {
    const int lane = threadIdx.x & 63, wave = threadIdx.x >> 6;
    const bf16* KVX = (const bf16*)(ws + WS_KVX); const bf16* WQK = (const bf16*)(ws + WS_WQK); const bf16* WVOT = (const bf16*)(ws + WS_WVOT);
    const int gw = blockIdx.x * NWAVES + wave, NGW = G * NWAVES;
    for (int s = gw; s < 3 * 2048; s += NGW) {
        const unsigned hsh = (unsigned)s * 2654435761u; const int kind = s / 2048; float ref = 0.f, got = 0.f;
        if (kind == 0) { const int r = (hsh >> 7) & 511, c = (hsh >> 16) & 8191;
            float a = 0.f; for (int k = lane; k < DM; k += 64) a += mem[(size_t)r * DM + k] * w_xkv[(size_t)k * (2 * DM) + c];
            ref = wave_sum(a); got = bf2f(KVX[(size_t)r * 8192 + c]); }
        else if (kind == 1) { const int n = (hsh >> 7) & 2047, k = (hsh >> 18) & 4095, bb = n >> 10, h = (n >> 8) & 3, m = n & 255;
            float a = 0.f; for (int j = lane; j < 1024; j += 64) a += bf2f(KVX[(size_t)(bb * 256 + m) * 8192 + h * 1024 + j]) * w_xq[(size_t)k * DM + h * 1024 + j];
            ref = wave_sum(a) * g1[k]; got = bf2f(WQK[(size_t)n * DM + k]); }
        else { const int j = (hsh >> 7) & 4095, n = (hsh >> 19) & 2047, bb = n >> 10, h = (n >> 8) & 3, m = n & 255;
            float a = 0.f; for (int d = lane; d < 1024; d += 64) a += w_xo[(size_t)(h * 1024 + d) * DM + j] * bf2f(KVX[(size_t)(bb * 256 + m) * 8192 + 4096 + h * 1024 + d]);
            ref = wave_sum(a); got = bf2f(WVOT[(size_t)j * 2048 + n]); }
        const unsigned long long bb2 = __ballot(!(fabsf(got - ref) <= 0.02f + 0.02f * fabsf(ref)));
        if (lane == 0) { if (bb2) { __hip_atomic_fetch_add(ctl + CW_CHK + 2, 1u, RLX_AGENT); __hip_atomic_fetch_add(ctl + CW_CHK + 4 + kind, 1u, RLX_AGENT); } __hip_atomic_fetch_add(ctl + CW_CHK + 3, 1u, RLX_AGENT); }
    }
}
__device__ __noinline__ void xattn_check_b(unsigned char* ws, gu32* ctl, LAS float* ldsf, const float* w_xq, const float* g1, const float* b1, int G) {
    const int lane = threadIdx.x & 63, wave = threadIdx.x >> 6;
    const bf16* TB = (const bf16*)(ws + WS_TB); const bf16* KVX = (const bf16*)(ws + WS_KVX); const bf16* PB = (const bf16*)(ws + WS_PB);
    LAS float* hl = ldsf + wave * 4096; LAS float* ql = hl;
    const int gw = blockIdx.x * NWAVES + wave, NGW = G * NWAVES;
    for (int s = gw; s < 1024; s += NGW) {
        const unsigned hsh = (unsigned)s * 2654435761u; const int t = (hsh >> 9) & (M - 1), h = (hsh >> 5) & 3, bb = t >> 13;
        float sm = 0.f; for (int k = lane; k < DM; k += 64) sm += bf2f(TB[(size_t)t * DM + k]);
        const float mean = wave_sum(sm) * (1.f / DM); float sq = 0.f;
        for (int k = lane; k < DM; k += 64) { const float d = bf2f(TB[(size_t)t * DM + k]) - mean; sq += d * d; }
        const float rstd = 1.f / sqrtf(wave_sum(sq) * (1.f / DM) + LN_EPS);
        for (int k = lane; k < DM; k += 64) hl[k] = (bf2f(TB[(size_t)t * DM + k]) - mean) * rstd * g1[k] + b1[k];
        LDS_WAIT();
        float q[16];
#pragma unroll
        for (int j = 0; j < 16; ++j) q[j] = 0.f;
        for (int k = 0; k < DM; ++k) { const float hv = hl[k]; const float* wr = w_xq + (size_t)k * DM + h * 1024 + lane;
#pragma unroll
            for (int j = 0; j < 16; ++j) q[j] += hv * wr[64 * j]; }
        LDS_WAIT();
#pragma unroll
        for (int j = 0; j < 16; ++j) ql[lane + 64 * j] = q[j];
        LDS_WAIT();
        float sc[4]; float mx = -1e30f;
#pragma unroll
        for (int r = 0; r < 4; ++r) { const int m = lane + 64 * r; const bf16* kr = KVX + (size_t)(bb * 256 + m) * 8192 + h * 1024; float a = 0.f;
            for (int n = 0; n < 1024; ++n) a += ql[n] * bf2f(kr[n]);
            sc[r] = a * 0.03125f; mx = fmaxf(mx, sc[r]); }
#pragma unroll
        for (int o = 1; o < 64; o <<= 1) mx = fmaxf(mx, __shfl_xor(mx, o));
        float sum = 0.f;
#pragma unroll
        for (int r = 0; r < 4; ++r) { sc[r] = __expf(sc[r] - mx); sum += sc[r]; }
        sum = wave_sum(sum); bool bad = false;
#pragma unroll
        for (int r = 0; r < 4; ++r) { const float ref = sc[r] / sum, got = bf2f(PB[(size_t)t * 1024 + h * 256 + lane + 64 * r]); bad = bad || !(fabsf(got - ref) <= 2e-4f + 0.04f * ref); }
        const unsigned long long bb2 = __ballot(bad);
        if (lane == 0) { if (bb2) { __hip_atomic_fetch_add(ctl + CW_CHK + 2, 1u, RLX_AGENT); __hip_atomic_fetch_add(ctl + CW_CHK + 7, 1u, RLX_AGENT); } __hip_atomic_fetch_add(ctl + CW_CHK + 3, 1u, RLX_AGENT); }
        LDS_WAIT();
    }
}
#endif

__device__ __forceinline__ void combine_one(const float2 (&ml)[4], const v4u (&r)[4], int nsel, bf16* dst) {
    constexpr float C = att::SCALE * 1.4426950408889634f;
    float mx = ml[3].x;
#pragma unroll
    for (int k = 0; k < 3; ++k) if (k < nsel) mx = fmaxf(mx, ml[k].x);
    float acc[8]; float wsum = 0.f;
#pragma unroll
    for (int e = 0; e < 8; ++e) acc[e] = 0.f;
#pragma unroll
    for (int k = 0; k < 4; ++k) { const float w = (k == 3 || k < nsel) ? ml[k].y * __builtin_amdgcn_exp2f((ml[k].x - mx) * C) : 0.f; wsum += w;
        acc[0] += w * bf_lo(r[k].x); acc[1] += w * bf_hi(r[k].x); acc[2] += w * bf_lo(r[k].y); acc[3] += w * bf_hi(r[k].y);
        acc[4] += w * bf_lo(r[k].z); acc[5] += w * bf_hi(r[k].z); acc[6] += w * bf_lo(r[k].w); acc[7] += w * bf_hi(r[k].w); }
    const float inv = 1.0f / wsum;
    v4u o; o.x = pk2(acc[0] * inv, acc[1] * inv); o.y = pk2(acc[2] * inv, acc[3] * inv); o.z = pk2(acc[4] * inv, acc[5] * inv); o.w = pk2(acc[6] * inv, acc[7] * inv);
    *(GAS v4u*)dst = o;
}
__device__ __forceinline__ void combine_phase(Frame& F) {
    const bf16* PO = (const bf16*)(F.ws + WS_PARTO); const float2* ML = (const float2*)(F.ws + WS_ML); bf16* CAT = (bf16*)(F.ws + WS_CAT);
    const size_t gt = (size_t)blockIdx.x * (NWAVES * 64) + F.tid, NT = (size_t)F.G * NWAVES * 64, NE = (size_t)32 * SEQ * 16, HALFE = NE / 2;
    for (size_t idx = gt; idx < HALFE; idx += NT) {
        float2 ml[2][4]; v4u r[2][4]; int nsel[2]; bf16* dst[2];
#pragma unroll
        for (int u = 0; u < 2; ++u) { const size_t id = idx + u * HALFE;
            const int dc = (int)(id & 15), t = (int)((id >> 4) & (SEQ - 1)), bh = (int)(id >> 17), qb = t >> 8; nsel[u] = qb < 3 ? qb : 3;
            dst[u] = CAT + ((size_t)(bh >> 4) * SEQ + t) * DM + PW + (bh & 15) * HD + dc * 8;
#pragma unroll
            for (int k = 0; k < 4; ++k) { const int ks = (k == 3 || k < nsel[u]) ? k : 3;
                ml[u][k] = ML[((size_t)ks * 32 + bh) * SEQ + t]; r[u][k] = *(const GAS v4u*)(PO + (((size_t)ks * 32 + bh) * SEQ + t) * HD + dc * 8); } }
        combine_one(ml[0], r[0], nsel[0], dst[0]); combine_one(ml[1], r[1], nsel[1], dst[1]);
    }
}

struct Args { const float* in[18]; float* out; unsigned char* ws; int ph_lo, ph_hi, li, pad; };
__global__ void __launch_bounds__(NWAVES * 64, 2) mega_fwd(Args args) {
    extern __shared__ __attribute__((aligned(16))) unsigned char lds[];
    Frame F;
    F.lds = (LAS unsigned char*)lds;
    F.MISC = (volatile LAS unsigned*)(F.lds + MISC_OFF);
    F.tid = threadIdx.x; F.lane = F.tid & 63; F.wave = __builtin_amdgcn_readfirstlane(F.tid >> 6);
    F.G = gridDim.x; F.ws = args.ws;
    F.ctl = (gu32*)(args.ws + WS_CTL);
    for (int u = F.tid; u < (LDS_BYTES - LDSCTL_OFF) / 4; u += NWAVES * 64) ((LAS unsigned*)(F.lds + LDSCTL_OFF))[u] = 0u;
    __syncthreads();
    XcdBarrier bar; bar.bar = (unsigned*)(F.ctl + CW_BAR); bar.x = 0; bar.st = nullptr;
    if (N_LAUNCHES == 1) bar = xcd_barrier_post((unsigned*)(F.ctl + CW_BAR), F.MISC + 8);
#define GRID_BAR() do { if (N_LAUNCHES == 1) xcd_barrier(bar); } while (0)
    const int lo = args.ph_lo, hi = args.ph_hi;
#define IN(k) (lo <= (k) && (k) < hi)
#define BOTH(k) (IN(k) && IN((k) + 1))
#if defined(PROBE_SKEW)
#ifndef PROBE_PREV
#define PROBE_PREV (PROBE_SKEW - 1)
#endif
#define SKEW_MARK(k) do { if ((k) == PROBE_SKEW && F.tid == 0) { const unsigned tt = (unsigned)wall_clock64(); __hip_atomic_fetch_max(F.ctl + CW_CHK + 8, ~tt, RLX_AGENT); __hip_atomic_fetch_max(F.ctl + CW_CHK + 9, tt, RLX_AGENT); __hip_atomic_fetch_max(F.ctl + CW_CHK + 16 + (bar.x & 7), tt, RLX_AGENT); } if ((k) == PROBE_PREV && F.tid == 0) { const unsigned tt = (unsigned)wall_clock64(); __hip_atomic_fetch_max(F.ctl + CW_CHK + 10, ~tt, RLX_AGENT); __hip_atomic_fetch_max(F.ctl + CW_CHK + 11, tt, RLX_AGENT); } } while (0)
#else
#define SKEW_MARK(k) do { } while (0)
#endif
#ifndef PROBE_DUP
#define PROBE_DUP 0
#endif
#define DUPON(k) ((PROBE_DUP >> (k)) & 1)
#define REP(k) for (int _rep = 0; _rep < (DUPON(k) ? 2 : 1); ++_rep)
    unsigned char* ws = args.ws;
    const int G = F.G, cid = (int)blockIdx.x;
    float* out = args.out;

    if (IN(0)) { REP(0) { p0_prologue(F, args.in); }
#if defined(WDOWN_IN_P0)
      convert_wdown_static(F, args.in[15], cid, G);
#endif
#if !defined(GU_BF16)
      GRID_BAR(); quant_wgu(F);
#endif
      SKEW_MARK(0); if (BOTH(0)) GRID_BAR(); }

    if (IN(1)) {
#if MIX8 == 0
        { pg8::Gemm g = pg8::make_gemm(ws + WS_XB, DM, ws + WS_WIN, DM, DM); pg8::StaticOrder S; S.init(M, MIXIN, G, cid);
          pg8::EpiMixIn E{(pg8::bf16_t*)(ws + WS_HP), (size_t)M * 2048, (const float*)(ws + WS_ROPE), 0};
          pg8::gemm_phase<pg8::EpiMixIn, pg8::StaticOrder, true, true>(F.lds + RING_OFF, g, S, E); }
#else
        { constexpr int N8 = (MIX8 == 1) ? 2048 : 4096;
          pg8::Gemm g = pg8::make_gemm(ws + WS_X8, DM / 2, ws + WS_W8IN, DM / 2, DM / 2); pg8::StaticOrder S; S.init(M, N8, G, cid);
          pg8::EpiMix8 E{(pg8::bf16_t*)(ws + WS_HP), (size_t)M * 2048, (const float*)(F.ctl + CW_SX), (const float*)(F.ctl + CW_SBIN), (MIX8 == 2) ? 0 : (MIX8 == 3) ? 2 : 3, 3, (const float*)(ws + WS_ROPE)};
          pg8::gemm_phase<pg8::EpiMix8, pg8::StaticOrder, true, true, pg8::Gemm, true>(F.lds + RING_OFF, g, S, E); }
        { constexpr int NB = (MIX8 == 1) ? 6144 : 4096, R0 = (MIX8 == 2) ? 2048 : 0;
          pg8::Gemm g = pg8::make_gemm(ws + WS_XB, DM, ws + WS_WIN + (size_t)R0 * DM * 2, DM, DM); pg8::StaticOrder S; S.init(M, NB, G, cid);
          pg8::EpiMixIn E{(pg8::bf16_t*)(ws + WS_HP), (size_t)M * 2048, (const float*)(ws + WS_ROPE), R0 / 256};
          pg8::gemm_phase<pg8::EpiMixIn, pg8::StaticOrder, true, true>(F.lds + RING_OFF, g, S, E); }
#endif
        {
          pg8::GemmKV g{(const char*)(ws + WS_MEMB), (const char*)(ws + WS_WXKV), DM, DM, 1024}; pg8::EpiSlabKV E{(float*)(ws + WS_SLAB)};
          gu32* kvq = F.ctl + CW_DYN + 4096 + 2048;
#pragma nounroll
          for (;;) {
              if (F.tid == 0) { const unsigned t = __hip_atomic_fetch_add(kvq, 1u, RLX_AGENT); F.MISC[20] = t < 256u ? t : 0xffffffffu; }
              __syncthreads(); const unsigned L = F.MISC[20]; __syncthreads();
              if (L == 0xffffffffu) break;
              pg8::OrderOne S; S.u.pz = (int)(L & 3u); S.u.pm = (int)(L >> 7); S.u.pn = (int)((L >> 2) & 31u);
              pg8::gemm_phase<pg8::EpiSlabKV, pg8::OrderOne, true, true, pg8::GemmKV>(F.lds + RING_OFF, g, S, E);
          } }
        gu_filler(F, args.in, 1); SKEW_MARK(1); if (BOTH(1)) GRID_BAR();
    }

    if (IN(2)) { REP(2) { pool_ew(F); kmean_phase(F); kv_reduce(F); } SKEW_MARK(2); if (BOTH(2)) GRID_BAR(); }

#if defined(PROBE_XBAR)
    for (int xb = 0; xb < PROBE_XBAR; ++xb) GRID_BAR();
#endif
    if (IN(3)) {
        { pg8::Gemm g = pg8::make_gemm(ws + WS_WOUT, 2048, ws + WS_WPOOL, 512, 512); g.a_pn = 512 * 2; g.a_pn_sh = 1; pg8::StaticOrder S; S.init(DM, PW, G, cid);
          pg8::EpiStore E{(pg8::bf16_t*)(ws + WS_WOUT2), DM, 0};
          pg8::gemm_phase<pg8::EpiStore, pg8::StaticOrder, true, true>(F.lds + RING_OFF, g, S, E); if (DUPON(3)) { pg8::gemm_phase<pg8::EpiStore, pg8::StaticOrder, true, true>(F.lds + RING_OFF, g, S, E); } }
        if (G == 256) { pg8::GemmAbs g{(const char*)(ws + WS_KVX), (const char*)(ws + WS_WXQ), (const char*)(ws + WS_WXO), cid < 128 ? 8192 : 4096, cid < 128 ? 4096 : 8192, 1024};
          pg8::OrderAbs S{cid}; pg8::EpiStoreAbs E{(pg8::bf16_t*)(ws + WS_WQK), (pg8::bf16_t*)(ws + WS_WVOT), (float*)(F.ctl + CW_K1), (float*)(F.ctl + CW_K2)};
          pg8::gemm_phase<pg8::EpiStoreAbs, pg8::OrderAbs, true, true, pg8::GemmAbs>(F.lds + RING_OFF, g, S, E); if (DUPON(17)) { pg8::gemm_phase<pg8::EpiStoreAbs, pg8::OrderAbs, true, true, pg8::GemmAbs>(F.lds + RING_OFF, g, S, E); } }
        gate_phase(F);
        gu_filler(F, args.in, 3); SKEW_MARK(3); if (BOTH(3)) GRID_BAR();
#if defined(XATTN_CHECK) && XATTN_CHECK
        xattn_check_a(ws, F.ctl, args.in[1], args.in[8], args.in[9], args.in[10], args.in[6], G); __syncthreads();
#endif
    }

    if (IN(4)) { attn_phase(F, (char*)lds + RING_OFF); if (DUPON(4)) { __syncthreads(); attn_phase(F, (char*)lds + RING_OFF); } gu_filler(F, args.in, 4); SKEW_MARK(4); if (BOTH(4)) GRID_BAR(); }

    if (IN(5)) { REP(5) { combine_phase(F); } SKEW_MARK(5); if (BOTH(5)) GRID_BAR(); }
#if defined(MOBA_CHECK) && MOBA_CHECK
    if (IN(5)) { moba_check(F); __syncthreads(); }
#endif

    if (IN(6)) {
        pg8::Gemm g = pg8::make_gemm(ws + WS_CAT, DM, ws + WS_WOUT2, DM, DM); pg8::StaticOrder S; S.init(M, DM, G, cid);
        pg8::EpiResid E{args.in[0], (pg8::bf16_t*)(ws + WS_TB), DM, DN_ALPHA, (pg8::f32x2*)(ws + WS_SLOT)};
        pg8::gemm_phase<pg8::EpiResid, pg8::StaticOrder, true, true>(F.lds + RING_OFF, g, S, E); if (DUPON(6)) { pg8::gemm_phase<pg8::EpiResid, pg8::StaticOrder, true, true>(F.lds + RING_OFF, g, S, E); }
        gu_filler(F, args.in, 6); SKEW_MARK(6); if (BOTH(6)) GRID_BAR();
    }
    if (IN(7)) { ln_finalize(F, (const float2*)(ws + WS_SLOT), (float2*)(ws + WS_STATS)); SKEW_MARK(7); if (BOTH(7)) GRID_BAR(); }

    if (IN(9)) {
        if (G == 256) {
            pg8::Gemm g = pg8::make_gemm(ws + WS_TB, DM, ws + WS_WQK, DM, DM); g.b_pm = (size_t)1024 * DM * 2; g.b_pm_sh = 5;
            pg8::StaticOrder S; S.init(M, XH * 256, G, cid);
            pg8::EpiSoftmax E{(pg8::bf16_t*)(ws + WS_PB), XH * MEMLEN, 0.03125f * 1.4426950408889634f, (const pg8::f32x2*)(ws + WS_STATS), (const float*)(F.ctl + CW_K1), (const float*)(F.ctl + CW_K2)};
            pg8::gemm_phase<pg8::EpiSoftmax, pg8::StaticOrder, false, true>(F.lds + RING_OFF, g, S, E); if (DUPON(9)) { pg8::gemm_phase<pg8::EpiSoftmax, pg8::StaticOrder, false, true>(F.lds + RING_OFF, g, S, E); }
        }
        gu_filler(F, args.in, 9); SKEW_MARK(9); if (BOTH(9)) GRID_BAR();
#if defined(XATTN_CHECK) && XATTN_CHECK
        xattn_check_b(ws, F.ctl, (LAS float*)(F.lds + RING_OFF), args.in[8], args.in[6], args.in[7], G); __syncthreads(); GRID_BAR();
#endif
    }
    if (IN(11)) {
        pg8::Gemm g = pg8::make_gemm(ws + WS_PB, XH * MEMLEN, ws + WS_WVOT, 2048, XH * MEMLEN); g.b_pm = (size_t)1024 * 2; g.b_pm_sh = 5;
        pg8::StaticOrder S; S.init(M, DM, G, cid);
#if defined(GU_BF16)
        pg8::EpiResidLN E{(pg8::bf16_t*)(ws + WS_TB), (const pg8::f32x2*)(ws + WS_STATS), 6, (pg8::f32x2*)(ws + WS_SLOT)};
#else
        pg8::EpiResidLN E{(pg8::bf16_t*)(ws + WS_TB), (const pg8::f32x2*)(ws + WS_STATS), 6, nullptr};
#endif
        pg8::gemm_phase<pg8::EpiResidLN, pg8::StaticOrder, true, true>(F.lds + RING_OFF, g, S, E);
        gu_filler(F, args.in, 11); SKEW_MARK(11); if (BOTH(11)) GRID_BAR();
    }
#if defined(GU_BF16)
    if (IN(12)) { ln_finalize(F, (const float2*)(ws + WS_SLOT), (float2*)(ws + WS_STATS)); gu_drain(F, args.in); SKEW_MARK(12); if (BOTH(12)) GRID_BAR(); }
#else
    if (IN(12)) { ln_rows_q8(F, (const bf16*)(ws + WS_TB), ws + WS_H8, (float*)(F.ctl + CW_SA), (float2*)(ws + WS_STATS), args.in[11], args.in[12]); SKEW_MARK(12); if (BOTH(12)) GRID_BAR(); }
#endif

#if defined(PROBE_SLEEP_US)
    { const unsigned long long w0 = wall_clock64(); while (wall_clock64() - w0 < (unsigned long long)PROBE_SLEEP_US * 100ull) __builtin_amdgcn_s_sleep(64); SKEW_MARK(20); GRID_BAR(); }
#endif
    if (IN(13)) {
#if defined(GU_BF16)
        pg8::Gemm g = pg8::make_gemm(ws + WS_TB, DM, ws + WS_WGU, DM, DM);
        pg8::EpiSwiGLU E{(pg8::bf16_t*)(ws + WS_G), FF, (const pg8::f32x2*)(ws + WS_STATS), (const float*)(F.ctl + CW_C1G), (const float*)(F.ctl + CW_C2G)};
        typedef pg8::EpiSwiGLU EpiGU; constexpr bool GU_I8 = false;
#else
        pg8::Gemm g = pg8::make_gemm(ws + WS_H8, DM / 2, ws + WS_WGU, DM / 2, DM / 2);
        pg8::EpiSwiGLU8 E{(pg8::bf16_t*)(ws + WS_G), FF, (const float*)(F.ctl + CW_SA), (const float*)(F.ctl + CW_SB)};
        typedef pg8::EpiSwiGLU8 EpiGU; constexpr bool GU_I8 = true;
#endif
#if defined(STATIC_ORDER)
        pg8::StaticOrder S; S.init(M, 2 * FF, G, cid);
        pg8::gemm_phase<EpiGU, pg8::StaticOrder, true, true, pg8::Gemm, GU_I8>(F.lds + RING_OFF, g, S, E);
#else
        #ifndef GU_WGM
#define GU_WGM 8
#endif
#ifndef GU_ROT
#define GU_ROT 0
#endif
        pg8::DynOrder S; S.init(M, 2 * FF, (unsigned*)(F.ctl + CW_DYN + 512 * 3), (volatile LAS int*)(F.MISC + 16), (int)xb_xcc_id(), GU_ROT, GU_WGM); S.start(F.wave, F.lane);
        pg8::gemm_phase<EpiGU, pg8::DynOrder, true, true, pg8::Gemm, GU_I8>(F.lds + RING_OFF, g, S, E);
#endif
#if !defined(WDOWN_IN_P0)
        convert_wdown(F, args.in[15], F.ctl + CW_DYN + 4096);
#endif
        SKEW_MARK(13); if (BOTH(13)) GRID_BAR();
    }
    if (IN(14)) {
#ifndef DOWN_WGM
#define DOWN_WGM 4
#endif
        pg8::Gemm g = pg8::make_gemm(ws + WS_G, FF, ws + WS_WDN, FF, FF); pg8::StaticOrder S; S.init(M, DM, G, cid, DOWN_WGM);
        pg8::EpiResidLN E{(pg8::bf16_t*)(ws + WS_TB), (const pg8::f32x2*)(ws + WS_STATS), 11, nullptr};
        if (DUPON(14)) { pg8::EpiStore E2{(pg8::bf16_t*)(ws + WS_HB), DM, 0}; pg8::gemm_phase<pg8::EpiStore, pg8::StaticOrder, true, true>(F.lds + RING_OFF, g, S, E2); }
        pg8::gemm_phase<pg8::EpiResidLN, pg8::StaticOrder, true, true>(F.lds + RING_OFF, g, S, E);
        SKEW_MARK(14); if (BOTH(14)) GRID_BAR();
    }
#if defined(MOBA_CHECK) && MOBA_CHECK
#define CHK_TAIL 1
#endif
    if (IN(15)) { ln_rows<true>(F, (const bf16*)(ws + WS_TB), nullptr, nullptr, out, args.in[16], args.in[17]); if (DUPON(15)) { ln_rows<true>(F, (const bf16*)(ws + WS_TB), nullptr, nullptr, out, args.in[16], args.in[17]); } }
#if defined(PROBE_SKEW)
    GRID_BAR();
    if (blockIdx.x == 0 && F.tid == 0) { const unsigned t0 = ~__hip_atomic_load(F.ctl + CW_CHK + 8, RLX_AGENT), t1 = __hip_atomic_load(F.ctl + CW_CHK + 9, RLX_AGENT), ts = ~__hip_atomic_load(F.ctl + CW_CHK + 10, RLX_AGENT), tp = __hip_atomic_load(F.ctl + CW_CHK + 11, RLX_AGENT);
        unsigned xmin = 0xffffffffu, xmax = 0u; for (int x = 0; x < 8; ++x) { const unsigned v = __hip_atomic_load(F.ctl + CW_CHK + 16 + x, RLX_AGENT); if (v) { xmin = v < xmin ? v : xmin; xmax = v > xmax ? v : xmax; } }
        const unsigned long long ticks = (unsigned long long)((PROBE_SKEW_WHAT == 0) ? (t1 - t0) : (PROBE_SKEW_WHAT == 1) ? (t1 - ts) : (PROBE_SKEW_WHAT == 3) ? (t1 - tp) : (xmax - xmin)) * PROBE_AMP;
        const unsigned long long w0 = wall_clock64(); while (wall_clock64() - w0 < ticks) __builtin_amdgcn_s_sleep(32); }
#endif
#if defined(XATTN_CHECK) && XATTN_CHECK
    GRID_BAR();
    if (blockIdx.x == 0 && F.tid < 64) { const unsigned nbad = __hip_atomic_load(F.ctl + CW_CHK + 2, RLX_AGENT), nrun = __hip_atomic_load(F.ctl + CW_CHK + 3, RLX_AGENT);
        if (nbad != 0u) { float pz = 0.f; for (int kk = 3; kk >= 0; --kk) { const unsigned nb = __hip_atomic_load(F.ctl + CW_CHK + 4 + kk, RLX_AGENT); if (nb) pz = 100.0f * (kk + 1) + 10.0f * (float)(nb < 9u ? nb : 9u); } out[F.tid] = pz; }
        else if (nrun != 3u * 2048u + 1024u) out[F.tid] = 50.0f; }
#endif
#if defined(MOBA_CHECK) && MOBA_CHECK
    GRID_BAR();
    if (blockIdx.x == 0 && F.tid < 64) { const unsigned nbad = __hip_atomic_load(F.ctl + CW_CHK, RLX_AGENT), nrun = __hip_atomic_load(F.ctl + CW_CHK + 1, RLX_AGENT);
        if (nbad != 0u) out[F.tid] = 1000.0f + (float)nbad;
        else if (nrun != 4096u) out[F.tid] = 500.0f + (float)nrun; }
#endif
#undef IN
#undef BOTH
#undef GRID_BAR
}

extern "C" void kernel_launch(void* const* d_in, const int* in_sizes, int n_in, void* d_out, int out_size, void* d_ws, size_t ws_size, hipStream_t stream) {
    static int grid = 0;
    if (grid == 0) {
        if (n_in != 18 || in_sizes[0] != M * DM || out_size != M * DM || ws_size < WS_END) { fprintf(stderr, "kernel_launch: shape / workspace mismatch (n_in %d, in0 %d, out %d, ws %zu, need %zu)\n", n_in, n_in > 0 ? in_sizes[0] : -1, out_size, ws_size, (size_t)WS_END); grid = -1; return; }
        int dev = 0, cus = 0, per_cu = 0;
        if (hipGetDevice(&dev) != hipSuccess || hipDeviceGetAttribute(&cus, hipDeviceAttributeMultiprocessorCount, dev) != hipSuccess) { grid = -1; return; }
        if (hipFuncSetAttribute((const void*)mega_fwd, hipFuncAttributeMaxDynamicSharedMemorySize, LDS_BYTES) != hipSuccess) { fprintf(stderr, "kernel_launch: hipFuncSetAttribute failed\n"); grid = -1; return; }
        if (hipOccupancyMaxActiveBlocksPerMultiprocessor(&per_cu, (const void*)mega_fwd, NWAVES * 64, LDS_BYTES) != hipSuccess || per_cu < 1)
            fprintf(stderr, "kernel_launch: note: occupancy query reports %d workgroups per CU\n", per_cu);
        (void)hipGetLastError();
        grid = cus;
        if (grid != 256) fprintf(stderr, "kernel_launch: %d CUs; the cross-attention score phase needs a 256-workgroup grid\n", grid);
    }
    if (grid < 0) return;
    if (hipMemsetAsync((char*)d_ws + WS_CTL, 0, CTL_ZERO_BYTES, stream) != hipSuccess) return;
    Args a{};
    for (int i = 0; i < 18; ++i) a.in[i] = (const float*)d_in[i];
    a.out = (float*)d_out; a.ws = (unsigned char*)d_ws; a.pad = 0;
    for (int li = 0; li < N_LAUNCHES; ++li) {
        a.ph_lo = (N_LAUNCHES == 1) ? 0 : li; a.ph_hi = (N_LAUNCHES == 1) ? N_PHASES : li + 1; a.li = li;
        hipLaunchKernelGGL(mega_fwd, dim3(grid), dim3(NWAVES * 64), LDS_BYTES, stream, a);
        if (hipPeekAtLastError() != hipSuccess) { fprintf(stderr, "kernel_launch: launch %d failed\n", li); break; }
    }
}
```

```cpp
#include <hip/hip_runtime.h>
#include <cstdio>
#include <cstdint>

namespace pg8 {
#define PG8_LAS __attribute__((address_space(3)))
typedef unsigned short bf16_t;
typedef short bf16x8 __attribute__((ext_vector_type(8)));
typedef float f32x4 __attribute__((ext_vector_type(4)));
typedef float f32x2 __attribute__((ext_vector_type(2)));
typedef unsigned u32x4 __attribute__((ext_vector_type(4)));
typedef unsigned u32x2 __attribute__((ext_vector_type(2)));
typedef int i32x4 __attribute__((ext_vector_type(4)));
constexpr int BM = 256, BK = 64, HALF = 128, HTB = HALF * BK * 2  , STAGE_BYTES = 8 * HTB, NXCD = 8, WGM = 8;

__host__ __device__ __forceinline__ int lds_byte(int r, int c) { const int st = (r >> 4) * 2 + (c >> 5), rr = r & 15, cc = c & 31, ob = rr * 64 + cc * 2; return st * 1024 + (ob ^ (((ob >> 9) & 1) << 5)); }
__host__ __device__ __forceinline__ void stage_rc(int b, int& R, int& C) { const int st = b / 1024, sb = b % 1024, swz = sb ^ (((sb >> 9) & 1) << 5); R = (st >> 1) * 16 + swz / 64; C = (st & 1) * 32 + (swz % 64) / 2; }
__host__ __device__ __forceinline__ int perm32(int rho) { const int n = rho >> 4, i = rho & 15; return 8 * (i >> 2) + 4 * n + (i & 3); }

struct Unit { int pm, pn, pz; };
struct Gemm {
    const char* A; const char* B; int lda, ldb, K;
    size_t a_pm, a_pn; int a_pn_sh; size_t b_pn, b_pm; int b_pm_sh;
    __device__ __forceinline__ const char* a_ptr(const Unit& u) const { return A + (size_t)u.pm * a_pm + (size_t)(u.pn >> a_pn_sh) * a_pn; }
    __device__ __forceinline__ const char* b_ptr(const Unit& u) const { return B + (size_t)u.pn * b_pn + (size_t)(u.pm >> b_pm_sh) * b_pm; }
};
__device__ __forceinline__ Gemm make_gemm(const void* A, int lda, const void* B, int ldb, int K) {
    Gemm g; g.A = (const char*)A; g.B = (const char*)B; g.lda = lda; g.ldb = ldb; g.K = K;
    g.a_pm = (size_t)BM * lda * 2; g.a_pn = 0; g.a_pn_sh = 0; g.b_pn = (size_t)BM * ldb * 2; g.b_pm = 0; g.b_pm_sh = 0; return g;
}

struct StaticOrder {
    int nM, nN, nwg, G, c, wgm;
    __host__ __device__ void init(int M, int N, int G_, int c_, int wgm_ = WGM) { nM = M / BM; nN = N / BM; nwg = nM * nN; G = G_; c = c_; wgm = wgm_; }
    __host__ __device__ bool next(int i, Unit& u) const {
        const long L = (long)i * G + c; if (L >= nwg) return false;
        int wgid = (int)L; { const int q = nwg / NXCD, r = nwg % NXCD, xcd = wgid % NXCD, off = wgid / NXCD; wgid = (xcd < r ? xcd * (q + 1) : r * (q + 1) + (xcd - r) * q) + off; }
        const int nig = wgm * nN, gid = wgid / nig, fm = gid * wgm, gsz = (nM - fm) < wgm ? (nM - fm) : wgm;
        u.pm = fm + ((wgid % nig) % gsz); u.pn = (wgid % nig) / gsz; u.pz = 0; return true;
    }
    __device__ __forceinline__ void a_ready(const Unit&) const {}
    __device__ __forceinline__ void done(const Unit&) const {}
    __device__ __forceinline__ int pre_epi(int, int, int) const { return 0; }
    __device__ __forceinline__ void post_epi(int, int, int, int) const {}
};

struct DynOrder {
    int nM, nN, q, home, rot, wgm; unsigned* ctr; volatile PG8_LAS int* tk;
    __device__ __forceinline__ void init(int M, int N, unsigned* ctr_, volatile PG8_LAS int* tk_, int home_, int rot_ = 0, int wgm_ = WGM) { nM = M / BM; nN = N / BM; q = (nM * nN) / NXCD; ctr = ctr_; tk = tk_; home = home_; rot = rot_; wgm = wgm_; }
    __device__ __forceinline__ int fetch() const {
        for (int k = 0; k < NXCD; ++k) { const int y = (home + k) & (NXCD - 1); const unsigned t = __hip_atomic_fetch_add(ctr + 64 * y, 1u, __ATOMIC_RELAXED, __HIP_MEMORY_SCOPE_AGENT); if (t < (unsigned)q) return y * q + (int)t; }
        return -1; }
    __device__ __forceinline__ void start(int wid, int lane) const {
        if (wid == 0 && lane == 0) { const int a = fetch(); const int b = (a >= 0) ? fetch() : -1; tk[0] = a; tk[1] = b; }
        __syncthreads(); }
    __device__ __forceinline__ bool next(int i, Unit& u) const {
        const int wgid = tk[i & 3]; if (wgid < 0) return false;
        const int nig = wgm * nN, gid = wgid / nig, fm = gid * wgm, gsz = (nM - fm) < wgm ? (nM - fm) : wgm;
        u.pm = fm + ((wgid % nig) % gsz); u.pn = ((wgid % nig) / gsz + (wgid / q) * rot) % nN; u.pz = 0; return true; }
    __device__ __forceinline__ void a_ready(const Unit&) const {}
    __device__ __forceinline__ void done(const Unit&) const {}
    __device__ __forceinline__ int pre_epi(int, int wid, int lane) const { int t = 0; if (wid == 0 && lane == 0) t = (int)__hip_atomic_fetch_add(ctr + 64 * (home & (NXCD - 1)), 1u, __ATOMIC_RELAXED, __HIP_MEMORY_SCOPE_AGENT); return t; }
    __device__ __forceinline__ void post_epi(int ui, int wid, int lane, int t) const {
        if (wid == 0 && lane == 0) { int w = -1;
            if ((unsigned)t < (unsigned)q) w = (home & (NXCD - 1)) * q + t;
            else for (int k = 1; k < NXCD; ++k) { const int y = (home + k) & (NXCD - 1); const unsigned s = __hip_atomic_fetch_add(ctr + 64 * y, 1u, __ATOMIC_RELAXED, __HIP_MEMORY_SCOPE_AGENT); if (s < (unsigned)q) { w = y * q + (int)s; break; } }
            tk[(ui + 2) & 3] = w; } }
};

__device__ __forceinline__ unsigned cvt_pk_bf16(float lo, float hi) { unsigned r; asm volatile("v_cvt_pk_bf16_f32 %0, %1, %2" : "=v"(r) : "v"(lo), "v"(hi)); return r; }

struct EpiMixIn {
    static constexpr bool PERM = true, AFTER_DRAIN = false;
    bf16_t* base; size_t tstride; const float* rope; int pn_off;
    __device__ __forceinline__ void operator()(const f32x4 (&acc)[2][2][4][2], const Unit& u, int wr, int wc, int fr, int fq) const {
        const int t = (u.pn + pn_off) >> 3; const bool rp = (t == 1) || (t == 2);
        bf16_t* ob = base + (size_t)t * tstride;
        const int row0 = u.pm * BM + wr * 64 + fr, col0 = (u.pn & 7) * BM + wc * 32 + 8 * fq;
#pragma unroll
        for (int ai = 0; ai < 2; ++ai)
#pragma unroll
            for (int m = 0; m < 4; ++m) {
                const int row = row0 + ai * HALF + m * 16; bf16_t* rowp = ob + (size_t)row * 2048 + col0;
                f32x4 cs0 = (f32x4){1.f, 0.f, 1.f, 0.f}, cs1 = cs0;
                if (rp) { const f32x4* tp = (const f32x4*)(rope + ((size_t)(row & 8191) * 64 + wc * 16 + fq * 4) * 2); cs0 = tp[0]; cs1 = tp[1]; }
#pragma unroll
                for (int bj = 0; bj < 2; ++bj) {
                    const f32x4 v0 = acc[ai][bj][m][0], v1 = acc[ai][bj][m][1];
                    const float a0 = v0[0] * cs0[0] - v0[1] * cs0[1], a1 = v0[1] * cs0[0] + v0[0] * cs0[1];
                    const float a2 = v0[2] * cs0[2] - v0[3] * cs0[3], a3 = v0[3] * cs0[2] + v0[2] * cs0[3];
                    const float b0 = v1[0] * cs1[0] - v1[1] * cs1[1], b1 = v1[1] * cs1[0] + v1[0] * cs1[1];
                    const float b2 = v1[2] * cs1[2] - v1[3] * cs1[3], b3 = v1[3] * cs1[2] + v1[2] * cs1[3];
                    u32x4 w; w.x = cvt_pk_bf16(a0, a1); w.y = cvt_pk_bf16(a2, a3); w.z = cvt_pk_bf16(b0, b1); w.w = cvt_pk_bf16(b2, b3);
                    *(u32x4*)(rowp + bj * HALF) = w;
                }
            }
    }
};
struct EpiMix8 {
    static constexpr bool PERM = true, AFTER_DRAIN = false;
    bf16_t* base; size_t tstride; const float* sx; const float* sb; int t0, t1; const float* rope;
    __device__ __forceinline__ f32x4 cv(const f32x4& a) const { return __builtin_convertvector(__builtin_bit_cast(i32x4, a), f32x4); }
    __device__ __forceinline__ void operator()(const f32x4 (&acc)[2][2][4][2], const Unit& u, int wr, int wc, int fr, int fq) const {
        const int t = (u.pn >> 3) ? t1 + (u.pn >> 3) - 1 : t0; const bool rp = (t == 1) || (t == 2);
        bf16_t* ob = base + (size_t)t * tstride;
        const int row0 = u.pm * BM + wr * 64 + fr, col0 = (u.pn & 7) * BM + wc * 32 + 8 * fq, n0 = u.pn * BM + wc * 32 + 8 * fq;
        f32x4 c[2][2];
#pragma unroll
        for (int bj = 0; bj < 2; ++bj) { c[bj][0] = *(const f32x4*)(sb + n0 + bj * HALF); c[bj][1] = *(const f32x4*)(sb + n0 + bj * HALF + 4); }
#pragma unroll
        for (int ai = 0; ai < 2; ++ai)
#pragma unroll
            for (int m = 0; m < 4; ++m) { const int row = row0 + ai * HALF + m * 16; bf16_t* rowp = ob + (size_t)row * 2048 + col0; const float sr = sx[row];
                f32x4 cs0 = (f32x4){1.f, 0.f, 1.f, 0.f}, cs1 = cs0;
                if (rp) { const f32x4* tp = (const f32x4*)(rope + ((size_t)(row & 8191) * 64 + wc * 16 + fq * 4) * 2); cs0 = tp[0]; cs1 = tp[1]; }
#pragma unroll
                for (int bj = 0; bj < 2; ++bj) { const f32x4 v0 = cv(acc[ai][bj][m][0]) * (c[bj][0] * sr), v1 = cv(acc[ai][bj][m][1]) * (c[bj][1] * sr);
                    const float a0 = v0[0] * cs0[0] - v0[1] * cs0[1], a1 = v0[1] * cs0[0] + v0[0] * cs0[1];
                    const float a2 = v0[2] * cs0[2] - v0[3] * cs0[3], a3 = v0[3] * cs0[2] + v0[2] * cs0[3];
                    const float b0 = v1[0] * cs1[0] - v1[1] * cs1[1], b1 = v1[1] * cs1[0] + v1[0] * cs1[1];
                    const float b2 = v1[2] * cs1[2] - v1[3] * cs1[3], b3 = v1[3] * cs1[2] + v1[2] * cs1[3];
                    u32x4 w; w.x = cvt_pk_bf16(a0, a1); w.y = cvt_pk_bf16(a2, a3); w.z = cvt_pk_bf16(b0, b1); w.w = cvt_pk_bf16(b2, b3);
                    *(u32x4*)(rowp + bj * HALF) = w; } }
    }
};
struct EpiStore {
    static constexpr bool PERM = true, AFTER_DRAIN = false;
    bf16_t* O; int ldc, coff;
    __device__ __forceinline__ void operator()(const f32x4 (&acc)[2][2][4][2], const Unit& u, int wr, int wc, int fr, int fq) const {
        const int row0 = u.pm * BM + wr * 64 + fr, col0 = coff + u.pn * BM + wc * 32 + 8 * fq;
#pragma unroll
        for (int ai = 0; ai < 2; ++ai)
#pragma unroll
            for (int m = 0; m < 4; ++m) { bf16_t* rowp = O + (size_t)(row0 + ai * HALF + m * 16) * ldc + col0;
#pragma unroll
                for (int bj = 0; bj < 2; ++bj) { const f32x4 v0 = acc[ai][bj][m][0], v1 = acc[ai][bj][m][1];
                    u32x4 w; w.x = cvt_pk_bf16(v0[0], v0[1]); w.y = cvt_pk_bf16(v0[2], v0[3]); w.z = cvt_pk_bf16(v1[0], v1[1]); w.w = cvt_pk_bf16(v1[2], v1[3]);
                    *(u32x4*)(rowp + bj * HALF) = w; } }
    }
};
__device__ __forceinline__ void row_stat_acc(const u32x4& w, float& s, float& q) {
    const float a0 = __builtin_bit_cast(float, w.x << 16), a1 = __builtin_bit_cast(float, w.x & 0xffff0000u), a2 = __builtin_bit_cast(float, w.y << 16), a3 = __builtin_bit_cast(float, w.y & 0xffff0000u);
    const float a4 = __builtin_bit_cast(float, w.z << 16), a5 = __builtin_bit_cast(float, w.z & 0xffff0000u), a6 = __builtin_bit_cast(float, w.w << 16), a7 = __builtin_bit_cast(float, w.w & 0xffff0000u);
    s += ((a0 + a1) + (a2 + a3)) + ((a4 + a5) + (a6 + a7));
    q += ((a0 * a0 + a1 * a1) + (a2 * a2 + a3 * a3)) + ((a4 * a4 + a5 * a5) + (a6 * a6 + a7 * a7));
}
__device__ __forceinline__ void row_stat_store(f32x2* slots, int row, int slot, int fq, float s, float q) {
    s += __shfl_xor(s, 16); q += __shfl_xor(q, 16); s += __shfl_xor(s, 32); q += __shfl_xor(q, 32);
    if (fq == 0) slots[(size_t)row * 64 + slot] = (f32x2){s, q};
}
struct EpiResid {
    static constexpr bool PERM = true, AFTER_DRAIN = false;
    const float* res; bf16_t* out; int ldc; float alpha; f32x2* slots;
    __device__ __forceinline__ void operator()(const f32x4 (&acc)[2][2][4][2], const Unit& u, int wr, int wc, int fr, int fq) const {
        const int row0 = u.pm * BM + wr * 64 + fr, col0 = u.pn * BM + wc * 32 + 8 * fq;
#pragma unroll
        for (int ai = 0; ai < 2; ++ai)
#pragma unroll
            for (int m = 0; m < 4; ++m) { const size_t off = (size_t)(row0 + ai * HALF + m * 16) * ldc + col0; float ss = 0.f, qq = 0.f;
#pragma unroll
                for (int bj = 0; bj < 2; ++bj) { const f32x4 r0 = *(const f32x4*)(res + off + bj * HALF), r1 = *(const f32x4*)(res + off + bj * HALF + 4);
                    const f32x4 v0 = r0 * alpha + acc[ai][bj][m][0], v1 = r1 * alpha + acc[ai][bj][m][1];
                    u32x4 w; w.x = cvt_pk_bf16(v0[0], v0[1]); w.y = cvt_pk_bf16(v0[2], v0[3]); w.z = cvt_pk_bf16(v1[0], v1[1]); w.w = cvt_pk_bf16(v1[2], v1[3]);
                    *(u32x4*)(out + off + bj * HALF) = w; row_stat_acc(w, ss, qq); }
                row_stat_store(slots, row0 + ai * HALF + m * 16, u.pn * 4 + wc, fq, ss, qq);
                if (m == 3) asm volatile("" ::: "memory"); }
    }
};
struct EpiSwiGLU {
    static constexpr bool PERM = true, AFTER_DRAIN = false;
    bf16_t* G; int ldc; const f32x2* stats; const float* c1; const float* c2;
    __device__ __forceinline__ float act(float g, float u) const { return g * u * __builtin_amdgcn_rcpf(1.0f + __builtin_amdgcn_exp2f(-1.4426950408889634f * g)); }
    __device__ __forceinline__ void operator()(const f32x4 (&acc)[2][2][4][2], const Unit& u, int wr, int wc, int fr, int fq) const {
        const int row0 = u.pm * BM + wr * 64 + fr, col0 = u.pn * HALF + wc * 32 + 8 * fq, n0 = u.pn * BM + wc * 32 + 8 * fq;
        const f32x4 cg0 = *(const f32x4*)(c1 + n0), cg1 = *(const f32x4*)(c1 + n0 + 4), cu0 = *(const f32x4*)(c1 + n0 + HALF), cu1 = *(const f32x4*)(c1 + n0 + HALF + 4);
        const f32x4 dg0 = *(const f32x4*)(c2 + n0), dg1 = *(const f32x4*)(c2 + n0 + 4), du0 = *(const f32x4*)(c2 + n0 + HALF), du1 = *(const f32x4*)(c2 + n0 + HALF + 4);
#pragma unroll
        for (int ai = 0; ai < 2; ++ai)
#pragma unroll
            for (int m = 0; m < 4; ++m) { const int row = row0 + ai * HALF + m * 16; bf16_t* rowp = G + (size_t)row * ldc + col0; const f32x2 st = stats[row];
                const f32x4 g0 = (acc[ai][0][m][0] - cg0 * st.x) * st.y + dg0, g1 = (acc[ai][0][m][1] - cg1 * st.x) * st.y + dg1;
                const f32x4 u0 = (acc[ai][1][m][0] - cu0 * st.x) * st.y + du0, u1 = (acc[ai][1][m][1] - cu1 * st.x) * st.y + du1;
                u32x4 w; w.x = cvt_pk_bf16(act(g0[0], u0[0]), act(g0[1], u0[1])); w.y = cvt_pk_bf16(act(g0[2], u0[2]), act(g0[3], u0[3]));
                w.z = cvt_pk_bf16(act(g1[0], u1[0]), act(g1[1], u1[1])); w.w = cvt_pk_bf16(act(g1[2], u1[2]), act(g1[3], u1[3]));
                *(u32x4*)rowp = w; }
    }
};
struct EpiSwiGLU8 {
    static constexpr bool PERM = true, AFTER_DRAIN = false;
    bf16_t* G; int ldc; const float* sa; const float* sb;
    __device__ __forceinline__ float act(float g, float u) const { return g * u * __builtin_amdgcn_rcpf(1.0f + __builtin_amdgcn_exp2f(-1.4426950408889634f * g)); }
    __device__ __forceinline__ f32x4 cv(const f32x4& a) const { return __builtin_convertvector(__builtin_bit_cast(i32x4, a), f32x4); }
    __device__ __forceinline__ void operator()(const f32x4 (&acc)[2][2][4][2], const Unit& u, int wr, int wc, int fr, int fq) const {
        const int row0 = u.pm * BM + wr * 64 + fr, col0 = u.pn * HALF + wc * 32 + 8 * fq, n0 = u.pn * BM + wc * 32 + 8 * fq;
        const f32x4 cg0 = *(const f32x4*)(sb + n0), cg1 = *(const f32x4*)(sb + n0 + 4), cu0 = *(const f32x4*)(sb + n0 + HALF), cu1 = *(const f32x4*)(sb + n0 + HALF + 4);
#pragma unroll
        for (int ai = 0; ai < 2; ++ai)
#pragma unroll
            for (int m = 0; m < 4; ++m) { const int row = row0 + ai * HALF + m * 16; bf16_t* rowp = G + (size_t)row * ldc + col0; const float s = sa[row];
                const f32x4 g0 = cv(acc[ai][0][m][0]) * (cg0 * s), g1 = cv(acc[ai][0][m][1]) * (cg1 * s);
                const f32x4 u0 = cv(acc[ai][1][m][0]) * (cu0 * s), u1 = cv(acc[ai][1][m][1]) * (cu1 * s);
                u32x4 w; w.x = cvt_pk_bf16(act(g0[0], u0[0]), act(g0[1], u0[1])); w.y = cvt_pk_bf16(act(g0[2], u0[2]), act(g0[3], u0[3]));
                w.z = cvt_pk_bf16(act(g1[0], u1[0]), act(g1[1], u1[1])); w.w = cvt_pk_bf16(act(g1[2], u1[2]), act(g1[3], u1[3]));
                *(u32x4*)rowp = w; }
    }
};
struct EpiSoftmax {
    static constexpr bool PERM = true, AFTER_DRAIN = true;
    bf16_t* P; int ldc; float c2; const f32x2* stats; const float* k1; const float* k2;
    __device__ __forceinline__ void fused(f32x4 (&acc)[2][2][4][2], const Unit& u, int wr, int wc, int fr, int fq, PG8_LAS unsigned char* lds, int wid, int lane) const {
        PG8_LAS float* T1 = (PG8_LAS float*)lds;
        PG8_LAS float* T2 = (PG8_LAS float*)(lds + 4096);
        { const int nb = (u.pm >> 5) * 1024 + u.pn * BM + wc * 32 + 8 * fq;
          f32x4 ka[2][2], kb[2][2];
#pragma unroll
          for (int bj = 0; bj < 2; ++bj)
#pragma unroll
              for (int n = 0; n < 2; ++n) { ka[bj][n] = *(const f32x4*)(k1 + nb + bj * HALF + 4 * n); kb[bj][n] = *(const f32x4*)(k2 + nb + bj * HALF + 4 * n); }
#pragma unroll
          for (int ai = 0; ai < 2; ++ai)
#pragma unroll
              for (int m = 0; m < 4; ++m) { const f32x2 st = stats[u.pm * BM + ai * HALF + wr * 64 + m * 16 + fr];
#pragma unroll
                  for (int bj = 0; bj < 2; ++bj)
#pragma unroll
                      for (int n = 0; n < 2; ++n) acc[ai][bj][m][n] = (acc[ai][bj][m][n] - ka[bj][n] * st.x) * st.y + kb[bj][n]; } }
#pragma unroll
        for (int ai = 0; ai < 2; ++ai)
#pragma unroll
            for (int m = 0; m < 4; ++m) { float mx = -3.0e38f;
#pragma unroll
                for (int bj = 0; bj < 2; ++bj)
#pragma unroll
                    for (int n = 0; n < 2; ++n) { const f32x4 x = acc[ai][bj][m][n]; mx = fmaxf(mx, fmaxf(fmaxf(x[0], x[1]), fmaxf(x[2], x[3]))); }
                mx = fmaxf(mx, __shfl_xor(mx, 16)); mx = fmaxf(mx, __shfl_xor(mx, 32));
                if (fq == 0) T1[(ai * HALF + wr * 64 + m * 16 + fr) * 4 + wc] = mx; }
        asm volatile("s_waitcnt lgkmcnt(0)" ::: "memory"); __builtin_amdgcn_s_barrier(); asm volatile("" ::: "memory");
#pragma unroll
        for (int ai = 0; ai < 2; ++ai)
#pragma unroll
            for (int m = 0; m < 4; ++m) { const int r = ai * HALF + wr * 64 + m * 16 + fr;
                const f32x4 t = *(const PG8_LAS f32x4*)(T1 + r * 4); const float mx = fmaxf(fmaxf(t[0], t[1]), fmaxf(t[2], t[3])) * c2; float s = 0.f;
#pragma unroll
                for (int bj = 0; bj < 2; ++bj)
#pragma unroll
                    for (int n = 0; n < 2; ++n) { f32x4 x = acc[ai][bj][m][n];
#pragma unroll
                        for (int e = 0; e < 4; ++e) { x[e] = __builtin_amdgcn_exp2f(x[e] * c2 - mx); s += x[e]; }
                        acc[ai][bj][m][n] = x; }
                s += __shfl_xor(s, 16); s += __shfl_xor(s, 32);
                if (fq == 0) T2[r * 4 + wc] = s; }
        asm volatile("s_waitcnt lgkmcnt(0)" ::: "memory"); __builtin_amdgcn_s_barrier(); asm volatile("" ::: "memory");
        const int row0 = u.pm * BM + wr * 64 + fr, col0 = u.pn * BM + wc * 32 + 8 * fq;
#pragma unroll
        for (int ai = 0; ai < 2; ++ai)
#pragma unroll
            for (int m = 0; m < 4; ++m) { const int r = ai * HALF + wr * 64 + m * 16 + fr;
                const f32x4 t = *(const PG8_LAS f32x4*)(T2 + r * 4); const float inv = 1.0f / ((t[0] + t[1]) + (t[2] + t[3]));
                bf16_t* rowp = P + (size_t)(row0 + ai * HALF + m * 16) * ldc + col0;
#pragma unroll
                for (int bj = 0; bj < 2; ++bj) { const f32x4 v0 = acc[ai][bj][m][0] * inv, v1 = acc[ai][bj][m][1] * inv;
                    u32x4 w; w.x = cvt_pk_bf16(v0[0], v0[1]); w.y = cvt_pk_bf16(v0[2], v0[3]); w.z = cvt_pk_bf16(v1[0], v1[1]); w.w = cvt_pk_bf16(v1[2], v1[3]);
                    *(u32x4*)(rowp + bj * HALF) = w; } }
    }
};

struct GemmKV {
    const char* memb; const char* wkv; int lda, ldb, K;
    __device__ __forceinline__ const char* a_ptr(const Unit& u) const { return memb + (size_t)u.pm * (BM * 4096 * 2) + (size_t)u.pz * 2048; }
    __device__ __forceinline__ const char* b_ptr(const Unit& u) const { return wkv + (size_t)u.pn * (BM * 4096 * 2) + (size_t)u.pz * 2048; }
};
struct OrderKV {
    int G, c;
    __device__ __forceinline__ bool next(int i, Unit& u) const { const int L = i * G + c; if (L >= 256) return false; const int tile = L >> 2; u.pz = L & 3; u.pm = tile >> 5; u.pn = tile & 31; return true; }
    __device__ __forceinline__ void a_ready(const Unit&) const {}
    __device__ __forceinline__ void done(const Unit&) const {}
    __device__ __forceinline__ int pre_epi(int, int, int) const { return 0; }
    __device__ __forceinline__ void post_epi(int, int, int, int) const {}
};
struct OrderOne {
    Unit u;
    __device__ __forceinline__ bool next(int i, Unit& o) const { if (i != 0) return false; o = u; return true; }
    __device__ __forceinline__ void a_ready(const Unit&) const {}
    __device__ __forceinline__ void done(const Unit&) const {}
    __device__ __forceinline__ int pre_epi(int, int, int) const { return 0; }
    __device__ __forceinline__ void post_epi(int, int, int, int) const {}
};
struct EpiSlabKV {
    static constexpr bool PERM = false, AFTER_DRAIN = false;
    float* S;
    __device__ __forceinline__ void operator()(const f32x4 (&acc)[2][2][4][2], const Unit& u, int wr, int wc, int fr, int fq) const {
        float* C = S + (size_t)u.pz * (512 * 8192);
        const int row0 = u.pm * BM + wr * 64 + fr, col0 = u.pn * BM + wc * 32 + 4 * fq;
#pragma unroll
        for (int ai = 0; ai < 2; ++ai)
#pragma unroll
            for (int m = 0; m < 4; ++m) { float* rowp = C + (size_t)(row0 + ai * HALF + m * 16) * 8192 + col0;
#pragma unroll
                for (int bj = 0; bj < 2; ++bj)
#pragma unroll
                    for (int n = 0; n < 2; ++n) *(f32x4*)(rowp + bj * HALF + n * 16) = acc[ai][bj][m][n]; }
    }
};
struct GemmAbs {
    const char* kvx; const char* wq_raw; const char* wo_t; int lda, ldb, K;
    __device__ __forceinline__ const char* a_ptr(const Unit& u) const {
        return u.pz ? wo_t + (size_t)u.pm * (BM * 4096 * 2) + (size_t)(u.pn & 3) * 2048
                    : kvx + (size_t)(u.pm >> 2) * (BM * 8192 * 2) + (size_t)(u.pm & 3) * 2048; }
    __device__ __forceinline__ const char* b_ptr(const Unit& u) const {
        return u.pz ? kvx + 8192 + (size_t)(u.pn >> 2) * (BM * 8192 * 2) + (size_t)(u.pn & 3) * 2048
                    : wq_raw + (size_t)u.pn * (BM * 4096 * 2) + (size_t)(u.pm & 3) * 2048; }
};
struct OrderAbs {
    int c;
    __device__ __forceinline__ bool next(int i, Unit& u) const { if (i != 0 || c >= 256) return false; if (c < 128) { u.pz = 0; u.pm = c >> 4; u.pn = c & 15; } else { const int t = c - 128; u.pz = 1; u.pm = t >> 3; u.pn = t & 7; } return true; }
    __device__ __forceinline__ void a_ready(const Unit&) const {}
    __device__ __forceinline__ void done(const Unit&) const {}
    __device__ __forceinline__ int pre_epi(int, int, int) const { return 0; }
    __device__ __forceinline__ void post_epi(int, int, int, int) const {}
};
struct EpiStoreAbs {
    static constexpr bool PERM = true, AFTER_DRAIN = false;
    bf16_t* WQK; bf16_t* WVOT; float* k1; float* k2;
    __device__ __forceinline__ void operator()(const f32x4 (&acc)[2][2][4][2], const Unit& u, int wr, int wc, int fr, int fq) const {
        bf16_t* O = u.pz ? WVOT : WQK; const int ldc = u.pz ? 2048 : 4096;
        const int row0 = u.pm * BM + wr * 64 + fr, col0 = u.pn * BM + wc * 32 + 8 * fq;
        f32x4 gv[2][2], bv[2][2];
#pragma unroll
        for (int bj = 0; bj < 2; ++bj)
#pragma unroll
            for (int n = 0; n < 2; ++n) { gv[bj][n] = (f32x4){1.f, 1.f, 1.f, 1.f}; bv[bj][n] = (f32x4){0.f, 0.f, 0.f, 0.f}; }
        if (!u.pz) { const float* const __attribute__((address_space(4)))* inp = (const float* const __attribute__((address_space(4)))*)__builtin_amdgcn_kernarg_segment_ptr();
            const float* g = inp[6]; const float* b = inp[7];
#pragma unroll
            for (int bj = 0; bj < 2; ++bj)
#pragma unroll
                for (int n = 0; n < 2; ++n) { gv[bj][n] = *(const f32x4*)(g + col0 + bj * HALF + 4 * n); bv[bj][n] = *(const f32x4*)(b + col0 + bj * HALF + 4 * n); } }
#pragma unroll
        for (int ai = 0; ai < 2; ++ai)
#pragma unroll
            for (int m = 0; m < 4; ++m) { const int row = row0 + ai * HALF + m * 16; bf16_t* rowp = O + (size_t)row * ldc + col0; float s1 = 0.f, s2 = 0.f, dummy = 0.f;
#pragma unroll
                for (int bj = 0; bj < 2; ++bj) { const f32x4 a0 = acc[ai][bj][m][0], a1 = acc[ai][bj][m][1], v0 = a0 * gv[bj][0], v1 = a1 * gv[bj][1];
                    u32x4 w; w.x = cvt_pk_bf16(v0[0], v0[1]); w.y = cvt_pk_bf16(v0[2], v0[3]); w.z = cvt_pk_bf16(v1[0], v1[1]); w.w = cvt_pk_bf16(v1[2], v1[3]);
                    *(u32x4*)(rowp + bj * HALF) = w; row_stat_acc(w, s1, dummy);
                    const f32x4 t0 = a0 * bv[bj][0], t1 = a1 * bv[bj][1]; s2 += ((t0[0] + t0[1]) + (t0[2] + t0[3])) + ((t1[0] + t1[1]) + (t1[2] + t1[3])); }
                if (!u.pz) { s1 += __shfl_xor(s1, 16); s2 += __shfl_xor(s2, 16); s1 += __shfl_xor(s1, 32); s2 += __shfl_xor(s2, 32);
                    if (fq == 0) { __hip_atomic_fetch_add(k1 + row, s1, __ATOMIC_RELAXED, __HIP_MEMORY_SCOPE_AGENT); __hip_atomic_fetch_add(k2 + row, s2, __ATOMIC_RELAXED, __HIP_MEMORY_SCOPE_AGENT); } } }
    }
};
struct EpiResidLN {
    static constexpr bool PERM = true, AFTER_DRAIN = false;
    bf16_t* T; const f32x2* stats; int gi; f32x2* slots;
    __device__ __forceinline__ void operator()(const f32x4 (&acc)[2][2][4][2], const Unit& u, int wr, int wc, int fr, int fq) const {
        constexpr int ldc = 4096; constexpr float alpha = 1.189207115002721f;
        const float* const __attribute__((address_space(4)))* inp = (const float* const __attribute__((address_space(4)))*)__builtin_amdgcn_kernarg_segment_ptr();
        const float* g = inp[gi]; const float* b = inp[gi + 1];
        const int row0 = u.pm * BM + wr * 64 + fr, col0 = u.pn * BM + wc * 32 + 8 * fq;
        f32x4 gv[2][2], bv[2][2];
#pragma unroll
        for (int bj = 0; bj < 2; ++bj)
#pragma unroll
            for (int n = 0; n < 2; ++n) { gv[bj][n] = *(const f32x4*)(g + col0 + bj * HALF + n * 4) * alpha; bv[bj][n] = *(const f32x4*)(b + col0 + bj * HALF + n * 4) * alpha; }
#pragma unroll
        for (int ai = 0; ai < 2; ++ai)
#pragma unroll
            for (int m = 0; m < 4; ++m) { const int row = row0 + ai * HALF + m * 16; const size_t off = (size_t)row * ldc + col0; const f32x2 st = stats[row]; float ss = 0.f, qq = 0.f;
#pragma unroll
                for (int bj = 0; bj < 2; ++bj) { const u32x4 r = *(const u32x4*)(T + off + bj * HALF);
                    const f32x4 t0 = (f32x4){__builtin_bit_cast(float, r.x << 16), __builtin_bit_cast(float, r.x & 0xffff0000u), __builtin_bit_cast(float, r.y << 16), __builtin_bit_cast(float, r.y & 0xffff0000u)};
                    const f32x4 t1 = (f32x4){__builtin_bit_cast(float, r.z << 16), __builtin_bit_cast(float, r.z & 0xffff0000u), __builtin_bit_cast(float, r.w << 16), __builtin_bit_cast(float, r.w & 0xffff0000u)};
                    const f32x4 v0 = ((t0 - st.x) * st.y) * gv[bj][0] + bv[bj][0] + acc[ai][bj][m][0], v1 = ((t1 - st.x) * st.y) * gv[bj][1] + bv[bj][1] + acc[ai][bj][m][1];
                    u32x4 w; w.x = cvt_pk_bf16(v0[0], v0[1]); w.y = cvt_pk_bf16(v0[2], v0[3]); w.z = cvt_pk_bf16(v1[0], v1[1]); w.w = cvt_pk_bf16(v1[2], v1[3]);
                    *(u32x4*)(T + off + bj * HALF) = w; row_stat_acc(w, ss, qq); }
                if (slots) row_stat_store(slots, row, u.pn * 4 + wc, fq, ss, qq);
                if (m == 3) asm volatile("" ::: "memory"); }
    }
};

template <class Epi, class Sched, bool ALIGN_EPI = false, bool SP2 = false, class GT = Gemm, bool I8 = false>
__device__ __forceinline__ void gemm_phase(PG8_LAS unsigned char* lds, const GT g, const Sched& S, const Epi& E) {
    const int tid = threadIdx.x, wid = __builtin_amdgcn_readfirstlane(tid >> 6), lane = tid & 63, wr = wid >> 2, wc = wid & 3, fr = lane & 15, fq = lane >> 4;
    const int K = g.K, nt = K / BK;
    unsigned voffA[2], voffB[2];
#pragma unroll
    for (int i = 0; i < 2; ++i) { int R, C; stage_rc(tid * 16 + i * 8192, R, C); const int Rb = Epi::PERM ? ((R & ~31) + perm32(R & 31)) : R;
        voffA[i] = (unsigned)(R * g.lda + C) * 2u; voffB[i] = (unsigned)(Rb * g.ldb + C) * 2u; }
    const size_t kstep = (size_t)(BK * 2);
    const size_t hA = (size_t)HALF * g.lda * 2, hB = (size_t)HALF * g.ldb * 2;
    const unsigned ldsw = (unsigned)wid * 1024u;
    const int aoff = lds_byte(wr * 64 + fr, fq * 8), boff = lds_byte(wc * 32 + fr, fq * 8);
#define PG8_SA(b, h) (((b) * 2 + (h)) * HTB)
#define PG8_SB(b, h) ((4 + (b) * 2 + (h)) * HTB)
#define PG8_STAGE(bufoff, gbase, voff) do { _Pragma("unroll") for (int _i = 0; _i < 2; ++_i) \
        __builtin_amdgcn_global_load_lds((const unsigned*)((const char*)(gbase) + (voff)[_i]), (PG8_LAS unsigned*)(lds + (bufoff) + ldsw + _i * 8192), 16, 0, 0); } while (0)
#define PG8_LDA(dst, b, h) do { _Pragma("unroll") for (int m = 0; m < 4; ++m) _Pragma("unroll") for (int k = 0; k < 2; ++k) dst[m][k] = *(const PG8_LAS bf16x8*)(lds + PG8_SA(b, h) + aoff + m * 2048 + k * 1024); } while (0)
#define PG8_LDB(dst, b, h) do { _Pragma("unroll") for (int n = 0; n < 2; ++n) _Pragma("unroll") for (int k = 0; k < 2; ++k) dst[n][k] = *(const PG8_LAS bf16x8*)(lds + PG8_SB(b, h) + boff + n * 2048 + k * 1024); } while (0)
#define PG8_MMA(ai, bj, At, Bt) do { __builtin_amdgcn_s_setprio(1); _Pragma("unroll") for (int m = 0; m < 4; ++m) _Pragma("unroll") for (int n = 0; n < 2; ++n) _Pragma("unroll") for (int k = 0; k < 2; ++k) \
        { if constexpr (I8) acc[ai][bj][m][n] = __builtin_bit_cast(f32x4, __builtin_amdgcn_mfma_i32_16x16x64_i8(__builtin_bit_cast(i32x4, Bt[n][k]), __builtin_bit_cast(i32x4, At[m][k]), __builtin_bit_cast(i32x4, acc[ai][bj][m][n]), 0, 0, 0)); \
          else acc[ai][bj][m][n] = __builtin_amdgcn_mfma_f32_16x16x32_bf16(Bt[n][k], At[m][k], acc[ai][bj][m][n], 0, 0, 0); } __builtin_amdgcn_s_setprio(0); } while (0)
#define PG8_WAIT_V(n) asm volatile("s_waitcnt vmcnt(" #n ")" ::: "memory")
#define PG8_WAIT_L(n) asm volatile("s_waitcnt lgkmcnt(" #n ")" ::: "memory")
#define PG8_BAR __builtin_amdgcn_s_barrier()
#define PG8_SCHED __builtin_amdgcn_sched_barrier(0)
    Unit cur, nxt; int ui = 0;
    if (!S.next(0, cur)) return;
    f32x4 acc[2][2][4][2];
#pragma unroll
    for (int a = 0; a < 2; ++a)
#pragma unroll
        for (int b = 0; b < 2; ++b)
#pragma unroll
            for (int m = 0; m < 4; ++m)
#pragma unroll
                for (int n = 0; n < 2; ++n) acc[a][b][m][n] = (f32x4){0.f, 0.f, 0.f, 0.f};
    bf16x8 At[4][2], B0[2][2], B1[2][2];
    const char* cA = g.a_ptr(cur); const char* cB = g.b_ptr(cur);
    S.a_ready(cur);
    if constexpr (SP2) {
        PG8_STAGE(PG8_SB(0, 0), cB, voffB); PG8_STAGE(PG8_SB(0, 1), cB + hB, voffB); PG8_STAGE(PG8_SA(0, 0), cA, voffA); PG8_STAGE(PG8_SA(0, 1), cA + hA, voffA);
        if (wr == 1) PG8_BAR;
        PG8_WAIT_V(2); PG8_BAR;
        PG8_STAGE(PG8_SB(1, 0), cB + kstep, voffB); PG8_STAGE(PG8_SA(1, 0), cA + kstep, voffA); PG8_STAGE(PG8_SB(1, 1), cB + hB + kstep, voffB);
        PG8_WAIT_V(6); PG8_BAR;
    } else {
        PG8_STAGE(PG8_SB(0, 0), cB, voffB); PG8_STAGE(PG8_SA(0, 0), cA, voffA); PG8_STAGE(PG8_SB(0, 1), cB + hB, voffB); PG8_STAGE(PG8_SA(0, 1), cA + hA, voffA);
        if (wr == 1) PG8_BAR;
        PG8_WAIT_V(4); PG8_BAR;
        PG8_STAGE(PG8_SB(1, 0), cB + kstep, voffB); PG8_STAGE(PG8_SA(1, 0), cA + kstep, voffA); PG8_STAGE(PG8_SB(1, 1), cB + hB + kstep, voffB);
        PG8_WAIT_V(6); PG8_BAR;
    }
    for (;;) {
        bool has_next = false;
        const char* nA = cA; const char* nB = cB;
        for (int t = 0; t < nt; t += 2) {
            const bool last = (t == nt - 2);
            if (last) { has_next = S.next(ui + 1, nxt); if (has_next) { nA = g.a_ptr(nxt); nB = g.b_ptr(nxt); S.a_ready(nxt); } }
            const char* a1 = cA + (size_t)(t + 1) * kstep;
            const char* a2 = last ? nA : cA + (size_t)(t + 2) * kstep; const char* b2 = last ? nB : cB + (size_t)(t + 2) * kstep;
            const char* a3 = a2 + kstep; const char* b3 = b2 + kstep;
            if constexpr (SP2) {
            PG8_LDB(B0, 0, 0); PG8_LDB(B1, 0, 1); PG8_SCHED; PG8_LDA(At, 0, 0); PG8_STAGE(PG8_SA(1, 1), a1 + hA, voffA);
            PG8_WAIT_V(8); PG8_WAIT_L(0); PG8_BAR; PG8_MMA(0, 0, At, B0); PG8_MMA(0, 1, At, B1); PG8_BAR; PG8_SCHED;
            PG8_LDA(At, 0, 1); PG8_STAGE(PG8_SB(0, 0), b2, voffB); PG8_STAGE(PG8_SB(0, 1), b2 + hB, voffB); PG8_STAGE(PG8_SA(0, 0), a2, voffA);
            PG8_WAIT_V(8); PG8_WAIT_L(0); PG8_BAR; PG8_MMA(1, 0, At, B0); PG8_MMA(1, 1, At, B1); PG8_BAR; PG8_SCHED;
            PG8_LDB(B0, 1, 0); PG8_LDB(B1, 1, 1); PG8_SCHED; PG8_LDA(At, 1, 0); PG8_STAGE(PG8_SA(0, 1), a2 + hA, voffA);
            PG8_WAIT_V(8); PG8_WAIT_L(0); PG8_BAR; PG8_MMA(0, 0, At, B0); PG8_MMA(0, 1, At, B1); PG8_BAR; PG8_SCHED;
            PG8_LDA(At, 1, 1); PG8_STAGE(PG8_SB(1, 0), b3, voffB); PG8_STAGE(PG8_SB(1, 1), b3 + hB, voffB); PG8_STAGE(PG8_SA(1, 0), a3, voffA);
            PG8_WAIT_V(8); PG8_WAIT_L(0); PG8_BAR; PG8_MMA(1, 0, At, B0); PG8_MMA(1, 1, At, B1); PG8_BAR; PG8_SCHED;
            } else {
            PG8_LDB(B0, 0, 0); PG8_SCHED; PG8_LDA(At, 0, 0); PG8_STAGE(PG8_SA(1, 1), a1 + hA, voffA);
            PG8_WAIT_L(8); PG8_BAR; PG8_WAIT_L(0); PG8_MMA(0, 0, At, B0); PG8_BAR; PG8_SCHED;
            PG8_LDB(B1, 0, 1); PG8_STAGE(PG8_SB(0, 0), b2, voffB);
            PG8_BAR; PG8_WAIT_L(0); PG8_MMA(0, 1, At, B1); PG8_BAR;
            PG8_LDA(At, 0, 1); PG8_STAGE(PG8_SA(0, 0), a2, voffA);
            PG8_BAR; PG8_WAIT_L(0); PG8_MMA(1, 0, At, B0); PG8_BAR; PG8_SCHED;
            PG8_STAGE(PG8_SB(0, 1), b2 + hB, voffB);
            PG8_WAIT_V(6); PG8_BAR; PG8_MMA(1, 1, At, B1); PG8_BAR;
            PG8_LDB(B0, 1, 0); PG8_SCHED; PG8_LDA(At, 1, 0); PG8_STAGE(PG8_SA(0, 1), a2 + hA, voffA);
            PG8_WAIT_L(8); PG8_BAR; PG8_WAIT_L(0); PG8_MMA(0, 0, At, B0); PG8_BAR; PG8_SCHED;
            PG8_LDB(B1, 1, 1); PG8_STAGE(PG8_SB(1, 0), b3, voffB);
            PG8_BAR; PG8_WAIT_L(0); PG8_MMA(0, 1, At, B1); PG8_BAR;
            PG8_LDA(At, 1, 1); PG8_STAGE(PG8_SA(1, 0), a3, voffA);
            PG8_BAR; PG8_WAIT_L(0); PG8_MMA(1, 0, At, B0); PG8_BAR; PG8_SCHED;
            PG8_STAGE(PG8_SB(1, 1), b3 + hB, voffB);
            PG8_WAIT_V(6); PG8_BAR; PG8_MMA(1, 1, At, B1); PG8_BAR;
            }
        }
        if constexpr (ALIGN_EPI) { if (wr == 0) PG8_BAR; }
        if constexpr (!Epi::AFTER_DRAIN) { const int tk_ = S.pre_epi(ui, wid, lane); E(acc, cur, wr, wc, fr, fq); S.post_epi(ui, wid, lane, tk_); S.done(cur); }
        if (!has_next) break;
#pragma unroll
        for (int a = 0; a < 2; ++a)
#pragma unroll
            for (int b = 0; b < 2; ++b)
#pragma unroll
                for (int m = 0; m < 4; ++m)
#pragma unroll
                    for (int n = 0; n < 2; ++n) acc[a][b][m][n] = (f32x4){0.f, 0.f, 0.f, 0.f};
        cur = nxt; cA = nA; cB = nB; ++ui;
        if constexpr (ALIGN_EPI) { if (wr == 1) PG8_BAR; }
    }
    PG8_WAIT_V(0);
    if constexpr (!ALIGN_EPI) { if (wr == 0) PG8_BAR; }
    PG8_BAR;
    if constexpr (Epi::AFTER_DRAIN) { E.fused(acc, cur, wr, wc, fr, fq, lds, wid, lane); S.done(cur); }
#undef PG8_SA
#undef PG8_SB
#undef PG8_STAGE
#undef PG8_LDA
#undef PG8_LDB
#undef PG8_MMA
#undef PG8_WAIT_V
#undef PG8_WAIT_L
#undef PG8_BAR
#undef PG8_SCHED
}
}

namespace att {
using bf16_t = unsigned short;
using bf16x8 = __attribute__((ext_vector_type(8))) short;
using s16x4  = __attribute__((ext_vector_type(4))) short;
using f32x16 = __attribute__((ext_vector_type(16))) float;
using u32x4  = __attribute__((ext_vector_type(4))) unsigned;
using u32x2  = __attribute__((ext_vector_type(2))) unsigned;
constexpr int   D = 128, NW = 8, QBLK = 32, KVBLK = 64, NT = 4;
constexpr float SCALE = 0.088388347648318440f;
constexpr float THR = 8.f;
constexpr int   LDQ = 2048, LDK = 2048;
constexpr size_t SHM_V = KVBLK * D * 2, SHM_K = KVBLK * D * 2, SHM_ATTN = 2 * SHM_V + 2 * SHM_K;
#define KSWZ(row, colB) ((row) * 256 + ((colB) ^ (((row) & 7) << 4)))
#define SBAR() __builtin_amdgcn_sched_barrier(0)
__device__ __forceinline__ int crow(int r, int hi) { return (r & 3) + 8 * (r >> 2) + 4 * hi; }
__device__ __forceinline__ unsigned cvtpk(float lo, float hi) { unsigned r; asm volatile("v_cvt_pk_bf16_f32 %0, %1, %2" : "=v"(r) : "v"(lo), "v"(hi)); return r; }

__device__ __forceinline__ void partialSM(f32x16& p0, f32x16& p1, float& m_reg, float& mn, float& alpha) {
  constexpr float C = SCALE * 1.4426950408889634f;
  float pmax = p0[0];
#pragma unroll
  for (int r = 1; r < 16; ++r) pmax = fmaxf(pmax, p0[r]);
#pragma unroll
  for (int r = 0; r < 16; ++r) pmax = fmaxf(pmax, p1[r]);
  { auto rr = __builtin_amdgcn_permlane32_swap(__float_as_uint(pmax), __float_as_uint(pmax), false, false);
    pmax = fmaxf(__uint_as_float(rr[0]), __uint_as_float(rr[1])); }
  if (__builtin_expect(__all(pmax - m_reg <= THR / SCALE), 1)) { mn = m_reg; alpha = 1.f; }
  else { mn = fmaxf(m_reg, pmax); alpha = __builtin_amdgcn_exp2f((m_reg - mn) * C); m_reg = mn; }
  float mnC = -mn * C;
#pragma unroll
  for (int r = 0; r < 16; ++r) p0[r] = fmaf(p0[r], C, mnC);
#pragma unroll
  for (int r = 0; r < 16; ++r) p1[r] = fmaf(p1[r], C, mnC);
#pragma unroll
  for (int r = 0; r < 16; ++r) p0[r] = __builtin_amdgcn_exp2f(p0[r]);
}
__device__ __forceinline__ void finishSM(f32x16& p0, f32x16& p1, float alpha, float& l_reg, bf16x8& pa0, bf16x8& pa1, bf16x8& pa2, bf16x8& pa3) {
#pragma unroll
  for (int r = 0; r < 16; ++r) p1[r] = __builtin_amdgcn_exp2f(p1[r]);
  float ps = 0;
#pragma unroll
  for (int r = 0; r < 16; ++r) ps += p0[r];
#pragma unroll
  for (int r = 0; r < 16; ++r) ps += p1[r];
  { auto rr = __builtin_amdgcn_permlane32_swap(__float_as_uint(ps), __float_as_uint(ps), false, false);
    ps = __uint_as_float(rr[0]) + __uint_as_float(rr[1]); }
  l_reg = l_reg * alpha + ps;
#define PK4(P, BASE, OUT) do { unsigned a0 = cvtpk(P[BASE + 0], P[BASE + 1]), a1 = cvtpk(P[BASE + 2], P[BASE + 3]);   \
    unsigned b0 = cvtpk(P[BASE + 4], P[BASE + 5]), b1 = cvtpk(P[BASE + 6], P[BASE + 7]);                              \
    auto r0 = __builtin_amdgcn_permlane32_swap(a0, b0, false, false); auto r1 = __builtin_amdgcn_permlane32_swap(a1, b1, false, false); \
    u32x4 w = {r0[0], r1[0], r0[1], r1[1]}; OUT = *reinterpret_cast<bf16x8*>(&w); } while (0)
  PK4(p0, 0, pa0); PK4(p0, 8, pa1); PK4(p1, 0, pa2); PK4(p1, 8, pa3);
#undef PK4
}
__device__ __forceinline__ void qkt(f32x16& p0, f32x16& p1, const char* Ks, const bf16x8* qr, int r32, int hi) {
  p0 = f32x16{}; p1 = f32x16{};
#pragma unroll
  for (int d0 = 0; d0 < 8; ++d0) { int cb = (d0 * 16 + hi * 8) * 2;
    bf16x8 b0 = *reinterpret_cast<const bf16x8*>(Ks + KSWZ(r32, cb));
    bf16x8 b1 = *reinterpret_cast<const bf16x8*>(Ks + KSWZ(32 + r32, cb));
    p0 = __builtin_amdgcn_mfma_f32_32x32x16_bf16(b0, qr[d0], p0, 0, 0, 0);
    p1 = __builtin_amdgcn_mfma_f32_32x32x16_bf16(b1, qr[d0], p1, 0, 0, 0); }
}
__device__ __forceinline__ void cmask(f32x16& p0, f32x16& p1, int jt, int qloc, int hi) {
#pragma unroll
  for (int r = 0; r < 16; ++r) { const int key = 64 * jt + crow(r, hi); if (key > qloc) p0[r] = -1e30f; if (key + 32 > qloc) p1[r] = -1e30f; }
}
__device__ __forceinline__ int v_st(int k, int c) { const int kk = (k & ~0xC) | ((k & 4) << 1) | ((k & 8) >> 1); return ((kk >> 3) * 4 + (c >> 5)) * 512 + ((kk & 7) * 32 + (c & 31)) * 2; }
__device__ __forceinline__ int v_rd_base(int lane) { return ((lane & 3) << 3) | (((lane >> 2) & 3) << 6) | (((lane >> 4) & 1) << 5) | (((lane >> 5) & 1) << 8); }
constexpr int v_rd_off(int d0, int ks, int half) { return d0 * 512 + ks * 4096 + half * 2048; }
template <int OFF> __device__ __forceinline__ s16x4 tr_read(int vb) {
  s16x4 r; asm volatile("ds_read_b64_tr_b16 %0, %1 offset:%2" : "=&v"(r) : "v"(vb), "i"(OFF) : "memory"); return r;
}
template <int D0> __device__ __forceinline__ void pv_one(f32x16& od, int vb, bf16x8 pa0, bf16x8 pa1, bf16x8 pa2, bf16x8 pa3) {
  const s16x4 l0 = tr_read<v_rd_off(D0, 0, 0)>(vb), h0 = tr_read<v_rd_off(D0, 0, 1)>(vb), l1 = tr_read<v_rd_off(D0, 1, 0)>(vb), h1 = tr_read<v_rd_off(D0, 1, 1)>(vb);
  const s16x4 l2 = tr_read<v_rd_off(D0, 2, 0)>(vb), h2 = tr_read<v_rd_off(D0, 2, 1)>(vb), l3 = tr_read<v_rd_off(D0, 3, 0)>(vb), h3 = tr_read<v_rd_off(D0, 3, 1)>(vb);
  asm volatile("s_waitcnt lgkmcnt(0)" ::: "memory"); SBAR();
#define PK(L, H) (bf16x8){L[0], L[1], L[2], L[3], H[0], H[1], H[2], H[3]}
  od = __builtin_amdgcn_mfma_f32_32x32x16_bf16(PK(l0, h0), pa0, od, 0, 0, 0);
  od = __builtin_amdgcn_mfma_f32_32x32x16_bf16(PK(l1, h1), pa1, od, 0, 0, 0);
  od = __builtin_amdgcn_mfma_f32_32x32x16_bf16(PK(l2, h2), pa2, od, 0, 0, 0);
  od = __builtin_amdgcn_mfma_f32_32x32x16_bf16(PK(l3, h3), pa3, od, 0, 0, 0);
#undef PK
}
__device__ __forceinline__ void pv_d0(f32x16* o, int vb, bf16x8 pa0, bf16x8 pa1, bf16x8 pa2, bf16x8 pa3) {
  pv_one<0>(o[0], vb, pa0, pa1, pa2, pa3); pv_one<1>(o[1], vb, pa0, pa1, pa2, pa3); pv_one<2>(o[2], vb, pa0, pa1, pa2, pa3); pv_one<3>(o[3], vb, pa0, pa1, pa2, pa3);
}

__device__ __forceinline__ void attn_item(const bf16_t* __restrict__ Qrow, const bf16_t* __restrict__ Kh, const bf16_t* __restrict__ Vh, bool causal, int qloc,
                                          bf16_t* Orow, float2* MLrow, bool valid, char* lds) {
  const int tid = threadIdx.x, lane = tid & 63, r32 = lane & 31, hi = lane >> 5;
  char* V_lds = lds; char* K_lds = lds + 2 * SHM_V;
  float m_reg = -1e30f, l_reg = 0; f32x16 o[4] = {}; bf16x8 qr[8];
  const bf16_t* Qw = Qrow + hi * 8;
#pragma unroll
  for (int d0 = 0; d0 < 8; ++d0) qr[d0] = *reinterpret_cast<const bf16x8*>(Qw + d0 * 16);
  const int sr = tid >> 4, sc = (tid & 15) * 8, vst0 = v_st(sr, sc), vst1 = v_st(32 + sr, sc);
  const int vb0 = (int)(uintptr_t)V_lds + v_rd_base(lane);
  struct { bf16x8 vs0, vs1, ks0, ks1; } sr_[2];
#define SLOAD(i, k0) do { sr_[i].vs0 = *reinterpret_cast<const bf16x8*>(&Vh[(long)((k0) + sr) * LDK + sc]); sr_[i].vs1 = *reinterpret_cast<const bf16x8*>(&Vh[(long)((k0) + 32 + sr) * LDK + sc]); \
    sr_[i].ks0 = *reinterpret_cast<const bf16x8*>(&Kh[(long)((k0) + sr) * LDK + sc]); sr_[i].ks1 = *reinterpret_cast<const bf16x8*>(&Kh[(long)((k0) + 32 + sr) * LDK + sc]); } while (0)
#define SWRITE(b, i) do { *(bf16x8*)(V_lds + (b) * SHM_V + vst0) = sr_[i].vs0;          \
    *(bf16x8*)(V_lds + (b) * SHM_V + vst1) = sr_[i].vs1; int kc = sc * 2;               \
    *(bf16x8*)(K_lds + (b) * SHM_K + KSWZ(sr, kc)) = sr_[i].ks0;                       \
    *(bf16x8*)(K_lds + (b) * SHM_K + KSWZ(32 + sr, kc)) = sr_[i].ks1; } while (0)
#define SWAIT() asm volatile("s_waitcnt vmcnt(4)" ::: "memory")
#define RESC(a) do { if (__any((a) < 1.f)) { _Pragma("unroll") for (int d = 0; d < 4; ++d) _Pragma("unroll") for (int r = 0; r < 16; ++r) o[d][r] *= (a); } } while (0)
  f32x16 pA0, pA1, pB0, pB1; float mnA, mnB, alA, alB; bf16x8 pa0, pa1, pa2, pa3;
  constexpr int SE = 0, SO = 1;
  SLOAD(SE, 0); asm volatile("s_waitcnt vmcnt(0)" ::: "memory"); SWRITE(0, SE); __syncthreads();
  qkt(pA0, pA1, K_lds, qr, r32, hi); if (causal) cmask(pA0, pA1, 0, qloc, hi); partialSM(pA0, pA1, m_reg, mnA, alA);
  SLOAD(SO, KVBLK); SLOAD(SE, 2 * KVBLK);
  SWAIT(); SWRITE(1, SO); __syncthreads();
  {
    SBAR(); qkt(pB0, pB1, K_lds + SHM_K, qr, r32, hi); if (causal) cmask(pB0, pB1, 1, qloc, hi);
    finishSM(pA0, pA1, alA, l_reg, pa0, pa1, pa2, pa3); SBAR();
    SLOAD(SO, 3 * KVBLK); SBAR();
    pv_d0(o, vb0, pa0, pa1, pa2, pa3); partialSM(pB0, pB1, m_reg, mnB, alB);
    __syncthreads(); SWAIT(); SWRITE(0, SE);
    RESC(alB); __syncthreads();
    SBAR(); qkt(pA0, pA1, K_lds, qr, r32, hi); if (causal) cmask(pA0, pA1, 2, qloc, hi);
    finishSM(pB0, pB1, alB, l_reg, pa0, pa1, pa2, pa3); SBAR();
    pv_d0(o, vb0 + (int)SHM_V, pa0, pa1, pa2, pa3); partialSM(pA0, pA1, m_reg, mnA, alA);
    __syncthreads(); asm volatile("s_waitcnt vmcnt(0)" ::: "memory"); SWRITE(1, SO);
    RESC(alA); __syncthreads();
  }
  SBAR(); qkt(pB0, pB1, K_lds + SHM_K, qr, r32, hi); if (causal) cmask(pB0, pB1, 3, qloc, hi);
  finishSM(pA0, pA1, alA, l_reg, pa0, pa1, pa2, pa3); SBAR();
  pv_d0(o, vb0, pa0, pa1, pa2, pa3); partialSM(pB0, pB1, m_reg, mnB, alB);
  __syncthreads(); RESC(alB);
  finishSM(pB0, pB1, alB, l_reg, pa0, pa1, pa2, pa3); SBAR();
  pv_d0(o, vb0 + (int)SHM_V, pa0, pa1, pa2, pa3);
  const float rl = 1.0f / l_reg;
  if (valid) {
#pragma unroll
    for (int d0 = 0; d0 < 4; ++d0)
#pragma unroll
      for (int g = 0; g < 4; ++g) { u32x2 w; w.x = cvtpk(o[d0][4 * g] * rl, o[d0][4 * g + 1] * rl); w.y = cvtpk(o[d0][4 * g + 2] * rl, o[d0][4 * g + 3] * rl);
        *reinterpret_cast<u32x2*>(Orow + 32 * d0 + 8 * g + 4 * hi) = w; }
    if (hi == 0) *MLrow = make_float2(m_reg, l_reg);
  }
#undef SLOAD
#undef SWRITE
#undef SWAIT
#undef RESC
}

struct ItemCtx { const bf16_t* Q; const bf16_t* K; const bf16_t* V; bf16_t* PO; float2* ML; const unsigned short* lists; };
__device__ __forceinline__ unsigned item_entry(const ItemCtx& C, const __attribute__((address_space(3))) int* D, int k, int rloc) {
  const int own = D[4 * k + 1], j = D[4 * k] & 31, cnt = D[4 * k + 3];
  if (own) return (unsigned)(256 * j + rloc) | (3u << 13);
  return (unsigned)C.lists[(size_t)(unsigned)D[4 * k + 2] + (rloc < cnt ? rloc : 0)];
}
__device__ __forceinline__ void attn_items(const ItemCtx& C, const __attribute__((address_space(3))) int* D, int nloc, char* lds) {
  if (nloc <= 0) return;
  const int tid = threadIdx.x, wid = tid >> 6, lane = tid & 63, r32 = lane & 31, hi = lane >> 5, rloc = 32 * wid + r32;
  char* V_lds = lds; char* K_lds = lds + 2 * SHM_V;
  const int sr = tid >> 4, sc = (tid & 15) * 8, vst0 = v_st(sr, sc), vst1 = v_st(32 + sr, sc);
  const int vb0 = (int)(uintptr_t)V_lds + v_rd_base(lane);
  struct { bf16x8 vs0, vs1, ks0, ks1; } sr_[2];
  bf16x8 qr[8];
#define KVBASE(k, Kh, Vh) const bf16_t* Kh; const bf16_t* Vh; { const int bhj_ = D[4 * (k)], bh_ = bhj_ >> 5, j_ = bhj_ & 31; \
    const size_t off_ = ((size_t)(bh_ >> 4) * 8192 + 256 * j_) * LDK + (bh_ & 15) * D_; Kh = C.K + off_; Vh = C.V + off_; }
#define SLOADP(i, Kh, Vh, k0) do { sr_[i].vs0 = *reinterpret_cast<const bf16x8*>(&Vh[(long)((k0) + sr) * LDK + sc]); sr_[i].vs1 = *reinterpret_cast<const bf16x8*>(&Vh[(long)((k0) + 32 + sr) * LDK + sc]); \
    sr_[i].ks0 = *reinterpret_cast<const bf16x8*>(&Kh[(long)((k0) + sr) * LDK + sc]); sr_[i].ks1 = *reinterpret_cast<const bf16x8*>(&Kh[(long)((k0) + 32 + sr) * LDK + sc]); } while (0)
#define SWRITE(b, i) do { *(bf16x8*)(V_lds + (b) * SHM_V + vst0) = sr_[i].vs0;          \
    *(bf16x8*)(V_lds + (b) * SHM_V + vst1) = sr_[i].vs1; int kc = sc * 2;               \
    *(bf16x8*)(K_lds + (b) * SHM_K + KSWZ(sr, kc)) = sr_[i].ks0;                       \
    *(bf16x8*)(K_lds + (b) * SHM_K + KSWZ(32 + sr, kc)) = sr_[i].ks1; } while (0)
#define QLOAD(e, k) do { const int bh_ = D[4 * (k)] >> 5; const bf16_t* Qw_ = C.Q + ((size_t)(bh_ >> 4) * 8192 + ((e) & 8191u)) * LDQ + (bh_ & 15) * D_ + hi * 8; \
    _Pragma("unroll") for (int d0 = 0; d0 < 8; ++d0) qr[d0] = *reinterpret_cast<const bf16x8*>(Qw_ + d0 * 16); } while (0)
#define RESC(a) do { if (__any((a) < 1.f)) { _Pragma("unroll") for (int d = 0; d < 4; ++d) _Pragma("unroll") for (int r = 0; r < 16; ++r) o[d][r] *= (a); } } while (0)
  constexpr int D_ = 128, SE = 0, SO = 1;
  unsigned e_cur = item_entry(C, D, 0, rloc), e_nxt = (nloc > 1) ? item_entry(C, D, 1, rloc) : 0u;
  { KVBASE(0, Kh, Vh); SLOADP(SE, Kh, Vh, 0); SLOADP(SO, Kh, Vh, KVBLK); }
  QLOAD(e_cur, 0);
  for (int k = 0; k < nloc; ++k) {
    const bool has_next = (k + 1 < nloc);
    const bool causal = D[4 * k + 1] != 0; const int cnt = D[4 * k + 3];
    KVBASE(k, Kh, Vh);
    float m_reg = -1e30f, l_reg = 0; f32x16 o[4] = {};
    f32x16 pA0, pA1, pB0, pB1; float mnA, mnB, alA, alB; bf16x8 pa0, pa1, pa2, pa3;
    asm volatile("s_waitcnt vmcnt(0)" ::: "memory"); SWRITE(0, SE); __syncthreads();
    qkt(pA0, pA1, K_lds, qr, r32, hi); if (causal) cmask(pA0, pA1, 0, rloc, hi); partialSM(pA0, pA1, m_reg, mnA, alA);
    SLOADP(SE, Kh, Vh, 2 * KVBLK);
    SWRITE(1, SO); __syncthreads();
    SLOADP(SO, Kh, Vh, 3 * KVBLK);
    SBAR(); qkt(pB0, pB1, K_lds + SHM_K, qr, r32, hi); if (causal) cmask(pB0, pB1, 1, rloc, hi);
    finishSM(pA0, pA1, alA, l_reg, pa0, pa1, pa2, pa3); SBAR();
    pv_d0(o, vb0, pa0, pa1, pa2, pa3); partialSM(pB0, pB1, m_reg, mnB, alB);
    __syncthreads(); asm volatile("s_waitcnt vmcnt(4)" ::: "memory"); SWRITE(0, SE);
    RESC(alB); __syncthreads();
    if (has_next) { KVBASE(k + 1, Kn, Vn); SLOADP(SE, Kn, Vn, 0); }
    SBAR(); qkt(pA0, pA1, K_lds, qr, r32, hi); if (causal) cmask(pA0, pA1, 2, rloc, hi);
    finishSM(pB0, pB1, alB, l_reg, pa0, pa1, pa2, pa3); SBAR();
    pv_d0(o, vb0 + (int)SHM_V, pa0, pa1, pa2, pa3); partialSM(pA0, pA1, m_reg, mnA, alA);
    __syncthreads(); SWRITE(1, SO);
    RESC(alA); __syncthreads();
    if (has_next) { KVBASE(k + 1, Kn, Vn); SLOADP(SO, Kn, Vn, KVBLK); }
    SBAR(); qkt(pB0, pB1, K_lds + SHM_K, qr, r32, hi); if (causal) cmask(pB0, pB1, 3, rloc, hi);
    SBAR();
    if (has_next) QLOAD(e_nxt, k + 1);
    finishSM(pA0, pA1, alA, l_reg, pa0, pa1, pa2, pa3); SBAR();
    pv_d0(o, vb0, pa0, pa1, pa2, pa3); partialSM(pB0, pB1, m_reg, mnB, alB);
    __syncthreads(); RESC(alB);
    finishSM(pB0, pB1, alB, l_reg, pa0, pa1, pa2, pa3); SBAR();
    pv_d0(o, vb0 + (int)SHM_V, pa0, pa1, pa2, pa3);
    { const float rl = 1.0f / l_reg; const int bh = D[4 * k] >> 5; const unsigned t = e_cur & 8191u, slot = e_cur >> 13;
      if (rloc < cnt) {
        bf16_t* Orow = C.PO + (((size_t)slot * 32 + bh) * 8192 + t) * D_;
#pragma unroll
        for (int d0 = 0; d0 < 4; ++d0)
#pragma unroll
          for (int g = 0; g < 4; ++g) { u32x2 w; w.x = cvtpk(o[d0][4 * g] * rl, o[d0][4 * g + 1] * rl); w.y = cvtpk(o[d0][4 * g + 2] * rl, o[d0][4 * g + 3] * rl);
            *reinterpret_cast<u32x2*>(Orow + 32 * d0 + 8 * g + 4 * hi) = w; }
        if (hi == 0) C.ML[((size_t)slot * 32 + bh) * 8192 + t] = make_float2(m_reg, l_reg);
      } }
    e_cur = e_nxt; if (k + 2 < nloc) e_nxt = item_entry(C, D, k + 2, rloc);
  }
#undef KVBASE
#undef SLOADP
#undef SWRITE
#undef QLOAD
#undef RESC
}
#undef KSWZ
#undef SBAR
}

constexpr int NWAVES = 8;
#ifndef MK_N_LAUNCHES
#define MK_N_LAUNCHES 1
#endif
constexpr int N_PHASES = 16;
constexpr int N_LAUNCHES = MK_N_LAUNCHES;

constexpr int BATCH = 2, SEQ = 8192, DM = 4096, M = BATCH * SEQ, MEMLEN = 256;
constexpr int PW = 2048, AW = 2048, NH = 16, HD = 128, NBLK = 32, MIXIN = 8192, FF = 11008, XH = 4, XHD = 1024;
constexpr float LN_EPS = 1e-5f;
constexpr float DN_ALPHA = 1.189207115002721f;

constexpr size_t MiB = 1u << 20;
constexpr size_t WS_CTL = 0, CTL_ZERO_BYTES = 1 * MiB;
constexpr size_t WS_ROPE = 1 * MiB;
constexpr size_t WS_KMH = 5 * MiB, WS_KML = 5 * MiB + 512 * 1024;
constexpr size_t WS_MEMB = 6 * MiB;
constexpr size_t WS_KVX = 10 * MiB;
constexpr size_t WS_LIST = 18 * MiB;
constexpr size_t WS_ML = 26 * MiB;
constexpr size_t WS_WIN = 34 * MiB, WS_WPOOL = 98 * MiB, WS_WOUT = 100 * MiB, WS_WXQ = 132 * MiB, WS_WXKV = 164 * MiB, WS_WXO = 228 * MiB, WS_WGU = 260 * MiB, WS_WDN = 432 * MiB;
constexpr size_t WS_ACT = 518 * MiB;
constexpr size_t WS_HP = WS_ACT, WS_Q = WS_ACT + 64 * MiB, WS_K = WS_ACT + 128 * MiB, WS_V = WS_ACT + 192 * MiB;
constexpr size_t WS_XB = WS_ACT + 256 * MiB;
constexpr size_t WS_PARTO = WS_ACT + 256 * MiB;
constexpr size_t WS_CAT = WS_ACT + 512 * MiB;
constexpr size_t WS_TB = WS_ACT;
constexpr size_t WS_HB = WS_ACT + 128 * MiB;
constexpr size_t WS_PB = WS_ACT + 256 * MiB;
constexpr size_t WS_G = WS_ACT + 256 * MiB;
constexpr size_t WS_SLAB = WS_ACT + 384 * MiB;
constexpr size_t WS_WQK = WS_ACT + 640 * MiB, WS_WVOT = WS_ACT + 656 * MiB;
constexpr size_t WS_WOUT2 = WS_ACT + 672 * MiB;
constexpr size_t WS_SLOT = WS_ML;
constexpr size_t WS_STATS = WS_LIST;
constexpr size_t WS_WTMP = WS_ACT;
constexpr size_t WS_H8 = WS_ACT + 128 * MiB;
constexpr size_t WS_W8IN = WS_WGU + 96 * MiB;
constexpr size_t WS_X8 = WS_ACT + 448 * MiB;
constexpr size_t WS_END = WS_ACT + 704 * MiB;
static_assert(WS_WDN + (size_t)DM * FF * 2 <= WS_ACT && WS_G + (size_t)M * FF * 2 <= WS_END && WS_WGU + (size_t)2 * FF * DM * 2 <= WS_WDN, "d_ws map");
constexpr int LIST_STRIDE = 256 * 496;
__host__ __device__ constexpr int list_off(int j) { return 256 * (31 * j - (j * (j - 1)) / 2); }
constexpr int CW_TMO = 0, CW_CODE = 1;
constexpr int CW_BAR = 4096;
constexpr int CW_GCNT = 8192;
constexpr int CW_CHK = 16384;
constexpr int CW_K1 = 32768, CW_K2 = 32768 + 2048;
constexpr int CW_DYN = 131072;
constexpr int CW_C1G = 65536, CW_C2G = 65536 + 22016;
constexpr int CW_SB = 65536;
constexpr int CW_SBIN = 212992, CW_SX = 221184;
constexpr int CW_SA = 196608;

#if !defined(GU_FILLER)
#define GU_IN_P0 1
#endif

#ifndef MIX8
#define MIX8 4
#endif

constexpr int RING_OFF = 0, RING_BYTES = 131072;
constexpr int LDSCTL_OFF = RING_BYTES, MISC_OFF = LDSCTL_OFF + 320;
constexpr int LDS_BYTES = 147456;

#define GAS __attribute__((address_space(1)))
#define LAS __attribute__((address_space(3)))
typedef unsigned short bf16;
typedef unsigned v4u __attribute__((ext_vector_type(4)));
typedef unsigned v2u __attribute__((ext_vector_type(2)));
typedef float f32x4 __attribute__((ext_vector_type(4)));
typedef short bf16x8 __attribute__((ext_vector_type(8)));
typedef float f32x16 __attribute__((ext_vector_type(16)));
typedef GAS unsigned gu32;
#define RLX_AGENT __ATOMIC_RELAXED, __HIP_MEMORY_SCOPE_AGENT
#define LDS_WAIT() asm volatile("s_waitcnt lgkmcnt(0)" ::: "memory")
#define VM_WAIT() asm volatile("s_waitcnt vmcnt(0)" ::: "memory")
__device__ __forceinline__ unsigned f2bf(float f) { unsigned u = __builtin_bit_cast(unsigned, f); return (u + 0x7fffu + ((u >> 16) & 1u)) >> 16; }
__device__ __forceinline__ unsigned pk2(float lo, float hi) { return f2bf(lo) | (f2bf(hi) << 16); }
__device__ __forceinline__ float bf_lo(unsigned w) { return __builtin_bit_cast(float, w << 16); }
__device__ __forceinline__ float bf_hi(unsigned w) { return __builtin_bit_cast(float, w & 0xffff0000u); }
__device__ __forceinline__ float bf2f(bf16 b) { return __builtin_bit_cast(float, ((unsigned)b) << 16); }
#define XB_TMO      128
#define XB_XCNT(j)  (256  + 64 * (j))
#define XB_XSUB(j)  (1280 + 64 * (j))
#define XB_XGEN(j)  (2304 + 64 * (j))
#define XB_TOP      3328
#define XB_TOPGEN   3392
#define XCD_BAR_WORDS 3456
#define XB_SPIN_CAP (1u << 18)

__device__ __forceinline__ unsigned xb_ld(unsigned* p)              { return __hip_atomic_load(p, __ATOMIC_RELAXED, __HIP_MEMORY_SCOPE_AGENT); }
__device__ __forceinline__ unsigned xb_add(unsigned* p, unsigned v) { return __hip_atomic_fetch_add(p, v, __ATOMIC_RELAXED, __HIP_MEMORY_SCOPE_AGENT); }
__device__ __forceinline__ unsigned xb_xcc_id() { return (unsigned)__builtin_amdgcn_s_getreg((3 << 11) | 20) & 0xFu; }
#define XB_SPIN(cond, bar) do { unsigned _sp = 0; while (cond) { __builtin_amdgcn_s_sleep(1); \
    if ((++_sp & 255u) == 0u) { if (xb_ld(&(bar)[XB_TMO])) break; if (_sp > XB_SPIN_CAP) { atomicAdd(&(bar)[XB_TMO], 1u); break; } } } } while (0)

struct XcdBarrier {
    unsigned* bar; unsigned x;
    volatile LAS unsigned* st;
};

__device__ __forceinline__ XcdBarrier xcd_barrier_post(unsigned* bar, volatile LAS unsigned* st) {
    XcdBarrier b; b.bar = bar; b.x = xb_xcc_id(); b.st = st;
    if (threadIdx.x == 0) (void)xb_add(&bar[XB_XCNT(b.x)], 1u);
    return b;
}
__device__ __forceinline__ void xcd_barrier_complete(unsigned* bar, unsigned x, unsigned& nloc, unsigned& nx) {
    const unsigned G = gridDim.x * gridDim.y * gridDim.z;
    unsigned sum, cnt, mine, sp = 0u;
    for (;;) {
        sum = 0u; cnt = 0u; mine = 0u;
#pragma unroll
        for (unsigned j = 0; j < 16; ++j) { const unsigned c = xb_ld(&bar[XB_XCNT(j)]); sum += c; cnt += (c > 0u) ? 1u : 0u; mine = (j == x) ? c : mine; }
        if (sum == G) break;
        __builtin_amdgcn_s_sleep(1);
        if ((++sp & 255u) == 0u) { if (xb_ld(&bar[XB_TMO])) break; if (sp > XB_SPIN_CAP) { atomicAdd(&bar[XB_TMO], 1u); break; } }
    }
    nloc = mine > 0u ? mine : 1u; nx = cnt > 0u ? cnt : 1u;
}

__device__ __forceinline__ void xcd_barrier(const XcdBarrier& b) {
    asm volatile("s_waitcnt vmcnt(0)" ::: "memory");
    __syncthreads();
    if (threadIdx.x == 0) {
        unsigned* bar = b.bar;
        __builtin_amdgcn_s_waitcnt(0);
        unsigned nloc = b.st[0], nx = b.st[1];
        if (nloc == 0u) { xcd_barrier_complete(bar, b.x, nloc, nx); b.st[0] = nloc; b.st[1] = nx; }
        const unsigned old = xb_add(&bar[XB_XSUB(b.x)], 1u);
        const unsigned gen = old / nloc;
        if (old + 1u == (gen + 1u) * nloc) {
            __builtin_amdgcn_fence(__ATOMIC_RELEASE, "agent");
            asm volatile("s_waitcnt vmcnt(0)" ::: "memory");
            const unsigned og = xb_add(&bar[XB_TOP], 1u);
            const unsigned tg = og / nx;
            if (og + 1u == (tg + 1u) * nx) xb_add(&bar[XB_TOPGEN], 1u);
            else XB_SPIN(xb_ld(&bar[XB_TOPGEN]) == tg, bar);
            __builtin_amdgcn_fence(__ATOMIC_ACQUIRE, "agent");
            xb_add(&bar[XB_XGEN(b.x)], 1u);
            asm volatile("s_waitcnt vmcnt(0)" ::: "memory");
        } else {
            XB_SPIN(xb_ld(&bar[XB_XGEN(b.x)]) == gen, bar);
            __builtin_amdgcn_fence(__ATOMIC_ACQUIRE, "agent");
            asm volatile("s_waitcnt vmcnt(0)" ::: "memory");
        }
    }
    __syncthreads();
}

struct Frame {
    LAS unsigned char* lds;
    volatile LAS unsigned* MISC;
    gu32* ctl;
    int tid, lane, wave;
    int G;
    unsigned char* ws;
};
__device__ __forceinline__ float wave_sum(float v) {
#pragma unroll
    for (int o = 1; o < 64; o <<= 1) v += __shfl_xor(v, o);
    return v;
}

#ifndef QW_NR
#define QW_NR 2
#endif
#ifndef Q8_NR
#define Q8_NR 2
#endif
__device__ __forceinline__ float wave_maxf(float v) {
#pragma unroll
    for (int o = 1; o < 64; o <<= 1) v = fmaxf(v, __shfl_xor(v, o));
    return v;
}
__device__ __forceinline__ unsigned pk4_i8(float a, float b, float c, float d) {
    const unsigned ia = __builtin_bit_cast(unsigned, a + 12582912.0f), ib = __builtin_bit_cast(unsigned, b + 12582912.0f), ic = __builtin_bit_cast(unsigned, c + 12582912.0f), id = __builtin_bit_cast(unsigned, d + 12582912.0f);
    return (ia & 0xffu) | ((ib & 0xffu) << 8) | ((ic & 0xffu) << 16) | (id << 24);
}

template <class RowMap>
__device__ __forceinline__ void p0_transpose_item(const float* W, int K, int N, bf16* WT, LAS float* scr, int item, int lane, const RowMap& rm, const float* colscale,
                                                  const float* kgain = nullptr, const float* kbias = nullptr, float* c1 = nullptr, float* c2 = nullptr) {
    const int nblk = N / 32, kb = item / nblk, nb = item % nblk, k0 = 64 * kb, n0 = 32 * nb;
    float ld[32];
    const float* src = W + (size_t)(k0 + (lane >> 5)) * N + n0 + (lane & 31);
#pragma unroll
    for (int i = 0; i < 32; ++i) ld[i] = *(const GAS float*)(src + (size_t)(2 * i) * N);
#pragma unroll
    for (int i = 0; i < 32; ++i) scr[(2 * i + (lane >> 5)) * 33 + (lane & 31)] = ld[i];
    LDS_WAIT(); asm volatile("" ::: "memory");
    const int c = lane & 7;
    f32x4 g0 = (f32x4){1.f, 1.f, 1.f, 1.f}, g1 = g0, b0 = (f32x4){0.f, 0.f, 0.f, 0.f}, b1 = b0;
    if (kgain) { g0 = *(const GAS f32x4*)(kgain + k0 + 8 * c); g1 = *(const GAS f32x4*)(kgain + k0 + 8 * c + 4); b0 = *(const GAS f32x4*)(kbias + k0 + 8 * c); b1 = *(const GAS f32x4*)(kbias + k0 + 8 * c + 4); }
#pragma unroll
    for (int j = 0; j < 4; ++j) { const int n = (lane >> 3) + 8 * j; const LAS float* s = scr + (8 * c) * 33 + n; const float sc = colscale ? colscale[n0 + n] : 1.0f;
        const float w0 = s[0 * 33] * sc, w1 = s[1 * 33] * sc, w2 = s[2 * 33] * sc, w3 = s[3 * 33] * sc, w4 = s[4 * 33] * sc, w5 = s[5 * 33] * sc, w6 = s[6 * 33] * sc, w7 = s[7 * 33] * sc;
        v4u o; o.x = pk2(w0 * g0.x, w1 * g0.y); o.y = pk2(w2 * g0.z, w3 * g0.w); o.z = pk2(w4 * g1.x, w5 * g1.y); o.w = pk2(w6 * g1.z, w7 * g1.w);
        const int row = rm(n0 + n);
        *(GAS v4u*)(WT + (size_t)row * K + k0 + 8 * c) = o;
        if (c1) {
            float t1 = ((bf_lo(o.x) + bf_hi(o.x)) + (bf_lo(o.y) + bf_hi(o.y))) + ((bf_lo(o.z) + bf_hi(o.z)) + (bf_lo(o.w) + bf_hi(o.w)));
            float t2 = ((w0 * b0.x + w1 * b0.y) + (w2 * b0.z + w3 * b0.w)) + ((w4 * b1.x + w5 * b1.y) + (w6 * b1.z + w7 * b1.w));
            t1 += __shfl_xor(t1, 1); t2 += __shfl_xor(t2, 1); t1 += __shfl_xor(t1, 2); t2 += __shfl_xor(t2, 2); t1 += __shfl_xor(t1, 4); t2 += __shfl_xor(t2, 4);
            if (c == 0) { __hip_atomic_fetch_add(c1 + row, t1, RLX_AGENT); __hip_atomic_fetch_add(c2 + row, t2, RLX_AGENT); } } }
    LDS_WAIT(); asm volatile("" ::: "memory");
}
struct RmIdent { int off; __device__ __forceinline__ int operator()(int n) const { return off + n; } };
struct RmMixIn { __device__ __forceinline__ int operator()(int n) const { if (n < 2048 || n >= 6144) return n; const int d = n & 127; return (n & ~127) + 2 * (d & 63) + (d >> 6); } };
struct RmGateUp { int up; __device__ __forceinline__ int operator()(int n) const { return (n >> 7) * 256 + up * 128 + (n & 127); } };

__device__ __forceinline__ void sincos_d(double a, double& s, double& c) {
    const double n = __builtin_rint(a * 0.63661977236758134308);
    double r = __builtin_fma(-n, 1.5707963267948966, a); r = __builtin_fma(-n, 6.123233995736766e-17, r);
    const double r2 = r * r;
    double ps = -7.6471637318198164759e-13; ps = ps * r2 + 1.6059043836821614599e-10; ps = ps * r2 - 2.5052108385441718775e-08; ps = ps * r2 + 2.7557319223985890653e-06;
    ps = ps * r2 - 1.9841269841269841270e-04; ps = ps * r2 + 8.3333333333333333333e-03; ps = ps * r2 - 1.6666666666666666667e-01; ps = r + r * r2 * ps;
    double pc = 4.7794773323873852974e-14; pc = pc * r2 - 1.1470745597729724714e-11; pc = pc * r2 + 2.0876756987868098979e-09; pc = pc * r2 - 2.7557319223985890653e-07;
    pc = pc * r2 + 2.4801587301587301587e-05; pc = pc * r2 - 1.3888888888888888889e-03; pc = pc * r2 + 4.1666666666666666667e-02; pc = pc * r2 - 0.5; pc = 1.0 + r2 * pc;
    const int q = ((int)n) & 3;
    s = (q == 0) ? ps : (q == 1) ? pc : (q == 2) ? -ps : -pc;
    c = (q == 0) ? pc : (q == 1) ? -ps : (q == 2) ? -pc : ps;
}
__device__ __forceinline__ float rope_inv(int i) {
    const double y = -(double)i * (13.287712379549449 / 64.0); const double fl = __builtin_floor(y); const double z = (y - fl) * 0.69314718055994530942;
    double e = 1.0, term = 1.0;
#pragma unroll
    for (int k = 1; k <= 20; ++k) { term = term * z / (double)k; e += term; }
    return (float)__builtin_ldexp(e, (int)fl);
}

__device__ __forceinline__ void p0_prologue(Frame& F, const float* const* in) {
    LAS float* scr = (LAS float*)(F.lds + RING_OFF + F.wave * 16384);
    const int gw = blockIdx.x * NWAVES + F.wave, NGW = F.G * NWAVES;
    const float* w_mix_in = in[2]; const float* w_pool = in[3]; const float* pool_scale = in[4]; const float* w_mix_out = in[5];
    const float* w_xq = in[8]; const float* w_xkv = in[9]; const float* w_xo = in[10]; const float* w_gate = in[13]; const float* w_up = in[14]; const float* w_down = in[15];
    bf16* WIN = (bf16*)(F.ws + WS_WIN); bf16* WPOOL = (bf16*)(F.ws + WS_WPOOL); bf16* WOUT = (bf16*)(F.ws + WS_WOUT); bf16* WXQ = (bf16*)(F.ws + WS_WXQ);
    bf16* WXKV = (bf16*)(F.ws + WS_WXKV); bf16* WXO = (bf16*)(F.ws + WS_WXO); bf16* WGU = (bf16*)(F.ws + WS_WGU); bf16* WDN = (bf16*)(F.ws + WS_WDN);
    constexpr int I_IN = (DM / 64) * (MIXIN / 32), I_POOL = (512 / 64) * (512 / 32), I_SQ = (DM / 64) * (DM / 32), I_KV = (DM / 64) * (2 * DM / 32), I_GU = (DM / 64) * (FF / 32), I_DN = (FF / 64) * (DM / 32);
#if defined(GU_IN_P0)
    constexpr int NITEMS = I_IN + 2 * I_SQ + I_KV + 2 * I_GU;
#else
    constexpr int NITEMS = I_IN + 2 * I_SQ + I_KV;
#endif
    const size_t gt = (size_t)blockIdx.x * (NWAVES * 64) + F.tid, NT = (size_t)F.G * NWAVES * 64;
#if MIX8 == 0
    { const float* x = in[0]; bf16* XB = (bf16*)(F.ws + WS_XB);
      for (size_t i = gt; i < (size_t)M * DM / 8; i += NT) { const f32x4 a = *(const GAS f32x4*)(x + i * 8), b = *(const GAS f32x4*)(x + i * 8 + 4);
          v4u o; o.x = pk2(a.x, a.y); o.y = pk2(a.z, a.w); o.z = pk2(b.x, b.y); o.w = pk2(b.z, b.w); *(GAS v4u*)(XB + i * 8) = o; } }
#else
    { const float* x = in[0]; bf16* XB = (bf16*)(F.ws + WS_XB); unsigned char* X8 = F.ws + WS_X8; float* sx = (float*)(F.ctl + CW_SX);
      for (int m = gw; m < M; m += NGW) { f32x4 a[8], b[8]; float am = 0.f;
#pragma unroll
          for (int j = 0; j < 8; ++j) { const size_t c = (size_t)m * DM + (64 * j + F.lane) * 8; a[j] = *(const GAS f32x4*)(x + c); b[j] = *(const GAS f32x4*)(x + c + 4); }
#pragma unroll
          for (int j = 0; j < 8; ++j) { const size_t c = (size_t)m * DM + (64 * j + F.lane) * 8;
              v4u o; o.x = pk2(a[j].x, a[j].y); o.y = pk2(a[j].z, a[j].w); o.z = pk2(b[j].x, b[j].y); o.w = pk2(b[j].z, b[j].w); *(GAS v4u*)(XB + c) = o;
              am = fmaxf(am, fmaxf(fmaxf(fmaxf(fabsf(a[j].x), fabsf(a[j].y)), fmaxf(fabsf(a[j].z), fabsf(a[j].w))), fmaxf(fmaxf(fabsf(b[j].x), fabsf(b[j].y)), fmaxf(fabsf(b[j].z), fabsf(b[j].w))))); }
          am = wave_maxf(am); const float inv = am > 0.f ? 127.0f / am : 0.f; if (F.lane == 0) sx[m] = am * (1.0f / 127.0f);
#pragma unroll
          for (int j = 0; j < 8; ++j) { const size_t c = (size_t)m * DM + (64 * j + F.lane) * 8;
              v2u o; o.x = pk4_i8(a[j].x * inv, a[j].y * inv, a[j].z * inv, a[j].w * inv); o.y = pk4_i8(b[j].x * inv, b[j].y * inv, b[j].z * inv, b[j].w * inv); *(GAS v2u*)(X8 + c) = o; } } }
#endif
    { const float* x = w_xq; bf16* XB = WXQ;
      for (size_t i = gt; i < (size_t)DM * DM / 8; i += NT) { const f32x4 a = *(const GAS f32x4*)(x + i * 8), b = *(const GAS f32x4*)(x + i * 8 + 4);
          v4u o; o.x = pk2(a.x, a.y); o.y = pk2(a.z, a.w); o.z = pk2(b.x, b.y); o.w = pk2(b.z, b.w); *(GAS v4u*)(XB + i * 8) = o; } }
    { bf16* WPR = WPOOL;
      for (size_t i = gt; i < (size_t)4 * 512 * 512 / 8; i += NT) { const size_t e = i * 8; const int d = (int)(e & 511), g = (int)(e >> 18);
          const f32x4 a = *(const GAS f32x4*)(w_pool + e), b = *(const GAS f32x4*)(w_pool + e + 4), s0 = *(const GAS f32x4*)(pool_scale + g * 512 + d), s1 = *(const GAS f32x4*)(pool_scale + g * 512 + d + 4);
          v4u o; o.x = pk2(a.x * s0.x, a.y * s0.y); o.y = pk2(a.z * s0.z, a.w * s0.w); o.z = pk2(b.x * s1.x, b.y * s1.y); o.w = pk2(b.z * s1.z, b.w * s1.w); *(GAS v4u*)(WPR + e) = o; } }
    { const float* x = in[1]; bf16* XB = (bf16*)(F.ws + WS_MEMB);
      for (size_t i = gt; i < (size_t)BATCH * MEMLEN * DM / 8; i += NT) { const f32x4 a = *(const GAS f32x4*)(x + i * 8), b = *(const GAS f32x4*)(x + i * 8 + 4);
          v4u o; o.x = pk2(a.x, a.y); o.y = pk2(a.z, a.w); o.z = pk2(b.x, b.y); o.w = pk2(b.z, b.w); *(GAS v4u*)(XB + i * 8) = o; } }
    { float2* tab = (float2*)(F.ws + WS_ROPE);
      for (size_t i = gt; i < (size_t)SEQ * 64; i += NT) { const int pos = (int)(i >> 6), fi = (int)(i & 63); const float ang = (float)pos * rope_inv(fi);
          double s, c; sincos_d((double)ang, s, c); tab[i] = make_float2((float)c, (float)s); } }
    for (int it = gw; it < NITEMS; it += NGW) {
        int r = it;
        if (r < I_IN) { p0_transpose_item(w_mix_in, DM, MIXIN, WIN, scr, r, F.lane, RmMixIn{}, nullptr); continue; } r -= I_IN;
        if (r < I_SQ) { const int kb = r / (DM / 32);
            if (kb < 32) p0_transpose_item(w_mix_out, 2048, DM, WOUT, scr, r, F.lane, RmIdent{0}, nullptr);
            else p0_transpose_item(w_mix_out, DM, DM, (bf16*)(F.ws + WS_WOUT2), scr, r, F.lane, RmIdent{0}, nullptr); continue; } r -= I_SQ;
        if (r < I_KV) { p0_transpose_item(w_xkv, DM, 2 * DM, WXKV, scr, r, F.lane, RmIdent{0}, nullptr); continue; } r -= I_KV;
        if (r < I_SQ) { p0_transpose_item(w_xo, DM, DM, WXO, scr, r, F.lane, RmIdent{0}, nullptr); continue; } r -= I_SQ;
        (void)w_gate; (void)w_up; (void)WGU;
#if defined(GU_IN_P0)
#if defined(GU_BF16)
        float* c1g = (float*)(F.ctl + CW_C1G); float* c2g = (float*)(F.ctl + CW_C2G);
        if (r < I_GU) { p0_transpose_item(w_gate, DM, FF, WGU, scr, r, F.lane, RmGateUp{0}, nullptr, in[11], in[12], c1g, c2g); continue; } r -= I_GU;
        p0_transpose_item(w_up, DM, FF, WGU, scr, r, F.lane, RmGateUp{1}, nullptr, in[11], in[12], c1g, c2g);
#else
        bf16* WTMP = (bf16*)(F.ws + WS_WTMP);
        if (r < I_GU) { p0_transpose_item(w_gate, DM, FF, WTMP, scr, r, F.lane, RmGateUp{0}, nullptr); continue; } r -= I_GU;
        p0_transpose_item(w_up, DM, FF, WTMP, scr, r, F.lane, RmGateUp{1}, nullptr);
#endif
#endif
    }
}

__device__ __forceinline__ void convert_wdown(Frame& F, const float* w_down, gu32* ctr) {
    LAS float* scr = (LAS float*)(F.lds + RING_OFF + F.wave * 16384); bf16* WDN = (bf16*)(F.ws + WS_WDN);
    constexpr int I_DN = (FF / 64) * (DM / 32);
    for (;;) { int base = 0; if (F.lane == 0) base = (int)__hip_atomic_fetch_add(ctr, 16u, RLX_AGENT); base = __builtin_amdgcn_readfirstlane(base);
        if (base >= I_DN) break;
        for (int it = base; it < base + 16 && it < I_DN; ++it) p0_transpose_item(w_down, FF, DM, WDN, scr, it, F.lane, RmIdent{0}, nullptr); }
}
__device__ __forceinline__ void convert_wdown_static(Frame& F, const float* w_down, int rk, int nwg) {
    LAS float* scr = (LAS float*)(F.lds + RING_OFF + F.wave * 16384); bf16* WDN = (bf16*)(F.ws + WS_WDN);
    constexpr int I_DN = (FF / 64) * (DM / 32);
    for (int it = rk * NWAVES + F.wave; it < I_DN; it += nwg * NWAVES) p0_transpose_item(w_down, FF, DM, WDN, scr, it, F.lane, RmIdent{0}, nullptr);
}

__device__ __forceinline__ bool gu_chunk(Frame& F, const float* const* in, gu32* q) {
    LAS float* scr = (LAS float*)(F.lds + RING_OFF + F.wave * 16384); bf16* WGU = (bf16*)(F.ws + WS_WGU);
    float* c1g = (float*)(F.ctl + CW_C1G); float* c2g = (float*)(F.ctl + CW_C2G);
    constexpr int I_GU = (DM / 64) * (FF / 32);
    int base = 0; if (F.lane == 0) base = (int)__hip_atomic_fetch_add(q, 4u, RLX_AGENT); base = __builtin_amdgcn_readfirstlane(base);
    if (base >= 2 * I_GU) return false;
    for (int it = base; it < base + 4; ++it) {
        if (it < I_GU) p0_transpose_item(in[13], DM, FF, WGU, scr, it, F.lane, RmGateUp{0}, nullptr, in[11], in[12], c1g, c2g);
        else p0_transpose_item(in[14], DM, FF, WGU, scr, it - I_GU, F.lane, RmGateUp{1}, nullptr, in[11], in[12], c1g, c2g); }
    return true;
}
__device__ __forceinline__ void gu_filler(Frame& F, const float* const* in, int slot) {
#if !defined(GU_IN_P0)
    gu32* q = F.ctl + CW_DYN + 4096 + 64; gu32* done = F.ctl + CW_DYN + 4096 + 128 + 64 * slot;
    __syncthreads();
    if (F.tid == 0) __hip_atomic_fetch_add(done, 1u, RLX_AGENT);
    for (;;) { if ((int)__builtin_amdgcn_readfirstlane((int)__hip_atomic_load(done, RLX_AGENT)) >= F.G) break; if (!gu_chunk(F, in, q)) break; }
#endif
}
__device__ __forceinline__ void gu_drain(Frame& F, const float* const* in) {
#if !defined(GU_IN_P0)
    gu32* q = F.ctl + CW_DYN + 4096 + 64;
    while (gu_chunk(F, in, q)) { }
#endif
}

__device__ __forceinline__ void ln_finalize(Frame& F, const float2* slots, float2* stats) {
    const int gw = blockIdx.x * NWAVES + F.wave, NGW = F.G * NWAVES;
    for (int m = gw; m < M; m += NGW) { const float2 p = slots[(size_t)m * 64 + F.lane];
        const float s = wave_sum(p.x), q = wave_sum(p.y), mean = s * (1.f / DM), var = fmaxf(q * (1.f / DM) - mean * mean, 0.f);
        if (F.lane == 0) stats[m] = make_float2(mean, 1.f / sqrtf(var + LN_EPS)); }
}

template <bool FINAL>
__device__ __forceinline__ void ln_rows(Frame& F, const bf16* T, bf16* XB, float2* stats, float* OUT, const float* g, const float* b) {
#ifndef LN_NR
#define LN_NR 2
#endif
    constexpr int NR = LN_NR;
    const int gw = blockIdx.x * NWAVES + F.wave, NGW = F.G * NWAVES;
    for (int mb = gw; mb < M; mb += NR * NGW) {
        int mr[NR]; v4u r[NR][8];
#pragma unroll
        for (int i = 0; i < NR; ++i) { mr[i] = (mb + i * NGW < M) ? mb + i * NGW : mb;
            const GAS v4u* tr = (const GAS v4u*)(T + (size_t)mr[i] * DM) + F.lane;
#pragma unroll
            for (int j = 0; j < 8; ++j) r[i][j] = tr[64 * j]; }
        float mean[NR], rstd[NR];
#pragma unroll
        for (int i = 0; i < NR; ++i) { float s = 0.f;
#pragma unroll
            for (int j = 0; j < 8; ++j) s += ((bf_lo(r[i][j].x) + bf_hi(r[i][j].x)) + (bf_lo(r[i][j].y) + bf_hi(r[i][j].y))) + ((bf_lo(r[i][j].z) + bf_hi(r[i][j].z)) + (bf_lo(r[i][j].w) + bf_hi(r[i][j].w)));
            mean[i] = wave_sum(s) * (1.f / DM); }
#pragma unroll
        for (int i = 0; i < NR; ++i) { float q = 0.f; const float mu = mean[i];
#pragma unroll
            for (int j = 0; j < 8; ++j) { float d;
                d = bf_lo(r[i][j].x) - mu; q += d * d; d = bf_hi(r[i][j].x) - mu; q += d * d; d = bf_lo(r[i][j].y) - mu; q += d * d; d = bf_hi(r[i][j].y) - mu; q += d * d;
                d = bf_lo(r[i][j].z) - mu; q += d * d; d = bf_hi(r[i][j].z) - mu; q += d * d; d = bf_lo(r[i][j].w) - mu; q += d * d; d = bf_hi(r[i][j].w) - mu; q += d * d; }
            rstd[i] = 1.f / sqrtf(wave_sum(q) * (1.f / DM) + LN_EPS); }
        if (!FINAL && F.lane == 0) {
#pragma unroll
            for (int i = 0; i < NR; ++i) stats[mr[i]] = make_float2(mean[i], rstd[i]); }
#pragma unroll
        for (int j = 0; j < 8; ++j) { const int c = (64 * j + F.lane) * 8;
            const f32x4 g0 = *(const GAS f32x4*)(g + c), g1 = *(const GAS f32x4*)(g + c + 4), b0 = *(const GAS f32x4*)(b + c), b1 = *(const GAS f32x4*)(b + c + 4);
#pragma unroll
            for (int i = 0; i < NR; ++i) { const float mu = mean[i], rs = rstd[i];
                const f32x4 ya = ((f32x4){bf_lo(r[i][j].x), bf_hi(r[i][j].x), bf_lo(r[i][j].y), bf_hi(r[i][j].y)} - mu) * rs * g0 + b0;
                const f32x4 yb = ((f32x4){bf_lo(r[i][j].z), bf_hi(r[i][j].z), bf_lo(r[i][j].w), bf_hi(r[i][j].w)} - mu) * rs * g1 + b1;
                if (FINAL) { *(GAS f32x4*)(OUT + (size_t)mr[i] * DM + c) = ya; *(GAS f32x4*)(OUT + (size_t)mr[i] * DM + c + 4) = yb; }
                else { v4u o; o.x = pk2(ya.x, ya.y); o.y = pk2(ya.z, ya.w); o.z = pk2(yb.x, yb.y); o.w = pk2(yb.z, yb.w); *(GAS v4u*)(XB + (size_t)mr[i] * DM + c) = o; } } }
    }
}

__device__ __forceinline__ void quant_rows(Frame& F, const bf16* T, unsigned char* Q, float* sb, const int NROW) {
    constexpr int NR = QW_NR;
    const int gw = blockIdx.x * NWAVES + F.wave, NGW = F.G * NWAVES;
    for (int mb = gw; mb < NROW; mb += NR * NGW) {
        int mr[NR]; v4u r[NR][8];
#pragma unroll
        for (int i = 0; i < NR; ++i) { mr[i] = (mb + i * NGW < NROW) ? mb + i * NGW : mb;
            const GAS v4u* tr = (const GAS v4u*)(T + (size_t)mr[i] * DM) + F.lane;
#pragma unroll
            for (int j = 0; j < 8; ++j) r[i][j] = tr[64 * j]; }
#pragma unroll
        for (int i = 0; i < NR; ++i) { float a = 0.f;
#pragma unroll
            for (int j = 0; j < 8; ++j) { const v4u w = r[i][j];
                a = fmaxf(a, fmaxf(fmaxf(fmaxf(fabsf(bf_lo(w.x)), fabsf(bf_hi(w.x))), fmaxf(fabsf(bf_lo(w.y)), fabsf(bf_hi(w.y)))), fmaxf(fmaxf(fabsf(bf_lo(w.z)), fabsf(bf_hi(w.z))), fmaxf(fabsf(bf_lo(w.w)), fabsf(bf_hi(w.w)))))); }
            a = wave_maxf(a); const float inv = a > 0.f ? 127.0f / a : 0.f;
            if (F.lane == 0) sb[mr[i]] = a * (1.0f / 127.0f);
            GAS v2u* qr = (GAS v2u*)(Q + (size_t)mr[i] * DM) + F.lane;
#pragma unroll
            for (int j = 0; j < 8; ++j) { const v4u w = r[i][j]; v2u o;
                o.x = pk4_i8(bf_lo(w.x) * inv, bf_hi(w.x) * inv, bf_lo(w.y) * inv, bf_hi(w.y) * inv); o.y = pk4_i8(bf_lo(w.z) * inv, bf_hi(w.z) * inv, bf_lo(w.w) * inv, bf_hi(w.w) * inv);
                qr[64 * j] = o; } }
    }
}
__device__ __forceinline__ void quant_wgu(Frame& F) {
    quant_rows(F, (const bf16*)(F.ws + WS_WTMP), F.ws + WS_WGU, (float*)(F.ctl + CW_SB), 2 * FF);
#if MIX8 == 1
    quant_rows(F, (const bf16*)(F.ws + WS_WIN) + (size_t)6144 * DM, F.ws + WS_W8IN, (float*)(F.ctl + CW_SBIN), 2048);
#elif MIX8 == 4
    quant_rows(F, (const bf16*)(F.ws + WS_WIN) + (size_t)2048 * DM, F.ws + WS_W8IN, (float*)(F.ctl + CW_SBIN), 6144);
#elif MIX8 == 3
    quant_rows(F, (const bf16*)(F.ws + WS_WIN) + (size_t)4096 * DM, F.ws + WS_W8IN, (float*)(F.ctl + CW_SBIN), 4096);
#elif MIX8 == 2
    quant_rows(F, (const bf16*)(F.ws + WS_WIN), F.ws + WS_W8IN, (float*)(F.ctl + CW_SBIN), 2048);
    quant_rows(F, (const bf16*)(F.ws + WS_WIN) + (size_t)6144 * DM, F.ws + WS_W8IN + (size_t)2048 * DM, (float*)(F.ctl + CW_SBIN) + 2048, 2048);
#endif
}

__device__ __forceinline__ void ln_rows_q8(Frame& F, const bf16* T, unsigned char* H8, float* sa, float2* stats, const float* g, const float* b) {
    constexpr int NR = Q8_NR;
    const int gw = blockIdx.x * NWAVES + F.wave, NGW = F.G * NWAVES;
    LAS float* gl = (LAS float*)(F.lds + RING_OFF); LAS float* bl = gl + DM;
    for (int u = F.tid; u < DM / 4; u += NWAVES * 64) { *(LAS f32x4*)(gl + 4 * u) = *(const GAS f32x4*)(g + 4 * u); *(LAS f32x4*)(bl + 4 * u) = *(const GAS f32x4*)(b + 4 * u); }
    __syncthreads();
    for (int mb = gw; mb < M; mb += NR * NGW) {
        int mr[NR]; v4u r[NR][8];
#pragma unroll
        for (int i = 0; i < NR; ++i) { mr[i] = (mb + i * NGW < M) ? mb + i * NGW : mb;
            const GAS v4u* tr = (const GAS v4u*)(T + (size_t)mr[i] * DM) + F.lane;
#pragma unroll
            for (int j = 0; j < 8; ++j) r[i][j] = tr[64 * j]; }
        float mean[NR], rstd[NR];
#pragma unroll
        for (int i = 0; i < NR; ++i) { float s = 0.f;
#pragma unroll
            for (int j = 0; j < 8; ++j) s += ((bf_lo(r[i][j].x) + bf_hi(r[i][j].x)) + (bf_lo(r[i][j].y) + bf_hi(r[i][j].y))) + ((bf_lo(r[i][j].z) + bf_hi(r[i][j].z)) + (bf_lo(r[i][j].w) + bf_hi(r[i][j].w)));
            mean[i] = wave_sum(s) * (1.f / DM); }
#pragma unroll
        for (int i = 0; i < NR; ++i) { float q = 0.f; const float mu = mean[i];
#pragma unroll
            for (int j = 0; j < 8; ++j) { float d;
                d = bf_lo(r[i][j].x) - mu; q += d * d; d = bf_hi(r[i][j].x) - mu; q += d * d; d = bf_lo(r[i][j].y) - mu; q += d * d; d = bf_hi(r[i][j].y) - mu; q += d * d;
                d = bf_lo(r[i][j].z) - mu; q += d * d; d = bf_hi(r[i][j].z) - mu; q += d * d; d = bf_lo(r[i][j].w) - mu; q += d * d; d = bf_hi(r[i][j].w) - mu; q += d * d; }
            rstd[i] = 1.f / sqrtf(wave_sum(q) * (1.f / DM) + LN_EPS); }
        if (F.lane == 0) {
#pragma unroll
            for (int i = 0; i < NR; ++i) stats[mr[i]] = make_float2(mean[i], rstd[i]); }
#pragma unroll
        for (int i = 0; i < NR; ++i) { const float mu = mean[i], rs = rstd[i]; float am = 0.f;
#pragma unroll
            for (int j = 0; j < 8; ++j) { const int c = (64 * j + F.lane) * 8;
                const f32x4 g0 = *(const LAS f32x4*)(gl + c), g1 = *(const LAS f32x4*)(gl + c + 4), b0 = *(const LAS f32x4*)(bl + c), b1 = *(const LAS f32x4*)(bl + c + 4);
                const f32x4 ya = ((f32x4){bf_lo(r[i][j].x), bf_hi(r[i][j].x), bf_lo(r[i][j].y), bf_hi(r[i][j].y)} - mu) * rs * g0 + b0;
                const f32x4 yb = ((f32x4){bf_lo(r[i][j].z), bf_hi(r[i][j].z), bf_lo(r[i][j].w), bf_hi(r[i][j].w)} - mu) * rs * g1 + b1;
                am = fmaxf(am, fmaxf(fmaxf(fmaxf(fabsf(ya.x), fabsf(ya.y)), fmaxf(fabsf(ya.z), fabsf(ya.w))), fmaxf(fmaxf(fabsf(yb.x), fabsf(yb.y)), fmaxf(fabsf(yb.z), fabsf(yb.w))))); }
            am = wave_maxf(am); const float iv = am > 0.f ? 127.0f / am : 0.f; if (F.lane == 0) sa[mr[i]] = am * (1.0f / 127.0f);
            asm volatile("" ::: "memory");
#pragma unroll
            for (int j = 0; j < 8; ++j) { const int c = (64 * j + F.lane) * 8;
                const f32x4 g0 = *(const LAS f32x4*)(gl + c), g1 = *(const LAS f32x4*)(gl + c + 4), b0 = *(const LAS f32x4*)(bl + c), b1 = *(const LAS f32x4*)(bl + c + 4);
                const f32x4 ya = (((f32x4){bf_lo(r[i][j].x), bf_hi(r[i][j].x), bf_lo(r[i][j].y), bf_hi(r[i][j].y)} - mu) * rs * g0 + b0) * iv;
                const f32x4 yb = (((f32x4){bf_lo(r[i][j].z), bf_hi(r[i][j].z), bf_lo(r[i][j].w), bf_hi(r[i][j].w)} - mu) * rs * g1 + b1) * iv;
                v2u o; o.x = pk4_i8(ya.x, ya.y, ya.z, ya.w); o.y = pk4_i8(yb.x, yb.y, yb.z, yb.w);
                *(GAS v2u*)(H8 + (size_t)mr[i] * DM + c) = o; }
            asm volatile("" ::: "memory"); }
    }
    __syncthreads();
}

__device__ __forceinline__ void up8(const v4u& r, float (&f)[8]) { f[0] = bf_lo(r.x); f[1] = bf_hi(r.x); f[2] = bf_lo(r.y); f[3] = bf_hi(r.y); f[4] = bf_lo(r.z); f[5] = bf_hi(r.z); f[6] = bf_lo(r.w); f[7] = bf_hi(r.w); }
template <int W>
__device__ __forceinline__ void pool_run(const bf16* HP, bf16* PMo, int t0, int c) {
    const int tp0 = t0 & (SEQ - 1);
    v4u raw[16 + W - 1];
#pragma unroll
    for (int j = 0; j < 16 + W - 1; ++j) { const int dt = j - (W - 1); raw[j] = (v4u){0u, 0u, 0u, 0u}; if (tp0 + dt >= 0) raw[j] = *(const GAS v4u*)(HP + (size_t)(t0 + dt) * PW + c); }
    float S[8], u[8];
#pragma unroll
    for (int e = 0; e < 8; ++e) S[e] = 0.f;
#pragma unroll
    for (int j = 0; j < W - 1; ++j) { up8(raw[j], u);
#pragma unroll
        for (int e = 0; e < 8; ++e) S[e] += u[e]; }
#pragma unroll
    for (int i = 0; i < 16; ++i) {
        up8(raw[W - 1 + i], u);
#pragma unroll
        for (int e = 0; e < 8; ++e) S[e] += u[e];
        const int tp = tp0 + i; const float inv = (tp + 1 < W) ? 1.0f / (float)(tp + 1) : 1.0f / (float)W;
        v4u o; o.x = pk2(S[0] * inv - u[0], S[1] * inv - u[1]); o.y = pk2(S[2] * inv - u[2], S[3] * inv - u[3]);
        o.z = pk2(S[4] * inv - u[4], S[5] * inv - u[5]); o.w = pk2(S[6] * inv - u[6], S[7] * inv - u[7]);
        *(GAS v4u*)(PMo + (size_t)(t0 + i) * DM + c) = o;
        float d[8]; up8(raw[i], d);
#pragma unroll
        for (int e = 0; e < 8; ++e) S[e] -= d[e];
    }
}
__device__ __forceinline__ void pool_ew(Frame& F) {
    const bf16* HP = (const bf16*)(F.ws + WS_HP); bf16* PMo = (bf16*)(F.ws + WS_CAT);
    const size_t gt = (size_t)blockIdx.x * (NWAVES * 64) + F.tid, NT = (size_t)F.G * NWAVES * 64;
    for (size_t idx = gt; idx < (size_t)(M / 16) * 256; idx += NT) {
        const int t0 = (int)(idx >> 8) * 16, c = (int)(idx & 255) * 8, grp = __builtin_amdgcn_readfirstlane(c >> 9);
        if (grp == 0) pool_run<2>(HP, PMo, t0, c); else if (grp == 1) pool_run<4>(HP, PMo, t0, c); else if (grp == 2) pool_run<8>(HP, PMo, t0, c); else pool_run<16>(HP, PMo, t0, c);
    }
}
__device__ __forceinline__ void kv_reduce(Frame& F) {
    const float* SK = (const float*)(F.ws + WS_SLAB); bf16* KVX = (bf16*)(F.ws + WS_KVX);
    const size_t gt = (size_t)blockIdx.x * (NWAVES * 64) + F.tid, NT = (size_t)F.G * NWAVES * 64, NE = (size_t)512 * 8192;
    for (size_t i = gt; i < NE / 4; i += NT) { const float* sb = SK + i * 4;
        const f32x4 a = *(const GAS f32x4*)sb + *(const GAS f32x4*)(sb + NE) + *(const GAS f32x4*)(sb + 2 * NE) + *(const GAS f32x4*)(sb + 3 * NE);
        v2u o; o.x = pk2(a.x, a.y); o.y = pk2(a.z, a.w); *(GAS v2u*)(KVX + i * 4) = o; }
}

__device__ __forceinline__ void kmean_phase(Frame& F) {
    const bf16* Kb = (const bf16*)(F.ws + WS_K); bf16* KMH = (bf16*)(F.ws + WS_KMH); bf16* KML = (bf16*)(F.ws + WS_KML);
    LAS float* part = (LAS float*)(F.lds + RING_OFF);
    for (int item = blockIdx.x; item < 64 * 4; item += F.G) {
        const int bn = item >> 2, chunk = item & 3;
        float acc[8];
#pragma unroll
        for (int e = 0; e < 8; ++e) acc[e] = 0.f;
        const bf16* base = Kb + (size_t)(bn * 256 + F.wave * 32) * AW + chunk * 512 + F.lane * 8;
#pragma unroll
        for (int r = 0; r < 32; ++r) { const v4u q = *(const GAS v4u*)(base + (size_t)r * AW);
            acc[0] += bf_lo(q.x); acc[1] += bf_hi(q.x); acc[2] += bf_lo(q.y); acc[3] += bf_hi(q.y); acc[4] += bf_lo(q.z); acc[5] += bf_hi(q.z); acc[6] += bf_lo(q.w); acc[7] += bf_hi(q.w); }
#pragma unroll
        for (int e = 0; e < 8; ++e) part[F.wave * 512 + F.lane * 8 + e] = acc[e];
        __syncthreads();
        { float s = 0.f;
#pragma unroll
          for (int w = 0; w < 8; ++w) s += part[w * 512 + F.tid];
          const float mean = s * (1.0f / 256.0f); const unsigned hb = f2bf(mean); const float hf = __builtin_bit_cast(float, hb << 16);
          KMH[(size_t)bn * AW + chunk * 512 + F.tid] = (bf16)hb; KML[(size_t)bn * AW + chunk * 512 + F.tid] = (bf16)f2bf(mean - hf); }
        __syncthreads();
    }
}

__device__ __forceinline__ void gate_phase(Frame& F) {
    const bf16* Qb = (const bf16*)(F.ws + WS_Q); const bf16* KMH = (const bf16*)(F.ws + WS_KMH); const bf16* KML = (const bf16*)(F.ws + WS_KML);
    unsigned short* lists = (unsigned short*)(F.ws + WS_LIST); gu32* gcnt = F.ctl + CW_GCNT;
    LAS float* gl = (LAS float*)(F.lds + RING_OFF);
    LAS unsigned* lcnt = (LAS unsigned*)(F.lds + RING_OFF + 34816);
    LAS unsigned* gb = lcnt + 32;
    const int r32 = F.lane & 31, hi = F.lane >> 5;
    for (int uid = blockIdx.x; uid < 1024; uid += F.G) {
        const int bh = uid >> 5, qb = uid & 31, b = bh >> 4, h = bh & 15;
        if (qb == 0) continue;
        if (F.tid < 32) lcnt[F.tid] = 0u;
        const size_t trow = (size_t)b * SEQ + 256 * qb + 32 * F.wave + r32;
        f32x16 acc = {};
#pragma unroll
        for (int s = 0; s < 8; ++s) {
            const bf16x8 bq = *(const GAS bf16x8*)(Qb + trow * AW + h * HD + 16 * s + 8 * hi);
            const bf16x8 ah = *(const GAS bf16x8*)(KMH + (size_t)(b * 32 + r32) * AW + h * HD + 16 * s + 8 * hi);
            const bf16x8 al = *(const GAS bf16x8*)(KML + (size_t)(b * 32 + r32) * AW + h * HD + 16 * s + 8 * hi);
            acc = __builtin_amdgcn_mfma_f32_32x32x16_bf16(ah, bq, acc, 0, 0, 0);
            acc = __builtin_amdgcn_mfma_f32_32x32x16_bf16(al, bq, acc, 0, 0, 0);
        }
#pragma unroll
        for (int r = 0; r < 16; ++r) gl[(32 * F.wave + r32) * 33 + att::crow(r, hi)] = acc[r];
        __syncthreads();
        int s0 = 0, s1 = 0, s2 = 0; unsigned p0 = 0, p1 = 0, p2 = 0; const int nsel = qb < 3 ? qb : 3;
        if (F.tid < 256) {
            float v0 = -__builtin_inff(), v1 = v0, v2 = v0;
            for (int n = 0; n < qb; ++n) { const float g = gl[F.tid * 33 + n];
                if (g > v0) { v2 = v1; s2 = s1; v1 = v0; s1 = s0; v0 = g; s0 = n; }
                else if (g > v1) { v2 = v1; s2 = s1; v1 = g; s1 = n; }
                else if (g > v2) { v2 = g; s2 = n; } }
            p0 = __hip_atomic_fetch_add(lcnt + s0, 1u, __ATOMIC_RELAXED, __HIP_MEMORY_SCOPE_WORKGROUP);
            if (nsel > 1) p1 = __hip_atomic_fetch_add(lcnt + s1, 1u, __ATOMIC_RELAXED, __HIP_MEMORY_SCOPE_WORKGROUP);
            if (nsel > 2) p2 = __hip_atomic_fetch_add(lcnt + s2, 1u, __ATOMIC_RELAXED, __HIP_MEMORY_SCOPE_WORKGROUP);
        }
        __syncthreads();
        if (F.tid < 32) { const unsigned c = lcnt[F.tid]; gb[F.tid] = c ? __hip_atomic_fetch_add(gcnt + bh * 32 + F.tid, c, RLX_AGENT) : 0u; }
        __syncthreads();
        if (F.tid < 256) {
            unsigned short* lb = lists + (size_t)bh * LIST_STRIDE; const unsigned tl = (unsigned)(256 * qb + F.tid);
            lb[list_off(s0) + gb[s0] + p0] = (unsigned short)(tl | (0u << 13));
            if (nsel > 1) lb[list_off(s1) + gb[s1] + p1] = (unsigned short)(tl | (1u << 13));
            if (nsel > 2) lb[list_off(s2) + gb[s2] + p2] = (unsigned short)(tl | (2u << 13));
        }
        __syncthreads();
    }
}

__device__ __forceinline__ void attn_phase(Frame& F, char* ldsg) {
    const bf16* Qb = (const bf16*)(F.ws + WS_Q); const bf16* Kb = (const bf16*)(F.ws + WS_K); const bf16* Vb = (const bf16*)(F.ws + WS_V);
    bf16* PO = (bf16*)(F.ws + WS_PARTO); float2* ML = (float2*)(F.ws + WS_ML);
    const unsigned short* lists = (const unsigned short*)(F.ws + WS_LIST); const gu32* gcnt = F.ctl + CW_GCNT;
    LAS int* pre = (LAS int*)(F.lds + RING_OFF + 67584);
    for (int i = F.tid; i < 1024; i += NWAVES * 64) pre[i] = (int)((__hip_atomic_load(gcnt + i, RLX_AGENT) + 255u) >> 8);
    __syncthreads();
    if (F.wave == 0) {
        int loc[16]; int s = 0;
#pragma unroll
        for (int k = 0; k < 16; ++k) { loc[k] = pre[F.lane * 16 + k]; s += loc[k]; }
        int incl = s;
#pragma unroll
        for (int o = 1; o < 64; o <<= 1) { const int v = __shfl_up(incl, o); if (F.lane >= o) incl += v; }
        int run = incl - s;
#pragma unroll
        for (int k = 0; k < 16; ++k) { pre[F.lane * 16 + k] = run; run += loc[k]; }
        if (F.lane == 63) pre[1024] = incl;
    }
    __syncthreads();
    const int total = 1024 + pre[1024];
    LAS int* DSC = (LAS int*)(F.lds + RING_OFF + 67584 + 4224);
    const int nloc = (total > (int)blockIdx.x) ? (total - (int)blockIdx.x + F.G - 1) / F.G : 0;
    if (F.tid < nloc && F.tid < 64) {
        const int id = blockIdx.x + F.tid * F.G; int bhj, own, lpos, cnt;
        if (id < 1024) { bhj = id; own = 1; lpos = 0; cnt = 256; }
        else { const int x = id - 1024; int lo = 0, hi2 = 1023;
            while (lo < hi2) { const int mid = (lo + hi2 + 1) >> 1; if (pre[mid] <= x) lo = mid; else hi2 = mid - 1; }
            const int li = lo, chunk = x - pre[li]; bhj = li; own = 0; lpos = (li >> 5) * LIST_STRIDE + list_off(li & 31) + 256 * chunk;
            const int c = (int)__hip_atomic_load(gcnt + li, RLX_AGENT) - 256 * chunk; cnt = c < 256 ? c : 256; }
        DSC[4 * F.tid] = bhj; DSC[4 * F.tid + 1] = own; DSC[4 * F.tid + 2] = lpos; DSC[4 * F.tid + 3] = cnt;
    }
    __syncthreads();
    att::ItemCtx C{Qb, Kb, Vb, PO, ML, lists};
    att::attn_items(C, (const LAS int*)DSC, nloc < 64 ? nloc : 64, ldsg);
}


#if defined(MOBA_CHECK) && MOBA_CHECK
__device__ __forceinline__ float wave_max(float v) {
#pragma unroll
    for (int o = 1; o < 64; o <<= 1) v = fmaxf(v, __shfl_xor(v, o));
    return v;
}
__device__ __forceinline__ void moba_check(Frame& F) {
    const bf16* Qb = (const bf16*)(F.ws + WS_Q); const bf16* Kb = (const bf16*)(F.ws + WS_K); const bf16* Vb = (const bf16*)(F.ws + WS_V);
    const bf16* KMH = (const bf16*)(F.ws + WS_KMH); const bf16* KML = (const bf16*)(F.ws + WS_KML); const bf16* CAT = (const bf16*)(F.ws + WS_CAT);
    LAS float* pl = (LAS float*)(F.lds + RING_OFF + F.wave * 8192);
    LAS float* ql = pl + 1024;
    const int gw = blockIdx.x * NWAVES + F.wave, NGW = F.G * NWAVES;
    for (int s = gw; s < 4096; s += NGW) {
        const unsigned hsh = (unsigned)s * 2654435761u; const int bh = (hsh >> 8) & 31; int t = (hsh >> 13) & 8191; if ((s & 7) == 0) t &= 1023;
        const int b = bh >> 4, h = bh & 15, qb = t >> 8, tl = t & 255;
        const bf16* qrow = Qb + ((size_t)b * SEQ + t) * AW + h * HD;
        ql[F.lane] = bf2f(qrow[F.lane]); ql[64 + F.lane] = bf2f(qrow[64 + F.lane]); LDS_WAIT();
        float g = -__builtin_inff();
        if (F.lane < qb) { const bf16* kh = KMH + (size_t)(b * 32 + F.lane) * AW + h * HD; const bf16* kl = KML + (size_t)(b * 32 + F.lane) * AW + h * HD; float a = 0.f;
            for (int d = 0; d < 128; ++d) a += ql[d] * (bf2f(kh[d]) + bf2f(kl[d])); g = a; }
        int sel[3]; const int nsel = qb < 3 ? qb : 3;
#pragma unroll
        for (int k = 0; k < 3; ++k) { const float mx = wave_max(g); const unsigned long long bal = __ballot(g == mx && F.lane < qb); const int idx = bal ? (int)__builtin_ctzll(bal) : 0; sel[k] = idx; if (F.lane == idx) g = -__builtin_inff(); }
        float sc[4][4]; float mx = -1e30f;
#pragma unroll
        for (int u = 0; u < 4; ++u) { const bool on = (u == 3) || (u < nsel); const int j = (u == 3) ? qb : sel[u];
#pragma unroll
            for (int r = 0; r < 4; ++r) { const int key = F.lane + 64 * r; float a = -1e30f;
                if (on && !(u == 3 && key > tl)) { const bf16* kr = Kb + ((size_t)b * SEQ + 256 * j + key) * AW + h * HD; a = 0.f; for (int d = 0; d < 128; ++d) a += ql[d] * bf2f(kr[d]); a *= 0.088388347648318440f; }
                sc[u][r] = a; mx = fmaxf(mx, a); } }
        mx = wave_max(mx); float sum = 0.f;
#pragma unroll
        for (int u = 0; u < 4; ++u)
#pragma unroll
            for (int r = 0; r < 4; ++r) { const float p = (sc[u][r] > -1e29f) ? __expf(sc[u][r] - mx) : 0.f; sum += p; pl[u * 256 + F.lane + 64 * r] = p; }
        sum = wave_sum(sum); LDS_WAIT();
        float o0 = 0.f, o1 = 0.f;
#pragma unroll
        for (int u = 0; u < 4; ++u) { const bool on = (u == 3) || (u < nsel); const int j = (u == 3) ? qb : sel[u];
            if (on) for (int key = 0; key < 256; ++key) { const float p = pl[u * 256 + key]; const bf16* vr = Vb + ((size_t)b * SEQ + 256 * j + key) * AW + h * HD; o0 += p * bf2f(vr[F.lane]); o1 += p * bf2f(vr[64 + F.lane]); } }
        o0 /= sum; o1 /= sum;
        const bf16* cr = CAT + ((size_t)b * SEQ + t) * DM + PW + h * HD; const float c0 = bf2f(cr[F.lane]), c1 = bf2f(cr[64 + F.lane]);
        const bool bad = !(fabsf(c0 - o0) <= 1.5e-3f + 0.03f * fabsf(o0)) || !(fabsf(c1 - o1) <= 1.5e-3f + 0.03f * fabsf(o1));
        const unsigned long long bb = __ballot(bad);
        if (F.lane == 0 && bb) __hip_atomic_fetch_add(F.ctl + CW_CHK, 1u, RLX_AGENT);
        if (F.lane == 0) __hip_atomic_fetch_add(F.ctl + CW_CHK + 1, 1u, RLX_AGENT);
        LDS_WAIT();
    }
}
#endif


#if defined(XATTN_CHECK) && XATTN_CHECK
__device__ __noinline__ void xattn_check_a(unsigned char* ws, gu32* ctl, const float* mem, const float* w_xq, const float* w_xkv, const float* w_xo, const float* g1, int G) {
    const int lane = threadIdx.x & 63, wave = threadIdx.x >> 6;
    const bf16* KVX = (const bf16*)(ws + WS_KVX); const bf16* WQK = (const bf16*)(ws + WS_WQK); const bf16* WVOT = (const bf16*)(ws + WS_WVOT);
    const int gw = blockIdx.x * NWAVES + wave, NGW = G * NWAVES;
    for (int s = gw; s < 3 * 2048; s += NGW) {
        const unsigned hsh = (unsigned)s * 2654435761u; const int kind = s / 2048; float ref = 0.f, got = 0.f;
        if (kind == 0) { const int r = (hsh >> 7) & 511, c = (hsh >> 16) & 8191;
            float a = 0.f; for (int k = lane; k < DM; k += 64) a += mem[(size_t)r * DM + k] * w_xkv[(size_t)k * (2 * DM) + c];
            ref = wave_sum(a); got = bf2f(KVX[(size_t)r * 8192 + c]); }
        else if (kind == 1) { const int n = (hsh >> 7) & 2047, k = (hsh >> 18) & 4095, bb = n >> 10, h = (n >> 8) & 3, m = n & 255;
            float a = 0.f; for (int j = lane; j < 1024; j += 64) a += bf2f(KVX[(size_t)(bb * 256 + m) * 8192 + h * 1024 + j]) * w_xq[(size_t)k * DM + h * 1024 + j];
            ref = wave_sum(a) * g1[k]; got = bf2f(WQK[(size_t)n * DM + k]); }
        else { const int j = (hsh >> 7) & 4095, n = (hsh >> 19) & 2047, bb = n >> 10, h = (n >> 8) & 3, m = n & 255;
            float a = 0.f; for (int d = lane; d < 1024; d += 64) a += w_xo[(size_t)(h * 1024 + d) * DM + j] * bf2f(KVX[(size_t)(bb * 256 + m) * 8192 + 4096 + h * 1024 + d]);
            ref = wave_sum(a); got = bf2f(WVOT[(size_t)j * 2048 + n]); }
        const unsigned long long bb2 = __ballot(!(fabsf(got - ref) <= 0.02f + 0.02f * fabsf(ref)));
        if (lane == 0) { if (bb2) { __hip_atomic_fetch_add(ctl + CW_CHK + 2, 1u, RLX_AGENT); __hip_atomic_fetch_add(ctl + CW_CHK + 4 + kind, 1u, RLX_AGENT); } __hip_atomic_fetch_add(ctl + CW_CHK + 3, 1u, RLX_AGENT); }
    }
}
__device__ __noinline__ void xattn_check_b(unsigned char* ws, gu32* ctl, LAS float* ldsf, const float* w_xq, const float* g1, const float* b1, int G) {
    const int lane = threadIdx.x & 63, wave = threadIdx.x >> 6;
    const bf16* TB = (const bf16*)(ws + WS_TB); const bf16* KVX = (const bf16*)(ws + WS_KVX); const bf16* PB = (const bf16*)(ws + WS_PB);
    LAS float* hl = ldsf + wave * 4096; LAS float* ql = hl;
    const int gw = blockIdx.x * NWAVES + wave, NGW = G * NWAVES;
    for (int s = gw; s < 1024; s += NGW) {
        const unsigned hsh = (unsigned)s * 2654435761u; const int t = (hsh >> 9) & (M - 1), h = (hsh >> 5) & 3, bb = t >> 13;
        float sm = 0.f; for (int k = lane; k < DM; k += 64) sm += bf2f(TB[(size_t)t * DM + k]);
        const float mean = wave_sum(sm) * (1.f / DM); float sq = 0.f;
        for (int k = lane; k < DM; k += 64) { const float d = bf2f(TB[(size_t)t * DM + k]) - mean; sq += d * d; }
        const float rstd = 1.f / sqrtf(wave_sum(sq) * (1.f / DM) + LN_EPS);
        for (int k = lane; k < DM; k += 64) hl[k] = (bf2f(TB[(size_t)t * DM + k]) - mean) * rstd * g1[k] + b1[k];
        LDS_WAIT();
        float q[16];
#pragma unroll
        for (int j = 0; j < 16; ++j) q[j] = 0.f;
        for (int k = 0; k < DM; ++k) { const float hv = hl[k]; const float* wr = w_xq + (size_t)k * DM + h * 1024 + lane;
#pragma unroll
            for (int j = 0; j < 16; ++j) q[j] += hv * wr[64 * j]; }
        LDS_WAIT();
#pragma unroll
        for (int j = 0; j < 16; ++j) ql[lane + 64 * j] = q[j];
        LDS_WAIT();
        float sc[4]; float mx = -1e30f;
#pragma unroll
        for (int r = 0; r < 4; ++r) { const int m = lane + 64 * r; const bf16* kr = KVX + (size_t)(bb * 256 + m) * 8192 + h * 1024; float a = 0.f;
            for (int n = 0; n < 1024; ++n) a += ql[n] * bf2f(kr[n]);
            sc[r] = a * 0.03125f; mx = fmaxf(mx, sc[r]); }
#pragma unroll
        for (int o = 1; o < 64; o <<= 1) mx = fmaxf(mx, __shfl_xor(mx, o));
        float sum = 0.f;
#pragma unroll
        for (int r = 0; r < 4; ++r) { sc[r] = __expf(sc[r] - mx); sum += sc[r]; }
        sum = wave_sum(sum); bool bad = false;
#pragma unroll
        for (int r = 0; r < 4; ++r) { const float ref = sc[r] / sum, got = bf2f(PB[(size_t)t * 1024 + h * 256 + lane + 64 * r]); bad = bad || !(fabsf(got - ref) <= 2e-4f + 0.04f * ref); }
        const unsigned long long bb2 = __ballot(bad);
        if (lane == 0) { if (bb2) { __hip_atomic_fetch_add(ctl + CW_CHK + 2, 1u, RLX_AGENT); __hip_atomic_fetch_add(ctl + CW_CHK + 7, 1u, RLX_AGENT); } __hip_atomic_fetch_add(ctl + CW_CHK + 3, 1u, RLX_AGENT); }
        LDS_WAIT();
    }
}
#endif

__device__ __forceinline__ void combine_one(const float2 (&ml)[4], const v4u (&r)[4], int nsel, bf16* dst) {
    constexpr float C = att::SCALE * 1.4426950408889634f;
    float mx = ml[3].x;
#pragma unroll
    for (int k = 0; k < 3; ++k) if (k < nsel) mx = fmaxf(mx, ml[k].x);
    float acc[8]; float wsum = 0.f;
#pragma unroll
    for (int e = 0; e < 8; ++e) acc[e] = 0.f;
#pragma unroll
    for (int k = 0; k < 4; ++k) { const float w = (k == 3 || k < nsel) ? ml[k].y * __builtin_amdgcn_exp2f((ml[k].x - mx) * C) : 0.f; wsum += w;
        acc[0] += w * bf_lo(r[k].x); acc[1] += w * bf_hi(r[k].x); acc[2] += w * bf_lo(r[k].y); acc[3] += w * bf_hi(r[k].y);
        acc[4] += w * bf_lo(r[k].z); acc[5] += w * bf_hi(r[k].z); acc[6] += w * bf_lo(r[k].w); acc[7] += w * bf_hi(r[k].w); }
    const float inv = 1.0f / wsum;
    v4u o; o.x = pk2(acc[0] * inv, acc[1] * inv); o.y = pk2(acc[2] * inv, acc[3] * inv); o.z = pk2(acc[4] * inv, acc[5] * inv); o.w = pk2(acc[6] * inv, acc[7] * inv);
    *(GAS v4u*)dst = o;
}
__device__ __forceinline__ void combine_phase(Frame& F) {
    const bf16* PO = (const bf16*)(F.ws + WS_PARTO); const float2* ML = (const float2*)(F.ws + WS_ML); bf16* CAT = (bf16*)(F.ws + WS_CAT);
    const size_t gt = (size_t)blockIdx.x * (NWAVES * 64) + F.tid, NT = (size_t)F.G * NWAVES * 64, NE = (size_t)32 * SEQ * 16, HALFE = NE / 2;
    for (size_t idx = gt; idx < HALFE; idx += NT) {
        float2 ml[2][4]; v4u r[2][4]; int nsel[2]; bf16* dst[2];
#pragma unroll
        for (int u = 0; u < 2; ++u) { const size_t id = idx + u * HALFE;
            const int dc = (int)(id & 15), t = (int)((id >> 4) & (SEQ - 1)), bh = (int)(id >> 17), qb = t >> 8; nsel[u] = qb < 3 ? qb : 3;
            dst[u] = CAT + ((size_t)(bh >> 4) * SEQ + t) * DM + PW + (bh & 15) * HD + dc * 8;
#pragma unroll
            for (int k = 0; k < 4; ++k) { const int ks = (k == 3 || k < nsel[u]) ? k : 3;
                ml[u][k] = ML[((size_t)ks * 32 + bh) * SEQ + t]; r[u][k] = *(const GAS v4u*)(PO + (((size_t)ks * 32 + bh) * SEQ + t) * HD + dc * 8); } }
        combine_one(ml[0], r[0], nsel[0], dst[0]); combine_one(ml[1], r[1], nsel[1], dst[1]);
    }
}

struct Args { const float* in[18]; float* out; unsigned char* ws; int ph_lo, ph_hi, li, pad; };
__global__ void __launch_bounds__(NWAVES * 64, 2) mega_fwd(Args args) {
    extern __shared__ __attribute__((aligned(16))) unsigned char lds[];
    Frame F;
    F.lds = (LAS unsigned char*)lds;
    F.MISC = (volatile LAS unsigned*)(F.lds + MISC_OFF);
    F.tid = threadIdx.x; F.lane = F.tid & 63; F.wave = __builtin_amdgcn_readfirstlane(F.tid >> 6);
    F.G = gridDim.x; F.ws = args.ws;
    F.ctl = (gu32*)(args.ws + WS_CTL);
    for (int u = F.tid; u < (LDS_BYTES - LDSCTL_OFF) / 4; u += NWAVES * 64) ((LAS unsigned*)(F.lds + LDSCTL_OFF))[u] = 0u;
    __syncthreads();
    XcdBarrier bar; bar.bar = (unsigned*)(F.ctl + CW_BAR); bar.x = 0; bar.st = nullptr;
    if (N_LAUNCHES == 1) bar = xcd_barrier_post((unsigned*)(F.ctl + CW_BAR), F.MISC + 8);
#define GRID_BAR() do { if (N_LAUNCHES == 1) xcd_barrier(bar); } while (0)
    const int lo = args.ph_lo, hi = args.ph_hi;
#define IN(k) (lo <= (k) && (k) < hi)
#define BOTH(k) (IN(k) && IN((k) + 1))
#if defined(PROBE_SKEW)
#ifndef PROBE_PREV
#define PROBE_PREV (PROBE_SKEW - 1)
#endif
#define SKEW_MARK(k) do { if ((k) == PROBE_SKEW && F.tid == 0) { const unsigned tt = (unsigned)wall_clock64(); __hip_atomic_fetch_max(F.ctl + CW_CHK + 8, ~tt, RLX_AGENT); __hip_atomic_fetch_max(F.ctl + CW_CHK + 9, tt, RLX_AGENT); __hip_atomic_fetch_max(F.ctl + CW_CHK + 16 + (bar.x & 7), tt, RLX_AGENT); } if ((k) == PROBE_PREV && F.tid == 0) { const unsigned tt = (unsigned)wall_clock64(); __hip_atomic_fetch_max(F.ctl + CW_CHK + 10, ~tt, RLX_AGENT); __hip_atomic_fetch_max(F.ctl + CW_CHK + 11, tt, RLX_AGENT); } } while (0)
#else
#define SKEW_MARK(k) do { } while (0)
#endif
#ifndef PROBE_DUP
#define PROBE_DUP 0
#endif
#define DUPON(k) ((PROBE_DUP >> (k)) & 1)
#define REP(k) for (int _rep = 0; _rep < (DUPON(k) ? 2 : 1); ++_rep)
    unsigned char* ws = args.ws;
    const int G = F.G, cid = (int)blockIdx.x;
    float* out = args.out;

    if (IN(0)) { REP(0) { p0_prologue(F, args.in); }
#if defined(WDOWN_IN_P0)
      convert_wdown_static(F, args.in[15], cid, G);
#endif
#if !defined(GU_BF16)
      GRID_BAR(); quant_wgu(F);
#endif
      SKEW_MARK(0); if (BOTH(0)) GRID_BAR(); }

    if (IN(1)) {
#if MIX8 == 0
        { pg8::Gemm g = pg8::make_gemm(ws + WS_XB, DM, ws + WS_WIN, DM, DM); pg8::StaticOrder S; S.init(M, MIXIN, G, cid);
          pg8::EpiMixIn E{(pg8::bf16_t*)(ws + WS_HP), (size_t)M * 2048, (const float*)(ws + WS_ROPE), 0};
          pg8::gemm_phase<pg8::EpiMixIn, pg8::StaticOrder, true, true>(F.lds + RING_OFF, g, S, E); }
#else
        { constexpr int N8 = (MIX8 == 1) ? 2048 : (MIX8 == 4) ? 6144 : 4096;
          pg8::Gemm g = pg8::make_gemm(ws + WS_X8, DM / 2, ws + WS_W8IN, DM / 2, DM / 2); pg8::StaticOrder S; S.init(M, N8, G, cid);
          pg8::EpiMix8 E{(pg8::bf16_t*)(ws + WS_HP), (size_t)M * 2048, (const float*)(F.ctl + CW_SX), (const float*)(F.ctl + CW_SBIN), (MIX8 == 2) ? 0 : (MIX8 == 3) ? 2 : (MIX8 == 4) ? 1 : 3, (MIX8 == 4) ? 2 : 3, (const float*)(ws + WS_ROPE)};
          pg8::gemm_phase<pg8::EpiMix8, pg8::StaticOrder, true, true, pg8::Gemm, true>(F.lds + RING_OFF, g, S, E); }
        { constexpr int NB = (MIX8 == 1) ? 6144 : (MIX8 == 4) ? 2048 : 4096, R0 = (MIX8 == 2) ? 2048 : 0;
          pg8::Gemm g = pg8::make_gemm(ws + WS_XB, DM, ws + WS_WIN + (size_t)R0 * DM * 2, DM, DM); pg8::StaticOrder S; S.init(M, NB, G, cid);
          pg8::EpiMixIn E{(pg8::bf16_t*)(ws + WS_HP), (size_t)M * 2048, (const float*)(ws + WS_ROPE), R0 / 256};
          pg8::gemm_phase<pg8::EpiMixIn, pg8::StaticOrder, true, true>(F.lds + RING_OFF, g, S, E); }
#endif
        {
          pg8::GemmKV g{(const char*)(ws + WS_MEMB), (const char*)(ws + WS_WXKV), DM, DM, 1024}; pg8::EpiSlabKV E{(float*)(ws + WS_SLAB)};
          gu32* kvq = F.ctl + CW_DYN + 4096 + 2048;
#pragma nounroll
          for (;;) {
              if (F.tid == 0) { const unsigned t = __hip_atomic_fetch_add(kvq, 1u, RLX_AGENT); F.MISC[20] = t < 256u ? t : 0xffffffffu; }
              __syncthreads(); const unsigned L = F.MISC[20]; __syncthreads();
              if (L == 0xffffffffu) break;
              pg8::OrderOne S; S.u.pz = (int)(L & 3u); S.u.pm = (int)(L >> 7); S.u.pn = (int)((L >> 2) & 31u);
              pg8::gemm_phase<pg8::EpiSlabKV, pg8::OrderOne, true, true, pg8::GemmKV>(F.lds + RING_OFF, g, S, E);
          } }
        gu_filler(F, args.in, 1); SKEW_MARK(1); if (BOTH(1)) GRID_BAR();
    }

    if (IN(2)) { REP(2) { pool_ew(F); kmean_phase(F); kv_reduce(F); } SKEW_MARK(2); if (BOTH(2)) GRID_BAR(); }

#if defined(PROBE_XBAR)
    for (int xb = 0; xb < PROBE_XBAR; ++xb) GRID_BAR();
#endif
    if (IN(3)) {
        { pg8::Gemm g = pg8::make_gemm(ws + WS_WOUT, 2048, ws + WS_WPOOL, 512, 512); g.a_pn = 512 * 2; g.a_pn_sh = 1; pg8::StaticOrder S; S.init(DM, PW, G, cid);
          pg8::EpiStore E{(pg8::bf16_t*)(ws + WS_WOUT2), DM, 0};
          pg8::gemm_phase<pg8::EpiStore, pg8::StaticOrder, true, true>(F.lds + RING_OFF, g, S, E); if (DUPON(3)) { pg8::gemm_phase<pg8::EpiStore, pg8::StaticOrder, true, true>(F.lds + RING_OFF, g, S, E); } }
        if (G == 256) { pg8::GemmAbs g{(const char*)(ws + WS_KVX), (const char*)(ws + WS_WXQ), (const char*)(ws + WS_WXO), cid < 128 ? 8192 : 4096, cid < 128 ? 4096 : 8192, 1024};
          pg8::OrderAbs S{cid}; pg8::EpiStoreAbs E{(pg8::bf16_t*)(ws + WS_WQK), (pg8::bf16_t*)(ws + WS_WVOT), (float*)(F.ctl + CW_K1), (float*)(F.ctl + CW_K2)};
          pg8::gemm_phase<pg8::EpiStoreAbs, pg8::OrderAbs, true, true, pg8::GemmAbs>(F.lds + RING_OFF, g, S, E); if (DUPON(17)) { pg8::gemm_phase<pg8::EpiStoreAbs, pg8::OrderAbs, true, true, pg8::GemmAbs>(F.lds + RING_OFF, g, S, E); } }
        gate_phase(F);
        gu_filler(F, args.in, 3); SKEW_MARK(3); if (BOTH(3)) GRID_BAR();
#if defined(XATTN_CHECK) && XATTN_CHECK
        xattn_check_a(ws, F.ctl, args.in[1], args.in[8], args.in[9], args.in[10], args.in[6], G); __syncthreads();
#endif
    }

    if (IN(4)) { attn_phase(F, (char*)lds + RING_OFF); if (DUPON(4)) { __syncthreads(); attn_phase(F, (char*)lds + RING_OFF); } gu_filler(F, args.in, 4); SKEW_MARK(4); if (BOTH(4)) GRID_BAR(); }

    if (IN(5)) { REP(5) { combine_phase(F); } SKEW_MARK(5); if (BOTH(5)) GRID_BAR(); }
#if defined(MOBA_CHECK) && MOBA_CHECK
    if (IN(5)) { moba_check(F); __syncthreads(); }
#endif

    if (IN(6)) {
        pg8::Gemm g = pg8::make_gemm(ws + WS_CAT, DM, ws + WS_WOUT2, DM, DM); pg8::StaticOrder S; S.init(M, DM, G, cid);
        pg8::EpiResid E{args.in[0], (pg8::bf16_t*)(ws + WS_TB), DM, DN_ALPHA, (pg8::f32x2*)(ws + WS_SLOT)};
        pg8::gemm_phase<pg8::EpiResid, pg8::StaticOrder, true, true>(F.lds + RING_OFF, g, S, E); if (DUPON(6)) { pg8::gemm_phase<pg8::EpiResid, pg8::StaticOrder, true, true>(F.lds + RING_OFF, g, S, E); }
        gu_filler(F, args.in, 6); SKEW_MARK(6); if (BOTH(6)) GRID_BAR();
    }
    if (IN(7)) { ln_finalize(F, (const float2*)(ws + WS_SLOT), (float2*)(ws + WS_STATS)); SKEW_MARK(7); if (BOTH(7)) GRID_BAR(); }

    if (IN(9)) {
        if (G == 256) {
            pg8::Gemm g = pg8::make_gemm(ws + WS_TB, DM, ws + WS_WQK, DM, DM); g.b_pm = (size_t)1024 * DM * 2; g.b_pm_sh = 5;
            pg8::StaticOrder S; S.init(M, XH * 256, G, cid);
            pg8::EpiSoftmax E{(pg8::bf16_t*)(ws + WS_PB), XH * MEMLEN, 0.03125f * 1.4426950408889634f, (const pg8::f32x2*)(ws + WS_STATS), (const float*)(F.ctl + CW_K1), (const float*)(F.ctl + CW_K2)};
            pg8::gemm_phase<pg8::EpiSoftmax, pg8::StaticOrder, false, true>(F.lds + RING_OFF, g, S, E); if (DUPON(9)) { pg8::gemm_phase<pg8::EpiSoftmax, pg8::StaticOrder, false, true>(F.lds + RING_OFF, g, S, E); }
        }
        gu_filler(F, args.in, 9); SKEW_MARK(9); if (BOTH(9)) GRID_BAR();
#if defined(XATTN_CHECK) && XATTN_CHECK
        xattn_check_b(ws, F.ctl, (LAS float*)(F.lds + RING_OFF), args.in[8], args.in[6], args.in[7], G); __syncthreads(); GRID_BAR();
#endif
    }
    if (IN(11)) {
        pg8::Gemm g = pg8::make_gemm(ws + WS_PB, XH * MEMLEN, ws + WS_WVOT, 2048, XH * MEMLEN); g.b_pm = (size_t)1024 * 2; g.b_pm_sh = 5;
        pg8::StaticOrder S; S.init(M, DM, G, cid);
#if defined(GU_BF16)
        pg8::EpiResidLN E{(pg8::bf16_t*)(ws + WS_TB), (const pg8::f32x2*)(ws + WS_STATS), 6, (pg8::f32x2*)(ws + WS_SLOT)};
#else
        pg8::EpiResidLN E{(pg8::bf16_t*)(ws + WS_TB), (const pg8::f32x2*)(ws + WS_STATS), 6, nullptr};
#endif
        pg8::gemm_phase<pg8::EpiResidLN, pg8::StaticOrder, true, true>(F.lds + RING_OFF, g, S, E);
        gu_filler(F, args.in, 11); SKEW_MARK(11); if (BOTH(11)) GRID_BAR();
    }
#if defined(GU_BF16)
    if (IN(12)) { ln_finalize(F, (const float2*)(ws + WS_SLOT), (float2*)(ws + WS_STATS)); gu_drain(F, args.in); SKEW_MARK(12); if (BOTH(12)) GRID_BAR(); }
#else
    if (IN(12)) { ln_rows_q8(F, (const bf16*)(ws + WS_TB), ws + WS_H8, (float*)(F.ctl + CW_SA), (float2*)(ws + WS_STATS), args.in[11], args.in[12]); SKEW_MARK(12); if (BOTH(12)) GRID_BAR(); }
#endif

#if defined(PROBE_SLEEP_US)
    { const unsigned long long w0 = wall_clock64(); while (wall_clock64() - w0 < (unsigned long long)PROBE_SLEEP_US * 100ull) __builtin_amdgcn_s_sleep(64); SKEW_MARK(20); GRID_BAR(); }
#endif
    if (IN(13)) {
#if defined(GU_BF16)
        pg8::Gemm g = pg8::make_gemm(ws + WS_TB, DM, ws + WS_WGU, DM, DM);
        pg8::EpiSwiGLU E{(pg8::bf16_t*)(ws + WS_G), FF, (const pg8::f32x2*)(ws + WS_STATS), (const float*)(F.ctl + CW_C1G), (const float*)(F.ctl + CW_C2G)};
        typedef pg8::EpiSwiGLU EpiGU; constexpr bool GU_I8 = false;
#else
        pg8::Gemm g = pg8::make_gemm(ws + WS_H8, DM / 2, ws + WS_WGU, DM / 2, DM / 2);
        pg8::EpiSwiGLU8 E{(pg8::bf16_t*)(ws + WS_G), FF, (const float*)(F.ctl + CW_SA), (const float*)(F.ctl + CW_SB)};
        typedef pg8::EpiSwiGLU8 EpiGU; constexpr bool GU_I8 = true;
#endif
#if defined(STATIC_ORDER)
        pg8::StaticOrder S; S.init(M, 2 * FF, G, cid);
        pg8::gemm_phase<EpiGU, pg8::StaticOrder, true, true, pg8::Gemm, GU_I8>(F.lds + RING_OFF, g, S, E);
#else
        #ifndef GU_WGM
#define GU_WGM 8
#endif
#ifndef GU_ROT
#define GU_ROT 0
#endif
        pg8::DynOrder S; S.init(M, 2 * FF, (unsigned*)(F.ctl + CW_DYN + 512 * 3), (volatile LAS int*)(F.MISC + 16), (int)xb_xcc_id(), GU_ROT, GU_WGM); S.start(F.wave, F.lane);
        pg8::gemm_phase<EpiGU, pg8::DynOrder, true, true, pg8::Gemm, GU_I8>(F.lds + RING_OFF, g, S, E);
#endif
#if !defined(WDOWN_IN_P0)
        convert_wdown(F, args.in[15], F.ctl + CW_DYN + 4096);
#endif
        SKEW_MARK(13); if (BOTH(13)) GRID_BAR();
    }
    if (IN(14)) {
#ifndef DOWN_WGM
#define DOWN_WGM 4
#endif
        pg8::Gemm g = pg8::make_gemm(ws + WS_G, FF, ws + WS_WDN, FF, FF); pg8::StaticOrder S; S.init(M, DM, G, cid, DOWN_WGM);
        pg8::EpiResidLN E{(pg8::bf16_t*)(ws + WS_TB), (const pg8::f32x2*)(ws + WS_STATS), 11, nullptr};
        if (DUPON(14)) { pg8::EpiStore E2{(pg8::bf16_t*)(ws + WS_HB), DM, 0}; pg8::gemm_phase<pg8::EpiStore, pg8::StaticOrder, true, true>(F.lds + RING_OFF, g, S, E2); }
        pg8::gemm_phase<pg8::EpiResidLN, pg8::StaticOrder, true, true>(F.lds + RING_OFF, g, S, E);
        SKEW_MARK(14); if (BOTH(14)) GRID_BAR();
    }
#if defined(MOBA_CHECK) && MOBA_CHECK
#define CHK_TAIL 1
#endif
    if (IN(15)) { ln_rows<true>(F, (const bf16*)(ws + WS_TB), nullptr, nullptr, out, args.in[16], args.in[17]); if (DUPON(15)) { ln_rows<true>(F, (const bf16*)(ws + WS_TB), nullptr, nullptr, out, args.in[16], args.in[17]); } }
#if defined(PROBE_SKEW)
    GRID_BAR();
    if (blockIdx.x == 0 && F.tid == 0) { const unsigned t0 = ~__hip_atomic_load(F.ctl + CW_CHK + 8, RLX_AGENT), t1 = __hip_atomic_load(F.ctl + CW_CHK + 9, RLX_AGENT), ts = ~__hip_atomic_load(F.ctl + CW_CHK + 10, RLX_AGENT), tp = __hip_atomic_load(F.ctl + CW_CHK + 11, RLX_AGENT);
        unsigned xmin = 0xffffffffu, xmax = 0u; for (int x = 0; x < 8; ++x) { const unsigned v = __hip_atomic_load(F.ctl + CW_CHK + 16 + x, RLX_AGENT); if (v) { xmin = v < xmin ? v : xmin; xmax = v > xmax ? v : xmax; } }
        const unsigned long long ticks = (unsigned long long)((PROBE_SKEW_WHAT == 0) ? (t1 - t0) : (PROBE_SKEW_WHAT == 1) ? (t1 - ts) : (PROBE_SKEW_WHAT == 3) ? (t1 - tp) : (xmax - xmin)) * PROBE_AMP;
        const unsigned long long w0 = wall_clock64(); while (wall_clock64() - w0 < ticks) __builtin_amdgcn_s_sleep(32); }
#endif
#if defined(XATTN_CHECK) && XATTN_CHECK
    GRID_BAR();
    if (blockIdx.x == 0 && F.tid < 64) { const unsigned nbad = __hip_atomic_load(F.ctl + CW_CHK + 2, RLX_AGENT), nrun = __hip_atomic_load(F.ctl + CW_CHK + 3, RLX_AGENT);
        if (nbad != 0u) { float pz = 0.f; for (int kk = 3; kk >= 0; --kk) { const unsigned nb = __hip_atomic_load(F.ctl + CW_CHK + 4 + kk, RLX_AGENT); if (nb) pz = 100.0f * (kk + 1) + 10.0f * (float)(nb < 9u ? nb : 9u); } out[F.tid] = pz; }
        else if (nrun != 3u * 2048u + 1024u) out[F.tid] = 50.0f; }
#endif
#if defined(MOBA_CHECK) && MOBA_CHECK
    GRID_BAR();
    if (blockIdx.x == 0 && F.tid < 64) { const unsigned nbad = __hip_atomic_load(F.ctl + CW_CHK, RLX_AGENT), nrun = __hip_atomic_load(F.ctl + CW_CHK + 1, RLX_AGENT);
        if (nbad != 0u) out[F.tid] = 1000.0f + (float)nbad;
        else if (nrun != 4096u) out[F.tid] = 500.0f + (float)nrun; }
#endif
#undef IN
#undef BOTH
#undef GRID_BAR
}

extern "C" void kernel_launch(void* const* d_in, const int* in_sizes, int n_in, void* d_out, int out_size, void* d_ws, size_t ws_size, hipStream_t stream) {
    static int grid = 0;
    if (grid == 0) {
        if (n_in != 18 || in_sizes[0] != M * DM || out_size != M * DM || ws_size < WS_END) { fprintf(stderr, "kernel_launch: shape / workspace mismatch (n_in %d, in0 %d, out %d, ws %zu, need %zu)\n", n_in, n_in > 0 ? in_sizes[0] : -1, out_size, ws_size, (size_t)WS_END); grid = -1; return; }
        int dev = 0, cus = 0, per_cu = 0;
        if (hipGetDevice(&dev) != hipSuccess || hipDeviceGetAttribute(&cus, hipDeviceAttributeMultiprocessorCount, dev) != hipSuccess) { grid = -1; return; }
        if (hipFuncSetAttribute((const void*)mega_fwd, hipFuncAttributeMaxDynamicSharedMemorySize, LDS_BYTES) != hipSuccess) { fprintf(stderr, "kernel_launch: hipFuncSetAttribute failed\n"); grid = -1; return; }
        if (hipOccupancyMaxActiveBlocksPerMultiprocessor(&per_cu, (const void*)mega_fwd, NWAVES * 64, LDS_BYTES) != hipSuccess || per_cu < 1)
            fprintf(stderr, "kernel_launch: note: occupancy query reports %d workgroups per CU\n", per_cu);
        (void)hipGetLastError();
        grid = cus;
        if (grid != 256) fprintf(stderr, "kernel_launch: %d CUs; the cross-attention score phase needs a 256-workgroup grid\n", grid);
    }
    if (grid < 0) return;
    if (hipMemsetAsync((char*)d_ws + WS_CTL, 0, CTL_ZERO_BYTES, stream) != hipSuccess) return;
    Args a{};
    for (int i = 0; i < 18; ++i) a.in[i] = (const float*)d_in[i];
    a.out = (float*)d_out; a.ws = (unsigned char*)d_ws; a.pad = 0;
    for (int li = 0; li < N_LAUNCHES; ++li) {
        a.ph_lo = (N_LAUNCHES == 1) ? 0 : li; a.ph_hi = (N_LAUNCHES == 1) ? N_PHASES : li + 1; a.li = li;
        hipLaunchKernelGGL(mega_fwd, dim3(grid), dim3(NWAVES * 64), LDS_BYTES, stream, a);
        if (hipPeekAtLastError() != hipSuccess) { fprintf(stderr, "kernel_launch: launch %d failed\n", li); break; }
    }
}
```
